# Optimizing an MI355X kernel written in HIP

```python
import math
import jax, jax.numpy as jnp
from jax import lax
import numpy as np


D_MODEL = 1024
BATCH = 4
SEQ = 4096
DEPTH = 2

HY_WIDTH = 512
HY_ORDER = 2
HY_EMB = 33
HY_FFN = 64
HY_SHORT = 3
HY_FAST_DECAY = 0.3
HY_SLOW_DECAY = 1.5
HY_TARGET = 1e-2
HY_FILTER_SCALE = 0.03
DA_HEADS = 4
DA_HEAD_DIM = 64
DA_V_DIM = 2 * DA_HEAD_DIM
DA_QK_WIDTH = DA_HEADS * 2 * DA_HEAD_DIM
DA_V_WIDTH = DA_HEADS * DA_V_DIM
Q_BLOCK = 128
ROPE_THETA = 10000.0
N_BRANCH = 2
IN_WIDTH = (HY_ORDER + 1) * HY_WIDTH + 2 * DA_QK_WIDTH + DA_V_WIDTH + N_BRANCH * D_MODEL
N_EXPERTS = 16
EC_FACTOR = 2
D_EXPERT = 2048
NORM_EPS = 1e-6
SUBLN_EPS = 1e-5

kernel_name = "hybrid_hyena_diffattn_ec_moe_encoder"


def rms_norm(x, g, eps=NORM_EPS):
    xf = x.astype(jnp.float32)
    y = xf * lax.rsqrt(jnp.mean(xf * xf, axis=-1, keepdims=True) + eps) * g.astype(jnp.float32)
    return y.astype(x.dtype)


def rope(x, pos):
    dh = x.shape[-1]
    half = dh // 2
    inv = ROPE_THETA ** (-jnp.arange(half, dtype=jnp.float32) * 2.0 / dh)
    ang = pos[:, None] * inv[None, :]
    cos = jnp.cos(ang)[None, :, None, :]
    sin = jnp.sin(ang)[None, :, None, :]
    xf = x.astype(jnp.float32)
    x1, x2 = xf[..., :half], xf[..., half:]
    out = jnp.concatenate([x1 * cos - x2 * sin, x2 * cos + x1 * sin], axis=-1)
    return out.astype(x.dtype)


def hyena_filters(L, w1, b1, f1, w2, b2, f2, w3):
    t = jnp.linspace(0.0, 1.0, L, dtype=jnp.float32)
    bands = (HY_EMB - 1) // 2
    w = 2.0 * math.pi * jnp.arange(L, dtype=jnp.float32) / L
    fr = jnp.linspace(1e-4, bands - 1, bands, dtype=jnp.float32)
    ang = w[:, None] * fr[None, :]
    z = jnp.concatenate([t[:, None], jnp.cos(ang), -jnp.sin(ang)], axis=-1)
    h = jnp.sin(f1.astype(jnp.float32) * (z @ w1.astype(jnp.float32) + b1.astype(jnp.float32)))
    h = jnp.sin(f2.astype(jnp.float32) * (h @ w2.astype(jnp.float32) + b2.astype(jnp.float32)))
    h = h @ w3.astype(jnp.float32)
    h = h.reshape(L, HY_ORDER, 2, HY_WIDTH).transpose(1, 2, 0, 3)
    min_decay = math.log(HY_TARGET) / HY_FAST_DECAY
    max_decay = math.log(HY_TARGET) / HY_SLOW_DECAY
    deltas = jnp.abs(jnp.linspace(min_decay, max_decay, HY_WIDTH, dtype=jnp.float32))
    decay = jnp.exp(-t[:, None] * deltas[None, :])
    return h * decay[None, None]


def bidir_fftconv(z, h_fwd, h_bwd, d_bias):
    L, C = z.shape[1], z.shape[2]
    h_full = jnp.concatenate([h_fwd, jnp.zeros((1, C), jnp.float32), h_bwd[1:][::-1]], axis=0)
    hf = jnp.fft.rfft(h_full, n=2 * L, axis=0)
    zf = jnp.fft.rfft(z.astype(jnp.float32), n=2 * L, axis=1)
    y = jnp.fft.irfft(zf * hf[None], n=2 * L, axis=1)[:, :L]
    y = y + z.astype(jnp.float32) * d_bias.astype(jnp.float32)
    return y.astype(z.dtype)


def hyena_branch(u, conv_w, conv_b, filters, d_bias):
    up = jnp.pad(u, ((0, 0), (1, 1), (0, 0)))
    uc = up[:, :-2] * conv_w[0] + up[:, 1:-1] * conv_w[1] + up[:, 2:] * conv_w[2] + conv_b
    v, x1, x2 = jnp.split(uc, HY_ORDER + 1, axis=-1)
    z = v
    for o, gate in enumerate((x1, x2)):
        z = gate * bidir_fftconv(z, filters[o, 0], filters[o, 1], d_bias[o])
    return z


def diff_attention(q, k, v, lam, lam_init, subln_g):
    B, S = q.shape[0], q.shape[1]
    nb = S // Q_BLOCK
    scale = DA_HEAD_DIM ** -0.5
    qb = (q * scale).reshape(B, nb, Q_BLOCK, DA_HEADS, 2, DA_HEAD_DIM).transpose(1, 0, 3, 4, 2, 5)
    kh = k.reshape(B, S, DA_HEADS, 2, DA_HEAD_DIM).transpose(0, 2, 3, 1, 4)
    vh = v.transpose(0, 2, 1, 3)

    def block(qblk):
        s = jnp.einsum('bhcqd,bhckd->bhcqk', qblk, kh).astype(jnp.float32)
        p = jax.nn.softmax(s, axis=-1)
        a = p[:, :, 0] - lam * p[:, :, 1]
        return jnp.einsum('bhqk,bhkv->bhqv', a.astype(vh.dtype), vh)

    o = lax.map(block, qb)
    o = o.transpose(1, 0, 3, 2, 4).reshape(B, S, DA_HEADS, DA_V_DIM)
    o = rms_norm(o, subln_g, SUBLN_EPS) * (1.0 - lam_init)
    return o.reshape(B, S, DA_V_WIDTH)


def ec_moe(n, w_r, b_r, w_gate, w_up, w_down):
    B, S, D = n.shape
    cap = EC_FACTOR * S // N_EXPERTS
    logits = (n @ w_r + b_r).astype(jnp.float32)
    aff = jax.nn.softmax(logits, axis=-1)
    g, idx = lax.top_k(aff.transpose(0, 2, 1), cap)
    xg = jax.vmap(lambda xb, ib: xb[ib])(n, idx)
    hdn = jax.nn.silu(jnp.einsum('becd,edf->becf', xg, w_gate)) * jnp.einsum('becd,edf->becf', xg, w_up)
    ye = jnp.einsum('becf,efd->becd', hdn, w_down) * g[..., None].astype(n.dtype)
    flat = (jnp.arange(B, dtype=jnp.int32)[:, None, None] * S + idx).reshape(-1)
    out = jnp.zeros((B * S, D), n.dtype).at[flat].add(ye.reshape(-1, D))
    return out.reshape(B, S, D)


def setup_inputs(seed: int = 0) -> dict:
    key = jax.random.key(seed)
    ks = jax.random.split(key, 32)

    def nrm(k, shape, scale):
        return jax.random.normal(k, shape, jnp.float32) * scale

    C = HY_WIDTH
    E = N_EXPERTS
    F = D_EXPERT
    return {
        "x": nrm(ks[0], (BATCH, SEQ, D_MODEL), 1.0),
        "norm_mix": 1.0 + nrm(ks[1], (DEPTH, D_MODEL), 0.02),
        "w_in": nrm(ks[2], (DEPTH, D_MODEL, IN_WIDTH), D_MODEL ** -0.5),
        "b_in": nrm(ks[3], (DEPTH, IN_WIDTH), 0.02),
        "hy_conv_w": nrm(ks[4], (DEPTH, HY_SHORT, (HY_ORDER + 1) * C), HY_SHORT ** -0.5),
        "hy_conv_b": nrm(ks[5], (DEPTH, (HY_ORDER + 1) * C), 0.02),
        "hy_ffn_w1": nrm(ks[6], (DEPTH, HY_EMB, HY_FFN), HY_EMB ** -0.5),
        "hy_ffn_b1": nrm(ks[7], (DEPTH, HY_FFN), 0.02),
        "hy_ffn_f1": 1.0 + nrm(ks[8], (DEPTH, HY_FFN), 0.02),
        "hy_ffn_w2": nrm(ks[9], (DEPTH, HY_FFN, HY_FFN), HY_FFN ** -0.5),
        "hy_ffn_b2": nrm(ks[10], (DEPTH, HY_FFN), 0.02),
        "hy_ffn_f2": 1.0 + nrm(ks[11], (DEPTH, HY_FFN), 0.02),
        "hy_ffn_w3": nrm(ks[12], (DEPTH, HY_FFN, HY_ORDER * 2 * C), HY_FILTER_SCALE * HY_FFN ** -0.5),
        "hy_bias": nrm(ks[13], (DEPTH, HY_ORDER, C), 0.2),
        "lambda_q1": nrm(ks[14], (DEPTH, DA_HEAD_DIM), 0.1),
        "lambda_k1": nrm(ks[15], (DEPTH, DA_HEAD_DIM), 0.1),
        "lambda_q2": nrm(ks[16], (DEPTH, DA_HEAD_DIM), 0.1),
        "lambda_k2": nrm(ks[17], (DEPTH, DA_HEAD_DIM), 0.1),
        "subln_g": 1.0 + nrm(ks[18], (DEPTH, DA_V_DIM), 0.02),
        "w_up_hyena": nrm(ks[19], (DEPTH, C, D_MODEL), C ** -0.5),
        "w_up_attn": nrm(ks[20], (DEPTH, DA_V_WIDTH, D_MODEL), DA_V_WIDTH ** -0.5),
        "w_out": nrm(ks[21], (DEPTH, D_MODEL, D_MODEL), D_MODEL ** -0.5),
        "norm_ffn": 1.0 + nrm(ks[22], (DEPTH, D_MODEL), 0.02),
        "w_router": nrm(ks[23], (DEPTH, D_MODEL, E), D_MODEL ** -0.5),
        "b_router": nrm(ks[24], (DEPTH, E), 0.01),
        "w_e_gate": nrm(ks[25], (DEPTH, E, D_MODEL, F), D_MODEL ** -0.5),
        "w_e_up": nrm(ks[26], (DEPTH, E, D_MODEL, F), D_MODEL ** -0.5),
        "w_e_down": nrm(ks[27], (DEPTH, E, F, D_MODEL), F ** -0.5),
        "norm_final": 1.0 + nrm(ks[28], (D_MODEL,), 0.02),
    }


def reference(x, norm_mix, w_in, b_in, hy_conv_w, hy_conv_b, hy_ffn_w1, hy_ffn_b1, hy_ffn_f1,
              hy_ffn_w2, hy_ffn_b2, hy_ffn_f2, hy_ffn_w3, hy_bias, lambda_q1, lambda_k1, lambda_q2,
              lambda_k2, subln_g, w_up_hyena, w_up_attn, w_out, norm_ffn, w_router, b_router,
              w_e_gate, w_e_up, w_e_down, norm_final):
    B, S, D = x.shape
    pos = jnp.arange(S, dtype=jnp.float32)
    splits = np.cumsum([(HY_ORDER + 1) * HY_WIDTH, DA_QK_WIDTH, DA_QK_WIDTH, DA_V_WIDTH, D_MODEL]).tolist()
    for l in range(DEPTH):
        n = rms_norm(x, norm_mix[l])
        p = n @ w_in[l] + b_in[l]
        u_hy, q, k, v, g_hy, g_da = jnp.split(p, splits, axis=-1)

        filt = hyena_filters(S, hy_ffn_w1[l], hy_ffn_b1[l], hy_ffn_f1[l], hy_ffn_w2[l],
                             hy_ffn_b2[l], hy_ffn_f2[l], hy_ffn_w3[l])
        y_hy = hyena_branch(u_hy, hy_conv_w[l], hy_conv_b[l], filt, hy_bias[l])

        q = rope(q.reshape(B, S, 2 * DA_HEADS, DA_HEAD_DIM), pos)
        k = rope(k.reshape(B, S, 2 * DA_HEADS, DA_HEAD_DIM), pos)
        v = v.reshape(B, S, DA_HEADS, DA_V_DIM)
        lam_init = 0.8 - 0.6 * math.exp(-0.3 * l)
        lam = (jnp.exp(jnp.sum(lambda_q1[l].astype(jnp.float32) * lambda_k1[l].astype(jnp.float32)))
               - jnp.exp(jnp.sum(lambda_q2[l].astype(jnp.float32) * lambda_k2[l].astype(jnp.float32)))
               + lam_init)
        y_da = diff_attention(q, k, v, lam, lam_init, subln_g[l])

        gh = jax.nn.sigmoid(g_hy.astype(jnp.float32)).astype(x.dtype)
        ga = jax.nn.sigmoid(g_da.astype(jnp.float32)).astype(x.dtype)
        merged = gh * (y_hy @ w_up_hyena[l]) + ga * (y_da @ w_up_attn[l])
        x = x + merged @ w_out[l]

        x = x + ec_moe(rms_norm(x, norm_ffn[l]), w_router[l], b_router[l],
                       w_e_gate[l], w_e_up[l], w_e_down[l])
    return rms_norm(x, norm_final)
```

```cpp
#include <hip/hip_runtime.h>
#include <hip/hip_cooperative_groups.h>
#include <cstdio>
#include <cstdint>
#include <cmath>
namespace tk {
constexpr int S = 4096, E = 16, CAP = 512, NT = 512;
__device__ __forceinline__ void topk_problem(const float* __restrict__ aff, int tokbase, int e, int slotbase, int* __restrict__ rows, float* __restrict__ gate, int* __restrict__ inv, int* sm) {
    const int tid = threadIdx.x, lane = tid & 63, wid = tid >> 6;
    int* hist = sm; int* ctl = sm + 256;
    unsigned key[8];
    { const uint4 a = ((const uint4*)aff)[tid * 2], b = ((const uint4*)aff)[tid * 2 + 1];
      key[0] = a.x; key[1] = a.y; key[2] = a.z; key[3] = a.w; key[4] = b.x; key[5] = b.y; key[6] = b.z; key[7] = b.w; }
    unsigned prefix = 0u, mask = 0u; int kth = CAP;
    for (int pass = 3; pass >= 0; --pass) {
        __syncthreads();
        if (tid < 256) hist[tid] = 0;
        __syncthreads();
#pragma unroll
        for (int i = 0; i < 8; ++i) if ((key[i] & mask) == prefix) atomicAdd(&hist[(key[i] >> (8 * pass)) & 255u], 1);
        __syncthreads();
        if (tid < 64) {
            const int b0 = hist[4 * lane], b1 = hist[4 * lane + 1], b2 = hist[4 * lane + 2], b3 = hist[4 * lane + 3];
            const int tot = b0 + b1 + b2 + b3;
            int suf = tot;
#pragma unroll
            for (int o = 1; o < 64; o <<= 1) { const int v = __shfl_down(suf, o); if (lane + o < 64) suf += v; }
            const int above = suf - tot;
            if (above < kth && kth <= above + tot) {
                int cum = above, bin, k2;
                if (cum + b3 >= kth) { bin = 4 * lane + 3; k2 = kth - cum; }
                else { cum += b3; if (cum + b2 >= kth) { bin = 4 * lane + 2; k2 = kth - cum; }
                else { cum += b2; if (cum + b1 >= kth) { bin = 4 * lane + 1; k2 = kth - cum; }
                else { cum += b1; bin = 4 * lane; k2 = kth - cum; } } }
                ctl[0] = bin; ctl[1] = k2;
            }
        }
        __syncthreads();
        prefix |= ((unsigned)ctl[0]) << (8 * pass); mask |= 0xFFu << (8 * pass); kth = ctl[1];
    }
    const unsigned thr = prefix; const int need_eq = kth; const int n_gt = CAP - need_eq;
    int cg = 0, ce = 0;
#pragma unroll
    for (int i = 0; i < 8; ++i) { cg += key[i] > thr; ce += key[i] == thr; }
    int sg = cg, se = ce;
#pragma unroll
    for (int o = 1; o < 64; o <<= 1) { const int a = __shfl_up(sg, o), b = __shfl_up(se, o); if (lane >= o) { sg += a; se += b; } }
    __syncthreads();
    if (lane == 63) { ctl[8 + wid] = sg; ctl[16 + wid] = se; }
    __syncthreads();
    int og = sg - cg, oe = se - ce;
    for (int w = 0; w < wid; ++w) { og += ctl[8 + w]; oe += ctl[16 + w]; }
#pragma unroll
    for (int i = 0; i < 8; ++i) {
        const int idx = tid * 8 + i; int slot = -1;
        if (key[i] > thr) slot = og++;
        else if (key[i] == thr) { if (oe < need_eq) slot = n_gt + oe; ++oe; }
        if (slot >= 0) { rows[slot] = tokbase + idx; gate[slot] = __uint_as_float(key[i]); }
        inv[(size_t)(tokbase + idx) * E + e] = slot >= 0 ? slotbase + slot : -1;
    }
    __syncthreads();
}
}
namespace nv {
constexpr int D = 1024, B = 4, S = 4096, T = B * S, DEPTH = 2, C = 512, INW = 5120, E = 16, CAP = 512, F = 2048;

__device__ __forceinline__ float wave_sum(float v) {
#pragma unroll
    for (int o = 1; o < 64; o <<= 1) v += __shfl_xor(v, o);
    return v;
}
__device__ __forceinline__ float wave_max(float v) {
#pragma unroll
    for (int o = 1; o < 64; o <<= 1) v = fmaxf(v, __shfl_xor(v, o));
    return v;
}

__global__ void rmsnorm_rows(const float* __restrict__ x, const float* __restrict__ g, float* __restrict__ out, int rows, float eps) {
    const int lane = threadIdx.x & 63, w = (blockIdx.x * blockDim.x + threadIdx.x) >> 6;
    if (w >= rows) return;
    const float4* xr = (const float4*)(x + (size_t)w * D);
    float4 v[4]; float s = 0.f;
#pragma unroll
    for (int j = 0; j < 4; ++j) { v[j] = xr[lane + 64 * j]; s += v[j].x * v[j].x + v[j].y * v[j].y + v[j].z * v[j].z + v[j].w * v[j].w; }
    s = wave_sum(s);
    const float r = rsqrtf(s * (1.f / D) + eps);
    float4* o = (float4*)(out + (size_t)w * D);
#pragma unroll
    for (int j = 0; j < 4; ++j) { const float4 gg = ((const float4*)g)[lane + 64 * j]; float4 y; y.x = v[j].x * r * gg.x; y.y = v[j].y * r * gg.y; y.z = v[j].z * r * gg.z; y.w = v[j].w * r * gg.w; o[lane + 64 * j] = y; }
}

template <bool TB>
__global__ void __launch_bounds__(256) gemm_naive(const float* __restrict__ A, int lda, const int* __restrict__ arow, const float* __restrict__ Bm, int ldb,
                                                  float* __restrict__ Cm, int ldc, int K, const float* __restrict__ bias, const float* __restrict__ R, int ldr,
                                                  size_t sA, size_t sB, size_t sC) {
    __shared__ float As[8][132], Bs[8][132];
    A += blockIdx.z * sA; Bm += blockIdx.z * sB; Cm += blockIdx.z * sC;
    const int tid = threadIdx.x, tx = tid & 15, ty = tid >> 4;
    const int m0 = blockIdx.y * 128, n0 = blockIdx.x * 128;
    float acc[8][8];
#pragma unroll
    for (int i = 0; i < 8; ++i)
#pragma unroll
        for (int j = 0; j < 8; ++j) acc[i][j] = 0.f;
    const int ar = tid >> 1, ak = (tid & 1) * 4;
    const size_t arow_g = arow ? (size_t)arow[m0 + ar] : (size_t)(m0 + ar);
    const float* ap = A + arow_g * lda + ak;
    for (int k0 = 0; k0 < K; k0 += 8) {
        const float4 av = *(const float4*)(ap + k0);
        As[ak + 0][ar] = av.x; As[ak + 1][ar] = av.y; As[ak + 2][ar] = av.z; As[ak + 3][ar] = av.w;
        if (TB) {
            const float4 bv = *(const float4*)(Bm + (size_t)(n0 + ar) * ldb + k0 + ak);
            Bs[ak + 0][ar] = bv.x; Bs[ak + 1][ar] = bv.y; Bs[ak + 2][ar] = bv.z; Bs[ak + 3][ar] = bv.w;
        } else {
            const int bk = tid >> 5, bn = (tid & 31) * 4;
            const float4 bv = *(const float4*)(Bm + (size_t)(k0 + bk) * ldb + n0 + bn);
            Bs[bk][bn] = bv.x; Bs[bk][bn + 1] = bv.y; Bs[bk][bn + 2] = bv.z; Bs[bk][bn + 3] = bv.w;
        }
        __syncthreads();
#pragma unroll
        for (int kk = 0; kk < 8; ++kk) {
            float a[8], b[8];
#pragma unroll
            for (int i = 0; i < 8; ++i) a[i] = As[kk][ty * 8 + i];
#pragma unroll
            for (int j = 0; j < 8; ++j) b[j] = Bs[kk][tx * 8 + j];
#pragma unroll
            for (int i = 0; i < 8; ++i)
#pragma unroll
                for (int j = 0; j < 8; ++j) acc[i][j] += a[i] * b[j];
        }
        __syncthreads();
    }
#pragma unroll
    for (int i = 0; i < 8; ++i) {
        const int m = m0 + ty * 8 + i;
#pragma unroll
        for (int j = 0; j < 8; ++j) {
            const int n = n0 + tx * 8 + j; float v = acc[i][j];
            if (bias) v += bias[n];
            if (R) v += R[(size_t)m * ldr + n];
            Cm[(size_t)m * ldc + n] = v;
        }
    }
}

__global__ void __launch_bounds__(256) hyena_filters(const float* __restrict__ w1, const float* __restrict__ b1, const float* __restrict__ f1, const float* __restrict__ w2,
                                                     const float* __restrict__ b2, const float* __restrict__ f2, const float* __restrict__ w3, float* __restrict__ filt) {
    __shared__ float z[33], h1[64], h2[64];
    const int t = blockIdx.x, tid = threadIdx.x;
    const float tt = (float)t / (float)(S - 1);
    if (tid < 33) {
        float v;
        if (tid == 0) v = tt;
        else { const int j = (tid - 1) & 15; const float w = 2.0f * 3.14159265358979323846f * (float)t / (float)S; const float fr = 1e-4f + (float)j * ((15.0f - 1e-4f) / 15.0f); const float ang = w * fr; v = (tid <= 16) ? cosf(ang) : -sinf(ang); }
        z[tid] = v;
    }
    __syncthreads();
    if (tid < 64) { float a = b1[tid]; for (int i = 0; i < 33; ++i) a += z[i] * w1[i * 64 + tid]; h1[tid] = sinf(f1[tid] * a); }
    __syncthreads();
    if (tid < 64) { float a = b2[tid]; for (int i = 0; i < 64; ++i) a += h1[i] * w2[i * 64 + tid]; h2[tid] = sinf(f2[tid] * a); }
    __syncthreads();
    const float min_decay = logf(1e-2f) / 0.3f, max_decay = logf(1e-2f) / 1.5f;
    for (int n = tid; n < 2048; n += 256) {
        float a = 0.f; for (int i = 0; i < 64; ++i) a += h2[i] * w3[i * 2048 + n];
        const int c = n & 511, od = n >> 9;
        const float delta = fabsf(min_decay + (float)c * ((max_decay - min_decay) / 511.0f));
        a *= expf(-tt * delta);
        filt[((size_t)od * S + t) * C + c] = a;
    }
}

__global__ void shortconv(const float* __restrict__ P, const float* __restrict__ cw, const float* __restrict__ cb, float* __restrict__ uc) {
    const size_t i = (size_t)blockIdx.x * blockDim.x + threadIdx.x;
    if (i >= (size_t)T * 1536) return;
    const int ch = (int)(i % 1536); const int tok = (int)(i / 1536); const int t = tok & (S - 1);
    const float* p = P + (size_t)tok * INW + ch;
    float v = p[0] * cw[1536 + ch] + cb[ch];
    if (t > 0) v += p[-INW] * cw[ch];
    if (t < S - 1) v += p[INW] * cw[2 * 1536 + ch];
    uc[i] = v;
}

__global__ void __launch_bounds__(256) longconv_naive(const float* __restrict__ z, int ldz, const float* __restrict__ gate, int ldg, const float* __restrict__ hf, const float* __restrict__ hb,
                                                      const float* __restrict__ bias, float* __restrict__ out, int ldo) {
    const int c = blockIdx.x * 64 + (threadIdx.x & 63), tg = threadIdx.x >> 6, b = blockIdx.z;
    const int t0 = (blockIdx.y * 4 + tg) * 16;
    const float* zb = z + (size_t)b * S * ldz + c;
    float acc[16], ring[16];
#pragma unroll
    for (int i = 0; i < 16; ++i) acc[i] = 0.f;
    auto H = [&](int d) -> float { if (d >= 0) return d < S ? hf[(size_t)d * C + c] : 0.f; const int e = -d; return e < S ? hb[(size_t)e * C + c] : 0.f; };
#pragma unroll
    for (int i = 0; i < 16; ++i) ring[i] = H(t0 + i);
    for (int s0 = 0; s0 < S; s0 += 16) {
#pragma unroll
        for (int j = 0; j < 16; ++j) {
            const float zs = zb[(size_t)(s0 + j) * ldz];
#pragma unroll
            for (int i = 0; i < 16; ++i) acc[i] += ring[(i - j) & 15] * zs;
            ring[(15 - j) & 15] = H(t0 - 1 - j - s0);
        }
    }
#pragma unroll
    for (int i = 0; i < 16; ++i) {
        const size_t tok = (size_t)b * S + t0 + i;
        const float zz = z[tok * ldz + c];
        out[tok * ldo + c] = gate[tok * ldg + c] * (acc[i] + bias[c] * zz);
    }
}

__global__ void rope_qk(float* __restrict__ P) {
    const size_t i = (size_t)blockIdx.x * blockDim.x + threadIdx.x;
    if (i >= (size_t)T * 16 * 32) return;
    const int j = (int)(i & 31), hd = (int)((i >> 5) & 15); const size_t tok = i >> 9; const int pos = (int)(tok & (S - 1));
    const float inv = powf(10000.0f, -(float)j * 2.0f / 64.0f);
    const float ang = (float)pos * inv; const float cs = cosf(ang), sn = sinf(ang);
    float* p = P + tok * INW + 1536 + hd * 64 + j;
    const float x1 = p[0], x2 = p[32];
    p[0] = x1 * cs - x2 * sn; p[32] = x2 * cs + x1 * sn;
}

__device__ __forceinline__ float block_reduce_max(float v, float* sm) {
    v = wave_max(v); __syncthreads(); if ((threadIdx.x & 63) == 0) sm[threadIdx.x >> 6] = v; __syncthreads();
    float r = sm[0]; for (int i = 1; i < (int)(blockDim.x >> 6); ++i) r = fmaxf(r, sm[i]); return r;
}
__device__ __forceinline__ float block_reduce_sum(float v, float* sm) {
    v = wave_sum(v); __syncthreads(); if ((threadIdx.x & 63) == 0) sm[threadIdx.x >> 6] = v; __syncthreads();
    float r = 0.f; for (int i = 0; i < (int)(blockDim.x >> 6); ++i) r += sm[i]; return r;
}
__device__ __forceinline__ float lam_value(const float* q1, const float* k1, const float* q2, const float* k2, float lam_init) {
    float a = 0.f, b = 0.f; for (int i = 0; i < 64; ++i) { a += q1[i] * k1[i]; b += q2[i] * k2[i]; }
    return expf(a) - expf(b) + lam_init;
}
__global__ void __launch_bounds__(256) softmax_diff(float* __restrict__ SB, const float* q1, const float* k1, const float* q2, const float* k2, float lam_init) {
    __shared__ float sm[8];
    const int r = blockIdx.x; float* s0 = SB + (size_t)r * S; float* s1 = SB + (size_t)S * S + (size_t)r * S;
    const float lam = lam_value(q1, k1, q2, k2, lam_init);
    float m0 = -1e30f, m1 = -1e30f;
    for (int i = threadIdx.x; i < S; i += 256) { m0 = fmaxf(m0, s0[i]); m1 = fmaxf(m1, s1[i]); }
    m0 = block_reduce_max(m0, sm); m1 = block_reduce_max(m1, sm);
    float l0 = 0.f, l1 = 0.f;
    for (int i = threadIdx.x; i < S; i += 256) { l0 += expf((s0[i] - m0) * 0.125f); l1 += expf((s1[i] - m1) * 0.125f); }
    l0 = block_reduce_sum(l0, sm); l1 = block_reduce_sum(l1, sm);
    const float i0 = 1.f / l0, i1 = lam / l1;
    for (int i = threadIdx.x; i < S; i += 256) s0[i] = expf((s0[i] - m0) * 0.125f) * i0 - expf((s1[i] - m1) * 0.125f) * i1;
}
__global__ void subln(float* __restrict__ OA, const float* __restrict__ g, float mul) {
    const int lane = threadIdx.x & 63; const size_t w = ((size_t)blockIdx.x * blockDim.x + threadIdx.x) >> 6;
    if (w >= (size_t)T * 4) return;
    float* p = OA + w * 128; const float a = p[lane], b = p[lane + 64];
    const float s = wave_sum(a * a + b * b); const float r = rsqrtf(s * (1.f / 128.f) + 1e-5f) * mul;
    p[lane] = a * r * g[lane]; p[lane + 64] = b * r * g[lane + 64];
}
__device__ __forceinline__ float sigmoidf_(float x) { return 1.f / (1.f + expf(-x)); }
__global__ void merge_gates(const float* __restrict__ P, const float* __restrict__ UH, const float* __restrict__ UA, float* __restrict__ out) {
    const size_t i = (size_t)blockIdx.x * blockDim.x + threadIdx.x; if (i >= (size_t)T * D) return;
    const size_t tok = i >> 10; const int n = (int)(i & 1023);
    out[i] = sigmoidf_(P[tok * INW + 3072 + n]) * UH[i] + sigmoidf_(P[tok * INW + 4096 + n]) * UA[i];
}
__global__ void router_aff(const float* __restrict__ n2, const float* __restrict__ wr, const float* __restrict__ br, float* __restrict__ afft) {
    const int lane = threadIdx.x & 63; const size_t tok = ((size_t)blockIdx.x * blockDim.x + threadIdx.x) >> 6; if (tok >= (size_t)T) return;
    float acc[16];
#pragma unroll
    for (int e = 0; e < 16; ++e) acc[e] = 0.f;
    for (int k = lane; k < D; k += 64) { const float xv = n2[tok * D + k]; const float4* w = (const float4*)(wr + (size_t)k * 16);
#pragma unroll
        for (int q = 0; q < 4; ++q) { const float4 ww = w[q]; acc[q * 4] += xv * ww.x; acc[q * 4 + 1] += xv * ww.y; acc[q * 4 + 2] += xv * ww.z; acc[q * 4 + 3] += xv * ww.w; } }
    float mx = -1e30f;
#pragma unroll
    for (int e = 0; e < 16; ++e) { acc[e] = wave_sum(acc[e]) + br[e]; mx = fmaxf(mx, acc[e]); }
    float l = 0.f;
#pragma unroll
    for (int e = 0; e < 16; ++e) { acc[e] = expf(acc[e] - mx); l += acc[e]; }
    const int b = (int)(tok >> 12), s = (int)(tok & (S - 1));
    if (lane < 16) { float v = 0.f;
#pragma unroll
        for (int e = 0; e < 16; ++e) if (lane == e) v = acc[e];
        afft[((size_t)b * E + lane) * S + s] = v / l; }
}
__global__ void silu_mul(const float* __restrict__ g1, const float* __restrict__ u1, float* __restrict__ out, size_t n) {
    const size_t i = (size_t)blockIdx.x * blockDim.x + threadIdx.x; if (i >= n) return;
    const float g = g1[i]; out[i] = g / (1.f + expf(-g)) * u1[i];
}
__global__ void moe_combine(const float* __restrict__ x, const float* __restrict__ YE, const int* __restrict__ inv, const float* __restrict__ gate, float* __restrict__ xo) {
    const int lane = threadIdx.x & 63; const size_t tok = ((size_t)blockIdx.x * blockDim.x + threadIdx.x) >> 6; if (tok >= (size_t)T) return;
    float4 a[4];
#pragma unroll
    for (int j = 0; j < 4; ++j) a[j] = ((const float4*)(x + tok * D))[lane + 64 * j];
    for (int e = 0; e < E; ++e) { const int sl = inv[tok * E + e]; if (sl < 0) continue; const float g = gate[sl]; const float4* y = (const float4*)(YE + (size_t)sl * D);
#pragma unroll
        for (int j = 0; j < 4; ++j) { const float4 v = y[lane + 64 * j]; a[j].x += g * v.x; a[j].y += g * v.y; a[j].z += g * v.z; a[j].w += g * v.w; } }
#pragma unroll
    for (int j = 0; j < 4; ++j) ((float4*)(xo + tok * D))[lane + 64 * j] = a[j];
}
}
namespace nv {
__global__ void __launch_bounds__(512) topk_kernel(const float* __restrict__ afft, int* __restrict__ rows, float* __restrict__ gate, int* __restrict__ inv) {
    __shared__ int sm[320];
    const int p = blockIdx.x, b = p >> 4, e = p & 15; const int slotbase = e * 2048 + b * 512;
    tk::topk_problem(afft + (size_t)p * S, b * S, e, slotbase, rows + slotbase, gate + slotbase, inv, sm);
}
struct Ws {
    float *X0, *X1, *NB, *P, *FILT, *UC, *Z1, *Z2, *SB, *OA, *UH, *UA, *MG, *YE, *G1, *U1, *HD, *AFFT, *GATE; int *INV, *ROWS;
};
constexpr size_t MiB = 1u << 20;
static Ws carve(unsigned char* ws) {
    Ws w; size_t o = 0;
    auto take = [&](size_t mib) { float* p = (float*)(ws + o); o += mib * MiB; return p; };
    w.X0 = take(64); w.X1 = take(64); w.NB = take(64); w.P = take(320); w.FILT = take(32); w.UC = take(96); w.Z1 = take(32); w.Z2 = take(32); w.SB = take(128); w.OA = take(32);
    w.UH = w.SB; w.UA = w.SB + 16 * MiB; w.MG = w.UC;
    unsigned char* pb = (unsigned char*)w.P;
    w.YE = (float*)pb; w.G1 = (float*)(pb + 128 * MiB); w.U1 = (float*)(pb + 144 * MiB); w.HD = (float*)(pb + 160 * MiB); w.AFFT = (float*)(pb + 176 * MiB);
    w.INV = (int*)(pb + 177 * MiB); w.ROWS = (int*)(pb + 178 * MiB); w.GATE = (float*)(pb + 179 * MiB);
    return w;
}
constexpr size_t NAIVE_WS_BYTES = 864 * MiB;

template <bool TB>
static void gemm(hipStream_t st, const float* A, int lda, const int* arow, const float* Bm, int ldb, float* Cm, int ldc, int M, int N, int K, const float* bias, const float* R, int ldr,
                 int batch = 1, size_t sA = 0, size_t sB = 0, size_t sC = 0) {
    gemm_naive<TB><<<dim3(N / 128, M / 128, batch), 256, 0, st>>>(A, lda, arow, Bm, ldb, Cm, ldc, K, bias, R, ldr, sA, sB, sC);
}
static void naive_layer(hipStream_t st, void* const* d_in, const Ws& w, int l, const float* xin) {
    const float* norm_mix = (const float*)d_in[1]; const float* w_in = (const float*)d_in[2]; const float* b_in = (const float*)d_in[3];
    const float* cw = (const float*)d_in[4]; const float* cb = (const float*)d_in[5];
    const float *fw1 = (const float*)d_in[6], *fb1 = (const float*)d_in[7], *ff1 = (const float*)d_in[8], *fw2 = (const float*)d_in[9], *fb2 = (const float*)d_in[10], *ff2 = (const float*)d_in[11], *fw3 = (const float*)d_in[12];
    const float* hyb = (const float*)d_in[13];
    const float *lq1 = (const float*)d_in[14], *lk1 = (const float*)d_in[15], *lq2 = (const float*)d_in[16], *lk2 = (const float*)d_in[17];
    const float* sg = (const float*)d_in[18]; const float* wuh = (const float*)d_in[19]; const float* wua = (const float*)d_in[20]; const float* wout = (const float*)d_in[21];
    const float* nffn = (const float*)d_in[22]; const float* wr = (const float*)d_in[23]; const float* br = (const float*)d_in[24];
    const float *weg = (const float*)d_in[25], *weu = (const float*)d_in[26], *wed = (const float*)d_in[27];
    const float lam_init = 0.8f - 0.6f * expf(-0.3f * (float)l);
    rmsnorm_rows<<<T / 4, 256, 0, st>>>(xin, norm_mix + l * D, w.NB, T, 1e-6f);
    gemm<false>(st, w.NB, D, nullptr, w_in + (size_t)l * D * INW, INW, w.P, INW, T, INW, D, b_in + l * INW, nullptr, 0);
    hyena_filters<<<S, 256, 0, st>>>(fw1 + l * 33 * 64, fb1 + l * 64, ff1 + l * 64, fw2 + l * 64 * 64, fb2 + l * 64, ff2 + l * 64, fw3 + (size_t)l * 64 * 2048, w.FILT);
    shortconv<<<(T * 1536) / 256, 256, 0, st>>>(w.P, cw + l * 3 * 1536, cb + l * 1536, w.UC);
    const size_t FS = (size_t)S * C;
    longconv_naive<<<dim3(C / 64, S / 64, B), 256, 0, st>>>(w.UC, 1536, w.UC + 512, 1536, w.FILT, w.FILT + FS, hyb + l * 1024, w.Z1, 512);
    longconv_naive<<<dim3(C / 64, S / 64, B), 256, 0, st>>>(w.Z1, 512, w.UC + 1024, 1536, w.FILT + 2 * FS, w.FILT + 3 * FS, hyb + l * 1024 + 512, w.Z2, 512);
    rope_qk<<<(T * 512) / 256, 256, 0, st>>>(w.P);
    for (int b = 0; b < B; ++b)
        for (int h = 0; h < 4; ++h) {
            const float* Pb = w.P + (size_t)b * S * INW;
            gemm<true>(st, Pb + 1536 + 2 * h * 64, INW, nullptr, Pb + 2048 + 2 * h * 64, INW, w.SB, S, S, S, 64, nullptr, nullptr, 0, 2, 64, 64, (size_t)S * S);
            softmax_diff<<<S, 256, 0, st>>>(w.SB, lq1 + l * 64, lk1 + l * 64, lq2 + l * 64, lk2 + l * 64, lam_init);
            gemm<false>(st, w.SB, S, nullptr, Pb + 2560 + h * 128, INW, w.OA + (size_t)b * S * 512 + h * 128, 512, S, 128, S, nullptr, nullptr, 0);
        }
    subln<<<(T * 4) / 4, 256, 0, st>>>(w.OA, sg + l * 128, 1.0f - lam_init);
    gemm<false>(st, w.Z2, 512, nullptr, wuh + (size_t)l * 512 * D, D, w.UH, D, T, D, 512, nullptr, nullptr, 0);
    gemm<false>(st, w.OA, 512, nullptr, wua + (size_t)l * 512 * D, D, w.UA, D, T, D, 512, nullptr, nullptr, 0);
    merge_gates<<<(T * D) / 256, 256, 0, st>>>(w.P, w.UH, w.UA, w.MG);
    gemm<false>(st, w.MG, D, nullptr, wout + (size_t)l * D * D, D, w.X0, D, T, D, D, nullptr, xin, D);
    rmsnorm_rows<<<T / 4, 256, 0, st>>>(w.X0, nffn + l * D, w.NB, T, 1e-6f);
    router_aff<<<T / 4, 256, 0, st>>>(w.NB, wr + (size_t)l * D * E, br + l * E, w.AFFT);
    topk_kernel<<<B * E, 512, 0, st>>>(w.AFFT, w.ROWS, w.GATE, w.INV);
    for (int e = 0; e < E; ++e) {
        const size_t we = (size_t)(l * E + e) * D * F;
        gemm<false>(st, w.NB, D, w.ROWS + e * 2048, weg + we, F, w.G1, F, 2048, F, D, nullptr, nullptr, 0);
        gemm<false>(st, w.NB, D, w.ROWS + e * 2048, weu + we, F, w.U1, F, 2048, F, D, nullptr, nullptr, 0);
        silu_mul<<<(2048 * F) / 256, 256, 0, st>>>(w.G1, w.U1, w.HD, (size_t)2048 * F);
        gemm<false>(st, w.HD, F, nullptr, wed + we, D, w.YE + (size_t)e * 2048 * D, D, 2048, D, F, nullptr, nullptr, 0);
    }
    moe_combine<<<T / 4, 256, 0, st>>>(w.X0, w.YE, w.INV, w.GATE, w.X1);
}
static void naive_forward(hipStream_t st, void* const* d_in, float* d_out, unsigned char* ws) {
    const Ws w = carve(ws);
    naive_layer(st, d_in, w, 0, (const float*)d_in[0]);
    naive_layer(st, d_in, w, 1, w.X1);
    rmsnorm_rows<<<T / 4, 256, 0, st>>>(w.X1, (const float*)d_in[28], d_out, T, 1e-6f);
}
}
extern "C" void kernel_launch(void* const* d_in, const int* in_sizes, int n_in, void* d_out, int out_size, void* d_ws, size_t ws_size, hipStream_t stream) {
    if (n_in != 29 || out_size != nv::T * nv::D || ws_size < nv::NAIVE_WS_BYTES) { fprintf(stderr, "kernel_launch: unexpected sizes n_in %d out %d ws %zu\n", n_in, out_size, ws_size); return; }
    nv::naive_forward(stream, d_in, (float*)d_out, (unsigned char*)d_ws);
}
```

```cpp
#include <hip/hip_runtime.h>
#include <hip/hip_cooperative_groups.h>
#include <cstdio>
#include <cstdint>
#include <cmath>
namespace tk {
constexpr int S = 4096, E = 16, CAP = 512, NT = 512;
__device__ __forceinline__ void topk_problem(const float* __restrict__ aff, int tokbase, int e, int slotbase, int* __restrict__ rows, float* __restrict__ gate, int* __restrict__ inv, int* sm, int tid) {
    const int lane = tid & 63, wid = tid >> 6;
    int* hist = sm; int* ctl = sm + 256;
    unsigned key[8];
    { const uint4 a = ((const uint4*)aff)[tid * 2], b = ((const uint4*)aff)[tid * 2 + 1];
      key[0] = a.x; key[1] = a.y; key[2] = a.z; key[3] = a.w; key[4] = b.x; key[5] = b.y; key[6] = b.z; key[7] = b.w; }
    unsigned prefix = 0u, mask = 0u; int kth = CAP;
    for (int pass = 3; pass >= 0; --pass) {
        __syncthreads();
        if (tid < 256) hist[tid] = 0;
        __syncthreads();
#pragma unroll
        for (int i = 0; i < 8; ++i) if ((key[i] & mask) == prefix) atomicAdd(&hist[(key[i] >> (8 * pass)) & 255u], 1);
        __syncthreads();
        if (tid < 64) {
            const int b0 = hist[4 * lane], b1 = hist[4 * lane + 1], b2 = hist[4 * lane + 2], b3 = hist[4 * lane + 3];
            const int tot = b0 + b1 + b2 + b3;
            int suf = tot;
#pragma unroll
            for (int o = 1; o < 64; o <<= 1) { const int v = __shfl_down(suf, o); if (lane + o < 64) suf += v; }
            const int above = suf - tot;
            if (above < kth && kth <= above + tot) {
                int cum = above, bin, k2;
                if (cum + b3 >= kth) { bin = 4 * lane + 3; k2 = kth - cum; }
                else { cum += b3; if (cum + b2 >= kth) { bin = 4 * lane + 2; k2 = kth - cum; }
                else { cum += b2; if (cum + b1 >= kth) { bin = 4 * lane + 1; k2 = kth - cum; }
                else { cum += b1; bin = 4 * lane; k2 = kth - cum; } } }
                ctl[0] = bin; ctl[1] = k2;
            }
        }
        __syncthreads();
        prefix |= ((unsigned)ctl[0]) << (8 * pass); mask |= 0xFFu << (8 * pass); kth = ctl[1];
    }
    const unsigned thr = prefix; const int need_eq = kth; const int n_gt = CAP - need_eq;
    int cg = 0, ce = 0;
#pragma unroll
    for (int i = 0; i < 8; ++i) { cg += key[i] > thr; ce += key[i] == thr; }
    int sg = cg, se = ce;
#pragma unroll
    for (int o = 1; o < 64; o <<= 1) { const int a = __shfl_up(sg, o), b = __shfl_up(se, o); if (lane >= o) { sg += a; se += b; } }
    __syncthreads();
    if (lane == 63) { ctl[8 + wid] = sg; ctl[16 + wid] = se; }
    __syncthreads();
    int og = sg - cg, oe = se - ce;
    for (int w = 0; w < wid; ++w) { og += ctl[8 + w]; oe += ctl[16 + w]; }
#pragma unroll
    for (int i = 0; i < 8; ++i) {
        const int idx = tid * 8 + i; int slot = -1;
        if (key[i] > thr) slot = og++;
        else if (key[i] == thr) { if (oe < need_eq) slot = n_gt + oe; ++oe; }
        if (slot >= 0) { rows[slot] = tokbase + idx; gate[slot] = __uint_as_float(key[i]); }
        inv[(size_t)(tokbase + idx) * E + e] = slot >= 0 ? slotbase + slot : -1;
    }
    __syncthreads();
}
}
namespace pg8 {
#define PG8_LAS __attribute__((address_space(3)))
typedef unsigned short bf16_t;
typedef short bf16x8 __attribute__((ext_vector_type(8)));
typedef float f32x4 __attribute__((ext_vector_type(4)));
typedef unsigned u32x4 __attribute__((ext_vector_type(4)));
constexpr int BM = 256, BK = 64, HALF = 128, HTB = HALF * BK * 2  , STAGE_BYTES = 8 * HTB, NXCD = 8, WGM = 8;

__host__ __device__ __forceinline__ int lds_byte(int r, int c) { const int st = (r >> 4) * 2 + (c >> 5), rr = r & 15, cc = c & 31, ob = rr * 64 + cc * 2; return st * 1024 + (ob ^ (((ob >> 9) & 1) << 5)); }
__host__ __device__ __forceinline__ void stage_rc(int b, int& R, int& C) { const int st = b / 1024, sb = b % 1024, swz = sb ^ (((sb >> 9) & 1) << 5); R = (st >> 1) * 16 + swz / 64; C = (st & 1) * 32 + (swz % 64) / 2; }
__host__ __device__ __forceinline__ int perm32(int rho) { const int n = rho >> 4, i = rho & 15; return 8 * (i >> 2) + 4 * n + (i & 3); }

struct Unit { int pm, pn, pb; };
struct Gemm { const bf16_t* A; const bf16_t* Bt; int M, N, K; };

struct StaticOrder {
    int nM, nN, nwg, G, c;
    __host__ __device__ void init(int M, int N, int G_, int c_) { nM = M / BM; nN = N / BM; nwg = nM * nN; G = G_; c = c_; }
    __host__ __device__ bool next(int i, Unit& u) const {
        const long L = (long)i * G + c; if (L >= nwg) return false;
        int wgid = (int)L; { const int q = nwg / NXCD, r = nwg % NXCD, xcd = wgid % NXCD, off = wgid / NXCD; wgid = (xcd < r ? xcd * (q + 1) : r * (q + 1) + (xcd - r) * q) + off; }
        const int nig = WGM * nN, gid = wgid / nig, fm = gid * WGM, gsz = (nM - fm) < WGM ? (nM - fm) : WGM;
        u.pm = fm + ((wgid % nig) % gsz); u.pn = (wgid % nig) / gsz; u.pb = u.pn; return true;
    }
    __device__ __forceinline__ void a_ready(const Unit&) const {}
    __device__ __forceinline__ void done(const Unit&) const {}
};

template <class Epi, class Sched, bool ALIGN_EPI = false, bool SP2 = false>
__device__ __forceinline__ void gemm_phase(PG8_LAS unsigned char* lds, const Gemm g, const Sched& S, const Epi& E) {
    int tid = threadIdx.x; asm volatile("" : "+v"(tid));
    const int wid = __builtin_amdgcn_readfirstlane(tid >> 6), lane = tid & 63, wr = wid >> 2, wc = wid & 3, fr = lane & 15, fq = lane >> 4;
    const int K = g.K, nt = K / BK;
    unsigned voffA[2], voffB[2];
#pragma unroll
    for (int i = 0; i < 2; ++i) { int R, C; stage_rc(tid * 16 + i * 8192, R, C); const int Rb = Epi::PERM ? ((R & ~31) + perm32(R & 31)) : R;
        voffA[i] = (unsigned)(R * K + C) * 2u; voffB[i] = (unsigned)(Rb * K + C) * 2u; }
    const size_t kstep = (size_t)(BK * 2);
    const size_t hstep = (size_t)HALF * K * 2;
    const size_t tstep = 2 * hstep;
    const unsigned ldsw = (unsigned)wid * 1024u;
    const int aoff = lds_byte(wr * 64 + fr, fq * 8), boff = lds_byte(wc * 32 + fr, fq * 8);
#define PG8_SA(b, h) (((b) * 2 + (h)) * HTB)
#define PG8_SB(b, h) ((4 + (b) * 2 + (h)) * HTB)
#define PG8_STAGE(bufoff, gbase, voff) do { _Pragma("unroll") for (int _i = 0; _i < 2; ++_i) \
        __builtin_amdgcn_global_load_lds((const unsigned*)((const char*)(gbase) + (voff)[_i]), (PG8_LAS unsigned*)(lds + (bufoff) + ldsw + _i * 8192), 16, 0, 0); } while (0)
#define PG8_LDA(dst, b, h) do { _Pragma("unroll") for (int m = 0; m < 4; ++m) _Pragma("unroll") for (int k = 0; k < 2; ++k) dst[m][k] = *(const PG8_LAS bf16x8*)(lds + PG8_SA(b, h) + aoff + m * 2048 + k * 1024); } while (0)
#define PG8_LDB(dst, b, h) do { _Pragma("unroll") for (int n = 0; n < 2; ++n) _Pragma("unroll") for (int k = 0; k < 2; ++k) dst[n][k] = *(const PG8_LAS bf16x8*)(lds + PG8_SB(b, h) + boff + n * 2048 + k * 1024); } while (0)
#define PG8_MMA(ai, bj, At, Bt) do { __builtin_amdgcn_s_setprio(1); _Pragma("unroll") for (int m = 0; m < 4; ++m) _Pragma("unroll") for (int n = 0; n < 2; ++n) _Pragma("unroll") for (int k = 0; k < 2; ++k) \
        acc[ai][bj][m][n] = __builtin_amdgcn_mfma_f32_16x16x32_bf16(Bt[n][k], At[m][k], acc[ai][bj][m][n], 0, 0, 0); __builtin_amdgcn_s_setprio(0); } while (0)
#define PG8_WAIT_V(n) asm volatile("s_waitcnt vmcnt(" #n ")" ::: "memory")
#define PG8_WAIT_L(n) asm volatile("s_waitcnt lgkmcnt(" #n ")" ::: "memory")
#define PG8_BAR __builtin_amdgcn_s_barrier()
#define PG8_SCHED __builtin_amdgcn_sched_barrier(0)
    Unit cur, nxt; int ui = 0;
    if (!S.next(0, cur)) return;
    f32x4 acc[2][2][4][2];
#pragma unroll
    for (int a = 0; a < 2; ++a)
#pragma unroll
        for (int b = 0; b < 2; ++b)
#pragma unroll
            for (int m = 0; m < 4; ++m)
#pragma unroll
                for (int n = 0; n < 2; ++n) acc[a][b][m][n] = (f32x4){0.f, 0.f, 0.f, 0.f};
    bf16x8 At[4][2], B0[2][2], B1[2][2];
    const char* cA = (const char*)g.A + (size_t)cur.pm * tstep; const char* cB = (const char*)g.Bt + (size_t)cur.pb * tstep;
    S.a_ready(cur);
    if constexpr (SP2) {
        PG8_STAGE(PG8_SB(0, 0), cB, voffB); PG8_STAGE(PG8_SB(0, 1), cB + hstep, voffB); PG8_STAGE(PG8_SA(0, 0), cA, voffA); PG8_STAGE(PG8_SA(0, 1), cA + hstep, voffA);
        if (wr == 1) PG8_BAR;
        PG8_WAIT_V(2); PG8_BAR;
        PG8_STAGE(PG8_SB(1, 0), cB + kstep, voffB); PG8_STAGE(PG8_SA(1, 0), cA + kstep, voffA); PG8_STAGE(PG8_SB(1, 1), cB + hstep + kstep, voffB);
        PG8_WAIT_V(6); PG8_BAR;
    } else {
        PG8_STAGE(PG8_SB(0, 0), cB, voffB); PG8_STAGE(PG8_SA(0, 0), cA, voffA); PG8_STAGE(PG8_SB(0, 1), cB + hstep, voffB); PG8_STAGE(PG8_SA(0, 1), cA + hstep, voffA);
        if (wr == 1) PG8_BAR;
        PG8_WAIT_V(4); PG8_BAR;
        PG8_STAGE(PG8_SB(1, 0), cB + kstep, voffB); PG8_STAGE(PG8_SA(1, 0), cA + kstep, voffA); PG8_STAGE(PG8_SB(1, 1), cB + hstep + kstep, voffB);
        PG8_WAIT_V(6); PG8_BAR;
    }
    for (;;) {
        const bool has_next = S.next(ui + 1, nxt);
        const char* nA = has_next ? (const char*)g.A + (size_t)nxt.pm * tstep : cA; const char* nB = has_next ? (const char*)g.Bt + (size_t)nxt.pb * tstep : cB;
        for (int t = 0; t < nt; t += 2) {
            const bool last = (t == nt - 2);
            const char* a1 = cA + (size_t)(t + 1) * kstep;
            const char* a2 = last ? nA : cA + (size_t)(t + 2) * kstep; const char* b2 = last ? nB : cB + (size_t)(t + 2) * kstep;
            const char* a3 = a2 + kstep; const char* b3 = b2 + kstep;
            if (last && has_next) S.a_ready(nxt);
            if constexpr (SP2) {
            PG8_LDB(B0, 0, 0); PG8_LDB(B1, 0, 1); PG8_SCHED; PG8_LDA(At, 0, 0); PG8_STAGE(PG8_SA(1, 1), a1 + hstep, voffA);
            PG8_WAIT_V(8); PG8_WAIT_L(0); PG8_BAR; PG8_MMA(0, 0, At, B0); PG8_MMA(0, 1, At, B1); PG8_BAR; PG8_SCHED;
            PG8_LDA(At, 0, 1); PG8_STAGE(PG8_SB(0, 0), b2, voffB); PG8_STAGE(PG8_SB(0, 1), b2 + hstep, voffB); PG8_STAGE(PG8_SA(0, 0), a2, voffA);
            PG8_WAIT_V(8); PG8_WAIT_L(0); PG8_BAR; PG8_MMA(1, 0, At, B0); PG8_MMA(1, 1, At, B1); PG8_BAR; PG8_SCHED;
            PG8_LDB(B0, 1, 0); PG8_LDB(B1, 1, 1); PG8_SCHED; PG8_LDA(At, 1, 0); PG8_STAGE(PG8_SA(0, 1), a2 + hstep, voffA);
            PG8_WAIT_V(8); PG8_WAIT_L(0); PG8_BAR; PG8_MMA(0, 0, At, B0); PG8_MMA(0, 1, At, B1); PG8_BAR; PG8_SCHED;
            PG8_LDA(At, 1, 1); PG8_STAGE(PG8_SB(1, 0), b3, voffB); PG8_STAGE(PG8_SB(1, 1), b3 + hstep, voffB); PG8_STAGE(PG8_SA(1, 0), a3, voffA);
            PG8_WAIT_V(8); PG8_WAIT_L(0); PG8_BAR; PG8_MMA(1, 0, At, B0); PG8_MMA(1, 1, At, B1); PG8_BAR; PG8_SCHED;
            } else {
            PG8_LDB(B0, 0, 0); PG8_SCHED; PG8_LDA(At, 0, 0); PG8_STAGE(PG8_SA(1, 1), a1 + hstep, voffA);
            PG8_WAIT_L(8); PG8_BAR; PG8_WAIT_L(0); PG8_MMA(0, 0, At, B0); PG8_BAR; PG8_SCHED;
            PG8_LDB(B1, 0, 1); PG8_STAGE(PG8_SB(0, 0), b2, voffB);
            PG8_BAR; PG8_WAIT_L(0); PG8_MMA(0, 1, At, B1); PG8_BAR;
            PG8_LDA(At, 0, 1); PG8_STAGE(PG8_SA(0, 0), a2, voffA);
            PG8_BAR; PG8_WAIT_L(0); PG8_MMA(1, 0, At, B0); PG8_BAR; PG8_SCHED;
            PG8_STAGE(PG8_SB(0, 1), b2 + hstep, voffB);
            PG8_WAIT_V(6); PG8_BAR; PG8_MMA(1, 1, At, B1); PG8_BAR;
            PG8_LDB(B0, 1, 0); PG8_SCHED; PG8_LDA(At, 1, 0); PG8_STAGE(PG8_SA(0, 1), a2 + hstep, voffA);
            PG8_WAIT_L(8); PG8_BAR; PG8_WAIT_L(0); PG8_MMA(0, 0, At, B0); PG8_BAR; PG8_SCHED;
            PG8_LDB(B1, 1, 1); PG8_STAGE(PG8_SB(1, 0), b3, voffB);
            PG8_BAR; PG8_WAIT_L(0); PG8_MMA(0, 1, At, B1); PG8_BAR;
            PG8_LDA(At, 1, 1); PG8_STAGE(PG8_SA(1, 0), a3, voffA);
            PG8_BAR; PG8_WAIT_L(0); PG8_MMA(1, 0, At, B0); PG8_BAR; PG8_SCHED;
            PG8_STAGE(PG8_SB(1, 1), b3 + hstep, voffB);
            PG8_WAIT_V(6); PG8_BAR; PG8_MMA(1, 1, At, B1); PG8_BAR;
            }
        }
        if constexpr (ALIGN_EPI) { if (wr == 0) PG8_BAR; }
        if constexpr (!Epi::AFTER_DRAIN) { E(acc, cur, wr, wc, fr, fq); S.done(cur); }
        if (!has_next) break;
#pragma unroll
        for (int a = 0; a < 2; ++a)
#pragma unroll
            for (int b = 0; b < 2; ++b)
#pragma unroll
                for (int m = 0; m < 4; ++m)
#pragma unroll
                    for (int n = 0; n < 2; ++n) acc[a][b][m][n] = (f32x4){0.f, 0.f, 0.f, 0.f};
        cur = nxt; cA = nA; cB = nB; ++ui;
        if constexpr (ALIGN_EPI) { if (wr == 1) PG8_BAR; }
    }
    PG8_WAIT_V(0);
    if constexpr (!ALIGN_EPI) { if (wr == 0) PG8_BAR; }
    PG8_BAR;
    if constexpr (Epi::AFTER_DRAIN) { E.fused(acc, cur, wr, wc, fr, fq, lds, wid, lane); S.done(cur); }
#undef PG8_SA
#undef PG8_SB
#undef PG8_STAGE
#undef PG8_LDA
#undef PG8_LDB
#undef PG8_MMA
#undef PG8_WAIT_V
#undef PG8_WAIT_L
#undef PG8_BAR
#undef PG8_SCHED
}
}

namespace mk {
constexpr int D = 1024, B = 4, S = 4096, T = B * S, C = 512, INW = 5120, E = 16, CAP = 512, F = 2048, NTH = 512, NWAVES = 8;
typedef unsigned short bf16;
#define LAS __attribute__((address_space(3)))
typedef unsigned v4u __attribute__((ext_vector_type(4)));
typedef unsigned v2u __attribute__((ext_vector_type(2)));
typedef float f32x4 __attribute__((ext_vector_type(4)));
typedef short bf16x8 __attribute__((ext_vector_type(8)));
typedef float f32x16 __attribute__((ext_vector_type(16)));
typedef short s16x4 __attribute__((ext_vector_type(4)));

constexpr size_t MiB = 1u << 20;
constexpr size_t WS_WIN = 2 * MiB;
constexpr size_t WS_WUH = 22 * MiB;
constexpr size_t WS_WUA = 24 * MiB;
constexpr size_t WS_WOUT = 26 * MiB;
constexpr size_t WS_BINP = 30 * MiB;
constexpr size_t WS_ROPE = 31 * MiB;
constexpr size_t WS_AFFT = 32 * MiB;
constexpr size_t WS_INV = 33 * MiB;
constexpr size_t WS_ROWS = 34 * MiB;
constexpr size_t WS_GATE = 34 * MiB + 512 * 1024;
constexpr size_t WS_FILT = 36 * MiB;
constexpr size_t WS_X = 68 * MiB;
constexpr size_t WS_XN = 132 * MiB;
constexpr size_t WS_SH = 164 * MiB;
constexpr size_t WS_U = WS_SH;
constexpr size_t WS_UCT = WS_SH + 48 * MiB;
constexpr size_t WS_Q = WS_SH + 96 * MiB;
constexpr size_t WS_K = WS_SH + 112 * MiB;
constexpr size_t WS_V = WS_SH + 128 * MiB;
constexpr size_t WS_GH = WS_SH + 144 * MiB;
constexpr size_t WS_GA = WS_SH + 176 * MiB;
constexpr size_t WS_YH = WS_SH + 208 * MiB;
constexpr size_t WS_YA = WS_SH + 224 * MiB;
constexpr size_t WS_T1 = WS_U;
constexpr size_t WS_MG = WS_UCT;
constexpr size_t WS_XG = WS_SH;
constexpr size_t WS_HB = WS_SH + 64 * MiB;
constexpr size_t WS_YE = WS_SH + 192 * MiB;
constexpr size_t WS_WGU = 420 * MiB;
constexpr size_t WS_WD = 676 * MiB;
constexpr size_t WS_END = 804 * MiB;

constexpr int LDS_BYTES = 155648;
constexpr float QSCALE = 0.125f * 1.4426950408889634f;

struct Args {
    const float* in[29]; float* out; unsigned char* ws; int ph_lo, ph_hi; int p0_mask, pad;
};

__device__ __forceinline__ unsigned f2bf(float f) { unsigned u = __builtin_bit_cast(unsigned, f); return (u + 0x7fffu + ((u >> 16) & 1u)) >> 16; }
__device__ __forceinline__ unsigned pk2(float lo, float hi) { return f2bf(lo) | (f2bf(hi) << 16); }
__device__ __forceinline__ float bf2f(unsigned h) { return __builtin_bit_cast(float, h << 16); }
__device__ __forceinline__ float bflo(unsigned w) { return __builtin_bit_cast(float, w << 16); }
__device__ __forceinline__ float bfhi(unsigned w) { return __builtin_bit_cast(float, w & 0xffff0000u); }
__device__ __forceinline__ float wave_sum(float v) {
#pragma unroll
    for (int o = 1; o < 64; o <<= 1) v += __shfl_xor(v, o);
    return v;
}
__device__ __forceinline__ float sigm(float x) { return 1.f / (1.f + __expf(-x)); }

struct Ctx { int tid, lane, wave, gw, ngw, vcu, G, bid; LAS unsigned char* lds; unsigned char* ws; };

template <int MAP> __device__ __forceinline__ int rowmap(int n) {
    if (MAP == 1) {
        if (n < 1536 || n >= 2560) return n;
        const int hb = (n - 1536) & ~63, d = (n - 1536) & 63, i = (d & 31) >> 2, j = d & 3;
        return 1536 + hb + 8 * i + ((d >> 5) << 2) + j;
    }
    if (MAP == 2) return ((n >> 7) << 8) + (n & 127);
    if (MAP == 3) return ((n >> 7) << 8) + 128 + (n & 127);
    return n;
}
template <int MAP> __device__ __forceinline__ void p0_transpose_item(const float* __restrict__ W, int K, int N, bf16* __restrict__ WT, LAS float* scr, int item, int lane) {
    const int nblk = N / 32, kb = item / nblk, nb = item % nblk, k0 = 64 * kb, n0 = 32 * nb;
#pragma unroll 8
    for (int i = 0; i < 32; ++i) { const int kk = 2 * i + (lane >> 5); scr[kk * 33 + (lane & 31)] = W[(size_t)(k0 + kk) * N + n0 + (lane & 31)]; }
    asm volatile("s_waitcnt lgkmcnt(0)" ::: "memory");
    const int c = lane & 7;
#pragma unroll
    for (int j = 0; j < 4; ++j) { const int n = (lane >> 3) + 8 * j; const LAS float* s = scr + (8 * c) * 33 + n;
        v4u o; o.x = pk2(s[0 * 33], s[1 * 33]); o.y = pk2(s[2 * 33], s[3 * 33]); o.z = pk2(s[4 * 33], s[5 * 33]); o.w = pk2(s[6 * 33], s[7 * 33]);
        *(v4u*)(WT + (size_t)rowmap<MAP>(n0 + n) * K + k0 + 8 * c) = o; }
    asm volatile("s_waitcnt lgkmcnt(0)" ::: "memory");
}
template <int MAP> __device__ __forceinline__ void p0_transpose(const Ctx& X, const float* W, int K, int N, bf16* WT, int nmat, size_t sstride, size_t dstride) {
    LAS float* scr = (LAS float*)(X.lds + X.wave * 16384);
    const int per = (K / 64) * (N / 32), tot = per * nmat;
    for (int it = X.gw; it < tot; it += X.ngw) { const int m = it / per, r = it - m * per; p0_transpose_item<MAP>(W + (size_t)m * sstride, K, N, WT + (size_t)m * dstride, scr, r, X.lane); }
}
__device__ __forceinline__ void rms_row_to_bf16(const float* __restrict__ xrow, const float* __restrict__ g, bf16* __restrict__ orow, int lane) {
    const f32x4* xr = (const f32x4*)xrow + lane; f32x4 v[4]; float s = 0.f;
#pragma unroll
    for (int j = 0; j < 4; ++j) { v[j] = xr[64 * j]; s += (v[j].x * v[j].x + v[j].y * v[j].y) + (v[j].z * v[j].z + v[j].w * v[j].w); }
    const float r = rsqrtf(wave_sum(s) * (1.f / D) + 1e-6f);
    v2u* o8 = (v2u*)orow + lane;
#pragma unroll
    for (int j = 0; j < 4; ++j) { const f32x4 gg = ((const f32x4*)g)[lane + 64 * j]; v2u w; w.x = pk2(v[j].x * r * gg.x, v[j].y * r * gg.y); w.y = pk2(v[j].z * r * gg.z, v[j].w * r * gg.w); o8[64 * j] = w; }
}
__device__ __forceinline__ void p0_filters(const Ctx& X, const Args& a) {
    LAS float* z = (LAS float*)X.lds;
    LAS float* h1 = z + 8 * 36;
    LAS float* h2 = h1 + 8 * 64;
    bf16* FILT = (bf16*)(X.ws + WS_FILT);
    const int tid = X.tid, tt = tid >> 6, j = tid & 63;
    const float min_decay = logf(1e-2f) / 0.3f, max_decay = logf(1e-2f) / 1.5f;
    for (int it = X.bid; it < 2 * (S / 8); it += X.G) {
        const int l = it / (S / 8), t0 = (it % (S / 8)) * 8;
        const float *w1 = a.in[6] + l * 33 * 64, *b1 = a.in[7] + l * 64, *f1 = a.in[8] + l * 64, *w2 = a.in[9] + l * 64 * 64, *b2 = a.in[10] + l * 64, *f2 = a.in[11] + l * 64, *w3 = a.in[12] + (size_t)l * 64 * 2048;
        __syncthreads();
        if (j < 33) { const int t = t0 + tt; float v;
            if (j == 0) v = (float)t / (float)(S - 1);
            else { const int jj = (j - 1) & 15; const float w = 2.0f * 3.14159265358979323846f * (float)t / (float)S; const float fr = 1e-4f + (float)jj * ((15.0f - 1e-4f) / 15.0f); const float ang = w * fr; v = (j <= 16) ? cosf(ang) : -sinf(ang); }
            z[tt * 36 + j] = v; }
        __syncthreads();
        { float acc = b1[j]; for (int i = 0; i < 33; ++i) acc += z[tt * 36 + i] * w1[i * 64 + j]; h1[tt * 64 + j] = sinf(f1[j] * acc); }
        __syncthreads();
        { float acc = b2[j]; for (int i = 0; i < 64; ++i) acc += h1[tt * 64 + i] * w2[i * 64 + j]; h2[tt * 64 + j] = sinf(f2[j] * acc); }
        __syncthreads();
#pragma unroll 1
        for (int k = 0; k < 4; ++k) { const int n = tid + 512 * k; float acc[8];
#pragma unroll
            for (int q = 0; q < 8; ++q) acc[q] = 0.f;
            for (int i = 0; i < 64; ++i) { const float w = w3[i * 2048 + n];
#pragma unroll
                for (int q = 0; q < 8; ++q) acc[q] += h2[q * 64 + i] * w; }
            const int c = n & 511, od = n >> 9; const float delta = fabsf(min_decay + (float)c * ((max_decay - min_decay) / 511.0f));
#pragma unroll
            for (int q = 0; q < 8; ++q) acc[q] *= expf(-((float)(t0 + q) / (float)(S - 1)) * delta);
            v4u o; o.x = pk2(acc[0], acc[1]); o.y = pk2(acc[2], acc[3]); o.z = pk2(acc[4], acc[5]); o.w = pk2(acc[6], acc[7]);
            *(v4u*)(FILT + (((size_t)l * 4 + od) * C + c) * S + t0) = o; }
    }
    __syncthreads();
}
__device__ __forceinline__ void p0_prologue(const Ctx& X, const Args& a) {
    const int m = a.p0_mask;
    if (m & 1) {
        p0_transpose<1>(X, a.in[2], D, INW, (bf16*)(X.ws + WS_WIN), 2, (size_t)D * INW, (size_t)D * INW);
        p0_transpose<0>(X, a.in[19], C, D, (bf16*)(X.ws + WS_WUH), 2, (size_t)C * D, (size_t)C * D);
        p0_transpose<0>(X, a.in[20], C, D, (bf16*)(X.ws + WS_WUA), 2, (size_t)C * D, (size_t)C * D);
        p0_transpose<0>(X, a.in[21], D, D, (bf16*)(X.ws + WS_WOUT), 2, (size_t)D * D, (size_t)D * D);
        float* binp = (float*)(X.ws + WS_BINP);
        for (int i = X.gw * 64 + X.lane; i < 2 * INW; i += X.ngw * 64) { const int l = i / INW, n = i - l * INW; binp[l * INW + rowmap<1>(n)] = a.in[3][i]; }
        float* rope = (float*)(X.ws + WS_ROPE);
        for (int i = X.gw * 64 + X.lane; i < S * 32; i += X.ngw * 64) { const int pos = i >> 5, j = i & 31; const float inv = powf(10000.0f, -(float)j * 2.0f / 64.0f); float sn, cs; sincosf((float)pos * inv, &sn, &cs); rope[2 * i] = cs; rope[2 * i + 1] = sn; }
    }
    if (m & 2) {
        p0_transpose<2>(X, a.in[25], D, F, (bf16*)(X.ws + WS_WGU), 2 * E, (size_t)D * F, (size_t)2 * F * D);
        p0_transpose<3>(X, a.in[26], D, F, (bf16*)(X.ws + WS_WGU), 2 * E, (size_t)D * F, (size_t)2 * F * D);
        p0_transpose<0>(X, a.in[27], F, D, (bf16*)(X.ws + WS_WD), 2 * E, (size_t)F * D, (size_t)F * D);
    }
    if (m & 4) p0_filters(X, a);
    if (m & 8) { bf16* XN = (bf16*)(X.ws + WS_XN); for (int r = X.gw; r < T; r += X.ngw) rms_row_to_bf16(a.in[0] + (size_t)r * D, a.in[1], XN + (size_t)r * D, X.lane); }
}
}
namespace mk {
using pg8::Unit;
__device__ __forceinline__ unsigned cvtpk(float lo, float hi) { unsigned r; asm volatile("v_cvt_pk_bf16_f32 %0, %1, %2" : "=v"(r) : "v"(lo), "v"(hi)); return r; }
__device__ __forceinline__ v4u pack8(f32x4 a, f32x4 b) { v4u w; w.x = cvtpk(a[0], a[1]); w.y = cvtpk(a[2], a[3]); w.z = cvtpk(b[0], b[1]); w.w = cvtpk(b[2], b[3]); return w; }
__device__ __forceinline__ void unpack8(v4u w, f32x4& a, f32x4& b) { a = (f32x4){bflo(w.x), bfhi(w.x), bflo(w.y), bfhi(w.y)}; b = (f32x4){bflo(w.z), bfhi(w.z), bflo(w.w), bfhi(w.w)}; }
__device__ __forceinline__ float fsig(float x) { return __builtin_amdgcn_rcpf(1.f + __expf(-x)); }

struct EpiWin {
    static constexpr bool PERM = true, AFTER_DRAIN = false;
    unsigned char* ws; const float* bias; const float* rope;
    __device__ __forceinline__ void operator()(const f32x4 (&acc)[2][2][4][2], const Unit& u, int wr, int wc, int fr, int fq) const {
        const int colt = u.pn * 256, row0 = u.pm * 256 + wr * 64 + fr, cin = wc * 32 + 8 * fq;
        bf16* base; int ldc, col0, mode; float sc = 1.f;
        if (colt < 1536) { base = (bf16*)(ws + WS_U); ldc = 1536; col0 = colt; mode = 0; }
        else if (colt < 2048) { base = (bf16*)(ws + WS_Q); ldc = 512; col0 = colt - 1536; mode = 1; sc = QSCALE; }
        else if (colt < 2560) { base = (bf16*)(ws + WS_K); ldc = 512; col0 = colt - 2048; mode = 1; }
        else if (colt < 3072) { base = (bf16*)(ws + WS_V); ldc = 512; col0 = colt - 2560; mode = 0; }
        else if (colt < 4096) { base = (bf16*)(ws + WS_GH); ldc = 1024; col0 = colt - 3072; mode = 2; }
        else { base = (bf16*)(ws + WS_GA); ldc = 1024; col0 = colt - 4096; mode = 2; }
        f32x4 bv[2][2];
#pragma unroll
        for (int bj = 0; bj < 2; ++bj)
#pragma unroll
            for (int n = 0; n < 2; ++n) bv[bj][n] = *(const f32x4*)(bias + colt + bj * 128 + cin + 4 * n);
#pragma unroll
        for (int ai = 0; ai < 2; ++ai)
#pragma unroll
            for (int m = 0; m < 4; ++m) {
                const int row = row0 + ai * 128 + m * 16; bf16* rowp = base + (size_t)row * ldc + col0 + cin;
#pragma unroll
                for (int bj = 0; bj < 2; ++bj) {
                    f32x4 v0 = acc[ai][bj][m][0] + bv[bj][0], v1 = acc[ai][bj][m][1] + bv[bj][1];
                    if (mode == 1) {
                        const int i = ((bj * 128 + cin) & 63) >> 3; const float* rp = rope + ((size_t)(row & (S - 1)) * 32 + 4 * i) * 2;
                        const f32x4 r0 = *(const f32x4*)rp, r1 = *(const f32x4*)(rp + 4);
                        const f32x4 cs = {r0[0], r0[2], r1[0], r1[2]}, sn = {r0[1], r0[3], r1[1], r1[3]};
                        const f32x4 o1 = (v0 * cs - v1 * sn) * sc, o2 = (v1 * cs + v0 * sn) * sc; v0 = o1; v1 = o2;
                    } else if (mode == 2) {
#pragma unroll
                        for (int e = 0; e < 4; ++e) { v0[e] = fsig(v0[e]); v1[e] = fsig(v1[e]); }
                    }
                    *(v4u*)(rowp + bj * 128) = pack8(v0, v1);
                }
            }
    }
};
template <int STEP> struct EpiMerge {
    static constexpr bool PERM = true, AFTER_DRAIN = false;
    const bf16* G; bf16* T1; bf16* MG;
    __device__ __forceinline__ void operator()(const f32x4 (&acc)[2][2][4][2], const Unit& u, int wr, int wc, int fr, int fq) const {
        const int row0 = u.pm * 256 + wr * 64 + fr, col0 = u.pn * 256 + wc * 32 + 8 * fq;
#pragma unroll
        for (int ai = 0; ai < 2; ++ai)
#pragma unroll
            for (int m = 0; m < 4; ++m) { const size_t off = (size_t)(row0 + ai * 128 + m * 16) * D + col0;
#pragma unroll
                for (int bj = 0; bj < 2; ++bj) { f32x4 g0, g1; unpack8(*(const v4u*)(G + off + bj * 128), g0, g1);
                    f32x4 v0 = acc[ai][bj][m][0] * g0, v1 = acc[ai][bj][m][1] * g1;
                    if (STEP == 1) { f32x4 t0, t1; unpack8(*(const v4u*)(T1 + off + bj * 128), t0, t1); v0 += t0; v1 += t1; *(v4u*)(MG + off + bj * 128) = pack8(v0, v1); }
                    else *(v4u*)(T1 + off + bj * 128) = pack8(v0, v1); } }
    }
};
struct EpiOut {
    static constexpr bool PERM = false, AFTER_DRAIN = false;
    const float* xin; float* X;
    __device__ __forceinline__ void operator()(const f32x4 (&acc)[2][2][4][2], const Unit& u, int wr, int wc, int fr, int fq) const {
        const int row0 = u.pm * 256 + wr * 64 + fr, col0 = u.pn * 256 + wc * 32 + 4 * fq;
#pragma unroll
        for (int ai = 0; ai < 2; ++ai)
#pragma unroll
            for (int m = 0; m < 4; ++m) { const size_t off = (size_t)(row0 + ai * 128 + m * 16) * D + col0;
#pragma unroll
                for (int bj = 0; bj < 2; ++bj)
#pragma unroll
                    for (int n = 0; n < 2; ++n) *(f32x4*)(X + off + bj * 128 + n * 16) = *(const f32x4*)(xin + off + bj * 128 + n * 16) + acc[ai][bj][m][n]; }
    }
};
struct EpiSwiGLU {
    static constexpr bool PERM = true, AFTER_DRAIN = false;
    bf16* HB;
    __device__ __forceinline__ void operator()(const f32x4 (&acc)[2][2][4][2], const Unit& u, int wr, int wc, int fr, int fq) const {
        const int row0 = u.pm * 256 + wr * 64 + fr, col0 = u.pn * 128 + wc * 32 + 8 * fq;
#pragma unroll
        for (int ai = 0; ai < 2; ++ai)
#pragma unroll
            for (int m = 0; m < 4; ++m) { f32x4 h[2];
#pragma unroll
                for (int n = 0; n < 2; ++n) { const f32x4 g = acc[ai][0][m][n], up = acc[ai][1][m][n];
#pragma unroll
                    for (int e = 0; e < 4; ++e) h[n][e] = g[e] * fsig(g[e]) * up[e]; }
                *(v4u*)(HB + (size_t)(row0 + ai * 128 + m * 16) * F + col0) = pack8(h[0], h[1]); }
    }
};
struct EpiDown {
    static constexpr bool PERM = true, AFTER_DRAIN = false;
    bf16* YE; const float* gate;
    __device__ __forceinline__ void operator()(const f32x4 (&acc)[2][2][4][2], const Unit& u, int wr, int wc, int fr, int fq) const {
        const int row0 = u.pm * 256 + wr * 64 + fr, col0 = u.pn * 256 + wc * 32 + 8 * fq;
#pragma unroll
        for (int ai = 0; ai < 2; ++ai)
#pragma unroll
            for (int m = 0; m < 4; ++m) { const int row = row0 + ai * 128 + m * 16; const float g = gate[row];
#pragma unroll
                for (int bj = 0; bj < 2; ++bj) *(v4u*)(YE + (size_t)row * D + col0 + bj * 128) = pack8(acc[ai][bj][m][0] * g, acc[ai][bj][m][1] * g); }
    }
};
struct OrderMoE1 {
    int G, c;
    __device__ __forceinline__ bool next(int i, Unit& u) const {
        if (G != 256) { const int L = i * G + c; if (L >= 2048) return false; const int e = L >> 7, r = L & 127; u.pm = e * 8 + (r & 7); u.pn = r >> 3; u.pb = e * 16 + u.pn; return true; }
        if (i >= 8) return false;
        const int ch = i * 8 + (c & 7), j = c >> 3, e = ch >> 2, ng = ch & 3; u.pm = e * 8 + (j & 7); u.pn = ng * 4 + (j >> 3); u.pb = e * 16 + u.pn; return true;
    }
    __device__ __forceinline__ void a_ready(const Unit&) const {}
    __device__ __forceinline__ void done(const Unit&) const {}
};
struct OrderMoE2 {
    int G, c;
    __device__ __forceinline__ bool next(int i, Unit& u) const {
        if (G != 256) { const int L = i * G + c; if (L >= 512) return false; const int e = L >> 5, r = L & 31; u.pm = e * 8 + (r & 7); u.pn = r >> 3; u.pb = e * 4 + u.pn; return true; }
        if (i >= 2) return false;
        const int e = i * 8 + (c & 7), j = c >> 3; u.pm = e * 8 + (j & 7); u.pn = j >> 3; u.pb = e * 4 + u.pn; return true;
    }
    __device__ __forceinline__ void a_ready(const Unit&) const {}
    __device__ __forceinline__ void done(const Unit&) const {}
};

__device__ __forceinline__ void p5_norm_router(const Ctx& X, const float* Xr, const float* __restrict__ g, const float* __restrict__ wr, const float* __restrict__ br) {
    bf16* XN = (bf16*)(X.ws + WS_XN); float* afft = (float*)(X.ws + WS_AFFT); const int lane = X.lane;
    for (int tok = X.gw; tok < T; tok += X.ngw) {
        const f32x4* xr = (const f32x4*)(Xr + (size_t)tok * D) + lane; f32x4 v[4]; float s = 0.f;
#pragma unroll
        for (int j = 0; j < 4; ++j) { v[j] = xr[64 * j]; s += (v[j].x * v[j].x + v[j].y * v[j].y) + (v[j].z * v[j].z + v[j].w * v[j].w); }
        const float r = rsqrtf(wave_sum(s) * (1.f / D) + 1e-6f);
        float acc[16];
#pragma unroll
        for (int e = 0; e < 16; ++e) acc[e] = 0.f;
        v2u* o8 = (v2u*)(XN + (size_t)tok * D) + lane;
#pragma unroll
        for (int j = 0; j < 4; ++j) { const f32x4 gg = ((const f32x4*)g)[lane + 64 * j]; const f32x4 y = {v[j].x * r * gg.x, v[j].y * r * gg.y, v[j].z * r * gg.z, v[j].w * r * gg.w};
            v2u w; w.x = pk2(y.x, y.y); w.y = pk2(y.z, y.w); o8[64 * j] = w;
#pragma unroll
            for (int q = 0; q < 4; ++q) { const f32x4* wp = (const f32x4*)(wr + (size_t)(4 * (lane + 64 * j) + q) * 16);
#pragma unroll
                for (int p = 0; p < 4; ++p) { const f32x4 ww = wp[p]; acc[4 * p] += y[q] * ww.x; acc[4 * p + 1] += y[q] * ww.y; acc[4 * p + 2] += y[q] * ww.z; acc[4 * p + 3] += y[q] * ww.w; }
                if (q & 1) asm volatile("" ::: "memory"); } }
        float mx = -1e30f;
#pragma unroll
        for (int e = 0; e < 16; ++e) { acc[e] = wave_sum(acc[e]) + br[e]; mx = fmaxf(mx, acc[e]); }
        float l = 0.f;
#pragma unroll
        for (int e = 0; e < 16; ++e) { acc[e] = expf(acc[e] - mx); l += acc[e]; }
        const int b = tok >> 12, s_ = tok & (S - 1);
        if (lane < 16) { float vv = 0.f;
#pragma unroll
            for (int e = 0; e < 16; ++e) if (lane == e) vv = acc[e];
            afft[((size_t)b * E + lane) * S + s_] = vv / l; }
    }
}
__device__ __forceinline__ void p6_topk(const Ctx& X) {
    const float* afft = (const float*)(X.ws + WS_AFFT); int* rows = (int*)(X.ws + WS_ROWS); float* gate = (float*)(X.ws + WS_GATE); int* inv = (int*)(X.ws + WS_INV);
    for (int p = X.bid; p < B * E; p += X.G) { const int b = p >> 4, e = p & 15, slotbase = e * 2048 + b * 512;
        tk::topk_problem(afft + (size_t)p * S, b * S, e, slotbase, rows + slotbase, gate + slotbase, inv, (int*)(X.lds), X.tid); }
}
__device__ __forceinline__ void p6_gather(const Ctx& X) {
    const int* rows = (const int*)(X.ws + WS_ROWS); const bf16* XN = (const bf16*)(X.ws + WS_XN); bf16* XG = (bf16*)(X.ws + WS_XG);
    for (int sl = X.gw; sl < E * 2048; sl += X.ngw) { const int tok = __builtin_amdgcn_readfirstlane(__hip_atomic_load(rows + sl, __ATOMIC_RELAXED, __HIP_MEMORY_SCOPE_AGENT)); const v4u* s = (const v4u*)(XN + (size_t)tok * D) + X.lane; v4u* d = (v4u*)(XG + (size_t)sl * D) + X.lane; d[0] = s[0]; d[64] = s[64]; }
}
__device__ __forceinline__ void p9_combine(const Ctx& X, float* Xr, const float* __restrict__ g, bool final_, float* __restrict__ out) {
    const int* inv = (const int*)(X.ws + WS_INV); const bf16* YE = (const bf16*)(X.ws + WS_YE); bf16* XN = (bf16*)(X.ws + WS_XN); const int lane = X.lane;
    for (int tok = X.gw; tok < T; tok += X.ngw) {
        f32x4* xr = (f32x4*)(Xr + (size_t)tok * D) + lane; f32x4 v[4];
#pragma unroll
        for (int j = 0; j < 4; ++j) v[j] = xr[64 * j];
        const int myinv = lane < 16 ? inv[(size_t)tok * E + lane] : -1;
        for (int e = 0; e < E; ++e) { const int sl = __shfl(myinv, e); if (sl < 0) continue; const v2u* y = (const v2u*)(YE + (size_t)sl * D) + lane;
#pragma unroll
            for (int j = 0; j < 4; ++j) { const v2u w = y[64 * j]; v[j].x += bflo(w.x); v[j].y += bfhi(w.x); v[j].z += bflo(w.y); v[j].w += bfhi(w.y); } }
        float s = 0.f;
#pragma unroll
        for (int j = 0; j < 4; ++j) s += (v[j].x * v[j].x + v[j].y * v[j].y) + (v[j].z * v[j].z + v[j].w * v[j].w);
        const float r = rsqrtf(wave_sum(s) * (1.f / D) + 1e-6f);
        if (final_) {
#pragma unroll
            for (int j = 0; j < 4; ++j) { const f32x4 gg = ((const f32x4*)g)[lane + 64 * j]; ((f32x4*)(out + (size_t)tok * D))[lane + 64 * j] = (f32x4){v[j].x * r * gg.x, v[j].y * r * gg.y, v[j].z * r * gg.z, v[j].w * r * gg.w}; }
        } else {
            v2u* o8 = (v2u*)(XN + (size_t)tok * D) + lane;
#pragma unroll
            for (int j = 0; j < 4; ++j) { xr[64 * j] = v[j]; const f32x4 gg = ((const f32x4*)g)[lane + 64 * j]; v2u w; w.x = pk2(v[j].x * r * gg.x, v[j].y * r * gg.y); w.y = pk2(v[j].z * r * gg.z, v[j].w * r * gg.w); o8[64 * j] = w; }
        }
    }
}
}
namespace mk {
__device__ __forceinline__ void p1t_shortconv(const Ctx& X, const float* __restrict__ cw, const float* __restrict__ cb) {
    const bf16* U = (const bf16*)(X.ws + WS_U); bf16* UCT = (bf16*)(X.ws + WS_UCT);
    LAS float* raw = (LAS float*)(X.lds + X.wave * 17408);
    const int lane = X.lane;
    for (int it = X.gw; it < (T / 64) * 24; it += X.ngw) {
        const int tt = it / 24, cg = it - tt * 24, tok0 = tt * 64, ch0 = cg * 64; const int tin = tok0 & (S - 1);
#pragma unroll 3
        for (int i = 0; i < 33; ++i) { const int r = 2 * i + (lane >> 5), cp = lane & 31; const int tpos = tin + r - 1;
            unsigned w = 0u; if (tpos >= 0 && tpos < S) w = *(const unsigned*)(U + (size_t)(tok0 + r - 1) * 1536 + ch0 + 2 * cp);
            raw[r * 65 + 2 * cp] = bflo(w); raw[r * 65 + 2 * cp + 1] = bfhi(w); }
        asm volatile("s_waitcnt lgkmcnt(0)" ::: "memory");
        const int chs = lane >> 3, tch = lane & 7;
#pragma unroll
        for (int g = 0; g < 8; ++g) { const int ch = 8 * g + chs, gc = ch0 + ch; const float w0 = cw[gc], w1 = cw[1536 + gc], w2 = cw[3072 + gc], bb = cb[gc];
            float v[10];
#pragma unroll
            for (int k = 0; k < 10; ++k) v[k] = raw[(8 * tch + k) * 65 + ch];
            float o[8];
#pragma unroll
            for (int k = 0; k < 8; ++k) o[k] = v[k] * w0 + v[k + 1] * w1 + v[k + 2] * w2 + bb;
            v4u pk; pk.x = pk2(o[0], o[1]); pk.y = pk2(o[2], o[3]); pk.z = pk2(o[4], o[5]); pk.w = pk2(o[6], o[7]);
            *(v4u*)(UCT + (size_t)gc * T + tok0 + 8 * tch) = pk; }
        asm volatile("s_waitcnt lgkmcnt(0)" ::: "memory");
    }
}

namespace at {
constexpr int KVBLK = 64, LDK = 512;
constexpr int SHM_V = 64 * 128 * 2, SHM_K = 64 * 128 * 2;
constexpr int OFF_V = 0, OFF_K = 2 * SHM_V, OFF_Q = OFF_K + 2 * SHM_K, OFF_WS = OFF_Q + 256 * 256, LDS_TOTAL = OFF_WS + 8 * 160 * 4;
constexpr float THR2 = 8.0f * 1.4426950408889634f;
#define KSWZ(row, colB) ((row) * 256 + ((colB) ^ (((row) & 7) << 4)))
#define SBAR() __builtin_amdgcn_sched_barrier(0)
__device__ __forceinline__ int crow(int r, int hi) { return (r & 3) + 8 * (r >> 2) + 4 * hi; }
__device__ __forceinline__ int v_st(int k, int c) { const int kk = (k & ~0xC) | ((k & 4) << 1) | ((k & 8) >> 1); return ((kk >> 3) * 4 + (c >> 5)) * 512 + ((kk & 7) * 32 + (c & 31)) * 2; }
__device__ __forceinline__ int v_rd_base(int lane) { return ((lane & 3) << 3) | (((lane >> 2) & 3) << 6) | (((lane >> 4) & 1) << 5) | (((lane >> 5) & 1) << 8); }
constexpr int v_rd_off(int d0, int ks, int half) { return d0 * 512 + ks * 4096 + half * 2048; }
template <int OFF> __device__ __forceinline__ s16x4 tr_read(int vb) { s16x4 r; asm volatile("ds_read_b64_tr_b16 %0, %1 offset:%2" : "=&v"(r) : "v"(vb), "i"(OFF) : "memory"); return r; }

template <int CO> __device__ __forceinline__ void qkt(f32x16& p0, f32x16& p1, const char* Ks, const char* Qs, int qrow, int r32, int hi) {
    p0 = f32x16{}; p1 = f32x16{};
#define QK_LD(d0, qf, b0, b1) do { const int cb = (CO * 64 + (d0) * 16 + hi * 8) * 2; qf = *reinterpret_cast<const bf16x8*>(Qs + KSWZ(qrow, cb)); \
    b0 = *reinterpret_cast<const bf16x8*>(Ks + KSWZ(r32, cb)); b1 = *reinterpret_cast<const bf16x8*>(Ks + KSWZ(32 + r32, cb)); } while (0)
    bf16x8 qa, a0, a1, qb, c0, c1;
    QK_LD(0, qa, a0, a1); QK_LD(1, qb, c0, c1); asm volatile("" ::: "memory");
    p0 = __builtin_amdgcn_mfma_f32_32x32x16_bf16(a0, qa, p0, 0, 0, 0); p1 = __builtin_amdgcn_mfma_f32_32x32x16_bf16(a1, qa, p1, 0, 0, 0);
    QK_LD(2, qa, a0, a1); asm volatile("" ::: "memory");
    p0 = __builtin_amdgcn_mfma_f32_32x32x16_bf16(c0, qb, p0, 0, 0, 0); p1 = __builtin_amdgcn_mfma_f32_32x32x16_bf16(c1, qb, p1, 0, 0, 0);
    QK_LD(3, qb, c0, c1); asm volatile("" ::: "memory");
    p0 = __builtin_amdgcn_mfma_f32_32x32x16_bf16(a0, qa, p0, 0, 0, 0); p1 = __builtin_amdgcn_mfma_f32_32x32x16_bf16(a1, qa, p1, 0, 0, 0);
    p0 = __builtin_amdgcn_mfma_f32_32x32x16_bf16(c0, qb, p0, 0, 0, 0); p1 = __builtin_amdgcn_mfma_f32_32x32x16_bf16(c1, qb, p1, 0, 0, 0);
#undef QK_LD
}
__device__ __forceinline__ void softmax_tile(f32x16& p0, f32x16& p1, float& m_reg, float& l_reg, float& alpha, bf16x8& pa0, bf16x8& pa1, bf16x8& pa2, bf16x8& pa3) {
    float pmax = p0[0];
#pragma unroll
    for (int r = 1; r < 16; ++r) pmax = fmaxf(pmax, p0[r]);
#pragma unroll
    for (int r = 0; r < 16; ++r) pmax = fmaxf(pmax, p1[r]);
    { auto rr = __builtin_amdgcn_permlane32_swap(__float_as_uint(pmax), __float_as_uint(pmax), false, false); pmax = fmaxf(__uint_as_float(rr[0]), __uint_as_float(rr[1])); }
    float mn;
    if (__builtin_expect(__all(pmax - m_reg <= THR2), 1)) { mn = m_reg; alpha = 1.f; }
    else { mn = fmaxf(m_reg, pmax); alpha = __builtin_amdgcn_exp2f(m_reg - mn); m_reg = mn; }
#pragma unroll
    for (int r = 0; r < 16; ++r) { p0[r] = __builtin_amdgcn_exp2f(p0[r] - mn); p1[r] = __builtin_amdgcn_exp2f(p1[r] - mn); }
    float ps = 0.f;
#pragma unroll
    for (int r = 0; r < 16; ++r) ps += p0[r];
#pragma unroll
    for (int r = 0; r < 16; ++r) ps += p1[r];
    { auto rr = __builtin_amdgcn_permlane32_swap(__float_as_uint(ps), __float_as_uint(ps), false, false); ps = __uint_as_float(rr[0]) + __uint_as_float(rr[1]); }
    l_reg = l_reg * alpha + ps;
#define PK4(P, BASE, OUT) do { unsigned a0 = cvtpk(P[BASE + 0], P[BASE + 1]), a1 = cvtpk(P[BASE + 2], P[BASE + 3]);   \
    unsigned b0 = cvtpk(P[BASE + 4], P[BASE + 5]), b1 = cvtpk(P[BASE + 6], P[BASE + 7]);                              \
    auto r0 = __builtin_amdgcn_permlane32_swap(a0, b0, false, false); auto r1 = __builtin_amdgcn_permlane32_swap(a1, b1, false, false); \
    v4u w = {r0[0], r1[0], r0[1], r1[1]}; OUT = *reinterpret_cast<bf16x8*>(&w); } while (0)
    PK4(p0, 0, pa0); PK4(p0, 8, pa1); PK4(p1, 0, pa2); PK4(p1, 8, pa3);
#undef PK4
}
template <int D0> __device__ __forceinline__ void pv_one(f32x16& oa, int vb, const bf16x8 (&pa)[4]) {
    const s16x4 l0 = tr_read<v_rd_off(D0, 0, 0)>(vb), h0 = tr_read<v_rd_off(D0, 0, 1)>(vb), l1 = tr_read<v_rd_off(D0, 1, 0)>(vb), h1 = tr_read<v_rd_off(D0, 1, 1)>(vb);
    const s16x4 l2 = tr_read<v_rd_off(D0, 2, 0)>(vb), h2 = tr_read<v_rd_off(D0, 2, 1)>(vb), l3 = tr_read<v_rd_off(D0, 3, 0)>(vb), h3 = tr_read<v_rd_off(D0, 3, 1)>(vb);
    asm volatile("s_waitcnt lgkmcnt(0)" ::: "memory"); SBAR();
#define PK(L, H) (bf16x8){L[0], L[1], L[2], L[3], H[0], H[1], H[2], H[3]}
    oa = __builtin_amdgcn_mfma_f32_32x32x16_bf16(pa[0], PK(l0, h0), oa, 0, 0, 0);
    oa = __builtin_amdgcn_mfma_f32_32x32x16_bf16(pa[1], PK(l1, h1), oa, 0, 0, 0);
    oa = __builtin_amdgcn_mfma_f32_32x32x16_bf16(pa[2], PK(l2, h2), oa, 0, 0, 0);
    oa = __builtin_amdgcn_mfma_f32_32x32x16_bf16(pa[3], PK(l3, h3), oa, 0, 0, 0);
#undef PK
}
__device__ __forceinline__ void rescale(f32x16 (&o)[4], float al, float* wsf, int r32, int hi) {
    if (__any(al < 1.f)) {
        if (hi == 0) wsf[r32] = al; asm volatile("s_waitcnt lgkmcnt(0)" ::: "memory");
#pragma unroll
        for (int r = 0; r < 16; ++r) { const float a = wsf[crow(r, hi)];
#pragma unroll
            for (int d = 0; d < 4; ++d) o[d][r] *= a; }
    }
}

__device__ __forceinline__ void epilogue(const Ctx& X, f32x16 (&oa)[4], f32x16 (&ob)[4], const float* wsf, int r32, int hi, int b, int h, int qb, float lam, float mul, const float* __restrict__ sg) {
    bf16* Yw = (bf16*)(X.ws + WS_YA) + ((size_t)b * S + qb * 256 + X.wave * 32) * 512 + h * 128;
    float gcol[4];
#pragma unroll
    for (int d = 0; d < 4; ++d) gcol[d] = sg[d * 32 + r32] * mul;
#pragma unroll
    for (int r = 0; r < 16; ++r) { const int orow = crow(r, hi); const float i0 = __builtin_amdgcn_rcpf(wsf[64 + orow]), i1 = lam * __builtin_amdgcn_rcpf(wsf[96 + orow]);
        float v[4], ss = 0.f;
#pragma unroll
        for (int d = 0; d < 4; ++d) { v[d] = oa[d][r] * i0 - ob[d][r] * i1; ss += v[d] * v[d]; }
        ss += __shfl_xor(ss, 1); ss += __shfl_xor(ss, 2); ss += __shfl_xor(ss, 4); ss += __shfl_xor(ss, 8); ss += __shfl_xor(ss, 16);
        const float rn = rsqrtf(ss * (1.f / 128.f) + 1e-5f);
#pragma unroll
        for (int d = 0; d < 4; ++d) Yw[(size_t)orow * 512 + d * 32 + r32] = (bf16)f2bf(v[d] * rn * gcol[d]); }
}
__device__ __forceinline__ void attn_unit(const Ctx& X, int b, int h, int qb, float lam, float mul, const float* __restrict__ sg) {
    char* lds = (char*)X.lds;
    int tid = X.tid; asm volatile("" : "+v"(tid));
    const int wid = X.wave, lane = tid & 63, r32 = lane & 31, hi = lane >> 5;
    const bf16* Qg = (const bf16*)(X.ws + WS_Q) + ((size_t)b * S + qb * 256) * LDK + h * 128;
    const bf16* Kh = (const bf16*)(X.ws + WS_K) + (size_t)b * S * LDK + h * 128;
    const bf16* Vh = (const bf16*)(X.ws + WS_V) + (size_t)b * S * LDK + h * 128;
    char* V_lds = lds + OFF_V; char* K_lds = lds + OFF_K; char* Q_lds = lds + OFF_Q;
    float* wsf = (float*)(lds + OFF_WS) + wid * 160;
    const int sr = tid >> 4, sc = (tid & 15) * 8, vst0 = v_st(sr, sc), vst1 = v_st(32 + sr, sc);
    const int vb0 = (int)(uintptr_t)V_lds + v_rd_base(lane);
#pragma unroll
    for (int i = 0; i < 8; ++i) { const int row = sr + 32 * i; *(bf16x8*)(Q_lds + KSWZ(row, sc * 2)) = *reinterpret_cast<const bf16x8*>(Qg + (size_t)row * LDK + sc); }
    bf16x8 st0, st1;
#define KLOAD(k0) do { st0 = *reinterpret_cast<const bf16x8*>(&Kh[(size_t)((k0) + sr) * LDK + sc]); st1 = *reinterpret_cast<const bf16x8*>(&Kh[(size_t)((k0) + 32 + sr) * LDK + sc]); } while (0)
#define VLOAD(k0) do { st0 = *reinterpret_cast<const bf16x8*>(&Vh[(size_t)((k0) + sr) * LDK + sc]); st1 = *reinterpret_cast<const bf16x8*>(&Vh[(size_t)((k0) + 32 + sr) * LDK + sc]); } while (0)
#define KWRITE(bb) do { *(bf16x8*)(K_lds + (bb) * SHM_K + KSWZ(sr, sc * 2)) = st0; *(bf16x8*)(K_lds + (bb) * SHM_K + KSWZ(32 + sr, sc * 2)) = st1; } while (0)
#define VWRITE(bb) do { *(bf16x8*)(V_lds + (bb) * SHM_V + vst0) = st0; *(bf16x8*)(V_lds + (bb) * SHM_V + vst1) = st1; } while (0)
    float m0 = -1e30f, m1 = -1e30f, l0 = 0.f, l1 = 0.f; f32x16 oa[4] = {}, ob[4] = {};
    const int qrow = wid * 32 + r32; constexpr int NT = S / KVBLK;
    KLOAD(0); KWRITE(0); VLOAD(0); VWRITE(0); __syncthreads();
    for (int j = 0; j < NT; ++j) {
        const int bb = j & 1; const char* Ks = K_lds + bb * SHM_K;
        if (j + 1 < NT) KLOAD((j + 1) * KVBLK);
        const int vb = vb0 + bb * SHM_V;
        { f32x16 p0, p1; float al; bf16x8 pa[4];
          qkt<0>(p0, p1, Ks, Q_lds, qrow, r32, hi); softmax_tile(p0, p1, m0, l0, al, pa[0], pa[1], pa[2], pa[3]);
          rescale(oa, al, wsf, r32, hi);
          pv_one<0>(oa[0], vb, pa); pv_one<1>(oa[1], vb, pa); pv_one<2>(oa[2], vb, pa); pv_one<3>(oa[3], vb, pa); }
        if (j + 1 < NT) { KWRITE(bb ^ 1); VLOAD((j + 1) * KVBLK); }
        asm volatile("" ::: "memory");
        { f32x16 p0, p1; float al; bf16x8 pa[4];
          qkt<1>(p0, p1, Ks, Q_lds, qrow, r32, hi); softmax_tile(p0, p1, m1, l1, al, pa[0], pa[1], pa[2], pa[3]);
          rescale(ob, al, wsf + 32, r32, hi);
          pv_one<0>(ob[0], vb, pa); pv_one<1>(ob[1], vb, pa); pv_one<2>(ob[2], vb, pa); pv_one<3>(ob[3], vb, pa); }
        if (j + 1 < NT) VWRITE(bb ^ 1);
        __syncthreads();
    }
#undef KLOAD
#undef VLOAD
#undef KWRITE
#undef VWRITE
    if (hi == 0) { wsf[64 + r32] = l0; wsf[96 + r32] = l1; } asm volatile("s_waitcnt lgkmcnt(0)" ::: "memory");
    { int t2 = X.tid; asm volatile("" : "+v"(t2)); epilogue(X, oa, ob, wsf, t2 & 31, (t2 & 63) >> 5, b, h, qb, lam, mul, sg); }
    __syncthreads();
}
__device__ __forceinline__ void epilogue_unused() {}
#if 0
    bf16* Yw = (bf16*)(X.ws + WS_YA) + ((size_t)b * S + qb * 256 + wid * 32) * 512 + h * 128;
    float gcol[4];
#pragma unroll
    for (int d = 0; d < 4; ++d) gcol[d] = sg[d * 32 + r32] * mul;
#pragma unroll
    for (int r = 0; r < 16; ++r) { const int orow = crow(r, hi); const float i0 = __builtin_amdgcn_rcpf(wsf[64 + orow]), i1 = lam * __builtin_amdgcn_rcpf(wsf[96 + orow]);
        float v[4], ss = 0.f;
#pragma unroll
        for (int d = 0; d < 4; ++d) { v[d] = oa[d][r] * i0 - ob[d][r] * i1; ss += v[d] * v[d]; }
        ss += __shfl_xor(ss, 1); ss += __shfl_xor(ss, 2); ss += __shfl_xor(ss, 4); ss += __shfl_xor(ss, 8); ss += __shfl_xor(ss, 16);
        const float rn = rsqrtf(ss * (1.f / 128.f) + 1e-5f);
#pragma unroll
        for (int d = 0; d < 4; ++d) Yw[(size_t)orow * 512 + d * 32 + r32] = (bf16)f2bf(v[d] * rn * gcol[d]); }
    __syncthreads();
}
#endif
#undef KSWZ
#undef SBAR
}
}
namespace mk {
namespace hy {
constexpr int CPS = 16704;
constexpr int NEL = 8352;
constexpr int OFF_Z = 4 * CPS;
constexpr int ZROW = 144, ZB = 128 * ZROW;
constexpr int LDS_TOTAL = OFF_Z + 4 * ZB;

__device__ __forceinline__ float Hval(const bf16* hf, const bf16* hb, float bias, int d) {
    if (d >= 0) { if (d >= S) return 0.f; const float v = bf2f(hf[d]); return d == 0 ? v + bias : v; }
    const int e = -d; return e < S ? bf2f(hb[e]) : 0.f;
}
__device__ __forceinline__ void build_hrev(const Ctx& X, const bf16* hf, const bf16* hb, float bias) {
    for (int i = X.tid; i < 4 * (NEL / 2); i += NTH) { const int m = i / (NEL / 2), ip = (i - m * (NEL / 2)) * 2;
        const float a = Hval(hf, hb, bias, 4100 - ip - m), b = Hval(hf, hb, bias, 4100 - ip - 1 - m);
        *(LAS unsigned*)(X.lds + m * CPS + ip * 2) = pk2(a, b); }
}
__device__ __forceinline__ void channel(const Ctx& X, int l, int c, const float* __restrict__ hyb) {
    const bf16* UCT = (const bf16*)(X.ws + WS_UCT); const bf16* FILT = (const bf16*)(X.ws + WS_FILT) + (size_t)l * 4 * C * S; bf16* YH = (bf16*)(X.ws + WS_YH);
    const int tid = X.tid, lane = X.lane, wid = X.wave, r = lane & 31, h = lane >> 5, b = wid >> 1, jt = wid & 1;
    LAS unsigned char* zl = X.lds + OFF_Z;
    __syncthreads();
    for (int i = tid; i < 4 * 64 * 9; i += NTH) { const int bb = i / 576, rr = (i % 576) / 9, ch = i % 9; const int row = rr < 32 ? rr : 64 + rr;
        *(LAS v4u*)(zl + bb * ZB + row * ZROW + ch * 16) = (v4u){0u, 0u, 0u, 0u}; }
    for (int i = tid; i < 4 * 64 * 8; i += NTH) { const int bb = i >> 9, s1 = (i >> 3) & 63, ch = i & 7;
        *(LAS v4u*)(zl + bb * ZB + (32 + s1) * ZROW + ch * 16) = *(const v4u*)(UCT + (size_t)c * T + bb * S + s1 * 64 + ch * 8); }
    const int m4 = (4 - (r & 3)) & 3;
    const int baseA = m4 * CPS + 2 * (8 * h - r + 4100 - m4);
    for (int o = 0; o < 2; ++o) {
        build_hrev(X, FILT + ((size_t)(2 * o) * C + c) * S, FILT + ((size_t)(2 * o + 1) * C + c) * S, hyb[(l * 2 + o) * C + c]);
        __syncthreads();
        f32x16 acc0 = {}, acc1 = {};
        const int d1max = 32 * jt + 31, d1min = 32 * jt - 63; int q = -4 * d1max;
        auto ldA = [&](int qq) -> bf16x8 { const LAS unsigned char* p = X.lds + baseA + 32 * qq; const v2u lo = *(const LAS v2u*)p, hi2 = *(const LAS v2u*)(p + 8); v4u w = {lo.x, lo.y, hi2.x, hi2.y}; return *reinterpret_cast<bf16x8*>(&w); };
        bf16x8 f2 = ldA(q - 2), f1 = ldA(q - 1);
        const LAS unsigned char* zb = zl + b * ZB + (32 + 32 * jt + r) * ZROW + 16 * h;
        for (int d1 = d1max; d1 >= d1min; --d1) {
            const LAS unsigned char* zr = zb - d1 * ZROW;
#pragma unroll
            for (int ks = 0; ks < 4; ++ks) {
                const bf16x8 f0 = ldA(q); const bf16x8 bz = *(const LAS bf16x8*)(zr + 32 * ks);
                acc0 = __builtin_amdgcn_mfma_f32_32x32x16_bf16(f0, bz, acc0, 0, 0, 0);
                acc1 = __builtin_amdgcn_mfma_f32_32x32x16_bf16(f2, bz, acc1, 0, 0, 0);
                f2 = f1; f1 = f0; ++q; }
        }
        const bf16* gate = UCT + (size_t)((o + 1) * C + c) * T + (size_t)b * S;
        const int t1 = 32 * jt + r;
        __syncthreads();
#pragma unroll
        for (int mt = 0; mt < 2; ++mt)
#pragma unroll
            for (int g = 0; g < 4; ++g) { const int t0 = 32 * mt + 8 * g + 4 * h; const v2u gw = *(const v2u*)(gate + t1 * 64 + t0);
                const f32x16& a = mt ? acc1 : acc0;
                const float y0 = a[4 * g] * bflo(gw.x), y1 = a[4 * g + 1] * bfhi(gw.x), y2 = a[4 * g + 2] * bflo(gw.y), y3 = a[4 * g + 3] * bfhi(gw.y);
                if (o == 0) { v2u w; w.x = pk2(y0, y1); w.y = pk2(y2, y3); *(LAS v2u*)(zl + b * ZB + (32 + t1) * ZROW + t0 * 2) = w; }
                else { bf16* yo = YH + ((size_t)b * S + t1 * 64 + t0) * C + c; yo[0] = (bf16)f2bf(y0); yo[C] = (bf16)f2bf(y1); yo[2 * C] = (bf16)f2bf(y2); yo[3 * C] = (bf16)f2bf(y3); } }
    }
    __syncthreads();
}
}
}
namespace mk {
namespace cg = cooperative_groups;
constexpr int PH_PER_LAYER = 11, N_PHASES = 1 + 2 * PH_PER_LAYER;

__device__ __forceinline__ float lam_of(const Args& a, int l, float lam_init) {
    const float *q1 = a.in[14] + l * 64, *k1 = a.in[15] + l * 64, *q2 = a.in[16] + l * 64, *k2 = a.in[17] + l * 64;
    float s1 = 0.f, s2 = 0.f; for (int i = 0; i < 64; ++i) { s1 += q1[i] * k1[i]; s2 += q2[i] * k2[i]; }
    return expf(s1) - expf(s2) + lam_init;
}

typedef const __attribute__((address_space(4))) Args* KArgPtr;
__global__ void __launch_bounds__(NTH, 2) fwd(Args a_byval) {
    extern __shared__ __attribute__((aligned(16))) unsigned char lds_raw[];
    cg::grid_group grid = cg::this_grid();
    const int ph_lo = a_byval.ph_lo, ph_hi = a_byval.ph_hi;
    for (int ph = ph_lo; ph < ph_hi; ++ph) {
        KArgPtr ap = (KArgPtr)__builtin_amdgcn_kernarg_segment_ptr(); asm volatile("" : "+s"(ap));
        const Args a = *(const Args*)ap;
        float* Xr = (float*)(a.ws + WS_X);
        Ctx X; { int t = threadIdx.x; asm volatile("" : "+v"(t)); X.tid = t; }
        X.lane = X.tid & 63; X.wave = __builtin_amdgcn_readfirstlane(X.tid >> 6);
        { int g_ = gridDim.x, b_ = blockIdx.x; asm volatile("" : "+s"(g_), "+s"(b_)); X.G = g_; X.bid = b_; }
        { const int bx = X.bid; X.vcu = (X.G % 8 == 0) ? (bx % 8) * (X.G / 8) + bx / 8 : bx; }
        X.gw = X.vcu * NWAVES + X.wave; X.ngw = X.G * NWAVES; X.lds = (LAS unsigned char*)lds_raw; X.ws = a.ws;
#ifndef MK_EN
#define MK_EN 0xFFFF
#endif
#ifndef MK_ATT
#define MK_ATT 3
#endif
        if (ph == 0) { if (MK_EN & 512) p0_prologue(X, a); }
        else {
            const int l = (ph - 1) / PH_PER_LAYER, sp = (ph - 1) % PH_PER_LAYER;
            const float lam_init = 0.8f - 0.6f * expf(-0.3f * (float)l);
            if (0) {}
#if MK_EN & 1
            else if (sp == 0) {
                pg8::Gemm g{(const bf16*)(a.ws + WS_XN), (const bf16*)(a.ws + WS_WIN) + (size_t)l * INW * D, T, INW, D};
                pg8::StaticOrder So; So.init(T, INW, X.G, X.bid);
                EpiWin Ep{a.ws, (const float*)(a.ws + WS_BINP) + l * INW, (const float*)(a.ws + WS_ROPE)};
                pg8::gemm_phase<EpiWin, pg8::StaticOrder, true, true>(X.lds, g, So, Ep);
            }
#endif
#if MK_EN & 2
            else if (sp == 1) {
                p1t_shortconv(X, a.in[4] + l * 3 * 1536, a.in[5] + l * 1536);
            }
#endif
#if MK_EN & 4
            else if (sp == 2) {
                const float lam = lam_of(a, l, lam_init);
                const int c = X.bid;
                if (MK_ATT & 1) for (int u = c; u < 256; u += X.G) { const int bh = 2 * (u & 7) + ((u >> 3) >> 4), qb = (u >> 3) & 15; at::attn_unit(X, bh >> 2, bh & 3, qb, lam, 1.0f - lam_init, a.in[18] + l * 128); }
                if (MK_ATT & 2) for (int u = c; u < 256; u += X.G) { const int ch = 64 * (u & 7) + 2 * (u >> 3); hy::channel(X, l, ch, a.in[13]); hy::channel(X, l, ch + 1, a.in[13]); }
            }
#endif
#if MK_EN & 8
            else if (sp == 3) {
                pg8::StaticOrder So; So.init(T, D, X.G, X.bid);
                { pg8::Gemm g{(const bf16*)(a.ws + WS_YH), (const bf16*)(a.ws + WS_WUH) + (size_t)l * D * C, T, D, C};
                  EpiMerge<0> Ep{(const bf16*)(a.ws + WS_GH), (bf16*)(a.ws + WS_T1), (bf16*)(a.ws + WS_MG)};
                  pg8::gemm_phase<EpiMerge<0>, pg8::StaticOrder, true, true>(X.lds, g, So, Ep); }
                { pg8::Gemm g{(const bf16*)(a.ws + WS_YA), (const bf16*)(a.ws + WS_WUA) + (size_t)l * D * C, T, D, C};
                  EpiMerge<1> Ep{(const bf16*)(a.ws + WS_GA), (bf16*)(a.ws + WS_T1), (bf16*)(a.ws + WS_MG)};
                  pg8::gemm_phase<EpiMerge<1>, pg8::StaticOrder, true, true>(X.lds, g, So, Ep); }
            }
#endif
#if MK_EN & 16
            else if (sp == 4) {
                pg8::Gemm g{(const bf16*)(a.ws + WS_MG), (const bf16*)(a.ws + WS_WOUT) + (size_t)l * D * D, T, D, D};
                pg8::StaticOrder So; So.init(T, D, X.G, X.bid);
                EpiOut Ep{l == 0 ? a.in[0] : Xr, Xr};
                pg8::gemm_phase<EpiOut, pg8::StaticOrder, true, true>(X.lds, g, So, Ep);
            }
#endif
#if MK_EN & 32
            else if (sp == 5) {
                p5_norm_router(X, Xr, a.in[22] + l * D, a.in[23] + (size_t)l * D * E, a.in[24] + l * E);
            } else if (sp == 6) { p6_topk(X);
            } else if (sp == 7) { p6_gather(X);
            }
#endif
#if MK_EN & 64
            else if (sp == 8) {
                pg8::Gemm g{(const bf16*)(a.ws + WS_XG), (const bf16*)(a.ws + WS_WGU) + (size_t)l * E * 2 * F * D, E * 2048, 2 * F, D};
                OrderMoE1 So{X.G, X.bid}; EpiSwiGLU Ep{(bf16*)(a.ws + WS_HB)};
                pg8::gemm_phase<EpiSwiGLU, OrderMoE1, true, true>(X.lds, g, So, Ep);
            }
#endif
#if MK_EN & 128
            else if (sp == 9) {
                pg8::Gemm g{(const bf16*)(a.ws + WS_HB), (const bf16*)(a.ws + WS_WD) + (size_t)l * E * D * F, E * 2048, D, F};
                OrderMoE2 So{X.G, X.bid}; EpiDown Ep{(bf16*)(a.ws + WS_YE), (const float*)(a.ws + WS_GATE)};
                pg8::gemm_phase<EpiDown, OrderMoE2, true, true>(X.lds, g, So, Ep);
            }
#endif
#if MK_EN & 256
            else if (sp == 10) {
                p9_combine(X, Xr, l == 0 ? a.in[1] + D : a.in[28], l == 1, a.out);
            }
#endif
        }
        if (ph + 1 < ph_hi) grid.sync();
    }
}

static int g_grid = 0;
static bool mega_setup() {
    if (g_grid) return g_grid > 0;
    int dev = 0, cus = 0, per_cu = 0;
    if (hipGetDevice(&dev) != hipSuccess || hipDeviceGetAttribute(&cus, hipDeviceAttributeMultiprocessorCount, dev) != hipSuccess) { g_grid = -1; return false; }
    if (hipFuncSetAttribute((const void*)fwd, hipFuncAttributeMaxDynamicSharedMemorySize, LDS_BYTES) != hipSuccess) { fprintf(stderr, "hipFuncSetAttribute failed\n"); g_grid = -1; return false; }
    if (hipOccupancyMaxActiveBlocksPerMultiprocessor(&per_cu, (const void*)fwd, NTH, LDS_BYTES) != hipSuccess || per_cu < 1) { fprintf(stderr, "occupancy query failed (%d)\n", per_cu); g_grid = -1; return false; }
    g_grid = cus * 1;
    return true;
}
static void mega_launch(hipStream_t st, void* const* d_in, float* d_out, unsigned char* ws, int ph_lo, int ph_hi, int p0_mask) {
    if (!mega_setup()) return;
    Args a{};
    for (int i = 0; i < 29; ++i) a.in[i] = (const float*)d_in[i];
    a.out = d_out; a.ws = ws; a.ph_lo = ph_lo; a.ph_hi = ph_hi; a.p0_mask = p0_mask; a.pad = 0;
    void* args[] = {&a};
    const hipError_t e = hipLaunchCooperativeKernel((const void*)fwd, dim3(g_grid), dim3(NTH), args, LDS_BYTES, st);
    if (e != hipSuccess) fprintf(stderr, "cooperative launch failed: %s (grid %d)\n", hipGetErrorString(e), g_grid);
}
}
extern "C" void kernel_launch(void* const* d_in, const int* in_sizes, int n_in, void* d_out, int out_size, void* d_ws, size_t ws_size, hipStream_t stream) {
    if (n_in != 29 || out_size != mk::T * mk::D || ws_size < mk::WS_END) { fprintf(stderr, "kernel_launch: unexpected sizes n_in %d out %d ws %zu\n", n_in, out_size, ws_size); return; }
    mk::mega_launch(stream, d_in, (float*)d_out, (unsigned char*)d_ws, 0, mk::N_PHASES, 15);
}
```

```cpp
#include <hip/hip_runtime.h>
#include <hip/hip_cooperative_groups.h>
#include <cstdio>
#include <cstdint>
#include <cmath>
namespace tk {
constexpr int S = 4096, E = 16, CAP = 512, NT = 512;
__device__ __forceinline__ void topk_problem(const float* __restrict__ aff, int tokbase, int e, int slotbase, int* __restrict__ rows, float* __restrict__ gate, int* __restrict__ inv, int* sm, int tid) {
    const int lane = tid & 63, wid = tid >> 6;
    int* hist = sm; int* ctl = sm + 256;
    unsigned key[8];
    { const uint4 a = ((const uint4*)aff)[tid * 2], b = ((const uint4*)aff)[tid * 2 + 1];
      key[0] = a.x; key[1] = a.y; key[2] = a.z; key[3] = a.w; key[4] = b.x; key[5] = b.y; key[6] = b.z; key[7] = b.w; }
    unsigned prefix = 0u, mask = 0u; int kth = CAP;
    for (int pass = 3; pass >= 0; --pass) {
        __syncthreads();
        if (tid < 256) hist[tid] = 0;
        __syncthreads();
#pragma unroll
        for (int i = 0; i < 8; ++i) if ((key[i] & mask) == prefix) atomicAdd(&hist[(key[i] >> (8 * pass)) & 255u], 1);
        __syncthreads();
        if (tid < 64) {
            const int b0 = hist[4 * lane], b1 = hist[4 * lane + 1], b2 = hist[4 * lane + 2], b3 = hist[4 * lane + 3];
            const int tot = b0 + b1 + b2 + b3;
            int suf = tot;
#pragma unroll
            for (int o = 1; o < 64; o <<= 1) { const int v = __builtin_amdgcn_ds_bpermute(((lane + o) & 63) << 2, suf); if (lane + o < 64) suf += v; }
            const int above = suf - tot;
            if (above < kth && kth <= above + tot) {
                int cum = above, bin, k2;
                if (cum + b3 >= kth) { bin = 4 * lane + 3; k2 = kth - cum; }
                else { cum += b3; if (cum + b2 >= kth) { bin = 4 * lane + 2; k2 = kth - cum; }
                else { cum += b2; if (cum + b1 >= kth) { bin = 4 * lane + 1; k2 = kth - cum; }
                else { cum += b1; bin = 4 * lane; k2 = kth - cum; } } }
                ctl[0] = bin; ctl[1] = k2;
            }
        }
        __syncthreads();
        prefix |= ((unsigned)ctl[0]) << (8 * pass); mask |= 0xFFu << (8 * pass); kth = ctl[1];
    }
    const unsigned thr = prefix; const int need_eq = kth; const int n_gt = CAP - need_eq;
    int cg = 0, ce = 0;
#pragma unroll
    for (int i = 0; i < 8; ++i) { cg += key[i] > thr; ce += key[i] == thr; }
    int sg = cg, se = ce;
#pragma unroll
    for (int o = 1; o < 64; o <<= 1) { const int a = __builtin_amdgcn_ds_bpermute(((lane - o) & 63) << 2, sg), b = __builtin_amdgcn_ds_bpermute(((lane - o) & 63) << 2, se); if (lane >= o) { sg += a; se += b; } }
    __syncthreads();
    if (lane == 63) { ctl[8 + wid] = sg; ctl[16 + wid] = se; }
    __syncthreads();
    int og = sg - cg, oe = se - ce;
    for (int w = 0; w < wid; ++w) { og += ctl[8 + w]; oe += ctl[16 + w]; }
#pragma unroll
    for (int i = 0; i < 8; ++i) {
        const int idx = tid * 8 + i; int slot = -1;
        if (key[i] > thr) slot = og++;
        else if (key[i] == thr) { if (oe < need_eq) slot = n_gt + oe; ++oe; }
        if (slot >= 0) { rows[slot] = tokbase + idx; gate[slot] = __uint_as_float(key[i]); }
        inv[(size_t)(tokbase + idx) * E + e] = slot >= 0 ? slotbase + slot : -1;
    }
    __syncthreads();
}
}
namespace pg8 {
#define PG8_LAS __attribute__((address_space(3)))
typedef unsigned short bf16_t;
typedef short bf16x8 __attribute__((ext_vector_type(8)));
typedef float f32x4 __attribute__((ext_vector_type(4)));
typedef unsigned u32x4 __attribute__((ext_vector_type(4)));
constexpr int BM = 256, BK = 64, HALF = 128, HTB = HALF * BK * 2  , STAGE_BYTES = 8 * HTB, NXCD = 8, WGM = 8;

__host__ __device__ __forceinline__ int lds_byte(int r, int c) { const int st = (r >> 4) * 2 + (c >> 5), rr = r & 15, cc = c & 31, ob = rr * 64 + cc * 2; return st * 1024 + (ob ^ (((ob >> 9) & 1) << 5)); }
__host__ __device__ __forceinline__ void stage_rc(int b, int& R, int& C) { const int st = b / 1024, sb = b % 1024, swz = sb ^ (((sb >> 9) & 1) << 5); R = (st >> 1) * 16 + swz / 64; C = (st & 1) * 32 + (swz % 64) / 2; }
__host__ __device__ __forceinline__ int perm32(int rho) { const int n = rho >> 4, i = rho & 15; return 8 * (i >> 2) + 4 * n + (i & 3); }

struct Unit { int pm, pn, pb, pa; };
struct Gemm { const bf16_t* A; const bf16_t* Bt; int M, N, K; };

struct StaticOrder {
    int nM, nN, nwg, G, c;
    __host__ __device__ void init(int M, int N, int G_, int c_) { nM = M / BM; nN = N / BM; nwg = nM * nN; G = G_; c = c_; }
    __host__ __device__ bool next(int i, Unit& u) const {
        const long L = (long)i * G + c; if (L >= nwg) return false;
        int wgid = (int)L; { const int q = nwg / NXCD, r = nwg % NXCD, xcd = wgid % NXCD, off = wgid / NXCD; wgid = (xcd < r ? xcd * (q + 1) : r * (q + 1) + (xcd - r) * q) + off; }
        const int nig = WGM * nN, gid = wgid / nig, fm = gid * WGM, gsz = (nM - fm) < WGM ? (nM - fm) : WGM;
        u.pm = fm + ((wgid % nig) % gsz); u.pn = (wgid % nig) / gsz; u.pb = u.pn; u.pa = u.pm; return true;
    }
    __device__ __forceinline__ void a_ready(const Unit&) const {}
    __device__ __forceinline__ void done(const Unit&) const {}
};

template <class Epi, class Sched, bool ALIGN_EPI = false, bool SP2 = false>
__device__ __forceinline__ void gemm_phase(PG8_LAS unsigned char* lds, const Gemm g, const Sched& S, const Epi& E, int tid) {
    asm volatile("" : "+v"(tid));
    const int wid = __builtin_amdgcn_readfirstlane(tid >> 6), lane = tid & 63, wr = wid >> 2, wc = wid & 3, fr = lane & 15, fq = lane >> 4;
    const int K = g.K, nt = K / BK;
    unsigned voffA[2], voffB[2];
#pragma unroll
    for (int i = 0; i < 2; ++i) { int R, C; stage_rc(tid * 16 + i * 8192, R, C); const int Rb = Epi::PERM ? ((R & ~31) + perm32(R & 31)) : R;
        voffA[i] = (unsigned)(R * K + C) * 2u; voffB[i] = (unsigned)(Rb * K + C) * 2u; }
    const size_t kstep = (size_t)(BK * 2);
    const size_t hstep = (size_t)HALF * K * 2;
    const size_t tstep = 2 * hstep;
    const unsigned ldsw = (unsigned)wid * 1024u;
    const int aoff = lds_byte(wr * 64 + fr, fq * 8), boff = lds_byte(wc * 32 + fr, fq * 8);
#define PG8_SA(b, h) (((b) * 2 + (h)) * HTB)
#define PG8_SB(b, h) ((4 + (b) * 2 + (h)) * HTB)
#define PG8_STAGE(bufoff, gbase, voff) do { _Pragma("unroll") for (int _i = 0; _i < 2; ++_i) \
        __builtin_amdgcn_global_load_lds((const unsigned*)((const char*)(gbase) + (voff)[_i]), (PG8_LAS unsigned*)(lds + (bufoff) + ldsw + _i * 8192), 16, 0, 0); } while (0)
#define PG8_LDA(dst, b, h) do { _Pragma("unroll") for (int m = 0; m < 4; ++m) _Pragma("unroll") for (int k = 0; k < 2; ++k) dst[m][k] = *(const PG8_LAS bf16x8*)(lds + PG8_SA(b, h) + aoff + m * 2048 + k * 1024); } while (0)
#define PG8_LDB(dst, b, h) do { _Pragma("unroll") for (int n = 0; n < 2; ++n) _Pragma("unroll") for (int k = 0; k < 2; ++k) dst[n][k] = *(const PG8_LAS bf16x8*)(lds + PG8_SB(b, h) + boff + n * 2048 + k * 1024); } while (0)
#define PG8_MMA(ai, bj, At, Bt) do { __builtin_amdgcn_s_setprio(1); _Pragma("unroll") for (int m = 0; m < 4; ++m) _Pragma("unroll") for (int n = 0; n < 2; ++n) _Pragma("unroll") for (int k = 0; k < 2; ++k) \
        acc[ai][bj][m][n] = __builtin_amdgcn_mfma_f32_16x16x32_bf16(Bt[n][k], At[m][k], acc[ai][bj][m][n], 0, 0, 0); __builtin_amdgcn_s_setprio(0); } while (0)
#define PG8_WAIT_V(n) asm volatile("s_waitcnt vmcnt(" #n ")" ::: "memory")
#define PG8_WAIT_L(n) asm volatile("s_waitcnt lgkmcnt(" #n ")" ::: "memory")
#define PG8_BAR __builtin_amdgcn_s_barrier()
#define PG8_SCHED __builtin_amdgcn_sched_barrier(0)
    Unit cur, nxt; int ui = 0;
    if (!S.next(0, cur)) return;
    f32x4 acc[2][2][4][2];
#pragma unroll
    for (int a = 0; a < 2; ++a)
#pragma unroll
        for (int b = 0; b < 2; ++b)
#pragma unroll
            for (int m = 0; m < 4; ++m)
#pragma unroll
                for (int n = 0; n < 2; ++n) acc[a][b][m][n] = (f32x4){0.f, 0.f, 0.f, 0.f};
    bf16x8 At[4][2], B0[2][2], B1[2][2];
    const char* cA = (const char*)g.A + (size_t)cur.pa * tstep; const char* cB = (const char*)g.Bt + (size_t)cur.pb * tstep;
    S.a_ready(cur);
    if constexpr (SP2) {
        PG8_STAGE(PG8_SB(0, 0), cB, voffB); PG8_STAGE(PG8_SB(0, 1), cB + hstep, voffB); PG8_STAGE(PG8_SA(0, 0), cA, voffA); PG8_STAGE(PG8_SA(0, 1), cA + hstep, voffA);
        if (wr == 1) PG8_BAR;
        PG8_WAIT_V(2); PG8_BAR;
        PG8_STAGE(PG8_SB(1, 0), cB + kstep, voffB); PG8_STAGE(PG8_SA(1, 0), cA + kstep, voffA); PG8_STAGE(PG8_SB(1, 1), cB + hstep + kstep, voffB);
        PG8_WAIT_V(6); PG8_BAR;
    } else {
        PG8_STAGE(PG8_SB(0, 0), cB, voffB); PG8_STAGE(PG8_SA(0, 0), cA, voffA); PG8_STAGE(PG8_SB(0, 1), cB + hstep, voffB); PG8_STAGE(PG8_SA(0, 1), cA + hstep, voffA);
        if (wr == 1) PG8_BAR;
        PG8_WAIT_V(4); PG8_BAR;
        PG8_STAGE(PG8_SB(1, 0), cB + kstep, voffB); PG8_STAGE(PG8_SA(1, 0), cA + kstep, voffA); PG8_STAGE(PG8_SB(1, 1), cB + hstep + kstep, voffB);
        PG8_WAIT_V(6); PG8_BAR;
    }
    for (;;) {
        const bool has_next = S.next(ui + 1, nxt);
        const char* nA = has_next ? (const char*)g.A + (size_t)nxt.pa * tstep : cA; const char* nB = has_next ? (const char*)g.Bt + (size_t)nxt.pb * tstep : cB;
        for (int t = 0; t < nt; t += 2) {
            const bool last = (t == nt - 2);
            const char* a1 = cA + (size_t)(t + 1) * kstep;
            const char* a2 = last ? nA : cA + (size_t)(t + 2) * kstep; const char* b2 = last ? nB : cB + (size_t)(t + 2) * kstep;
            const char* a3 = a2 + kstep; const char* b3 = b2 + kstep;
            if (last && has_next) S.a_ready(nxt);
            if constexpr (SP2) {
            PG8_LDB(B0, 0, 0); PG8_LDB(B1, 0, 1); PG8_SCHED; PG8_LDA(At, 0, 0); PG8_STAGE(PG8_SA(1, 1), a1 + hstep, voffA);
            PG8_WAIT_V(8); PG8_WAIT_L(0); PG8_BAR; PG8_MMA(0, 0, At, B0); PG8_MMA(0, 1, At, B1); PG8_BAR; PG8_SCHED;
            PG8_LDA(At, 0, 1); PG8_STAGE(PG8_SB(0, 0), b2, voffB); PG8_STAGE(PG8_SB(0, 1), b2 + hstep, voffB); PG8_STAGE(PG8_SA(0, 0), a2, voffA);
            PG8_WAIT_V(8); PG8_WAIT_L(0); PG8_BAR; PG8_MMA(1, 0, At, B0); PG8_MMA(1, 1, At, B1); PG8_BAR; PG8_SCHED;
            PG8_LDB(B0, 1, 0); PG8_LDB(B1, 1, 1); PG8_SCHED; PG8_LDA(At, 1, 0); PG8_STAGE(PG8_SA(0, 1), a2 + hstep, voffA);
            PG8_WAIT_V(8); PG8_WAIT_L(0); PG8_BAR; PG8_MMA(0, 0, At, B0); PG8_MMA(0, 1, At, B1); PG8_BAR; PG8_SCHED;
            PG8_LDA(At, 1, 1); PG8_STAGE(PG8_SB(1, 0), b3, voffB); PG8_STAGE(PG8_SB(1, 1), b3 + hstep, voffB); PG8_STAGE(PG8_SA(1, 0), a3, voffA);
            PG8_WAIT_V(8); PG8_WAIT_L(0); PG8_BAR; PG8_MMA(1, 0, At, B0); PG8_MMA(1, 1, At, B1); PG8_BAR; PG8_SCHED;
            } else {
            PG8_LDB(B0, 0, 0); PG8_SCHED; PG8_LDA(At, 0, 0); PG8_STAGE(PG8_SA(1, 1), a1 + hstep, voffA);
            PG8_WAIT_L(8); PG8_BAR; PG8_WAIT_L(0); PG8_MMA(0, 0, At, B0); PG8_BAR; PG8_SCHED;
            PG8_LDB(B1, 0, 1); PG8_STAGE(PG8_SB(0, 0), b2, voffB);
            PG8_BAR; PG8_WAIT_L(0); PG8_MMA(0, 1, At, B1); PG8_BAR;
            PG8_LDA(At, 0, 1); PG8_STAGE(PG8_SA(0, 0), a2, voffA);
            PG8_BAR; PG8_WAIT_L(0); PG8_MMA(1, 0, At, B0); PG8_BAR; PG8_SCHED;
            PG8_STAGE(PG8_SB(0, 1), b2 + hstep, voffB);
            PG8_WAIT_V(6); PG8_BAR; PG8_MMA(1, 1, At, B1); PG8_BAR;
            PG8_LDB(B0, 1, 0); PG8_SCHED; PG8_LDA(At, 1, 0); PG8_STAGE(PG8_SA(0, 1), a2 + hstep, voffA);
            PG8_WAIT_L(8); PG8_BAR; PG8_WAIT_L(0); PG8_MMA(0, 0, At, B0); PG8_BAR; PG8_SCHED;
            PG8_LDB(B1, 1, 1); PG8_STAGE(PG8_SB(1, 0), b3, voffB);
            PG8_BAR; PG8_WAIT_L(0); PG8_MMA(0, 1, At, B1); PG8_BAR;
            PG8_LDA(At, 1, 1); PG8_STAGE(PG8_SA(1, 0), a3, voffA);
            PG8_BAR; PG8_WAIT_L(0); PG8_MMA(1, 0, At, B0); PG8_BAR; PG8_SCHED;
            PG8_STAGE(PG8_SB(1, 1), b3 + hstep, voffB);
            PG8_WAIT_V(6); PG8_BAR; PG8_MMA(1, 1, At, B1); PG8_BAR;
            }
        }
        if constexpr (ALIGN_EPI) { if (wr == 0) PG8_BAR; }
        if constexpr (!Epi::AFTER_DRAIN) { E(acc, cur, wr, wc, fr, fq); S.done(cur); }
        if (!has_next) break;
#pragma unroll
        for (int a = 0; a < 2; ++a)
#pragma unroll
            for (int b = 0; b < 2; ++b)
#pragma unroll
                for (int m = 0; m < 4; ++m)
#pragma unroll
                    for (int n = 0; n < 2; ++n) acc[a][b][m][n] = (f32x4){0.f, 0.f, 0.f, 0.f};
        cur = nxt; cA = nA; cB = nB; ++ui;
        if constexpr (ALIGN_EPI) { if (wr == 1) PG8_BAR; }
    }
    PG8_WAIT_V(0);
    if constexpr (!ALIGN_EPI) { if (wr == 0) PG8_BAR; }
    PG8_BAR;
    if constexpr (Epi::AFTER_DRAIN) { E.fused(acc, cur, wr, wc, fr, fq, lds, wid, lane); S.done(cur); }
#undef PG8_SA
#undef PG8_SB
#undef PG8_STAGE
#undef PG8_LDA
#undef PG8_LDB
#undef PG8_MMA
#undef PG8_WAIT_V
#undef PG8_WAIT_L
#undef PG8_BAR
#undef PG8_SCHED
}
}

namespace mk {
constexpr int D = 1024, B = 4, S = 4096, T = B * S, C = 512, INW = 5120, E = 16, CAP = 512, F = 2048, NTH = 512, NWAVES = 8;
typedef unsigned short bf16;
#define LAS __attribute__((address_space(3)))
typedef unsigned v4u __attribute__((ext_vector_type(4)));
typedef unsigned v2u __attribute__((ext_vector_type(2)));
typedef float f32x4 __attribute__((ext_vector_type(4)));
typedef short bf16x8 __attribute__((ext_vector_type(8)));
typedef float f32x16 __attribute__((ext_vector_type(16)));
typedef short s16x4 __attribute__((ext_vector_type(4)));

constexpr size_t MiB = 1u << 20;
constexpr size_t WS_WIN = 2 * MiB;
constexpr size_t WS_WUH = 22 * MiB;
constexpr size_t WS_WUA = 23 * MiB;
constexpr size_t WS_WOUT = 26 * MiB;
constexpr size_t WS_BINP = 30 * MiB;
constexpr size_t WS_ROPE = 31 * MiB;
constexpr size_t WS_AFFT = 32 * MiB;
constexpr size_t WS_INV = 33 * MiB;
constexpr size_t WS_ROWS = 34 * MiB;
constexpr size_t WS_GATE = 34 * MiB + 512 * 1024;
constexpr size_t WS_FILT = 36 * MiB;
constexpr size_t WS_X = 68 * MiB;
constexpr size_t WS_XN = 132 * MiB;
constexpr size_t WS_SH = 164 * MiB;
constexpr size_t WS_U = WS_SH;
constexpr size_t WS_UCT = WS_SH + 48 * MiB;
constexpr size_t WS_Q = WS_SH + 96 * MiB;
constexpr size_t WS_K = WS_SH + 112 * MiB;
constexpr size_t WS_V = WS_SH + 128 * MiB;
constexpr size_t WS_GH = WS_SH + 144 * MiB;
constexpr size_t WS_GA = WS_SH + 176 * MiB;
constexpr size_t WS_YH = WS_SH + 208 * MiB;
constexpr size_t WS_YA = WS_SH + 224 * MiB;
constexpr size_t WS_T1 = WS_U;
constexpr size_t WS_MG = WS_UCT;
constexpr size_t WS_XG = WS_SH;
constexpr size_t WS_HB = WS_SH + 64 * MiB;
constexpr size_t WS_YE = WS_SH + 192 * MiB;
constexpr size_t WS_WGU = 420 * MiB;
constexpr size_t WS_WD = 676 * MiB;
constexpr size_t WS_END = 804 * MiB;

constexpr int LDS_BYTES = 155648;
constexpr float QSCALE = 0.125f * 1.4426950408889634f;

struct Args {
    const float* in[29]; float* out; unsigned char* ws; int ph_lo, ph_hi; int p0_mask, pad;
};

__device__ __forceinline__ unsigned f2bf(float f) { unsigned u = __builtin_bit_cast(unsigned, f); return (u + 0x7fffu + ((u >> 16) & 1u)) >> 16; }
__device__ __forceinline__ unsigned pk2(float lo, float hi) { return f2bf(lo) | (f2bf(hi) << 16); }
__device__ __forceinline__ float bf2f(unsigned h) { return __builtin_bit_cast(float, h << 16); }
__device__ __forceinline__ float bflo(unsigned w) { return __builtin_bit_cast(float, w << 16); }
__device__ __forceinline__ float bfhi(unsigned w) { return __builtin_bit_cast(float, w & 0xffff0000u); }
template <int O> __device__ __forceinline__ float xor_f(float v) { return __builtin_bit_cast(float, __builtin_amdgcn_ds_swizzle(__builtin_bit_cast(int, v), (O << 10) | 0x1f)); }
__device__ __forceinline__ float wave_sum(float v) { v += xor_f<1>(v); v += xor_f<2>(v); v += xor_f<4>(v); v += xor_f<8>(v); v += xor_f<16>(v);
    const int b = __builtin_bit_cast(int, v); return __builtin_bit_cast(float, __builtin_amdgcn_readlane(b, 0)) + __builtin_bit_cast(float, __builtin_amdgcn_readlane(b, 32)); }

__device__ __forceinline__ float sigm(float x) { return 1.f / (1.f + __expf(-x)); }

struct Ctx { int tid, lane, wave, gw, ngw, vcu, G, bid, wave_s; LAS unsigned char* lds; unsigned char* ws; };

__device__ __forceinline__ int fresh_tid(int wave_s) { int l; asm volatile("v_mbcnt_lo_u32_b32 %0, -1, 0\n\tv_mbcnt_hi_u32_b32 %0, -1, %0" : "=v"(l)); return (wave_s << 6) | l; }
__device__ __forceinline__ Ctx relaunder(const Ctx& X) { Ctx Y = X; const int t = fresh_tid(X.wave_s); Y.tid = t; Y.lane = t & 63; return Y; }

template <int MAP> __device__ __forceinline__ int rowmap(int n) {
    if (MAP == 1) {
        if (n < 1536 || n >= 2560) return n;
        const int hb = (n - 1536) & ~63, d = (n - 1536) & 63, i = (d & 31) >> 2, j = d & 3;
        return 1536 + hb + 8 * i + ((d >> 5) << 2) + j;
    }
    if (MAP == 2) return ((n >> 7) << 8) + (n & 127);
    if (MAP == 3) return ((n >> 7) << 8) + 128 + (n & 127);
    return n;
}
__device__ __forceinline__ unsigned cvtpk_(float lo, float hi) { unsigned r; asm volatile("v_cvt_pk_bf16_f32 %0, %1, %2" : "=v"(r) : "v"(lo), "v"(hi)); return r; }
struct TrItem { const float* src; bf16* dst; };
template <int MAP> __device__ __forceinline__ void p0_transpose(const Ctx& X, const float* W, int K, int N, bf16* WT, int nmat, size_t sstride, size_t dstride) {
    LAS float* scr = (LAS float*)(X.lds + X.wave * 16640);
    const int nblk = N / 64, per = (K / 64) * nblk, tot = per * nmat, lane = X.lane;
    const int nq = lane & 15, kr = lane >> 4, c = lane & 7, nsub = lane >> 3;
    f32x4 v[16];
    int it = X.gw;
#define TR_SRC(it_) (W + (size_t)((it_) / per) * sstride + (size_t)(64 * (((it_) % per) / nblk) + kr) * N + 64 * (((it_) % per) % nblk) + 4 * nq)
    if (it < tot) { const float* s = TR_SRC(it);
#pragma unroll
        for (int i = 0; i < 16; ++i) v[i] = __builtin_nontemporal_load((const f32x4*)(s + (size_t)(4 * i) * N)); }
    while (it < tot) {
#pragma unroll
        for (int i = 0; i < 16; ++i) { LAS float* d = scr + (4 * i + kr) * 65 + 4 * nq; d[0] = v[i][0]; d[1] = v[i][1]; d[2] = v[i][2]; d[3] = v[i][3]; }
        const int nit = it + X.ngw;
        if (nit < tot) { const float* s = TR_SRC(nit);
#pragma unroll
            for (int i = 0; i < 16; ++i) v[i] = __builtin_nontemporal_load((const f32x4*)(s + (size_t)(4 * i) * N)); }
        asm volatile("s_waitcnt lgkmcnt(0)" ::: "memory");
        const int m = it / per, r = it - m * per, k0 = 64 * (r / nblk), n0 = 64 * (r % nblk);
        bf16* dst = WT + (size_t)m * dstride;
#pragma unroll
        for (int j = 0; j < 8; ++j) { const int n = nsub + 8 * j; const LAS float* s = scr + (8 * c) * 65 + n;
            v4u o; o.x = cvtpk_(s[0 * 65], s[1 * 65]); o.y = cvtpk_(s[2 * 65], s[3 * 65]); o.z = cvtpk_(s[4 * 65], s[5 * 65]); o.w = cvtpk_(s[6 * 65], s[7 * 65]);
            __builtin_nontemporal_store(o, (v4u*)(dst + (size_t)rowmap<MAP>(n0 + n) * K + k0 + 8 * c)); }
        asm volatile("s_waitcnt lgkmcnt(0)" ::: "memory");
        it = nit;
    }
#undef TR_SRC
}
struct Row8 { f32x4 a[2][2]; };
__device__ __forceinline__ void row8_load(Row8& r, const float* p, int lane) {
#pragma unroll
    for (int j = 0; j < 2; ++j) { const f32x4* q = (const f32x4*)p + 2 * (lane + 64 * j); r.a[j][0] = q[0]; r.a[j][1] = q[1]; }
}
__device__ __forceinline__ float row8_sumsq(const Row8& r) {
    float s = 0.f;
#pragma unroll
    for (int j = 0; j < 2; ++j)
#pragma unroll
        for (int h = 0; h < 2; ++h) s += (r.a[j][h].x * r.a[j][h].x + r.a[j][h].y * r.a[j][h].y) + (r.a[j][h].z * r.a[j][h].z + r.a[j][h].w * r.a[j][h].w);
    return s;
}
__device__ __forceinline__ void rms_row_to_bf16(const float* __restrict__ xrow, const float* __restrict__ g, bf16* __restrict__ orow, int lane) {
    const f32x4* xr = (const f32x4*)xrow + lane; f32x4 v[4]; float s = 0.f;
#pragma unroll
    for (int j = 0; j < 4; ++j) { v[j] = xr[64 * j]; s += (v[j].x * v[j].x + v[j].y * v[j].y) + (v[j].z * v[j].z + v[j].w * v[j].w); }
    const float r = rsqrtf(wave_sum(s) * (1.f / D) + 1e-6f);
    v2u* o8 = (v2u*)orow + lane;
#pragma unroll
    for (int j = 0; j < 4; ++j) { const f32x4 gg = ((const f32x4*)g)[lane + 64 * j]; v2u w; w.x = pk2(v[j].x * r * gg.x, v[j].y * r * gg.y); w.y = pk2(v[j].z * r * gg.z, v[j].w * r * gg.w); o8[64 * j] = w; }
}
__device__ __forceinline__ void p0_filters(const Ctx& X, const Args& a) {
    LAS float* z = (LAS float*)X.lds;
    LAS float* h1 = z + 32 * 36;
    LAS float* h2T = h1 + 32 * 64;
    bf16* FILT = (bf16*)(X.ws + WS_FILT);
    const int tid = X.tid, j = tid & 63, tq = tid >> 6;
    const float min_decay = logf(1e-2f) / 0.3f, max_decay = logf(1e-2f) / 1.5f;
    for (int it = X.bid; it < 2 * (S / 32); it += X.G) {
        const int l = it / (S / 32), t0 = (it % (S / 32)) * 32;
        const float *w1 = a.in[6] + l * 33 * 64, *b1 = a.in[7] + l * 64, *f1 = a.in[8] + l * 64, *w2 = a.in[9] + l * 64 * 64, *b2 = a.in[10] + l * 64, *f2 = a.in[11] + l * 64, *w3 = a.in[12] + (size_t)l * 64 * 2048;
        __syncthreads();
        for (int e = tid; e < 32 * 33; e += NTH) { const int tt = e / 33, jj0 = e - tt * 33, t = t0 + tt; float v;
            if (jj0 == 0) v = (float)t / (float)(S - 1);
            else { const int jj = (jj0 - 1) & 15; const float w = 2.0f * 3.14159265358979323846f * (float)t / (float)S; const float fr = 1e-4f + (float)jj * ((15.0f - 1e-4f) / 15.0f); const float ang = w * fr; v = (jj0 <= 16) ? cosf(ang) : -sinf(ang); }
            z[tt * 36 + jj0] = v; }
        __syncthreads();
#pragma unroll 1
        for (int k = 0; k < 4; ++k) { const int tt = tq + 8 * k; float acc = b1[j]; for (int i = 0; i < 33; ++i) acc += z[tt * 36 + i] * w1[i * 64 + j]; h1[tt * 64 + j] = sinf(f1[j] * acc); }
        __syncthreads();
#pragma unroll 1
        for (int k = 0; k < 4; ++k) { const int tt = tq + 8 * k; float acc = b2[j]; for (int i = 0; i < 64; ++i) acc += h1[tt * 64 + i] * w2[i * 64 + j]; h2T[j * 32 + tt] = sinf(f2[j] * acc); }
        __syncthreads();
        { const int n0 = 4 * tid; f32x4 acc[32];
#pragma unroll
            for (int q = 0; q < 32; ++q) acc[q] = (f32x4){0.f, 0.f, 0.f, 0.f};
#pragma unroll 4
            for (int i = 0; i < 64; ++i) { const f32x4 w = *(const f32x4*)(w3 + i * 2048 + n0);
#pragma unroll
                for (int g = 0; g < 8; ++g) { const f32x4 hh = *(const LAS f32x4*)(h2T + i * 32 + 4 * g); acc[4 * g] += w * hh.x; acc[4 * g + 1] += w * hh.y; acc[4 * g + 2] += w * hh.z; acc[4 * g + 3] += w * hh.w; } }
            const int c0 = n0 & 511, od = n0 >> 9;
#pragma unroll
            for (int e = 0; e < 4; ++e) { const float delta = fabsf(min_decay + (float)(c0 + e) * ((max_decay - min_decay) / 511.0f));
#pragma unroll
                for (int g = 0; g < 4; ++g) { float o8[8];
#pragma unroll
                    for (int q = 0; q < 8; ++q) o8[q] = acc[8 * g + q][e] * expf(-((float)(t0 + 8 * g + q) / (float)(S - 1)) * delta);
                    v4u o; o.x = pk2(o8[0], o8[1]); o.y = pk2(o8[2], o8[3]); o.z = pk2(o8[4], o8[5]); o.w = pk2(o8[6], o8[7]);
                    *(v4u*)(FILT + (((size_t)l * 4 + od) * C + c0 + e) * S + t0 + 8 * g) = o; } } }
    }
    __syncthreads();
}
__device__ __forceinline__ void p0_experts(const Ctx& X, const Args& a, int l) {
    bf16* wgu = (bf16*)(X.ws + WS_WGU) + (size_t)l * E * 2 * F * D; bf16* wd = (bf16*)(X.ws + WS_WD) + (size_t)l * E * F * D;
    p0_transpose<2>(X, a.in[25] + (size_t)l * E * D * F, D, F, wgu, E, (size_t)D * F, (size_t)2 * F * D);
    p0_transpose<3>(X, a.in[26] + (size_t)l * E * D * F, D, F, wgu, E, (size_t)D * F, (size_t)2 * F * D);
    p0_transpose<0>(X, a.in[27] + (size_t)l * E * D * F, F, D, wd, E, (size_t)F * D, (size_t)F * D);
}
__device__ __forceinline__ void p0_prologue(const Ctx& X, const Args& a) {
    const int m = a.p0_mask;
    if (m & 1) {
        p0_transpose<1>(X, a.in[2], D, INW, (bf16*)(X.ws + WS_WIN), 2, (size_t)D * INW, (size_t)D * INW);
        p0_transpose<0>(X, a.in[19], C, D, (bf16*)(X.ws + WS_WUH), 2, (size_t)C * D, (size_t)2 * C * D);
        p0_transpose<0>(X, a.in[20], C, D, (bf16*)(X.ws + WS_WUA), 2, (size_t)C * D, (size_t)2 * C * D);
        p0_transpose<0>(X, a.in[21], D, D, (bf16*)(X.ws + WS_WOUT), 2, (size_t)D * D, (size_t)D * D);
        float* binp = (float*)(X.ws + WS_BINP);
        for (int i = X.gw * 64 + X.lane; i < 2 * INW; i += X.ngw * 64) { const int l = i / INW, n = i - l * INW; binp[l * INW + rowmap<1>(n)] = a.in[3][i]; }
        float* rope = (float*)(X.ws + WS_ROPE);
        for (int i = X.gw * 64 + X.lane; i < S * 32; i += X.ngw * 64) { const int pos = i >> 5, j = i & 31; const float inv = powf(10000.0f, -(float)j * 2.0f / 64.0f); float sn, cs; sincosf((float)pos * inv, &sn, &cs); rope[2 * i] = cs; rope[2 * i + 1] = sn; }
    }
    if (m & 2) { p0_experts(X, a, 0); p0_experts(X, a, 1); }
    if (m & 4) p0_filters(X, a);
    if (m & 8) {
        bf16* XN = (bf16*)(X.ws + WS_XN); const int lane = X.lane; Row8 gg; row8_load(gg, a.in[1], lane);
        int r = X.gw; Row8 cur; if (r < T) row8_load(cur, a.in[0] + (size_t)r * D, lane);
        while (r < T) { const int nr = r + X.ngw; Row8 nxt; if (nr < T) row8_load(nxt, a.in[0] + (size_t)nr * D, lane);
            const float rs = rsqrtf(wave_sum(row8_sumsq(cur)) * (1.f / D) + 1e-6f);
#pragma unroll
            for (int j = 0; j < 2; ++j) { const f32x4 y0 = cur.a[j][0] * gg.a[j][0] * rs, y1 = cur.a[j][1] * gg.a[j][1] * rs;
                v4u w; w.x = pk2(y0.x, y0.y); w.y = pk2(y0.z, y0.w); w.z = pk2(y1.x, y1.y); w.w = pk2(y1.z, y1.w); ((v4u*)(XN + (size_t)r * D))[lane + 64 * j] = w; }
            cur = nxt; r = nr; }
    }
}
}
namespace mk {
using pg8::Unit;
#ifndef MK_SIMPLE_ORDER
#define MK_SIMPLE_ORDER 0
#endif
__device__ __forceinline__ unsigned cvtpk(float lo, float hi) { unsigned r; asm volatile("v_cvt_pk_bf16_f32 %0, %1, %2" : "=v"(r) : "v"(lo), "v"(hi)); return r; }
__device__ __forceinline__ v4u pack8(f32x4 a, f32x4 b) { v4u w; w.x = cvtpk(a[0], a[1]); w.y = cvtpk(a[2], a[3]); w.z = cvtpk(b[0], b[1]); w.w = cvtpk(b[2], b[3]); return w; }
__device__ __forceinline__ void unpack8(v4u w, f32x4& a, f32x4& b) { a = (f32x4){bflo(w.x), bfhi(w.x), bflo(w.y), bfhi(w.y)}; b = (f32x4){bflo(w.z), bfhi(w.z), bflo(w.w), bfhi(w.w)}; }
__device__ __forceinline__ float fsig(float x) { return __builtin_amdgcn_rcpf(1.f + __expf(-x)); }

struct EpiWin {
    static constexpr bool PERM = true, AFTER_DRAIN = false;
    unsigned char* ws; const float* bias; const float* rope;
    __device__ __forceinline__ void operator()(const f32x4 (&acc)[2][2][4][2], const Unit& u, int wr, int wc, int fr, int fq) const {
        const int colt = u.pn * 256, row0 = u.pm * 256 + wr * 64 + fr, cin = wc * 32 + 8 * fq;
        bf16* base; int ldc, col0, mode; float sc = 1.f;
        if (colt < 1536) { base = (bf16*)(ws + WS_U); ldc = 1536; col0 = colt; mode = 0; }
        else if (colt < 2048) { base = (bf16*)(ws + WS_Q); ldc = 512; col0 = colt - 1536; mode = 1; sc = QSCALE; }
        else if (colt < 2560) { base = (bf16*)(ws + WS_K); ldc = 512; col0 = colt - 2048; mode = 1; }
        else if (colt < 3072) { base = (bf16*)(ws + WS_V); ldc = 512; col0 = colt - 2560; mode = 0; }
        else if (colt < 4096) { base = (bf16*)(ws + WS_GH); ldc = 1024; col0 = colt - 3072; mode = 2; }
        else { base = (bf16*)(ws + WS_GA); ldc = 1024; col0 = colt - 4096; mode = 2; }
        f32x4 bv[2][2];
#pragma unroll
        for (int bj = 0; bj < 2; ++bj)
#pragma unroll
            for (int n = 0; n < 2; ++n) bv[bj][n] = *(const f32x4*)(bias + colt + bj * 128 + cin + 4 * n);
#pragma unroll
        for (int ai = 0; ai < 2; ++ai)
#pragma unroll
            for (int m = 0; m < 4; ++m) {
                const int row = row0 + ai * 128 + m * 16; bf16* rowp = base + (size_t)row * ldc + col0 + cin;
#pragma unroll
                for (int bj = 0; bj < 2; ++bj) {
                    f32x4 v0 = acc[ai][bj][m][0] + bv[bj][0], v1 = acc[ai][bj][m][1] + bv[bj][1];
                    if (mode == 1) {
                        const int i = ((bj * 128 + cin) & 63) >> 3; const float* rp = rope + ((size_t)(row & (S - 1)) * 32 + 4 * i) * 2;
                        const f32x4 r0 = *(const f32x4*)rp, r1 = *(const f32x4*)(rp + 4);
                        const f32x4 cs = {r0[0], r0[2], r1[0], r1[2]}, sn = {r0[1], r0[3], r1[1], r1[3]};
                        const f32x4 o1 = (v0 * cs - v1 * sn) * sc, o2 = (v1 * cs + v0 * sn) * sc; v0 = o1; v1 = o2;
                    } else if (mode == 2) {
#pragma unroll
                        for (int e = 0; e < 4; ++e) { v0[e] = fsig(v0[e]); v1[e] = fsig(v1[e]); }
                    }
                    *(v4u*)(rowp + bj * 128) = pack8(v0, v1);
                }
            }
    }
};
struct EpiMerge2 {
    static constexpr bool PERM = true, AFTER_DRAIN = false;
    const bf16* GH; const bf16* GA; bf16* T1; bf16* MG;
    __device__ __forceinline__ void operator()(const f32x4 (&acc)[2][2][4][2], const Unit& u, int wr, int wc, int fr, int fq) const {
        const int row0 = u.pm * 256 + wr * 64 + fr, col0 = u.pn * 256 + wc * 32 + 8 * fq; const bool second = u.pa != u.pm; const bf16* G = second ? GA : GH;
#pragma unroll
        for (int ai = 0; ai < 2; ++ai)
#pragma unroll
            for (int m = 0; m < 4; ++m) { const size_t off = (size_t)(row0 + ai * 128 + m * 16) * D + col0;
#pragma unroll
                for (int bj = 0; bj < 2; ++bj) { f32x4 g0, g1; unpack8(*(const v4u*)(G + off + bj * 128), g0, g1);
                    f32x4 v0 = acc[ai][bj][m][0] * g0, v1 = acc[ai][bj][m][1] * g1;
                    if (second) { f32x4 t0, t1; unpack8(*(const v4u*)(T1 + off + bj * 128), t0, t1); v0 += t0; v1 += t1; *(v4u*)(MG + off + bj * 128) = pack8(v0, v1); }
                    else *(v4u*)(T1 + off + bj * 128) = pack8(v0, v1); } }
    }
};
struct OrderMerge {
    pg8::StaticOrder so;
    __device__ __forceinline__ bool next(int i, Unit& u) const { if (!so.next(i >> 1, u)) return false; if (i & 1) { u.pa = u.pm + T / 256; u.pb = u.pn + 4; } return true; }
    __device__ __forceinline__ void a_ready(const Unit&) const {}
    __device__ __forceinline__ void done(const Unit&) const {}
};
struct EpiOut {
    static constexpr bool PERM = false, AFTER_DRAIN = false;
    const float* xin; float* X;
    __device__ __forceinline__ void operator()(const f32x4 (&acc)[2][2][4][2], const Unit& u, int wr, int wc, int fr, int fq) const {
        const int row0 = u.pm * 256 + wr * 64 + fr, col0 = u.pn * 256 + wc * 32 + 4 * fq;
#pragma unroll
        for (int ai = 0; ai < 2; ++ai)
#pragma unroll
            for (int m = 0; m < 4; ++m) { const size_t off = (size_t)(row0 + ai * 128 + m * 16) * D + col0;
#pragma unroll
                for (int bj = 0; bj < 2; ++bj)
#pragma unroll
                    for (int n = 0; n < 2; ++n) *(f32x4*)(X + off + bj * 128 + n * 16) = *(const f32x4*)(xin + off + bj * 128 + n * 16) + acc[ai][bj][m][n]; }
    }
};
struct EpiSwiGLU {
    static constexpr bool PERM = true, AFTER_DRAIN = false;
    bf16* HB;
    __device__ __forceinline__ void operator()(const f32x4 (&acc)[2][2][4][2], const Unit& u, int wr, int wc, int fr, int fq) const {
        const int row0 = u.pm * 256 + wr * 64 + fr, col0 = u.pn * 128 + wc * 32 + 8 * fq;
#pragma unroll
        for (int ai = 0; ai < 2; ++ai)
#pragma unroll
            for (int m = 0; m < 4; ++m) { f32x4 h[2];
#pragma unroll
                for (int n = 0; n < 2; ++n) { const f32x4 g = acc[ai][0][m][n], up = acc[ai][1][m][n];
#pragma unroll
                    for (int e = 0; e < 4; ++e) h[n][e] = g[e] * fsig(g[e]) * up[e]; }
                *(v4u*)(HB + (size_t)(row0 + ai * 128 + m * 16) * F + col0) = pack8(h[0], h[1]); }
    }
};
struct EpiDown {
    static constexpr bool PERM = true, AFTER_DRAIN = false;
    bf16* YE; const float* gate;
    __device__ __forceinline__ void operator()(const f32x4 (&acc)[2][2][4][2], const Unit& u, int wr, int wc, int fr, int fq) const {
        const int row0 = u.pm * 256 + wr * 64 + fr, col0 = u.pn * 256 + wc * 32 + 8 * fq;
#pragma unroll
        for (int ai = 0; ai < 2; ++ai)
#pragma unroll
            for (int m = 0; m < 4; ++m) { const int row = row0 + ai * 128 + m * 16; const float g = gate[row];
#pragma unroll
                for (int bj = 0; bj < 2; ++bj) *(v4u*)(YE + (size_t)row * D + col0 + bj * 128) = pack8(acc[ai][bj][m][0] * g, acc[ai][bj][m][1] * g); }
    }
};
struct OrderMoE1 {
    int G, c;
    __device__ __forceinline__ bool next(int i, Unit& u) const {
        if (MK_SIMPLE_ORDER || G != 256) { const int L = i * G + c; if (L >= 2048) return false; const int e = L >> 7, r = L & 127; u.pm = e * 8 + (r & 7); u.pn = r >> 3; u.pb = e * 16 + u.pn; u.pa = u.pm; return true; }
        if (i >= 8) return false;
        const int ch = i * 8 + (c & 7), j = c >> 3, e = ch >> 2, ng = ch & 3; u.pm = e * 8 + (j & 7); u.pn = ng * 4 + (j >> 3); u.pb = e * 16 + u.pn; u.pa = u.pm; return true;
    }
    __device__ __forceinline__ void a_ready(const Unit&) const {}
    __device__ __forceinline__ void done(const Unit&) const {}
};
struct OrderMoE2 {
    int G, c;
    __device__ __forceinline__ bool next(int i, Unit& u) const {
        if (MK_SIMPLE_ORDER || G != 256) { const int L = i * G + c; if (L >= 512) return false; const int e = L >> 5, r = L & 31; u.pm = e * 8 + (r & 7); u.pn = r >> 3; u.pb = e * 4 + u.pn; u.pa = u.pm; return true; }
        if (i >= 2) return false;
        const int e = i * 8 + (c & 7), j = c >> 3; u.pm = e * 8 + (j & 7); u.pn = j >> 3; u.pb = e * 4 + u.pn; u.pa = u.pm; return true;
    }
    __device__ __forceinline__ void a_ready(const Unit&) const {}
    __device__ __forceinline__ void done(const Unit&) const {}
};

__device__ __forceinline__ void p5_norm_router(const Ctx& X, const float* Xr, const float* __restrict__ g, const float* __restrict__ wr, const float* __restrict__ br) {
    bf16* XN = (bf16*)(X.ws + WS_XN); float* afft = (float*)(X.ws + WS_AFFT); const int lane = X.lane;
    LAS float* wt = (LAS float*)X.lds;
    __syncthreads();
    for (int i = X.tid; i < D * 4; i += NTH) { const f32x4 w = ((const f32x4*)wr)[i]; const int k = i >> 2, e0 = (i & 3) * 4; wt[(e0 + 0) * D + k] = w.x; wt[(e0 + 1) * D + k] = w.y; wt[(e0 + 2) * D + k] = w.z; wt[(e0 + 3) * D + k] = w.w; }
    __syncthreads();
    Row8 gg; row8_load(gg, g, lane);
    int tok = X.gw; Row8 cur; if (tok < T) row8_load(cur, Xr + (size_t)tok * D, lane);
    while (tok < T) {
        const int ntok = tok + X.ngw; Row8 nxt; if (ntok < T) row8_load(nxt, Xr + (size_t)ntok * D, lane);
        const float r = rsqrtf(wave_sum(row8_sumsq(cur)) * (1.f / D) + 1e-6f);
        float acc[16];
#pragma unroll
        for (int e = 0; e < 16; ++e) acc[e] = 0.f;
#pragma unroll
        for (int j = 0; j < 2; ++j) { f32x4 y[2];
#pragma unroll
            for (int h = 0; h < 2; ++h) y[h] = cur.a[j][h] * gg.a[j][h] * r;
            v4u w; w.x = pk2(y[0].x, y[0].y); w.y = pk2(y[0].z, y[0].w); w.z = pk2(y[1].x, y[1].y); w.w = pk2(y[1].z, y[1].w);
            ((v4u*)(XN + (size_t)tok * D))[lane + 64 * j] = w;
#pragma unroll
            for (int e = 0; e < 16; ++e) { const LAS f32x4* wp = (const LAS f32x4*)(wt + e * D + 8 * (lane + 64 * j)); const f32x4 w0 = wp[0], w1 = wp[1];
                acc[e] += ((y[0].x * w0.x + y[0].y * w0.y) + (y[0].z * w0.z + y[0].w * w0.w)) + ((y[1].x * w1.x + y[1].y * w1.y) + (y[1].z * w1.z + y[1].w * w1.w));
                if ((e & 3) == 3) asm volatile("" ::: "memory"); } }
        float mx = -1e30f;
#pragma unroll
        for (int e = 0; e < 16; ++e) { acc[e] = wave_sum(acc[e]) + br[e]; mx = fmaxf(mx, acc[e]); }
        float l = 0.f;
#pragma unroll
        for (int e = 0; e < 16; ++e) { acc[e] = expf(acc[e] - mx); l += acc[e]; }
        const int b = tok >> 12, s_ = tok & (S - 1);
        if (lane < 16) { float vv = 0.f;
#pragma unroll
            for (int e = 0; e < 16; ++e) if (lane == e) vv = acc[e];
            afft[((size_t)b * E + lane) * S + s_] = vv / l; }
        cur = nxt; tok = ntok;
    }
    __syncthreads();
}
__device__ __forceinline__ void p6_topk(const Ctx& X) {
    const float* afft = (const float*)(X.ws + WS_AFFT); int* rows = (int*)(X.ws + WS_ROWS); float* gate = (float*)(X.ws + WS_GATE); int* inv = (int*)(X.ws + WS_INV);
    for (int p = X.bid; p < B * E; p += X.G) { const int b = p >> 4, e = p & 15, slotbase = e * 2048 + b * 512;
        tk::topk_problem(afft + (size_t)p * S, b * S, e, slotbase, rows + slotbase, gate + slotbase, inv, (int*)(X.lds), X.tid); }
}
__device__ __forceinline__ void p6_gather(const Ctx& X) {
    const int* rows = (const int*)(X.ws + WS_ROWS); const bf16* XN = (const bf16*)(X.ws + WS_XN); bf16* XG = (bf16*)(X.ws + WS_XG);
    for (int sl0 = X.gw * 4; sl0 < E * 2048; sl0 += X.ngw * 4) {
        const int myrow = X.lane < 4 ? __hip_atomic_load(rows + sl0 + X.lane, __ATOMIC_RELAXED, __HIP_MEMORY_SCOPE_AGENT) : 0;
        v4u d[4][2];
#pragma unroll
        for (int i = 0; i < 4; ++i) { const int tok = __builtin_amdgcn_readlane(myrow, i); const v4u* s = (const v4u*)(XN + (size_t)tok * D) + X.lane; d[i][0] = s[0]; d[i][1] = s[64]; }
#pragma unroll
        for (int i = 0; i < 4; ++i) { v4u* o = (v4u*)(XG + (size_t)(sl0 + i) * D) + X.lane; o[0] = d[i][0]; o[64] = d[i][1]; }
    }
}
__device__ __forceinline__ void p9_combine(const Ctx& X, float* Xr, const float* __restrict__ g, bool final_, float* __restrict__ out) {
    const int* inv = (const int*)(X.ws + WS_INV); const bf16* YE = (const bf16*)(X.ws + WS_YE); bf16* XN = (bf16*)(X.ws + WS_XN); const int lane = X.lane;
    Row8 gg; row8_load(gg, g, lane);
    int tok = X.gw; Row8 cur; int myinv = -1;
    if (tok < T) { row8_load(cur, Xr + (size_t)tok * D, lane); if (lane < 16) myinv = inv[(size_t)tok * E + lane]; }
    while (tok < T) {
        const int ntok = tok + X.ngw; Row8 nxt; int ninv = -1;
        if (ntok < T) { row8_load(nxt, Xr + (size_t)ntok * D, lane); if (lane < 16) ninv = inv[(size_t)ntok * E + lane]; }
        unsigned long long m = __ballot(myinv >= 0);
        while (m) {
            int sl[4];
#pragma unroll
            for (int i = 0; i < 4; ++i) { if (m) { const int e = __builtin_ctzll(m); m &= m - 1; sl[i] = __builtin_amdgcn_readlane(myinv, e); } else sl[i] = -1; }
            v4u y[4][2];
#pragma unroll
            for (int i = 0; i < 4; ++i) if (sl[i] >= 0) { const v4u* yp = (const v4u*)(YE + (size_t)sl[i] * D); y[i][0] = yp[lane]; y[i][1] = yp[lane + 64]; }
#pragma unroll
            for (int i = 0; i < 4; ++i) if (sl[i] >= 0) {
#pragma unroll
                for (int j = 0; j < 2; ++j) { f32x4 p, q; unpack8(y[i][j], p, q); cur.a[j][0] += p; cur.a[j][1] += q; } }
        }
        const float r = rsqrtf(wave_sum(row8_sumsq(cur)) * (1.f / D) + 1e-6f);
        if (final_) {
#pragma unroll
            for (int j = 0; j < 2; ++j)
#pragma unroll
                for (int h = 0; h < 2; ++h) ((f32x4*)(out + (size_t)tok * D))[2 * (lane + 64 * j) + h] = cur.a[j][h] * gg.a[j][h] * r;
        } else {
#pragma unroll
            for (int j = 0; j < 2; ++j) {
#pragma unroll
                for (int h = 0; h < 2; ++h) ((f32x4*)(Xr + (size_t)tok * D))[2 * (lane + 64 * j) + h] = cur.a[j][h];
                const f32x4 y0 = cur.a[j][0] * gg.a[j][0] * r, y1 = cur.a[j][1] * gg.a[j][1] * r;
                v4u w; w.x = pk2(y0.x, y0.y); w.y = pk2(y0.z, y0.w); w.z = pk2(y1.x, y1.y); w.w = pk2(y1.z, y1.w);
                ((v4u*)(XN + (size_t)tok * D))[lane + 64 * j] = w; }
        }
        cur = nxt; myinv = ninv; tok = ntok;
    }
}
}
namespace mk {
__device__ __forceinline__ void p1t_shortconv(const Ctx& X, const float* __restrict__ cw, const float* __restrict__ cb) {
    const bf16* U = (const bf16*)(X.ws + WS_U); bf16* UCT = (bf16*)(X.ws + WS_UCT);
    LAS float* raw = (LAS float*)(X.lds + X.wave * 17408);
    const int lane = X.lane, rq = lane >> 3, cq = lane & 7;
    constexpr int NIT = (T / 64) * 24;
    v4u w[9];
#define P1T_LOAD(it_) do { const int tt_ = (it_) / 24, cg_ = (it_) - tt_ * 24, tok0_ = tt_ * 64, tin_ = tok0_ & (S - 1); \
        _Pragma("unroll") for (int i = 0; i < 9; ++i) { const int r = 8 * i + rq, tpos = tin_ + r - 1; w[i] = (v4u){0u, 0u, 0u, 0u}; \
            if (r < 66 && tpos >= 0 && tpos < S) w[i] = *(const v4u*)(U + (size_t)(tok0_ + r - 1) * 1536 + cg_ * 64 + 8 * cq); } } while (0)
    int it = X.gw;
    if (it < NIT) P1T_LOAD(it);
    while (it < NIT) {
        const int tt = it / 24, cg = it - tt * 24, tok0 = tt * 64, ch0 = cg * 64;
#pragma unroll
        for (int i = 0; i < 9; ++i) { const int r = 8 * i + rq; if (r < 66) { LAS float* d = raw + r * 65 + 8 * cq; f32x4 p, q; unpack8(w[i], p, q);
            d[0] = p.x; d[1] = p.y; d[2] = p.z; d[3] = p.w; d[4] = q.x; d[5] = q.y; d[6] = q.z; d[7] = q.w; } }
        const int nit = it + X.ngw;
        if (nit < NIT) P1T_LOAD(nit);
        asm volatile("s_waitcnt lgkmcnt(0)" ::: "memory");
        const int chs = lane >> 3, tch = lane & 7;
#pragma unroll
        for (int g = 0; g < 8; ++g) { const int ch = 8 * g + chs, gc = ch0 + ch; const float w0 = cw[gc], w1 = cw[1536 + gc], w2 = cw[3072 + gc], bb = cb[gc];
            float v[10];
#pragma unroll
            for (int k = 0; k < 10; ++k) v[k] = raw[(8 * tch + k) * 65 + ch];
            float o[8];
#pragma unroll
            for (int k = 0; k < 8; ++k) o[k] = v[k] * w0 + v[k + 1] * w1 + v[k + 2] * w2 + bb;
            v4u pk; pk.x = pk2(o[0], o[1]); pk.y = pk2(o[2], o[3]); pk.z = pk2(o[4], o[5]); pk.w = pk2(o[6], o[7]);
            *(v4u*)(UCT + (size_t)gc * T + tok0 + 8 * tch) = pk; }
        asm volatile("s_waitcnt lgkmcnt(0)" ::: "memory");
        it = nit;
    }
#undef P1T_LOAD
}

__device__ __forceinline__ void p1t_kmax(const Ctx& X, unsigned* kmax2) {
    const bf16* K = (const bf16*)(X.ws + WS_K); const int lane = X.lane; LAS float* red = (LAS float*)(X.lds + 8 * 17408);
    const int b = X.gw / 512, t0 = X.gw % 512; float mx = 0.f;
    if (b < B) {
        v4u w[8];
#pragma unroll
        for (int i = 0; i < 8; ++i) w[i] = ((const v4u*)(K + ((size_t)b * S + t0 + 512 * i) * 512))[lane];
#pragma unroll
        for (int i = 0; i < 8; ++i) { f32x4 p, q; unpack8(w[i], p, q); float ss = (p.x * p.x + p.y * p.y) + (p.z * p.z + p.w * p.w) + (q.x * q.x + q.y * q.y) + (q.z * q.z + q.w * q.w);
            ss += xor_f<1>(ss); ss += xor_f<2>(ss); ss += xor_f<4>(ss); mx = fmaxf(mx, ss); }
    }
    __syncthreads();
    if ((lane & 7) == 0) red[X.wave * 8 + (lane >> 3)] = mx;
    __syncthreads();
    if (X.tid < 8 && b < B) { float m = red[X.tid]; for (int w_ = 1; w_ < 8; ++w_) m = fmaxf(m, red[w_ * 8 + X.tid]); atomicMax(kmax2 + b * 8 + X.tid, __float_as_uint(m)); }
}

namespace at {
constexpr int KVBLK = 64, LDK = 512;
constexpr int KPITCH = 272;
constexpr int SHM_V = 64 * 128 * 2, SHM_K = 64 * KPITCH;
constexpr int OFF_V = 0, OFF_K = 2 * SHM_V, OFF_Q = OFF_K + 2 * SHM_K, OFF_WS = OFF_Q + 256 * KPITCH, LDS_TOTAL = OFF_WS + 8 * 160 * 4;
constexpr float THR2 = 8.0f * 1.4426950408889634f;
#define KSWZ(row, colB) ((row) * KPITCH + (colB))
#define SBAR() __builtin_amdgcn_sched_barrier(0)
__device__ __forceinline__ int crow(int r, int hi) { return (r & 3) + 8 * (r >> 2) + 4 * hi; }
__device__ __forceinline__ int v_st(int k, int c) { const int kk = (k & ~0xC) | ((k & 4) << 1) | ((k & 8) >> 1); return ((kk >> 3) * 4 + (c >> 5)) * 512 + ((kk & 7) * 32 + (c & 31)) * 2; }
__device__ __forceinline__ int v_rd_base(int lane) { return ((lane & 3) << 3) | (((lane >> 2) & 3) << 6) | (((lane >> 4) & 1) << 5) | (((lane >> 5) & 1) << 8); }
constexpr int v_rd_off(int d0, int ks, int half) { return d0 * 512 + ks * 4096 + half * 2048; }
template <int OFF> __device__ __forceinline__ s16x4 tr_read(int vb) { s16x4 r; asm volatile("ds_read_b64_tr_b16 %0, %1 offset:%2" : "=&v"(r) : "v"(vb), "i"(OFF) : "memory"); return r; }

template <int CO> __device__ __forceinline__ void qkt(f32x16& p0, f32x16& p1, const char* Ks, const char* Qs, int qrow, int r32, int hi) {
    p0 = f32x16{}; p1 = f32x16{};
    const char* qp = Qs + KSWZ(qrow, (CO * 64 + hi * 8) * 2); const char* kp = Ks + KSWZ(r32, (CO * 64 + hi * 8) * 2);
#pragma unroll
    for (int d0 = 0; d0 < 4; ++d0) {
        const bf16x8 qf = *reinterpret_cast<const bf16x8*>(qp + d0 * 32);
        const bf16x8 b0 = *reinterpret_cast<const bf16x8*>(kp + d0 * 32);
        const bf16x8 b1 = *reinterpret_cast<const bf16x8*>(kp + 32 * KPITCH + d0 * 32);
        p0 = __builtin_amdgcn_mfma_f32_32x32x16_bf16(b0, qf, p0, 0, 0, 0);
        p1 = __builtin_amdgcn_mfma_f32_32x32x16_bf16(b1, qf, p1, 0, 0, 0);
        if (d0 == 1) asm volatile("" ::: "memory"); }
}
__device__ __forceinline__ void softmax_tile(f32x16& p0, f32x16& p1, float& m_reg, float& l_reg, float& alpha, bf16x8& pa0, bf16x8& pa1, bf16x8& pa2, bf16x8& pa3) {
    float pmax = p0[0];
#pragma unroll
    for (int r = 1; r < 16; ++r) pmax = fmaxf(pmax, p0[r]);
#pragma unroll
    for (int r = 0; r < 16; ++r) pmax = fmaxf(pmax, p1[r]);
    { auto rr = __builtin_amdgcn_permlane32_swap(__float_as_uint(pmax), __float_as_uint(pmax), false, false); pmax = fmaxf(__uint_as_float(rr[0]), __uint_as_float(rr[1])); }
    float mn;
    if (__builtin_expect(__all(pmax - m_reg <= THR2), 1)) { mn = m_reg; alpha = 1.f; }
    else { mn = fmaxf(m_reg, pmax); alpha = __builtin_amdgcn_exp2f(m_reg - mn); m_reg = mn; }
#pragma unroll
    for (int r = 0; r < 16; ++r) { p0[r] = __builtin_amdgcn_exp2f(p0[r] - mn); p1[r] = __builtin_amdgcn_exp2f(p1[r] - mn); }
    float ps = 0.f;
#pragma unroll
    for (int r = 0; r < 16; ++r) ps += p0[r];
#pragma unroll
    for (int r = 0; r < 16; ++r) ps += p1[r];
    { auto rr = __builtin_amdgcn_permlane32_swap(__float_as_uint(ps), __float_as_uint(ps), false, false); ps = __uint_as_float(rr[0]) + __uint_as_float(rr[1]); }
    l_reg = l_reg * alpha + ps;
#define PK4(P, BASE, OUT) do { unsigned a0 = cvtpk(P[BASE + 0], P[BASE + 1]), a1 = cvtpk(P[BASE + 2], P[BASE + 3]);   \
    unsigned b0 = cvtpk(P[BASE + 4], P[BASE + 5]), b1 = cvtpk(P[BASE + 6], P[BASE + 7]);                              \
    auto r0 = __builtin_amdgcn_permlane32_swap(a0, b0, false, false); auto r1 = __builtin_amdgcn_permlane32_swap(a1, b1, false, false); \
    v4u w = {r0[0], r1[0], r0[1], r1[1]}; OUT = *reinterpret_cast<bf16x8*>(&w); } while (0)
    PK4(p0, 0, pa0); PK4(p0, 8, pa1); PK4(p1, 0, pa2); PK4(p1, 8, pa3);
#undef PK4
}
__device__ __forceinline__ void softmax_fixed(f32x16& p0, f32x16& p1, float m, float& l_half, bf16x8& pa0, bf16x8& pa1, bf16x8& pa2, bf16x8& pa3) {
#pragma unroll
    for (int r = 0; r < 16; ++r) { p0[r] = __builtin_amdgcn_exp2f(p0[r] - m); p1[r] = __builtin_amdgcn_exp2f(p1[r] - m); }
    float ps = 0.f;
#pragma unroll
    for (int r = 0; r < 16; ++r) ps += p0[r] + p1[r];
    l_half += ps;
#define PK4(P, BASE, OUT) do { unsigned a0 = cvtpk(P[BASE + 0], P[BASE + 1]), a1 = cvtpk(P[BASE + 2], P[BASE + 3]);   \
    unsigned b0 = cvtpk(P[BASE + 4], P[BASE + 5]), b1 = cvtpk(P[BASE + 6], P[BASE + 7]);                              \
    auto r0 = __builtin_amdgcn_permlane32_swap(a0, b0, false, false); auto r1 = __builtin_amdgcn_permlane32_swap(a1, b1, false, false); \
    v4u w = {r0[0], r1[0], r0[1], r1[1]}; OUT = *reinterpret_cast<bf16x8*>(&w); } while (0)
    PK4(p0, 0, pa0); PK4(p0, 8, pa1); PK4(p1, 0, pa2); PK4(p1, 8, pa3);
#undef PK4
}
template <int D0> __device__ __forceinline__ void pv_one(f32x16& oa, int vb, const bf16x8 (&pa)[4]) {
#define PK(L, H) (bf16x8){L[0], L[1], L[2], L[3], H[0], H[1], H[2], H[3]}
    {   const s16x4 l0 = tr_read<v_rd_off(D0, 0, 0)>(vb), h0 = tr_read<v_rd_off(D0, 0, 1)>(vb), l1 = tr_read<v_rd_off(D0, 1, 0)>(vb), h1 = tr_read<v_rd_off(D0, 1, 1)>(vb);
        asm volatile("s_waitcnt lgkmcnt(0)" ::: "memory"); SBAR();
        oa = __builtin_amdgcn_mfma_f32_32x32x16_bf16(pa[0], PK(l0, h0), oa, 0, 0, 0);
        oa = __builtin_amdgcn_mfma_f32_32x32x16_bf16(pa[1], PK(l1, h1), oa, 0, 0, 0); }
    {   const s16x4 l2 = tr_read<v_rd_off(D0, 2, 0)>(vb), h2 = tr_read<v_rd_off(D0, 2, 1)>(vb), l3 = tr_read<v_rd_off(D0, 3, 0)>(vb), h3 = tr_read<v_rd_off(D0, 3, 1)>(vb);
        asm volatile("s_waitcnt lgkmcnt(0)" ::: "memory"); SBAR();
        oa = __builtin_amdgcn_mfma_f32_32x32x16_bf16(pa[2], PK(l2, h2), oa, 0, 0, 0);
        oa = __builtin_amdgcn_mfma_f32_32x32x16_bf16(pa[3], PK(l3, h3), oa, 0, 0, 0); }
#undef PK
}
template <int D0> __device__ __forceinline__ void pv_two(f32x16& oa, f32x16& ob, int vb, const bf16x8 (&pa)[4], const bf16x8 (&pb)[4]) {
#define PK(L, H) (bf16x8){L[0], L[1], L[2], L[3], H[0], H[1], H[2], H[3]}
    {   const s16x4 l0 = tr_read<v_rd_off(D0, 0, 0)>(vb), h0 = tr_read<v_rd_off(D0, 0, 1)>(vb), l1 = tr_read<v_rd_off(D0, 1, 0)>(vb), h1 = tr_read<v_rd_off(D0, 1, 1)>(vb);
        asm volatile("s_waitcnt lgkmcnt(0)" ::: "memory"); SBAR();
        const bf16x8 v0 = PK(l0, h0), v1 = PK(l1, h1);
        oa = __builtin_amdgcn_mfma_f32_32x32x16_bf16(pa[0], v0, oa, 0, 0, 0); ob = __builtin_amdgcn_mfma_f32_32x32x16_bf16(pb[0], v0, ob, 0, 0, 0);
        oa = __builtin_amdgcn_mfma_f32_32x32x16_bf16(pa[1], v1, oa, 0, 0, 0); ob = __builtin_amdgcn_mfma_f32_32x32x16_bf16(pb[1], v1, ob, 0, 0, 0); }
    {   const s16x4 l2 = tr_read<v_rd_off(D0, 2, 0)>(vb), h2 = tr_read<v_rd_off(D0, 2, 1)>(vb), l3 = tr_read<v_rd_off(D0, 3, 0)>(vb), h3 = tr_read<v_rd_off(D0, 3, 1)>(vb);
        asm volatile("s_waitcnt lgkmcnt(0)" ::: "memory"); SBAR();
        const bf16x8 v2 = PK(l2, h2), v3 = PK(l3, h3);
        oa = __builtin_amdgcn_mfma_f32_32x32x16_bf16(pa[2], v2, oa, 0, 0, 0); ob = __builtin_amdgcn_mfma_f32_32x32x16_bf16(pb[2], v2, ob, 0, 0, 0);
        oa = __builtin_amdgcn_mfma_f32_32x32x16_bf16(pa[3], v3, oa, 0, 0, 0); ob = __builtin_amdgcn_mfma_f32_32x32x16_bf16(pb[3], v3, ob, 0, 0, 0); }
#undef PK
}
__device__ __forceinline__ void rescale(f32x16 (&o)[4], float al, float* wsf, int r32, int hi) {
    if (__any(al < 1.f)) {
        if (hi == 0) wsf[r32] = al; asm volatile("s_waitcnt lgkmcnt(0)" ::: "memory");
#pragma unroll
        for (int r = 0; r < 16; ++r) { const float a = wsf[crow(r, hi)];
#pragma unroll
            for (int d = 0; d < 4; ++d) o[d][r] *= a; }
    }
}

__device__ __forceinline__ void epilogue(const Ctx& X, f32x16 (&oa)[4], f32x16 (&ob)[4], const float* wsf, int r32, int hi, int b, int h, int qb, float lam, float mul, const float* __restrict__ sg) {
    bf16* Yw = (bf16*)(X.ws + WS_YA) + ((size_t)b * S + qb * 256 + X.wave * 32) * 512 + h * 128;
    float gcol[4];
#pragma unroll
    for (int d = 0; d < 4; ++d) gcol[d] = sg[d * 32 + r32] * mul;
#pragma unroll
    for (int r = 0; r < 16; ++r) { const int orow = crow(r, hi); const float i0 = __builtin_amdgcn_rcpf(wsf[orow] + wsf[64 + orow]), i1 = lam * __builtin_amdgcn_rcpf(wsf[32 + orow] + wsf[96 + orow]);
        float v[4], ss = 0.f;
#pragma unroll
        for (int d = 0; d < 4; ++d) { v[d] = oa[d][r] * i0 - ob[d][r] * i1; ss += v[d] * v[d]; }
        ss += xor_f<1>(ss); ss += xor_f<2>(ss); ss += xor_f<4>(ss); ss += xor_f<8>(ss); ss += xor_f<16>(ss);
        const float rn = rsqrtf(ss * (1.f / 128.f) + 1e-5f);
#pragma unroll
        for (int d = 0; d < 4; ++d) Yw[(size_t)orow * 512 + d * 32 + r32] = (bf16)f2bf(v[d] * rn * gcol[d]); }
}
__device__ __forceinline__ int vkey(int T_, int lane) { const int kk = ((T_ >> 2) << 3) | ((lane & 31) >> 2); return (kk & ~0xC) | ((kk & 4) << 1) | ((kk & 8) >> 1); }
__device__ __forceinline__ int vcol(int T_, int lane) { return (T_ & 3) * 32 + (lane & 3) * 8; }
__device__ __forceinline__ void attn_unit(const Ctx& X, int b, int h, int qb, float lam, float mul, const float* __restrict__ sg, unsigned* kmax2) {
    char* lds = (char*)X.lds;
    const int tid = fresh_tid(X.wave_s);
    const int wid = X.wave, lane = tid & 63, r32 = lane & 31, hi = lane >> 5;
    const bf16* Qg = (const bf16*)(X.ws + WS_Q) + ((size_t)b * S + qb * 256) * LDK + h * 128;
    const bf16* Kh = (const bf16*)(X.ws + WS_K) + (size_t)b * S * LDK + h * 128;
    const bf16* Vh = (const bf16*)(X.ws + WS_V) + (size_t)b * S * LDK + h * 128;
    char* V_lds = lds + OFF_V; char* K_lds = lds + OFF_K; char* Q_lds = lds + OFF_Q;
    float* wsf = (float*)(lds + OFF_WS) + wid * 160;
    const int sr = tid >> 4, sc = (tid & 15) * 8, vst0 = v_st(sr, sc), vst1 = v_st(32 + sr, sc);
    const int vb0 = (int)(uintptr_t)V_lds + v_rd_base(lane);
#pragma unroll
    for (int i = 0; i < 8; ++i) { const int row = sr + 32 * i; *(bf16x8*)(Q_lds + KSWZ(row, sc * 2)) = *reinterpret_cast<const bf16x8*>(Qg + (size_t)row * LDK + sc); }
    bf16x8 st0, st1;
    const unsigned goff = (unsigned)(sr * LDK + sc) * 2u;
#define KLOAD(k0) do { const char* t_ = (const char*)Kh + (size_t)(k0) * (LDK * 2); st0 = *reinterpret_cast<const bf16x8*>(t_ + goff); st1 = *reinterpret_cast<const bf16x8*>(t_ + 32 * LDK * 2 + goff); } while (0)
#define VLOAD(k0) do { const char* t_ = (const char*)Vh + (size_t)(k0) * (LDK * 2); st0 = *reinterpret_cast<const bf16x8*>(t_ + goff); st1 = *reinterpret_cast<const bf16x8*>(t_ + 32 * LDK * 2 + goff); } while (0)
#define KWRITE(bb) do { *(bf16x8*)(K_lds + (bb) * SHM_K + KSWZ(sr, sc * 2)) = st0; *(bf16x8*)(K_lds + (bb) * SHM_K + KSWZ(32 + sr, sc * 2)) = st1; } while (0)
    const unsigned vsrc0 = (unsigned)(vkey(2 * wid + (lane >> 5), lane) * LDK + vcol(2 * wid + (lane >> 5), lane)) * 2u, vsrc1 = (unsigned)(vkey(2 * (wid + 8) + (lane >> 5), lane) * LDK + vcol(2 * (wid + 8) + (lane >> 5), lane)) * 2u;
#define VDMA(k0, bbn) do { const char* t_ = (const char*)Vh + (size_t)(k0) * (LDK * 2); LAS unsigned char* d_ = X.lds + OFF_V + (bbn) * SHM_V + wid * 1024; \
    __builtin_amdgcn_global_load_lds((const unsigned*)(t_ + vsrc0), (LAS unsigned*)d_, 16, 0, 0); __builtin_amdgcn_global_load_lds((const unsigned*)(t_ + vsrc1), (LAS unsigned*)(d_ + 8192), 16, 0, 0); } while (0)
    const unsigned ksrc = (unsigned)(wid * 8 * LDK * 2) + (unsigned)lane * 4u;
#define KDMA(k0, bbn) do { const char* t_ = (const char*)Kh + (size_t)(k0) * (LDK * 2) + ksrc; LAS unsigned char* d_ = X.lds + OFF_K + (bbn) * SHM_K + wid * 8 * KPITCH; \
    _Pragma("unroll") for (int i_ = 0; i_ < 8; ++i_) __builtin_amdgcn_global_load_lds((const unsigned*)(t_ + i_ * (LDK * 2)), (LAS unsigned*)(d_ + i_ * KPITCH), 4, 0, 0); } while (0)
#define VWRITE(bb) do { *(bf16x8*)(V_lds + (bb) * SHM_V + vst0) = st0; *(bf16x8*)(V_lds + (bb) * SHM_V + vst1) = st1; } while (0)
    float l0 = 0.f, l1 = 0.f; f32x16 oa[4] = {}, ob[4] = {};
    const int qrow = wid * 32 + r32; constexpr int NT = S / KVBLK;
    KDMA(0, 0); VDMA(0, 0); __syncthreads();
    float m0, m1;
    { float s0 = 0.f, s1 = 0.f;
#pragma unroll
      for (int d0 = 0; d0 < 8; ++d0) { const v4u w = *reinterpret_cast<const v4u*>(Q_lds + KSWZ(qrow, (d0 * 16 + hi * 8) * 2)); f32x4 p, q; unpack8(w, p, q);
          const float ss = (p.x * p.x + p.y * p.y) + (p.z * p.z + p.w * p.w) + (q.x * q.x + q.y * q.y) + (q.z * q.z + q.w * q.w); if (d0 < 4) s0 += ss; else s1 += ss; }
      wsf[hi * 64 + r32] = s0; wsf[hi * 64 + 32 + r32] = s1; asm volatile("s_waitcnt lgkmcnt(0)" ::: "memory");
      s0 += wsf[(hi ^ 1) * 64 + r32]; s1 += wsf[(hi ^ 1) * 64 + 32 + r32]; asm volatile("s_waitcnt lgkmcnt(0)" ::: "memory");
      const float k0 = __uint_as_float(__hip_atomic_load(kmax2 + b * 8 + h * 2, __ATOMIC_RELAXED, __HIP_MEMORY_SCOPE_AGENT)), k1 = __uint_as_float(__hip_atomic_load(kmax2 + b * 8 + h * 2 + 1, __ATOMIC_RELAXED, __HIP_MEMORY_SCOPE_AGENT));
      m0 = sqrtf(s0 * k0) * 1.001f + 1e-3f; m1 = sqrtf(s1 * k1) * 1.001f + 1e-3f; }
    for (int j = 0; j < NT; ++j) {
        const int bb = j & 1; const char* Ks = K_lds + bb * SHM_K;
        const int kn = (j + 1) * KVBLK;
        if (j + 1 < NT) { KDMA(kn, bb ^ 1); VDMA(kn, bb ^ 1); }
        const int vb = vb0 + bb * SHM_V;
        bf16x8 pa[4], pb[4];
        { f32x16 p0, p1, q0, q1;
          qkt<0>(p0, p1, Ks, Q_lds, qrow, r32, hi); qkt<1>(q0, q1, Ks, Q_lds, qrow, r32, hi);
          softmax_fixed(p0, p1, m0, l0, pa[0], pa[1], pa[2], pa[3]);
          softmax_fixed(q0, q1, m1, l1, pb[0], pb[1], pb[2], pb[3]); }
        SBAR();
        pv_two<0>(oa[0], ob[0], vb, pa, pb); pv_two<1>(oa[1], ob[1], vb, pa, pb); pv_two<2>(oa[2], ob[2], vb, pa, pb); pv_two<3>(oa[3], ob[3], vb, pa, pb);
        __syncthreads();
    }
#undef KLOAD
#undef VLOAD
#undef VDMA
#undef KDMA
#undef KWRITE
#undef VWRITE
    wsf[hi * 64 + r32] = l0; wsf[hi * 64 + 32 + r32] = l1; asm volatile("s_waitcnt lgkmcnt(0)" ::: "memory");
    { const int t2 = fresh_tid(X.wave_s); epilogue(X, oa, ob, wsf, t2 & 31, (t2 & 63) >> 5, b, h, qb, lam, mul, sg); }
    __syncthreads();
}
__device__ __forceinline__ void epilogue_unused() {}
#undef KSWZ
#undef SBAR
}
}
namespace mk {
namespace hy {
constexpr int CPS = 16704;
constexpr int NEL = 8352;
constexpr int OFF_Z = 4 * CPS;
constexpr int ZROW = 144, ZB = 128 * ZROW;
constexpr int LDS_TOTAL = OFF_Z + 4 * ZB;

__device__ __forceinline__ void build_hrev(const Ctx& X, const bf16* hf, const bf16* hb, float bias) {
    const int tid = X.tid;
    if (tid < 4 * 8) { const int m = tid >> 3, e = tid & 7; if (e < 5 - m) *(LAS bf16*)(X.lds + m * CPS + 2 * e) = 0; }
    for (int i = tid; i < 4 * (NEL - 8192); i += NTH) { const int m = i / (NEL - 8192), e = 8192 + (i - m * (NEL - 8192)); if (e > 8195 - m) *(LAS bf16*)(X.lds + m * CPS + 2 * e) = 0; }
#pragma unroll
    for (int half = 0; half < 2; ++half) {
        const v4u w = *(const v4u*)((half ? hb : hf) + 8 * tid);
        unsigned short v[8] = {(unsigned short)(w.x & 0xffff), (unsigned short)(w.x >> 16), (unsigned short)(w.y & 0xffff), (unsigned short)(w.y >> 16), (unsigned short)(w.z & 0xffff), (unsigned short)(w.z >> 16), (unsigned short)(w.w & 0xffff), (unsigned short)(w.w >> 16)};
        if (half == 0 && tid == 0) v[0] = (unsigned short)f2bf(bf2f(v[0]) + bias);
#pragma unroll
        for (int k = 0; k < 8; ++k) { const int d = 8 * tid + k; if (half == 1 && d == 0) continue;
            const int e0 = half ? 4100 + d : 4100 - d;
#pragma unroll
            for (int m = 0; m < 4; ++m) *(LAS bf16*)(X.lds + m * CPS + 2 * (e0 - m)) = v[k]; }
    }
}
#define HY_LDA(dst, qq) do { const v2u lo_ = *(const volatile LAS v2u*)(X.lds + baseA + 32 * (qq)), hi_ = *(const volatile LAS v2u*)(X.lds + baseA8 + 32 * (qq)); v4u w_ = {lo_.x, lo_.y, hi_.x, hi_.y}; dst = *reinterpret_cast<bf16x8*>(&w_); } while (0)
#define HY_LOAD_E(FA, FB, d1_, q_) do { const LAS unsigned char* zr_ = zb - (d1_) * ZROW; HY_LDA(FA[0], (q_)); HY_LDA(FA[1], (q_) + 1); \
    FB[0] = *(const LAS bf16x8*)(zr_); FB[1] = *(const LAS bf16x8*)(zr_ + 32); FB[2] = *(const LAS bf16x8*)(zr_ + 64); FB[3] = *(const LAS bf16x8*)(zr_ + 96); } while (0)
#define HY_LOAD_L(FA, q_) do { HY_LDA(FA[2], (q_) + 2); HY_LDA(FA[3], (q_) + 3); } while (0)
#define HY_MMA1(FA, FB, PA) do { __builtin_amdgcn_s_setprio(1); \
    acc0 = __builtin_amdgcn_mfma_f32_32x32x16_bf16(FA[0], FB[0], acc0, 0, 0, 0); acc1 = __builtin_amdgcn_mfma_f32_32x32x16_bf16(PA[2], FB[0], acc1, 0, 0, 0); \
    acc0 = __builtin_amdgcn_mfma_f32_32x32x16_bf16(FA[1], FB[1], acc0, 0, 0, 0); acc1 = __builtin_amdgcn_mfma_f32_32x32x16_bf16(PA[3], FB[1], acc1, 0, 0, 0); __builtin_amdgcn_s_setprio(0); } while (0)
#define HY_MMA2(FA, FB) do { __builtin_amdgcn_s_setprio(1); \
    acc0 = __builtin_amdgcn_mfma_f32_32x32x16_bf16(FA[2], FB[2], acc0, 0, 0, 0); acc1 = __builtin_amdgcn_mfma_f32_32x32x16_bf16(FA[0], FB[2], acc1, 0, 0, 0); \
    acc0 = __builtin_amdgcn_mfma_f32_32x32x16_bf16(FA[3], FB[3], acc0, 0, 0, 0); acc1 = __builtin_amdgcn_mfma_f32_32x32x16_bf16(FA[1], FB[3], acc1, 0, 0, 0); __builtin_amdgcn_s_setprio(0); } while (0)
template <int PAIR> __device__ __forceinline__ void channel(const Ctx& X, int l, int c, const float* __restrict__ hyb, v2u (&keep)[2][4]) {
    const bf16* UCT = (const bf16*)(X.ws + WS_UCT); const bf16* FILT = (const bf16*)(X.ws + WS_FILT) + (size_t)l * 4 * C * S; bf16* YH = (bf16*)(X.ws + WS_YH);
    const int tid = X.tid, lane = X.lane, wid = X.wave, r = lane & 31, h = lane >> 5, b = wid >> 1, jt = wid & 1;
    LAS unsigned char* zl = X.lds + OFF_Z;
    __syncthreads();
    v4u zero4 = {0u, 0u, 0u, 0u}; asm volatile("" : "+v"(zero4));
    for (int i = tid; i < 4 * 64 * 9; i += NTH) { const int bb = i / 576, rr = (i % 576) / 9, ch = i % 9; const int row = rr < 32 ? rr : 64 + rr;
        *(LAS v4u*)(zl + bb * ZB + row * ZROW + ch * 16) = zero4; }
    for (int i = tid; i < 4 * 64 * 8; i += NTH) { const int bb = i >> 9, s1 = (i >> 3) & 63, ch = i & 7;
        *(LAS v4u*)(zl + bb * ZB + (32 + s1) * ZROW + ch * 16) = *(const v4u*)(UCT + (size_t)c * T + bb * S + s1 * 64 + ch * 8); }
    const int m4 = (4 - (r & 3)) & 3;
    const int baseA = m4 * CPS + 2 * (8 * h - r + 4100 - m4);
    int baseA8 = baseA + 8; asm volatile("" : "+v"(baseA8));
    for (int o = 0; o < 2; ++o) {
        build_hrev(X, FILT + ((size_t)(2 * o) * C + c) * S, FILT + ((size_t)(2 * o + 1) * C + c) * S, hyb[(l * 2 + o) * C + c]);
#ifdef MK_HY_DUPBUILD
        asm volatile("" ::: "memory"); build_hrev(X, FILT + ((size_t)(2 * o) * C + c) * S, FILT + ((size_t)(2 * o + 1) * C + c) * S, hyb[(l * 2 + o) * C + c]);
#endif
        const bf16* gate = UCT + (size_t)((o + 1) * C + c) * T + (size_t)b * S;
        const int t1 = 32 * jt + r;
        v2u gw[2][4];
#pragma unroll
        for (int mt = 0; mt < 2; ++mt)
#pragma unroll
            for (int g = 0; g < 4; ++g) gw[mt][g] = *(const v2u*)(gate + t1 * 64 + 32 * mt + 8 * g + 4 * h);
        __syncthreads();
#ifndef MK_HY_SWEEPS
#define MK_HY_SWEEPS 1
#endif
        f32x16 acc0 = {}, acc1 = {};
        for (int rep = 0; rep < MK_HY_SWEEPS; ++rep) {
        const int d1max = 32 * jt + 31; int q = -4 * d1max;
        const LAS unsigned char* zb = zl + b * ZB + (32 + 32 * jt + r) * ZROW + 16 * h;
        bf16x8 fa0[4], fb0[4], fa1[4], fb1[4];
        HY_LDA(fa1[2], q - 2); HY_LDA(fa1[3], q - 1);
        HY_LOAD_E(fa0, fb0, d1max, q); HY_LOAD_L(fa0, q);
        int d1 = d1max;
        for (int it = 0; it < 47; ++it) {
            HY_LOAD_E(fa1, fb1, d1 - 1, q + 4);
            HY_MMA1(fa0, fb0, fa1);
            HY_LOAD_L(fa1, q + 4);
            HY_MMA2(fa0, fb0);
            HY_LOAD_E(fa0, fb0, d1 - 2, q + 8);
            HY_MMA1(fa1, fb1, fa0);
            HY_LOAD_L(fa0, q + 8);
            HY_MMA2(fa1, fb1);
            d1 -= 2; q += 8;
        }
        HY_MMA1(fa0, fb0, fa1); HY_MMA2(fa0, fb0);
        }
        if (MK_HY_SWEEPS == 2) { acc0 *= 0.5f; acc1 *= 0.5f; }
        __syncthreads();
#pragma unroll
        for (int mt = 0; mt < 2; ++mt)
#pragma unroll
            for (int g = 0; g < 4; ++g) { const int t0 = 32 * mt + 8 * g + 4 * h; const v2u gwv = gw[mt][g];
                const f32x16& a = mt ? acc1 : acc0;
                const float y0 = a[4 * g] * bflo(gwv.x), y1 = a[4 * g + 1] * bfhi(gwv.x), y2 = a[4 * g + 2] * bflo(gwv.y), y3 = a[4 * g + 3] * bfhi(gwv.y);
                if (o == 0) { v2u w; w.x = pk2(y0, y1); w.y = pk2(y2, y3); *(LAS v2u*)(zl + b * ZB + (32 + t1) * ZROW + t0 * 2) = w; }
                else if (PAIR == 0) { keep[mt][g].x = pk2(y0, y1); keep[mt][g].y = pk2(y2, y3); }
                else { unsigned* yo = (unsigned*)(YH + ((size_t)b * S + t1 * 64 + t0) * C + (c - 1)); const v2u kp = keep[mt][g];
                    yo[0] = (kp.x & 0xffffu) | (f2bf(y0) << 16); yo[C / 2] = (kp.x >> 16) | (f2bf(y1) << 16); yo[C] = (kp.y & 0xffffu) | (f2bf(y2) << 16); yo[3 * C / 2] = (kp.y >> 16) | (f2bf(y3) << 16); } }
    }
    __syncthreads();
}
#undef HY_LDA
#undef HY_LOAD_E
#undef HY_LOAD_L
#undef HY_MMA1
#undef HY_MMA2
}
}
namespace mk {
#define GAS __attribute__((address_space(1)))
typedef GAS unsigned gu32;
typedef GAS unsigned long long gu64;
#define RLX_AGENT __ATOMIC_RELAXED, __HIP_MEMORY_SCOPE_AGENT
#define LDS_WAIT() asm volatile("s_waitcnt lgkmcnt(0)" ::: "memory")
#define VM_WAIT() asm volatile("s_waitcnt vmcnt(0)" ::: "memory")
__device__ __forceinline__ unsigned long long rt() { return __builtin_amdgcn_s_memrealtime(); }
#define XB_TMO      128
#define XB_XCNT(j)  (256  + 64 * (j))
#define XB_XSUB(j)  (1280 + 64 * (j))
#define XB_XGEN(j)  (2304 + 64 * (j))
#define XB_TOP      3328
#define XB_TOPGEN   3392
#define XCD_BAR_WORDS 3456
#define XB_SPIN_CAP (1u << 18)

__device__ __forceinline__ unsigned xb_ld(unsigned* p)              { return __hip_atomic_load(p, __ATOMIC_RELAXED, __HIP_MEMORY_SCOPE_AGENT); }
__device__ __forceinline__ unsigned xb_add(unsigned* p, unsigned v) { return __hip_atomic_fetch_add(p, v, __ATOMIC_RELAXED, __HIP_MEMORY_SCOPE_AGENT); }
__device__ __forceinline__ unsigned xb_xcc_id() { return (unsigned)__builtin_amdgcn_s_getreg((3 << 11) | 20) & 0xFu; }
#define XB_SPIN(cond, bar) do { unsigned _sp = 0; while (cond) { __builtin_amdgcn_s_sleep(1); \
    if ((++_sp & 255u) == 0u) { if (xb_ld(&(bar)[XB_TMO])) break; if (_sp > XB_SPIN_CAP) { atomicAdd(&(bar)[XB_TMO], 1u); break; } } } } while (0)

struct XcdBarrier {
    unsigned* bar; unsigned x;
    volatile LAS unsigned* st;
};

__device__ __forceinline__ XcdBarrier xcd_barrier_post(unsigned* bar, volatile LAS unsigned* st) {
    XcdBarrier b; b.bar = bar; b.x = xb_xcc_id(); b.st = st;
    if (threadIdx.x == 0) (void)xb_add(&bar[XB_XCNT(b.x)], 1u);
    return b;
}
__device__ __forceinline__ void xcd_barrier_complete(unsigned* bar, unsigned x, unsigned& nloc, unsigned& nx) {
    const unsigned G = gridDim.x * gridDim.y * gridDim.z;
    unsigned sum, cnt, mine, sp = 0u;
    for (;;) {
        sum = 0u; cnt = 0u; mine = 0u;
#pragma unroll
        for (unsigned j = 0; j < 16; ++j) { const unsigned c = xb_ld(&bar[XB_XCNT(j)]); sum += c; cnt += (c > 0u) ? 1u : 0u; mine = (j == x) ? c : mine; }
        if (sum == G) break;
        __builtin_amdgcn_s_sleep(1);
        if ((++sp & 255u) == 0u) { if (xb_ld(&bar[XB_TMO])) break; if (sp > XB_SPIN_CAP) { atomicAdd(&bar[XB_TMO], 1u); break; } }
    }
    nloc = mine > 0u ? mine : 1u; nx = cnt > 0u ? cnt : 1u;
}

__device__ __forceinline__ void xcd_barrier(const XcdBarrier& b, int wave_s) {
    asm volatile("s_waitcnt vmcnt(0)" ::: "memory");
    __syncthreads();
    if (fresh_tid(wave_s) == 0) {
        unsigned* bar = b.bar;
        __builtin_amdgcn_s_waitcnt(0);
        unsigned nloc = b.st[0], nx = b.st[1];
        if (nloc == 0u) { xcd_barrier_complete(bar, b.x, nloc, nx); b.st[0] = nloc; b.st[1] = nx; }
        const unsigned old = xb_add(&bar[XB_XSUB(b.x)], 1u);
        const unsigned gen = old / nloc;
        if (old + 1u == (gen + 1u) * nloc) {
            __builtin_amdgcn_fence(__ATOMIC_RELEASE, "agent");
            asm volatile("s_waitcnt vmcnt(0)" ::: "memory");
            const unsigned og = xb_add(&bar[XB_TOP], 1u);
            const unsigned tg = og / nx;
            if (og + 1u == (tg + 1u) * nx) xb_add(&bar[XB_TOPGEN], 1u);
            else XB_SPIN(xb_ld(&bar[XB_TOPGEN]) == tg, bar);
            __builtin_amdgcn_fence(__ATOMIC_ACQUIRE, "agent");
            xb_add(&bar[XB_XGEN(b.x)], 1u);
            asm volatile("s_waitcnt vmcnt(0)" ::: "memory");
        } else {
            XB_SPIN(xb_ld(&bar[XB_XGEN(b.x)]) == gen, bar);
            __builtin_amdgcn_fence(__ATOMIC_ACQUIRE, "agent");
            asm volatile("s_waitcnt vmcnt(0)" ::: "memory");
        }
    }
    __syncthreads();
}

}
namespace mk {
namespace cg = cooperative_groups;
constexpr int PH_PER_LAYER = 11, N_PHASES = 1 + 2 * PH_PER_LAYER;

__device__ __forceinline__ float lam_of(const Args& a, int l, float lam_init) {
    const float *q1 = a.in[14] + l * 64, *k1 = a.in[15] + l * 64, *q2 = a.in[16] + l * 64, *k2 = a.in[17] + l * 64;
    float s1 = 0.f, s2 = 0.f; for (int i = 0; i < 64; ++i) { s1 += q1[i] * k1[i]; s2 += q2[i] * k2[i]; }
    return expf(s1) - expf(s2) + lam_init;
}

typedef const __attribute__((address_space(4))) Args* KArgPtr;
__global__ void __launch_bounds__(NTH, 2) fwd(Args a_byval) {
    extern __shared__ __attribute__((aligned(16))) unsigned char lds_raw[];
    cg::grid_group grid = cg::this_grid();
    const int ph_lo = a_byval.ph_lo, ph_hi = a_byval.ph_hi;
    const int wave_s = __builtin_amdgcn_readfirstlane((int)threadIdx.x >> 6);
    volatile LAS unsigned* bar_st = (volatile LAS unsigned*)((LAS unsigned char*)lds_raw + LDS_BYTES - 64);
    if (threadIdx.x == 0) { bar_st[0] = 0u; bar_st[1] = 0u; }
    __syncthreads();
    const XcdBarrier bar = xcd_barrier_post((unsigned*)a_byval.ws, bar_st);
    int rep_flag = 0;
    for (int ph = ph_lo; ph < ph_hi; ++ph) {
        KArgPtr ap = (KArgPtr)__builtin_amdgcn_kernarg_segment_ptr(); asm volatile("" : "+s"(ap));
        const Args a = *(const Args*)ap;
        float* Xr = (float*)(a.ws + WS_X);
        Ctx X; X.wave_s = wave_s; X.wave = wave_s; X.tid = 0; X.lane = 0;
#define FRESH() do { X.tid = fresh_tid(wave_s); X.lane = X.tid & 63; } while (0)
        { int g_ = gridDim.x, b_ = blockIdx.x; asm volatile("" : "+s"(g_), "+s"(b_)); X.G = g_; X.bid = b_; }
        { const int bx = X.bid; X.vcu = (X.G % 8 == 0) ? (bx % 8) * (X.G / 8) + bx / 8 : bx; }
        X.gw = X.vcu * NWAVES + X.wave; X.ngw = X.G * NWAVES; X.lds = (LAS unsigned char*)lds_raw; X.ws = a.ws;
#ifndef MK_EN
#define MK_EN 0xFFFF
#endif
#ifndef MK_ATT
#define MK_ATT 3
#endif
#ifndef MK_REP_SP
#define MK_REP_SP 99
#endif
        if (ph == 0) { if (MK_EN & 512) { FRESH(); p0_prologue(X, a); } }
        else {
            const int l = (ph - 1) / PH_PER_LAYER, sp = (ph - 1) % PH_PER_LAYER;
            const float lam_init = 0.8f - 0.6f * expf(-0.3f * (float)l);
            if (0) {}
#if MK_EN & 1
            else if (sp == 0) {
                FRESH();
                pg8::Gemm g{(const bf16*)(a.ws + WS_XN), (const bf16*)(a.ws + WS_WIN) + (size_t)l * INW * D, T, INW, D};
                pg8::StaticOrder So; So.init(T, INW, X.G, X.bid);
                EpiWin Ep{a.ws, (const float*)(a.ws + WS_BINP) + l * INW, (const float*)(a.ws + WS_ROPE)};
                pg8::gemm_phase<EpiWin, pg8::StaticOrder, true, true>(X.lds, g, So, Ep, X.tid);
            }
#endif
#if MK_EN & 2
            else if (sp == 1) {
                FRESH();
                p1t_shortconv(X, a.in[4] + l * 3 * 1536, a.in[5] + l * 1536);
                p1t_kmax(X, (unsigned*)(a.ws + 14336) + l * 32);
            }
#endif
#if MK_EN & 4
            else if (sp == 2) {
                FRESH();
                const float lam = lam_of(a, l, lam_init);
                const int c = X.bid;
#ifndef MK_REP_ATT
#define MK_REP_ATT 1
#endif
#ifndef MK_REP_HY
#define MK_REP_HY 1
#endif
                const int cg_ = X.vcu & 3;
                if (cg_ == 0) { __syncthreads(); p0_experts(relaunder(X), a, l); __syncthreads(); }
                for (int rep = 0; rep < MK_REP_ATT; ++rep) for (int u = c; u < 256; u += X.G) { const int bh = 2 * (u & 7) + ((u >> 3) >> 4), qb = (u >> 3) & 15; at::attn_unit(X, bh >> 2, bh & 3, qb, lam, 1.0f - lam_init, a.in[18] + l * 128, (unsigned*)(a.ws + 14336) + l * 32); }
                if (cg_ == 1) { __syncthreads(); p0_experts(relaunder(X), a, l); __syncthreads(); }
                for (int rep = 0; rep < MK_REP_HY; ++rep) for (int u = c; u < 256; u += X.G) { const int ch = 64 * (u & 7) + 2 * (u >> 3); v2u keep[2][4]; hy::channel<0>(relaunder(X), l, ch, a.in[13], keep);
                    if (cg_ == 2) { __syncthreads(); p0_experts(relaunder(X), a, l); __syncthreads(); }
                    hy::channel<1>(relaunder(X), l, ch + 1, a.in[13], keep); }
                if (cg_ == 3) { __syncthreads(); p0_experts(relaunder(X), a, l); __syncthreads(); }
            }
#endif
#if MK_EN & 8
            else if (sp == 3) {
                FRESH();
                OrderMerge So; So.so.init(T, D, X.G, X.bid);
                pg8::Gemm g{(const bf16*)(a.ws + WS_YH), (const bf16*)(a.ws + WS_WUH) + (size_t)l * 2 * D * C, 2 * T, 2 * D, C};
                EpiMerge2 Ep{(const bf16*)(a.ws + WS_GH), (const bf16*)(a.ws + WS_GA), (bf16*)(a.ws + WS_T1), (bf16*)(a.ws + WS_MG)};
                pg8::gemm_phase<EpiMerge2, OrderMerge, true, true>(X.lds, g, So, Ep, X.tid);
            }
#endif
#if MK_EN & 16
            else if (sp == 4) {
                FRESH();
                pg8::Gemm g{(const bf16*)(a.ws + WS_MG), (const bf16*)(a.ws + WS_WOUT) + (size_t)l * D * D, T, D, D};
                pg8::StaticOrder So; So.init(T, D, X.G, X.bid);
                EpiOut Ep{l == 0 ? a.in[0] : Xr, Xr};
                pg8::gemm_phase<EpiOut, pg8::StaticOrder, true, true>(X.lds, g, So, Ep, X.tid);
            }
#endif
#if MK_EN & 32
            else if (sp == 5) {
                FRESH();
                p5_norm_router(X, Xr, a.in[22] + l * D, a.in[23] + (size_t)l * D * E, a.in[24] + l * E);
            } else if (sp == 6) { FRESH(); p6_topk(X);
            } else if (sp == 7) { FRESH(); p6_gather(X);
            }
#endif
#if MK_EN & 64
            else if (sp == 8) {
                FRESH();
                pg8::Gemm g{(const bf16*)(a.ws + WS_XG), (const bf16*)(a.ws + WS_WGU) + (size_t)l * E * 2 * F * D, E * 2048, 2 * F, D};
                OrderMoE1 So{X.G, X.bid}; EpiSwiGLU Ep{(bf16*)(a.ws + WS_HB)};
                pg8::gemm_phase<EpiSwiGLU, OrderMoE1, true, true>(X.lds, g, So, Ep, X.tid);
            }
#endif
#if MK_EN & 128
            else if (sp == 9) {
                FRESH();
                pg8::Gemm g{(const bf16*)(a.ws + WS_HB), (const bf16*)(a.ws + WS_WD) + (size_t)l * E * D * F, E * 2048, D, F};
                OrderMoE2 So{X.G, X.bid}; EpiDown Ep{(bf16*)(a.ws + WS_YE), (const float*)(a.ws + WS_GATE)};
                pg8::gemm_phase<EpiDown, OrderMoE2, true, true>(X.lds, g, So, Ep, X.tid);
            }
#endif
#if MK_EN & 256
            else if (sp == 10) {
                FRESH();
                p9_combine(X, Xr, l == 0 ? a.in[1] + D : a.in[28], l == 1, a.out);
            }
#endif
        }
#ifndef MK_EXTRA_SYNC
#define MK_EXTRA_SYNC 0
#endif
        if (ph + 1 < ph_hi) { if (ph_hi > 4096) grid.sync(); else xcd_barrier(bar, wave_s); }
        for (int es = 0; es < MK_EXTRA_SYNC; ++es) xcd_barrier(bar, wave_s);
        if (MK_REP_SP != 99) { const int sp_ = ph == 0 ? -1 : (ph - 1) % PH_PER_LAYER; if (sp_ == MK_REP_SP && rep_flag == 0) { rep_flag = 1; --ph; } else rep_flag = 0; }
    }
}

static int g_grid = 0;
static bool mega_setup() {
    if (g_grid) return g_grid > 0;
    int dev = 0, cus = 0, per_cu = 0;
    if (hipGetDevice(&dev) != hipSuccess || hipDeviceGetAttribute(&cus, hipDeviceAttributeMultiprocessorCount, dev) != hipSuccess) { g_grid = -1; return false; }
    if (hipFuncSetAttribute((const void*)fwd, hipFuncAttributeMaxDynamicSharedMemorySize, LDS_BYTES) != hipSuccess) { fprintf(stderr, "hipFuncSetAttribute failed\n"); g_grid = -1; return false; }
    if (hipOccupancyMaxActiveBlocksPerMultiprocessor(&per_cu, (const void*)fwd, NTH, LDS_BYTES) != hipSuccess || per_cu < 1) { fprintf(stderr, "occupancy query failed (%d)\n", per_cu); g_grid = -1; return false; }
    g_grid = cus * 1;
    return true;
}
static void mega_launch(hipStream_t st, void* const* d_in, float* d_out, unsigned char* ws, int ph_lo, int ph_hi, int p0_mask) {
    if (!mega_setup()) return;
    Args a{};
    for (int i = 0; i < 29; ++i) a.in[i] = (const float*)d_in[i];
    a.out = d_out; a.ws = ws; a.ph_lo = ph_lo; a.ph_hi = ph_hi; a.p0_mask = p0_mask; a.pad = 0;
    if (hipMemsetAsync(ws, 0, 16384, st) != hipSuccess) { fprintf(stderr, "memset of the barrier words failed\n"); return; }
    void* args[] = {&a};
    const hipError_t e = hipLaunchCooperativeKernel((const void*)fwd, dim3(g_grid), dim3(NTH), args, LDS_BYTES, st);
    if (e != hipSuccess) fprintf(stderr, "cooperative launch failed: %s (grid %d)\n", hipGetErrorString(e), g_grid);
}
}
extern "C" void kernel_launch(void* const* d_in, const int* in_sizes, int n_in, void* d_out, int out_size, void* d_ws, size_t ws_size, hipStream_t stream) {
    if (n_in != 29 || out_size != mk::T * mk::D || ws_size < mk::WS_END) { fprintf(stderr, "kernel_launch: unexpected sizes n_in %d out %d ws %zu\n", n_in, out_size, ws_size); return; }
    mk::mega_launch(stream, d_in, (float*)d_out, (unsigned char*)d_ws, 0, mk::N_PHASES, 13);
}
```

```cpp
#include <hip/hip_runtime.h>
#include <hip/hip_cooperative_groups.h>
#include <cstdio>
#include <cstdint>
#include <cmath>
namespace tk {
constexpr int S = 4096, E = 16, CAP = 512, NT = 512;
__device__ __forceinline__ void topk_problem(const float* __restrict__ aff, int tokbase, int e, int slotbase, int* __restrict__ rows, float* __restrict__ gate, int* __restrict__ inv, int* sm, int tid) {
    const int lane = tid & 63, wid = tid >> 6;
    int* hist = sm; int* ctl = sm + 256;
    unsigned key[8];
    { const uint4 a = ((const uint4*)aff)[tid * 2], b = ((const uint4*)aff)[tid * 2 + 1];
      key[0] = a.x; key[1] = a.y; key[2] = a.z; key[3] = a.w; key[4] = b.x; key[5] = b.y; key[6] = b.z; key[7] = b.w; }
    unsigned prefix = 0u, mask = 0u; int kth = CAP;
    for (int pass = 3; pass >= 0; --pass) {
        __syncthreads();
        if (tid < 256) hist[tid] = 0;
        __syncthreads();
#pragma unroll
        for (int i = 0; i < 8; ++i) if ((key[i] & mask) == prefix) atomicAdd(&hist[(key[i] >> (8 * pass)) & 255u], 1);
        __syncthreads();
        if (tid < 64) {
            const int b0 = hist[4 * lane], b1 = hist[4 * lane + 1], b2 = hist[4 * lane + 2], b3 = hist[4 * lane + 3];
            const int tot = b0 + b1 + b2 + b3;
            int suf = tot;
#pragma unroll
            for (int o = 1; o < 64; o <<= 1) { const int v = __builtin_amdgcn_ds_bpermute(((lane + o) & 63) << 2, suf); if (lane + o < 64) suf += v; }
            const int above = suf - tot;
            if (above < kth && kth <= above + tot) {
                int cum = above, bin, k2;
                if (cum + b3 >= kth) { bin = 4 * lane + 3; k2 = kth - cum; }
                else { cum += b3; if (cum + b2 >= kth) { bin = 4 * lane + 2; k2 = kth - cum; }
                else { cum += b2; if (cum + b1 >= kth) { bin = 4 * lane + 1; k2 = kth - cum; }
                else { cum += b1; bin = 4 * lane; k2 = kth - cum; } } }
                ctl[0] = bin; ctl[1] = k2;
            }
        }
        __syncthreads();
        prefix |= ((unsigned)ctl[0]) << (8 * pass); mask |= 0xFFu << (8 * pass); kth = ctl[1];
    }
    const unsigned thr = prefix; const int need_eq = kth; const int n_gt = CAP - need_eq;
    int cg = 0, ce = 0;
#pragma unroll
    for (int i = 0; i < 8; ++i) { cg += key[i] > thr; ce += key[i] == thr; }
    int sg = cg, se = ce;
#pragma unroll
    for (int o = 1; o < 64; o <<= 1) { const int a = __builtin_amdgcn_ds_bpermute(((lane - o) & 63) << 2, sg), b = __builtin_amdgcn_ds_bpermute(((lane - o) & 63) << 2, se); if (lane >= o) { sg += a; se += b; } }
    __syncthreads();
    if (lane == 63) { ctl[8 + wid] = sg; ctl[16 + wid] = se; }
    __syncthreads();
    int og = sg - cg, oe = se - ce;
    for (int w = 0; w < wid; ++w) { og += ctl[8 + w]; oe += ctl[16 + w]; }
#pragma unroll
    for (int i = 0; i < 8; ++i) {
        const int idx = tid * 8 + i; int slot = -1;
        if (key[i] > thr) slot = og++;
        else if (key[i] == thr) { if (oe < need_eq) slot = n_gt + oe; ++oe; }
        if (slot >= 0) { rows[slot] = tokbase + idx; gate[slot] = __uint_as_float(key[i]); }
        inv[(size_t)(tokbase + idx) * E + e] = slot >= 0 ? slotbase + slot : -1;
    }
    __syncthreads();
}
}
namespace pg8 {
#define PG8_LAS __attribute__((address_space(3)))
typedef unsigned short bf16_t;
typedef short bf16x8 __attribute__((ext_vector_type(8)));
typedef float f32x4 __attribute__((ext_vector_type(4)));
typedef unsigned u32x4 __attribute__((ext_vector_type(4)));
constexpr int BM = 256, BK = 64, HALF = 128, HTB = HALF * BK * 2  , STAGE_BYTES = 8 * HTB, NXCD = 8, WGM = 8;

__host__ __device__ __forceinline__ int lds_byte(int r, int c) { const int st = (r >> 4) * 2 + (c >> 5), rr = r & 15, cc = c & 31, ob = rr * 64 + cc * 2; return st * 1024 + (ob ^ (((ob >> 9) & 1) << 5)); }
__host__ __device__ __forceinline__ void stage_rc(int b, int& R, int& C) { const int st = b / 1024, sb = b % 1024, swz = sb ^ (((sb >> 9) & 1) << 5); R = (st >> 1) * 16 + swz / 64; C = (st & 1) * 32 + (swz % 64) / 2; }
__host__ __device__ __forceinline__ int perm32(int rho) { const int n = rho >> 4, i = rho & 15; return 8 * (i >> 2) + 4 * n + (i & 3); }

struct Unit { int pm, pn, pb, pa; };
struct Gemm { const bf16_t* A; const bf16_t* Bt; int M, N, K; };

struct StaticOrder {
    int nM, nN, nwg, G, c;
    __host__ __device__ void init(int M, int N, int G_, int c_) { nM = M / BM; nN = N / BM; nwg = nM * nN; G = G_; c = c_; }
    __host__ __device__ bool next(int i, Unit& u) const {
        const long L = (long)i * G + c; if (L >= nwg) return false;
        int wgid = (int)L; { const int q = nwg / NXCD, r = nwg % NXCD, xcd = wgid % NXCD, off = wgid / NXCD; wgid = (xcd < r ? xcd * (q + 1) : r * (q + 1) + (xcd - r) * q) + off; }
        const int nig = WGM * nN, gid = wgid / nig, fm = gid * WGM, gsz = (nM - fm) < WGM ? (nM - fm) : WGM;
        u.pm = fm + ((wgid % nig) % gsz); u.pn = (wgid % nig) / gsz; u.pb = u.pn; u.pa = u.pm; return true;
    }
    __device__ __forceinline__ void a_ready(const Unit&) const {}
    __device__ __forceinline__ void done(const Unit&) const {}
};

template <class Epi, class Sched, bool ALIGN_EPI = false, bool SP2 = false>
__device__ __forceinline__ void gemm_phase(PG8_LAS unsigned char* lds, const Gemm g, const Sched& S, const Epi& E, int tid) {
    asm volatile("" : "+v"(tid));
    const int wid = __builtin_amdgcn_readfirstlane(tid >> 6), lane = tid & 63, wr = wid >> 2, wc = wid & 3, fr = lane & 15, fq = lane >> 4;
    const int K = g.K, nt = K / BK;
    unsigned voffA[2], voffB[2];
#pragma unroll
    for (int i = 0; i < 2; ++i) { int R, C; stage_rc(tid * 16 + i * 8192, R, C); const int Rb = Epi::PERM ? ((R & ~31) + perm32(R & 31)) : R;
        voffA[i] = (unsigned)(R * K + C) * 2u; voffB[i] = (unsigned)(Rb * K + C) * 2u; }
    const size_t kstep = (size_t)(BK * 2);
    const size_t hstep = (size_t)HALF * K * 2;
    const size_t tstep = 2 * hstep;
    const unsigned ldsw = (unsigned)wid * 1024u;
    const int aoff = lds_byte(wr * 64 + fr, fq * 8), boff = lds_byte(wc * 32 + fr, fq * 8);
#define PG8_SA(b, h) (((b) * 2 + (h)) * HTB)
#define PG8_SB(b, h) ((4 + (b) * 2 + (h)) * HTB)
#define PG8_STAGE(bufoff, gbase, voff) do { _Pragma("unroll") for (int _i = 0; _i < 2; ++_i) \
        __builtin_amdgcn_global_load_lds((const unsigned*)((const char*)(gbase) + (voff)[_i]), (PG8_LAS unsigned*)(lds + (bufoff) + ldsw + _i * 8192), 16, 0, 0); } while (0)
#define PG8_LDA(dst, b, h) do { _Pragma("unroll") for (int m = 0; m < 4; ++m) _Pragma("unroll") for (int k = 0; k < 2; ++k) dst[m][k] = *(const PG8_LAS bf16x8*)(lds + PG8_SA(b, h) + aoff + m * 2048 + k * 1024); } while (0)
#define PG8_LDB(dst, b, h) do { _Pragma("unroll") for (int n = 0; n < 2; ++n) _Pragma("unroll") for (int k = 0; k < 2; ++k) dst[n][k] = *(const PG8_LAS bf16x8*)(lds + PG8_SB(b, h) + boff + n * 2048 + k * 1024); } while (0)
#define PG8_MMA(ai, bj, At, Bt) do { __builtin_amdgcn_s_setprio(1); _Pragma("unroll") for (int m = 0; m < 4; ++m) _Pragma("unroll") for (int n = 0; n < 2; ++n) _Pragma("unroll") for (int k = 0; k < 2; ++k) \
        acc[ai][bj][m][n] = __builtin_amdgcn_mfma_f32_16x16x32_bf16(Bt[n][k], At[m][k], acc[ai][bj][m][n], 0, 0, 0); __builtin_amdgcn_s_setprio(0); } while (0)
#define PG8_WAIT_V(n) asm volatile("s_waitcnt vmcnt(" #n ")" ::: "memory")
#define PG8_WAIT_L(n) asm volatile("s_waitcnt lgkmcnt(" #n ")" ::: "memory")
#define PG8_BAR __builtin_amdgcn_s_barrier()
#define PG8_SCHED __builtin_amdgcn_sched_barrier(0)
    Unit cur, nxt; int ui = 0;
    if (!S.next(0, cur)) return;
    f32x4 acc[2][2][4][2];
#pragma unroll
    for (int a = 0; a < 2; ++a)
#pragma unroll
        for (int b = 0; b < 2; ++b)
#pragma unroll
            for (int m = 0; m < 4; ++m)
#pragma unroll
                for (int n = 0; n < 2; ++n) acc[a][b][m][n] = (f32x4){0.f, 0.f, 0.f, 0.f};
    bf16x8 At[4][2], B0[2][2], B1[2][2];
    const char* cA = (const char*)g.A + (size_t)cur.pa * tstep; const char* cB = (const char*)g.Bt + (size_t)cur.pb * tstep;
    S.a_ready(cur);
    if constexpr (SP2) {
        PG8_STAGE(PG8_SB(0, 0), cB, voffB); PG8_STAGE(PG8_SB(0, 1), cB + hstep, voffB); PG8_STAGE(PG8_SA(0, 0), cA, voffA); PG8_STAGE(PG8_SA(0, 1), cA + hstep, voffA);
        if (wr == 1) PG8_BAR;
        PG8_WAIT_V(2); PG8_BAR;
        PG8_STAGE(PG8_SB(1, 0), cB + kstep, voffB); PG8_STAGE(PG8_SA(1, 0), cA + kstep, voffA); PG8_STAGE(PG8_SB(1, 1), cB + hstep + kstep, voffB);
        PG8_WAIT_V(6); PG8_BAR;
    } else {
        PG8_STAGE(PG8_SB(0, 0), cB, voffB); PG8_STAGE(PG8_SA(0, 0), cA, voffA); PG8_STAGE(PG8_SB(0, 1), cB + hstep, voffB); PG8_STAGE(PG8_SA(0, 1), cA + hstep, voffA);
        if (wr == 1) PG8_BAR;
        PG8_WAIT_V(4); PG8_BAR;
        PG8_STAGE(PG8_SB(1, 0), cB + kstep, voffB); PG8_STAGE(PG8_SA(1, 0), cA + kstep, voffA); PG8_STAGE(PG8_SB(1, 1), cB + hstep + kstep, voffB);
        PG8_WAIT_V(6); PG8_BAR;
    }
    for (;;) {
        const bool has_next = S.next(ui + 1, nxt);
        const char* nA = has_next ? (const char*)g.A + (size_t)nxt.pa * tstep : cA; const char* nB = has_next ? (const char*)g.Bt + (size_t)nxt.pb * tstep : cB;
        for (int t = 0; t < nt; t += 2) {
            const bool last = (t == nt - 2);
            const char* a1 = cA + (size_t)(t + 1) * kstep;
            const char* a2 = last ? nA : cA + (size_t)(t + 2) * kstep; const char* b2 = last ? nB : cB + (size_t)(t + 2) * kstep;
            const char* a3 = a2 + kstep; const char* b3 = b2 + kstep;
            if (last && has_next) S.a_ready(nxt);
            if constexpr (SP2) {
            PG8_LDB(B0, 0, 0); PG8_LDB(B1, 0, 1); PG8_SCHED; PG8_LDA(At, 0, 0); PG8_STAGE(PG8_SA(1, 1), a1 + hstep, voffA);
            PG8_WAIT_V(8); PG8_WAIT_L(0); PG8_BAR; PG8_MMA(0, 0, At, B0); PG8_MMA(0, 1, At, B1); PG8_BAR; PG8_SCHED;
            PG8_LDA(At, 0, 1); PG8_STAGE(PG8_SB(0, 0), b2, voffB); PG8_STAGE(PG8_SB(0, 1), b2 + hstep, voffB); PG8_STAGE(PG8_SA(0, 0), a2, voffA);
            PG8_WAIT_V(8); PG8_WAIT_L(0); PG8_BAR; PG8_MMA(1, 0, At, B0); PG8_MMA(1, 1, At, B1); PG8_BAR; PG8_SCHED;
            PG8_LDB(B0, 1, 0); PG8_LDB(B1, 1, 1); PG8_SCHED; PG8_LDA(At, 1, 0); PG8_STAGE(PG8_SA(0, 1), a2 + hstep, voffA);
            PG8_WAIT_V(8); PG8_WAIT_L(0); PG8_BAR; PG8_MMA(0, 0, At, B0); PG8_MMA(0, 1, At, B1); PG8_BAR; PG8_SCHED;
            PG8_LDA(At, 1, 1); PG8_STAGE(PG8_SB(1, 0), b3, voffB); PG8_STAGE(PG8_SB(1, 1), b3 + hstep, voffB); PG8_STAGE(PG8_SA(1, 0), a3, voffA);
            PG8_WAIT_V(8); PG8_WAIT_L(0); PG8_BAR; PG8_MMA(1, 0, At, B0); PG8_MMA(1, 1, At, B1); PG8_BAR; PG8_SCHED;
            } else {
            PG8_LDB(B0, 0, 0); PG8_SCHED; PG8_LDA(At, 0, 0); PG8_STAGE(PG8_SA(1, 1), a1 + hstep, voffA);
            PG8_WAIT_L(8); PG8_BAR; PG8_WAIT_L(0); PG8_MMA(0, 0, At, B0); PG8_BAR; PG8_SCHED;
            PG8_LDB(B1, 0, 1); PG8_STAGE(PG8_SB(0, 0), b2, voffB);
            PG8_BAR; PG8_WAIT_L(0); PG8_MMA(0, 1, At, B1); PG8_BAR;
            PG8_LDA(At, 0, 1); PG8_STAGE(PG8_SA(0, 0), a2, voffA);
            PG8_BAR; PG8_WAIT_L(0); PG8_MMA(1, 0, At, B0); PG8_BAR; PG8_SCHED;
            PG8_STAGE(PG8_SB(0, 1), b2 + hstep, voffB);
            PG8_WAIT_V(6); PG8_BAR; PG8_MMA(1, 1, At, B1); PG8_BAR;
            PG8_LDB(B0, 1, 0); PG8_SCHED; PG8_LDA(At, 1, 0); PG8_STAGE(PG8_SA(0, 1), a2 + hstep, voffA);
            PG8_WAIT_L(8); PG8_BAR; PG8_WAIT_L(0); PG8_MMA(0, 0, At, B0); PG8_BAR; PG8_SCHED;
            PG8_LDB(B1, 1, 1); PG8_STAGE(PG8_SB(1, 0), b3, voffB);
            PG8_BAR; PG8_WAIT_L(0); PG8_MMA(0, 1, At, B1); PG8_BAR;
            PG8_LDA(At, 1, 1); PG8_STAGE(PG8_SA(1, 0), a3, voffA);
            PG8_BAR; PG8_WAIT_L(0); PG8_MMA(1, 0, At, B0); PG8_BAR; PG8_SCHED;
            PG8_STAGE(PG8_SB(1, 1), b3 + hstep, voffB);
            PG8_WAIT_V(6); PG8_BAR; PG8_MMA(1, 1, At, B1); PG8_BAR;
            }
        }
        if constexpr (ALIGN_EPI) { if (wr == 0) PG8_BAR; }
        if constexpr (!Epi::AFTER_DRAIN) { E(acc, cur, wr, wc, fr, fq); S.done(cur); }
        if (!has_next) break;
#pragma unroll
        for (int a = 0; a < 2; ++a)
#pragma unroll
            for (int b = 0; b < 2; ++b)
#pragma unroll
                for (int m = 0; m < 4; ++m)
#pragma unroll
                    for (int n = 0; n < 2; ++n) acc[a][b][m][n] = (f32x4){0.f, 0.f, 0.f, 0.f};
        cur = nxt; cA = nA; cB = nB; ++ui;
        if constexpr (ALIGN_EPI) { if (wr == 1) PG8_BAR; }
    }
    PG8_WAIT_V(0);
    if constexpr (!ALIGN_EPI) { if (wr == 0) PG8_BAR; }
    PG8_BAR;
    if constexpr (Epi::AFTER_DRAIN) { E.fused(acc, cur, wr, wc, fr, fq, lds, wid, lane); S.done(cur); }
#undef PG8_SA
#undef PG8_SB
#undef PG8_STAGE
#undef PG8_LDA
#undef PG8_LDB
#undef PG8_MMA
#undef PG8_WAIT_V
#undef PG8_WAIT_L
#undef PG8_BAR
#undef PG8_SCHED
}
}

namespace mk {
constexpr int D = 1024, B = 4, S = 4096, T = B * S, C = 512, INW = 5120, E = 16, CAP = 512, F = 2048, NTH = 512, NWAVES = 8;
typedef unsigned short bf16;
#define LAS __attribute__((address_space(3)))
typedef unsigned v4u __attribute__((ext_vector_type(4)));
typedef unsigned v2u __attribute__((ext_vector_type(2)));
typedef float f32x4 __attribute__((ext_vector_type(4)));
typedef short bf16x8 __attribute__((ext_vector_type(8)));
typedef float f32x16 __attribute__((ext_vector_type(16)));
typedef short s16x4 __attribute__((ext_vector_type(4)));

constexpr size_t MiB = 1u << 20;
constexpr size_t WS_WIN = 2 * MiB;
constexpr size_t WS_WUH = 22 * MiB;
constexpr size_t WS_WUA = 23 * MiB;
constexpr size_t WS_WOUT = 26 * MiB;
constexpr size_t WS_BINP = 30 * MiB;
constexpr size_t WS_ROPE = 31 * MiB;
constexpr size_t WS_AFFT = 32 * MiB;
constexpr size_t WS_INV = 33 * MiB;
constexpr size_t WS_ROWS = 34 * MiB;
constexpr size_t WS_GATE = 34 * MiB + 512 * 1024;
constexpr size_t WS_FILT = 36 * MiB;
constexpr size_t WS_X = 68 * MiB;
constexpr size_t WS_XN = 132 * MiB;
constexpr size_t WS_SH = 164 * MiB;
constexpr size_t WS_U = WS_SH;
constexpr size_t WS_UCT = WS_SH + 48 * MiB;
constexpr size_t WS_Q = WS_SH + 96 * MiB;
constexpr size_t WS_K = WS_SH + 112 * MiB;
constexpr size_t WS_V = WS_SH + 128 * MiB;
constexpr size_t WS_GH = WS_SH + 144 * MiB;
constexpr size_t WS_GA = WS_SH + 176 * MiB;
constexpr size_t WS_YH = WS_SH + 208 * MiB;
constexpr size_t WS_YA = WS_SH + 224 * MiB;
constexpr size_t WS_T1 = WS_U;
constexpr size_t WS_MG = WS_UCT;
constexpr size_t WS_XG = WS_SH;
constexpr size_t WS_HB = WS_SH + 64 * MiB;
constexpr size_t WS_YE = WS_SH + 192 * MiB;
constexpr size_t WS_WGU = 420 * MiB;
constexpr size_t WS_WD = 676 * MiB;
constexpr size_t WS_END = 804 * MiB;

constexpr int LDS_BYTES = 155648;
constexpr float QSCALE = 0.125f * 1.4426950408889634f;

struct Args {
    const float* in[29]; float* out; unsigned char* ws; int ph_lo, ph_hi; int p0_mask, pad;
};

__device__ __forceinline__ unsigned f2bf(float f) { unsigned u = __builtin_bit_cast(unsigned, f); return (u + 0x7fffu + ((u >> 16) & 1u)) >> 16; }
__device__ __forceinline__ unsigned pk2(float lo, float hi) { return f2bf(lo) | (f2bf(hi) << 16); }
__device__ __forceinline__ float bf2f(unsigned h) { return __builtin_bit_cast(float, h << 16); }
__device__ __forceinline__ float bflo(unsigned w) { return __builtin_bit_cast(float, w << 16); }
__device__ __forceinline__ float bfhi(unsigned w) { return __builtin_bit_cast(float, w & 0xffff0000u); }
template <int O> __device__ __forceinline__ float xor_f(float v) { return __builtin_bit_cast(float, __builtin_amdgcn_ds_swizzle(__builtin_bit_cast(int, v), (O << 10) | 0x1f)); }
__device__ __forceinline__ float wave_sum(float v) { v += xor_f<1>(v); v += xor_f<2>(v); v += xor_f<4>(v); v += xor_f<8>(v); v += xor_f<16>(v);
    const int b = __builtin_bit_cast(int, v); return __builtin_bit_cast(float, __builtin_amdgcn_readlane(b, 0)) + __builtin_bit_cast(float, __builtin_amdgcn_readlane(b, 32)); }

__device__ __forceinline__ float sigm(float x) { return 1.f / (1.f + __expf(-x)); }

struct Ctx { int tid, lane, wave, gw, ngw, vcu, G, bid, wave_s; LAS unsigned char* lds; unsigned char* ws; };

__device__ __forceinline__ int fresh_tid(int wave_s) { int l; asm volatile("v_mbcnt_lo_u32_b32 %0, -1, 0\n\tv_mbcnt_hi_u32_b32 %0, -1, %0" : "=v"(l)); return (wave_s << 6) | l; }
__device__ __forceinline__ Ctx relaunder(const Ctx& X) { Ctx Y = X; const int t = fresh_tid(X.wave_s); Y.tid = t; Y.lane = t & 63; return Y; }

template <int MAP> __device__ __forceinline__ int rowmap(int n) {
    if (MAP == 1) {
        if (n < 1536 || n >= 2560) return n;
        const int hb = (n - 1536) & ~63, d = (n - 1536) & 63, i = (d & 31) >> 2, j = d & 3;
        return 1536 + hb + 8 * i + ((d >> 5) << 2) + j;
    }
    if (MAP == 2) return ((n >> 7) << 8) + (n & 127);
    if (MAP == 3) return ((n >> 7) << 8) + 128 + (n & 127);
    return n;
}
__device__ __forceinline__ unsigned cvtpk_(float lo, float hi) { unsigned r; asm volatile("v_cvt_pk_bf16_f32 %0, %1, %2" : "=v"(r) : "v"(lo), "v"(hi)); return r; }
struct TrItem { const float* src; bf16* dst; };
template <int MAP> __device__ __forceinline__ void p0_transpose(const Ctx& X, const float* W, int K, int N, bf16* WT, int nmat, size_t sstride, size_t dstride) {
    LAS float* scr = (LAS float*)(X.lds + X.wave * 16640);
    const int nblk = N / 64, per = (K / 64) * nblk, tot = per * nmat, lane = X.lane;
    const int nq = lane & 15, kr = lane >> 4, c = lane & 7, nsub = lane >> 3;
    f32x4 v[16];
    int it = X.gw;
#define TR_SRC(it_) (W + (size_t)((it_) / per) * sstride + (size_t)(64 * (((it_) % per) / nblk) + kr) * N + 64 * (((it_) % per) % nblk) + 4 * nq)
    if (it < tot) { const float* s = TR_SRC(it);
#pragma unroll
        for (int i = 0; i < 16; ++i) v[i] = __builtin_nontemporal_load((const f32x4*)(s + (size_t)(4 * i) * N)); }
    while (it < tot) {
#pragma unroll
        for (int i = 0; i < 16; ++i) { LAS float* d = scr + (4 * i + kr) * 65 + 4 * nq; d[0] = v[i][0]; d[1] = v[i][1]; d[2] = v[i][2]; d[3] = v[i][3]; }
        const int nit = it + X.ngw;
        if (nit < tot) { const float* s = TR_SRC(nit);
#pragma unroll
            for (int i = 0; i < 16; ++i) v[i] = __builtin_nontemporal_load((const f32x4*)(s + (size_t)(4 * i) * N)); }
        asm volatile("s_waitcnt lgkmcnt(0)" ::: "memory");
        const int m = it / per, r = it - m * per, k0 = 64 * (r / nblk), n0 = 64 * (r % nblk);
        bf16* dst = WT + (size_t)m * dstride;
#pragma unroll
        for (int j = 0; j < 8; ++j) { const int n = nsub + 8 * j; const LAS float* s = scr + (8 * c) * 65 + n;
            v4u o; o.x = cvtpk_(s[0 * 65], s[1 * 65]); o.y = cvtpk_(s[2 * 65], s[3 * 65]); o.z = cvtpk_(s[4 * 65], s[5 * 65]); o.w = cvtpk_(s[6 * 65], s[7 * 65]);
            __builtin_nontemporal_store(o, (v4u*)(dst + (size_t)rowmap<MAP>(n0 + n) * K + k0 + 8 * c)); }
        asm volatile("s_waitcnt lgkmcnt(0)" ::: "memory");
        it = nit;
    }
#undef TR_SRC
}
struct Row8 { f32x4 a[2][2]; };
__device__ __forceinline__ void row8_load(Row8& r, const float* p, int lane) {
#pragma unroll
    for (int j = 0; j < 2; ++j) { const f32x4* q = (const f32x4*)p + 2 * (lane + 64 * j); r.a[j][0] = q[0]; r.a[j][1] = q[1]; }
}
__device__ __forceinline__ float row8_sumsq(const Row8& r) {
    float s = 0.f;
#pragma unroll
    for (int j = 0; j < 2; ++j)
#pragma unroll
        for (int h = 0; h < 2; ++h) s += (r.a[j][h].x * r.a[j][h].x + r.a[j][h].y * r.a[j][h].y) + (r.a[j][h].z * r.a[j][h].z + r.a[j][h].w * r.a[j][h].w);
    return s;
}
__device__ __forceinline__ void rms_row_to_bf16(const float* __restrict__ xrow, const float* __restrict__ g, bf16* __restrict__ orow, int lane) {
    const f32x4* xr = (const f32x4*)xrow + lane; f32x4 v[4]; float s = 0.f;
#pragma unroll
    for (int j = 0; j < 4; ++j) { v[j] = xr[64 * j]; s += (v[j].x * v[j].x + v[j].y * v[j].y) + (v[j].z * v[j].z + v[j].w * v[j].w); }
    const float r = rsqrtf(wave_sum(s) * (1.f / D) + 1e-6f);
    v2u* o8 = (v2u*)orow + lane;
#pragma unroll
    for (int j = 0; j < 4; ++j) { const f32x4 gg = ((const f32x4*)g)[lane + 64 * j]; v2u w; w.x = pk2(v[j].x * r * gg.x, v[j].y * r * gg.y); w.y = pk2(v[j].z * r * gg.z, v[j].w * r * gg.w); o8[64 * j] = w; }
}
__device__ __forceinline__ void p0_filters(const Ctx& X, const Args& a) {
    LAS float* z = (LAS float*)X.lds;
    LAS float* h1 = z + 32 * 36;
    LAS float* h2T = h1 + 32 * 64;
    LAS float* w1s = h2T + 64 * 32;
    LAS float* w2s = w1s + 33 * 64;
    bf16* FILT = (bf16*)(X.ws + WS_FILT);
    const int tid = X.tid, j = tid & 63, tq = tid >> 6;
    const float min_decay = logf(1e-2f) / 0.3f, max_decay = logf(1e-2f) / 1.5f;
    for (int it = X.bid; it < 2 * (S / 32); it += X.G) {
        const int l = it / (S / 32), t0 = (it % (S / 32)) * 32;
        const float *w1 = a.in[6] + l * 33 * 64, *b1 = a.in[7] + l * 64, *f1 = a.in[8] + l * 64, *w2 = a.in[9] + l * 64 * 64, *b2 = a.in[10] + l * 64, *f2 = a.in[11] + l * 64, *w3 = a.in[12] + (size_t)l * 64 * 2048;
        __syncthreads();
        for (int e = tid; e < 33 * 64; e += NTH) w1s[e] = w1[e];
        for (int e = tid; e < 64 * 64; e += NTH) w2s[e] = w2[e];
        for (int e = tid; e < 32 * 33; e += NTH) { const int tt = e / 33, jj0 = e - tt * 33, t = t0 + tt; float v;
            if (jj0 == 0) v = (float)t / (float)(S - 1);
            else { const int jj = (jj0 - 1) & 15; const float w = 2.0f * 3.14159265358979323846f * (float)t / (float)S; const float fr = 1e-4f + (float)jj * ((15.0f - 1e-4f) / 15.0f); const float ang = w * fr; v = (jj0 <= 16) ? cosf(ang) : -sinf(ang); }
            z[tt * 36 + jj0] = v; }
        const float bb1 = b1[j], ff1 = f1[j], bb2 = b2[j], ff2 = f2[j];
        __syncthreads();
        { float acc[4] = {bb1, bb1, bb1, bb1};
          for (int i = 0; i < 33; ++i) { const float w = w1s[i * 64 + j];
#pragma unroll
              for (int k = 0; k < 4; ++k) acc[k] += z[(tq + 8 * k) * 36 + i] * w; }
#pragma unroll
          for (int k = 0; k < 4; ++k) h1[(tq + 8 * k) * 64 + j] = sinf(ff1 * acc[k]); }
        __syncthreads();
        { float acc[4] = {bb2, bb2, bb2, bb2};
          for (int i = 0; i < 64; ++i) { const float w = w2s[i * 64 + j];
#pragma unroll
              for (int k = 0; k < 4; ++k) acc[k] += h1[(tq + 8 * k) * 64 + i] * w; }
#pragma unroll
          for (int k = 0; k < 4; ++k) h2T[j * 32 + tq + 8 * k] = sinf(ff2 * acc[k]); }
        __syncthreads();
        { const int n0 = 4 * tid; f32x4 acc[32];
#pragma unroll
            for (int q = 0; q < 32; ++q) acc[q] = (f32x4){0.f, 0.f, 0.f, 0.f};
#pragma unroll 1
            for (int i0 = 0; i0 < 64; i0 += 16) { f32x4 w[16];
#pragma unroll
                for (int u = 0; u < 16; ++u) w[u] = *(const f32x4*)(w3 + (i0 + u) * 2048 + n0);
#pragma unroll
                for (int u = 0; u < 16; ++u) {
#pragma unroll
                    for (int g = 0; g < 8; ++g) { const f32x4 hh = *(const LAS f32x4*)(h2T + (i0 + u) * 32 + 4 * g); acc[4 * g] += w[u] * hh.x; acc[4 * g + 1] += w[u] * hh.y; acc[4 * g + 2] += w[u] * hh.z; acc[4 * g + 3] += w[u] * hh.w; } } }
            const int c0 = n0 & 511, od = n0 >> 9;
#pragma unroll
            for (int e = 0; e < 4; ++e) { const float delta = fabsf(min_decay + (float)(c0 + e) * ((max_decay - min_decay) / 511.0f));
#pragma unroll
                for (int g = 0; g < 4; ++g) { float o8[8];
#pragma unroll
                    for (int q = 0; q < 8; ++q) o8[q] = acc[8 * g + q][e] * expf(-((float)(t0 + 8 * g + q) / (float)(S - 1)) * delta);
                    v4u o; o.x = pk2(o8[0], o8[1]); o.y = pk2(o8[2], o8[3]); o.z = pk2(o8[4], o8[5]); o.w = pk2(o8[6], o8[7]);
                    *(v4u*)(FILT + (((size_t)l * 4 + od) * C + c0 + e) * S + t0 + 8 * g) = o; } } }
    }
    __syncthreads();
}
__device__ __forceinline__ void p0_experts(const Ctx& X, const Args& a, int l) {
    bf16* wgu = (bf16*)(X.ws + WS_WGU) + (size_t)l * E * 2 * F * D; bf16* wd = (bf16*)(X.ws + WS_WD) + (size_t)l * E * F * D;
    p0_transpose<2>(X, a.in[25] + (size_t)l * E * D * F, D, F, wgu, E, (size_t)D * F, (size_t)2 * F * D);
    p0_transpose<3>(X, a.in[26] + (size_t)l * E * D * F, D, F, wgu, E, (size_t)D * F, (size_t)2 * F * D);
    p0_transpose<0>(X, a.in[27] + (size_t)l * E * D * F, F, D, wd, E, (size_t)F * D, (size_t)F * D);
}
#ifndef MK_P0_DUP
#define MK_P0_DUP 0
#endif
__device__ __forceinline__ void p0_prologue(const Ctx& X, const Args& a) {
    const int m = a.p0_mask;
    for (int dup_ = 0; dup_ < ((MK_P0_DUP & 1) ? 2 : 1); ++dup_)
    if (m & 1) {
        p0_transpose<1>(X, a.in[2], D, INW, (bf16*)(X.ws + WS_WIN), 2, (size_t)D * INW, (size_t)D * INW);
        p0_transpose<0>(X, a.in[19], C, D, (bf16*)(X.ws + WS_WUH), 2, (size_t)C * D, (size_t)2 * C * D);
        p0_transpose<0>(X, a.in[20], C, D, (bf16*)(X.ws + WS_WUA), 2, (size_t)C * D, (size_t)2 * C * D);
        p0_transpose<0>(X, a.in[21], D, D, (bf16*)(X.ws + WS_WOUT), 2, (size_t)D * D, (size_t)D * D);
        float* binp = (float*)(X.ws + WS_BINP);
        for (int i = X.gw * 64 + X.lane; i < 2 * INW; i += X.ngw * 64) { const int l = i / INW, n = i - l * INW; binp[l * INW + rowmap<1>(n)] = a.in[3][i]; }
        float* rope = (float*)(X.ws + WS_ROPE);
        for (int i = X.gw * 64 + X.lane; i < S * 32; i += X.ngw * 64) { const int pos = i >> 5, j = i & 31; const float inv = powf(10000.0f, -(float)j * 2.0f / 64.0f); float sn, cs; sincosf((float)pos * inv, &sn, &cs); rope[2 * i] = cs; rope[2 * i + 1] = sn; }
    }
    if (m & 2) { p0_experts(X, a, 0); p0_experts(X, a, 1); }
    for (int dup_ = 0; dup_ < ((MK_P0_DUP & 4) ? 2 : 1); ++dup_)
    if (m & 4) p0_filters(X, a);
    for (int dup_ = 0; dup_ < ((MK_P0_DUP & 8) ? 2 : 1); ++dup_)
    if (m & 8) {
        bf16* XN = (bf16*)(X.ws + WS_XN); const int lane = X.lane; Row8 gg; row8_load(gg, a.in[1], lane);
        int r = X.gw; Row8 cur; if (r < T) row8_load(cur, a.in[0] + (size_t)r * D, lane);
        while (r < T) { const int nr = r + X.ngw; Row8 nxt; if (nr < T) row8_load(nxt, a.in[0] + (size_t)nr * D, lane);
            const float rs = rsqrtf(wave_sum(row8_sumsq(cur)) * (1.f / D) + 1e-6f);
#pragma unroll
            for (int j = 0; j < 2; ++j) { const f32x4 y0 = cur.a[j][0] * gg.a[j][0] * rs, y1 = cur.a[j][1] * gg.a[j][1] * rs;
                v4u w; w.x = pk2(y0.x, y0.y); w.y = pk2(y0.z, y0.w); w.z = pk2(y1.x, y1.y); w.w = pk2(y1.z, y1.w); ((v4u*)(XN + (size_t)r * D))[lane + 64 * j] = w; }
            cur = nxt; r = nr; }
    }
}
}
namespace mk {
using pg8::Unit;
#ifndef MK_SIMPLE_ORDER
#define MK_SIMPLE_ORDER 0
#endif
__device__ __forceinline__ unsigned cvtpk(float lo, float hi) { unsigned r; asm volatile("v_cvt_pk_bf16_f32 %0, %1, %2" : "=v"(r) : "v"(lo), "v"(hi)); return r; }
__device__ __forceinline__ v4u pack8(f32x4 a, f32x4 b) { v4u w; w.x = cvtpk(a[0], a[1]); w.y = cvtpk(a[2], a[3]); w.z = cvtpk(b[0], b[1]); w.w = cvtpk(b[2], b[3]); return w; }
__device__ __forceinline__ void unpack8(v4u w, f32x4& a, f32x4& b) { a = (f32x4){bflo(w.x), bfhi(w.x), bflo(w.y), bfhi(w.y)}; b = (f32x4){bflo(w.z), bfhi(w.z), bflo(w.w), bfhi(w.w)}; }
__device__ __forceinline__ float fsig(float x) { return __builtin_amdgcn_rcpf(1.f + __expf(-x)); }

struct EpiWin {
    static constexpr bool PERM = true, AFTER_DRAIN = false;
    unsigned char* ws; const float* bias; const float* rope;
    __device__ __forceinline__ void operator()(const f32x4 (&acc)[2][2][4][2], const Unit& u, int wr, int wc, int fr, int fq) const {
        const int colt = u.pn * 256, row0 = u.pm * 256 + wr * 64 + fr, cin = wc * 32 + 8 * fq;
        bf16* base; int ldc, col0, mode; float sc = 1.f;
        if (colt < 1536) { base = (bf16*)(ws + WS_U); ldc = 1536; col0 = colt; mode = 0; }
        else if (colt < 2048) { base = (bf16*)(ws + WS_Q); ldc = 512; col0 = colt - 1536; mode = 1; sc = QSCALE; }
        else if (colt < 2560) { base = (bf16*)(ws + WS_K); ldc = 512; col0 = colt - 2048; mode = 1; }
        else if (colt < 3072) { base = (bf16*)(ws + WS_V); ldc = 512; col0 = colt - 2560; mode = 0; }
        else if (colt < 4096) { base = (bf16*)(ws + WS_GH); ldc = 1024; col0 = colt - 3072; mode = 2; }
        else { base = (bf16*)(ws + WS_GA); ldc = 1024; col0 = colt - 4096; mode = 2; }
        f32x4 bv[2][2];
#pragma unroll
        for (int bj = 0; bj < 2; ++bj)
#pragma unroll
            for (int n = 0; n < 2; ++n) bv[bj][n] = *(const f32x4*)(bias + colt + bj * 128 + cin + 4 * n);
#pragma unroll
        for (int ai = 0; ai < 2; ++ai)
#pragma unroll
            for (int m = 0; m < 4; ++m) {
                const int row = row0 + ai * 128 + m * 16; bf16* rowp = base + (size_t)row * ldc + col0 + cin;
#pragma unroll
                for (int bj = 0; bj < 2; ++bj) {
                    f32x4 v0 = acc[ai][bj][m][0] + bv[bj][0], v1 = acc[ai][bj][m][1] + bv[bj][1];
                    if (mode == 1) {
                        const int i = ((bj * 128 + cin) & 63) >> 3; const float* rp = rope + ((size_t)(row & (S - 1)) * 32 + 4 * i) * 2;
                        const f32x4 r0 = *(const f32x4*)rp, r1 = *(const f32x4*)(rp + 4);
                        const f32x4 cs = {r0[0], r0[2], r1[0], r1[2]}, sn = {r0[1], r0[3], r1[1], r1[3]};
                        const f32x4 o1 = (v0 * cs - v1 * sn) * sc, o2 = (v1 * cs + v0 * sn) * sc; v0 = o1; v1 = o2;
                    } else if (mode == 2) {
#pragma unroll
                        for (int e = 0; e < 4; ++e) { v0[e] = fsig(v0[e]); v1[e] = fsig(v1[e]); }
                    }
                    *(v4u*)(rowp + bj * 128) = pack8(v0, v1);
                }
            }
    }
};
struct EpiMerge2 {
    static constexpr bool PERM = true, AFTER_DRAIN = false;
    const bf16* GH; const bf16* GA; bf16* T1; bf16* MG;
    __device__ __forceinline__ void operator()(const f32x4 (&acc)[2][2][4][2], const Unit& u, int wr, int wc, int fr, int fq) const {
        const int row0 = u.pm * 256 + wr * 64 + fr, col0 = u.pn * 256 + wc * 32 + 8 * fq; const bool second = u.pa != u.pm; const bf16* G = second ? GA : GH;
#pragma unroll
        for (int ai = 0; ai < 2; ++ai)
#pragma unroll
            for (int m = 0; m < 4; ++m) { const size_t off = (size_t)(row0 + ai * 128 + m * 16) * D + col0;
#pragma unroll
                for (int bj = 0; bj < 2; ++bj) { f32x4 g0, g1; unpack8(*(const v4u*)(G + off + bj * 128), g0, g1);
                    f32x4 v0 = acc[ai][bj][m][0] * g0, v1 = acc[ai][bj][m][1] * g1;
                    if (second) { f32x4 t0, t1; unpack8(*(const v4u*)(T1 + off + bj * 128), t0, t1); v0 += t0; v1 += t1; *(v4u*)(MG + off + bj * 128) = pack8(v0, v1); }
                    else *(v4u*)(T1 + off + bj * 128) = pack8(v0, v1); } }
    }
};
struct OrderMerge {
    pg8::StaticOrder so;
    __device__ __forceinline__ bool next(int i, Unit& u) const { if (!so.next(i >> 1, u)) return false; if (i & 1) { u.pa = u.pm + T / 256; u.pb = u.pn + 4; } return true; }
    __device__ __forceinline__ void a_ready(const Unit&) const {}
    __device__ __forceinline__ void done(const Unit&) const {}
};
struct EpiOut {
    static constexpr bool PERM = false, AFTER_DRAIN = false;
    const float* xin; float* X;
    __device__ __forceinline__ void operator()(const f32x4 (&acc)[2][2][4][2], const Unit& u, int wr, int wc, int fr, int fq) const {
        const int row0 = u.pm * 256 + wr * 64 + fr, col0 = u.pn * 256 + wc * 32 + 4 * fq;
#pragma unroll
        for (int ai = 0; ai < 2; ++ai)
#pragma unroll
            for (int m = 0; m < 4; ++m) { const size_t off = (size_t)(row0 + ai * 128 + m * 16) * D + col0;
#pragma unroll
                for (int bj = 0; bj < 2; ++bj)
#pragma unroll
                    for (int n = 0; n < 2; ++n) *(f32x4*)(X + off + bj * 128 + n * 16) = *(const f32x4*)(xin + off + bj * 128 + n * 16) + acc[ai][bj][m][n]; }
    }
};
struct EpiSwiGLU {
    static constexpr bool PERM = true, AFTER_DRAIN = false;
    bf16* HB;
    __device__ __forceinline__ void operator()(const f32x4 (&acc)[2][2][4][2], const Unit& u, int wr, int wc, int fr, int fq) const {
        const int row0 = u.pm * 256 + wr * 64 + fr, col0 = u.pn * 128 + wc * 32 + 8 * fq;
#pragma unroll
        for (int ai = 0; ai < 2; ++ai)
#pragma unroll
            for (int m = 0; m < 4; ++m) { f32x4 h[2];
#pragma unroll
                for (int n = 0; n < 2; ++n) { const f32x4 g = acc[ai][0][m][n], up = acc[ai][1][m][n];
#pragma unroll
                    for (int e = 0; e < 4; ++e) h[n][e] = g[e] * fsig(g[e]) * up[e]; }
                *(v4u*)(HB + (size_t)(row0 + ai * 128 + m * 16) * F + col0) = pack8(h[0], h[1]); }
    }
};
struct EpiDown {
    static constexpr bool PERM = true, AFTER_DRAIN = false;
    bf16* YE; const float* gate;
    __device__ __forceinline__ void operator()(const f32x4 (&acc)[2][2][4][2], const Unit& u, int wr, int wc, int fr, int fq) const {
        const int row0 = u.pm * 256 + wr * 64 + fr, col0 = u.pn * 256 + wc * 32 + 8 * fq;
#pragma unroll
        for (int ai = 0; ai < 2; ++ai)
#pragma unroll
            for (int m = 0; m < 4; ++m) { const int row = row0 + ai * 128 + m * 16; const float g = gate[row];
#pragma unroll
                for (int bj = 0; bj < 2; ++bj) *(v4u*)(YE + (size_t)row * D + col0 + bj * 128) = pack8(acc[ai][bj][m][0] * g, acc[ai][bj][m][1] * g); }
    }
};
struct OrderMoE1 {
    int G, c;
    __device__ __forceinline__ bool next(int i, Unit& u) const {
        if (MK_SIMPLE_ORDER || G != 256) { const int L = i * G + c; if (L >= 2048) return false; const int e = L >> 7, r = L & 127; u.pm = e * 8 + (r & 7); u.pn = r >> 3; u.pb = e * 16 + u.pn; u.pa = u.pm; return true; }
        if (i >= 8) return false;
        const int ch = i * 8 + (c & 7), j = c >> 3, e = ch >> 2, ng = ch & 3; u.pm = e * 8 + (j & 7); u.pn = ng * 4 + (j >> 3); u.pb = e * 16 + u.pn; u.pa = u.pm; return true;
    }
    __device__ __forceinline__ void a_ready(const Unit&) const {}
    __device__ __forceinline__ void done(const Unit&) const {}
};
struct OrderMoE2 {
    int G, c;
    __device__ __forceinline__ bool next(int i, Unit& u) const {
        if (MK_SIMPLE_ORDER || G != 256) { const int L = i * G + c; if (L >= 512) return false; const int e = L >> 5, r = L & 31; u.pm = e * 8 + (r & 7); u.pn = r >> 3; u.pb = e * 4 + u.pn; u.pa = u.pm; return true; }
        if (i >= 2) return false;
        const int e = i * 8 + (c & 7), j = c >> 3; u.pm = e * 8 + (j & 7); u.pn = j >> 3; u.pb = e * 4 + u.pn; u.pa = u.pm; return true;
    }
    __device__ __forceinline__ void a_ready(const Unit&) const {}
    __device__ __forceinline__ void done(const Unit&) const {}
};

__device__ __forceinline__ void p5_norm_router(const Ctx& X, const float* Xr, const float* __restrict__ g, const float* __restrict__ wr, const float* __restrict__ br) {
    bf16* XN = (bf16*)(X.ws + WS_XN); float* afft = (float*)(X.ws + WS_AFFT); const int lane = X.lane;
    LAS float* wt = (LAS float*)X.lds;
    __syncthreads();
    for (int i = X.tid; i < D * 4; i += NTH) { const f32x4 w = ((const f32x4*)wr)[i]; const int k = i >> 2, e0 = (i & 3) * 4; wt[(e0 + 0) * D + k] = w.x; wt[(e0 + 1) * D + k] = w.y; wt[(e0 + 2) * D + k] = w.z; wt[(e0 + 3) * D + k] = w.w; }
    __syncthreads();
    Row8 gg; row8_load(gg, g, lane);
    int tok = X.gw; Row8 cur; if (tok < T) row8_load(cur, Xr + (size_t)tok * D, lane);
    while (tok < T) {
        const int ntok = tok + X.ngw; Row8 nxt; if (ntok < T) row8_load(nxt, Xr + (size_t)ntok * D, lane);
        const float r = rsqrtf(wave_sum(row8_sumsq(cur)) * (1.f / D) + 1e-6f);
        float acc[16];
#pragma unroll
        for (int e = 0; e < 16; ++e) acc[e] = 0.f;
#pragma unroll
        for (int j = 0; j < 2; ++j) { f32x4 y[2];
#pragma unroll
            for (int h = 0; h < 2; ++h) y[h] = cur.a[j][h] * gg.a[j][h] * r;
            v4u w; w.x = pk2(y[0].x, y[0].y); w.y = pk2(y[0].z, y[0].w); w.z = pk2(y[1].x, y[1].y); w.w = pk2(y[1].z, y[1].w);
            ((v4u*)(XN + (size_t)tok * D))[lane + 64 * j] = w;
#pragma unroll
            for (int e = 0; e < 16; ++e) { const LAS f32x4* wp = (const LAS f32x4*)(wt + e * D + 8 * (lane + 64 * j)); const f32x4 w0 = wp[0], w1 = wp[1];
                acc[e] += ((y[0].x * w0.x + y[0].y * w0.y) + (y[0].z * w0.z + y[0].w * w0.w)) + ((y[1].x * w1.x + y[1].y * w1.y) + (y[1].z * w1.z + y[1].w * w1.w));
                if ((e & 3) == 3) asm volatile("" ::: "memory"); } }
        float mx = -1e30f;
#pragma unroll
        for (int e = 0; e < 16; ++e) { acc[e] = wave_sum(acc[e]) + br[e]; mx = fmaxf(mx, acc[e]); }
        float l = 0.f;
#pragma unroll
        for (int e = 0; e < 16; ++e) { acc[e] = expf(acc[e] - mx); l += acc[e]; }
        const int b = tok >> 12, s_ = tok & (S - 1);
        if (lane < 16) { float vv = 0.f;
#pragma unroll
            for (int e = 0; e < 16; ++e) if (lane == e) vv = acc[e];
            afft[((size_t)b * E + lane) * S + s_] = vv / l; }
        cur = nxt; tok = ntok;
    }
    __syncthreads();
}
__device__ __forceinline__ void p6_topk(const Ctx& X) {
    const float* afft = (const float*)(X.ws + WS_AFFT); int* rows = (int*)(X.ws + WS_ROWS); float* gate = (float*)(X.ws + WS_GATE); int* inv = (int*)(X.ws + WS_INV);
    for (int p = X.bid; p < B * E; p += X.G) { const int b = p >> 4, e = p & 15, slotbase = e * 2048 + b * 512;
        tk::topk_problem(afft + (size_t)p * S, b * S, e, slotbase, rows + slotbase, gate + slotbase, inv, (int*)(X.lds), X.tid); }
}
__device__ __forceinline__ void p6_gather(const Ctx& X) {
    const int* rows = (const int*)(X.ws + WS_ROWS); const bf16* XN = (const bf16*)(X.ws + WS_XN); bf16* XG = (bf16*)(X.ws + WS_XG);
    for (int sl0 = X.gw * 4; sl0 < E * 2048; sl0 += X.ngw * 4) {
        const int myrow = X.lane < 4 ? __hip_atomic_load(rows + sl0 + X.lane, __ATOMIC_RELAXED, __HIP_MEMORY_SCOPE_AGENT) : 0;
        v4u d[4][2];
#pragma unroll
        for (int i = 0; i < 4; ++i) { const int tok = __builtin_amdgcn_readlane(myrow, i); const v4u* s = (const v4u*)(XN + (size_t)tok * D) + X.lane; d[i][0] = s[0]; d[i][1] = s[64]; }
#pragma unroll
        for (int i = 0; i < 4; ++i) { v4u* o = (v4u*)(XG + (size_t)(sl0 + i) * D) + X.lane; o[0] = d[i][0]; o[64] = d[i][1]; }
    }
}
__device__ __forceinline__ void p9_combine(const Ctx& X, float* Xr, const float* __restrict__ g, bool final_, float* __restrict__ out) {
    const int* inv = (const int*)(X.ws + WS_INV); const bf16* YE = (const bf16*)(X.ws + WS_YE); bf16* XN = (bf16*)(X.ws + WS_XN); const int lane = X.lane;
    Row8 gg; row8_load(gg, g, lane);
    int tok = X.gw; Row8 cur; int myinv = -1;
    if (tok < T) { row8_load(cur, Xr + (size_t)tok * D, lane); if (lane < 16) myinv = inv[(size_t)tok * E + lane]; }
    while (tok < T) {
        const int ntok = tok + X.ngw; Row8 nxt; int ninv = -1;
        if (ntok < T) { row8_load(nxt, Xr + (size_t)ntok * D, lane); if (lane < 16) ninv = inv[(size_t)ntok * E + lane]; }
        unsigned long long m = __ballot(myinv >= 0);
        while (m) {
            int sl[4];
#pragma unroll
            for (int i = 0; i < 4; ++i) { if (m) { const int e = __builtin_ctzll(m); m &= m - 1; sl[i] = __builtin_amdgcn_readlane(myinv, e); } else sl[i] = -1; }
            v4u y[4][2];
#pragma unroll
            for (int i = 0; i < 4; ++i) if (sl[i] >= 0) { const v4u* yp = (const v4u*)(YE + (size_t)sl[i] * D); y[i][0] = yp[lane]; y[i][1] = yp[lane + 64]; }
#pragma unroll
            for (int i = 0; i < 4; ++i) if (sl[i] >= 0) {
#pragma unroll
                for (int j = 0; j < 2; ++j) { f32x4 p, q; unpack8(y[i][j], p, q); cur.a[j][0] += p; cur.a[j][1] += q; } }
        }
        const float r = rsqrtf(wave_sum(row8_sumsq(cur)) * (1.f / D) + 1e-6f);
        if (final_) {
#pragma unroll
            for (int j = 0; j < 2; ++j)
#pragma unroll
                for (int h = 0; h < 2; ++h) ((f32x4*)(out + (size_t)tok * D))[2 * (lane + 64 * j) + h] = cur.a[j][h] * gg.a[j][h] * r;
        } else {
#pragma unroll
            for (int j = 0; j < 2; ++j) {
#pragma unroll
                for (int h = 0; h < 2; ++h) ((f32x4*)(Xr + (size_t)tok * D))[2 * (lane + 64 * j) + h] = cur.a[j][h];
                const f32x4 y0 = cur.a[j][0] * gg.a[j][0] * r, y1 = cur.a[j][1] * gg.a[j][1] * r;
                v4u w; w.x = pk2(y0.x, y0.y); w.y = pk2(y0.z, y0.w); w.z = pk2(y1.x, y1.y); w.w = pk2(y1.z, y1.w);
                ((v4u*)(XN + (size_t)tok * D))[lane + 64 * j] = w; }
        }
        cur = nxt; myinv = ninv; tok = ntok;
    }
}
}
namespace mk {
__device__ __forceinline__ void p1t_shortconv(const Ctx& X, const float* __restrict__ cw, const float* __restrict__ cb) {
    const bf16* U = (const bf16*)(X.ws + WS_U); bf16* UCT = (bf16*)(X.ws + WS_UCT);
    LAS float* raw = (LAS float*)(X.lds + X.wave * 17408);
    const int lane = X.lane, rq = lane >> 3, cq = lane & 7;
    constexpr int NIT = (T / 64) * 24;
    v4u w[9];
#define P1T_LOAD(it_) do { const int tt_ = (it_) / 24, cg_ = (it_) - tt_ * 24, tok0_ = tt_ * 64, tin_ = tok0_ & (S - 1); \
        _Pragma("unroll") for (int i = 0; i < 9; ++i) { const int r = 8 * i + rq, tpos = tin_ + r - 1; w[i] = (v4u){0u, 0u, 0u, 0u}; \
            if (r < 66 && tpos >= 0 && tpos < S) w[i] = *(const v4u*)(U + (size_t)(tok0_ + r - 1) * 1536 + cg_ * 64 + 8 * cq); } } while (0)
    int it = X.gw;
    if (it < NIT) P1T_LOAD(it);
    while (it < NIT) {
        const int tt = it / 24, cg = it - tt * 24, tok0 = tt * 64, ch0 = cg * 64;
#pragma unroll
        for (int i = 0; i < 9; ++i) { const int r = 8 * i + rq; if (r < 66) { LAS float* d = raw + r * 65 + 8 * cq; f32x4 p, q; unpack8(w[i], p, q);
            d[0] = p.x; d[1] = p.y; d[2] = p.z; d[3] = p.w; d[4] = q.x; d[5] = q.y; d[6] = q.z; d[7] = q.w; } }
        const int nit = it + X.ngw;
        if (nit < NIT) P1T_LOAD(nit);
        asm volatile("s_waitcnt lgkmcnt(0)" ::: "memory");
        const int chs = lane >> 3, tch = lane & 7;
#pragma unroll
        for (int g = 0; g < 8; ++g) { const int ch = 8 * g + chs, gc = ch0 + ch; const float w0 = cw[gc], w1 = cw[1536 + gc], w2 = cw[3072 + gc], bb = cb[gc];
            float v[10];
#pragma unroll
            for (int k = 0; k < 10; ++k) v[k] = raw[(8 * tch + k) * 65 + ch];
            float o[8];
#pragma unroll
            for (int k = 0; k < 8; ++k) o[k] = v[k] * w0 + v[k + 1] * w1 + v[k + 2] * w2 + bb;
            v4u pk; pk.x = pk2(o[0], o[1]); pk.y = pk2(o[2], o[3]); pk.z = pk2(o[4], o[5]); pk.w = pk2(o[6], o[7]);
            *(v4u*)(UCT + (size_t)gc * T + tok0 + 8 * tch) = pk; }
        asm volatile("s_waitcnt lgkmcnt(0)" ::: "memory");
        it = nit;
    }
#undef P1T_LOAD
}

__device__ __forceinline__ void p1t_kmax(const Ctx& X, unsigned* kmax2) {
    const bf16* K = (const bf16*)(X.ws + WS_K); const int lane = X.lane; LAS float* red = (LAS float*)(X.lds + 8 * 17408);
    const int b = X.gw / 512, t0 = X.gw % 512; float mx = 0.f;
    if (b < B) {
        v4u w[8];
#pragma unroll
        for (int i = 0; i < 8; ++i) w[i] = ((const v4u*)(K + ((size_t)b * S + t0 + 512 * i) * 512))[lane];
#pragma unroll
        for (int i = 0; i < 8; ++i) { f32x4 p, q; unpack8(w[i], p, q); float ss = (p.x * p.x + p.y * p.y) + (p.z * p.z + p.w * p.w) + (q.x * q.x + q.y * q.y) + (q.z * q.z + q.w * q.w);
            ss += xor_f<1>(ss); ss += xor_f<2>(ss); ss += xor_f<4>(ss); mx = fmaxf(mx, ss); }
    }
    __syncthreads();
    if ((lane & 7) == 0) red[X.wave * 8 + (lane >> 3)] = mx;
    __syncthreads();
    if (X.tid < 8 && b < B) { float m = red[X.tid]; for (int w_ = 1; w_ < 8; ++w_) m = fmaxf(m, red[w_ * 8 + X.tid]); atomicMax(kmax2 + b * 8 + X.tid, __float_as_uint(m)); }
}

namespace at {
constexpr int KVBLK = 64, LDK = 512;
constexpr int KPITCH = 272;
constexpr int SHM_V = 64 * 128 * 2, SHM_K = 64 * KPITCH;
constexpr int OFF_V = 0, OFF_K = 2 * SHM_V, OFF_Q = OFF_K + 2 * SHM_K, OFF_WS = OFF_Q + 256 * KPITCH, LDS_TOTAL = OFF_WS + 8 * 160 * 4;
constexpr float THR2 = 8.0f * 1.4426950408889634f;
#define KSWZ(row, colB) ((row) * KPITCH + (colB))
#define SBAR() __builtin_amdgcn_sched_barrier(0)
__device__ __forceinline__ int crow(int r, int hi) { return (r & 3) + 8 * (r >> 2) + 4 * hi; }
__device__ __forceinline__ int v_st(int k, int c) { const int kk = (k & ~0xC) | ((k & 4) << 1) | ((k & 8) >> 1); return ((kk >> 3) * 4 + (c >> 5)) * 512 + ((kk & 7) * 32 + (c & 31)) * 2; }
__device__ __forceinline__ int v_rd_base(int lane) { return ((lane & 3) << 3) | (((lane >> 2) & 3) << 6) | (((lane >> 4) & 1) << 5) | (((lane >> 5) & 1) << 8); }
constexpr int v_rd_off(int d0, int ks, int half) { return d0 * 512 + ks * 4096 + half * 2048; }
template <int OFF> __device__ __forceinline__ s16x4 tr_read(int vb) { s16x4 r; asm volatile("ds_read_b64_tr_b16 %0, %1 offset:%2" : "=&v"(r) : "v"(vb), "i"(OFF) : "memory"); return r; }

template <int CO> __device__ __forceinline__ void qkt(f32x16& p0, f32x16& p1, const char* Ks, const char* Qs, int qrow, int r32, int hi) {
    p0 = f32x16{}; p1 = f32x16{};
    const char* qp = Qs + KSWZ(qrow, (CO * 64 + hi * 8) * 2); const char* kp = Ks + KSWZ(r32, (CO * 64 + hi * 8) * 2);
#pragma unroll
    for (int d0 = 0; d0 < 4; ++d0) {
        const bf16x8 qf = *reinterpret_cast<const bf16x8*>(qp + d0 * 32);
        const bf16x8 b0 = *reinterpret_cast<const bf16x8*>(kp + d0 * 32);
        const bf16x8 b1 = *reinterpret_cast<const bf16x8*>(kp + 32 * KPITCH + d0 * 32);
        p0 = __builtin_amdgcn_mfma_f32_32x32x16_bf16(b0, qf, p0, 0, 0, 0);
        p1 = __builtin_amdgcn_mfma_f32_32x32x16_bf16(b1, qf, p1, 0, 0, 0);
        if (d0 == 1) asm volatile("" ::: "memory"); }
}
__device__ __forceinline__ void softmax_tile(f32x16& p0, f32x16& p1, float& m_reg, float& l_reg, float& alpha, bf16x8& pa0, bf16x8& pa1, bf16x8& pa2, bf16x8& pa3) {
    float pmax = p0[0];
#pragma unroll
    for (int r = 1; r < 16; ++r) pmax = fmaxf(pmax, p0[r]);
#pragma unroll
    for (int r = 0; r < 16; ++r) pmax = fmaxf(pmax, p1[r]);
    { auto rr = __builtin_amdgcn_permlane32_swap(__float_as_uint(pmax), __float_as_uint(pmax), false, false); pmax = fmaxf(__uint_as_float(rr[0]), __uint_as_float(rr[1])); }
    float mn;
    if (__builtin_expect(__all(pmax - m_reg <= THR2), 1)) { mn = m_reg; alpha = 1.f; }
    else { mn = fmaxf(m_reg, pmax); alpha = __builtin_amdgcn_exp2f(m_reg - mn); m_reg = mn; }
#pragma unroll
    for (int r = 0; r < 16; ++r) { p0[r] = __builtin_amdgcn_exp2f(p0[r] - mn); p1[r] = __builtin_amdgcn_exp2f(p1[r] - mn); }
    float ps = 0.f;
#pragma unroll
    for (int r = 0; r < 16; ++r) ps += p0[r];
#pragma unroll
    for (int r = 0; r < 16; ++r) ps += p1[r];
    { auto rr = __builtin_amdgcn_permlane32_swap(__float_as_uint(ps), __float_as_uint(ps), false, false); ps = __uint_as_float(rr[0]) + __uint_as_float(rr[1]); }
    l_reg = l_reg * alpha + ps;
#define PK4(P, BASE, OUT) do { unsigned a0 = cvtpk(P[BASE + 0], P[BASE + 1]), a1 = cvtpk(P[BASE + 2], P[BASE + 3]);   \
    unsigned b0 = cvtpk(P[BASE + 4], P[BASE + 5]), b1 = cvtpk(P[BASE + 6], P[BASE + 7]);                              \
    auto r0 = __builtin_amdgcn_permlane32_swap(a0, b0, false, false); auto r1 = __builtin_amdgcn_permlane32_swap(a1, b1, false, false); \
    v4u w = {r0[0], r1[0], r0[1], r1[1]}; OUT = *reinterpret_cast<bf16x8*>(&w); } while (0)
    PK4(p0, 0, pa0); PK4(p0, 8, pa1); PK4(p1, 0, pa2); PK4(p1, 8, pa3);
#undef PK4
}
__device__ __forceinline__ void softmax_fixed(f32x16& p0, f32x16& p1, float m, float& l_half, bf16x8& pa0, bf16x8& pa1, bf16x8& pa2, bf16x8& pa3) {
#pragma unroll
    for (int r = 0; r < 16; ++r) { p0[r] = __builtin_amdgcn_exp2f(p0[r] - m); p1[r] = __builtin_amdgcn_exp2f(p1[r] - m); }
    float ps = 0.f;
#pragma unroll
    for (int r = 0; r < 16; ++r) ps += p0[r] + p1[r];
    l_half += ps;
#define PK4(P, BASE, OUT) do { unsigned a0 = cvtpk(P[BASE + 0], P[BASE + 1]), a1 = cvtpk(P[BASE + 2], P[BASE + 3]);   \
    unsigned b0 = cvtpk(P[BASE + 4], P[BASE + 5]), b1 = cvtpk(P[BASE + 6], P[BASE + 7]);                              \
    auto r0 = __builtin_amdgcn_permlane32_swap(a0, b0, false, false); auto r1 = __builtin_amdgcn_permlane32_swap(a1, b1, false, false); \
    v4u w = {r0[0], r1[0], r0[1], r1[1]}; OUT = *reinterpret_cast<bf16x8*>(&w); } while (0)
    PK4(p0, 0, pa0); PK4(p0, 8, pa1); PK4(p1, 0, pa2); PK4(p1, 8, pa3);
#undef PK4
}
template <int D0> __device__ __forceinline__ void pv_one(f32x16& oa, int vb, const bf16x8 (&pa)[4]) {
#define PK(L, H) (bf16x8){L[0], L[1], L[2], L[3], H[0], H[1], H[2], H[3]}
    {   const s16x4 l0 = tr_read<v_rd_off(D0, 0, 0)>(vb), h0 = tr_read<v_rd_off(D0, 0, 1)>(vb), l1 = tr_read<v_rd_off(D0, 1, 0)>(vb), h1 = tr_read<v_rd_off(D0, 1, 1)>(vb);
        asm volatile("s_waitcnt lgkmcnt(0)" ::: "memory"); SBAR();
        oa = __builtin_amdgcn_mfma_f32_32x32x16_bf16(pa[0], PK(l0, h0), oa, 0, 0, 0);
        oa = __builtin_amdgcn_mfma_f32_32x32x16_bf16(pa[1], PK(l1, h1), oa, 0, 0, 0); }
    {   const s16x4 l2 = tr_read<v_rd_off(D0, 2, 0)>(vb), h2 = tr_read<v_rd_off(D0, 2, 1)>(vb), l3 = tr_read<v_rd_off(D0, 3, 0)>(vb), h3 = tr_read<v_rd_off(D0, 3, 1)>(vb);
        asm volatile("s_waitcnt lgkmcnt(0)" ::: "memory"); SBAR();
        oa = __builtin_amdgcn_mfma_f32_32x32x16_bf16(pa[2], PK(l2, h2), oa, 0, 0, 0);
        oa = __builtin_amdgcn_mfma_f32_32x32x16_bf16(pa[3], PK(l3, h3), oa, 0, 0, 0); }
#undef PK
}
template <int D0> __device__ __forceinline__ void pv_two(f32x16& oa, f32x16& ob, int vb, const bf16x8 (&pa)[4], const bf16x8 (&pb)[4]) {
#define PK(L, H) (bf16x8){L[0], L[1], L[2], L[3], H[0], H[1], H[2], H[3]}
    {   const s16x4 l0 = tr_read<v_rd_off(D0, 0, 0)>(vb), h0 = tr_read<v_rd_off(D0, 0, 1)>(vb), l1 = tr_read<v_rd_off(D0, 1, 0)>(vb), h1 = tr_read<v_rd_off(D0, 1, 1)>(vb);
        asm volatile("s_waitcnt lgkmcnt(0)" ::: "memory"); SBAR();
        const bf16x8 v0 = PK(l0, h0), v1 = PK(l1, h1);
        oa = __builtin_amdgcn_mfma_f32_32x32x16_bf16(pa[0], v0, oa, 0, 0, 0); ob = __builtin_amdgcn_mfma_f32_32x32x16_bf16(pb[0], v0, ob, 0, 0, 0);
        oa = __builtin_amdgcn_mfma_f32_32x32x16_bf16(pa[1], v1, oa, 0, 0, 0); ob = __builtin_amdgcn_mfma_f32_32x32x16_bf16(pb[1], v1, ob, 0, 0, 0); }
    {   const s16x4 l2 = tr_read<v_rd_off(D0, 2, 0)>(vb), h2 = tr_read<v_rd_off(D0, 2, 1)>(vb), l3 = tr_read<v_rd_off(D0, 3, 0)>(vb), h3 = tr_read<v_rd_off(D0, 3, 1)>(vb);
        asm volatile("s_waitcnt lgkmcnt(0)" ::: "memory"); SBAR();
        const bf16x8 v2 = PK(l2, h2), v3 = PK(l3, h3);
        oa = __builtin_amdgcn_mfma_f32_32x32x16_bf16(pa[2], v2, oa, 0, 0, 0); ob = __builtin_amdgcn_mfma_f32_32x32x16_bf16(pb[2], v2, ob, 0, 0, 0);
        oa = __builtin_amdgcn_mfma_f32_32x32x16_bf16(pa[3], v3, oa, 0, 0, 0); ob = __builtin_amdgcn_mfma_f32_32x32x16_bf16(pb[3], v3, ob, 0, 0, 0); }
#undef PK
}
__device__ __forceinline__ void rescale(f32x16 (&o)[4], float al, float* wsf, int r32, int hi) {
    if (__any(al < 1.f)) {
        if (hi == 0) wsf[r32] = al; asm volatile("s_waitcnt lgkmcnt(0)" ::: "memory");
#pragma unroll
        for (int r = 0; r < 16; ++r) { const float a = wsf[crow(r, hi)];
#pragma unroll
            for (int d = 0; d < 4; ++d) o[d][r] *= a; }
    }
}

__device__ __forceinline__ void epilogue(const Ctx& X, f32x16 (&oa)[4], f32x16 (&ob)[4], const float* wsf, int r32, int hi, int b, int h, int qb, float lam, float mul, const float* __restrict__ sg) {
    bf16* Yw = (bf16*)(X.ws + WS_YA) + ((size_t)b * S + qb * 256 + X.wave * 32) * 512 + h * 128;
    float gcol[4];
#pragma unroll
    for (int d = 0; d < 4; ++d) gcol[d] = sg[d * 32 + r32] * mul;
#pragma unroll
    for (int r = 0; r < 16; ++r) { const int orow = crow(r, hi); const float i0 = __builtin_amdgcn_rcpf(wsf[orow] + wsf[64 + orow]), i1 = lam * __builtin_amdgcn_rcpf(wsf[32 + orow] + wsf[96 + orow]);
        float v[4], ss = 0.f;
#pragma unroll
        for (int d = 0; d < 4; ++d) { v[d] = oa[d][r] * i0 - ob[d][r] * i1; ss += v[d] * v[d]; }
        ss += xor_f<1>(ss); ss += xor_f<2>(ss); ss += xor_f<4>(ss); ss += xor_f<8>(ss); ss += xor_f<16>(ss);
        const float rn = rsqrtf(ss * (1.f / 128.f) + 1e-5f);
#pragma unroll
        for (int d = 0; d < 4; ++d) Yw[(size_t)orow * 512 + d * 32 + r32] = (bf16)f2bf(v[d] * rn * gcol[d]); }
}
__device__ __forceinline__ int vkey(int T_, int lane) { const int kk = ((T_ >> 2) << 3) | ((lane & 31) >> 2); return (kk & ~0xC) | ((kk & 4) << 1) | ((kk & 8) >> 1); }
__device__ __forceinline__ int vcol(int T_, int lane) { return (T_ & 3) * 32 + (lane & 3) * 8; }
__device__ __forceinline__ void attn_unit(const Ctx& X, int b, int h, int qb, float lam, float mul, const float* __restrict__ sg, unsigned* kmax2) {
    char* lds = (char*)X.lds;
    const int tid = fresh_tid(X.wave_s);
    const int wid = X.wave, lane = tid & 63, r32 = lane & 31, hi = lane >> 5;
    const bf16* Qg = (const bf16*)(X.ws + WS_Q) + ((size_t)b * S + qb * 256) * LDK + h * 128;
    const bf16* Kh = (const bf16*)(X.ws + WS_K) + (size_t)b * S * LDK + h * 128;
    const bf16* Vh = (const bf16*)(X.ws + WS_V) + (size_t)b * S * LDK + h * 128;
    char* V_lds = lds + OFF_V; char* K_lds = lds + OFF_K; char* Q_lds = lds + OFF_Q;
    float* wsf = (float*)(lds + OFF_WS) + wid * 160;
    const int sr = tid >> 4, sc = (tid & 15) * 8, vst0 = v_st(sr, sc), vst1 = v_st(32 + sr, sc);
    const int vb0 = (int)(uintptr_t)V_lds + v_rd_base(lane);
#pragma unroll
    for (int i = 0; i < 8; ++i) { const int row = sr + 32 * i; *(bf16x8*)(Q_lds + KSWZ(row, sc * 2)) = *reinterpret_cast<const bf16x8*>(Qg + (size_t)row * LDK + sc); }
    bf16x8 st0, st1;
    const unsigned goff = (unsigned)(sr * LDK + sc) * 2u;
#define KLOAD(k0) do { const char* t_ = (const char*)Kh + (size_t)(k0) * (LDK * 2); st0 = *reinterpret_cast<const bf16x8*>(t_ + goff); st1 = *reinterpret_cast<const bf16x8*>(t_ + 32 * LDK * 2 + goff); } while (0)
#define VLOAD(k0) do { const char* t_ = (const char*)Vh + (size_t)(k0) * (LDK * 2); st0 = *reinterpret_cast<const bf16x8*>(t_ + goff); st1 = *reinterpret_cast<const bf16x8*>(t_ + 32 * LDK * 2 + goff); } while (0)
#define KWRITE(bb) do { *(bf16x8*)(K_lds + (bb) * SHM_K + KSWZ(sr, sc * 2)) = st0; *(bf16x8*)(K_lds + (bb) * SHM_K + KSWZ(32 + sr, sc * 2)) = st1; } while (0)
    const unsigned vsrc0 = (unsigned)(vkey(2 * wid + (lane >> 5), lane) * LDK + vcol(2 * wid + (lane >> 5), lane)) * 2u, vsrc1 = (unsigned)(vkey(2 * (wid + 8) + (lane >> 5), lane) * LDK + vcol(2 * (wid + 8) + (lane >> 5), lane)) * 2u;
#define VDMA(k0, bbn) do { const char* t_ = (const char*)Vh + (size_t)(k0) * (LDK * 2); LAS unsigned char* d_ = X.lds + OFF_V + (bbn) * SHM_V + wid * 1024; \
    __builtin_amdgcn_global_load_lds((const unsigned*)(t_ + vsrc0), (LAS unsigned*)d_, 16, 0, 0); __builtin_amdgcn_global_load_lds((const unsigned*)(t_ + vsrc1), (LAS unsigned*)(d_ + 8192), 16, 0, 0); } while (0)
    const unsigned ksrc = (unsigned)(wid * 8 * LDK * 2) + (unsigned)lane * 4u;
#define KDMA(k0, bbn) do { const char* t_ = (const char*)Kh + (size_t)(k0) * (LDK * 2) + ksrc; LAS unsigned char* d_ = X.lds + OFF_K + (bbn) * SHM_K + wid * 8 * KPITCH; \
    _Pragma("unroll") for (int i_ = 0; i_ < 8; ++i_) __builtin_amdgcn_global_load_lds((const unsigned*)(t_ + i_ * (LDK * 2)), (LAS unsigned*)(d_ + i_ * KPITCH), 4, 0, 0); } while (0)
#define VWRITE(bb) do { *(bf16x8*)(V_lds + (bb) * SHM_V + vst0) = st0; *(bf16x8*)(V_lds + (bb) * SHM_V + vst1) = st1; } while (0)
    float l0 = 0.f, l1 = 0.f; f32x16 oa[4] = {}, ob[4] = {};
    const int qrow = wid * 32 + r32; constexpr int NT = S / KVBLK;
    KDMA(0, 0); VDMA(0, 0); __syncthreads();
    float m0, m1;
    { float s0 = 0.f, s1 = 0.f;
#pragma unroll
      for (int d0 = 0; d0 < 8; ++d0) { const v4u w = *reinterpret_cast<const v4u*>(Q_lds + KSWZ(qrow, (d0 * 16 + hi * 8) * 2)); f32x4 p, q; unpack8(w, p, q);
          const float ss = (p.x * p.x + p.y * p.y) + (p.z * p.z + p.w * p.w) + (q.x * q.x + q.y * q.y) + (q.z * q.z + q.w * q.w); if (d0 < 4) s0 += ss; else s1 += ss; }
      wsf[hi * 64 + r32] = s0; wsf[hi * 64 + 32 + r32] = s1; asm volatile("s_waitcnt lgkmcnt(0)" ::: "memory");
      s0 += wsf[(hi ^ 1) * 64 + r32]; s1 += wsf[(hi ^ 1) * 64 + 32 + r32]; asm volatile("s_waitcnt lgkmcnt(0)" ::: "memory");
      const float k0 = __uint_as_float(__hip_atomic_load(kmax2 + b * 8 + h * 2, __ATOMIC_RELAXED, __HIP_MEMORY_SCOPE_AGENT)), k1 = __uint_as_float(__hip_atomic_load(kmax2 + b * 8 + h * 2 + 1, __ATOMIC_RELAXED, __HIP_MEMORY_SCOPE_AGENT));
      m0 = sqrtf(s0 * k0) * 1.001f + 1e-3f; m1 = sqrtf(s1 * k1) * 1.001f + 1e-3f; }
    for (int j = 0; j < NT; ++j) {
        const int bb = j & 1; const char* Ks = K_lds + bb * SHM_K;
        const int kn = (j + 1) * KVBLK;
        if (j + 1 < NT) { KDMA(kn, bb ^ 1); VDMA(kn, bb ^ 1); }
        const int vb = vb0 + bb * SHM_V;
        bf16x8 pa[4], pb[4];
        { f32x16 p0, p1, q0, q1;
          qkt<0>(p0, p1, Ks, Q_lds, qrow, r32, hi); qkt<1>(q0, q1, Ks, Q_lds, qrow, r32, hi);
          softmax_fixed(p0, p1, m0, l0, pa[0], pa[1], pa[2], pa[3]);
          softmax_fixed(q0, q1, m1, l1, pb[0], pb[1], pb[2], pb[3]); }
        SBAR();
        pv_two<0>(oa[0], ob[0], vb, pa, pb); pv_two<1>(oa[1], ob[1], vb, pa, pb); pv_two<2>(oa[2], ob[2], vb, pa, pb); pv_two<3>(oa[3], ob[3], vb, pa, pb);
        __syncthreads();
    }
#undef KLOAD
#undef VLOAD
#undef VDMA
#undef KDMA
#undef KWRITE
#undef VWRITE
    wsf[hi * 64 + r32] = l0; wsf[hi * 64 + 32 + r32] = l1; asm volatile("s_waitcnt lgkmcnt(0)" ::: "memory");
    { const int t2 = fresh_tid(X.wave_s); epilogue(X, oa, ob, wsf, t2 & 31, (t2 & 63) >> 5, b, h, qb, lam, mul, sg); }
    __syncthreads();
}
__device__ __forceinline__ void epilogue_unused() {}
#undef KSWZ
#undef SBAR
}
}
namespace mk {
namespace hy {
constexpr int CPS = 16704;
constexpr int NEL = 8352;
constexpr int OFF_Z = 4 * CPS;
constexpr int ZROW = 144, ZB = 128 * ZROW;
constexpr int LDS_TOTAL = OFF_Z + 4 * ZB;

__device__ __forceinline__ void build_hrev(const Ctx& X, const bf16* hf, const bf16* hb, float bias) {
    const int tid = X.tid;
    if (tid < 4 * 8) { const int m = tid >> 3, e = tid & 7; if (e < 5 - m) *(LAS bf16*)(X.lds + m * CPS + 2 * e) = 0; }
    for (int i = tid; i < 4 * (NEL - 8192); i += NTH) { const int m = i / (NEL - 8192), e = 8192 + (i - m * (NEL - 8192)); if (e > 8195 - m) *(LAS bf16*)(X.lds + m * CPS + 2 * e) = 0; }
#pragma unroll
    for (int half = 0; half < 2; ++half) {
        const v4u w = *(const v4u*)((half ? hb : hf) + 8 * tid);
        unsigned short v[8] = {(unsigned short)(w.x & 0xffff), (unsigned short)(w.x >> 16), (unsigned short)(w.y & 0xffff), (unsigned short)(w.y >> 16), (unsigned short)(w.z & 0xffff), (unsigned short)(w.z >> 16), (unsigned short)(w.w & 0xffff), (unsigned short)(w.w >> 16)};
        if (half == 0 && tid == 0) v[0] = (unsigned short)f2bf(bf2f(v[0]) + bias);
#pragma unroll
        for (int k = 0; k < 8; ++k) { const int d = 8 * tid + k; if (half == 1 && d == 0) continue;
            const int e0 = half ? 4100 + d : 4100 - d;
#pragma unroll
            for (int m = 0; m < 4; ++m) *(LAS bf16*)(X.lds + m * CPS + 2 * (e0 - m)) = v[k]; }
    }
}
#define HY_LDA(dst, qq) do { const v2u lo_ = *(const volatile LAS v2u*)(X.lds + baseA + 32 * (qq)), hi_ = *(const volatile LAS v2u*)(X.lds + baseA8 + 32 * (qq)); v4u w_ = {lo_.x, lo_.y, hi_.x, hi_.y}; dst = *reinterpret_cast<bf16x8*>(&w_); } while (0)
#define HY_LOAD_E(FA, FB, d1_, q_) do { const LAS unsigned char* zr_ = zb - (d1_) * ZROW; HY_LDA(FA[0], (q_)); HY_LDA(FA[1], (q_) + 1); \
    FB[0] = *(const LAS bf16x8*)(zr_); FB[1] = *(const LAS bf16x8*)(zr_ + 32); FB[2] = *(const LAS bf16x8*)(zr_ + 64); FB[3] = *(const LAS bf16x8*)(zr_ + 96); } while (0)
#define HY_LOAD_L(FA, q_) do { HY_LDA(FA[2], (q_) + 2); HY_LDA(FA[3], (q_) + 3); } while (0)
#define HY_MMA1(FA, FB, PA) do { __builtin_amdgcn_s_setprio(1); \
    acc0 = __builtin_amdgcn_mfma_f32_32x32x16_bf16(FA[0], FB[0], acc0, 0, 0, 0); acc1 = __builtin_amdgcn_mfma_f32_32x32x16_bf16(PA[2], FB[0], acc1, 0, 0, 0); \
    acc0 = __builtin_amdgcn_mfma_f32_32x32x16_bf16(FA[1], FB[1], acc0, 0, 0, 0); acc1 = __builtin_amdgcn_mfma_f32_32x32x16_bf16(PA[3], FB[1], acc1, 0, 0, 0); __builtin_amdgcn_s_setprio(0); } while (0)
#define HY_MMA2(FA, FB) do { __builtin_amdgcn_s_setprio(1); \
    acc0 = __builtin_amdgcn_mfma_f32_32x32x16_bf16(FA[2], FB[2], acc0, 0, 0, 0); acc1 = __builtin_amdgcn_mfma_f32_32x32x16_bf16(FA[0], FB[2], acc1, 0, 0, 0); \
    acc0 = __builtin_amdgcn_mfma_f32_32x32x16_bf16(FA[3], FB[3], acc0, 0, 0, 0); acc1 = __builtin_amdgcn_mfma_f32_32x32x16_bf16(FA[1], FB[3], acc1, 0, 0, 0); __builtin_amdgcn_s_setprio(0); } while (0)
template <int PAIR> __device__ __forceinline__ void channel(const Ctx& X, int l, int c, const float* __restrict__ hyb, v2u (&keep)[2][4]) {
    const bf16* UCT = (const bf16*)(X.ws + WS_UCT); const bf16* FILT = (const bf16*)(X.ws + WS_FILT) + (size_t)l * 4 * C * S; bf16* YH = (bf16*)(X.ws + WS_YH);
    const int tid = X.tid, lane = X.lane, wid = X.wave, r = lane & 31, h = lane >> 5, b = wid >> 1, jt = wid & 1;
    LAS unsigned char* zl = X.lds + OFF_Z;
    __syncthreads();
    v4u zero4 = {0u, 0u, 0u, 0u}; asm volatile("" : "+v"(zero4));
    for (int i = tid; i < 4 * 64 * 9; i += NTH) { const int bb = i / 576, rr = (i % 576) / 9, ch = i % 9; const int row = rr < 32 ? rr : 64 + rr;
        *(LAS v4u*)(zl + bb * ZB + row * ZROW + ch * 16) = zero4; }
    for (int i = tid; i < 4 * 64 * 8; i += NTH) { const int bb = i >> 9, s1 = (i >> 3) & 63, ch = i & 7;
        *(LAS v4u*)(zl + bb * ZB + (32 + s1) * ZROW + ch * 16) = *(const v4u*)(UCT + (size_t)c * T + bb * S + s1 * 64 + ch * 8); }
    const int m4 = (4 - (r & 3)) & 3;
    const int baseA = m4 * CPS + 2 * (8 * h - r + 4100 - m4);
    int baseA8 = baseA + 8; asm volatile("" : "+v"(baseA8));
    for (int o = 0; o < 2; ++o) {
        build_hrev(X, FILT + ((size_t)(2 * o) * C + c) * S, FILT + ((size_t)(2 * o + 1) * C + c) * S, hyb[(l * 2 + o) * C + c]);
#ifdef MK_HY_DUPBUILD
        asm volatile("" ::: "memory"); build_hrev(X, FILT + ((size_t)(2 * o) * C + c) * S, FILT + ((size_t)(2 * o + 1) * C + c) * S, hyb[(l * 2 + o) * C + c]);
#endif
        const bf16* gate = UCT + (size_t)((o + 1) * C + c) * T + (size_t)b * S;
        const int t1 = 32 * jt + r;
        v2u gw[2][4];
#pragma unroll
        for (int mt = 0; mt < 2; ++mt)
#pragma unroll
            for (int g = 0; g < 4; ++g) gw[mt][g] = *(const v2u*)(gate + t1 * 64 + 32 * mt + 8 * g + 4 * h);
        __syncthreads();
#ifndef MK_HY_SWEEPS
#define MK_HY_SWEEPS 1
#endif
        f32x16 acc0 = {}, acc1 = {};
        for (int rep = 0; rep < MK_HY_SWEEPS; ++rep) {
        const int d1max = 32 * jt + 31; int q = -4 * d1max;
        const LAS unsigned char* zb = zl + b * ZB + (32 + 32 * jt + r) * ZROW + 16 * h;
        bf16x8 fa0[4], fb0[4], fa1[4], fb1[4];
        HY_LDA(fa1[2], q - 2); HY_LDA(fa1[3], q - 1);
        HY_LOAD_E(fa0, fb0, d1max, q); HY_LOAD_L(fa0, q);
        int d1 = d1max;
        for (int it = 0; it < 47; ++it) {
            HY_LOAD_E(fa1, fb1, d1 - 1, q + 4);
            HY_MMA1(fa0, fb0, fa1);
            HY_LOAD_L(fa1, q + 4);
            HY_MMA2(fa0, fb0);
            HY_LOAD_E(fa0, fb0, d1 - 2, q + 8);
            HY_MMA1(fa1, fb1, fa0);
            HY_LOAD_L(fa0, q + 8);
            HY_MMA2(fa1, fb1);
            d1 -= 2; q += 8;
        }
        HY_MMA1(fa0, fb0, fa1); HY_MMA2(fa0, fb0);
        }
        if (MK_HY_SWEEPS == 2) { acc0 *= 0.5f; acc1 *= 0.5f; }
        __syncthreads();
#pragma unroll
        for (int mt = 0; mt < 2; ++mt)
#pragma unroll
            for (int g = 0; g < 4; ++g) { const int t0 = 32 * mt + 8 * g + 4 * h; const v2u gwv = gw[mt][g];
                const f32x16& a = mt ? acc1 : acc0;
                const float y0 = a[4 * g] * bflo(gwv.x), y1 = a[4 * g + 1] * bfhi(gwv.x), y2 = a[4 * g + 2] * bflo(gwv.y), y3 = a[4 * g + 3] * bfhi(gwv.y);
                if (o == 0) { v2u w; w.x = pk2(y0, y1); w.y = pk2(y2, y3); *(LAS v2u*)(zl + b * ZB + (32 + t1) * ZROW + t0 * 2) = w; }
                else if (PAIR == 0) { keep[mt][g].x = pk2(y0, y1); keep[mt][g].y = pk2(y2, y3); }
                else { unsigned* yo = (unsigned*)(YH + ((size_t)b * S + t1 * 64 + t0) * C + (c - 1)); const v2u kp = keep[mt][g];
                    yo[0] = (kp.x & 0xffffu) | (f2bf(y0) << 16); yo[C / 2] = (kp.x >> 16) | (f2bf(y1) << 16); yo[C] = (kp.y & 0xffffu) | (f2bf(y2) << 16); yo[3 * C / 2] = (kp.y >> 16) | (f2bf(y3) << 16); } }
    }
    __syncthreads();
}
#undef HY_LDA
#undef HY_LOAD_E
#undef HY_LOAD_L
#undef HY_MMA1
#undef HY_MMA2
}
}
namespace mk {
#define GAS __attribute__((address_space(1)))
typedef GAS unsigned gu32;
typedef GAS unsigned long long gu64;
#define RLX_AGENT __ATOMIC_RELAXED, __HIP_MEMORY_SCOPE_AGENT
#define LDS_WAIT() asm volatile("s_waitcnt lgkmcnt(0)" ::: "memory")
#define VM_WAIT() asm volatile("s_waitcnt vmcnt(0)" ::: "memory")
__device__ __forceinline__ unsigned long long rt() { return __builtin_amdgcn_s_memrealtime(); }
#define XB_TMO      128
#define XB_XCNT(j)  (256  + 64 * (j))
#define XB_XSUB(j)  (1280 + 64 * (j))
#define XB_XGEN(j)  (2304 + 64 * (j))
#define XB_TOP      3328
#define XB_TOPGEN   3392
#define XCD_BAR_WORDS 3456
#define XB_SPIN_CAP (1u << 18)

__device__ __forceinline__ unsigned xb_ld(unsigned* p)              { return __hip_atomic_load(p, __ATOMIC_RELAXED, __HIP_MEMORY_SCOPE_AGENT); }
__device__ __forceinline__ unsigned xb_add(unsigned* p, unsigned v) { return __hip_atomic_fetch_add(p, v, __ATOMIC_RELAXED, __HIP_MEMORY_SCOPE_AGENT); }
__device__ __forceinline__ unsigned xb_xcc_id() { return (unsigned)__builtin_amdgcn_s_getreg((3 << 11) | 20) & 0xFu; }
#define XB_SPIN(cond, bar) do { unsigned _sp = 0; while (cond) { __builtin_amdgcn_s_sleep(1); \
    if ((++_sp & 255u) == 0u) { if (xb_ld(&(bar)[XB_TMO])) break; if (_sp > XB_SPIN_CAP) { atomicAdd(&(bar)[XB_TMO], 1u); break; } } } } while (0)

struct XcdBarrier {
    unsigned* bar; unsigned x;
    volatile LAS unsigned* st;
};

__device__ __forceinline__ XcdBarrier xcd_barrier_post(unsigned* bar, volatile LAS unsigned* st) {
    XcdBarrier b; b.bar = bar; b.x = xb_xcc_id(); b.st = st;
    if (threadIdx.x == 0) (void)xb_add(&bar[XB_XCNT(b.x)], 1u);
    return b;
}
__device__ __forceinline__ void xcd_barrier_complete(unsigned* bar, unsigned x, unsigned& nloc, unsigned& nx) {
    const unsigned G = gridDim.x * gridDim.y * gridDim.z;
    unsigned sum, cnt, mine, sp = 0u;
    for (;;) {
        sum = 0u; cnt = 0u; mine = 0u;
#pragma unroll
        for (unsigned j = 0; j < 16; ++j) { const unsigned c = xb_ld(&bar[XB_XCNT(j)]); sum += c; cnt += (c > 0u) ? 1u : 0u; mine = (j == x) ? c : mine; }
        if (sum == G) break;
        __builtin_amdgcn_s_sleep(1);
        if ((++sp & 255u) == 0u) { if (xb_ld(&bar[XB_TMO])) break; if (sp > XB_SPIN_CAP) { atomicAdd(&bar[XB_TMO], 1u); break; } }
    }
    nloc = mine > 0u ? mine : 1u; nx = cnt > 0u ? cnt : 1u;
}

__device__ __forceinline__ void xcd_barrier(const XcdBarrier& b, int wave_s) {
    asm volatile("s_waitcnt vmcnt(0)" ::: "memory");
    __syncthreads();
    if (fresh_tid(wave_s) == 0) {
        unsigned* bar = b.bar;
        __builtin_amdgcn_s_waitcnt(0);
        unsigned nloc = b.st[0], nx = b.st[1];
        if (nloc == 0u) { xcd_barrier_complete(bar, b.x, nloc, nx); b.st[0] = nloc; b.st[1] = nx; }
        const unsigned old = xb_add(&bar[XB_XSUB(b.x)], 1u);
        const unsigned gen = old / nloc;
        if (old + 1u == (gen + 1u) * nloc) {
            __builtin_amdgcn_fence(__ATOMIC_RELEASE, "agent");
            asm volatile("s_waitcnt vmcnt(0)" ::: "memory");
            const unsigned og = xb_add(&bar[XB_TOP], 1u);
            const unsigned tg = og / nx;
            if (og + 1u == (tg + 1u) * nx) xb_add(&bar[XB_TOPGEN], 1u);
            else XB_SPIN(xb_ld(&bar[XB_TOPGEN]) == tg, bar);
            __builtin_amdgcn_fence(__ATOMIC_ACQUIRE, "agent");
            xb_add(&bar[XB_XGEN(b.x)], 1u);
            asm volatile("s_waitcnt vmcnt(0)" ::: "memory");
        } else {
            XB_SPIN(xb_ld(&bar[XB_XGEN(b.x)]) == gen, bar);
            __builtin_amdgcn_fence(__ATOMIC_ACQUIRE, "agent");
            asm volatile("s_waitcnt vmcnt(0)" ::: "memory");
        }
    }
    __syncthreads();
}

}
namespace mk {
namespace cg = cooperative_groups;
constexpr int PH_PER_LAYER = 11, N_PHASES = 1 + 2 * PH_PER_LAYER;

__device__ __forceinline__ float lam_of(const Args& a, int l, float lam_init) {
    const float *q1 = a.in[14] + l * 64, *k1 = a.in[15] + l * 64, *q2 = a.in[16] + l * 64, *k2 = a.in[17] + l * 64;
    float s1 = 0.f, s2 = 0.f; for (int i = 0; i < 64; ++i) { s1 += q1[i] * k1[i]; s2 += q2[i] * k2[i]; }
    return expf(s1) - expf(s2) + lam_init;
}

typedef const __attribute__((address_space(4))) Args* KArgPtr;
__global__ void __launch_bounds__(NTH, 2) fwd(Args a_byval) {
    extern __shared__ __attribute__((aligned(16))) unsigned char lds_raw[];
    cg::grid_group grid = cg::this_grid();
    const int ph_lo = a_byval.ph_lo, ph_hi = a_byval.ph_hi;
    const int wave_s = __builtin_amdgcn_readfirstlane((int)threadIdx.x >> 6);
    volatile LAS unsigned* bar_st = (volatile LAS unsigned*)((LAS unsigned char*)lds_raw + LDS_BYTES - 64);
    if (threadIdx.x == 0) { bar_st[0] = 0u; bar_st[1] = 0u; }
    __syncthreads();
    const XcdBarrier bar = xcd_barrier_post((unsigned*)a_byval.ws, bar_st);
    int rep_flag = 0;
    for (int ph = ph_lo; ph < ph_hi; ++ph) {
        KArgPtr ap = (KArgPtr)__builtin_amdgcn_kernarg_segment_ptr(); asm volatile("" : "+s"(ap));
        const Args a = *(const Args*)ap;
        float* Xr = (float*)(a.ws + WS_X);
        Ctx X; X.wave_s = wave_s; X.wave = wave_s; X.tid = 0; X.lane = 0;
#define FRESH() do { X.tid = fresh_tid(wave_s); X.lane = X.tid & 63; } while (0)
        { int g_ = gridDim.x, b_ = blockIdx.x; asm volatile("" : "+s"(g_), "+s"(b_)); X.G = g_; X.bid = b_; }
        { const int bx = X.bid; X.vcu = (X.G % 8 == 0) ? (bx % 8) * (X.G / 8) + bx / 8 : bx; }
        X.gw = X.vcu * NWAVES + X.wave; X.ngw = X.G * NWAVES; X.lds = (LAS unsigned char*)lds_raw; X.ws = a.ws;
#ifndef MK_EN
#define MK_EN 0xFFFF
#endif
#ifndef MK_ATT
#define MK_ATT 3
#endif
#ifndef MK_REP_SP
#define MK_REP_SP 99
#endif
        if (ph == 0) { if (MK_EN & 512) { FRESH(); p0_prologue(X, a); } }
        else {
            const int l = (ph - 1) / PH_PER_LAYER, sp = (ph - 1) % PH_PER_LAYER;
            const float lam_init = 0.8f - 0.6f * expf(-0.3f * (float)l);
            if (0) {}
#if MK_EN & 1
            else if (sp == 0) {
                FRESH();
                pg8::Gemm g{(const bf16*)(a.ws + WS_XN), (const bf16*)(a.ws + WS_WIN) + (size_t)l * INW * D, T, INW, D};
                pg8::StaticOrder So; So.init(T, INW, X.G, X.bid);
                EpiWin Ep{a.ws, (const float*)(a.ws + WS_BINP) + l * INW, (const float*)(a.ws + WS_ROPE)};
                pg8::gemm_phase<EpiWin, pg8::StaticOrder, true, true>(X.lds, g, So, Ep, X.tid);
            }
#endif
#if MK_EN & 2
            else if (sp == 1) {
                FRESH();
                p1t_shortconv(X, a.in[4] + l * 3 * 1536, a.in[5] + l * 1536);
                p1t_kmax(X, (unsigned*)(a.ws + 14336) + l * 32);
            }
#endif
#if MK_EN & 4
            else if (sp == 2) {
                FRESH();
                const float lam = lam_of(a, l, lam_init);
                const int c = X.bid;
#ifndef MK_REP_ATT
#define MK_REP_ATT 1
#endif
#ifndef MK_CONV_REP
#define MK_CONV_REP 1
#endif
#ifndef MK_REP_HY
#define MK_REP_HY 1
#endif
                const int cg_ = X.vcu & 3;
                if (cg_ == 0) { __syncthreads(); p0_experts(relaunder(X), a, l); if (MK_CONV_REP > 1) { __syncthreads(); p0_experts(relaunder(X), a, l); } __syncthreads(); }
                for (int rep = 0; rep < MK_REP_ATT; ++rep) for (int u = c; u < 256; u += X.G) { const int bh = 2 * (u & 7) + ((u >> 3) >> 4), qb = (u >> 3) & 15; at::attn_unit(X, bh >> 2, bh & 3, qb, lam, 1.0f - lam_init, a.in[18] + l * 128, (unsigned*)(a.ws + 14336) + l * 32); }
                if (cg_ == 1) { __syncthreads(); p0_experts(relaunder(X), a, l); if (MK_CONV_REP > 1) { __syncthreads(); p0_experts(relaunder(X), a, l); } __syncthreads(); }
                for (int rep = 0; rep < MK_REP_HY; ++rep) for (int u = c; u < 256; u += X.G) { const int ch = 64 * (u & 7) + 2 * (u >> 3); v2u keep[2][4]; hy::channel<0>(relaunder(X), l, ch, a.in[13], keep);
                    if (cg_ == 2) { __syncthreads(); p0_experts(relaunder(X), a, l); if (MK_CONV_REP > 1) { __syncthreads(); p0_experts(relaunder(X), a, l); } __syncthreads(); }
                    hy::channel<1>(relaunder(X), l, ch + 1, a.in[13], keep); }
                if (cg_ == 3) { __syncthreads(); p0_experts(relaunder(X), a, l); if (MK_CONV_REP > 1) { __syncthreads(); p0_experts(relaunder(X), a, l); } __syncthreads(); }
            }
#endif
#if MK_EN & 8
            else if (sp == 3) {
                FRESH();
                OrderMerge So; So.so.init(T, D, X.G, X.bid);
                pg8::Gemm g{(const bf16*)(a.ws + WS_YH), (const bf16*)(a.ws + WS_WUH) + (size_t)l * 2 * D * C, 2 * T, 2 * D, C};
                EpiMerge2 Ep{(const bf16*)(a.ws + WS_GH), (const bf16*)(a.ws + WS_GA), (bf16*)(a.ws + WS_T1), (bf16*)(a.ws + WS_MG)};
                pg8::gemm_phase<EpiMerge2, OrderMerge, true, true>(X.lds, g, So, Ep, X.tid);
            }
#endif
#if MK_EN & 16
            else if (sp == 4) {
                FRESH();
                pg8::Gemm g{(const bf16*)(a.ws + WS_MG), (const bf16*)(a.ws + WS_WOUT) + (size_t)l * D * D, T, D, D};
                pg8::StaticOrder So; So.init(T, D, X.G, X.bid);
                EpiOut Ep{l == 0 ? a.in[0] : Xr, Xr};
                pg8::gemm_phase<EpiOut, pg8::StaticOrder, true, true>(X.lds, g, So, Ep, X.tid);
            }
#endif
#if MK_EN & 32
            else if (sp == 5) {
                FRESH();
                p5_norm_router(X, Xr, a.in[22] + l * D, a.in[23] + (size_t)l * D * E, a.in[24] + l * E);
            } else if (sp == 6) { FRESH(); p6_topk(X);
            } else if (sp == 7) { FRESH(); p6_gather(X);
            }
#endif
#if MK_EN & 64
            else if (sp == 8) {
                FRESH();
                pg8::Gemm g{(const bf16*)(a.ws + WS_XG), (const bf16*)(a.ws + WS_WGU) + (size_t)l * E * 2 * F * D, E * 2048, 2 * F, D};
                OrderMoE1 So{X.G, X.bid}; EpiSwiGLU Ep{(bf16*)(a.ws + WS_HB)};
                pg8::gemm_phase<EpiSwiGLU, OrderMoE1, true, true>(X.lds, g, So, Ep, X.tid);
            }
#endif
#if MK_EN & 128
            else if (sp == 9) {
                FRESH();
                pg8::Gemm g{(const bf16*)(a.ws + WS_HB), (const bf16*)(a.ws + WS_WD) + (size_t)l * E * D * F, E * 2048, D, F};
                OrderMoE2 So{X.G, X.bid}; EpiDown Ep{(bf16*)(a.ws + WS_YE), (const float*)(a.ws + WS_GATE)};
                pg8::gemm_phase<EpiDown, OrderMoE2, true, true>(X.lds, g, So, Ep, X.tid);
            }
#endif
#if MK_EN & 256
            else if (sp == 10) {
                FRESH();
                p9_combine(X, Xr, l == 0 ? a.in[1] + D : a.in[28], l == 1, a.out);
            }
#endif
        }
#ifndef MK_EXTRA_SYNC
#define MK_EXTRA_SYNC 0
#endif
        if (ph + 1 < ph_hi) { if (ph_hi > 4096) grid.sync(); else xcd_barrier(bar, wave_s); }
        for (int es = 0; es < MK_EXTRA_SYNC; ++es) xcd_barrier(bar, wave_s);
        if (MK_REP_SP != 99) { const int sp_ = ph == 0 ? -1 : (ph - 1) % PH_PER_LAYER; if (sp_ == MK_REP_SP && rep_flag == 0) { rep_flag = 1; --ph; } else rep_flag = 0; }
    }
}

static int g_grid = 0;
static bool mega_setup() {
    if (g_grid) return g_grid > 0;
    int dev = 0, cus = 0, per_cu = 0;
    if (hipGetDevice(&dev) != hipSuccess || hipDeviceGetAttribute(&cus, hipDeviceAttributeMultiprocessorCount, dev) != hipSuccess) { g_grid = -1; return false; }
    if (hipFuncSetAttribute((const void*)fwd, hipFuncAttributeMaxDynamicSharedMemorySize, LDS_BYTES) != hipSuccess) { fprintf(stderr, "hipFuncSetAttribute failed\n"); g_grid = -1; return false; }
    if (hipOccupancyMaxActiveBlocksPerMultiprocessor(&per_cu, (const void*)fwd, NTH, LDS_BYTES) != hipSuccess || per_cu < 1) { fprintf(stderr, "occupancy query failed (%d)\n", per_cu); g_grid = -1; return false; }
    g_grid = cus * 1;
    return true;
}
static void mega_launch(hipStream_t st, void* const* d_in, float* d_out, unsigned char* ws, int ph_lo, int ph_hi, int p0_mask) {
    if (!mega_setup()) return;
    Args a{};
    for (int i = 0; i < 29; ++i) a.in[i] = (const float*)d_in[i];
    a.out = d_out; a.ws = ws; a.ph_lo = ph_lo; a.ph_hi = ph_hi; a.p0_mask = p0_mask; a.pad = 0;
    if (hipMemsetAsync(ws, 0, 16384, st) != hipSuccess) { fprintf(stderr, "memset of the barrier words failed\n"); return; }
    void* args[] = {&a};
    const hipError_t e = hipLaunchCooperativeKernel((const void*)fwd, dim3(g_grid), dim3(NTH), args, LDS_BYTES, st);
    if (e != hipSuccess) fprintf(stderr, "cooperative launch failed: %s (grid %d)\n", hipGetErrorString(e), g_grid);
}
}
extern "C" void kernel_launch(void* const* d_in, const int* in_sizes, int n_in, void* d_out, int out_size, void* d_ws, size_t ws_size, hipStream_t stream) {
    if (n_in != 29 || out_size != mk::T * mk::D || ws_size < mk::WS_END) { fprintf(stderr, "kernel_launch: unexpected sizes n_in %d out %d ws %zu\n", n_in, out_size, ws_size); return; }
    mk::mega_launch(stream, d_in, (float*)d_out, (unsigned char*)d_ws, 0, mk::N_PHASES, 13);
}
```

```cpp
#include <hip/hip_runtime.h>
#include <hip/hip_cooperative_groups.h>
#include <cstdio>
#include <cstdint>
#include <cmath>
namespace tk {
constexpr int S = 4096, E = 16, CAP = 512, NT = 512;
__device__ __forceinline__ void topk_problem(const float* __restrict__ aff, int tokbase, int e, int slotbase, int* __restrict__ rows, float* __restrict__ gate, int* __restrict__ inv, int* sm, int tid) {
    const int lane = tid & 63, wid = tid >> 6;
    int* hist = sm; int* ctl = sm + 256;
    unsigned key[8];
    { const uint4 a = ((const uint4*)aff)[tid * 2], b = ((const uint4*)aff)[tid * 2 + 1];
      key[0] = a.x; key[1] = a.y; key[2] = a.z; key[3] = a.w; key[4] = b.x; key[5] = b.y; key[6] = b.z; key[7] = b.w; }
    unsigned prefix = 0u, mask = 0u; int kth = CAP;
    for (int pass = 3; pass >= 0; --pass) {
        __syncthreads();
        if (tid < 256) hist[tid] = 0;
        __syncthreads();
#pragma unroll
        for (int i = 0; i < 8; ++i) if ((key[i] & mask) == prefix) atomicAdd(&hist[(key[i] >> (8 * pass)) & 255u], 1);
        __syncthreads();
        if (tid < 64) {
            const int b0 = hist[4 * lane], b1 = hist[4 * lane + 1], b2 = hist[4 * lane + 2], b3 = hist[4 * lane + 3];
            const int tot = b0 + b1 + b2 + b3;
            int suf = tot;
#pragma unroll
            for (int o = 1; o < 64; o <<= 1) { const int v = __builtin_amdgcn_ds_bpermute(((lane + o) & 63) << 2, suf); if (lane + o < 64) suf += v; }
            const int above = suf - tot;
            if (above < kth && kth <= above + tot) {
                int cum = above, bin, k2;
                if (cum + b3 >= kth) { bin = 4 * lane + 3; k2 = kth - cum; }
                else { cum += b3; if (cum + b2 >= kth) { bin = 4 * lane + 2; k2 = kth - cum; }
                else { cum += b2; if (cum + b1 >= kth) { bin = 4 * lane + 1; k2 = kth - cum; }
                else { cum += b1; bin = 4 * lane; k2 = kth - cum; } } }
                ctl[0] = bin; ctl[1] = k2;
            }
        }
        __syncthreads();
        prefix |= ((unsigned)ctl[0]) << (8 * pass); mask |= 0xFFu << (8 * pass); kth = ctl[1];
    }
    const unsigned thr = prefix; const int need_eq = kth; const int n_gt = CAP - need_eq;
    int cg = 0, ce = 0;
#pragma unroll
    for (int i = 0; i < 8; ++i) { cg += key[i] > thr; ce += key[i] == thr; }
    int sg = cg, se = ce;
#pragma unroll
    for (int o = 1; o < 64; o <<= 1) { const int a = __builtin_amdgcn_ds_bpermute(((lane - o) & 63) << 2, sg), b = __builtin_amdgcn_ds_bpermute(((lane - o) & 63) << 2, se); if (lane >= o) { sg += a; se += b; } }
    __syncthreads();
    if (lane == 63) { ctl[8 + wid] = sg; ctl[16 + wid] = se; }
    __syncthreads();
    int og = sg - cg, oe = se - ce;
    for (int w = 0; w < wid; ++w) { og += ctl[8 + w]; oe += ctl[16 + w]; }
#pragma unroll
    for (int i = 0; i < 8; ++i) {
        const int idx = tid * 8 + i; int slot = -1;
        if (key[i] > thr) slot = og++;
        else if (key[i] == thr) { if (oe < need_eq) slot = n_gt + oe; ++oe; }
        if (slot >= 0) { rows[slot] = tokbase + idx; gate[slot] = __uint_as_float(key[i]); }
        inv[(size_t)(tokbase + idx) * E + e] = slot >= 0 ? slotbase + slot : -1;
    }
    __syncthreads();
}
}
namespace pg8 {
#define PG8_LAS __attribute__((address_space(3)))
typedef unsigned short bf16_t;
typedef short bf16x8 __attribute__((ext_vector_type(8)));
typedef float f32x4 __attribute__((ext_vector_type(4)));
typedef unsigned u32x4 __attribute__((ext_vector_type(4)));
typedef short s16x4 __attribute__((ext_vector_type(4)));
constexpr int BM = 256, BK = 64, HALF = 128, HTB = HALF * BK * 2  , STAGE_BYTES = 8 * HTB, NXCD = 8, WGM = 8;

__host__ __device__ __forceinline__ int lds_byte(int r, int c) { const int st = (r >> 4) * 2 + (c >> 5), rr = r & 15, cc = c & 31, ob = rr * 64 + cc * 2; return st * 1024 + (ob ^ (((ob >> 9) & 1) << 5)); }
__host__ __device__ __forceinline__ void stage_rc(int b, int& R, int& C) { const int st = b / 1024, sb = b % 1024, swz = sb ^ (((sb >> 9) & 1) << 5); R = (st >> 1) * 16 + swz / 64; C = (st & 1) * 32 + (swz % 64) / 2; }
__host__ __device__ __forceinline__ int perm32(int rho) { const int n = rho >> 4, i = rho & 15; return 8 * (i >> 2) + 4 * n + (i & 3); }

struct Unit { int pm, pn, pb, pa; };
struct Gemm { const bf16_t* A; const bf16_t* Bt; int M, N, K; int bN = 0, bsh = 0; size_t bes = 0; };

struct StaticOrder {
    int nM, nN, nwg, G, c;
    __host__ __device__ void init(int M, int N, int G_, int c_) { nM = M / BM; nN = N / BM; nwg = nM * nN; G = G_; c = c_; }
    __host__ __device__ bool next(int i, Unit& u) const {
        const long L = (long)i * G + c; if (L >= nwg) return false;
        int wgid = (int)L; { const int q = nwg / NXCD, r = nwg % NXCD, xcd = wgid % NXCD, off = wgid / NXCD; wgid = (xcd < r ? xcd * (q + 1) : r * (q + 1) + (xcd - r) * q) + off; }
        const int nig = WGM * nN, gid = wgid / nig, fm = gid * WGM, gsz = (nM - fm) < WGM ? (nM - fm) : WGM;
        u.pm = fm + ((wgid % nig) % gsz); u.pn = (wgid % nig) / gsz; u.pb = u.pn; u.pa = u.pm; return true;
    }
    __device__ __forceinline__ void a_ready(const Unit&) const {}
    __device__ __forceinline__ void done(const Unit&) const {}
};

template <class Epi, class Sched, bool ALIGN_EPI = false, bool SP2 = false, bool BT = false>
__device__ __forceinline__ void gemm_phase(PG8_LAS unsigned char* lds, const Gemm g, const Sched& S, const Epi& E, int tid) {
    asm volatile("" : "+v"(tid));
    const int wid = __builtin_amdgcn_readfirstlane(tid >> 6), lane = tid & 63, wr = wid >> 2, wc = wid & 3, fr = lane & 15, fq = lane >> 4;
    const int K = g.K, nt = K / BK;
    unsigned voffA[2], voffB[2];
#pragma unroll
    for (int i = 0; i < 2; ++i) { int R, C; stage_rc(tid * 16 + i * 8192, R, C); const int Rb = Epi::PERM ? ((R & ~31) + perm32(R & 31)) : R;
        voffA[i] = (unsigned)(R * K + C) * 2u; voffB[i] = (unsigned)(Rb * K + C) * 2u;
        if constexpr (BT) { const int p = i * 512 + tid, row = ((p >> 7) << 3) | ((p >> 2) & 7), ch = (((p >> 5) & 3) << 2) | ((p & 3) ^ ((row >> 2) & 3));
            voffB[i] = (unsigned)(row * g.bN + 8 * ch) * 2u; } }
    const size_t kstep = (size_t)(BK * 2);
    const size_t hstep = (size_t)HALF * K * 2;
    const size_t tstep = 2 * hstep;
    const size_t kstepB = BT ? (size_t)BK * g.bN * 2 : kstep, hstepB = BT ? (size_t)HALF * 2 : hstep;
#define PG8_BBASE(pb) ((const char*)g.Bt + (BT ? (size_t)((pb) >> g.bsh) * g.bes + (size_t)((pb) & ((1 << g.bsh) - 1)) * 512 : (size_t)(pb) * tstep))
    const unsigned ldsw = (unsigned)wid * 1024u;
    const int aoff = lds_byte(wr * 64 + fr, fq * 8), boff = lds_byte(wc * 32 + fr, fq * 8);
    int tr0 = 0, tr1 = 0;
    if constexpr (BT) { static_assert(Epi::PERM, "BT needs the PERM column order"); const int q_ = (lane >> 2) & 3, p_ = lane & 3, f1_ = fq & 1;
        const int L_ = (int)(size_t)lds + 2048 * fq + 512 * wc + 64 * q_ + 32 * ((p_ >> 1) ^ f1_); tr0 = L_ + 16 * (p_ & 1); tr1 = L_ + 256 + 16 * (1 - (p_ & 1)); }
#define PG8_SA(b, h) (((b) * 2 + (h)) * HTB)
#define PG8_SB(b, h) ((4 + (b) * 2 + (h)) * HTB)
#define PG8_STAGE(bufoff, gbase, voff) do { _Pragma("unroll") for (int _i = 0; _i < 2; ++_i) \
        __builtin_amdgcn_global_load_lds((const unsigned*)((const char*)(gbase) + (voff)[_i]), (PG8_LAS unsigned*)(lds + (bufoff) + ldsw + _i * 8192), 16, 0, 0); } while (0)
#define PG8_LDA(dst, b, h) do { _Pragma("unroll") for (int m = 0; m < 4; ++m) _Pragma("unroll") for (int k = 0; k < 2; ++k) dst[m][k] = *(const PG8_LAS bf16x8*)(lds + PG8_SA(b, h) + aoff + m * 2048 + k * 1024); } while (0)
#define PG8_TR(dst4, addr, OFF) asm volatile("ds_read_b64_tr_b16 %0, %1 offset:%2" : "=&v"(dst4) : "v"(addr), "i"(OFF) : "memory")
#define PG8_TRF(dst8, a0, a1, OFF) do { s16x4 lo_, hi_; PG8_TR(lo_, a0, OFF); PG8_TR(hi_, a1, OFF); dst8 = __builtin_shufflevector(lo_, hi_, 0, 1, 2, 3, 4, 5, 6, 7); } while (0)
#define PG8_LDB(dst, b, h) do { if constexpr (BT) { const int a0_ = tr0 + PG8_SB(b, h), a1_ = tr1 + PG8_SB(b, h); \
        PG8_TRF(dst[0][0], a0_, a1_, 0); PG8_TRF(dst[0][1], a0_, a1_, 8192); PG8_TRF(dst[1][0], a0_, a1_, 8); PG8_TRF(dst[1][1], a0_, a1_, 8200); } else { \
    _Pragma("unroll") for (int n = 0; n < 2; ++n) _Pragma("unroll") for (int k = 0; k < 2; ++k) dst[n][k] = *(const PG8_LAS bf16x8*)(lds + PG8_SB(b, h) + boff + n * 2048 + k * 1024); } } while (0)
#define PG8_MMA(ai, bj, At, Bt) do { __builtin_amdgcn_s_setprio(1); _Pragma("unroll") for (int m = 0; m < 4; ++m) _Pragma("unroll") for (int n = 0; n < 2; ++n) _Pragma("unroll") for (int k = 0; k < 2; ++k) \
        acc[ai][bj][m][n] = __builtin_amdgcn_mfma_f32_16x16x32_bf16(Bt[n][k], At[m][k], acc[ai][bj][m][n], 0, 0, 0); __builtin_amdgcn_s_setprio(0); } while (0)
#define PG8_WAIT_V(n) asm volatile("s_waitcnt vmcnt(" #n ")" ::: "memory")
#define PG8_WAIT_L(n) asm volatile("s_waitcnt lgkmcnt(" #n ")" ::: "memory")
#define PG8_BAR __builtin_amdgcn_s_barrier()
#define PG8_SCHED __builtin_amdgcn_sched_barrier(0)
    Unit cur, nxt; int ui = 0;
    if (!S.next(0, cur)) return;
    f32x4 acc[2][2][4][2];
#pragma unroll
    for (int a = 0; a < 2; ++a)
#pragma unroll
        for (int b = 0; b < 2; ++b)
#pragma unroll
            for (int m = 0; m < 4; ++m)
#pragma unroll
                for (int n = 0; n < 2; ++n) acc[a][b][m][n] = (f32x4){0.f, 0.f, 0.f, 0.f};
    bf16x8 At[4][2], B0[2][2], B1[2][2];
    const char* cA = (const char*)g.A + (size_t)cur.pa * tstep; const char* cB = PG8_BBASE(cur.pb);
    S.a_ready(cur);
    if constexpr (SP2) {
        PG8_STAGE(PG8_SB(0, 0), cB, voffB); PG8_STAGE(PG8_SB(0, 1), cB + hstepB, voffB); PG8_STAGE(PG8_SA(0, 0), cA, voffA); PG8_STAGE(PG8_SA(0, 1), cA + hstep, voffA);
        if (wr == 1) PG8_BAR;
        PG8_WAIT_V(2); PG8_BAR;
        PG8_STAGE(PG8_SB(1, 0), cB + kstepB, voffB); PG8_STAGE(PG8_SA(1, 0), cA + kstep, voffA); PG8_STAGE(PG8_SB(1, 1), cB + hstepB + kstepB, voffB);
        PG8_WAIT_V(6); PG8_BAR;
    } else {
        PG8_STAGE(PG8_SB(0, 0), cB, voffB); PG8_STAGE(PG8_SA(0, 0), cA, voffA); PG8_STAGE(PG8_SB(0, 1), cB + hstepB, voffB); PG8_STAGE(PG8_SA(0, 1), cA + hstep, voffA);
        if (wr == 1) PG8_BAR;
        PG8_WAIT_V(4); PG8_BAR;
        PG8_STAGE(PG8_SB(1, 0), cB + kstepB, voffB); PG8_STAGE(PG8_SA(1, 0), cA + kstep, voffA); PG8_STAGE(PG8_SB(1, 1), cB + hstepB + kstepB, voffB);
        PG8_WAIT_V(6); PG8_BAR;
    }
    for (;;) {
        const bool has_next = S.next(ui + 1, nxt);
        const char* nA = has_next ? (const char*)g.A + (size_t)nxt.pa * tstep : cA; const char* nB = has_next ? PG8_BBASE(nxt.pb) : cB;
        for (int t = 0; t < nt; t += 2) {
            const bool last = (t == nt - 2);
            const char* a1 = cA + (size_t)(t + 1) * kstep;
            const char* a2 = last ? nA : cA + (size_t)(t + 2) * kstep; const char* b2 = last ? nB : cB + (size_t)(t + 2) * kstepB;
            const char* a3 = a2 + kstep; const char* b3 = b2 + kstepB;
            if (last && has_next) S.a_ready(nxt);
            if constexpr (SP2) {
            PG8_LDB(B0, 0, 0); PG8_LDB(B1, 0, 1); PG8_SCHED; PG8_LDA(At, 0, 0); PG8_STAGE(PG8_SA(1, 1), a1 + hstep, voffA);
            PG8_WAIT_V(8); PG8_WAIT_L(0); PG8_BAR; PG8_MMA(0, 0, At, B0); PG8_MMA(0, 1, At, B1); PG8_BAR; PG8_SCHED;
            PG8_LDA(At, 0, 1); PG8_STAGE(PG8_SB(0, 0), b2, voffB); PG8_STAGE(PG8_SB(0, 1), b2 + hstepB, voffB); PG8_STAGE(PG8_SA(0, 0), a2, voffA);
            PG8_WAIT_V(8); PG8_WAIT_L(0); PG8_BAR; PG8_MMA(1, 0, At, B0); PG8_MMA(1, 1, At, B1); PG8_BAR; PG8_SCHED;
            PG8_LDB(B0, 1, 0); PG8_LDB(B1, 1, 1); PG8_SCHED; PG8_LDA(At, 1, 0); PG8_STAGE(PG8_SA(0, 1), a2 + hstep, voffA);
            PG8_WAIT_V(8); PG8_WAIT_L(0); PG8_BAR; PG8_MMA(0, 0, At, B0); PG8_MMA(0, 1, At, B1); PG8_BAR; PG8_SCHED;
            PG8_LDA(At, 1, 1); PG8_STAGE(PG8_SB(1, 0), b3, voffB); PG8_STAGE(PG8_SB(1, 1), b3 + hstepB, voffB); PG8_STAGE(PG8_SA(1, 0), a3, voffA);
            PG8_WAIT_V(8); PG8_WAIT_L(0); PG8_BAR; PG8_MMA(1, 0, At, B0); PG8_MMA(1, 1, At, B1); PG8_BAR; PG8_SCHED;
            } else {
            PG8_LDB(B0, 0, 0); PG8_SCHED; PG8_LDA(At, 0, 0); PG8_STAGE(PG8_SA(1, 1), a1 + hstep, voffA);
            PG8_WAIT_L(8); PG8_BAR; PG8_WAIT_L(0); PG8_MMA(0, 0, At, B0); PG8_BAR; PG8_SCHED;
            PG8_LDB(B1, 0, 1); PG8_STAGE(PG8_SB(0, 0), b2, voffB);
            PG8_BAR; PG8_WAIT_L(0); PG8_MMA(0, 1, At, B1); PG8_BAR;
            PG8_LDA(At, 0, 1); PG8_STAGE(PG8_SA(0, 0), a2, voffA);
            PG8_BAR; PG8_WAIT_L(0); PG8_MMA(1, 0, At, B0); PG8_BAR; PG8_SCHED;
            PG8_STAGE(PG8_SB(0, 1), b2 + hstepB, voffB);
            PG8_WAIT_V(6); PG8_BAR; PG8_MMA(1, 1, At, B1); PG8_BAR;
            PG8_LDB(B0, 1, 0); PG8_SCHED; PG8_LDA(At, 1, 0); PG8_STAGE(PG8_SA(0, 1), a2 + hstep, voffA);
            PG8_WAIT_L(8); PG8_BAR; PG8_WAIT_L(0); PG8_MMA(0, 0, At, B0); PG8_BAR; PG8_SCHED;
            PG8_LDB(B1, 1, 1); PG8_STAGE(PG8_SB(1, 0), b3, voffB);
            PG8_BAR; PG8_WAIT_L(0); PG8_MMA(0, 1, At, B1); PG8_BAR;
            PG8_LDA(At, 1, 1); PG8_STAGE(PG8_SA(1, 0), a3, voffA);
            PG8_BAR; PG8_WAIT_L(0); PG8_MMA(1, 0, At, B0); PG8_BAR; PG8_SCHED;
            PG8_STAGE(PG8_SB(1, 1), b3 + hstepB, voffB);
            PG8_WAIT_V(6); PG8_BAR; PG8_MMA(1, 1, At, B1); PG8_BAR;
            }
        }
        if constexpr (ALIGN_EPI) { if (wr == 0) PG8_BAR; }
        if constexpr (!Epi::AFTER_DRAIN) { E(acc, cur, wr, wc, fr, fq); S.done(cur); }
        if (!has_next) break;
#pragma unroll
        for (int a = 0; a < 2; ++a)
#pragma unroll
            for (int b = 0; b < 2; ++b)
#pragma unroll
                for (int m = 0; m < 4; ++m)
#pragma unroll
                    for (int n = 0; n < 2; ++n) acc[a][b][m][n] = (f32x4){0.f, 0.f, 0.f, 0.f};
        cur = nxt; cA = nA; cB = nB; ++ui;
        if constexpr (ALIGN_EPI) { if (wr == 1) PG8_BAR; }
    }
    PG8_WAIT_V(0);
    if constexpr (!ALIGN_EPI) { if (wr == 0) PG8_BAR; }
    PG8_BAR;
    if constexpr (Epi::AFTER_DRAIN) { E.fused(acc, cur, wr, wc, fr, fq, lds, wid, lane); S.done(cur); }
#undef PG8_SA
#undef PG8_SB
#undef PG8_STAGE
#undef PG8_LDA
#undef PG8_LDB
#undef PG8_TR
#undef PG8_TRF
#undef PG8_BBASE
#undef PG8_MMA
#undef PG8_WAIT_V
#undef PG8_WAIT_L
#undef PG8_BAR
#undef PG8_SCHED
}
}

namespace mk {
constexpr int D = 1024, B = 4, S = 4096, T = B * S, C = 512, INW = 5120, E = 16, CAP = 512, F = 2048, NTH = 512, NWAVES = 8;
typedef unsigned short bf16;
#define LAS __attribute__((address_space(3)))
typedef unsigned v4u __attribute__((ext_vector_type(4)));
typedef unsigned v2u __attribute__((ext_vector_type(2)));
typedef float f32x4 __attribute__((ext_vector_type(4)));
typedef short bf16x8 __attribute__((ext_vector_type(8)));
typedef float f32x16 __attribute__((ext_vector_type(16)));
typedef short s16x4 __attribute__((ext_vector_type(4)));

constexpr size_t MiB = 1u << 20;
constexpr size_t WS_WIN = 2 * MiB;
constexpr size_t WS_WUH = 22 * MiB;
constexpr size_t WS_WUA = 23 * MiB;
constexpr size_t WS_WOUT = 26 * MiB;
constexpr size_t WS_BINP = 30 * MiB;
constexpr size_t WS_ROPE = 31 * MiB;
constexpr size_t WS_AFFT = 32 * MiB;
constexpr size_t WS_INV = 33 * MiB;
constexpr size_t WS_ROWS = 34 * MiB;
constexpr size_t WS_GATE = 34 * MiB + 512 * 1024;
constexpr size_t WS_FILT = 36 * MiB;
constexpr size_t WS_X = 68 * MiB;
constexpr size_t WS_XN = 132 * MiB;
constexpr size_t WS_SH = 164 * MiB;
constexpr size_t WS_U = WS_SH;
constexpr size_t WS_UCT = WS_SH + 48 * MiB;
constexpr size_t WS_Q = WS_SH + 96 * MiB;
constexpr size_t WS_K = WS_SH + 112 * MiB;
constexpr size_t WS_V = WS_SH + 128 * MiB;
constexpr size_t WS_GH = WS_SH + 144 * MiB;
constexpr size_t WS_GA = WS_SH + 176 * MiB;
constexpr size_t WS_YH = WS_SH + 208 * MiB;
constexpr size_t WS_YA = WS_SH + 224 * MiB;
constexpr size_t WS_T1 = WS_U;
constexpr size_t WS_MG = WS_UCT;
constexpr size_t WS_XG = WS_SH;
constexpr size_t WS_HB = WS_SH + 64 * MiB;
constexpr size_t WS_YE = WS_SH + 192 * MiB;
constexpr size_t WS_WGU = 420 * MiB;
constexpr size_t WS_WD = 676 * MiB;
constexpr size_t WS_END = 804 * MiB;

constexpr int LDS_BYTES = 155648;
constexpr float QSCALE = 0.125f * 1.4426950408889634f;

struct Args {
    const float* in[29]; float* out; unsigned char* ws; int ph_lo, ph_hi; int p0_mask, pad;
};

__device__ __forceinline__ unsigned f2bf(float f) { unsigned u = __builtin_bit_cast(unsigned, f); return (u + 0x7fffu + ((u >> 16) & 1u)) >> 16; }
__device__ __forceinline__ unsigned pk2(float lo, float hi) { return f2bf(lo) | (f2bf(hi) << 16); }
__device__ __forceinline__ float bf2f(unsigned h) { return __builtin_bit_cast(float, h << 16); }
__device__ __forceinline__ float bflo(unsigned w) { return __builtin_bit_cast(float, w << 16); }
__device__ __forceinline__ float bfhi(unsigned w) { return __builtin_bit_cast(float, w & 0xffff0000u); }
template <int O> __device__ __forceinline__ float xor_f(float v) { return __builtin_bit_cast(float, __builtin_amdgcn_ds_swizzle(__builtin_bit_cast(int, v), (O << 10) | 0x1f)); }
__device__ __forceinline__ float wave_sum(float v) { v += xor_f<1>(v); v += xor_f<2>(v); v += xor_f<4>(v); v += xor_f<8>(v); v += xor_f<16>(v);
    const int b = __builtin_bit_cast(int, v); return __builtin_bit_cast(float, __builtin_amdgcn_readlane(b, 0)) + __builtin_bit_cast(float, __builtin_amdgcn_readlane(b, 32)); }

__device__ __forceinline__ float sigm(float x) { return 1.f / (1.f + __expf(-x)); }

struct Ctx { int tid, lane, wave, gw, ngw, vcu, G, bid, wave_s; LAS unsigned char* lds; unsigned char* ws; };

__device__ __forceinline__ int fresh_tid(int wave_s) { int l; asm volatile("v_mbcnt_lo_u32_b32 %0, -1, 0\n\tv_mbcnt_hi_u32_b32 %0, -1, %0" : "=v"(l)); return (wave_s << 6) | l; }
__device__ __forceinline__ Ctx relaunder(const Ctx& X) { Ctx Y = X; const int t = fresh_tid(X.wave_s); Y.tid = t; Y.lane = t & 63; return Y; }

template <int MAP> __device__ __forceinline__ int rowmap(int n) {
    if (MAP == 1) {
        if (n < 1536 || n >= 2560) return n;
        const int hb = (n - 1536) & ~63, d = (n - 1536) & 63, i = (d & 31) >> 2, j = d & 3;
        return 1536 + hb + 8 * i + ((d >> 5) << 2) + j;
    }
    if (MAP == 2) return ((n >> 7) << 8) + (n & 127);
    if (MAP == 3) return ((n >> 7) << 8) + 128 + (n & 127);
    return n;
}
__device__ __forceinline__ unsigned cvtpk_(float lo, float hi) { unsigned r; asm volatile("v_cvt_pk_bf16_f32 %0, %1, %2" : "=v"(r) : "v"(lo), "v"(hi)); return r; }
struct TrItem { const float* src; bf16* dst; };
template <int MAP> __device__ __forceinline__ void p0_transpose(const Ctx& X, const float* W, int K, int N, bf16* WT, int nmat, size_t sstride, size_t dstride) {
    LAS float* scr = (LAS float*)(X.lds + X.wave * 16640);
    const int nblk = N / 64, per = (K / 64) * nblk, tot = per * nmat, lane = X.lane;
    const int nq = lane & 15, kr = lane >> 4, c = lane & 7, nsub = lane >> 3;
    f32x4 v[16];
    int it = X.gw;
#define TR_SRC(it_) (W + (size_t)((it_) / per) * sstride + (size_t)(64 * (((it_) % per) / nblk) + kr) * N + 64 * (((it_) % per) % nblk) + 4 * nq)
    if (it < tot) { const float* s = TR_SRC(it);
#pragma unroll
        for (int i = 0; i < 16; ++i) v[i] = __builtin_nontemporal_load((const f32x4*)(s + (size_t)(4 * i) * N)); }
    while (it < tot) {
#pragma unroll
        for (int i = 0; i < 16; ++i) { LAS float* d = scr + (4 * i + kr) * 65 + 4 * nq; d[0] = v[i][0]; d[1] = v[i][1]; d[2] = v[i][2]; d[3] = v[i][3]; }
        const int nit = it + X.ngw;
        if (nit < tot) { const float* s = TR_SRC(nit);
#pragma unroll
            for (int i = 0; i < 16; ++i) v[i] = __builtin_nontemporal_load((const f32x4*)(s + (size_t)(4 * i) * N)); }
        asm volatile("s_waitcnt lgkmcnt(0)" ::: "memory");
        const int m = it / per, r = it - m * per, k0 = 64 * (r / nblk), n0 = 64 * (r % nblk);
        bf16* dst = WT + (size_t)m * dstride;
#pragma unroll
        for (int j = 0; j < 8; ++j) { const int n = nsub + 8 * j; const LAS float* s = scr + (8 * c) * 65 + n;
            v4u o; o.x = cvtpk_(s[0 * 65], s[1 * 65]); o.y = cvtpk_(s[2 * 65], s[3 * 65]); o.z = cvtpk_(s[4 * 65], s[5 * 65]); o.w = cvtpk_(s[6 * 65], s[7 * 65]);
            __builtin_nontemporal_store(o, (v4u*)(dst + (size_t)rowmap<MAP>(n0 + n) * K + k0 + 8 * c)); }
        asm volatile("s_waitcnt lgkmcnt(0)" ::: "memory");
        it = nit;
    }
#undef TR_SRC
}
struct Row8 { f32x4 a[2][2]; };
__device__ __forceinline__ void row8_load(Row8& r, const float* p, int lane) {
#pragma unroll
    for (int j = 0; j < 2; ++j) { const f32x4* q = (const f32x4*)p + 2 * (lane + 64 * j); r.a[j][0] = q[0]; r.a[j][1] = q[1]; }
}
__device__ __forceinline__ float row8_sumsq(const Row8& r) {
    float s = 0.f;
#pragma unroll
    for (int j = 0; j < 2; ++j)
#pragma unroll
        for (int h = 0; h < 2; ++h) s += (r.a[j][h].x * r.a[j][h].x + r.a[j][h].y * r.a[j][h].y) + (r.a[j][h].z * r.a[j][h].z + r.a[j][h].w * r.a[j][h].w);
    return s;
}
__device__ __forceinline__ void rms_row_to_bf16(const float* __restrict__ xrow, const float* __restrict__ g, bf16* __restrict__ orow, int lane) {
    const f32x4* xr = (const f32x4*)xrow + lane; f32x4 v[4]; float s = 0.f;
#pragma unroll
    for (int j = 0; j < 4; ++j) { v[j] = xr[64 * j]; s += (v[j].x * v[j].x + v[j].y * v[j].y) + (v[j].z * v[j].z + v[j].w * v[j].w); }
    const float r = rsqrtf(wave_sum(s) * (1.f / D) + 1e-6f);
    v2u* o8 = (v2u*)orow + lane;
#pragma unroll
    for (int j = 0; j < 4; ++j) { const f32x4 gg = ((const f32x4*)g)[lane + 64 * j]; v2u w; w.x = pk2(v[j].x * r * gg.x, v[j].y * r * gg.y); w.y = pk2(v[j].z * r * gg.z, v[j].w * r * gg.w); o8[64 * j] = w; }
}
__device__ __forceinline__ void p0_filters(const Ctx& X, const Args& a) {
    LAS float* z = (LAS float*)X.lds;
    LAS float* h1 = z + 32 * 36;
    LAS float* h2T = h1 + 32 * 64;
    LAS float* w1s = h2T + 64 * 32;
    LAS float* w2s = w1s + 33 * 64;
    bf16* FILT = (bf16*)(X.ws + WS_FILT);
    const int tid = X.tid, j = tid & 63, tq = tid >> 6;
    const float min_decay = logf(1e-2f) / 0.3f, max_decay = logf(1e-2f) / 1.5f;
    for (int it = X.bid; it < 2 * (S / 32); it += X.G) {
        const int l = it / (S / 32), t0 = (it % (S / 32)) * 32;
        const float *w1 = a.in[6] + l * 33 * 64, *b1 = a.in[7] + l * 64, *f1 = a.in[8] + l * 64, *w2 = a.in[9] + l * 64 * 64, *b2 = a.in[10] + l * 64, *f2 = a.in[11] + l * 64, *w3 = a.in[12] + (size_t)l * 64 * 2048;
        __syncthreads();
        for (int e = tid; e < 33 * 64; e += NTH) w1s[e] = w1[e];
        for (int e = tid; e < 64 * 64; e += NTH) w2s[e] = w2[e];
        for (int e = tid; e < 32 * 33; e += NTH) { const int tt = e / 33, jj0 = e - tt * 33, t = t0 + tt; float v;
            if (jj0 == 0) v = (float)t / (float)(S - 1);
            else { const int jj = (jj0 - 1) & 15; const float w = 2.0f * 3.14159265358979323846f * (float)t / (float)S; const float fr = 1e-4f + (float)jj * ((15.0f - 1e-4f) / 15.0f); const float ang = w * fr; v = (jj0 <= 16) ? cosf(ang) : -sinf(ang); }
            z[tt * 36 + jj0] = v; }
        const float bb1 = b1[j], ff1 = f1[j], bb2 = b2[j], ff2 = f2[j];
        __syncthreads();
        { float acc[4] = {bb1, bb1, bb1, bb1};
          for (int i = 0; i < 33; ++i) { const float w = w1s[i * 64 + j];
#pragma unroll
              for (int k = 0; k < 4; ++k) acc[k] += z[(tq + 8 * k) * 36 + i] * w; }
#pragma unroll
          for (int k = 0; k < 4; ++k) h1[(tq + 8 * k) * 64 + j] = sinf(ff1 * acc[k]); }
        __syncthreads();
        { float acc[4] = {bb2, bb2, bb2, bb2};
          for (int i = 0; i < 64; ++i) { const float w = w2s[i * 64 + j];
#pragma unroll
              for (int k = 0; k < 4; ++k) acc[k] += h1[(tq + 8 * k) * 64 + i] * w; }
#pragma unroll
          for (int k = 0; k < 4; ++k) h2T[j * 32 + tq + 8 * k] = sinf(ff2 * acc[k]); }
        __syncthreads();
        { const int n0 = 4 * tid; f32x4 acc[32];
#pragma unroll
            for (int q = 0; q < 32; ++q) acc[q] = (f32x4){0.f, 0.f, 0.f, 0.f};
#pragma unroll 1
            for (int i0 = 0; i0 < 64; i0 += 16) { f32x4 w[16];
#pragma unroll
                for (int u = 0; u < 16; ++u) w[u] = *(const f32x4*)(w3 + (i0 + u) * 2048 + n0);
#pragma unroll
                for (int u = 0; u < 16; ++u) {
#pragma unroll
                    for (int g = 0; g < 8; ++g) { const f32x4 hh = *(const LAS f32x4*)(h2T + (i0 + u) * 32 + 4 * g); acc[4 * g] += w[u] * hh.x; acc[4 * g + 1] += w[u] * hh.y; acc[4 * g + 2] += w[u] * hh.z; acc[4 * g + 3] += w[u] * hh.w; } } }
            const int c0 = n0 & 511, od = n0 >> 9;
#pragma unroll
            for (int e = 0; e < 4; ++e) { const float delta = fabsf(min_decay + (float)(c0 + e) * ((max_decay - min_decay) / 511.0f));
#pragma unroll
                for (int g = 0; g < 4; ++g) { float o8[8];
#pragma unroll
                    for (int q = 0; q < 8; ++q) o8[q] = acc[8 * g + q][e] * expf(-((float)(t0 + 8 * g + q) / (float)(S - 1)) * delta);
                    v4u o; o.x = pk2(o8[0], o8[1]); o.y = pk2(o8[2], o8[3]); o.z = pk2(o8[4], o8[5]); o.w = pk2(o8[6], o8[7]);
                    *(v4u*)(FILT + (((size_t)l * 4 + od) * C + c0 + e) * S + t0 + 8 * g) = o; } } }
    }
    __syncthreads();
}
template <int MAP> __device__ __forceinline__ void p0_convert(const Ctx& X, const float* W, int K, int N, bf16* WB, int dN, int nmat, size_t sstride, size_t dstride) {
    const int nblk = N / 256, per = (K / 16) * nblk, tot = per * nmat, lane = X.lane;
    f32x4 v[16];
    int it = X.gw;
#define CV_SRC(it_) (W + (size_t)((it_) / per) * sstride + (size_t)(16 * (((it_) % per) / nblk)) * N + 256 * (((it_) % per) % nblk) + 4 * lane)
    if (it < tot) { const float* s = CV_SRC(it);
#pragma unroll
        for (int i = 0; i < 16; ++i) v[i] = __builtin_nontemporal_load((const f32x4*)(s + (size_t)i * N)); }
    while (it < tot) {
        v2u o[16];
#pragma unroll
        for (int i = 0; i < 16; ++i) { o[i].x = cvtpk_(v[i][0], v[i][1]); o[i].y = cvtpk_(v[i][2], v[i][3]); }
        const int nit = it + X.ngw;
        if (nit < tot) { const float* s = CV_SRC(nit);
#pragma unroll
            for (int i = 0; i < 16; ++i) v[i] = __builtin_nontemporal_load((const f32x4*)(s + (size_t)i * N)); }
        const int mi = it / per, r = it - mi * per, k0 = 16 * (r / nblk), n = 256 * (r % nblk) + 4 * lane;
        const int dc = MAP == 0 ? n : (((n >> 7) << 8) + (n & 127) + (MAP == 3 ? 128 : 0));
        bf16* dst = WB + (size_t)mi * dstride + (size_t)k0 * dN + dc;
#pragma unroll
        for (int i = 0; i < 16; ++i) __builtin_nontemporal_store(o[i], (v2u*)(dst + (size_t)i * dN));
        it = nit;
    }
#undef CV_SRC
}
__device__ __forceinline__ void p0_experts(const Ctx& X, const Args& a, int l) {
    bf16* wgu = (bf16*)(X.ws + WS_WGU) + (size_t)l * E * 2 * F * D; bf16* wd = (bf16*)(X.ws + WS_WD) + (size_t)l * E * F * D;
    p0_convert<2>(X, a.in[25] + (size_t)l * E * D * F, D, F, wgu, 2 * F, E, (size_t)D * F, (size_t)2 * F * D);
    p0_convert<3>(X, a.in[26] + (size_t)l * E * D * F, D, F, wgu, 2 * F, E, (size_t)D * F, (size_t)2 * F * D);
    p0_convert<0>(X, a.in[27] + (size_t)l * E * D * F, F, D, wd, D, E, (size_t)F * D, (size_t)F * D);
}
#ifndef MK_P0_DUP
#define MK_P0_DUP 0
#endif
__device__ __forceinline__ void p0_prologue(const Ctx& X, const Args& a) {
    const int m = a.p0_mask;
    for (int dup_ = 0; dup_ < ((MK_P0_DUP & 1) ? 2 : 1); ++dup_)
    if (m & 1) {
        p0_transpose<1>(X, a.in[2], D, INW, (bf16*)(X.ws + WS_WIN), 2, (size_t)D * INW, (size_t)D * INW);
        p0_transpose<0>(X, a.in[19], C, D, (bf16*)(X.ws + WS_WUH), 2, (size_t)C * D, (size_t)2 * C * D);
        p0_transpose<0>(X, a.in[20], C, D, (bf16*)(X.ws + WS_WUA), 2, (size_t)C * D, (size_t)2 * C * D);
        p0_transpose<0>(X, a.in[21], D, D, (bf16*)(X.ws + WS_WOUT), 2, (size_t)D * D, (size_t)D * D);
        float* binp = (float*)(X.ws + WS_BINP);
        for (int i = X.gw * 64 + X.lane; i < 2 * INW; i += X.ngw * 64) { const int l = i / INW, n = i - l * INW; binp[l * INW + rowmap<1>(n)] = a.in[3][i]; }
        float* rope = (float*)(X.ws + WS_ROPE);
        for (int i = X.gw * 64 + X.lane; i < S * 32; i += X.ngw * 64) { const int pos = i >> 5, j = i & 31; const float inv = powf(10000.0f, -(float)j * 2.0f / 64.0f); float sn, cs; sincosf((float)pos * inv, &sn, &cs); rope[2 * i] = cs; rope[2 * i + 1] = sn; }
    }
    if (m & 2) { p0_experts(X, a, 0); p0_experts(X, a, 1); }
    for (int dup_ = 0; dup_ < ((MK_P0_DUP & 4) ? 2 : 1); ++dup_)
    if (m & 4) p0_filters(X, a);
    for (int dup_ = 0; dup_ < ((MK_P0_DUP & 8) ? 2 : 1); ++dup_)
    if (m & 8) {
        bf16* XN = (bf16*)(X.ws + WS_XN); const int lane = X.lane; Row8 gg; row8_load(gg, a.in[1], lane);
        int r = X.gw; Row8 cur; if (r < T) row8_load(cur, a.in[0] + (size_t)r * D, lane);
        while (r < T) { const int nr = r + X.ngw; Row8 nxt; if (nr < T) row8_load(nxt, a.in[0] + (size_t)nr * D, lane);
            const float rs = rsqrtf(wave_sum(row8_sumsq(cur)) * (1.f / D) + 1e-6f);
#pragma unroll
            for (int j = 0; j < 2; ++j) { const f32x4 y0 = cur.a[j][0] * gg.a[j][0] * rs, y1 = cur.a[j][1] * gg.a[j][1] * rs;
                v4u w; w.x = pk2(y0.x, y0.y); w.y = pk2(y0.z, y0.w); w.z = pk2(y1.x, y1.y); w.w = pk2(y1.z, y1.w); ((v4u*)(XN + (size_t)r * D))[lane + 64 * j] = w; }
            cur = nxt; r = nr; }
    }
}
}
namespace mk {
using pg8::Unit;
#ifndef MK_SIMPLE_ORDER
#define MK_SIMPLE_ORDER 0
#endif
__device__ __forceinline__ unsigned cvtpk(float lo, float hi) { unsigned r; asm volatile("v_cvt_pk_bf16_f32 %0, %1, %2" : "=v"(r) : "v"(lo), "v"(hi)); return r; }
__device__ __forceinline__ v4u pack8(f32x4 a, f32x4 b) { v4u w; w.x = cvtpk(a[0], a[1]); w.y = cvtpk(a[2], a[3]); w.z = cvtpk(b[0], b[1]); w.w = cvtpk(b[2], b[3]); return w; }
__device__ __forceinline__ void unpack8(v4u w, f32x4& a, f32x4& b) { a = (f32x4){bflo(w.x), bfhi(w.x), bflo(w.y), bfhi(w.y)}; b = (f32x4){bflo(w.z), bfhi(w.z), bflo(w.w), bfhi(w.w)}; }
__device__ __forceinline__ float fsig(float x) { return __builtin_amdgcn_rcpf(1.f + __expf(-x)); }

struct EpiWin {
    static constexpr bool PERM = true, AFTER_DRAIN = false;
    unsigned char* ws; const float* bias; const float* rope;
    __device__ __forceinline__ void operator()(const f32x4 (&acc)[2][2][4][2], const Unit& u, int wr, int wc, int fr, int fq) const {
        const int colt = u.pn * 256, row0 = u.pm * 256 + wr * 64 + fr, cin = wc * 32 + 8 * fq;
        bf16* base; int ldc, col0, mode; float sc = 1.f;
        if (colt < 1536) { base = (bf16*)(ws + WS_U); ldc = 1536; col0 = colt; mode = 0; }
        else if (colt < 2048) { base = (bf16*)(ws + WS_Q); ldc = 512; col0 = colt - 1536; mode = 1; sc = QSCALE; }
        else if (colt < 2560) { base = (bf16*)(ws + WS_K); ldc = 512; col0 = colt - 2048; mode = 1; }
        else if (colt < 3072) { base = (bf16*)(ws + WS_V); ldc = 512; col0 = colt - 2560; mode = 0; }
        else if (colt < 4096) { base = (bf16*)(ws + WS_GH); ldc = 1024; col0 = colt - 3072; mode = 2; }
        else { base = (bf16*)(ws + WS_GA); ldc = 1024; col0 = colt - 4096; mode = 2; }
        f32x4 bv[2][2];
#pragma unroll
        for (int bj = 0; bj < 2; ++bj)
#pragma unroll
            for (int n = 0; n < 2; ++n) bv[bj][n] = *(const f32x4*)(bias + colt + bj * 128 + cin + 4 * n);
#pragma unroll
        for (int ai = 0; ai < 2; ++ai)
#pragma unroll
            for (int m = 0; m < 4; ++m) {
                const int row = row0 + ai * 128 + m * 16; bf16* rowp = base + (size_t)row * ldc + col0 + cin;
#pragma unroll
                for (int bj = 0; bj < 2; ++bj) {
                    f32x4 v0 = acc[ai][bj][m][0] + bv[bj][0], v1 = acc[ai][bj][m][1] + bv[bj][1];
                    if (mode == 1) {
                        const int i = ((bj * 128 + cin) & 63) >> 3; const float* rp = rope + ((size_t)(row & (S - 1)) * 32 + 4 * i) * 2;
                        const f32x4 r0 = *(const f32x4*)rp, r1 = *(const f32x4*)(rp + 4);
                        const f32x4 cs = {r0[0], r0[2], r1[0], r1[2]}, sn = {r0[1], r0[3], r1[1], r1[3]};
                        const f32x4 o1 = (v0 * cs - v1 * sn) * sc, o2 = (v1 * cs + v0 * sn) * sc; v0 = o1; v1 = o2;
                    } else if (mode == 2) {
#pragma unroll
                        for (int e = 0; e < 4; ++e) { v0[e] = fsig(v0[e]); v1[e] = fsig(v1[e]); }
                    }
                    *(v4u*)(rowp + bj * 128) = pack8(v0, v1);
                }
            }
    }
};
struct EpiMerge2 {
    static constexpr bool PERM = true, AFTER_DRAIN = false;
    const bf16* GH; const bf16* GA; bf16* T1; bf16* MG;
    __device__ __forceinline__ void operator()(const f32x4 (&acc)[2][2][4][2], const Unit& u, int wr, int wc, int fr, int fq) const {
        const int row0 = u.pm * 256 + wr * 64 + fr, col0 = u.pn * 256 + wc * 32 + 8 * fq; const bool second = u.pa != u.pm; const bf16* G = second ? GA : GH;
#pragma unroll
        for (int ai = 0; ai < 2; ++ai)
#pragma unroll
            for (int m = 0; m < 4; ++m) { const size_t off = (size_t)(row0 + ai * 128 + m * 16) * D + col0;
#pragma unroll
                for (int bj = 0; bj < 2; ++bj) { f32x4 g0, g1; unpack8(*(const v4u*)(G + off + bj * 128), g0, g1);
                    f32x4 v0 = acc[ai][bj][m][0] * g0, v1 = acc[ai][bj][m][1] * g1;
                    if (second) { f32x4 t0, t1; unpack8(*(const v4u*)(T1 + off + bj * 128), t0, t1); v0 += t0; v1 += t1; *(v4u*)(MG + off + bj * 128) = pack8(v0, v1); }
                    else *(v4u*)(T1 + off + bj * 128) = pack8(v0, v1); } }
    }
};
struct OrderMerge {
    pg8::StaticOrder so;
    __device__ __forceinline__ bool next(int i, Unit& u) const { if (!so.next(i >> 1, u)) return false; if (i & 1) { u.pa = u.pm + T / 256; u.pb = u.pn + 4; } return true; }
    __device__ __forceinline__ void a_ready(const Unit&) const {}
    __device__ __forceinline__ void done(const Unit&) const {}
};
struct EpiOut {
    static constexpr bool PERM = false, AFTER_DRAIN = false;
    const float* xin; float* X;
    __device__ __forceinline__ void operator()(const f32x4 (&acc)[2][2][4][2], const Unit& u, int wr, int wc, int fr, int fq) const {
        const int row0 = u.pm * 256 + wr * 64 + fr, col0 = u.pn * 256 + wc * 32 + 4 * fq;
#pragma unroll
        for (int ai = 0; ai < 2; ++ai)
#pragma unroll
            for (int m = 0; m < 4; ++m) { const size_t off = (size_t)(row0 + ai * 128 + m * 16) * D + col0;
#pragma unroll
                for (int bj = 0; bj < 2; ++bj)
#pragma unroll
                    for (int n = 0; n < 2; ++n) *(f32x4*)(X + off + bj * 128 + n * 16) = *(const f32x4*)(xin + off + bj * 128 + n * 16) + acc[ai][bj][m][n]; }
    }
};
struct EpiSwiGLU {
    static constexpr bool PERM = true, AFTER_DRAIN = false;
    bf16* HB;
    __device__ __forceinline__ void operator()(const f32x4 (&acc)[2][2][4][2], const Unit& u, int wr, int wc, int fr, int fq) const {
        const int row0 = u.pm * 256 + wr * 64 + fr, col0 = u.pn * 128 + wc * 32 + 8 * fq;
#pragma unroll
        for (int ai = 0; ai < 2; ++ai)
#pragma unroll
            for (int m = 0; m < 4; ++m) { f32x4 h[2];
#pragma unroll
                for (int n = 0; n < 2; ++n) { const f32x4 g = acc[ai][0][m][n], up = acc[ai][1][m][n];
#pragma unroll
                    for (int e = 0; e < 4; ++e) h[n][e] = g[e] * fsig(g[e]) * up[e]; }
                *(v4u*)(HB + (size_t)(row0 + ai * 128 + m * 16) * F + col0) = pack8(h[0], h[1]); }
    }
};
struct EpiDown {
    static constexpr bool PERM = true, AFTER_DRAIN = false;
    bf16* YE; const float* gate;
    __device__ __forceinline__ void operator()(const f32x4 (&acc)[2][2][4][2], const Unit& u, int wr, int wc, int fr, int fq) const {
        const int row0 = u.pm * 256 + wr * 64 + fr, col0 = u.pn * 256 + wc * 32 + 8 * fq;
#pragma unroll
        for (int ai = 0; ai < 2; ++ai)
#pragma unroll
            for (int m = 0; m < 4; ++m) { const int row = row0 + ai * 128 + m * 16; const float g = gate[row];
#pragma unroll
                for (int bj = 0; bj < 2; ++bj) *(v4u*)(YE + (size_t)row * D + col0 + bj * 128) = pack8(acc[ai][bj][m][0] * g, acc[ai][bj][m][1] * g); }
    }
};
struct OrderMoE1 {
    int G, c;
    __device__ __forceinline__ bool next(int i, Unit& u) const {
        if (MK_SIMPLE_ORDER || G != 256) { const int L = i * G + c; if (L >= 2048) return false; const int e = L >> 7, r = L & 127; u.pm = e * 8 + (r & 7); u.pn = r >> 3; u.pb = e * 16 + u.pn; u.pa = u.pm; return true; }
        if (i >= 8) return false;
        const int ch = i * 8 + (c & 7), j = c >> 3, e = ch >> 2, ng = ch & 3; u.pm = e * 8 + (j & 7); u.pn = ng * 4 + (j >> 3); u.pb = e * 16 + u.pn; u.pa = u.pm; return true;
    }
    __device__ __forceinline__ void a_ready(const Unit&) const {}
    __device__ __forceinline__ void done(const Unit&) const {}
};
struct OrderMoE2 {
    int G, c;
    __device__ __forceinline__ bool next(int i, Unit& u) const {
        if (MK_SIMPLE_ORDER || G != 256) { const int L = i * G + c; if (L >= 512) return false; const int e = L >> 5, r = L & 31; u.pm = e * 8 + (r & 7); u.pn = r >> 3; u.pb = e * 4 + u.pn; u.pa = u.pm; return true; }
        if (i >= 2) return false;
        const int e = i * 8 + (c & 7), j = c >> 3; u.pm = e * 8 + (j & 7); u.pn = j >> 3; u.pb = e * 4 + u.pn; u.pa = u.pm; return true;
    }
    __device__ __forceinline__ void a_ready(const Unit&) const {}
    __device__ __forceinline__ void done(const Unit&) const {}
};

__device__ __forceinline__ void p5_norm_router(const Ctx& X, const float* Xr, const float* __restrict__ g, const float* __restrict__ wr, const float* __restrict__ br) {
    bf16* XN = (bf16*)(X.ws + WS_XN); float* afft = (float*)(X.ws + WS_AFFT); const int lane = X.lane;
    LAS float* wt = (LAS float*)X.lds;
    __syncthreads();
    for (int i = X.tid; i < D * 4; i += NTH) { const f32x4 w = ((const f32x4*)wr)[i]; const int k = i >> 2, e0 = (i & 3) * 4; wt[(e0 + 0) * D + k] = w.x; wt[(e0 + 1) * D + k] = w.y; wt[(e0 + 2) * D + k] = w.z; wt[(e0 + 3) * D + k] = w.w; }
    __syncthreads();
    Row8 gg; row8_load(gg, g, lane);
    int tok = X.gw; Row8 cur; if (tok < T) row8_load(cur, Xr + (size_t)tok * D, lane);
    while (tok < T) {
        const int ntok = tok + X.ngw; Row8 nxt; if (ntok < T) row8_load(nxt, Xr + (size_t)ntok * D, lane);
        const float r = rsqrtf(wave_sum(row8_sumsq(cur)) * (1.f / D) + 1e-6f);
        float acc[16];
#pragma unroll
        for (int e = 0; e < 16; ++e) acc[e] = 0.f;
#pragma unroll
        for (int j = 0; j < 2; ++j) { f32x4 y[2];
#pragma unroll
            for (int h = 0; h < 2; ++h) y[h] = cur.a[j][h] * gg.a[j][h] * r;
            v4u w; w.x = pk2(y[0].x, y[0].y); w.y = pk2(y[0].z, y[0].w); w.z = pk2(y[1].x, y[1].y); w.w = pk2(y[1].z, y[1].w);
            ((v4u*)(XN + (size_t)tok * D))[lane + 64 * j] = w;
#pragma unroll
            for (int e = 0; e < 16; ++e) { const LAS f32x4* wp = (const LAS f32x4*)(wt + e * D + 8 * (lane + 64 * j)); const f32x4 w0 = wp[0], w1 = wp[1];
                acc[e] += ((y[0].x * w0.x + y[0].y * w0.y) + (y[0].z * w0.z + y[0].w * w0.w)) + ((y[1].x * w1.x + y[1].y * w1.y) + (y[1].z * w1.z + y[1].w * w1.w));
                if ((e & 3) == 3) asm volatile("" ::: "memory"); } }
        float mx = -1e30f;
#pragma unroll
        for (int e = 0; e < 16; ++e) { acc[e] = wave_sum(acc[e]) + br[e]; mx = fmaxf(mx, acc[e]); }
        float l = 0.f;
#pragma unroll
        for (int e = 0; e < 16; ++e) { acc[e] = expf(acc[e] - mx); l += acc[e]; }
        const int b = tok >> 12, s_ = tok & (S - 1);
        if (lane < 16) { float vv = 0.f;
#pragma unroll
            for (int e = 0; e < 16; ++e) if (lane == e) vv = acc[e];
            afft[((size_t)b * E + lane) * S + s_] = vv / l; }
        cur = nxt; tok = ntok;
    }
    __syncthreads();
}
__device__ __forceinline__ void p6_topk(const Ctx& X) {
    const float* afft = (const float*)(X.ws + WS_AFFT); int* rows = (int*)(X.ws + WS_ROWS); float* gate = (float*)(X.ws + WS_GATE); int* inv = (int*)(X.ws + WS_INV);
    for (int p = X.bid; p < B * E; p += X.G) { const int b = p >> 4, e = p & 15, slotbase = e * 2048 + b * 512;
        tk::topk_problem(afft + (size_t)p * S, b * S, e, slotbase, rows + slotbase, gate + slotbase, inv, (int*)(X.lds), X.tid); }
}
__device__ __forceinline__ void p6_gather(const Ctx& X) {
    const int* rows = (const int*)(X.ws + WS_ROWS); const bf16* XN = (const bf16*)(X.ws + WS_XN); bf16* XG = (bf16*)(X.ws + WS_XG);
    for (int sl0 = X.gw * 4; sl0 < E * 2048; sl0 += X.ngw * 4) {
        const int myrow = X.lane < 4 ? __hip_atomic_load(rows + sl0 + X.lane, __ATOMIC_RELAXED, __HIP_MEMORY_SCOPE_AGENT) : 0;
        v4u d[4][2];
#pragma unroll
        for (int i = 0; i < 4; ++i) { const int tok = __builtin_amdgcn_readlane(myrow, i); const v4u* s = (const v4u*)(XN + (size_t)tok * D) + X.lane; d[i][0] = s[0]; d[i][1] = s[64]; }
#pragma unroll
        for (int i = 0; i < 4; ++i) { v4u* o = (v4u*)(XG + (size_t)(sl0 + i) * D) + X.lane; o[0] = d[i][0]; o[64] = d[i][1]; }
    }
}
__device__ __forceinline__ void p9_combine(const Ctx& X, float* Xr, const float* __restrict__ g, bool final_, float* __restrict__ out) {
    const int* inv = (const int*)(X.ws + WS_INV); const bf16* YE = (const bf16*)(X.ws + WS_YE); bf16* XN = (bf16*)(X.ws + WS_XN); const int lane = X.lane;
    Row8 gg; row8_load(gg, g, lane);
    int tok = X.gw; Row8 cur; int myinv = -1;
    if (tok < T) { row8_load(cur, Xr + (size_t)tok * D, lane); if (lane < 16) myinv = inv[(size_t)tok * E + lane]; }
    while (tok < T) {
        const int ntok = tok + X.ngw; Row8 nxt; int ninv = -1;
        if (ntok < T) { row8_load(nxt, Xr + (size_t)ntok * D, lane); if (lane < 16) ninv = inv[(size_t)ntok * E + lane]; }
        unsigned long long m = __ballot(myinv >= 0);
        while (m) {
            int sl[4];
#pragma unroll
            for (int i = 0; i < 4; ++i) { if (m) { const int e = __builtin_ctzll(m); m &= m - 1; sl[i] = __builtin_amdgcn_readlane(myinv, e); } else sl[i] = -1; }
            v4u y[4][2];
#pragma unroll
            for (int i = 0; i < 4; ++i) if (sl[i] >= 0) { const v4u* yp = (const v4u*)(YE + (size_t)sl[i] * D); y[i][0] = __builtin_nontemporal_load(yp + lane); y[i][1] = __builtin_nontemporal_load(yp + lane + 64); }
#pragma unroll
            for (int i = 0; i < 4; ++i) if (sl[i] >= 0) {
#pragma unroll
                for (int j = 0; j < 2; ++j) { f32x4 p, q; unpack8(y[i][j], p, q); cur.a[j][0] += p; cur.a[j][1] += q; } }
        }
        const float r = rsqrtf(wave_sum(row8_sumsq(cur)) * (1.f / D) + 1e-6f);
        if (final_) {
#pragma unroll
            for (int j = 0; j < 2; ++j)
#pragma unroll
                for (int h = 0; h < 2; ++h) ((f32x4*)(out + (size_t)tok * D))[2 * (lane + 64 * j) + h] = cur.a[j][h] * gg.a[j][h] * r;
        } else {
#pragma unroll
            for (int j = 0; j < 2; ++j) {
#pragma unroll
                for (int h = 0; h < 2; ++h) ((f32x4*)(Xr + (size_t)tok * D))[2 * (lane + 64 * j) + h] = cur.a[j][h];
                const f32x4 y0 = cur.a[j][0] * gg.a[j][0] * r, y1 = cur.a[j][1] * gg.a[j][1] * r;
                v4u w; w.x = pk2(y0.x, y0.y); w.y = pk2(y0.z, y0.w); w.z = pk2(y1.x, y1.y); w.w = pk2(y1.z, y1.w);
                ((v4u*)(XN + (size_t)tok * D))[lane + 64 * j] = w; }
        }
        cur = nxt; myinv = ninv; tok = ntok;
    }
}
}
namespace mk {
__device__ __forceinline__ void p1t_shortconv(const Ctx& X, const float* __restrict__ cw, const float* __restrict__ cb) {
    const bf16* U = (const bf16*)(X.ws + WS_U); bf16* UCT = (bf16*)(X.ws + WS_UCT);
    LAS float* raw = (LAS float*)(X.lds + X.wave * 17408);
    const int lane = X.lane, rq = lane >> 3, cq = lane & 7;
    constexpr int NIT = (T / 64) * 24;
    v4u w[9];
#define P1T_LOAD(it_) do { const int tt_ = (it_) / 24, cg_ = (it_) - tt_ * 24, tok0_ = tt_ * 64, tin_ = tok0_ & (S - 1); \
        _Pragma("unroll") for (int i = 0; i < 9; ++i) { const int r = 8 * i + rq, tpos = tin_ + r - 1; w[i] = (v4u){0u, 0u, 0u, 0u}; \
            if (r < 66 && tpos >= 0 && tpos < S) w[i] = *(const v4u*)(U + (size_t)(tok0_ + r - 1) * 1536 + cg_ * 64 + 8 * cq); } } while (0)
    int it = X.gw;
    if (it < NIT) P1T_LOAD(it);
    while (it < NIT) {
        const int tt = it / 24, cg = it - tt * 24, tok0 = tt * 64, ch0 = cg * 64;
#pragma unroll
        for (int i = 0; i < 9; ++i) { const int r = 8 * i + rq; if (r < 66) { LAS float* d = raw + r * 65 + 8 * cq; f32x4 p, q; unpack8(w[i], p, q);
            d[0] = p.x; d[1] = p.y; d[2] = p.z; d[3] = p.w; d[4] = q.x; d[5] = q.y; d[6] = q.z; d[7] = q.w; } }
        const int nit = it + X.ngw;
        if (nit < NIT) P1T_LOAD(nit);
        asm volatile("s_waitcnt lgkmcnt(0)" ::: "memory");
        const int chs = lane >> 3, tch = lane & 7;
#pragma unroll
        for (int g = 0; g < 8; ++g) { const int ch = 8 * g + chs, gc = ch0 + ch; const float w0 = cw[gc], w1 = cw[1536 + gc], w2 = cw[3072 + gc], bb = cb[gc];
            float v[10];
#pragma unroll
            for (int k = 0; k < 10; ++k) v[k] = raw[(8 * tch + k) * 65 + ch];
            float o[8];
#pragma unroll
            for (int k = 0; k < 8; ++k) o[k] = v[k] * w0 + v[k + 1] * w1 + v[k + 2] * w2 + bb;
            v4u pk; pk.x = pk2(o[0], o[1]); pk.y = pk2(o[2], o[3]); pk.z = pk2(o[4], o[5]); pk.w = pk2(o[6], o[7]);
            *(v4u*)(UCT + (size_t)gc * T + tok0 + 8 * tch) = pk; }
        asm volatile("s_waitcnt lgkmcnt(0)" ::: "memory");
        it = nit;
    }
#undef P1T_LOAD
}

__device__ __forceinline__ void p1t_kmax(const Ctx& X, unsigned* kmax2) {
    const bf16* K = (const bf16*)(X.ws + WS_K); const int lane = X.lane; LAS float* red = (LAS float*)(X.lds + 8 * 17408);
    const int b = X.gw / 512, t0 = X.gw % 512; float mx = 0.f;
    if (b < B) {
        v4u w[8];
#pragma unroll
        for (int i = 0; i < 8; ++i) w[i] = ((const v4u*)(K + ((size_t)b * S + t0 + 512 * i) * 512))[lane];
#pragma unroll
        for (int i = 0; i < 8; ++i) { f32x4 p, q; unpack8(w[i], p, q); float ss = (p.x * p.x + p.y * p.y) + (p.z * p.z + p.w * p.w) + (q.x * q.x + q.y * q.y) + (q.z * q.z + q.w * q.w);
            ss += xor_f<1>(ss); ss += xor_f<2>(ss); ss += xor_f<4>(ss); mx = fmaxf(mx, ss); }
    }
    __syncthreads();
    if ((lane & 7) == 0) red[X.wave * 8 + (lane >> 3)] = mx;
    __syncthreads();
    if (X.tid < 8 && b < B) { float m = red[X.tid]; for (int w_ = 1; w_ < 8; ++w_) m = fmaxf(m, red[w_ * 8 + X.tid]); atomicMax(kmax2 + b * 8 + X.tid, __float_as_uint(m)); }
}

namespace at {
constexpr int KVBLK = 64, LDK = 512;
constexpr int KPITCH = 272;
constexpr int SHM_V = 64 * 128 * 2, SHM_K = 64 * KPITCH;
constexpr int OFF_V = 0, OFF_K = 2 * SHM_V, OFF_Q = OFF_K + 2 * SHM_K, OFF_WS = OFF_Q + 256 * KPITCH, LDS_TOTAL = OFF_WS + 8 * 160 * 4;
constexpr float THR2 = 8.0f * 1.4426950408889634f;
#define KSWZ(row, colB) ((row) * KPITCH + (colB))
#define SBAR() __builtin_amdgcn_sched_barrier(0)
__device__ __forceinline__ int crow(int r, int hi) { return (r & 3) + 8 * (r >> 2) + 4 * hi; }
__device__ __forceinline__ int v_st(int k, int c) { const int kk = (k & ~0xC) | ((k & 4) << 1) | ((k & 8) >> 1); return ((kk >> 3) * 4 + (c >> 5)) * 512 + ((kk & 7) * 32 + (c & 31)) * 2; }
__device__ __forceinline__ int v_rd_base(int lane) { return ((lane & 3) << 3) | (((lane >> 2) & 3) << 6) | (((lane >> 4) & 1) << 5) | (((lane >> 5) & 1) << 8); }
constexpr int v_rd_off(int d0, int ks, int half) { return d0 * 512 + ks * 4096 + half * 2048; }
template <int OFF> __device__ __forceinline__ s16x4 tr_read(int vb) { s16x4 r; asm volatile("ds_read_b64_tr_b16 %0, %1 offset:%2" : "=&v"(r) : "v"(vb), "i"(OFF) : "memory"); return r; }

template <int CO> __device__ __forceinline__ void qkt(f32x16& p0, f32x16& p1, const char* Ks, const char* Qs, int qrow, int r32, int hi) {
    p0 = f32x16{}; p1 = f32x16{};
    const char* qp = Qs + KSWZ(qrow, (CO * 64 + hi * 8) * 2); const char* kp = Ks + KSWZ(r32, (CO * 64 + hi * 8) * 2);
#pragma unroll
    for (int d0 = 0; d0 < 4; ++d0) {
        const bf16x8 qf = *reinterpret_cast<const bf16x8*>(qp + d0 * 32);
        const bf16x8 b0 = *reinterpret_cast<const bf16x8*>(kp + d0 * 32);
        const bf16x8 b1 = *reinterpret_cast<const bf16x8*>(kp + 32 * KPITCH + d0 * 32);
        p0 = __builtin_amdgcn_mfma_f32_32x32x16_bf16(b0, qf, p0, 0, 0, 0);
        p1 = __builtin_amdgcn_mfma_f32_32x32x16_bf16(b1, qf, p1, 0, 0, 0);
        if (d0 == 1) asm volatile("" ::: "memory"); }
}
__device__ __forceinline__ void softmax_tile(f32x16& p0, f32x16& p1, float& m_reg, float& l_reg, float& alpha, bf16x8& pa0, bf16x8& pa1, bf16x8& pa2, bf16x8& pa3) {
    float pmax = p0[0];
#pragma unroll
    for (int r = 1; r < 16; ++r) pmax = fmaxf(pmax, p0[r]);
#pragma unroll
    for (int r = 0; r < 16; ++r) pmax = fmaxf(pmax, p1[r]);
    { auto rr = __builtin_amdgcn_permlane32_swap(__float_as_uint(pmax), __float_as_uint(pmax), false, false); pmax = fmaxf(__uint_as_float(rr[0]), __uint_as_float(rr[1])); }
    float mn;
    if (__builtin_expect(__all(pmax - m_reg <= THR2), 1)) { mn = m_reg; alpha = 1.f; }
    else { mn = fmaxf(m_reg, pmax); alpha = __builtin_amdgcn_exp2f(m_reg - mn); m_reg = mn; }
#pragma unroll
    for (int r = 0; r < 16; ++r) { p0[r] = __builtin_amdgcn_exp2f(p0[r] - mn); p1[r] = __builtin_amdgcn_exp2f(p1[r] - mn); }
    float ps = 0.f;
#pragma unroll
    for (int r = 0; r < 16; ++r) ps += p0[r];
#pragma unroll
    for (int r = 0; r < 16; ++r) ps += p1[r];
    { auto rr = __builtin_amdgcn_permlane32_swap(__float_as_uint(ps), __float_as_uint(ps), false, false); ps = __uint_as_float(rr[0]) + __uint_as_float(rr[1]); }
    l_reg = l_reg * alpha + ps;
#define PK4(P, BASE, OUT) do { unsigned a0 = cvtpk(P[BASE + 0], P[BASE + 1]), a1 = cvtpk(P[BASE + 2], P[BASE + 3]);   \
    unsigned b0 = cvtpk(P[BASE + 4], P[BASE + 5]), b1 = cvtpk(P[BASE + 6], P[BASE + 7]);                              \
    auto r0 = __builtin_amdgcn_permlane32_swap(a0, b0, false, false); auto r1 = __builtin_amdgcn_permlane32_swap(a1, b1, false, false); \
    v4u w = {r0[0], r1[0], r0[1], r1[1]}; OUT = *reinterpret_cast<bf16x8*>(&w); } while (0)
    PK4(p0, 0, pa0); PK4(p0, 8, pa1); PK4(p1, 0, pa2); PK4(p1, 8, pa3);
#undef PK4
}
__device__ __forceinline__ void softmax_fixed(f32x16& p0, f32x16& p1, float m, float& l_half, bf16x8& pa0, bf16x8& pa1, bf16x8& pa2, bf16x8& pa3) {
#pragma unroll
    for (int r = 0; r < 16; ++r) { p0[r] = __builtin_amdgcn_exp2f(p0[r] - m); p1[r] = __builtin_amdgcn_exp2f(p1[r] - m); }
    float ps = 0.f;
#pragma unroll
    for (int r = 0; r < 16; ++r) ps += p0[r] + p1[r];
    l_half += ps;
#define PK4(P, BASE, OUT) do { unsigned a0 = cvtpk(P[BASE + 0], P[BASE + 1]), a1 = cvtpk(P[BASE + 2], P[BASE + 3]);   \
    unsigned b0 = cvtpk(P[BASE + 4], P[BASE + 5]), b1 = cvtpk(P[BASE + 6], P[BASE + 7]);                              \
    auto r0 = __builtin_amdgcn_permlane32_swap(a0, b0, false, false); auto r1 = __builtin_amdgcn_permlane32_swap(a1, b1, false, false); \
    v4u w = {r0[0], r1[0], r0[1], r1[1]}; OUT = *reinterpret_cast<bf16x8*>(&w); } while (0)
    PK4(p0, 0, pa0); PK4(p0, 8, pa1); PK4(p1, 0, pa2); PK4(p1, 8, pa3);
#undef PK4
}
template <int D0> __device__ __forceinline__ void pv_one(f32x16& oa, int vb, const bf16x8 (&pa)[4]) {
#define PK(L, H) (bf16x8){L[0], L[1], L[2], L[3], H[0], H[1], H[2], H[3]}
    {   const s16x4 l0 = tr_read<v_rd_off(D0, 0, 0)>(vb), h0 = tr_read<v_rd_off(D0, 0, 1)>(vb), l1 = tr_read<v_rd_off(D0, 1, 0)>(vb), h1 = tr_read<v_rd_off(D0, 1, 1)>(vb);
        asm volatile("s_waitcnt lgkmcnt(0)" ::: "memory"); SBAR();
        oa = __builtin_amdgcn_mfma_f32_32x32x16_bf16(pa[0], PK(l0, h0), oa, 0, 0, 0);
        oa = __builtin_amdgcn_mfma_f32_32x32x16_bf16(pa[1], PK(l1, h1), oa, 0, 0, 0); }
    {   const s16x4 l2 = tr_read<v_rd_off(D0, 2, 0)>(vb), h2 = tr_read<v_rd_off(D0, 2, 1)>(vb), l3 = tr_read<v_rd_off(D0, 3, 0)>(vb), h3 = tr_read<v_rd_off(D0, 3, 1)>(vb);
        asm volatile("s_waitcnt lgkmcnt(0)" ::: "memory"); SBAR();
        oa = __builtin_amdgcn_mfma_f32_32x32x16_bf16(pa[2], PK(l2, h2), oa, 0, 0, 0);
        oa = __builtin_amdgcn_mfma_f32_32x32x16_bf16(pa[3], PK(l3, h3), oa, 0, 0, 0); }
#undef PK
}
template <int D0> __device__ __forceinline__ void pv_two(f32x16& oa, f32x16& ob, int vb, const bf16x8 (&pa)[4], const bf16x8 (&pb)[4]) {
#define PK(L, H) (bf16x8){L[0], L[1], L[2], L[3], H[0], H[1], H[2], H[3]}
    {   const s16x4 l0 = tr_read<v_rd_off(D0, 0, 0)>(vb), h0 = tr_read<v_rd_off(D0, 0, 1)>(vb), l1 = tr_read<v_rd_off(D0, 1, 0)>(vb), h1 = tr_read<v_rd_off(D0, 1, 1)>(vb);
        asm volatile("s_waitcnt lgkmcnt(0)" ::: "memory"); SBAR();
        const bf16x8 v0 = PK(l0, h0), v1 = PK(l1, h1);
        oa = __builtin_amdgcn_mfma_f32_32x32x16_bf16(pa[0], v0, oa, 0, 0, 0); ob = __builtin_amdgcn_mfma_f32_32x32x16_bf16(pb[0], v0, ob, 0, 0, 0);
        oa = __builtin_amdgcn_mfma_f32_32x32x16_bf16(pa[1], v1, oa, 0, 0, 0); ob = __builtin_amdgcn_mfma_f32_32x32x16_bf16(pb[1], v1, ob, 0, 0, 0); }
    {   const s16x4 l2 = tr_read<v_rd_off(D0, 2, 0)>(vb), h2 = tr_read<v_rd_off(D0, 2, 1)>(vb), l3 = tr_read<v_rd_off(D0, 3, 0)>(vb), h3 = tr_read<v_rd_off(D0, 3, 1)>(vb);
        asm volatile("s_waitcnt lgkmcnt(0)" ::: "memory"); SBAR();
        const bf16x8 v2 = PK(l2, h2), v3 = PK(l3, h3);
        oa = __builtin_amdgcn_mfma_f32_32x32x16_bf16(pa[2], v2, oa, 0, 0, 0); ob = __builtin_amdgcn_mfma_f32_32x32x16_bf16(pb[2], v2, ob, 0, 0, 0);
        oa = __builtin_amdgcn_mfma_f32_32x32x16_bf16(pa[3], v3, oa, 0, 0, 0); ob = __builtin_amdgcn_mfma_f32_32x32x16_bf16(pb[3], v3, ob, 0, 0, 0); }
#undef PK
}
__device__ __forceinline__ void rescale(f32x16 (&o)[4], float al, float* wsf, int r32, int hi) {
    if (__any(al < 1.f)) {
        if (hi == 0) wsf[r32] = al; asm volatile("s_waitcnt lgkmcnt(0)" ::: "memory");
#pragma unroll
        for (int r = 0; r < 16; ++r) { const float a = wsf[crow(r, hi)];
#pragma unroll
            for (int d = 0; d < 4; ++d) o[d][r] *= a; }
    }
}

__device__ __forceinline__ void epilogue(const Ctx& X, f32x16 (&oa)[4], f32x16 (&ob)[4], const float* wsf, int r32, int hi, int b, int h, int qb, float lam, float mul, const float* __restrict__ sg) {
    bf16* Yw = (bf16*)(X.ws + WS_YA) + ((size_t)b * S + qb * 256 + X.wave * 32) * 512 + h * 128;
    float gcol[4];
#pragma unroll
    for (int d = 0; d < 4; ++d) gcol[d] = sg[d * 32 + r32] * mul;
#pragma unroll
    for (int r = 0; r < 16; ++r) { const int orow = crow(r, hi); const float i0 = __builtin_amdgcn_rcpf(wsf[orow] + wsf[64 + orow]), i1 = lam * __builtin_amdgcn_rcpf(wsf[32 + orow] + wsf[96 + orow]);
        float v[4], ss = 0.f;
#pragma unroll
        for (int d = 0; d < 4; ++d) { v[d] = oa[d][r] * i0 - ob[d][r] * i1; ss += v[d] * v[d]; }
        ss += xor_f<1>(ss); ss += xor_f<2>(ss); ss += xor_f<4>(ss); ss += xor_f<8>(ss); ss += xor_f<16>(ss);
        const float rn = rsqrtf(ss * (1.f / 128.f) + 1e-5f);
#pragma unroll
        for (int d = 0; d < 4; ++d) Yw[(size_t)orow * 512 + d * 32 + r32] = (bf16)f2bf(v[d] * rn * gcol[d]); }
}
__device__ __forceinline__ int vkey(int T_, int lane) { const int kk = ((T_ >> 2) << 3) | ((lane & 31) >> 2); return (kk & ~0xC) | ((kk & 4) << 1) | ((kk & 8) >> 1); }
__device__ __forceinline__ int vcol(int T_, int lane) { return (T_ & 3) * 32 + (lane & 3) * 8; }
__device__ __forceinline__ void attn_unit(const Ctx& X, int b, int h, int qb, float lam, float mul, const float* __restrict__ sg, unsigned* kmax2) {
    char* lds = (char*)X.lds;
    const int tid = fresh_tid(X.wave_s);
    const int wid = X.wave, lane = tid & 63, r32 = lane & 31, hi = lane >> 5;
    const bf16* Qg = (const bf16*)(X.ws + WS_Q) + ((size_t)b * S + qb * 256) * LDK + h * 128;
    const bf16* Kh = (const bf16*)(X.ws + WS_K) + (size_t)b * S * LDK + h * 128;
    const bf16* Vh = (const bf16*)(X.ws + WS_V) + (size_t)b * S * LDK + h * 128;
    char* V_lds = lds + OFF_V; char* K_lds = lds + OFF_K; char* Q_lds = lds + OFF_Q;
    float* wsf = (float*)(lds + OFF_WS) + wid * 160;
    const int sr = tid >> 4, sc = (tid & 15) * 8, vst0 = v_st(sr, sc), vst1 = v_st(32 + sr, sc);
    const int vb0 = (int)(uintptr_t)V_lds + v_rd_base(lane);
#pragma unroll
    for (int i = 0; i < 8; ++i) { const int row = sr + 32 * i; *(bf16x8*)(Q_lds + KSWZ(row, sc * 2)) = *reinterpret_cast<const bf16x8*>(Qg + (size_t)row * LDK + sc); }
    bf16x8 st0, st1;
    const unsigned goff = (unsigned)(sr * LDK + sc) * 2u;
#define KLOAD(k0) do { const char* t_ = (const char*)Kh + (size_t)(k0) * (LDK * 2); st0 = *reinterpret_cast<const bf16x8*>(t_ + goff); st1 = *reinterpret_cast<const bf16x8*>(t_ + 32 * LDK * 2 + goff); } while (0)
#define VLOAD(k0) do { const char* t_ = (const char*)Vh + (size_t)(k0) * (LDK * 2); st0 = *reinterpret_cast<const bf16x8*>(t_ + goff); st1 = *reinterpret_cast<const bf16x8*>(t_ + 32 * LDK * 2 + goff); } while (0)
#define KWRITE(bb) do { *(bf16x8*)(K_lds + (bb) * SHM_K + KSWZ(sr, sc * 2)) = st0; *(bf16x8*)(K_lds + (bb) * SHM_K + KSWZ(32 + sr, sc * 2)) = st1; } while (0)
    const unsigned vsrc0 = (unsigned)(vkey(2 * wid + (lane >> 5), lane) * LDK + vcol(2 * wid + (lane >> 5), lane)) * 2u, vsrc1 = (unsigned)(vkey(2 * (wid + 8) + (lane >> 5), lane) * LDK + vcol(2 * (wid + 8) + (lane >> 5), lane)) * 2u;
#define VDMA(k0, bbn) do { const char* t_ = (const char*)Vh + (size_t)(k0) * (LDK * 2); LAS unsigned char* d_ = X.lds + OFF_V + (bbn) * SHM_V + wid * 1024; \
    __builtin_amdgcn_global_load_lds((const unsigned*)(t_ + vsrc0), (LAS unsigned*)d_, 16, 0, 0); __builtin_amdgcn_global_load_lds((const unsigned*)(t_ + vsrc1), (LAS unsigned*)(d_ + 8192), 16, 0, 0); } while (0)
    const unsigned ksrc = (unsigned)(wid * 8 * LDK * 2) + (unsigned)lane * 4u;
#define KDMA(k0, bbn) do { const char* t_ = (const char*)Kh + (size_t)(k0) * (LDK * 2) + ksrc; LAS unsigned char* d_ = X.lds + OFF_K + (bbn) * SHM_K + wid * 8 * KPITCH; \
    _Pragma("unroll") for (int i_ = 0; i_ < 8; ++i_) __builtin_amdgcn_global_load_lds((const unsigned*)(t_ + i_ * (LDK * 2)), (LAS unsigned*)(d_ + i_ * KPITCH), 4, 0, 0); } while (0)
#define VWRITE(bb) do { *(bf16x8*)(V_lds + (bb) * SHM_V + vst0) = st0; *(bf16x8*)(V_lds + (bb) * SHM_V + vst1) = st1; } while (0)
    float l0 = 0.f, l1 = 0.f; f32x16 oa[4] = {}, ob[4] = {};
    const int qrow = wid * 32 + r32; constexpr int NT = S / KVBLK;
    KDMA(0, 0); VDMA(0, 0); __syncthreads();
    float m0, m1;
    { float s0 = 0.f, s1 = 0.f;
#pragma unroll
      for (int d0 = 0; d0 < 8; ++d0) { const v4u w = *reinterpret_cast<const v4u*>(Q_lds + KSWZ(qrow, (d0 * 16 + hi * 8) * 2)); f32x4 p, q; unpack8(w, p, q);
          const float ss = (p.x * p.x + p.y * p.y) + (p.z * p.z + p.w * p.w) + (q.x * q.x + q.y * q.y) + (q.z * q.z + q.w * q.w); if (d0 < 4) s0 += ss; else s1 += ss; }
      wsf[hi * 64 + r32] = s0; wsf[hi * 64 + 32 + r32] = s1; asm volatile("s_waitcnt lgkmcnt(0)" ::: "memory");
      s0 += wsf[(hi ^ 1) * 64 + r32]; s1 += wsf[(hi ^ 1) * 64 + 32 + r32]; asm volatile("s_waitcnt lgkmcnt(0)" ::: "memory");
      const float k0 = __uint_as_float(__hip_atomic_load(kmax2 + b * 8 + h * 2, __ATOMIC_RELAXED, __HIP_MEMORY_SCOPE_AGENT)), k1 = __uint_as_float(__hip_atomic_load(kmax2 + b * 8 + h * 2 + 1, __ATOMIC_RELAXED, __HIP_MEMORY_SCOPE_AGENT));
      m0 = sqrtf(s0 * k0) * 1.001f + 1e-3f; m1 = sqrtf(s1 * k1) * 1.001f + 1e-3f; }
    for (int j = 0; j < NT; ++j) {
        const int bb = j & 1; const char* Ks = K_lds + bb * SHM_K;
        const int kn = (j + 1) * KVBLK;
        if (j + 1 < NT) { KDMA(kn, bb ^ 1); VDMA(kn, bb ^ 1); }
        const int vb = vb0 + bb * SHM_V;
        bf16x8 pa[4], pb[4];
        { f32x16 p0, p1, q0, q1;
          qkt<0>(p0, p1, Ks, Q_lds, qrow, r32, hi); qkt<1>(q0, q1, Ks, Q_lds, qrow, r32, hi);
          softmax_fixed(p0, p1, m0, l0, pa[0], pa[1], pa[2], pa[3]);
          softmax_fixed(q0, q1, m1, l1, pb[0], pb[1], pb[2], pb[3]); }
        SBAR();
        pv_two<0>(oa[0], ob[0], vb, pa, pb); pv_two<1>(oa[1], ob[1], vb, pa, pb); pv_two<2>(oa[2], ob[2], vb, pa, pb); pv_two<3>(oa[3], ob[3], vb, pa, pb);
        __syncthreads();
    }
#undef KLOAD
#undef VLOAD
#undef VDMA
#undef KDMA
#undef KWRITE
#undef VWRITE
    wsf[hi * 64 + r32] = l0; wsf[hi * 64 + 32 + r32] = l1; asm volatile("s_waitcnt lgkmcnt(0)" ::: "memory");
    { const int t2 = fresh_tid(X.wave_s); epilogue(X, oa, ob, wsf, t2 & 31, (t2 & 63) >> 5, b, h, qb, lam, mul, sg); }
    __syncthreads();
}
__device__ __forceinline__ void epilogue_unused() {}
#undef KSWZ
#undef SBAR
}
}
namespace mk {
namespace hy {
constexpr int CPS = 16704;
constexpr int NEL = 8352;
constexpr int OFF_Z = 4 * CPS;
constexpr int ZROW = 144, ZB = 128 * ZROW;
constexpr int LDS_TOTAL = OFF_Z + 4 * ZB;

__device__ __forceinline__ void build_hrev(const Ctx& X, const bf16* hf, const bf16* hb, float bias) {
    const int tid = X.tid;
    if (tid < 4 * 8) { const int m = tid >> 3, e = tid & 7; if (e < 5 - m) *(LAS bf16*)(X.lds + m * CPS + 2 * e) = 0; }
    for (int i = tid; i < 4 * (NEL - 8192); i += NTH) { const int m = i / (NEL - 8192), e = 8192 + (i - m * (NEL - 8192)); if (e > 8195 - m) *(LAS bf16*)(X.lds + m * CPS + 2 * e) = 0; }
#pragma unroll
    for (int half = 0; half < 2; ++half) {
        const v4u w = *(const v4u*)((half ? hb : hf) + 8 * tid);
        unsigned short v[8] = {(unsigned short)(w.x & 0xffff), (unsigned short)(w.x >> 16), (unsigned short)(w.y & 0xffff), (unsigned short)(w.y >> 16), (unsigned short)(w.z & 0xffff), (unsigned short)(w.z >> 16), (unsigned short)(w.w & 0xffff), (unsigned short)(w.w >> 16)};
        if (half == 0 && tid == 0) v[0] = (unsigned short)f2bf(bf2f(v[0]) + bias);
#pragma unroll
        for (int k = 0; k < 8; ++k) { const int d = 8 * tid + k; if (half == 1 && d == 0) continue;
            const int e0 = half ? 4100 + d : 4100 - d;
#pragma unroll
            for (int m = 0; m < 4; ++m) *(LAS bf16*)(X.lds + m * CPS + 2 * (e0 - m)) = v[k]; }
    }
}
#ifdef MK_HY_XLDS
#define HY_XL(qq) do { const v2u x0_ = *(const volatile LAS v2u*)(X.lds + baseA + 32 * (qq)), x1_ = *(const volatile LAS v2u*)(X.lds + baseA8 + 32 * (qq)); asm volatile("" :: "v"(x0_), "v"(x1_)); } while (0)
#else
#define HY_XL(qq) do {} while (0)
#endif
#define HY_LDA(dst, qq) do { HY_XL(qq); const v2u lo_ = *(const volatile LAS v2u*)(X.lds + baseA + 32 * (qq)), hi_ = *(const volatile LAS v2u*)(X.lds + baseA8 + 32 * (qq)); v4u w_ = {lo_.x, lo_.y, hi_.x, hi_.y}; dst = *reinterpret_cast<bf16x8*>(&w_); } while (0)
#define HY_LOAD_E(FA, FB, d1_, q_) do { const LAS unsigned char* zr_ = zb - (d1_) * ZROW; HY_LDA(FA[0], (q_)); HY_LDA(FA[1], (q_) + 1); \
    FB[0] = *(const LAS bf16x8*)(zr_); FB[1] = *(const LAS bf16x8*)(zr_ + 32); FB[2] = *(const LAS bf16x8*)(zr_ + 64); FB[3] = *(const LAS bf16x8*)(zr_ + 96); } while (0)
#define HY_LOAD_L(FA, q_) do { HY_LDA(FA[2], (q_) + 2); HY_LDA(FA[3], (q_) + 3); } while (0)
#ifdef MK_HY_XMFMA
#define HY_XM(A_, B_) do { dacc0 = __builtin_amdgcn_mfma_f32_32x32x16_bf16(A_, B_, dacc0, 0, 0, 0); } while (0)
#else
#define HY_XM(A_, B_) do {} while (0)
#endif
#define HY_MMA1(FA, FB, PA) do { __builtin_amdgcn_s_setprio(1); HY_XM(FA[0], FB[0]); HY_XM(PA[2], FB[0]); HY_XM(FA[1], FB[1]); HY_XM(PA[3], FB[1]); \
    acc0 = __builtin_amdgcn_mfma_f32_32x32x16_bf16(FA[0], FB[0], acc0, 0, 0, 0); acc1 = __builtin_amdgcn_mfma_f32_32x32x16_bf16(PA[2], FB[0], acc1, 0, 0, 0); \
    acc0 = __builtin_amdgcn_mfma_f32_32x32x16_bf16(FA[1], FB[1], acc0, 0, 0, 0); acc1 = __builtin_amdgcn_mfma_f32_32x32x16_bf16(PA[3], FB[1], acc1, 0, 0, 0); __builtin_amdgcn_s_setprio(0); } while (0)
#define HY_MMA2(FA, FB) do { __builtin_amdgcn_s_setprio(1); HY_XM(FA[2], FB[2]); HY_XM(FA[0], FB[2]); HY_XM(FA[3], FB[3]); HY_XM(FA[1], FB[3]); \
    acc0 = __builtin_amdgcn_mfma_f32_32x32x16_bf16(FA[2], FB[2], acc0, 0, 0, 0); acc1 = __builtin_amdgcn_mfma_f32_32x32x16_bf16(FA[0], FB[2], acc1, 0, 0, 0); \
    acc0 = __builtin_amdgcn_mfma_f32_32x32x16_bf16(FA[3], FB[3], acc0, 0, 0, 0); acc1 = __builtin_amdgcn_mfma_f32_32x32x16_bf16(FA[1], FB[3], acc1, 0, 0, 0); __builtin_amdgcn_s_setprio(0); } while (0)
template <int PAIR> __device__ __forceinline__ void channel(const Ctx& X, int l, int c, const float* __restrict__ hyb, v2u (&keep)[2][4]) {
    const bf16* UCT = (const bf16*)(X.ws + WS_UCT); const bf16* FILT = (const bf16*)(X.ws + WS_FILT) + (size_t)l * 4 * C * S; bf16* YH = (bf16*)(X.ws + WS_YH);
    const int tid = X.tid, lane = X.lane, wid = X.wave, r = lane & 31, h = lane >> 5, b = wid >> 1, jt = wid & 1;
    LAS unsigned char* zl = X.lds + OFF_Z;
    __syncthreads();
    v4u zero4 = {0u, 0u, 0u, 0u}; asm volatile("" : "+v"(zero4));
    for (int i = tid; i < 4 * 64 * 9; i += NTH) { const int bb = i / 576, rr = (i % 576) / 9, ch = i % 9; const int row = rr < 32 ? rr : 64 + rr;
        *(LAS v4u*)(zl + bb * ZB + row * ZROW + ch * 16) = zero4; }
    for (int i = tid; i < 4 * 64 * 8; i += NTH) { const int bb = i >> 9, s1 = (i >> 3) & 63, ch = i & 7;
        *(LAS v4u*)(zl + bb * ZB + (32 + s1) * ZROW + ch * 16) = *(const v4u*)(UCT + (size_t)c * T + bb * S + s1 * 64 + ch * 8); }
    const int m4 = (4 - (r & 3)) & 3;
    const int baseA = m4 * CPS + 2 * (8 * h - r + 4100 - m4);
    int baseA8 = baseA + 8; asm volatile("" : "+v"(baseA8));
    for (int o = 0; o < 2; ++o) {
        build_hrev(X, FILT + ((size_t)(2 * o) * C + c) * S, FILT + ((size_t)(2 * o + 1) * C + c) * S, hyb[(l * 2 + o) * C + c]);
#ifdef MK_HY_DUPBUILD
        asm volatile("" ::: "memory"); build_hrev(X, FILT + ((size_t)(2 * o) * C + c) * S, FILT + ((size_t)(2 * o + 1) * C + c) * S, hyb[(l * 2 + o) * C + c]);
#endif
        const bf16* gate = UCT + (size_t)((o + 1) * C + c) * T + (size_t)b * S;
        const int t1 = 32 * jt + r;
        v2u gw[2][4];
#pragma unroll
        for (int mt = 0; mt < 2; ++mt)
#pragma unroll
            for (int g = 0; g < 4; ++g) gw[mt][g] = *(const v2u*)(gate + t1 * 64 + 32 * mt + 8 * g + 4 * h);
        __syncthreads();
#ifndef MK_HY_SWEEPS
#define MK_HY_SWEEPS 1
#endif
        f32x16 acc0 = {}, acc1 = {};
#ifdef MK_HY_XMFMA
        f32x16 dacc0 = {};
#endif
        for (int rep = 0; rep < MK_HY_SWEEPS; ++rep) {
        const int d1max = 32 * jt + 31; int q = -4 * d1max;
        const LAS unsigned char* zb = zl + b * ZB + (32 + 32 * jt + r) * ZROW + 16 * h;
        bf16x8 fa0[4], fb0[4], fa1[4], fb1[4];
        HY_LDA(fa1[2], q - 2); HY_LDA(fa1[3], q - 1);
        HY_LOAD_E(fa0, fb0, d1max, q); HY_LOAD_L(fa0, q);
        int d1 = d1max;
        for (int it = 0; it < 47; ++it) {
            HY_LOAD_E(fa1, fb1, d1 - 1, q + 4);
            HY_MMA1(fa0, fb0, fa1);
            HY_LOAD_L(fa1, q + 4);
            HY_MMA2(fa0, fb0);
            HY_LOAD_E(fa0, fb0, d1 - 2, q + 8);
            HY_MMA1(fa1, fb1, fa0);
            HY_LOAD_L(fa0, q + 8);
            HY_MMA2(fa1, fb1);
            d1 -= 2; q += 8;
        }
        HY_MMA1(fa0, fb0, fa1); HY_MMA2(fa0, fb0);
        }
        if (MK_HY_SWEEPS == 2) { acc0 *= 0.5f; acc1 *= 0.5f; }
#ifdef MK_HY_XMFMA
        asm volatile("" :: "v"(dacc0));
#endif
        __syncthreads();
#pragma unroll
        for (int mt = 0; mt < 2; ++mt)
#pragma unroll
            for (int g = 0; g < 4; ++g) { const int t0 = 32 * mt + 8 * g + 4 * h; const v2u gwv = gw[mt][g];
                const f32x16& a = mt ? acc1 : acc0;
                const float y0 = a[4 * g] * bflo(gwv.x), y1 = a[4 * g + 1] * bfhi(gwv.x), y2 = a[4 * g + 2] * bflo(gwv.y), y3 = a[4 * g + 3] * bfhi(gwv.y);
                if (o == 0) { v2u w; w.x = pk2(y0, y1); w.y = pk2(y2, y3); *(LAS v2u*)(zl + b * ZB + (32 + t1) * ZROW + t0 * 2) = w; }
                else if (PAIR == 0) { keep[mt][g].x = pk2(y0, y1); keep[mt][g].y = pk2(y2, y3); }
                else { unsigned* yo = (unsigned*)(YH + ((size_t)b * S + t1 * 64 + t0) * C + (c - 1)); const v2u kp = keep[mt][g];
                    yo[0] = (kp.x & 0xffffu) | (f2bf(y0) << 16); yo[C / 2] = (kp.x >> 16) | (f2bf(y1) << 16); yo[C] = (kp.y & 0xffffu) | (f2bf(y2) << 16); yo[3 * C / 2] = (kp.y >> 16) | (f2bf(y3) << 16); } }
    }
    __syncthreads();
}
#undef HY_LDA
#undef HY_LOAD_E
#undef HY_LOAD_L
#undef HY_MMA1
#undef HY_MMA2
}
}
namespace mk {
#define GAS __attribute__((address_space(1)))
typedef GAS unsigned gu32;
typedef GAS unsigned long long gu64;
#define RLX_AGENT __ATOMIC_RELAXED, __HIP_MEMORY_SCOPE_AGENT
#define LDS_WAIT() asm volatile("s_waitcnt lgkmcnt(0)" ::: "memory")
#define VM_WAIT() asm volatile("s_waitcnt vmcnt(0)" ::: "memory")
__device__ __forceinline__ unsigned long long rt() { return __builtin_amdgcn_s_memrealtime(); }
#define XB_TMO      128
#define XB_XCNT(j)  (256  + 64 * (j))
#define XB_XSUB(j)  (1280 + 64 * (j))
#define XB_XGEN(j)  (2304 + 64 * (j))
#define XB_TOP      3328
#define XB_TOPGEN   3392
#define XCD_BAR_WORDS 3456
#define XB_SPIN_CAP (1u << 18)

__device__ __forceinline__ unsigned xb_ld(unsigned* p)              { return __hip_atomic_load(p, __ATOMIC_RELAXED, __HIP_MEMORY_SCOPE_AGENT); }
__device__ __forceinline__ unsigned xb_add(unsigned* p, unsigned v) { return __hip_atomic_fetch_add(p, v, __ATOMIC_RELAXED, __HIP_MEMORY_SCOPE_AGENT); }
__device__ __forceinline__ unsigned xb_xcc_id() { return (unsigned)__builtin_amdgcn_s_getreg((3 << 11) | 20) & 0xFu; }
#define XB_SPIN(cond, bar) do { unsigned _sp = 0; while (cond) { __builtin_amdgcn_s_sleep(1); \
    if ((++_sp & 255u) == 0u) { if (xb_ld(&(bar)[XB_TMO])) break; if (_sp > XB_SPIN_CAP) { atomicAdd(&(bar)[XB_TMO], 1u); break; } } } } while (0)

struct XcdBarrier {
    unsigned* bar; unsigned x;
    volatile LAS unsigned* st;
};

__device__ __forceinline__ XcdBarrier xcd_barrier_post(unsigned* bar, volatile LAS unsigned* st) {
    XcdBarrier b; b.bar = bar; b.x = xb_xcc_id(); b.st = st;
    if (threadIdx.x == 0) (void)xb_add(&bar[XB_XCNT(b.x)], 1u);
    return b;
}
__device__ __forceinline__ void xcd_barrier_complete(unsigned* bar, unsigned x, unsigned& nloc, unsigned& nx) {
    const unsigned G = gridDim.x * gridDim.y * gridDim.z;
    unsigned sum, cnt, mine, sp = 0u;
    for (;;) {
        sum = 0u; cnt = 0u; mine = 0u;
#pragma unroll
        for (unsigned j = 0; j < 16; ++j) { const unsigned c = xb_ld(&bar[XB_XCNT(j)]); sum += c; cnt += (c > 0u) ? 1u : 0u; mine = (j == x) ? c : mine; }
        if (sum == G) break;
        __builtin_amdgcn_s_sleep(1);
        if ((++sp & 255u) == 0u) { if (xb_ld(&bar[XB_TMO])) break; if (sp > XB_SPIN_CAP) { atomicAdd(&bar[XB_TMO], 1u); break; } }
    }
    nloc = mine > 0u ? mine : 1u; nx = cnt > 0u ? cnt : 1u;
}

__device__ __forceinline__ void xcd_barrier(const XcdBarrier& b, int wave_s) {
    asm volatile("s_waitcnt vmcnt(0)" ::: "memory");
    __syncthreads();
    if (fresh_tid(wave_s) == 0) {
        unsigned* bar = b.bar;
        __builtin_amdgcn_s_waitcnt(0);
        unsigned nloc = b.st[0], nx = b.st[1];
        if (nloc == 0u) { xcd_barrier_complete(bar, b.x, nloc, nx); b.st[0] = nloc; b.st[1] = nx; }
        const unsigned old = xb_add(&bar[XB_XSUB(b.x)], 1u);
        const unsigned gen = old / nloc;
        if (old + 1u == (gen + 1u) * nloc) {
            __builtin_amdgcn_fence(__ATOMIC_RELEASE, "agent");
            asm volatile("s_waitcnt vmcnt(0)" ::: "memory");
            const unsigned og = xb_add(&bar[XB_TOP], 1u);
            const unsigned tg = og / nx;
            if (og + 1u == (tg + 1u) * nx) xb_add(&bar[XB_TOPGEN], 1u);
            else XB_SPIN(xb_ld(&bar[XB_TOPGEN]) == tg, bar);
            __builtin_amdgcn_fence(__ATOMIC_ACQUIRE, "agent");
            xb_add(&bar[XB_XGEN(b.x)], 1u);
            asm volatile("s_waitcnt vmcnt(0)" ::: "memory");
        } else {
            XB_SPIN(xb_ld(&bar[XB_XGEN(b.x)]) == gen, bar);
            __builtin_amdgcn_fence(__ATOMIC_ACQUIRE, "agent");
            asm volatile("s_waitcnt vmcnt(0)" ::: "memory");
        }
    }
    __syncthreads();
}

}
namespace mk {
namespace cg = cooperative_groups;
constexpr int PH_PER_LAYER = 11, N_PHASES = 1 + 2 * PH_PER_LAYER;

__device__ __forceinline__ float lam_of(const Args& a, int l, float lam_init) {
    const float *q1 = a.in[14] + l * 64, *k1 = a.in[15] + l * 64, *q2 = a.in[16] + l * 64, *k2 = a.in[17] + l * 64;
    float s1 = 0.f, s2 = 0.f; for (int i = 0; i < 64; ++i) { s1 += q1[i] * k1[i]; s2 += q2[i] * k2[i]; }
    return expf(s1) - expf(s2) + lam_init;
}

typedef const __attribute__((address_space(4))) Args* KArgPtr;
__global__ void __launch_bounds__(NTH, 2) fwd(Args a_byval) {
    extern __shared__ __attribute__((aligned(16))) unsigned char lds_raw[];
    cg::grid_group grid = cg::this_grid();
    const int ph_lo = a_byval.ph_lo, ph_hi = a_byval.ph_hi;
    const int wave_s = __builtin_amdgcn_readfirstlane((int)threadIdx.x >> 6);
    volatile LAS unsigned* bar_st = (volatile LAS unsigned*)((LAS unsigned char*)lds_raw + LDS_BYTES - 64);
    if (threadIdx.x == 0) { bar_st[0] = 0u; bar_st[1] = 0u; }
    __syncthreads();
    const XcdBarrier bar = xcd_barrier_post((unsigned*)a_byval.ws, bar_st);
    int rep_flag = 0;
    for (int ph = ph_lo; ph < ph_hi; ++ph) {
        KArgPtr ap = (KArgPtr)__builtin_amdgcn_kernarg_segment_ptr(); asm volatile("" : "+s"(ap));
        const Args a = *(const Args*)ap;
        float* Xr = (float*)(a.ws + WS_X);
        Ctx X; X.wave_s = wave_s; X.wave = wave_s; X.tid = 0; X.lane = 0;
#define FRESH() do { X.tid = fresh_tid(wave_s); X.lane = X.tid & 63; } while (0)
        { int g_ = gridDim.x, b_ = blockIdx.x; asm volatile("" : "+s"(g_), "+s"(b_)); X.G = g_; X.bid = b_; }
        { const int bx = X.bid; X.vcu = (X.G % 8 == 0) ? (bx % 8) * (X.G / 8) + bx / 8 : bx; }
        X.gw = X.vcu * NWAVES + X.wave; X.ngw = X.G * NWAVES; X.lds = (LAS unsigned char*)lds_raw; X.ws = a.ws;
#ifndef MK_EN
#define MK_EN 0xFFFF
#endif
#ifndef MK_ATT
#define MK_ATT 3
#endif
#ifndef MK_REP_SP
#define MK_REP_SP 99
#endif
        if (ph == 0) { if (MK_EN & 512) { FRESH(); p0_prologue(X, a); } }
        else {
            const int l = (ph - 1) / PH_PER_LAYER, sp = (ph - 1) % PH_PER_LAYER;
            const float lam_init = 0.8f - 0.6f * expf(-0.3f * (float)l);
            if (0) {}
#if MK_EN & 1
            else if (sp == 0) {
                FRESH();
                pg8::Gemm g{(const bf16*)(a.ws + WS_XN), (const bf16*)(a.ws + WS_WIN) + (size_t)l * INW * D, T, INW, D};
                pg8::StaticOrder So; So.init(T, INW, X.G, X.bid);
                EpiWin Ep{a.ws, (const float*)(a.ws + WS_BINP) + l * INW, (const float*)(a.ws + WS_ROPE)};
                pg8::gemm_phase<EpiWin, pg8::StaticOrder, true, true>(X.lds, g, So, Ep, X.tid);
            }
#endif
#if MK_EN & 2
            else if (sp == 1) {
                FRESH();
                p1t_shortconv(X, a.in[4] + l * 3 * 1536, a.in[5] + l * 1536);
                p1t_kmax(X, (unsigned*)(a.ws + 14336) + l * 32);
            }
#endif
#if MK_EN & 4
            else if (sp == 2) {
                FRESH();
                const float lam = lam_of(a, l, lam_init);
                const int c = X.bid;
#ifndef MK_REP_ATT
#define MK_REP_ATT 1
#endif
#ifndef MK_CONV_REP
#define MK_CONV_REP 1
#endif
#ifndef MK_REP_HY
#define MK_REP_HY 1
#endif
                const int cg_ = X.vcu & 3;
                if (cg_ == 0) { __syncthreads(); p0_experts(relaunder(X), a, l); if (MK_CONV_REP > 1) { __syncthreads(); p0_experts(relaunder(X), a, l); } __syncthreads(); }
                for (int rep = 0; rep < MK_REP_ATT; ++rep) for (int u = c; u < 256; u += X.G) { const int bh = 2 * (u & 7) + ((u >> 3) >> 4), qb = (u >> 3) & 15; at::attn_unit(X, bh >> 2, bh & 3, qb, lam, 1.0f - lam_init, a.in[18] + l * 128, (unsigned*)(a.ws + 14336) + l * 32); }
                if (cg_ == 1) { __syncthreads(); p0_experts(relaunder(X), a, l); if (MK_CONV_REP > 1) { __syncthreads(); p0_experts(relaunder(X), a, l); } __syncthreads(); }
                for (int rep = 0; rep < MK_REP_HY; ++rep) for (int u = c; u < 256; u += X.G) { const int ch = 64 * (u & 7) + 2 * (u >> 3); v2u keep[2][4]; hy::channel<0>(relaunder(X), l, ch, a.in[13], keep);
                    if (cg_ == 2) { __syncthreads(); p0_experts(relaunder(X), a, l); if (MK_CONV_REP > 1) { __syncthreads(); p0_experts(relaunder(X), a, l); } __syncthreads(); }
                    hy::channel<1>(relaunder(X), l, ch + 1, a.in[13], keep); }
                if (cg_ == 3) { __syncthreads(); p0_experts(relaunder(X), a, l); if (MK_CONV_REP > 1) { __syncthreads(); p0_experts(relaunder(X), a, l); } __syncthreads(); }
            }
#endif
#if MK_EN & 8
            else if (sp == 3) {
                FRESH();
                OrderMerge So; So.so.init(T, D, X.G, X.bid);
                pg8::Gemm g{(const bf16*)(a.ws + WS_YH), (const bf16*)(a.ws + WS_WUH) + (size_t)l * 2 * D * C, 2 * T, 2 * D, C};
                EpiMerge2 Ep{(const bf16*)(a.ws + WS_GH), (const bf16*)(a.ws + WS_GA), (bf16*)(a.ws + WS_T1), (bf16*)(a.ws + WS_MG)};
                pg8::gemm_phase<EpiMerge2, OrderMerge, true, true>(X.lds, g, So, Ep, X.tid);
            }
#endif
#if MK_EN & 16
            else if (sp == 4) {
                FRESH();
                pg8::Gemm g{(const bf16*)(a.ws + WS_MG), (const bf16*)(a.ws + WS_WOUT) + (size_t)l * D * D, T, D, D};
                pg8::StaticOrder So; So.init(T, D, X.G, X.bid);
                EpiOut Ep{l == 0 ? a.in[0] : Xr, Xr};
                pg8::gemm_phase<EpiOut, pg8::StaticOrder, true, true>(X.lds, g, So, Ep, X.tid);
            }
#endif
#if MK_EN & 32
            else if (sp == 5) {
                FRESH();
                p5_norm_router(X, Xr, a.in[22] + l * D, a.in[23] + (size_t)l * D * E, a.in[24] + l * E);
            } else if (sp == 6) { FRESH(); p6_topk(X);
            } else if (sp == 7) { FRESH(); p6_gather(X);
            }
#endif
#if MK_EN & 64
            else if (sp == 8) {
                FRESH();
                pg8::Gemm g{(const bf16*)(a.ws + WS_XG), (const bf16*)(a.ws + WS_WGU) + (size_t)l * E * 2 * F * D, E * 2048, 2 * F, D, 2 * F, 4, (size_t)2 * F * D * 2};
                OrderMoE1 So{X.G, X.bid}; EpiSwiGLU Ep{(bf16*)(a.ws + WS_HB)};
                pg8::gemm_phase<EpiSwiGLU, OrderMoE1, true, true, true>(X.lds, g, So, Ep, X.tid);
            }
#endif
#if MK_EN & 128
            else if (sp == 9) {
                FRESH();
                pg8::Gemm g{(const bf16*)(a.ws + WS_HB), (const bf16*)(a.ws + WS_WD) + (size_t)l * E * D * F, E * 2048, D, F, D, 2, (size_t)D * F * 2};
                OrderMoE2 So{X.G, X.bid}; EpiDown Ep{(bf16*)(a.ws + WS_YE), (const float*)(a.ws + WS_GATE)};
                pg8::gemm_phase<EpiDown, OrderMoE2, true, true, true>(X.lds, g, So, Ep, X.tid);
            }
#endif
#if MK_EN & 256
            else if (sp == 10) {
                FRESH();
                p9_combine(X, Xr, l == 0 ? a.in[1] + D : a.in[28], l == 1, a.out);
            }
#endif
        }
#ifndef MK_EXTRA_SYNC
#define MK_EXTRA_SYNC 0
#endif
        if (ph + 1 < ph_hi) { if (ph_hi > 4096) grid.sync(); else xcd_barrier(bar, wave_s); }
        for (int es = 0; es < MK_EXTRA_SYNC; ++es) xcd_barrier(bar, wave_s);
        if (MK_REP_SP != 99) { const int sp_ = ph == 0 ? -1 : (ph - 1) % PH_PER_LAYER; if (sp_ == MK_REP_SP && rep_flag == 0) { rep_flag = 1; --ph; } else rep_flag = 0; }
    }
}

static int g_grid = 0;
static bool mega_setup() {
    if (g_grid) return g_grid > 0;
    int dev = 0, cus = 0, per_cu = 0;
    if (hipGetDevice(&dev) != hipSuccess || hipDeviceGetAttribute(&cus, hipDeviceAttributeMultiprocessorCount, dev) != hipSuccess) { g_grid = -1; return false; }
    if (hipFuncSetAttribute((const void*)fwd, hipFuncAttributeMaxDynamicSharedMemorySize, LDS_BYTES) != hipSuccess) { fprintf(stderr, "hipFuncSetAttribute failed\n"); g_grid = -1; return false; }
    if (hipOccupancyMaxActiveBlocksPerMultiprocessor(&per_cu, (const void*)fwd, NTH, LDS_BYTES) != hipSuccess || per_cu < 1) { fprintf(stderr, "occupancy query failed (%d)\n", per_cu); g_grid = -1; return false; }
    g_grid = cus * 1;
    return true;
}
static void mega_launch(hipStream_t st, void* const* d_in, float* d_out, unsigned char* ws, int ph_lo, int ph_hi, int p0_mask) {
    if (!mega_setup()) return;
    Args a{};
    for (int i = 0; i < 29; ++i) a.in[i] = (const float*)d_in[i];
    a.out = d_out; a.ws = ws; a.ph_lo = ph_lo; a.ph_hi = ph_hi; a.p0_mask = p0_mask; a.pad = 0;
    if (hipMemsetAsync(ws, 0, 16384, st) != hipSuccess) { fprintf(stderr, "memset of the barrier words failed\n"); return; }
    void* args[] = {&a};
    const hipError_t e = hipLaunchCooperativeKernel((const void*)fwd, dim3(g_grid), dim3(NTH), args, LDS_BYTES, st);
    if (e != hipSuccess) fprintf(stderr, "cooperative launch failed: %s (grid %d)\n", hipGetErrorString(e), g_grid);
}
}
extern "C" void kernel_launch(void* const* d_in, const int* in_sizes, int n_in, void* d_out, int out_size, void* d_ws, size_t ws_size, hipStream_t stream) {
    if (n_in != 29 || out_size != mk::T * mk::D || ws_size < mk::WS_END) { fprintf(stderr, "kernel_launch: unexpected sizes n_in %d out %d ws %zu\n", n_in, out_size, ws_size); return; }
    mk::mega_launch(stream, d_in, (float*)d_out, (unsigned char*)d_ws, 0, mk::N_PHASES, 13);
}
```

```cpp
#include <hip/hip_runtime.h>
#include <hip/hip_cooperative_groups.h>
#include <cstdio>
#include <cstdint>
#include <cmath>
namespace tk {
constexpr int S = 4096, E = 16, CAP = 512, NT = 512;
__device__ __forceinline__ void topk_problem(const float* __restrict__ aff, int tokbase, int e, int slotbase, int* __restrict__ rows, float* __restrict__ gate, int* __restrict__ inv, int* sm, int tid) {
    const int lane = tid & 63, wid = tid >> 6;
    int* hist = sm; int* ctl = sm + 256;
    unsigned key[8];
    { const uint4 a = ((const uint4*)aff)[tid * 2], b = ((const uint4*)aff)[tid * 2 + 1];
      key[0] = a.x; key[1] = a.y; key[2] = a.z; key[3] = a.w; key[4] = b.x; key[5] = b.y; key[6] = b.z; key[7] = b.w; }
    unsigned prefix = 0u, mask = 0u; int kth = CAP;
    for (int pass = 3; pass >= 0; --pass) {
        __syncthreads();
        if (tid < 256) hist[tid] = 0;
        __syncthreads();
#pragma unroll
        for (int i = 0; i < 8; ++i) if ((key[i] & mask) == prefix) atomicAdd(&hist[(key[i] >> (8 * pass)) & 255u], 1);
        __syncthreads();
        if (tid < 64) {
            const int b0 = hist[4 * lane], b1 = hist[4 * lane + 1], b2 = hist[4 * lane + 2], b3 = hist[4 * lane + 3];
            const int tot = b0 + b1 + b2 + b3;
            int suf = tot;
#pragma unroll
            for (int o = 1; o < 64; o <<= 1) { const int v = __builtin_amdgcn_ds_bpermute(((lane + o) & 63) << 2, suf); if (lane + o < 64) suf += v; }
            const int above = suf - tot;
            if (above < kth && kth <= above + tot) {
                int cum = above, bin, k2;
                if (cum + b3 >= kth) { bin = 4 * lane + 3; k2 = kth - cum; }
                else { cum += b3; if (cum + b2 >= kth) { bin = 4 * lane + 2; k2 = kth - cum; }
                else { cum += b2; if (cum + b1 >= kth) { bin = 4 * lane + 1; k2 = kth - cum; }
                else { cum += b1; bin = 4 * lane; k2 = kth - cum; } } }
                ctl[0] = bin; ctl[1] = k2;
            }
        }
        __syncthreads();
        prefix |= ((unsigned)ctl[0]) << (8 * pass); mask |= 0xFFu << (8 * pass); kth = ctl[1];
    }
    const unsigned thr = prefix; const int need_eq = kth; const int n_gt = CAP - need_eq;
    int cg = 0, ce = 0;
#pragma unroll
    for (int i = 0; i < 8; ++i) { cg += key[i] > thr; ce += key[i] == thr; }
    int sg = cg, se = ce;
#pragma unroll
    for (int o = 1; o < 64; o <<= 1) { const int a = __builtin_amdgcn_ds_bpermute(((lane - o) & 63) << 2, sg), b = __builtin_amdgcn_ds_bpermute(((lane - o) & 63) << 2, se); if (lane >= o) { sg += a; se += b; } }
    __syncthreads();
    if (lane == 63) { ctl[8 + wid] = sg; ctl[16 + wid] = se; }
    __syncthreads();
    int og = sg - cg, oe = se - ce;
    for (int w = 0; w < wid; ++w) { og += ctl[8 + w]; oe += ctl[16 + w]; }
#pragma unroll
    for (int i = 0; i < 8; ++i) {
        const int idx = tid * 8 + i; int slot = -1;
        if (key[i] > thr) slot = og++;
        else if (key[i] == thr) { if (oe < need_eq) slot = n_gt + oe; ++oe; }
        if (slot >= 0) { rows[slot] = tokbase + idx; gate[slot] = __uint_as_float(key[i]); }
        inv[(size_t)(tokbase + idx) * E + e] = slot >= 0 ? slotbase + slot : -1;
    }
    __syncthreads();
}
}
namespace pg8 {
#define PG8_LAS __attribute__((address_space(3)))
typedef unsigned short bf16_t;
typedef short bf16x8 __attribute__((ext_vector_type(8)));
typedef float f32x4 __attribute__((ext_vector_type(4)));
typedef unsigned u32x4 __attribute__((ext_vector_type(4)));
typedef short s16x4 __attribute__((ext_vector_type(4)));
constexpr int BM = 256, BK = 64, HALF = 128, HTB = HALF * BK * 2  , STAGE_BYTES = 8 * HTB, NXCD = 8, WGM = 8;

__host__ __device__ __forceinline__ int lds_byte(int r, int c) { const int st = (r >> 4) * 2 + (c >> 5), rr = r & 15, cc = c & 31, ob = rr * 64 + cc * 2; return st * 1024 + (ob ^ (((ob >> 9) & 1) << 5)); }
__host__ __device__ __forceinline__ void stage_rc(int b, int& R, int& C) { const int st = b / 1024, sb = b % 1024, swz = sb ^ (((sb >> 9) & 1) << 5); R = (st >> 1) * 16 + swz / 64; C = (st & 1) * 32 + (swz % 64) / 2; }
__host__ __device__ __forceinline__ int perm32(int rho) { const int n = rho >> 4, i = rho & 15; return 8 * (i >> 2) + 4 * n + (i & 3); }

struct Unit { int pm, pn, pb, pa; };
struct Gemm { const bf16_t* A; const bf16_t* Bt; int M, N, K; int bN = 0, bsh = 0; size_t bes = 0; const int* arows = nullptr; };

struct StaticOrder {
    int nM, nN, nwg, G, c;
    __host__ __device__ void init(int M, int N, int G_, int c_) { nM = M / BM; nN = N / BM; nwg = nM * nN; G = G_; c = c_; }
    __host__ __device__ bool next(int i, Unit& u) const {
        const long L = (long)i * G + c; if (L >= nwg) return false;
        int wgid = (int)L; { const int q = nwg / NXCD, r = nwg % NXCD, xcd = wgid % NXCD, off = wgid / NXCD; wgid = (xcd < r ? xcd * (q + 1) : r * (q + 1) + (xcd - r) * q) + off; }
        const int nig = WGM * nN, gid = wgid / nig, fm = gid * WGM, gsz = (nM - fm) < WGM ? (nM - fm) : WGM;
        u.pm = fm + ((wgid % nig) % gsz); u.pn = (wgid % nig) / gsz; u.pb = u.pn; u.pa = u.pm; return true;
    }
    __device__ __forceinline__ void a_ready(const Unit&) const {}
    __device__ __forceinline__ void done(const Unit&) const {}
};

template <class Epi, class Sched, bool ALIGN_EPI = false, bool SP2 = false, bool BT = false, bool GA = false>
__device__ __forceinline__ void gemm_phase(PG8_LAS unsigned char* lds, const Gemm g, const Sched& S, const Epi& E, int tid) {
    asm volatile("" : "+v"(tid));
    const int wid = __builtin_amdgcn_readfirstlane(tid >> 6), lane = tid & 63, wr = wid >> 2, wc = wid & 3, fr = lane & 15, fq = lane >> 4;
    const int K = g.K, nt = K / BK;
    unsigned voffA[2], voffB[2];
#pragma unroll
    for (int i = 0; i < 2; ++i) { int R, C; stage_rc(tid * 16 + i * 8192, R, C); const int Rb = Epi::PERM ? ((R & ~31) + perm32(R & 31)) : R;
        voffA[i] = (unsigned)(R * K + C) * 2u; voffB[i] = (unsigned)(Rb * K + C) * 2u; if constexpr (GA) voffA[i] = (unsigned)C * 2u;
        if constexpr (BT) { const int p = i * 512 + tid, row = ((p >> 7) << 3) | ((p >> 2) & 7), ch = (((p >> 5) & 3) << 2) | ((p & 3) ^ ((row >> 2) & 3));
            voffB[i] = (unsigned)(row * g.bN + 8 * ch) * 2u; } }
    const size_t kstep = (size_t)(BK * 2);
    const size_t hstep = (size_t)HALF * K * 2;
    const size_t tstep = 2 * hstep;
    const size_t kstepB = BT ? (size_t)BK * g.bN * 2 : kstep, hstepB = BT ? (size_t)HALF * 2 : hstep;
    const size_t hstepA = GA ? 0 : hstep;
    unsigned curA[2][2] = {{0u, 0u}, {0u, 0u}};
    PG8_LAS int* rowtab0 = (PG8_LAS int*)(lds + STAGE_BYTES);
#define PG8_ROWTAB (rowtab0 + ((ui + 1) & 1) * 512)
#define PG8_NXTOFF(o_, h) do { int t_ = tid; asm volatile("" : "+v"(t_)); _Pragma("unroll") for (int i_ = 0; i_ < 2; ++i_) { int R_, C_; stage_rc(t_ * 16 + i_ * 8192, R_, C_); \
        o_[i_] = (unsigned)PG8_ROWTAB[(h) * 128 + R_] * (unsigned)(K * 2) + (unsigned)C_ * 2u; } } while (0)
#define PG8_STAGE_A(bufoff, kbase, h, nx) do { if constexpr (GA) { if (nx) { unsigned o_[2]; PG8_NXTOFF(o_, h); PG8_STAGE(bufoff, kbase, o_); } else PG8_STAGE(bufoff, kbase, curA[h]); } \
        else PG8_STAGE(bufoff, (kbase) + ((h) ? hstep : 0), voffA); } while (0)
#define PG8_BBASE(pb) ((const char*)g.Bt + (BT ? (size_t)((pb) >> g.bsh) * g.bes + (size_t)((pb) & ((1 << g.bsh) - 1)) * 512 : (size_t)(pb) * tstep))
    const unsigned ldsw = (unsigned)wid * 1024u;
    const int aoff = lds_byte(wr * 64 + fr, fq * 8), boff = lds_byte(wc * 32 + fr, fq * 8);
    int tr0 = 0, tr1 = 0;
    if constexpr (BT) { static_assert(Epi::PERM, "BT needs the PERM column order"); const int q_ = (lane >> 2) & 3, p_ = lane & 3, f1_ = fq & 1;
        const int L_ = (int)(size_t)lds + 2048 * fq + 512 * wc + 64 * q_ + 32 * ((p_ >> 1) ^ f1_); tr0 = L_ + 16 * (p_ & 1); tr1 = L_ + 256 + 16 * (1 - (p_ & 1)); }
#define PG8_SA(b, h) (((b) * 2 + (h)) * HTB)
#define PG8_SB(b, h) ((4 + (b) * 2 + (h)) * HTB)
#define PG8_STAGE(bufoff, gbase, voff) do { _Pragma("unroll") for (int _i = 0; _i < 2; ++_i) \
        __builtin_amdgcn_global_load_lds((const unsigned*)((const char*)(gbase) + (voff)[_i]), (PG8_LAS unsigned*)(lds + (bufoff) + ldsw + _i * 8192), 16, 0, 0); } while (0)
#define PG8_LDA(dst, b, h) do { _Pragma("unroll") for (int m = 0; m < 4; ++m) _Pragma("unroll") for (int k = 0; k < 2; ++k) dst[m][k] = *(const PG8_LAS bf16x8*)(lds + PG8_SA(b, h) + aoff + m * 2048 + k * 1024); } while (0)
#define PG8_TR(dst4, addr, OFF) asm volatile("ds_read_b64_tr_b16 %0, %1 offset:%2" : "=&v"(dst4) : "v"(addr), "i"(OFF) : "memory")
#define PG8_TRF(dst8, a0, a1, OFF) do { s16x4 lo_, hi_; PG8_TR(lo_, a0, OFF); PG8_TR(hi_, a1, OFF); dst8 = __builtin_shufflevector(lo_, hi_, 0, 1, 2, 3, 4, 5, 6, 7); } while (0)
#define PG8_LDB(dst, b, h) do { if constexpr (BT) { const int a0_ = tr0 + PG8_SB(b, h), a1_ = tr1 + PG8_SB(b, h); \
        PG8_TRF(dst[0][0], a0_, a1_, 0); PG8_TRF(dst[0][1], a0_, a1_, 8192); PG8_TRF(dst[1][0], a0_, a1_, 8); PG8_TRF(dst[1][1], a0_, a1_, 8200); } else { \
    _Pragma("unroll") for (int n = 0; n < 2; ++n) _Pragma("unroll") for (int k = 0; k < 2; ++k) dst[n][k] = *(const PG8_LAS bf16x8*)(lds + PG8_SB(b, h) + boff + n * 2048 + k * 1024); } } while (0)
#define PG8_MMA(ai, bj, At, Bt) do { __builtin_amdgcn_s_setprio(1); _Pragma("unroll") for (int m = 0; m < 4; ++m) _Pragma("unroll") for (int n = 0; n < 2; ++n) _Pragma("unroll") for (int k = 0; k < 2; ++k) \
        acc[ai][bj][m][n] = __builtin_amdgcn_mfma_f32_16x16x32_bf16(Bt[n][k], At[m][k], acc[ai][bj][m][n], 0, 0, 0); __builtin_amdgcn_s_setprio(0); } while (0)
#define PG8_WAIT_V(n) asm volatile("s_waitcnt vmcnt(" #n ")" ::: "memory")
#define PG8_WAIT_L(n) asm volatile("s_waitcnt lgkmcnt(" #n ")" ::: "memory")
#define PG8_BAR __builtin_amdgcn_s_barrier()
#define PG8_SCHED __builtin_amdgcn_sched_barrier(0)
    Unit cur, nxt; int ui = 0;
    if (!S.next(0, cur)) return;
    f32x4 acc[2][2][4][2];
#pragma unroll
    for (int a = 0; a < 2; ++a)
#pragma unroll
        for (int b = 0; b < 2; ++b)
#pragma unroll
            for (int m = 0; m < 4; ++m)
#pragma unroll
                for (int n = 0; n < 2; ++n) acc[a][b][m][n] = (f32x4){0.f, 0.f, 0.f, 0.f};
    bf16x8 At[4][2], B0[2][2], B1[2][2];
    const char* cA = (const char*)g.A + (GA ? 0 : (size_t)cur.pa * tstep); const char* cB = PG8_BBASE(cur.pb);
    if constexpr (GA) {
#pragma unroll
        for (int h = 0; h < 2; ++h)
#pragma unroll
            for (int i = 0; i < 2; ++i) { int R, C; stage_rc(tid * 16 + i * 8192, R, C);
                curA[h][i] = (unsigned)__hip_atomic_load(g.arows + cur.pa * 256 + h * 128 + R, __ATOMIC_RELAXED, __HIP_MEMORY_SCOPE_AGENT) * (unsigned)(K * 2) + (unsigned)C * 2u; } }
    S.a_ready(cur);
    if constexpr (SP2) {
        PG8_STAGE(PG8_SB(0, 0), cB, voffB); PG8_STAGE(PG8_SB(0, 1), cB + hstepB, voffB); PG8_STAGE_A(PG8_SA(0, 0), cA, 0, false); PG8_STAGE_A(PG8_SA(0, 1), cA, 1, false);
        if (wr == 1) PG8_BAR;
        PG8_WAIT_V(2); PG8_BAR;
        PG8_STAGE(PG8_SB(1, 0), cB + kstepB, voffB); PG8_STAGE_A(PG8_SA(1, 0), cA + kstep, 0, false); PG8_STAGE(PG8_SB(1, 1), cB + hstepB + kstepB, voffB);
        PG8_WAIT_V(6); PG8_BAR;
    } else {
        PG8_STAGE(PG8_SB(0, 0), cB, voffB); PG8_STAGE_A(PG8_SA(0, 0), cA, 0, false); PG8_STAGE(PG8_SB(0, 1), cB + hstepB, voffB); PG8_STAGE_A(PG8_SA(0, 1), cA, 1, false);
        if (wr == 1) PG8_BAR;
        PG8_WAIT_V(4); PG8_BAR;
        PG8_STAGE(PG8_SB(1, 0), cB + kstepB, voffB); PG8_STAGE_A(PG8_SA(1, 0), cA + kstep, 0, false); PG8_STAGE(PG8_SB(1, 1), cB + hstepB + kstepB, voffB);
        PG8_WAIT_V(6); PG8_BAR;
    }
    for (;;) {
        const bool has_next = S.next(ui + 1, nxt);
        const char* nA = (has_next && !GA) ? (const char*)g.A + (size_t)nxt.pa * tstep : cA; const char* nB = has_next ? PG8_BBASE(nxt.pb) : cB;
        for (int t = 0; t < nt; t += 2) {
            const bool last = (t == nt - 2);
            const char* a1 = cA + (size_t)(t + 1) * kstep;
            const char* a2 = last ? nA : cA + (size_t)(t + 2) * kstep; const char* b2 = last ? nB : cB + (size_t)(t + 2) * kstepB;
            const char* a3 = a2 + kstep; const char* b3 = b2 + kstepB;
            if (last && has_next) S.a_ready(nxt);
            const bool nx = GA && last && has_next;
            if constexpr (GA) {
                if (t == 0 && has_next) { int l_ = lane; asm volatile("" : "+v"(l_)); __builtin_amdgcn_global_load_lds((const unsigned*)(g.arows + nxt.pa * 256 + (wid & 3) * 64 + l_), (PG8_LAS unsigned*)(PG8_ROWTAB + wid * 64), 4, 0, 0); }
            }
            if constexpr (SP2) {
            PG8_LDB(B0, 0, 0); PG8_LDB(B1, 0, 1); PG8_SCHED; PG8_LDA(At, 0, 0); PG8_STAGE_A(PG8_SA(1, 1), a1, 1, false);
            PG8_WAIT_V(8); PG8_WAIT_L(0); PG8_BAR; PG8_MMA(0, 0, At, B0); PG8_MMA(0, 1, At, B1); PG8_BAR; PG8_SCHED;
            PG8_LDA(At, 0, 1); PG8_STAGE(PG8_SB(0, 0), b2, voffB); PG8_STAGE(PG8_SB(0, 1), b2 + hstepB, voffB); PG8_STAGE_A(PG8_SA(0, 0), a2, 0, nx);
            PG8_WAIT_V(8); PG8_WAIT_L(0); PG8_BAR; PG8_MMA(1, 0, At, B0); PG8_MMA(1, 1, At, B1); PG8_BAR; PG8_SCHED;
            PG8_LDB(B0, 1, 0); PG8_LDB(B1, 1, 1); PG8_SCHED; PG8_LDA(At, 1, 0); PG8_STAGE_A(PG8_SA(0, 1), a2, 1, nx);
            PG8_WAIT_V(8); PG8_WAIT_L(0); PG8_BAR; PG8_MMA(0, 0, At, B0); PG8_MMA(0, 1, At, B1); PG8_BAR; PG8_SCHED;
            PG8_LDA(At, 1, 1); PG8_STAGE(PG8_SB(1, 0), b3, voffB); PG8_STAGE(PG8_SB(1, 1), b3 + hstepB, voffB); PG8_STAGE_A(PG8_SA(1, 0), a3, 0, nx);
            PG8_WAIT_V(8); PG8_WAIT_L(0); PG8_BAR; PG8_MMA(1, 0, At, B0); PG8_MMA(1, 1, At, B1); PG8_BAR; PG8_SCHED;
            } else {
            PG8_LDB(B0, 0, 0); PG8_SCHED; PG8_LDA(At, 0, 0); PG8_STAGE_A(PG8_SA(1, 1), a1, 1, false);
            PG8_WAIT_L(8); PG8_BAR; PG8_WAIT_L(0); PG8_MMA(0, 0, At, B0); PG8_BAR; PG8_SCHED;
            PG8_LDB(B1, 0, 1); PG8_STAGE(PG8_SB(0, 0), b2, voffB);
            PG8_BAR; PG8_WAIT_L(0); PG8_MMA(0, 1, At, B1); PG8_BAR;
            PG8_LDA(At, 0, 1); PG8_STAGE_A(PG8_SA(0, 0), a2, 0, nx);
            PG8_BAR; PG8_WAIT_L(0); PG8_MMA(1, 0, At, B0); PG8_BAR; PG8_SCHED;
            PG8_STAGE(PG8_SB(0, 1), b2 + hstepB, voffB);
            PG8_WAIT_V(6); PG8_BAR; PG8_MMA(1, 1, At, B1); PG8_BAR;
            PG8_LDB(B0, 1, 0); PG8_SCHED; PG8_LDA(At, 1, 0); PG8_STAGE_A(PG8_SA(0, 1), a2, 1, nx);
            PG8_WAIT_L(8); PG8_BAR; PG8_WAIT_L(0); PG8_MMA(0, 0, At, B0); PG8_BAR; PG8_SCHED;
            PG8_LDB(B1, 1, 1); PG8_STAGE(PG8_SB(1, 0), b3, voffB);
            PG8_BAR; PG8_WAIT_L(0); PG8_MMA(0, 1, At, B1); PG8_BAR;
            PG8_LDA(At, 1, 1); PG8_STAGE_A(PG8_SA(1, 0), a3, 0, nx);
            PG8_BAR; PG8_WAIT_L(0); PG8_MMA(1, 0, At, B0); PG8_BAR; PG8_SCHED;
            PG8_STAGE(PG8_SB(1, 1), b3 + hstepB, voffB);
            PG8_WAIT_V(6); PG8_BAR; PG8_MMA(1, 1, At, B1); PG8_BAR;
            }
        }
        if constexpr (ALIGN_EPI) { if (wr == 0) PG8_BAR; }
        if constexpr (!Epi::AFTER_DRAIN) { E(acc, cur, wr, wc, fr, fq); S.done(cur); }
        if (!has_next) break;
#pragma unroll
        for (int a = 0; a < 2; ++a)
#pragma unroll
            for (int b = 0; b < 2; ++b)
#pragma unroll
                for (int m = 0; m < 4; ++m)
#pragma unroll
                    for (int n = 0; n < 2; ++n) acc[a][b][m][n] = (f32x4){0.f, 0.f, 0.f, 0.f};
        if constexpr (GA) { PG8_NXTOFF(curA[0], 0); PG8_NXTOFF(curA[1], 1); }
        cur = nxt; cA = nA; cB = nB; ++ui;
        if constexpr (ALIGN_EPI) { if (wr == 1) PG8_BAR; }
    }
    PG8_WAIT_V(0);
    if constexpr (!ALIGN_EPI) { if (wr == 0) PG8_BAR; }
    PG8_BAR;
    if constexpr (Epi::AFTER_DRAIN) { E.fused(acc, cur, wr, wc, fr, fq, lds, wid, lane); S.done(cur); }
#undef PG8_SA
#undef PG8_SB
#undef PG8_STAGE
#undef PG8_STAGE_A
#undef PG8_NXTOFF
#undef PG8_ROWTAB
#undef PG8_LDA
#undef PG8_LDB
#undef PG8_TR
#undef PG8_TRF
#undef PG8_BBASE
#undef PG8_MMA
#undef PG8_WAIT_V
#undef PG8_WAIT_L
#undef PG8_BAR
#undef PG8_SCHED
}
}

namespace mk {
constexpr int D = 1024, B = 4, S = 4096, T = B * S, C = 512, INW = 5120, E = 16, CAP = 512, F = 2048, NTH = 512, NWAVES = 8;
typedef unsigned short bf16;
#define LAS __attribute__((address_space(3)))
typedef unsigned v4u __attribute__((ext_vector_type(4)));
typedef unsigned v2u __attribute__((ext_vector_type(2)));
typedef float f32x4 __attribute__((ext_vector_type(4)));
typedef short bf16x8 __attribute__((ext_vector_type(8)));
typedef float f32x16 __attribute__((ext_vector_type(16)));
typedef short s16x4 __attribute__((ext_vector_type(4)));

constexpr size_t MiB = 1u << 20;
constexpr size_t WS_WIN = 2 * MiB;
constexpr size_t WS_WUH = 22 * MiB;
constexpr size_t WS_WUA = 23 * MiB;
constexpr size_t WS_WOUT = 26 * MiB;
constexpr size_t WS_BINP = 30 * MiB;
constexpr size_t WS_ROPE = 31 * MiB;
constexpr size_t WS_AFFT = 32 * MiB;
constexpr size_t WS_INV = 33 * MiB;
constexpr size_t WS_ROWS = 34 * MiB;
constexpr size_t WS_GATE = 34 * MiB + 512 * 1024;
constexpr size_t WS_FILT = 36 * MiB;
constexpr size_t WS_X = 68 * MiB;
constexpr size_t WS_XN = 132 * MiB;
constexpr size_t WS_SH = 164 * MiB;
constexpr size_t WS_U = WS_SH;
constexpr size_t WS_UCT = WS_SH + 48 * MiB;
constexpr size_t WS_Q = WS_SH + 96 * MiB;
constexpr size_t WS_K = WS_SH + 112 * MiB;
constexpr size_t WS_V = WS_SH + 128 * MiB;
constexpr size_t WS_GH = WS_SH + 144 * MiB;
constexpr size_t WS_GA = WS_SH + 176 * MiB;
constexpr size_t WS_YH = WS_SH + 208 * MiB;
constexpr size_t WS_YA = WS_SH + 224 * MiB;
constexpr size_t WS_T1 = WS_U;
constexpr size_t WS_MG = WS_UCT;
constexpr size_t WS_XG = WS_SH;
constexpr size_t WS_HB = WS_SH + 64 * MiB;
constexpr size_t WS_YE = WS_SH + 192 * MiB;
constexpr size_t WS_WGU = 420 * MiB;
constexpr size_t WS_WD = 676 * MiB;
constexpr size_t WS_END = 804 * MiB;

constexpr int LDS_BYTES = 155648;
constexpr float QSCALE = 0.125f * 1.4426950408889634f;

struct Args {
    const float* in[29]; float* out; unsigned char* ws; int ph_lo, ph_hi; int p0_mask, pad;
};

__device__ __forceinline__ unsigned f2bf(float f) { unsigned u = __builtin_bit_cast(unsigned, f); return (u + 0x7fffu + ((u >> 16) & 1u)) >> 16; }
__device__ __forceinline__ unsigned pk2(float lo, float hi) { return f2bf(lo) | (f2bf(hi) << 16); }
__device__ __forceinline__ float bf2f(unsigned h) { return __builtin_bit_cast(float, h << 16); }
__device__ __forceinline__ float bflo(unsigned w) { return __builtin_bit_cast(float, w << 16); }
__device__ __forceinline__ float bfhi(unsigned w) { return __builtin_bit_cast(float, w & 0xffff0000u); }
template <int O> __device__ __forceinline__ float xor_f(float v) { return __builtin_bit_cast(float, __builtin_amdgcn_ds_swizzle(__builtin_bit_cast(int, v), (O << 10) | 0x1f)); }
__device__ __forceinline__ float wave_sum(float v) { v += xor_f<1>(v); v += xor_f<2>(v); v += xor_f<4>(v); v += xor_f<8>(v); v += xor_f<16>(v);
    const int b = __builtin_bit_cast(int, v); return __builtin_bit_cast(float, __builtin_amdgcn_readlane(b, 0)) + __builtin_bit_cast(float, __builtin_amdgcn_readlane(b, 32)); }

__device__ __forceinline__ float sigm(float x) { return 1.f / (1.f + __expf(-x)); }

struct Ctx { int tid, lane, wave, gw, ngw, vcu, G, bid, wave_s; LAS unsigned char* lds; unsigned char* ws; };

__device__ __forceinline__ int fresh_tid(int wave_s) { int l; asm volatile("v_mbcnt_lo_u32_b32 %0, -1, 0\n\tv_mbcnt_hi_u32_b32 %0, -1, %0" : "=v"(l)); return (wave_s << 6) | l; }
__device__ __forceinline__ Ctx relaunder(const Ctx& X) { Ctx Y = X; const int t = fresh_tid(X.wave_s); Y.tid = t; Y.lane = t & 63; return Y; }

template <int MAP> __device__ __forceinline__ int rowmap(int n) {
    if (MAP == 1) {
        if (n < 1536 || n >= 2560) return n;
        const int hb = (n - 1536) & ~63, d = (n - 1536) & 63, i = (d & 31) >> 2, j = d & 3;
        return 1536 + hb + 8 * i + ((d >> 5) << 2) + j;
    }
    if (MAP == 2) return ((n >> 7) << 8) + (n & 127);
    if (MAP == 3) return ((n >> 7) << 8) + 128 + (n & 127);
    return n;
}
__device__ __forceinline__ unsigned cvtpk_(float lo, float hi) { unsigned r; asm volatile("v_cvt_pk_bf16_f32 %0, %1, %2" : "=v"(r) : "v"(lo), "v"(hi)); return r; }
struct TrItem { const float* src; bf16* dst; };
template <int MAP> __device__ __forceinline__ void p0_transpose(const Ctx& X, const float* W, int K, int N, bf16* WT, int nmat, size_t sstride, size_t dstride) {
    LAS float* scr = (LAS float*)(X.lds + X.wave * 16640);
    const int nblk = N / 64, per = (K / 64) * nblk, tot = per * nmat, lane = X.lane;
    const int nq = lane & 15, kr = lane >> 4, c = lane & 7, nsub = lane >> 3;
    f32x4 v[16];
    int it = X.gw;
#define TR_SRC(it_) (W + (size_t)((it_) / per) * sstride + (size_t)(64 * (((it_) % per) / nblk) + kr) * N + 64 * (((it_) % per) % nblk) + 4 * nq)
    if (it < tot) { const float* s = TR_SRC(it);
#pragma unroll
        for (int i = 0; i < 16; ++i) v[i] = __builtin_nontemporal_load((const f32x4*)(s + (size_t)(4 * i) * N)); }
    while (it < tot) {
#pragma unroll
        for (int i = 0; i < 16; ++i) { LAS float* d = scr + (4 * i + kr) * 65 + 4 * nq; d[0] = v[i][0]; d[1] = v[i][1]; d[2] = v[i][2]; d[3] = v[i][3]; }
        const int nit = it + X.ngw;
        if (nit < tot) { const float* s = TR_SRC(nit);
#pragma unroll
            for (int i = 0; i < 16; ++i) v[i] = __builtin_nontemporal_load((const f32x4*)(s + (size_t)(4 * i) * N)); }
        asm volatile("s_waitcnt lgkmcnt(0)" ::: "memory");
        const int m = it / per, r = it - m * per, k0 = 64 * (r / nblk), n0 = 64 * (r % nblk);
        bf16* dst = WT + (size_t)m * dstride;
#pragma unroll
        for (int j = 0; j < 8; ++j) { const int n = nsub + 8 * j; const LAS float* s = scr + (8 * c) * 65 + n;
            v4u o; o.x = cvtpk_(s[0 * 65], s[1 * 65]); o.y = cvtpk_(s[2 * 65], s[3 * 65]); o.z = cvtpk_(s[4 * 65], s[5 * 65]); o.w = cvtpk_(s[6 * 65], s[7 * 65]);
            __builtin_nontemporal_store(o, (v4u*)(dst + (size_t)rowmap<MAP>(n0 + n) * K + k0 + 8 * c)); }
        asm volatile("s_waitcnt lgkmcnt(0)" ::: "memory");
        it = nit;
    }
#undef TR_SRC
}
struct Row8 { f32x4 a[2][2]; };
__device__ __forceinline__ void row8_load(Row8& r, const float* p, int lane) {
#pragma unroll
    for (int j = 0; j < 2; ++j) { const f32x4* q = (const f32x4*)p + 2 * (lane + 64 * j); r.a[j][0] = q[0]; r.a[j][1] = q[1]; }
}
__device__ __forceinline__ float row8_sumsq(const Row8& r) {
    float s = 0.f;
#pragma unroll
    for (int j = 0; j < 2; ++j)
#pragma unroll
        for (int h = 0; h < 2; ++h) s += (r.a[j][h].x * r.a[j][h].x + r.a[j][h].y * r.a[j][h].y) + (r.a[j][h].z * r.a[j][h].z + r.a[j][h].w * r.a[j][h].w);
    return s;
}
__device__ __forceinline__ void rms_row_to_bf16(const float* __restrict__ xrow, const float* __restrict__ g, bf16* __restrict__ orow, int lane) {
    const f32x4* xr = (const f32x4*)xrow + lane; f32x4 v[4]; float s = 0.f;
#pragma unroll
    for (int j = 0; j < 4; ++j) { v[j] = xr[64 * j]; s += (v[j].x * v[j].x + v[j].y * v[j].y) + (v[j].z * v[j].z + v[j].w * v[j].w); }
    const float r = rsqrtf(wave_sum(s) * (1.f / D) + 1e-6f);
    v2u* o8 = (v2u*)orow + lane;
#pragma unroll
    for (int j = 0; j < 4; ++j) { const f32x4 gg = ((const f32x4*)g)[lane + 64 * j]; v2u w; w.x = pk2(v[j].x * r * gg.x, v[j].y * r * gg.y); w.y = pk2(v[j].z * r * gg.z, v[j].w * r * gg.w); o8[64 * j] = w; }
}
__device__ __forceinline__ void p0_filters(const Ctx& X, const Args& a) {
    LAS float* z = (LAS float*)X.lds;
    LAS float* h1 = z + 32 * 36;
    LAS float* h2T = h1 + 32 * 64;
    LAS float* w1s = h2T + 64 * 32;
    LAS float* w2s = w1s + 33 * 64;
    bf16* FILT = (bf16*)(X.ws + WS_FILT);
    const float min_decay = logf(1e-2f) / 0.3f, max_decay = logf(1e-2f) / 1.5f;
    for (int it = X.bid; it < 2 * (S / 32); it += X.G) {
        int tid = X.tid; asm volatile("" : "+v"(tid));
        const int j = tid & 63, tq = tid >> 6;
        const int l = it / (S / 32), t0 = (it % (S / 32)) * 32;
        const float *w1 = a.in[6] + l * 33 * 64, *b1 = a.in[7] + l * 64, *f1 = a.in[8] + l * 64, *w2 = a.in[9] + l * 64 * 64, *b2 = a.in[10] + l * 64, *f2 = a.in[11] + l * 64, *w3 = a.in[12] + (size_t)l * 64 * 2048;
        __syncthreads();
        for (int e = tid; e < 33 * 64; e += NTH) w1s[e] = w1[e];
        for (int e = tid; e < 64 * 64; e += NTH) w2s[e] = w2[e];
        for (int e = tid; e < 32 * 33; e += NTH) { const int tt = e / 33, jj0 = e - tt * 33, t = t0 + tt; float v;
            if (jj0 == 0) v = (float)t / (float)(S - 1);
            else { const int jj = (jj0 - 1) & 15; const float w = 2.0f * 3.14159265358979323846f * (float)t / (float)S; const float fr = 1e-4f + (float)jj * ((15.0f - 1e-4f) / 15.0f); const float ang = w * fr; v = (jj0 <= 16) ? cosf(ang) : -sinf(ang); }
            z[tt * 36 + jj0] = v; }
        const float bb1 = b1[j], ff1 = f1[j], bb2 = b2[j], ff2 = f2[j];
        __syncthreads();
        { float acc[4] = {bb1, bb1, bb1, bb1};
          for (int i = 0; i < 33; ++i) { const float w = w1s[i * 64 + j];
#pragma unroll
              for (int k = 0; k < 4; ++k) acc[k] += z[(tq + 8 * k) * 36 + i] * w; }
#pragma unroll
          for (int k = 0; k < 4; ++k) h1[(tq + 8 * k) * 64 + j] = sinf(ff1 * acc[k]); }
        __syncthreads();
        { float acc[4] = {bb2, bb2, bb2, bb2};
          for (int i = 0; i < 64; ++i) { const float w = w2s[i * 64 + j];
#pragma unroll
              for (int k = 0; k < 4; ++k) acc[k] += h1[(tq + 8 * k) * 64 + i] * w; }
#pragma unroll
          for (int k = 0; k < 4; ++k) h2T[j * 32 + tq + 8 * k] = sinf(ff2 * acc[k]); }
        __syncthreads();
        { const int n0 = 4 * tid; f32x4 acc[32];
#pragma unroll
            for (int q = 0; q < 32; ++q) acc[q] = (f32x4){0.f, 0.f, 0.f, 0.f};
#pragma unroll 1
            for (int i0 = 0; i0 < 64; i0 += 16) { f32x4 w[16];
#pragma unroll
                for (int u = 0; u < 16; ++u) w[u] = *(const f32x4*)(w3 + (i0 + u) * 2048 + n0);
#pragma unroll
                for (int u = 0; u < 16; ++u) {
#pragma unroll
                    for (int g = 0; g < 8; ++g) { const f32x4 hh = *(const LAS f32x4*)(h2T + (i0 + u) * 32 + 4 * g); acc[4 * g] += w[u] * hh.x; acc[4 * g + 1] += w[u] * hh.y; acc[4 * g + 2] += w[u] * hh.z; acc[4 * g + 3] += w[u] * hh.w; } } }
            const int c0 = n0 & 511, od = n0 >> 9;
#pragma unroll
            for (int e = 0; e < 4; ++e) { const float delta = fabsf(min_decay + (float)(c0 + e) * ((max_decay - min_decay) / 511.0f));
#pragma unroll
                for (int g = 0; g < 4; ++g) { float o8[8];
#pragma unroll
                    for (int q = 0; q < 8; ++q) o8[q] = acc[8 * g + q][e] * expf(-((float)(t0 + 8 * g + q) / (float)(S - 1)) * delta);
                    v4u o; o.x = pk2(o8[0], o8[1]); o.y = pk2(o8[2], o8[3]); o.z = pk2(o8[4], o8[5]); o.w = pk2(o8[6], o8[7]);
                    *(v4u*)(FILT + (((size_t)l * 4 + od) * C + c0 + e) * S + t0 + 8 * g) = o; } } }
    }
    __syncthreads();
}
template <int MAP> __device__ __forceinline__ void p0_convert(const Ctx& X, const float* W, int K, int N, bf16* WB, int dN, int nmat, size_t sstride, size_t dstride) {
    const int nblk = N / 256, per = (K / 16) * nblk, tot = per * nmat, lane = X.lane;
    f32x4 v[16];
    int it = X.gw;
#define CV_SRC(it_) (W + (size_t)((it_) / per) * sstride + (size_t)(16 * (((it_) % per) / nblk)) * N + 256 * (((it_) % per) % nblk) + 4 * lane)
    if (it < tot) { const float* s = CV_SRC(it);
#pragma unroll
        for (int i = 0; i < 16; ++i) v[i] = __builtin_nontemporal_load((const f32x4*)(s + (size_t)i * N)); }
    while (it < tot) {
        v2u o[16];
#pragma unroll
        for (int i = 0; i < 16; ++i) { o[i].x = cvtpk_(v[i][0], v[i][1]); o[i].y = cvtpk_(v[i][2], v[i][3]); }
        const int nit = it + X.ngw;
        if (nit < tot) { const float* s = CV_SRC(nit);
#pragma unroll
            for (int i = 0; i < 16; ++i) v[i] = __builtin_nontemporal_load((const f32x4*)(s + (size_t)i * N)); }
        const int mi = it / per, r = it - mi * per, k0 = 16 * (r / nblk), n = 256 * (r % nblk) + 4 * lane;
        const int dc = MAP == 0 ? n : (((n >> 7) << 8) + (n & 127) + (MAP == 3 ? 128 : 0));
        bf16* dst = WB + (size_t)mi * dstride + (size_t)k0 * dN + dc;
#pragma unroll
        for (int i = 0; i < 16; ++i) __builtin_nontemporal_store(o[i], (v2u*)(dst + (size_t)i * dN));
        it = nit;
    }
#undef CV_SRC
}
__device__ __forceinline__ void p0_experts(const Ctx& X, const Args& a, int l) {
    bf16* wgu = (bf16*)(X.ws + WS_WGU) + (size_t)l * E * 2 * F * D; bf16* wd = (bf16*)(X.ws + WS_WD) + (size_t)l * E * F * D;
    p0_convert<2>(X, a.in[25] + (size_t)l * E * D * F, D, F, wgu, 2 * F, E, (size_t)D * F, (size_t)2 * F * D);
    p0_convert<3>(X, a.in[26] + (size_t)l * E * D * F, D, F, wgu, 2 * F, E, (size_t)D * F, (size_t)2 * F * D);
    p0_convert<0>(X, a.in[27] + (size_t)l * E * D * F, F, D, wd, D, E, (size_t)F * D, (size_t)F * D);
}
#ifndef MK_P0_DUP
#define MK_P0_DUP 0
#endif
__device__ __forceinline__ void p0_prologue(const Ctx& X, const Args& a) {
    const int m = a.p0_mask;
    for (int dup_ = 0; dup_ < ((MK_P0_DUP & 1) ? 2 : 1); ++dup_)
    if (m & 1) {
        p0_transpose<1>(X, a.in[2], D, INW, (bf16*)(X.ws + WS_WIN), 2, (size_t)D * INW, (size_t)D * INW);
        p0_transpose<0>(X, a.in[19], C, D, (bf16*)(X.ws + WS_WUH), 2, (size_t)C * D, (size_t)2 * C * D);
        p0_transpose<0>(X, a.in[20], C, D, (bf16*)(X.ws + WS_WUA), 2, (size_t)C * D, (size_t)2 * C * D);
        p0_transpose<0>(X, a.in[21], D, D, (bf16*)(X.ws + WS_WOUT), 2, (size_t)D * D, (size_t)D * D);
        float* binp = (float*)(X.ws + WS_BINP);
        for (int i = X.gw * 64 + X.lane; i < 2 * INW; i += X.ngw * 64) { const int l = i / INW, n = i - l * INW; binp[l * INW + rowmap<1>(n)] = a.in[3][i]; }
        float* rope = (float*)(X.ws + WS_ROPE);
        for (int i = X.gw * 64 + X.lane; i < S * 32; i += X.ngw * 64) { const int pos = i >> 5, j = i & 31; const float inv = powf(10000.0f, -(float)j * 2.0f / 64.0f); float sn, cs; sincosf((float)pos * inv, &sn, &cs); rope[2 * i] = cs; rope[2 * i + 1] = sn; }
    }
    if (m & 2) { p0_experts(X, a, 0); p0_experts(X, a, 1); }
    for (int dup_ = 0; dup_ < ((MK_P0_DUP & 4) ? 2 : 1); ++dup_)
    if (m & 4) p0_filters(X, a);
    for (int dup_ = 0; dup_ < ((MK_P0_DUP & 8) ? 2 : 1); ++dup_)
    if (m & 8) {
        bf16* XN = (bf16*)(X.ws + WS_XN); const int lane = X.lane; Row8 gg; row8_load(gg, a.in[1], lane);
        int r = X.gw; Row8 cur; if (r < T) row8_load(cur, a.in[0] + (size_t)r * D, lane);
        while (r < T) { const int nr = r + X.ngw; Row8 nxt; if (nr < T) row8_load(nxt, a.in[0] + (size_t)nr * D, lane);
            const float rs = rsqrtf(wave_sum(row8_sumsq(cur)) * (1.f / D) + 1e-6f);
#pragma unroll
            for (int j = 0; j < 2; ++j) { const f32x4 y0 = cur.a[j][0] * gg.a[j][0] * rs, y1 = cur.a[j][1] * gg.a[j][1] * rs;
                v4u w; w.x = pk2(y0.x, y0.y); w.y = pk2(y0.z, y0.w); w.z = pk2(y1.x, y1.y); w.w = pk2(y1.z, y1.w); ((v4u*)(XN + (size_t)r * D))[lane + 64 * j] = w; }
            cur = nxt; r = nr; }
    }
}
}
namespace mk {
using pg8::Unit;
#ifndef MK_SIMPLE_ORDER
#define MK_SIMPLE_ORDER 0
#endif
__device__ __forceinline__ unsigned cvtpk(float lo, float hi) { unsigned r; asm volatile("v_cvt_pk_bf16_f32 %0, %1, %2" : "=v"(r) : "v"(lo), "v"(hi)); return r; }
__device__ __forceinline__ v4u pack8(f32x4 a, f32x4 b) { v4u w; w.x = cvtpk(a[0], a[1]); w.y = cvtpk(a[2], a[3]); w.z = cvtpk(b[0], b[1]); w.w = cvtpk(b[2], b[3]); return w; }
__device__ __forceinline__ void unpack8(v4u w, f32x4& a, f32x4& b) { a = (f32x4){bflo(w.x), bfhi(w.x), bflo(w.y), bfhi(w.y)}; b = (f32x4){bflo(w.z), bfhi(w.z), bflo(w.w), bfhi(w.w)}; }
__device__ __forceinline__ float fsig(float x) { return __builtin_amdgcn_rcpf(1.f + __expf(-x)); }

struct EpiWin {
    static constexpr bool PERM = true, AFTER_DRAIN = false;
    unsigned char* ws; const float* bias; const float* rope;
    __device__ __forceinline__ void operator()(const f32x4 (&acc)[2][2][4][2], const Unit& u, int wr, int wc, int fr, int fq) const {
        const int colt = u.pn * 256, row0 = u.pm * 256 + wr * 64 + fr, cin = wc * 32 + 8 * fq;
        bf16* base; int ldc, col0, mode; float sc = 1.f;
        if (colt < 1536) { base = (bf16*)(ws + WS_U); ldc = 1536; col0 = colt; mode = 0; }
        else if (colt < 2048) { base = (bf16*)(ws + WS_Q); ldc = 512; col0 = colt - 1536; mode = 1; sc = QSCALE; }
        else if (colt < 2560) { base = (bf16*)(ws + WS_K); ldc = 512; col0 = colt - 2048; mode = 1; }
        else if (colt < 3072) { base = (bf16*)(ws + WS_V); ldc = 512; col0 = colt - 2560; mode = 0; }
        else if (colt < 4096) { base = (bf16*)(ws + WS_GH); ldc = 1024; col0 = colt - 3072; mode = 2; }
        else { base = (bf16*)(ws + WS_GA); ldc = 1024; col0 = colt - 4096; mode = 2; }
        f32x4 bv[2][2];
#pragma unroll
        for (int bj = 0; bj < 2; ++bj)
#pragma unroll
            for (int n = 0; n < 2; ++n) bv[bj][n] = *(const f32x4*)(bias + colt + bj * 128 + cin + 4 * n);
#pragma unroll
        for (int ai = 0; ai < 2; ++ai)
#pragma unroll
            for (int m = 0; m < 4; ++m) {
                const int row = row0 + ai * 128 + m * 16; bf16* rowp = base + (size_t)row * ldc + col0 + cin;
#pragma unroll
                for (int bj = 0; bj < 2; ++bj) {
                    f32x4 v0 = acc[ai][bj][m][0] + bv[bj][0], v1 = acc[ai][bj][m][1] + bv[bj][1];
                    if (mode == 1) {
                        const int i = ((bj * 128 + cin) & 63) >> 3; const float* rp = rope + ((size_t)(row & (S - 1)) * 32 + 4 * i) * 2;
                        const f32x4 r0 = *(const f32x4*)rp, r1 = *(const f32x4*)(rp + 4);
                        const f32x4 cs = {r0[0], r0[2], r1[0], r1[2]}, sn = {r0[1], r0[3], r1[1], r1[3]};
                        const f32x4 o1 = (v0 * cs - v1 * sn) * sc, o2 = (v1 * cs + v0 * sn) * sc; v0 = o1; v1 = o2;
                    } else if (mode == 2) {
#pragma unroll
                        for (int e = 0; e < 4; ++e) { v0[e] = fsig(v0[e]); v1[e] = fsig(v1[e]); }
                    }
                    *(v4u*)(rowp + bj * 128) = pack8(v0, v1);
                }
            }
    }
};
struct EpiMerge2 {
    static constexpr bool PERM = true, AFTER_DRAIN = false;
    const bf16* GH; const bf16* GA; bf16* T1; bf16* MG;
    __device__ __forceinline__ void operator()(const f32x4 (&acc)[2][2][4][2], const Unit& u, int wr, int wc, int fr, int fq) const {
        const int row0 = u.pm * 256 + wr * 64 + fr, col0 = u.pn * 256 + wc * 32 + 8 * fq; const bool second = u.pa != u.pm; const bf16* G = second ? GA : GH;
#pragma unroll
        for (int ai = 0; ai < 2; ++ai)
#pragma unroll
            for (int m = 0; m < 4; ++m) { const size_t off = (size_t)(row0 + ai * 128 + m * 16) * D + col0;
#pragma unroll
                for (int bj = 0; bj < 2; ++bj) { f32x4 g0, g1; unpack8(*(const v4u*)(G + off + bj * 128), g0, g1);
                    f32x4 v0 = acc[ai][bj][m][0] * g0, v1 = acc[ai][bj][m][1] * g1;
                    if (second) { f32x4 t0, t1; unpack8(*(const v4u*)(T1 + off + bj * 128), t0, t1); v0 += t0; v1 += t1; *(v4u*)(MG + off + bj * 128) = pack8(v0, v1); }
                    else *(v4u*)(T1 + off + bj * 128) = pack8(v0, v1); } }
    }
};
struct OrderMerge {
    pg8::StaticOrder so;
    __device__ __forceinline__ bool next(int i, Unit& u) const { if (!so.next(i >> 1, u)) return false; if (i & 1) { u.pa = u.pm + T / 256; u.pb = u.pn + 4; } return true; }
    __device__ __forceinline__ void a_ready(const Unit&) const {}
    __device__ __forceinline__ void done(const Unit&) const {}
};
struct EpiOut {
    static constexpr bool PERM = false, AFTER_DRAIN = false;
    const float* xin; float* X;
    __device__ __forceinline__ void operator()(const f32x4 (&acc)[2][2][4][2], const Unit& u, int wr, int wc, int fr, int fq) const {
        const int row0 = u.pm * 256 + wr * 64 + fr, col0 = u.pn * 256 + wc * 32 + 4 * fq;
#pragma unroll
        for (int ai = 0; ai < 2; ++ai)
#pragma unroll
            for (int m = 0; m < 4; ++m) { const size_t off = (size_t)(row0 + ai * 128 + m * 16) * D + col0;
#pragma unroll
                for (int bj = 0; bj < 2; ++bj)
#pragma unroll
                    for (int n = 0; n < 2; ++n) *(f32x4*)(X + off + bj * 128 + n * 16) = *(const f32x4*)(xin + off + bj * 128 + n * 16) + acc[ai][bj][m][n]; }
    }
};
struct EpiSwiGLU {
    static constexpr bool PERM = true, AFTER_DRAIN = false;
    bf16* HB;
    __device__ __forceinline__ void operator()(const f32x4 (&acc)[2][2][4][2], const Unit& u, int wr, int wc, int fr, int fq) const {
        const int row0 = u.pm * 256 + wr * 64 + fr, col0 = u.pn * 128 + wc * 32 + 8 * fq;
#pragma unroll
        for (int ai = 0; ai < 2; ++ai)
#pragma unroll
            for (int m = 0; m < 4; ++m) { f32x4 h[2];
#pragma unroll
                for (int n = 0; n < 2; ++n) { const f32x4 g = acc[ai][0][m][n], up = acc[ai][1][m][n];
#pragma unroll
                    for (int e = 0; e < 4; ++e) h[n][e] = g[e] * fsig(g[e]) * up[e]; }
                *(v4u*)(HB + (size_t)(row0 + ai * 128 + m * 16) * F + col0) = pack8(h[0], h[1]); }
    }
};
struct EpiDown {
    static constexpr bool PERM = true, AFTER_DRAIN = false;
    bf16* YE; const float* gate;
    __device__ __forceinline__ void operator()(const f32x4 (&acc)[2][2][4][2], const Unit& u, int wr, int wc, int fr, int fq) const {
        const int row0 = u.pm * 256 + wr * 64 + fr, col0 = u.pn * 256 + wc * 32 + 8 * fq;
#pragma unroll
        for (int ai = 0; ai < 2; ++ai)
#pragma unroll
            for (int m = 0; m < 4; ++m) { const int row = row0 + ai * 128 + m * 16; const float g = gate[row];
#pragma unroll
                for (int bj = 0; bj < 2; ++bj) *(v4u*)(YE + (size_t)row * D + col0 + bj * 128) = pack8(acc[ai][bj][m][0] * g, acc[ai][bj][m][1] * g); }
    }
};
struct OrderMoE1 {
    int G, c;
    __device__ __forceinline__ bool next(int i, Unit& u) const {
        if (MK_SIMPLE_ORDER || G != 256) { const int L = i * G + c; if (L >= 2048) return false; const int e = L >> 7, r = L & 127; u.pm = e * 8 + (r & 7); u.pn = r >> 3; u.pb = e * 16 + u.pn; u.pa = u.pm; return true; }
        if (i >= 8) return false;
        const int ch = i * 8 + (c & 7), j = c >> 3, e = ch >> 2, ng = ch & 3; u.pm = e * 8 + (j & 7); u.pn = ng * 4 + (j >> 3); u.pb = e * 16 + u.pn; u.pa = u.pm; return true;
    }
    __device__ __forceinline__ void a_ready(const Unit&) const {}
    __device__ __forceinline__ void done(const Unit&) const {}
};
struct OrderMoE2 {
    int G, c;
    __device__ __forceinline__ bool next(int i, Unit& u) const {
        if (MK_SIMPLE_ORDER || G != 256) { const int L = i * G + c; if (L >= 512) return false; const int e = L >> 5, r = L & 31; u.pm = e * 8 + (r & 7); u.pn = r >> 3; u.pb = e * 4 + u.pn; u.pa = u.pm; return true; }
        if (i >= 2) return false;
        const int e = i * 8 + (c & 7), j = c >> 3; u.pm = e * 8 + (j & 7); u.pn = j >> 3; u.pb = e * 4 + u.pn; u.pa = u.pm; return true;
    }
    __device__ __forceinline__ void a_ready(const Unit&) const {}
    __device__ __forceinline__ void done(const Unit&) const {}
};

__device__ __forceinline__ void p5_norm_router(const Ctx& X, const float* Xr, const float* __restrict__ g, const float* __restrict__ wr, const float* __restrict__ br) {
    bf16* XN = (bf16*)(X.ws + WS_XN); float* afft = (float*)(X.ws + WS_AFFT); const int lane = X.lane;
    LAS float* wt = (LAS float*)X.lds;
    __syncthreads();
    for (int i = X.tid; i < D * 4; i += NTH) { const f32x4 w = ((const f32x4*)wr)[i]; const int k = i >> 2, e0 = (i & 3) * 4; wt[(e0 + 0) * D + k] = w.x; wt[(e0 + 1) * D + k] = w.y; wt[(e0 + 2) * D + k] = w.z; wt[(e0 + 3) * D + k] = w.w; }
    __syncthreads();
    Row8 gg; row8_load(gg, g, lane);
    int tok = X.gw; Row8 cur; if (tok < T) row8_load(cur, Xr + (size_t)tok * D, lane);
    while (tok < T) {
        const int ntok = tok + X.ngw; Row8 nxt; if (ntok < T) row8_load(nxt, Xr + (size_t)ntok * D, lane);
        const float r = rsqrtf(wave_sum(row8_sumsq(cur)) * (1.f / D) + 1e-6f);
        float acc[16];
#pragma unroll
        for (int e = 0; e < 16; ++e) acc[e] = 0.f;
#pragma unroll
        for (int j = 0; j < 2; ++j) { f32x4 y[2];
#pragma unroll
            for (int h = 0; h < 2; ++h) y[h] = cur.a[j][h] * gg.a[j][h] * r;
            v4u w; w.x = pk2(y[0].x, y[0].y); w.y = pk2(y[0].z, y[0].w); w.z = pk2(y[1].x, y[1].y); w.w = pk2(y[1].z, y[1].w);
            ((v4u*)(XN + (size_t)tok * D))[lane + 64 * j] = w;
#pragma unroll
            for (int e = 0; e < 16; ++e) { const LAS f32x4* wp = (const LAS f32x4*)(wt + e * D + 8 * (lane + 64 * j)); const f32x4 w0 = wp[0], w1 = wp[1];
                acc[e] += ((y[0].x * w0.x + y[0].y * w0.y) + (y[0].z * w0.z + y[0].w * w0.w)) + ((y[1].x * w1.x + y[1].y * w1.y) + (y[1].z * w1.z + y[1].w * w1.w));
                if ((e & 3) == 3) asm volatile("" ::: "memory"); } }
        float mx = -1e30f;
#pragma unroll
        for (int e = 0; e < 16; ++e) { acc[e] = wave_sum(acc[e]) + br[e]; mx = fmaxf(mx, acc[e]); }
        float l = 0.f;
#pragma unroll
        for (int e = 0; e < 16; ++e) { acc[e] = expf(acc[e] - mx); l += acc[e]; }
        const int b = tok >> 12, s_ = tok & (S - 1);
        if (lane < 16) { float vv = 0.f;
#pragma unroll
            for (int e = 0; e < 16; ++e) if (lane == e) vv = acc[e];
            afft[((size_t)b * E + lane) * S + s_] = vv / l; }
        cur = nxt; tok = ntok;
    }
    __syncthreads();
}
__device__ __forceinline__ void p6_topk(const Ctx& X) {
    const float* afft = (const float*)(X.ws + WS_AFFT); int* rows = (int*)(X.ws + WS_ROWS); float* gate = (float*)(X.ws + WS_GATE); int* inv = (int*)(X.ws + WS_INV);
    for (int p = X.bid; p < B * E; p += X.G) { const int b = p >> 4, e = p & 15, slotbase = e * 2048 + b * 512;
        tk::topk_problem(afft + (size_t)p * S, b * S, e, slotbase, rows + slotbase, gate + slotbase, inv, (int*)(X.lds), X.tid); }
}
__device__ __forceinline__ void p6_gather(const Ctx& X) {
    const int* rows = (const int*)(X.ws + WS_ROWS); const bf16* XN = (const bf16*)(X.ws + WS_XN); bf16* XG = (bf16*)(X.ws + WS_XG);
    for (int sl0 = X.gw * 4; sl0 < E * 2048; sl0 += X.ngw * 4) {
        const int myrow = X.lane < 4 ? __hip_atomic_load(rows + sl0 + X.lane, __ATOMIC_RELAXED, __HIP_MEMORY_SCOPE_AGENT) : 0;
        v4u d[4][2];
#pragma unroll
        for (int i = 0; i < 4; ++i) { const int tok = __builtin_amdgcn_readlane(myrow, i); const v4u* s = (const v4u*)(XN + (size_t)tok * D) + X.lane; d[i][0] = s[0]; d[i][1] = s[64]; }
#pragma unroll
        for (int i = 0; i < 4; ++i) { v4u* o = (v4u*)(XG + (size_t)(sl0 + i) * D) + X.lane; o[0] = d[i][0]; o[64] = d[i][1]; }
    }
}
__device__ __forceinline__ void p9_combine(const Ctx& X, float* Xr, const float* __restrict__ g, bool final_, float* __restrict__ out) {
    const int* inv = (const int*)(X.ws + WS_INV); const bf16* YE = (const bf16*)(X.ws + WS_YE); bf16* XN = (bf16*)(X.ws + WS_XN); const int lane = X.lane;
    Row8 gg; row8_load(gg, g, lane);
    int tok = X.gw; Row8 cur; int myinv = -1;
    if (tok < T) { row8_load(cur, Xr + (size_t)tok * D, lane); if (lane < 16) myinv = inv[(size_t)tok * E + lane]; }
    while (tok < T) {
        const int ntok = tok + X.ngw; Row8 nxt; int ninv = -1;
        if (ntok < T) { row8_load(nxt, Xr + (size_t)ntok * D, lane); if (lane < 16) ninv = inv[(size_t)ntok * E + lane]; }
        unsigned long long m = __ballot(myinv >= 0);
        while (m) {
            int sl[4];
#pragma unroll
            for (int i = 0; i < 4; ++i) { if (m) { const int e = __builtin_ctzll(m); m &= m - 1; sl[i] = __builtin_amdgcn_readlane(myinv, e); } else sl[i] = -1; }
            v4u y[4][2];
#pragma unroll
            for (int i = 0; i < 4; ++i) if (sl[i] >= 0) { const v4u* yp = (const v4u*)(YE + (size_t)sl[i] * D); y[i][0] = __builtin_nontemporal_load(yp + lane); y[i][1] = __builtin_nontemporal_load(yp + lane + 64); }
#pragma unroll
            for (int i = 0; i < 4; ++i) if (sl[i] >= 0) {
#pragma unroll
                for (int j = 0; j < 2; ++j) { f32x4 p, q; unpack8(y[i][j], p, q); cur.a[j][0] += p; cur.a[j][1] += q; } }
        }
        const float r = rsqrtf(wave_sum(row8_sumsq(cur)) * (1.f / D) + 1e-6f);
        if (final_) {
#pragma unroll
            for (int j = 0; j < 2; ++j)
#pragma unroll
                for (int h = 0; h < 2; ++h) ((f32x4*)(out + (size_t)tok * D))[2 * (lane + 64 * j) + h] = cur.a[j][h] * gg.a[j][h] * r;
        } else {
#pragma unroll
            for (int j = 0; j < 2; ++j) {
#pragma unroll
                for (int h = 0; h < 2; ++h) ((f32x4*)(Xr + (size_t)tok * D))[2 * (lane + 64 * j) + h] = cur.a[j][h];
                const f32x4 y0 = cur.a[j][0] * gg.a[j][0] * r, y1 = cur.a[j][1] * gg.a[j][1] * r;
                v4u w; w.x = pk2(y0.x, y0.y); w.y = pk2(y0.z, y0.w); w.z = pk2(y1.x, y1.y); w.w = pk2(y1.z, y1.w);
                ((v4u*)(XN + (size_t)tok * D))[lane + 64 * j] = w; }
        }
        cur = nxt; myinv = ninv; tok = ntok;
    }
}
}
namespace mk {
__device__ __forceinline__ void p1t_shortconv(const Ctx& X, const float* __restrict__ cw, const float* __restrict__ cb) {
    const bf16* U = (const bf16*)(X.ws + WS_U); bf16* UCT = (bf16*)(X.ws + WS_UCT);
    LAS float* raw = (LAS float*)(X.lds + X.wave * 17408);
    const int lane = X.lane, rq = lane >> 3, cq = lane & 7;
    constexpr int NIT = (T / 64) * 24;
    v4u w[9];
#define P1T_LOAD(it_) do { const int tt_ = (it_) / 24, cg_ = (it_) - tt_ * 24, tok0_ = tt_ * 64, tin_ = tok0_ & (S - 1); \
        _Pragma("unroll") for (int i = 0; i < 9; ++i) { const int r = 8 * i + rq, tpos = tin_ + r - 1; w[i] = (v4u){0u, 0u, 0u, 0u}; \
            if (r < 66 && tpos >= 0 && tpos < S) w[i] = *(const v4u*)(U + (size_t)(tok0_ + r - 1) * 1536 + cg_ * 64 + 8 * cq); } } while (0)
    int it = X.gw;
    if (it < NIT) P1T_LOAD(it);
    while (it < NIT) {
        const int tt = it / 24, cg = it - tt * 24, tok0 = tt * 64, ch0 = cg * 64;
#pragma unroll
        for (int i = 0; i < 9; ++i) { const int r = 8 * i + rq; if (r < 66) { LAS float* d = raw + r * 65 + 8 * cq; f32x4 p, q; unpack8(w[i], p, q);
            d[0] = p.x; d[1] = p.y; d[2] = p.z; d[3] = p.w; d[4] = q.x; d[5] = q.y; d[6] = q.z; d[7] = q.w; } }
        const int nit = it + X.ngw;
        if (nit < NIT) P1T_LOAD(nit);
        asm volatile("s_waitcnt lgkmcnt(0)" ::: "memory");
        const int chs = lane >> 3, tch = lane & 7;
#pragma unroll
        for (int g = 0; g < 8; ++g) { const int ch = 8 * g + chs, gc = ch0 + ch; const float w0 = cw[gc], w1 = cw[1536 + gc], w2 = cw[3072 + gc], bb = cb[gc];
            float v[10];
#pragma unroll
            for (int k = 0; k < 10; ++k) v[k] = raw[(8 * tch + k) * 65 + ch];
            float o[8];
#pragma unroll
            for (int k = 0; k < 8; ++k) o[k] = v[k] * w0 + v[k + 1] * w1 + v[k + 2] * w2 + bb;
            v4u pk; pk.x = pk2(o[0], o[1]); pk.y = pk2(o[2], o[3]); pk.z = pk2(o[4], o[5]); pk.w = pk2(o[6], o[7]);
            *(v4u*)(UCT + (size_t)gc * T + tok0 + 8 * tch) = pk; }
        asm volatile("s_waitcnt lgkmcnt(0)" ::: "memory");
        it = nit;
    }
#undef P1T_LOAD
}

__device__ __forceinline__ void p1t_kmax(const Ctx& X, unsigned* kmax2) {
    const bf16* K = (const bf16*)(X.ws + WS_K); const int lane = X.lane; LAS float* red = (LAS float*)(X.lds + 8 * 17408);
    const int b = X.gw / 512, t0 = X.gw % 512; float mx = 0.f;
    if (b < B) {
        v4u w[8];
#pragma unroll
        for (int i = 0; i < 8; ++i) w[i] = ((const v4u*)(K + ((size_t)b * S + t0 + 512 * i) * 512))[lane];
#pragma unroll
        for (int i = 0; i < 8; ++i) { f32x4 p, q; unpack8(w[i], p, q); float ss = (p.x * p.x + p.y * p.y) + (p.z * p.z + p.w * p.w) + (q.x * q.x + q.y * q.y) + (q.z * q.z + q.w * q.w);
            ss += xor_f<1>(ss); ss += xor_f<2>(ss); ss += xor_f<4>(ss); mx = fmaxf(mx, ss); }
    }
    __syncthreads();
    if ((lane & 7) == 0) red[X.wave * 8 + (lane >> 3)] = mx;
    __syncthreads();
    if (X.tid < 8 && b < B) { float m = red[X.tid]; for (int w_ = 1; w_ < 8; ++w_) m = fmaxf(m, red[w_ * 8 + X.tid]); atomicMax(kmax2 + b * 8 + X.tid, __float_as_uint(m)); }
}

namespace at {
constexpr int KVBLK = 64, LDK = 512;
constexpr int KPITCH = 272;
constexpr int SHM_V = 64 * 128 * 2, SHM_K = 64 * KPITCH;
constexpr int OFF_V = 0, OFF_K = 2 * SHM_V, OFF_Q = OFF_K + 2 * SHM_K, OFF_WS = OFF_Q + 256 * KPITCH, LDS_TOTAL = OFF_WS + 8 * 160 * 4;
constexpr float THR2 = 8.0f * 1.4426950408889634f;
#define KSWZ(row, colB) ((row) * KPITCH + (colB))
#define SBAR() __builtin_amdgcn_sched_barrier(0)
__device__ __forceinline__ int crow(int r, int hi) { return (r & 3) + 8 * (r >> 2) + 4 * hi; }
__device__ __forceinline__ int v_st(int k, int c) { const int kk = (k & ~0xC) | ((k & 4) << 1) | ((k & 8) >> 1); return ((kk >> 3) * 4 + (c >> 5)) * 512 + ((kk & 7) * 32 + (c & 31)) * 2; }
__device__ __forceinline__ int v_rd_base(int lane) { return ((lane & 3) << 3) | (((lane >> 2) & 3) << 6) | (((lane >> 4) & 1) << 5) | (((lane >> 5) & 1) << 8); }
constexpr int v_rd_off(int d0, int ks, int half) { return d0 * 512 + ks * 4096 + half * 2048; }
template <int OFF> __device__ __forceinline__ s16x4 tr_read(int vb) { s16x4 r; asm volatile("ds_read_b64_tr_b16 %0, %1 offset:%2" : "=&v"(r) : "v"(vb), "i"(OFF) : "memory"); return r; }

template <int CO> __device__ __forceinline__ void qkt(f32x16& p0, f32x16& p1, const char* Ks, const char* Qs, int qrow, int r32, int hi) {
    p0 = f32x16{}; p1 = f32x16{};
    const char* qp = Qs + KSWZ(qrow, (CO * 64 + hi * 8) * 2); const char* kp = Ks + KSWZ(r32, (CO * 64 + hi * 8) * 2);
#pragma unroll
    for (int d0 = 0; d0 < 4; ++d0) {
        const bf16x8 qf = *reinterpret_cast<const bf16x8*>(qp + d0 * 32);
        const bf16x8 b0 = *reinterpret_cast<const bf16x8*>(kp + d0 * 32);
        const bf16x8 b1 = *reinterpret_cast<const bf16x8*>(kp + 32 * KPITCH + d0 * 32);
        p0 = __builtin_amdgcn_mfma_f32_32x32x16_bf16(b0, qf, p0, 0, 0, 0);
        p1 = __builtin_amdgcn_mfma_f32_32x32x16_bf16(b1, qf, p1, 0, 0, 0);
        if (d0 == 1) asm volatile("" ::: "memory"); }
}
__device__ __forceinline__ void softmax_tile(f32x16& p0, f32x16& p1, float& m_reg, float& l_reg, float& alpha, bf16x8& pa0, bf16x8& pa1, bf16x8& pa2, bf16x8& pa3) {
    float pmax = p0[0];
#pragma unroll
    for (int r = 1; r < 16; ++r) pmax = fmaxf(pmax, p0[r]);
#pragma unroll
    for (int r = 0; r < 16; ++r) pmax = fmaxf(pmax, p1[r]);
    { auto rr = __builtin_amdgcn_permlane32_swap(__float_as_uint(pmax), __float_as_uint(pmax), false, false); pmax = fmaxf(__uint_as_float(rr[0]), __uint_as_float(rr[1])); }
    float mn;
    if (__builtin_expect(__all(pmax - m_reg <= THR2), 1)) { mn = m_reg; alpha = 1.f; }
    else { mn = fmaxf(m_reg, pmax); alpha = __builtin_amdgcn_exp2f(m_reg - mn); m_reg = mn; }
#pragma unroll
    for (int r = 0; r < 16; ++r) { p0[r] = __builtin_amdgcn_exp2f(p0[r] - mn); p1[r] = __builtin_amdgcn_exp2f(p1[r] - mn); }
    float ps = 0.f;
#pragma unroll
    for (int r = 0; r < 16; ++r) ps += p0[r];
#pragma unroll
    for (int r = 0; r < 16; ++r) ps += p1[r];
    { auto rr = __builtin_amdgcn_permlane32_swap(__float_as_uint(ps), __float_as_uint(ps), false, false); ps = __uint_as_float(rr[0]) + __uint_as_float(rr[1]); }
    l_reg = l_reg * alpha + ps;
#define PK4(P, BASE, OUT) do { unsigned a0 = cvtpk(P[BASE + 0], P[BASE + 1]), a1 = cvtpk(P[BASE + 2], P[BASE + 3]);   \
    unsigned b0 = cvtpk(P[BASE + 4], P[BASE + 5]), b1 = cvtpk(P[BASE + 6], P[BASE + 7]);                              \
    auto r0 = __builtin_amdgcn_permlane32_swap(a0, b0, false, false); auto r1 = __builtin_amdgcn_permlane32_swap(a1, b1, false, false); \
    v4u w = {r0[0], r1[0], r0[1], r1[1]}; OUT = *reinterpret_cast<bf16x8*>(&w); } while (0)
    PK4(p0, 0, pa0); PK4(p0, 8, pa1); PK4(p1, 0, pa2); PK4(p1, 8, pa3);
#undef PK4
}
__device__ __forceinline__ void softmax_fixed(f32x16& p0, f32x16& p1, float m, float& l_half, bf16x8& pa0, bf16x8& pa1, bf16x8& pa2, bf16x8& pa3) {
#pragma unroll
    for (int r = 0; r < 16; ++r) { p0[r] = __builtin_amdgcn_exp2f(p0[r] - m); p1[r] = __builtin_amdgcn_exp2f(p1[r] - m); }
    float ps = 0.f;
#pragma unroll
    for (int r = 0; r < 16; ++r) ps += p0[r] + p1[r];
    l_half += ps;
#define PK4(P, BASE, OUT) do { unsigned a0 = cvtpk(P[BASE + 0], P[BASE + 1]), a1 = cvtpk(P[BASE + 2], P[BASE + 3]);   \
    unsigned b0 = cvtpk(P[BASE + 4], P[BASE + 5]), b1 = cvtpk(P[BASE + 6], P[BASE + 7]);                              \
    auto r0 = __builtin_amdgcn_permlane32_swap(a0, b0, false, false); auto r1 = __builtin_amdgcn_permlane32_swap(a1, b1, false, false); \
    v4u w = {r0[0], r1[0], r0[1], r1[1]}; OUT = *reinterpret_cast<bf16x8*>(&w); } while (0)
    PK4(p0, 0, pa0); PK4(p0, 8, pa1); PK4(p1, 0, pa2); PK4(p1, 8, pa3);
#undef PK4
}
template <int D0> __device__ __forceinline__ void pv_one(f32x16& oa, int vb, const bf16x8 (&pa)[4]) {
#define PK(L, H) (bf16x8){L[0], L[1], L[2], L[3], H[0], H[1], H[2], H[3]}
    {   const s16x4 l0 = tr_read<v_rd_off(D0, 0, 0)>(vb), h0 = tr_read<v_rd_off(D0, 0, 1)>(vb), l1 = tr_read<v_rd_off(D0, 1, 0)>(vb), h1 = tr_read<v_rd_off(D0, 1, 1)>(vb);
        asm volatile("s_waitcnt lgkmcnt(0)" ::: "memory"); SBAR();
        oa = __builtin_amdgcn_mfma_f32_32x32x16_bf16(pa[0], PK(l0, h0), oa, 0, 0, 0);
        oa = __builtin_amdgcn_mfma_f32_32x32x16_bf16(pa[1], PK(l1, h1), oa, 0, 0, 0); }
    {   const s16x4 l2 = tr_read<v_rd_off(D0, 2, 0)>(vb), h2 = tr_read<v_rd_off(D0, 2, 1)>(vb), l3 = tr_read<v_rd_off(D0, 3, 0)>(vb), h3 = tr_read<v_rd_off(D0, 3, 1)>(vb);
        asm volatile("s_waitcnt lgkmcnt(0)" ::: "memory"); SBAR();
        oa = __builtin_amdgcn_mfma_f32_32x32x16_bf16(pa[2], PK(l2, h2), oa, 0, 0, 0);
        oa = __builtin_amdgcn_mfma_f32_32x32x16_bf16(pa[3], PK(l3, h3), oa, 0, 0, 0); }
#undef PK
}
template <int D0> __device__ __forceinline__ void pv_two(f32x16& oa, f32x16& ob, int vb, const bf16x8 (&pa)[4], const bf16x8 (&pb)[4]) {
#define PK(L, H) (bf16x8){L[0], L[1], L[2], L[3], H[0], H[1], H[2], H[3]}
    {   const s16x4 l0 = tr_read<v_rd_off(D0, 0, 0)>(vb), h0 = tr_read<v_rd_off(D0, 0, 1)>(vb), l1 = tr_read<v_rd_off(D0, 1, 0)>(vb), h1 = tr_read<v_rd_off(D0, 1, 1)>(vb);
        asm volatile("s_waitcnt lgkmcnt(0)" ::: "memory"); SBAR();
        const bf16x8 v0 = PK(l0, h0), v1 = PK(l1, h1);
        oa = __builtin_amdgcn_mfma_f32_32x32x16_bf16(pa[0], v0, oa, 0, 0, 0); ob = __builtin_amdgcn_mfma_f32_32x32x16_bf16(pb[0], v0, ob, 0, 0, 0);
        oa = __builtin_amdgcn_mfma_f32_32x32x16_bf16(pa[1], v1, oa, 0, 0, 0); ob = __builtin_amdgcn_mfma_f32_32x32x16_bf16(pb[1], v1, ob, 0, 0, 0); }
    {   const s16x4 l2 = tr_read<v_rd_off(D0, 2, 0)>(vb), h2 = tr_read<v_rd_off(D0, 2, 1)>(vb), l3 = tr_read<v_rd_off(D0, 3, 0)>(vb), h3 = tr_read<v_rd_off(D0, 3, 1)>(vb);
        asm volatile("s_waitcnt lgkmcnt(0)" ::: "memory"); SBAR();
        const bf16x8 v2 = PK(l2, h2), v3 = PK(l3, h3);
        oa = __builtin_amdgcn_mfma_f32_32x32x16_bf16(pa[2], v2, oa, 0, 0, 0); ob = __builtin_amdgcn_mfma_f32_32x32x16_bf16(pb[2], v2, ob, 0, 0, 0);
        oa = __builtin_amdgcn_mfma_f32_32x32x16_bf16(pa[3], v3, oa, 0, 0, 0); ob = __builtin_amdgcn_mfma_f32_32x32x16_bf16(pb[3], v3, ob, 0, 0, 0); }
#undef PK
}
__device__ __forceinline__ void rescale(f32x16 (&o)[4], float al, float* wsf, int r32, int hi) {
    if (__any(al < 1.f)) {
        if (hi == 0) wsf[r32] = al; asm volatile("s_waitcnt lgkmcnt(0)" ::: "memory");
#pragma unroll
        for (int r = 0; r < 16; ++r) { const float a = wsf[crow(r, hi)];
#pragma unroll
            for (int d = 0; d < 4; ++d) o[d][r] *= a; }
    }
}

__device__ __forceinline__ void epilogue(const Ctx& X, f32x16 (&oa)[4], f32x16 (&ob)[4], const float* wsf, int r32, int hi, int b, int h, int qb, float lam, float mul, const float* __restrict__ sg) {
    bf16* Yw = (bf16*)(X.ws + WS_YA) + ((size_t)b * S + qb * 256 + X.wave * 32) * 512 + h * 128;
    float gcol[4];
#pragma unroll
    for (int d = 0; d < 4; ++d) gcol[d] = sg[d * 32 + r32] * mul;
#pragma unroll
    for (int r = 0; r < 16; ++r) { const int orow = crow(r, hi); const float i0 = __builtin_amdgcn_rcpf(wsf[orow] + wsf[64 + orow]), i1 = lam * __builtin_amdgcn_rcpf(wsf[32 + orow] + wsf[96 + orow]);
        float v[4], ss = 0.f;
#pragma unroll
        for (int d = 0; d < 4; ++d) { v[d] = oa[d][r] * i0 - ob[d][r] * i1; ss += v[d] * v[d]; }
        ss += xor_f<1>(ss); ss += xor_f<2>(ss); ss += xor_f<4>(ss); ss += xor_f<8>(ss); ss += xor_f<16>(ss);
        const float rn = rsqrtf(ss * (1.f / 128.f) + 1e-5f);
#pragma unroll
        for (int d = 0; d < 4; ++d) Yw[(size_t)orow * 512 + d * 32 + r32] = (bf16)f2bf(v[d] * rn * gcol[d]); }
}
__device__ __forceinline__ int vkey(int T_, int lane) { const int kk = ((T_ >> 2) << 3) | ((lane & 31) >> 2); return (kk & ~0xC) | ((kk & 4) << 1) | ((kk & 8) >> 1); }
__device__ __forceinline__ int vcol(int T_, int lane) { return (T_ & 3) * 32 + (lane & 3) * 8; }
__device__ __forceinline__ void attn_unit(const Ctx& X, int b, int h, int qb, float lam, float mul, const float* __restrict__ sg, unsigned* kmax2) {
    char* lds = (char*)X.lds;
    const int tid = fresh_tid(X.wave_s);
    const int wid = X.wave, lane = tid & 63, r32 = lane & 31, hi = lane >> 5;
    const bf16* Qg = (const bf16*)(X.ws + WS_Q) + ((size_t)b * S + qb * 256) * LDK + h * 128;
    const bf16* Kh = (const bf16*)(X.ws + WS_K) + (size_t)b * S * LDK + h * 128;
    const bf16* Vh = (const bf16*)(X.ws + WS_V) + (size_t)b * S * LDK + h * 128;
    char* V_lds = lds + OFF_V; char* K_lds = lds + OFF_K; char* Q_lds = lds + OFF_Q;
    float* wsf = (float*)(lds + OFF_WS) + wid * 160;
    const int sr = tid >> 4, sc = (tid & 15) * 8, vst0 = v_st(sr, sc), vst1 = v_st(32 + sr, sc);
    const int vb0 = (int)(uintptr_t)V_lds + v_rd_base(lane);
#pragma unroll
    for (int i = 0; i < 8; ++i) { const int row = sr + 32 * i; *(bf16x8*)(Q_lds + KSWZ(row, sc * 2)) = *reinterpret_cast<const bf16x8*>(Qg + (size_t)row * LDK + sc); }
    bf16x8 st0, st1;
    const unsigned goff = (unsigned)(sr * LDK + sc) * 2u;
#define KLOAD(k0) do { const char* t_ = (const char*)Kh + (size_t)(k0) * (LDK * 2); st0 = *reinterpret_cast<const bf16x8*>(t_ + goff); st1 = *reinterpret_cast<const bf16x8*>(t_ + 32 * LDK * 2 + goff); } while (0)
#define VLOAD(k0) do { const char* t_ = (const char*)Vh + (size_t)(k0) * (LDK * 2); st0 = *reinterpret_cast<const bf16x8*>(t_ + goff); st1 = *reinterpret_cast<const bf16x8*>(t_ + 32 * LDK * 2 + goff); } while (0)
#define KWRITE(bb) do { *(bf16x8*)(K_lds + (bb) * SHM_K + KSWZ(sr, sc * 2)) = st0; *(bf16x8*)(K_lds + (bb) * SHM_K + KSWZ(32 + sr, sc * 2)) = st1; } while (0)
    const unsigned vsrc0 = (unsigned)(vkey(2 * wid + (lane >> 5), lane) * LDK + vcol(2 * wid + (lane >> 5), lane)) * 2u, vsrc1 = (unsigned)(vkey(2 * (wid + 8) + (lane >> 5), lane) * LDK + vcol(2 * (wid + 8) + (lane >> 5), lane)) * 2u;
#define VDMA(k0, bbn) do { const char* t_ = (const char*)Vh + (size_t)(k0) * (LDK * 2); LAS unsigned char* d_ = X.lds + OFF_V + (bbn) * SHM_V + wid * 1024; \
    __builtin_amdgcn_global_load_lds((const unsigned*)(t_ + vsrc0), (LAS unsigned*)d_, 16, 0, 0); __builtin_amdgcn_global_load_lds((const unsigned*)(t_ + vsrc1), (LAS unsigned*)(d_ + 8192), 16, 0, 0); } while (0)
    const unsigned ksrc = (unsigned)(wid * 8 * LDK * 2) + (unsigned)lane * 4u;
#define KDMA(k0, bbn) do { const char* t_ = (const char*)Kh + (size_t)(k0) * (LDK * 2) + ksrc; LAS unsigned char* d_ = X.lds + OFF_K + (bbn) * SHM_K + wid * 8 * KPITCH; \
    _Pragma("unroll") for (int i_ = 0; i_ < 8; ++i_) __builtin_amdgcn_global_load_lds((const unsigned*)(t_ + i_ * (LDK * 2)), (LAS unsigned*)(d_ + i_ * KPITCH), 4, 0, 0); } while (0)
#define VWRITE(bb) do { *(bf16x8*)(V_lds + (bb) * SHM_V + vst0) = st0; *(bf16x8*)(V_lds + (bb) * SHM_V + vst1) = st1; } while (0)
    float l0 = 0.f, l1 = 0.f; f32x16 oa[4] = {}, ob[4] = {};
    const int qrow = wid * 32 + r32; constexpr int NT = S / KVBLK;
    KDMA(0, 0); VDMA(0, 0); __syncthreads();
    float m0, m1;
    { float s0 = 0.f, s1 = 0.f;
#pragma unroll
      for (int d0 = 0; d0 < 8; ++d0) { const v4u w = *reinterpret_cast<const v4u*>(Q_lds + KSWZ(qrow, (d0 * 16 + hi * 8) * 2)); f32x4 p, q; unpack8(w, p, q);
          const float ss = (p.x * p.x + p.y * p.y) + (p.z * p.z + p.w * p.w) + (q.x * q.x + q.y * q.y) + (q.z * q.z + q.w * q.w); if (d0 < 4) s0 += ss; else s1 += ss; }
      wsf[hi * 64 + r32] = s0; wsf[hi * 64 + 32 + r32] = s1; asm volatile("s_waitcnt lgkmcnt(0)" ::: "memory");
      s0 += wsf[(hi ^ 1) * 64 + r32]; s1 += wsf[(hi ^ 1) * 64 + 32 + r32]; asm volatile("s_waitcnt lgkmcnt(0)" ::: "memory");
      const float k0 = __uint_as_float(__hip_atomic_load(kmax2 + b * 8 + h * 2, __ATOMIC_RELAXED, __HIP_MEMORY_SCOPE_AGENT)), k1 = __uint_as_float(__hip_atomic_load(kmax2 + b * 8 + h * 2 + 1, __ATOMIC_RELAXED, __HIP_MEMORY_SCOPE_AGENT));
      m0 = sqrtf(s0 * k0) * 1.001f + 1e-3f; m1 = sqrtf(s1 * k1) * 1.001f + 1e-3f; }
    for (int j = 0; j < NT; ++j) {
        const int bb = j & 1; const char* Ks = K_lds + bb * SHM_K;
        const int kn = (j + 1) * KVBLK;
        if (j + 1 < NT) { KDMA(kn, bb ^ 1); VDMA(kn, bb ^ 1); }
        const int vb = vb0 + bb * SHM_V;
        bf16x8 pa[4], pb[4];
        { f32x16 p0, p1, q0, q1;
          qkt<0>(p0, p1, Ks, Q_lds, qrow, r32, hi); qkt<1>(q0, q1, Ks, Q_lds, qrow, r32, hi);
          softmax_fixed(p0, p1, m0, l0, pa[0], pa[1], pa[2], pa[3]);
          softmax_fixed(q0, q1, m1, l1, pb[0], pb[1], pb[2], pb[3]); }
        SBAR();
        pv_two<0>(oa[0], ob[0], vb, pa, pb); pv_two<1>(oa[1], ob[1], vb, pa, pb); pv_two<2>(oa[2], ob[2], vb, pa, pb); pv_two<3>(oa[3], ob[3], vb, pa, pb);
        __syncthreads();
    }
#undef KLOAD
#undef VLOAD
#undef VDMA
#undef KDMA
#undef KWRITE
#undef VWRITE
    wsf[hi * 64 + r32] = l0; wsf[hi * 64 + 32 + r32] = l1; asm volatile("s_waitcnt lgkmcnt(0)" ::: "memory");
    { const int t2 = fresh_tid(X.wave_s); epilogue(X, oa, ob, wsf, t2 & 31, (t2 & 63) >> 5, b, h, qb, lam, mul, sg); }
    __syncthreads();
}
__device__ __forceinline__ void epilogue_unused() {}
#undef KSWZ
#undef SBAR
}
}
namespace mk {
namespace hy {
constexpr int CPS = 16704;
constexpr int NEL = 8352;
constexpr int OFF_Z = 4 * CPS;
constexpr int ZROW = 144, ZB = 128 * ZROW;
constexpr int LDS_TOTAL = OFF_Z + 4 * ZB;

__device__ __forceinline__ void build_hrev(const Ctx& X, const bf16* hf, const bf16* hb, float bias) {
    const int tid = X.tid;
    if (tid < 4 * 8) { const int m = tid >> 3, e = tid & 7; if (e < 5 - m) *(LAS bf16*)(X.lds + m * CPS + 2 * e) = 0; }
    for (int i = tid; i < 4 * (NEL - 8192); i += NTH) { const int m = i / (NEL - 8192), e = 8192 + (i - m * (NEL - 8192)); if (e > 8195 - m) *(LAS bf16*)(X.lds + m * CPS + 2 * e) = 0; }
#pragma unroll
    for (int half = 0; half < 2; ++half) {
        const v4u w = *(const v4u*)((half ? hb : hf) + 8 * tid);
        unsigned short v[8] = {(unsigned short)(w.x & 0xffff), (unsigned short)(w.x >> 16), (unsigned short)(w.y & 0xffff), (unsigned short)(w.y >> 16), (unsigned short)(w.z & 0xffff), (unsigned short)(w.z >> 16), (unsigned short)(w.w & 0xffff), (unsigned short)(w.w >> 16)};
        if (half == 0 && tid == 0) v[0] = (unsigned short)f2bf(bf2f(v[0]) + bias);
#pragma unroll
        for (int k = 0; k < 8; ++k) { const int d = 8 * tid + k; if (half == 1 && d == 0) continue;
            const int e0 = half ? 4100 + d : 4100 - d;
#pragma unroll
            for (int m = 0; m < 4; ++m) *(LAS bf16*)(X.lds + m * CPS + 2 * (e0 - m)) = v[k]; }
    }
}
#ifdef MK_HY_XLDS
#define HY_XL(qq) do { const v2u x0_ = *(const volatile LAS v2u*)(X.lds + baseA + 32 * (qq)), x1_ = *(const volatile LAS v2u*)(X.lds + baseA8 + 32 * (qq)); asm volatile("" :: "v"(x0_), "v"(x1_)); } while (0)
#else
#define HY_XL(qq) do {} while (0)
#endif
#define HY_LDA(dst, qq) do { HY_XL(qq); const v2u lo_ = *(const volatile LAS v2u*)(X.lds + baseA + 32 * (qq)), hi_ = *(const volatile LAS v2u*)(X.lds + baseA8 + 32 * (qq)); v4u w_ = {lo_.x, lo_.y, hi_.x, hi_.y}; dst = *reinterpret_cast<bf16x8*>(&w_); } while (0)
#define HY_LOAD_E(FA, FB, d1_, q_) do { const LAS unsigned char* zr_ = zb - (d1_) * ZROW; HY_LDA(FA[0], (q_)); HY_LDA(FA[1], (q_) + 1); \
    FB[0] = *(const LAS bf16x8*)(zr_); FB[1] = *(const LAS bf16x8*)(zr_ + 32); FB[2] = *(const LAS bf16x8*)(zr_ + 64); FB[3] = *(const LAS bf16x8*)(zr_ + 96); } while (0)
#define HY_LOAD_L(FA, q_) do { HY_LDA(FA[2], (q_) + 2); HY_LDA(FA[3], (q_) + 3); } while (0)
#ifdef MK_HY_XMFMA
#define HY_XM(A_, B_) do { dacc0 = __builtin_amdgcn_mfma_f32_32x32x16_bf16(A_, B_, dacc0, 0, 0, 0); } while (0)
#else
#define HY_XM(A_, B_) do {} while (0)
#endif
#define HY_MMA1(FA, FB, PA) do { __builtin_amdgcn_s_setprio(1); HY_XM(FA[0], FB[0]); HY_XM(PA[2], FB[0]); HY_XM(FA[1], FB[1]); HY_XM(PA[3], FB[1]); \
    acc0 = __builtin_amdgcn_mfma_f32_32x32x16_bf16(FA[0], FB[0], acc0, 0, 0, 0); acc1 = __builtin_amdgcn_mfma_f32_32x32x16_bf16(PA[2], FB[0], acc1, 0, 0, 0); \
    acc0 = __builtin_amdgcn_mfma_f32_32x32x16_bf16(FA[1], FB[1], acc0, 0, 0, 0); acc1 = __builtin_amdgcn_mfma_f32_32x32x16_bf16(PA[3], FB[1], acc1, 0, 0, 0); __builtin_amdgcn_s_setprio(0); } while (0)
#define HY_MMA2(FA, FB) do { __builtin_amdgcn_s_setprio(1); HY_XM(FA[2], FB[2]); HY_XM(FA[0], FB[2]); HY_XM(FA[3], FB[3]); HY_XM(FA[1], FB[3]); \
    acc0 = __builtin_amdgcn_mfma_f32_32x32x16_bf16(FA[2], FB[2], acc0, 0, 0, 0); acc1 = __builtin_amdgcn_mfma_f32_32x32x16_bf16(FA[0], FB[2], acc1, 0, 0, 0); \
    acc0 = __builtin_amdgcn_mfma_f32_32x32x16_bf16(FA[3], FB[3], acc0, 0, 0, 0); acc1 = __builtin_amdgcn_mfma_f32_32x32x16_bf16(FA[1], FB[3], acc1, 0, 0, 0); __builtin_amdgcn_s_setprio(0); } while (0)
template <int PAIR> __device__ __forceinline__ void channel(const Ctx& X, int l, int c, const float* __restrict__ hyb, v2u (&keep)[2][4]) {
    const bf16* UCT = (const bf16*)(X.ws + WS_UCT); const bf16* FILT = (const bf16*)(X.ws + WS_FILT) + (size_t)l * 4 * C * S; bf16* YH = (bf16*)(X.ws + WS_YH);
    const int tid = X.tid, lane = X.lane, wid = X.wave, r = lane & 31, h = lane >> 5, b = wid >> 1, jt = wid & 1;
    LAS unsigned char* zl = X.lds + OFF_Z;
    __syncthreads();
    v4u zero4 = {0u, 0u, 0u, 0u}; asm volatile("" : "+v"(zero4));
    for (int i = tid; i < 4 * 64 * 9; i += NTH) { const int bb = i / 576, rr = (i % 576) / 9, ch = i % 9; const int row = rr < 32 ? rr : 64 + rr;
        *(LAS v4u*)(zl + bb * ZB + row * ZROW + ch * 16) = zero4; }
    for (int i = tid; i < 4 * 64 * 8; i += NTH) { const int bb = i >> 9, s1 = (i >> 3) & 63, ch = i & 7;
        *(LAS v4u*)(zl + bb * ZB + (32 + s1) * ZROW + ch * 16) = *(const v4u*)(UCT + (size_t)c * T + bb * S + s1 * 64 + ch * 8); }
    const int m4 = (4 - (r & 3)) & 3;
    const int baseA = m4 * CPS + 2 * (8 * h - r + 4100 - m4);
    int baseA8 = baseA + 8; asm volatile("" : "+v"(baseA8));
    for (int o = 0; o < 2; ++o) {
        build_hrev(X, FILT + ((size_t)(2 * o) * C + c) * S, FILT + ((size_t)(2 * o + 1) * C + c) * S, hyb[(l * 2 + o) * C + c]);
#ifdef MK_HY_DUPBUILD
        asm volatile("" ::: "memory"); build_hrev(X, FILT + ((size_t)(2 * o) * C + c) * S, FILT + ((size_t)(2 * o + 1) * C + c) * S, hyb[(l * 2 + o) * C + c]);
#endif
        const bf16* gate = UCT + (size_t)((o + 1) * C + c) * T + (size_t)b * S;
        const int t1 = 32 * jt + r;
        v2u gw[2][4];
#pragma unroll
        for (int mt = 0; mt < 2; ++mt)
#pragma unroll
            for (int g = 0; g < 4; ++g) gw[mt][g] = *(const v2u*)(gate + t1 * 64 + 32 * mt + 8 * g + 4 * h);
        __syncthreads();
#ifndef MK_HY_SWEEPS
#define MK_HY_SWEEPS 1
#endif
        f32x16 acc0 = {}, acc1 = {};
#ifdef MK_HY_XMFMA
        f32x16 dacc0 = {};
#endif
        for (int rep = 0; rep < MK_HY_SWEEPS; ++rep) {
        const int d1max = 32 * jt + 31; int q = -4 * d1max;
        const LAS unsigned char* zb = zl + b * ZB + (32 + 32 * jt + r) * ZROW + 16 * h;
        bf16x8 fa0[4], fb0[4], fa1[4], fb1[4];
        HY_LDA(fa1[2], q - 2); HY_LDA(fa1[3], q - 1);
        HY_LOAD_E(fa0, fb0, d1max, q); HY_LOAD_L(fa0, q);
        int d1 = d1max;
        for (int it = 0; it < 47; ++it) {
            HY_LOAD_E(fa1, fb1, d1 - 1, q + 4);
            HY_MMA1(fa0, fb0, fa1);
            HY_LOAD_L(fa1, q + 4);
            HY_MMA2(fa0, fb0);
            HY_LOAD_E(fa0, fb0, d1 - 2, q + 8);
            HY_MMA1(fa1, fb1, fa0);
            HY_LOAD_L(fa0, q + 8);
            HY_MMA2(fa1, fb1);
            d1 -= 2; q += 8;
        }
        HY_MMA1(fa0, fb0, fa1); HY_MMA2(fa0, fb0);
        }
        if (MK_HY_SWEEPS == 2) { acc0 *= 0.5f; acc1 *= 0.5f; }
#ifdef MK_HY_XMFMA
        asm volatile("" :: "v"(dacc0));
#endif
        __syncthreads();
#pragma unroll
        for (int mt = 0; mt < 2; ++mt)
#pragma unroll
            for (int g = 0; g < 4; ++g) { const int t0 = 32 * mt + 8 * g + 4 * h; const v2u gwv = gw[mt][g];
                const f32x16& a = mt ? acc1 : acc0;
                const float y0 = a[4 * g] * bflo(gwv.x), y1 = a[4 * g + 1] * bfhi(gwv.x), y2 = a[4 * g + 2] * bflo(gwv.y), y3 = a[4 * g + 3] * bfhi(gwv.y);
                if (o == 0) { v2u w; w.x = pk2(y0, y1); w.y = pk2(y2, y3); *(LAS v2u*)(zl + b * ZB + (32 + t1) * ZROW + t0 * 2) = w; }
                else if (PAIR == 0) { keep[mt][g].x = pk2(y0, y1); keep[mt][g].y = pk2(y2, y3); }
                else { unsigned* yo = (unsigned*)(YH + ((size_t)b * S + t1 * 64 + t0) * C + (c - 1)); const v2u kp = keep[mt][g];
                    yo[0] = (kp.x & 0xffffu) | (f2bf(y0) << 16); yo[C / 2] = (kp.x >> 16) | (f2bf(y1) << 16); yo[C] = (kp.y & 0xffffu) | (f2bf(y2) << 16); yo[3 * C / 2] = (kp.y >> 16) | (f2bf(y3) << 16); } }
    }
    __syncthreads();
}
#undef HY_LDA
#undef HY_LOAD_E
#undef HY_LOAD_L
#undef HY_MMA1
#undef HY_MMA2
}
}
namespace mk {
#define GAS __attribute__((address_space(1)))
typedef GAS unsigned gu32;
typedef GAS unsigned long long gu64;
#define RLX_AGENT __ATOMIC_RELAXED, __HIP_MEMORY_SCOPE_AGENT
#define LDS_WAIT() asm volatile("s_waitcnt lgkmcnt(0)" ::: "memory")
#define VM_WAIT() asm volatile("s_waitcnt vmcnt(0)" ::: "memory")
__device__ __forceinline__ unsigned long long rt() { return __builtin_amdgcn_s_memrealtime(); }
#define XB_TMO      128
#define XB_XCNT(j)  (256  + 64 * (j))
#define XB_XSUB(j)  (1280 + 64 * (j))
#define XB_XGEN(j)  (2304 + 64 * (j))
#define XB_TOP      3328
#define XB_TOPGEN   3392
#define XCD_BAR_WORDS 3456
#define XB_SPIN_CAP (1u << 18)

__device__ __forceinline__ unsigned xb_ld(unsigned* p)              { return __hip_atomic_load(p, __ATOMIC_RELAXED, __HIP_MEMORY_SCOPE_AGENT); }
__device__ __forceinline__ unsigned xb_add(unsigned* p, unsigned v) { return __hip_atomic_fetch_add(p, v, __ATOMIC_RELAXED, __HIP_MEMORY_SCOPE_AGENT); }
__device__ __forceinline__ unsigned xb_xcc_id() { return (unsigned)__builtin_amdgcn_s_getreg((3 << 11) | 20) & 0xFu; }
#define XB_SPIN(cond, bar) do { unsigned _sp = 0; while (cond) { __builtin_amdgcn_s_sleep(1); \
    if ((++_sp & 255u) == 0u) { if (xb_ld(&(bar)[XB_TMO])) break; if (_sp > XB_SPIN_CAP) { atomicAdd(&(bar)[XB_TMO], 1u); break; } } } } while (0)

struct XcdBarrier {
    unsigned* bar; unsigned x;
    volatile LAS unsigned* st;
};

__device__ __forceinline__ XcdBarrier xcd_barrier_post(unsigned* bar, volatile LAS unsigned* st) {
    XcdBarrier b; b.bar = bar; b.x = xb_xcc_id(); b.st = st;
    if (threadIdx.x == 0) (void)xb_add(&bar[XB_XCNT(b.x)], 1u);
    return b;
}
__device__ __forceinline__ void xcd_barrier_complete(unsigned* bar, unsigned x, unsigned& nloc, unsigned& nx) {
    const unsigned G = gridDim.x * gridDim.y * gridDim.z;
    unsigned sum, cnt, mine, sp = 0u;
    for (;;) {
        sum = 0u; cnt = 0u; mine = 0u;
#pragma unroll
        for (unsigned j = 0; j < 16; ++j) { const unsigned c = xb_ld(&bar[XB_XCNT(j)]); sum += c; cnt += (c > 0u) ? 1u : 0u; mine = (j == x) ? c : mine; }
        if (sum == G) break;
        __builtin_amdgcn_s_sleep(1);
        if ((++sp & 255u) == 0u) { if (xb_ld(&bar[XB_TMO])) break; if (sp > XB_SPIN_CAP) { atomicAdd(&bar[XB_TMO], 1u); break; } }
    }
    nloc = mine > 0u ? mine : 1u; nx = cnt > 0u ? cnt : 1u;
}

__device__ __forceinline__ void xcd_barrier(const XcdBarrier& b, int wave_s) {
    asm volatile("s_waitcnt vmcnt(0)" ::: "memory");
    __syncthreads();
    if (fresh_tid(wave_s) == 0) {
        unsigned* bar = b.bar;
        __builtin_amdgcn_s_waitcnt(0);
        unsigned nloc = b.st[0], nx = b.st[1];
        if (nloc == 0u) { xcd_barrier_complete(bar, b.x, nloc, nx); b.st[0] = nloc; b.st[1] = nx; }
        const unsigned old = xb_add(&bar[XB_XSUB(b.x)], 1u);
        const unsigned gen = old / nloc;
        if (old + 1u == (gen + 1u) * nloc) {
            __builtin_amdgcn_fence(__ATOMIC_RELEASE, "agent");
            asm volatile("s_waitcnt vmcnt(0)" ::: "memory");
            const unsigned og = xb_add(&bar[XB_TOP], 1u);
            const unsigned tg = og / nx;
            if (og + 1u == (tg + 1u) * nx) xb_add(&bar[XB_TOPGEN], 1u);
            else XB_SPIN(xb_ld(&bar[XB_TOPGEN]) == tg, bar);
            __builtin_amdgcn_fence(__ATOMIC_ACQUIRE, "agent");
            xb_add(&bar[XB_XGEN(b.x)], 1u);
            asm volatile("s_waitcnt vmcnt(0)" ::: "memory");
        } else {
            XB_SPIN(xb_ld(&bar[XB_XGEN(b.x)]) == gen, bar);
            __builtin_amdgcn_fence(__ATOMIC_ACQUIRE, "agent");
            asm volatile("s_waitcnt vmcnt(0)" ::: "memory");
        }
    }
    __syncthreads();
}

}
namespace mk {
namespace cg = cooperative_groups;
constexpr int PH_PER_LAYER = 10, N_PHASES = 1 + 2 * PH_PER_LAYER;

__device__ __forceinline__ float lam_of(const Args& a, int l, float lam_init) {
    const float *q1 = a.in[14] + l * 64, *k1 = a.in[15] + l * 64, *q2 = a.in[16] + l * 64, *k2 = a.in[17] + l * 64;
    float s1 = 0.f, s2 = 0.f; for (int i = 0; i < 64; ++i) { s1 += q1[i] * k1[i]; s2 += q2[i] * k2[i]; }
    return expf(s1) - expf(s2) + lam_init;
}

typedef const __attribute__((address_space(4))) Args* KArgPtr;
__global__ void __launch_bounds__(NTH, 2) fwd(Args a_byval) {
    extern __shared__ __attribute__((aligned(16))) unsigned char lds_raw[];
    cg::grid_group grid = cg::this_grid();
    const int ph_lo = a_byval.ph_lo, ph_hi = a_byval.ph_hi;
    const int wave_s = __builtin_amdgcn_readfirstlane((int)threadIdx.x >> 6);
    volatile LAS unsigned* bar_st = (volatile LAS unsigned*)((LAS unsigned char*)lds_raw + LDS_BYTES - 64);
    if (threadIdx.x == 0) { bar_st[0] = 0u; bar_st[1] = 0u; }
    __syncthreads();
    const XcdBarrier bar = xcd_barrier_post((unsigned*)a_byval.ws, bar_st);
    int rep_flag = 0;
    for (int ph = ph_lo; ph < ph_hi; ++ph) {
        KArgPtr ap = (KArgPtr)__builtin_amdgcn_kernarg_segment_ptr(); asm volatile("" : "+s"(ap));
        const Args a = *(const Args*)ap;
        float* Xr = (float*)(a.ws + WS_X);
        Ctx X; X.wave_s = wave_s; X.wave = wave_s; X.tid = 0; X.lane = 0;
#define FRESH() do { X.tid = fresh_tid(wave_s); X.lane = X.tid & 63; } while (0)
        { int g_ = gridDim.x, b_ = blockIdx.x; asm volatile("" : "+s"(g_), "+s"(b_)); X.G = g_; X.bid = b_; }
        { const int bx = X.bid; X.vcu = (X.G % 8 == 0) ? (bx % 8) * (X.G / 8) + bx / 8 : bx; }
        X.gw = X.vcu * NWAVES + X.wave; X.ngw = X.G * NWAVES; X.lds = (LAS unsigned char*)lds_raw; X.ws = a.ws;
#ifndef MK_EN
#define MK_EN 0xFFFF
#endif
#ifndef MK_ATT
#define MK_ATT 3
#endif
#ifndef MK_REP_SP
#define MK_REP_SP 99
#endif
        if (ph == 0) { if (MK_EN & 512) { FRESH(); p0_prologue(X, a); } }
        else {
            const int l = (ph - 1) / PH_PER_LAYER, sp = (ph - 1) % PH_PER_LAYER;
            const float lam_init = 0.8f - 0.6f * expf(-0.3f * (float)l);
            if (0) {}
#if MK_EN & 1
            else if (sp == 0) {
                FRESH();
                pg8::Gemm g{(const bf16*)(a.ws + WS_XN), (const bf16*)(a.ws + WS_WIN) + (size_t)l * INW * D, T, INW, D};
                pg8::StaticOrder So; So.init(T, INW, X.G, X.bid);
                EpiWin Ep{a.ws, (const float*)(a.ws + WS_BINP) + l * INW, (const float*)(a.ws + WS_ROPE)};
                pg8::gemm_phase<EpiWin, pg8::StaticOrder, true, true>(X.lds, g, So, Ep, X.tid);
            }
#endif
#if MK_EN & 2
            else if (sp == 1) {
                FRESH();
                p1t_shortconv(X, a.in[4] + l * 3 * 1536, a.in[5] + l * 1536);
                p1t_kmax(X, (unsigned*)(a.ws + 14336) + l * 32);
            }
#endif
#if MK_EN & 4
            else if (sp == 2) {
                FRESH();
                const float lam = lam_of(a, l, lam_init);
                const int c = X.bid;
#ifndef MK_REP_ATT
#define MK_REP_ATT 1
#endif
#ifndef MK_CONV_REP
#define MK_CONV_REP 1
#endif
#ifndef MK_REP_HY
#define MK_REP_HY 1
#endif
                const int cg_ = X.vcu & 3;
                if (cg_ == 0) { __syncthreads(); p0_experts(relaunder(X), a, l); if (MK_CONV_REP > 1) { __syncthreads(); p0_experts(relaunder(X), a, l); } __syncthreads(); }
                for (int rep = 0; rep < MK_REP_ATT; ++rep) for (int u = c; u < 256; u += X.G) { const int bh = 2 * (u & 7) + ((u >> 3) >> 4), qb = (u >> 3) & 15; at::attn_unit(X, bh >> 2, bh & 3, qb, lam, 1.0f - lam_init, a.in[18] + l * 128, (unsigned*)(a.ws + 14336) + l * 32); }
                if (cg_ == 1) { __syncthreads(); p0_experts(relaunder(X), a, l); if (MK_CONV_REP > 1) { __syncthreads(); p0_experts(relaunder(X), a, l); } __syncthreads(); }
                for (int rep = 0; rep < MK_REP_HY; ++rep) for (int u = c; u < 256; u += X.G) { const int ch = 64 * (u & 7) + 2 * (u >> 3); v2u keep[2][4]; hy::channel<0>(relaunder(X), l, ch, a.in[13], keep);
                    if (cg_ == 2) { __syncthreads(); p0_experts(relaunder(X), a, l); if (MK_CONV_REP > 1) { __syncthreads(); p0_experts(relaunder(X), a, l); } __syncthreads(); }
                    hy::channel<1>(relaunder(X), l, ch + 1, a.in[13], keep); }
                if (cg_ == 3) { __syncthreads(); p0_experts(relaunder(X), a, l); if (MK_CONV_REP > 1) { __syncthreads(); p0_experts(relaunder(X), a, l); } __syncthreads(); }
            }
#endif
#if MK_EN & 8
            else if (sp == 3) {
                FRESH();
                OrderMerge So; So.so.init(T, D, X.G, X.bid);
                pg8::Gemm g{(const bf16*)(a.ws + WS_YH), (const bf16*)(a.ws + WS_WUH) + (size_t)l * 2 * D * C, 2 * T, 2 * D, C};
                EpiMerge2 Ep{(const bf16*)(a.ws + WS_GH), (const bf16*)(a.ws + WS_GA), (bf16*)(a.ws + WS_T1), (bf16*)(a.ws + WS_MG)};
                pg8::gemm_phase<EpiMerge2, OrderMerge, true, true>(X.lds, g, So, Ep, X.tid);
            }
#endif
#if MK_EN & 16
            else if (sp == 4) {
                FRESH();
                pg8::Gemm g{(const bf16*)(a.ws + WS_MG), (const bf16*)(a.ws + WS_WOUT) + (size_t)l * D * D, T, D, D};
                pg8::StaticOrder So; So.init(T, D, X.G, X.bid);
                EpiOut Ep{l == 0 ? a.in[0] : Xr, Xr};
                pg8::gemm_phase<EpiOut, pg8::StaticOrder, true, true>(X.lds, g, So, Ep, X.tid);
            }
#endif
#if MK_EN & 32
            else if (sp == 5) {
                FRESH();
                p5_norm_router(X, Xr, a.in[22] + l * D, a.in[23] + (size_t)l * D * E, a.in[24] + l * E);
            } else if (sp == 6) { FRESH(); p6_topk(X);
            }
#endif
#if MK_EN & 64
            else if (sp == 7) {
                FRESH();
                pg8::Gemm g{(const bf16*)(a.ws + WS_XN), (const bf16*)(a.ws + WS_WGU) + (size_t)l * E * 2 * F * D, E * 2048, 2 * F, D, 2 * F, 4, (size_t)2 * F * D * 2, (const int*)(a.ws + WS_ROWS)};
                OrderMoE1 So{X.G, X.bid}; EpiSwiGLU Ep{(bf16*)(a.ws + WS_HB)};
                pg8::gemm_phase<EpiSwiGLU, OrderMoE1, true, true, true, true>(X.lds, g, So, Ep, X.tid);
            }
#endif
#if MK_EN & 128
            else if (sp == 8) {
                FRESH();
                pg8::Gemm g{(const bf16*)(a.ws + WS_HB), (const bf16*)(a.ws + WS_WD) + (size_t)l * E * D * F, E * 2048, D, F, D, 2, (size_t)D * F * 2};
                OrderMoE2 So{X.G, X.bid}; EpiDown Ep{(bf16*)(a.ws + WS_YE), (const float*)(a.ws + WS_GATE)};
                pg8::gemm_phase<EpiDown, OrderMoE2, true, true, true>(X.lds, g, So, Ep, X.tid);
            }
#endif
#if MK_EN & 256
            else if (sp == 9) {
                FRESH();
                p9_combine(X, Xr, l == 0 ? a.in[1] + D : a.in[28], l == 1, a.out);
            }
#endif
        }
#ifndef MK_EXTRA_SYNC
#define MK_EXTRA_SYNC 0
#endif
        if (ph + 1 < ph_hi) { if (ph_hi > 4096) grid.sync(); else xcd_barrier(bar, wave_s); }
        for (int es = 0; es < MK_EXTRA_SYNC; ++es) xcd_barrier(bar, wave_s);
        if (MK_REP_SP != 99) { const int sp_ = ph == 0 ? -1 : (ph - 1) % PH_PER_LAYER; if (sp_ == MK_REP_SP && rep_flag == 0) { rep_flag = 1; --ph; } else rep_flag = 0; }
    }
}

static int g_grid = 0;
static bool mega_setup() {
    if (g_grid) return g_grid > 0;
    int dev = 0, cus = 0, per_cu = 0;
    if (hipGetDevice(&dev) != hipSuccess || hipDeviceGetAttribute(&cus, hipDeviceAttributeMultiprocessorCount, dev) != hipSuccess) { g_grid = -1; return false; }
    if (hipFuncSetAttribute((const void*)fwd, hipFuncAttributeMaxDynamicSharedMemorySize, LDS_BYTES) != hipSuccess) { fprintf(stderr, "hipFuncSetAttribute failed\n"); g_grid = -1; return false; }
    if (hipOccupancyMaxActiveBlocksPerMultiprocessor(&per_cu, (const void*)fwd, NTH, LDS_BYTES) != hipSuccess || per_cu < 1) { fprintf(stderr, "occupancy query failed (%d)\n", per_cu); g_grid = -1; return false; }
    g_grid = cus * 1;
    return true;
}
static void mega_launch(hipStream_t st, void* const* d_in, float* d_out, unsigned char* ws, int ph_lo, int ph_hi, int p0_mask) {
    if (!mega_setup()) return;
    Args a{};
    for (int i = 0; i < 29; ++i) a.in[i] = (const float*)d_in[i];
    a.out = d_out; a.ws = ws; a.ph_lo = ph_lo; a.ph_hi = ph_hi; a.p0_mask = p0_mask; a.pad = 0;
    if (hipMemsetAsync(ws, 0, 16384, st) != hipSuccess) { fprintf(stderr, "memset of the barrier words failed\n"); return; }
    void* args[] = {&a};
    const hipError_t e = hipLaunchCooperativeKernel((const void*)fwd, dim3(g_grid), dim3(NTH), args, LDS_BYTES, st);
    if (e != hipSuccess) fprintf(stderr, "cooperative launch failed: %s (grid %d)\n", hipGetErrorString(e), g_grid);
}
}
extern "C" void kernel_launch(void* const* d_in, const int* in_sizes, int n_in, void* d_out, int out_size, void* d_ws, size_t ws_size, hipStream_t stream) {
    if (n_in != 29 || out_size != mk::T * mk::D || ws_size < mk::WS_END) { fprintf(stderr, "kernel_launch: unexpected sizes n_in %d out %d ws %zu\n", n_in, out_size, ws_size); return; }
    mk::mega_launch(stream, d_in, (float*)d_out, (unsigned char*)d_ws, 0, mk::N_PHASES, 13);
}
```

```cpp
#include <hip/hip_runtime.h>
#include <hip/hip_cooperative_groups.h>
#include <cstdio>
#include <cstdint>
#include <cmath>
namespace tk {
constexpr int S = 4096, E = 16, CAP = 512, NT = 512;
__device__ __forceinline__ void topk_problem(const unsigned (&key)[8], const float (&rr)[8], int tokbase, int e, int slotbase, int* __restrict__ rows, float* __restrict__ gate, float* __restrict__ rsl, int* __restrict__ inv, int* sm, int tid) {
    const int lane = tid & 63, wid = tid >> 6;
    int* hist = sm; int* ctl = sm + 256;
    unsigned prefix = 0u, mask = 0u; int kth = CAP;
    for (int pass = 3; pass >= 0; --pass) {
        __syncthreads();
        if (tid < 256) hist[tid] = 0;
        __syncthreads();
#pragma unroll
        for (int i = 0; i < 8; ++i) if ((key[i] & mask) == prefix) atomicAdd(&hist[(key[i] >> (8 * pass)) & 255u], 1);
        __syncthreads();
        if (tid < 64) {
            const int b0 = hist[4 * lane], b1 = hist[4 * lane + 1], b2 = hist[4 * lane + 2], b3 = hist[4 * lane + 3];
            const int tot = b0 + b1 + b2 + b3;
            int suf = tot;
#pragma unroll
            for (int o = 1; o < 64; o <<= 1) { const int v = __builtin_amdgcn_ds_bpermute(((lane + o) & 63) << 2, suf); if (lane + o < 64) suf += v; }
            const int above = suf - tot;
            if (above < kth && kth <= above + tot) {
                int cum = above, bin, k2;
                if (cum + b3 >= kth) { bin = 4 * lane + 3; k2 = kth - cum; }
                else { cum += b3; if (cum + b2 >= kth) { bin = 4 * lane + 2; k2 = kth - cum; }
                else { cum += b2; if (cum + b1 >= kth) { bin = 4 * lane + 1; k2 = kth - cum; }
                else { cum += b1; bin = 4 * lane; k2 = kth - cum; } } }
                ctl[0] = bin; ctl[1] = k2;
            }
        }
        __syncthreads();
        prefix |= ((unsigned)ctl[0]) << (8 * pass); mask |= 0xFFu << (8 * pass); kth = ctl[1];
    }
    const unsigned thr = prefix; const int need_eq = kth; const int n_gt = CAP - need_eq;
    int cg = 0, ce = 0;
#pragma unroll
    for (int i = 0; i < 8; ++i) { cg += key[i] > thr; ce += key[i] == thr; }
    int sg = cg, se = ce;
#pragma unroll
    for (int o = 1; o < 64; o <<= 1) { const int a = __builtin_amdgcn_ds_bpermute(((lane - o) & 63) << 2, sg), b = __builtin_amdgcn_ds_bpermute(((lane - o) & 63) << 2, se); if (lane >= o) { sg += a; se += b; } }
    __syncthreads();
    if (lane == 63) { ctl[8 + wid] = sg; ctl[16 + wid] = se; }
    __syncthreads();
    int og = sg - cg, oe = se - ce;
    for (int w = 0; w < wid; ++w) { og += ctl[8 + w]; oe += ctl[16 + w]; }
#pragma unroll
    for (int i = 0; i < 8; ++i) {
        const int idx = tid * 8 + i; int slot = -1;
        if (key[i] > thr) slot = og++;
        else if (key[i] == thr) { if (oe < need_eq) slot = n_gt + oe; ++oe; }
        if (slot >= 0) { rows[slot] = tokbase + idx; gate[slot] = __uint_as_float(key[i]); rsl[slot] = rr[i]; }
        inv[(size_t)(tokbase + idx) * E + e] = slot >= 0 ? slotbase + slot : -1;
    }
    __syncthreads();
}
}
namespace pg8 {
#define PG8_LAS __attribute__((address_space(3)))
typedef unsigned short bf16_t;
typedef short bf16x8 __attribute__((ext_vector_type(8)));
typedef float f32x4 __attribute__((ext_vector_type(4)));
typedef unsigned u32x4 __attribute__((ext_vector_type(4)));
typedef short s16x4 __attribute__((ext_vector_type(4)));
constexpr int BM = 256, BK = 64, HALF = 128, HTB = HALF * BK * 2  , STAGE_BYTES = 8 * HTB, NXCD = 8, WGM = 8;

__host__ __device__ __forceinline__ int lds_byte(int r, int c) { const int st = (r >> 4) * 2 + (c >> 5), rr = r & 15, cc = c & 31, ob = rr * 64 + cc * 2; return st * 1024 + (ob ^ (((ob >> 9) & 1) << 5)); }
__host__ __device__ __forceinline__ void stage_rc(int b, int& R, int& C) { const int st = b / 1024, sb = b % 1024, swz = sb ^ (((sb >> 9) & 1) << 5); R = (st >> 1) * 16 + swz / 64; C = (st & 1) * 32 + (swz % 64) / 2; }
__host__ __device__ __forceinline__ int perm32(int rho) { const int n = rho >> 4, i = rho & 15; return 8 * (i >> 2) + 4 * n + (i & 3); }

struct Unit { int pm, pn, pb, pa; };
struct Gemm { const bf16_t* A; const bf16_t* Bt; int M, N, K; int bN = 0, bsh = 0; size_t bes = 0; const int* arows = nullptr; };

struct StaticOrder {
    int nM, nN, nwg, G, c;
    __host__ __device__ void init(int M, int N, int G_, int c_) { nM = M / BM; nN = N / BM; nwg = nM * nN; G = G_; c = c_; }
    __host__ __device__ bool next(int i, Unit& u) const {
        const long L = (long)i * G + c; if (L >= nwg) return false;
        int wgid = (int)L; { const int q = nwg / NXCD, r = nwg % NXCD, xcd = wgid % NXCD, off = wgid / NXCD; wgid = (xcd < r ? xcd * (q + 1) : r * (q + 1) + (xcd - r) * q) + off; }
        const int nig = WGM * nN, gid = wgid / nig, fm = gid * WGM, gsz = (nM - fm) < WGM ? (nM - fm) : WGM;
        u.pm = fm + ((wgid % nig) % gsz); u.pn = (wgid % nig) / gsz; u.pb = u.pn; u.pa = u.pm; return true;
    }
    __device__ __forceinline__ void a_ready(const Unit&) const {}
    __device__ __forceinline__ void done(const Unit&) const {}
};

template <class Epi, class Sched, bool ALIGN_EPI = false, bool SP2 = false, bool BT = false, bool GA = false>
__device__ __forceinline__ void gemm_phase(PG8_LAS unsigned char* lds, const Gemm g, const Sched& S, const Epi& E, int tid) {
    asm volatile("" : "+v"(tid));
    const int wid = __builtin_amdgcn_readfirstlane(tid >> 6), lane = tid & 63, wr = wid >> 2, wc = wid & 3, fr = lane & 15, fq = lane >> 4;
    const int K = g.K, nt = K / BK;
    unsigned voffA[2], voffB[2];
#pragma unroll
    for (int i = 0; i < 2; ++i) { int R, C; stage_rc(tid * 16 + i * 8192, R, C); const int Rb = Epi::PERM ? ((R & ~31) + perm32(R & 31)) : R;
        voffA[i] = (unsigned)(R * K + C) * 2u; voffB[i] = (unsigned)(Rb * K + C) * 2u; if constexpr (GA) voffA[i] = (unsigned)C * 2u;
        if constexpr (BT) { const int p = i * 512 + tid, row = ((p >> 7) << 3) | ((p >> 2) & 7), ch = (((p >> 5) & 3) << 2) | ((p & 3) ^ ((row >> 2) & 3));
            voffB[i] = (unsigned)(row * g.bN + 8 * ch) * 2u; } }
    const size_t kstep = (size_t)(BK * 2);
    const size_t hstep = (size_t)HALF * K * 2;
    const size_t tstep = 2 * hstep;
    const size_t kstepB = BT ? (size_t)BK * g.bN * 2 : kstep, hstepB = BT ? (size_t)HALF * 2 : hstep;
    const size_t hstepA = GA ? 0 : hstep;
    unsigned curA[2][2] = {{0u, 0u}, {0u, 0u}};
    PG8_LAS int* rowtab0 = (PG8_LAS int*)(lds + STAGE_BYTES);
#define PG8_ROWTAB (rowtab0 + ((ui + 1) & 1) * 512)
#define PG8_NXTOFF(o_, h) do { int t_ = tid; asm volatile("" : "+v"(t_)); _Pragma("unroll") for (int i_ = 0; i_ < 2; ++i_) { int R_, C_; stage_rc(t_ * 16 + i_ * 8192, R_, C_); \
        o_[i_] = (unsigned)PG8_ROWTAB[(h) * 128 + R_] * (unsigned)(K * 2) + (unsigned)C_ * 2u; } } while (0)
#define PG8_STAGE_A(bufoff, kbase, h, nx) do { if constexpr (GA) { if (nx) { unsigned o_[2]; PG8_NXTOFF(o_, h); PG8_STAGE(bufoff, kbase, o_); } else PG8_STAGE(bufoff, kbase, curA[h]); } \
        else PG8_STAGE(bufoff, (kbase) + ((h) ? hstep : 0), voffA); } while (0)
#define PG8_BBASE(pb) ((const char*)g.Bt + (BT ? (size_t)((pb) >> g.bsh) * g.bes + (size_t)((pb) & ((1 << g.bsh) - 1)) * 512 : (size_t)(pb) * tstep))
    const unsigned ldsw = (unsigned)wid * 1024u;
    const int aoff = lds_byte(wr * 64 + fr, fq * 8), boff = lds_byte(wc * 32 + fr, fq * 8);
    int tr0 = 0, tr1 = 0;
    if constexpr (BT) { static_assert(Epi::PERM, "BT needs the PERM column order"); const int q_ = (lane >> 2) & 3, p_ = lane & 3, f1_ = fq & 1;
        const int L_ = (int)(size_t)lds + 2048 * fq + 512 * wc + 64 * q_ + 32 * ((p_ >> 1) ^ f1_); tr0 = L_ + 16 * (p_ & 1); tr1 = L_ + 256 + 16 * (1 - (p_ & 1)); }
#define PG8_SA(b, h) (((b) * 2 + (h)) * HTB)
#define PG8_SB(b, h) ((4 + (b) * 2 + (h)) * HTB)
#define PG8_STAGE(bufoff, gbase, voff) do { _Pragma("unroll") for (int _i = 0; _i < 2; ++_i) \
        __builtin_amdgcn_global_load_lds((const unsigned*)((const char*)(gbase) + (voff)[_i]), (PG8_LAS unsigned*)(lds + (bufoff) + ldsw + _i * 8192), 16, 0, 0); } while (0)
#define PG8_LDA(dst, b, h) do { _Pragma("unroll") for (int m = 0; m < 4; ++m) _Pragma("unroll") for (int k = 0; k < 2; ++k) dst[m][k] = *(const PG8_LAS bf16x8*)(lds + PG8_SA(b, h) + aoff + m * 2048 + k * 1024); } while (0)
#define PG8_TR(dst4, addr, OFF) asm volatile("ds_read_b64_tr_b16 %0, %1 offset:%2" : "=&v"(dst4) : "v"(addr), "i"(OFF) : "memory")
#define PG8_TRF(dst8, a0, a1, OFF) do { s16x4 lo_, hi_; PG8_TR(lo_, a0, OFF); PG8_TR(hi_, a1, OFF); dst8 = __builtin_shufflevector(lo_, hi_, 0, 1, 2, 3, 4, 5, 6, 7); } while (0)
#define PG8_LDB(dst, b, h) do { if constexpr (BT) { const int a0_ = tr0 + PG8_SB(b, h), a1_ = tr1 + PG8_SB(b, h); \
        PG8_TRF(dst[0][0], a0_, a1_, 0); PG8_TRF(dst[0][1], a0_, a1_, 8192); PG8_TRF(dst[1][0], a0_, a1_, 8); PG8_TRF(dst[1][1], a0_, a1_, 8200); } else { \
    _Pragma("unroll") for (int n = 0; n < 2; ++n) _Pragma("unroll") for (int k = 0; k < 2; ++k) dst[n][k] = *(const PG8_LAS bf16x8*)(lds + PG8_SB(b, h) + boff + n * 2048 + k * 1024); } } while (0)
#define PG8_MMA(ai, bj, At, Bt) do { __builtin_amdgcn_s_setprio(1); _Pragma("unroll") for (int m = 0; m < 4; ++m) _Pragma("unroll") for (int n = 0; n < 2; ++n) _Pragma("unroll") for (int k = 0; k < 2; ++k) \
        acc[ai][bj][m][n] = __builtin_amdgcn_mfma_f32_16x16x32_bf16(Bt[n][k], At[m][k], acc[ai][bj][m][n], 0, 0, 0); __builtin_amdgcn_s_setprio(0); } while (0)
#define PG8_WAIT_V(n) asm volatile("s_waitcnt vmcnt(" #n ")" ::: "memory")
#define PG8_WAIT_L(n) asm volatile("s_waitcnt lgkmcnt(" #n ")" ::: "memory")
#define PG8_BAR __builtin_amdgcn_s_barrier()
#define PG8_SCHED __builtin_amdgcn_sched_barrier(0)
    Unit cur, nxt; int ui = 0;
    if (!S.next(0, cur)) return;
    f32x4 acc[2][2][4][2];
#pragma unroll
    for (int a = 0; a < 2; ++a)
#pragma unroll
        for (int b = 0; b < 2; ++b)
#pragma unroll
            for (int m = 0; m < 4; ++m)
#pragma unroll
                for (int n = 0; n < 2; ++n) acc[a][b][m][n] = (f32x4){0.f, 0.f, 0.f, 0.f};
    bf16x8 At[4][2], B0[2][2], B1[2][2];
    const char* cA = (const char*)g.A + (GA ? 0 : (size_t)cur.pa * tstep); const char* cB = PG8_BBASE(cur.pb);
    if constexpr (GA) {
#pragma unroll
        for (int h = 0; h < 2; ++h)
#pragma unroll
            for (int i = 0; i < 2; ++i) { int R, C; stage_rc(tid * 16 + i * 8192, R, C);
                curA[h][i] = (unsigned)__hip_atomic_load(g.arows + cur.pa * 256 + h * 128 + R, __ATOMIC_RELAXED, __HIP_MEMORY_SCOPE_AGENT) * (unsigned)(K * 2) + (unsigned)C * 2u; } }
    S.a_ready(cur);
    if constexpr (SP2) {
        PG8_STAGE(PG8_SB(0, 0), cB, voffB); PG8_STAGE(PG8_SB(0, 1), cB + hstepB, voffB); PG8_STAGE_A(PG8_SA(0, 0), cA, 0, false); PG8_STAGE_A(PG8_SA(0, 1), cA, 1, false);
        if (wr == 1) PG8_BAR;
        PG8_WAIT_V(2); PG8_BAR;
        PG8_STAGE(PG8_SB(1, 0), cB + kstepB, voffB); PG8_STAGE_A(PG8_SA(1, 0), cA + kstep, 0, false); PG8_STAGE(PG8_SB(1, 1), cB + hstepB + kstepB, voffB);
        PG8_WAIT_V(6); PG8_BAR;
    } else {
        PG8_STAGE(PG8_SB(0, 0), cB, voffB); PG8_STAGE_A(PG8_SA(0, 0), cA, 0, false); PG8_STAGE(PG8_SB(0, 1), cB + hstepB, voffB); PG8_STAGE_A(PG8_SA(0, 1), cA, 1, false);
        if (wr == 1) PG8_BAR;
        PG8_WAIT_V(4); PG8_BAR;
        PG8_STAGE(PG8_SB(1, 0), cB + kstepB, voffB); PG8_STAGE_A(PG8_SA(1, 0), cA + kstep, 0, false); PG8_STAGE(PG8_SB(1, 1), cB + hstepB + kstepB, voffB);
        PG8_WAIT_V(6); PG8_BAR;
    }
    for (;;) {
        const bool has_next = S.next(ui + 1, nxt);
        const char* nA = (has_next && !GA) ? (const char*)g.A + (size_t)nxt.pa * tstep : cA; const char* nB = has_next ? PG8_BBASE(nxt.pb) : cB;
        for (int t = 0; t < nt; t += 2) {
            const bool last = (t == nt - 2);
            const char* a1 = cA + (size_t)(t + 1) * kstep;
            const char* a2 = last ? nA : cA + (size_t)(t + 2) * kstep; const char* b2 = last ? nB : cB + (size_t)(t + 2) * kstepB;
            const char* a3 = a2 + kstep; const char* b3 = b2 + kstepB;
            if (last && has_next) S.a_ready(nxt);
            const bool nx = GA && last && has_next;
            if constexpr (GA) {
                if (t == 0 && has_next) { int l_ = lane; asm volatile("" : "+v"(l_)); __builtin_amdgcn_global_load_lds((const unsigned*)(g.arows + nxt.pa * 256 + (wid & 3) * 64 + l_), (PG8_LAS unsigned*)(PG8_ROWTAB + wid * 64), 4, 0, 0); }
            }
            if constexpr (SP2) {
            PG8_LDB(B0, 0, 0); PG8_LDB(B1, 0, 1); PG8_SCHED; PG8_LDA(At, 0, 0); PG8_STAGE_A(PG8_SA(1, 1), a1, 1, false);
            PG8_WAIT_V(8); PG8_WAIT_L(0); PG8_BAR; PG8_MMA(0, 0, At, B0); PG8_MMA(0, 1, At, B1); PG8_BAR; PG8_SCHED;
            PG8_LDA(At, 0, 1); PG8_STAGE(PG8_SB(0, 0), b2, voffB); PG8_STAGE(PG8_SB(0, 1), b2 + hstepB, voffB); PG8_STAGE_A(PG8_SA(0, 0), a2, 0, nx);
            PG8_WAIT_V(8); PG8_WAIT_L(0); PG8_BAR; PG8_MMA(1, 0, At, B0); PG8_MMA(1, 1, At, B1); PG8_BAR; PG8_SCHED;
            PG8_LDB(B0, 1, 0); PG8_LDB(B1, 1, 1); PG8_SCHED; PG8_LDA(At, 1, 0); PG8_STAGE_A(PG8_SA(0, 1), a2, 1, nx);
            PG8_WAIT_V(8); PG8_WAIT_L(0); PG8_BAR; PG8_MMA(0, 0, At, B0); PG8_MMA(0, 1, At, B1); PG8_BAR; PG8_SCHED;
            PG8_LDA(At, 1, 1); PG8_STAGE(PG8_SB(1, 0), b3, voffB); PG8_STAGE(PG8_SB(1, 1), b3 + hstepB, voffB); PG8_STAGE_A(PG8_SA(1, 0), a3, 0, nx);
            PG8_WAIT_V(8); PG8_WAIT_L(0); PG8_BAR; PG8_MMA(1, 0, At, B0); PG8_MMA(1, 1, At, B1); PG8_BAR; PG8_SCHED;
            } else {
            PG8_LDB(B0, 0, 0); PG8_SCHED; PG8_LDA(At, 0, 0); PG8_STAGE_A(PG8_SA(1, 1), a1, 1, false);
            PG8_WAIT_L(8); PG8_BAR; PG8_WAIT_L(0); PG8_MMA(0, 0, At, B0); PG8_BAR; PG8_SCHED;
            PG8_LDB(B1, 0, 1); PG8_STAGE(PG8_SB(0, 0), b2, voffB);
            PG8_BAR; PG8_WAIT_L(0); PG8_MMA(0, 1, At, B1); PG8_BAR;
            PG8_LDA(At, 0, 1); PG8_STAGE_A(PG8_SA(0, 0), a2, 0, nx);
            PG8_BAR; PG8_WAIT_L(0); PG8_MMA(1, 0, At, B0); PG8_BAR; PG8_SCHED;
            PG8_STAGE(PG8_SB(0, 1), b2 + hstepB, voffB);
            PG8_WAIT_V(6); PG8_BAR; PG8_MMA(1, 1, At, B1); PG8_BAR;
            PG8_LDB(B0, 1, 0); PG8_SCHED; PG8_LDA(At, 1, 0); PG8_STAGE_A(PG8_SA(0, 1), a2, 1, nx);
            PG8_WAIT_L(8); PG8_BAR; PG8_WAIT_L(0); PG8_MMA(0, 0, At, B0); PG8_BAR; PG8_SCHED;
            PG8_LDB(B1, 1, 1); PG8_STAGE(PG8_SB(1, 0), b3, voffB);
            PG8_BAR; PG8_WAIT_L(0); PG8_MMA(0, 1, At, B1); PG8_BAR;
            PG8_LDA(At, 1, 1); PG8_STAGE_A(PG8_SA(1, 0), a3, 0, nx);
            PG8_BAR; PG8_WAIT_L(0); PG8_MMA(1, 0, At, B0); PG8_BAR; PG8_SCHED;
            PG8_STAGE(PG8_SB(1, 1), b3 + hstepB, voffB);
            PG8_WAIT_V(6); PG8_BAR; PG8_MMA(1, 1, At, B1); PG8_BAR;
            }
        }
        if constexpr (ALIGN_EPI) { if (wr == 0) PG8_BAR; }
        if constexpr (!Epi::AFTER_DRAIN) { E(acc, cur, wr, wc, fr, fq); S.done(cur); }
        if (!has_next) break;
#pragma unroll
        for (int a = 0; a < 2; ++a)
#pragma unroll
            for (int b = 0; b < 2; ++b)
#pragma unroll
                for (int m = 0; m < 4; ++m)
#pragma unroll
                    for (int n = 0; n < 2; ++n) acc[a][b][m][n] = (f32x4){0.f, 0.f, 0.f, 0.f};
        if constexpr (GA) { PG8_NXTOFF(curA[0], 0); PG8_NXTOFF(curA[1], 1); }
        cur = nxt; cA = nA; cB = nB; ++ui;
        if constexpr (ALIGN_EPI) { if (wr == 1) PG8_BAR; }
    }
    PG8_WAIT_V(0);
    if constexpr (!ALIGN_EPI) { if (wr == 0) PG8_BAR; }
    PG8_BAR;
    if constexpr (Epi::AFTER_DRAIN) { E.fused(acc, cur, wr, wc, fr, fq, lds, wid, lane); S.done(cur); }
#undef PG8_SA
#undef PG8_SB
#undef PG8_STAGE
#undef PG8_STAGE_A
#undef PG8_NXTOFF
#undef PG8_ROWTAB
#undef PG8_LDA
#undef PG8_LDB
#undef PG8_TR
#undef PG8_TRF
#undef PG8_BBASE
#undef PG8_MMA
#undef PG8_WAIT_V
#undef PG8_WAIT_L
#undef PG8_BAR
#undef PG8_SCHED
}
}

namespace mk {
constexpr int D = 1024, B = 4, S = 4096, T = B * S, C = 512, INW = 5120, E = 16, CAP = 512, F = 2048, NTH = 512, NWAVES = 8;
typedef unsigned short bf16;
#define LAS __attribute__((address_space(3)))
typedef unsigned v4u __attribute__((ext_vector_type(4)));
typedef unsigned v2u __attribute__((ext_vector_type(2)));
typedef float f32x4 __attribute__((ext_vector_type(4)));
typedef short bf16x8 __attribute__((ext_vector_type(8)));
typedef float f32x16 __attribute__((ext_vector_type(16)));
typedef short s16x4 __attribute__((ext_vector_type(4)));

constexpr size_t MiB = 1u << 20;
constexpr size_t WS_WIN = 2 * MiB;
constexpr size_t WS_WUH = 22 * MiB;
constexpr size_t WS_WUA = 23 * MiB;
constexpr size_t WS_WOUT = 26 * MiB;
constexpr size_t WS_BINP = 30 * MiB;
constexpr size_t WS_WRP = 30 * MiB + 512 * 1024;
constexpr size_t WS_ROPE = 31 * MiB;
constexpr size_t WS_AFFT = 32 * MiB;
constexpr size_t WS_INV = 33 * MiB;
constexpr size_t WS_ROWS = 34 * MiB;
constexpr size_t WS_GATE = 34 * MiB + 512 * 1024;
constexpr size_t WS_RSL = 35 * MiB;
constexpr size_t WS_FILT = 36 * MiB;
constexpr size_t WS_X = 68 * MiB;
constexpr size_t WS_XN = 132 * MiB;
constexpr size_t WS_SH = 164 * MiB;
constexpr size_t WS_U = WS_SH;
constexpr size_t WS_UCT = WS_SH + 48 * MiB;
constexpr size_t WS_Q = WS_SH + 96 * MiB;
constexpr size_t WS_K = WS_SH + 112 * MiB;
constexpr size_t WS_V = WS_SH + 128 * MiB;
constexpr size_t WS_GH = WS_SH + 144 * MiB;
constexpr size_t WS_GA = WS_SH + 176 * MiB;
constexpr size_t WS_YH = WS_SH + 208 * MiB;
constexpr size_t WS_YA = WS_SH + 224 * MiB;
constexpr size_t WS_T1 = WS_U;
constexpr size_t WS_MG = WS_UCT;
constexpr size_t WS_PART = WS_SH;
constexpr size_t WS_HB = WS_SH + 64 * MiB;
constexpr size_t WS_YE = WS_SH + 192 * MiB;
constexpr size_t WS_WGU = 420 * MiB;
constexpr size_t WS_WD = 676 * MiB;
constexpr size_t WS_END = 804 * MiB;

constexpr int LDS_BYTES = 155648;
constexpr float QSCALE = 0.125f * 1.4426950408889634f;

struct Args {
    const float* in[29]; float* out; unsigned char* ws; int ph_lo, ph_hi; int p0_mask, pad;
};

__device__ __forceinline__ unsigned f2bf(float f) { unsigned u = __builtin_bit_cast(unsigned, f); return (u + 0x7fffu + ((u >> 16) & 1u)) >> 16; }
__device__ __forceinline__ unsigned pk2(float lo, float hi) { return f2bf(lo) | (f2bf(hi) << 16); }
__device__ __forceinline__ float bf2f(unsigned h) { return __builtin_bit_cast(float, h << 16); }
__device__ __forceinline__ float bflo(unsigned w) { return __builtin_bit_cast(float, w << 16); }
__device__ __forceinline__ float bfhi(unsigned w) { return __builtin_bit_cast(float, w & 0xffff0000u); }
template <int O> __device__ __forceinline__ float xor_f(float v) { return __builtin_bit_cast(float, __builtin_amdgcn_ds_swizzle(__builtin_bit_cast(int, v), (O << 10) | 0x1f)); }
__device__ __forceinline__ float wave_sum(float v) { v += xor_f<1>(v); v += xor_f<2>(v); v += xor_f<4>(v); v += xor_f<8>(v); v += xor_f<16>(v);
    const int b = __builtin_bit_cast(int, v); return __builtin_bit_cast(float, __builtin_amdgcn_readlane(b, 0)) + __builtin_bit_cast(float, __builtin_amdgcn_readlane(b, 32)); }

__device__ __forceinline__ float sigm(float x) { return 1.f / (1.f + __expf(-x)); }

struct Ctx { int tid, lane, wave, gw, ngw, vcu, G, bid, wave_s; LAS unsigned char* lds; unsigned char* ws; };

__device__ __forceinline__ int fresh_tid(int wave_s) { int l; asm volatile("v_mbcnt_lo_u32_b32 %0, -1, 0\n\tv_mbcnt_hi_u32_b32 %0, -1, %0" : "=v"(l)); return (wave_s << 6) | l; }
__device__ __forceinline__ Ctx relaunder(const Ctx& X) { Ctx Y = X; const int t = fresh_tid(X.wave_s); Y.tid = t; Y.lane = t & 63; return Y; }

template <int MAP> __device__ __forceinline__ int rowmap(int n) {
    if (MAP == 1) {
        if (n < 1536 || n >= 2560) return n;
        const int hb = (n - 1536) & ~63, d = (n - 1536) & 63, i = (d & 31) >> 2, j = d & 3;
        return 1536 + hb + 8 * i + ((d >> 5) << 2) + j;
    }
    if (MAP == 2) return ((n >> 7) << 8) + (n & 127);
    if (MAP == 3) return ((n >> 7) << 8) + 128 + (n & 127);
    return n;
}
__device__ __forceinline__ unsigned cvtpk_(float lo, float hi) { unsigned r; asm volatile("v_cvt_pk_bf16_f32 %0, %1, %2" : "=v"(r) : "v"(lo), "v"(hi)); return r; }
struct TrItem { const float* src; bf16* dst; };
template <int MAP> __device__ __forceinline__ void p0_transpose(const Ctx& X, const float* W, int K, int N, bf16* WT, int nmat, size_t sstride, size_t dstride) {
    LAS float* scr = (LAS float*)(X.lds + X.wave * 16640);
    const int nblk = N / 64, per = (K / 64) * nblk, tot = per * nmat, lane = X.lane;
    const int nq = lane & 15, kr = lane >> 4, c = lane & 7, nsub = lane >> 3;
    f32x4 v[16];
    int it = X.gw;
#define TR_SRC(it_) (W + (size_t)((it_) / per) * sstride + (size_t)(64 * (((it_) % per) / nblk) + kr) * N + 64 * (((it_) % per) % nblk) + 4 * nq)
    if (it < tot) { const float* s = TR_SRC(it);
#pragma unroll
        for (int i = 0; i < 16; ++i) v[i] = __builtin_nontemporal_load((const f32x4*)(s + (size_t)(4 * i) * N)); }
    while (it < tot) {
#pragma unroll
        for (int i = 0; i < 16; ++i) { LAS float* d = scr + (4 * i + kr) * 65 + 4 * nq; d[0] = v[i][0]; d[1] = v[i][1]; d[2] = v[i][2]; d[3] = v[i][3]; }
        const int nit = it + X.ngw;
        if (nit < tot) { const float* s = TR_SRC(nit);
#pragma unroll
            for (int i = 0; i < 16; ++i) v[i] = __builtin_nontemporal_load((const f32x4*)(s + (size_t)(4 * i) * N)); }
        asm volatile("s_waitcnt lgkmcnt(0)" ::: "memory");
        const int m = it / per, r = it - m * per, k0 = 64 * (r / nblk), n0 = 64 * (r % nblk);
        bf16* dst = WT + (size_t)m * dstride;
#pragma unroll
        for (int j = 0; j < 8; ++j) { const int n = nsub + 8 * j; const LAS float* s = scr + (8 * c) * 65 + n;
            v4u o; o.x = cvtpk_(s[0 * 65], s[1 * 65]); o.y = cvtpk_(s[2 * 65], s[3 * 65]); o.z = cvtpk_(s[4 * 65], s[5 * 65]); o.w = cvtpk_(s[6 * 65], s[7 * 65]);
            __builtin_nontemporal_store(o, (v4u*)(dst + (size_t)rowmap<MAP>(n0 + n) * K + k0 + 8 * c)); }
        asm volatile("s_waitcnt lgkmcnt(0)" ::: "memory");
        it = nit;
    }
#undef TR_SRC
}
struct Row8 { f32x4 a[2][2]; };
__device__ __forceinline__ void row8_load(Row8& r, const float* p, int lane) {
#pragma unroll
    for (int j = 0; j < 2; ++j) { const f32x4* q = (const f32x4*)p + 2 * (lane + 64 * j); r.a[j][0] = q[0]; r.a[j][1] = q[1]; }
}
__device__ __forceinline__ float row8_sumsq(const Row8& r) {
    float s = 0.f;
#pragma unroll
    for (int j = 0; j < 2; ++j)
#pragma unroll
        for (int h = 0; h < 2; ++h) s += (r.a[j][h].x * r.a[j][h].x + r.a[j][h].y * r.a[j][h].y) + (r.a[j][h].z * r.a[j][h].z + r.a[j][h].w * r.a[j][h].w);
    return s;
}
__device__ __forceinline__ void rms_row_to_bf16(const float* __restrict__ xrow, const float* __restrict__ g, bf16* __restrict__ orow, int lane) {
    const f32x4* xr = (const f32x4*)xrow + lane; f32x4 v[4]; float s = 0.f;
#pragma unroll
    for (int j = 0; j < 4; ++j) { v[j] = xr[64 * j]; s += (v[j].x * v[j].x + v[j].y * v[j].y) + (v[j].z * v[j].z + v[j].w * v[j].w); }
    const float r = rsqrtf(wave_sum(s) * (1.f / D) + 1e-6f);
    v2u* o8 = (v2u*)orow + lane;
#pragma unroll
    for (int j = 0; j < 4; ++j) { const f32x4 gg = ((const f32x4*)g)[lane + 64 * j]; v2u w; w.x = pk2(v[j].x * r * gg.x, v[j].y * r * gg.y); w.y = pk2(v[j].z * r * gg.z, v[j].w * r * gg.w); o8[64 * j] = w; }
}
__device__ __forceinline__ void p0_filters(const Ctx& X, const Args& a) {
    LAS float* z = (LAS float*)X.lds;
    LAS float* h1 = z + 32 * 36;
    LAS float* h2T = h1 + 32 * 64;
    LAS float* w1s = h2T + 64 * 32;
    LAS float* w2s = w1s + 33 * 64;
    bf16* FILT = (bf16*)(X.ws + WS_FILT);
    const float min_decay = logf(1e-2f) / 0.3f, max_decay = logf(1e-2f) / 1.5f;
    for (int it = X.bid; it < 2 * (S / 32); it += X.G) {
        int tid = X.tid; asm volatile("" : "+v"(tid));
        const int j = tid & 63, tq = tid >> 6;
        const int l = it / (S / 32), t0 = (it % (S / 32)) * 32;
        const float *w1 = a.in[6] + l * 33 * 64, *b1 = a.in[7] + l * 64, *f1 = a.in[8] + l * 64, *w2 = a.in[9] + l * 64 * 64, *b2 = a.in[10] + l * 64, *f2 = a.in[11] + l * 64, *w3 = a.in[12] + (size_t)l * 64 * 2048;
        __syncthreads();
        for (int e = tid; e < 33 * 64; e += NTH) w1s[e] = w1[e];
        for (int e = tid; e < 64 * 64; e += NTH) w2s[e] = w2[e];
        for (int e = tid; e < 32 * 33; e += NTH) { const int tt = e / 33, jj0 = e - tt * 33, t = t0 + tt; float v;
            if (jj0 == 0) v = (float)t / (float)(S - 1);
            else { const int jj = (jj0 - 1) & 15; const float w = 2.0f * 3.14159265358979323846f * (float)t / (float)S; const float fr = 1e-4f + (float)jj * ((15.0f - 1e-4f) / 15.0f); const float ang = w * fr; v = (jj0 <= 16) ? cosf(ang) : -sinf(ang); }
            z[tt * 36 + jj0] = v; }
        const float bb1 = b1[j], ff1 = f1[j], bb2 = b2[j], ff2 = f2[j];
        __syncthreads();
        { float acc[4] = {bb1, bb1, bb1, bb1};
          for (int i = 0; i < 33; ++i) { const float w = w1s[i * 64 + j];
#pragma unroll
              for (int k = 0; k < 4; ++k) acc[k] += z[(tq + 8 * k) * 36 + i] * w; }
#pragma unroll
          for (int k = 0; k < 4; ++k) h1[(tq + 8 * k) * 64 + j] = sinf(ff1 * acc[k]); }
        __syncthreads();
        { float acc[4] = {bb2, bb2, bb2, bb2};
          for (int i = 0; i < 64; ++i) { const float w = w2s[i * 64 + j];
#pragma unroll
              for (int k = 0; k < 4; ++k) acc[k] += h1[(tq + 8 * k) * 64 + i] * w; }
#pragma unroll
          for (int k = 0; k < 4; ++k) h2T[j * 32 + tq + 8 * k] = sinf(ff2 * acc[k]); }
        __syncthreads();
        { const int n0 = 4 * tid; f32x4 acc[32];
#pragma unroll
            for (int q = 0; q < 32; ++q) acc[q] = (f32x4){0.f, 0.f, 0.f, 0.f};
#pragma unroll 1
            for (int i0 = 0; i0 < 64; i0 += 16) { f32x4 w[16];
#pragma unroll
                for (int u = 0; u < 16; ++u) w[u] = *(const f32x4*)(w3 + (i0 + u) * 2048 + n0);
#pragma unroll
                for (int u = 0; u < 16; ++u) {
#pragma unroll
                    for (int g = 0; g < 8; ++g) { const f32x4 hh = *(const LAS f32x4*)(h2T + (i0 + u) * 32 + 4 * g); acc[4 * g] += w[u] * hh.x; acc[4 * g + 1] += w[u] * hh.y; acc[4 * g + 2] += w[u] * hh.z; acc[4 * g + 3] += w[u] * hh.w; } } }
            const int c0 = n0 & 511, od = n0 >> 9;
#pragma unroll
            for (int e = 0; e < 4; ++e) { const float delta = fabsf(min_decay + (float)(c0 + e) * ((max_decay - min_decay) / 511.0f));
#pragma unroll
                for (int g = 0; g < 4; ++g) { float o8[8];
#pragma unroll
                    for (int q = 0; q < 8; ++q) o8[q] = acc[8 * g + q][e] * expf(-((float)(t0 + 8 * g + q) / (float)(S - 1)) * delta);
                    v4u o; o.x = pk2(o8[0], o8[1]); o.y = pk2(o8[2], o8[3]); o.z = pk2(o8[4], o8[5]); o.w = pk2(o8[6], o8[7]);
                    *(v4u*)(FILT + (((size_t)l * 4 + od) * C + c0 + e) * S + t0 + 8 * g) = o; } } }
    }
    __syncthreads();
}
template <int MAP> __device__ __forceinline__ void p0_convert(const Ctx& X, const float* W, int K, int N, bf16* WB, int dN, int nmat, size_t sstride, size_t dstride, const float* __restrict__ rscale = nullptr) {
    const int nblk = N / 256, per = (K / 16) * nblk, tot = per * nmat, lane = X.lane;
    f32x4 v[16];
    int it = X.gw;
#define CV_SRC(it_) (W + (size_t)((it_) / per) * sstride + (size_t)(16 * (((it_) % per) / nblk)) * N + 256 * (((it_) % per) % nblk) + 4 * lane)
    if (it < tot) { const float* s = CV_SRC(it);
#pragma unroll
        for (int i = 0; i < 16; ++i) v[i] = __builtin_nontemporal_load((const f32x4*)(s + (size_t)i * N)); }
    while (it < tot) {
        v2u o[16];
        if (rscale) { const int k0s = 16 * ((it % per) / nblk);
#pragma unroll
            for (int i = 0; i < 16; ++i) { const float sc = rscale[k0s + i]; o[i].x = cvtpk_(v[i][0] * sc, v[i][1] * sc); o[i].y = cvtpk_(v[i][2] * sc, v[i][3] * sc); } }
        else {
#pragma unroll
        for (int i = 0; i < 16; ++i) { o[i].x = cvtpk_(v[i][0], v[i][1]); o[i].y = cvtpk_(v[i][2], v[i][3]); } }
        const int nit = it + X.ngw;
        if (nit < tot) { const float* s = CV_SRC(nit);
#pragma unroll
            for (int i = 0; i < 16; ++i) v[i] = __builtin_nontemporal_load((const f32x4*)(s + (size_t)i * N)); }
        const int mi = it / per, r = it - mi * per, k0 = 16 * (r / nblk), n = 256 * (r % nblk) + 4 * lane;
        const int dc = MAP == 0 ? n : (((n >> 7) << 8) + (n & 127) + (MAP == 3 ? 128 : 0));
        bf16* dst = WB + (size_t)mi * dstride + (size_t)k0 * dN + dc;
#pragma unroll
        for (int i = 0; i < 16; ++i) __builtin_nontemporal_store(o[i], (v2u*)(dst + (size_t)i * dN));
        it = nit;
    }
#undef CV_SRC
}
__device__ __forceinline__ void p0_experts(const Ctx& X, const Args& a, int l) {
    bf16* wgu = (bf16*)(X.ws + WS_WGU) + (size_t)l * E * 2 * F * D; bf16* wd = (bf16*)(X.ws + WS_WD) + (size_t)l * E * F * D;
    p0_convert<2>(X, a.in[25] + (size_t)l * E * D * F, D, F, wgu, 2 * F, E, (size_t)D * F, (size_t)2 * F * D, a.in[22] + l * D);
    p0_convert<3>(X, a.in[26] + (size_t)l * E * D * F, D, F, wgu, 2 * F, E, (size_t)D * F, (size_t)2 * F * D, a.in[22] + l * D);
    p0_convert<0>(X, a.in[27] + (size_t)l * E * D * F, F, D, wd, D, E, (size_t)F * D, (size_t)F * D);
}
#ifndef MK_P0_DUP
#define MK_P0_DUP 0
#endif
__device__ __forceinline__ void p0_prologue(const Ctx& X, const Args& a) {
    const int m = a.p0_mask;
    for (int dup_ = 0; dup_ < ((MK_P0_DUP & 1) ? 2 : 1); ++dup_)
    if (m & 1) {
        p0_transpose<1>(X, a.in[2], D, INW, (bf16*)(X.ws + WS_WIN), 2, (size_t)D * INW, (size_t)D * INW);
        p0_transpose<0>(X, a.in[19], C, D, (bf16*)(X.ws + WS_WUH), 2, (size_t)C * D, (size_t)2 * C * D);
        p0_transpose<0>(X, a.in[20], C, D, (bf16*)(X.ws + WS_WUA), 2, (size_t)C * D, (size_t)2 * C * D);
        p0_transpose<0>(X, a.in[21], D, D, (bf16*)(X.ws + WS_WOUT), 2, (size_t)D * D, (size_t)D * D);
        float* binp = (float*)(X.ws + WS_BINP);
        for (int i = X.gw * 64 + X.lane; i < 2 * INW; i += X.ngw * 64) { const int l = i / INW, n = i - l * INW; binp[l * INW + rowmap<1>(n)] = a.in[3][i]; }
        { bf16* wrp = (bf16*)(X.ws + WS_WRP);
          for (int i = X.gw * 64 + X.lane; i < 2 * E * D; i += X.ngw * 64) { const int l = i / (E * D), e = (i / D) % E, k = i % D; const float v = a.in[22][l * D + k] * a.in[23][((size_t)l * D + k) * E + e];
              const unsigned hi = f2bf(v); const float lo = v - __builtin_bit_cast(float, hi << 16); wrp[((l * 2 + 0) * E + e) * D + k] = (bf16)hi; wrp[((l * 2 + 1) * E + e) * D + k] = (bf16)f2bf(lo); } }
        float* rope = (float*)(X.ws + WS_ROPE);
        for (int i = X.gw * 64 + X.lane; i < S * 32; i += X.ngw * 64) { const int pos = i >> 5, j = i & 31; const float inv = powf(10000.0f, -(float)j * 2.0f / 64.0f); float sn, cs; sincosf((float)pos * inv, &sn, &cs); rope[2 * i] = cs; rope[2 * i + 1] = sn; }
    }
    if (m & 2) { p0_experts(X, a, 0); p0_experts(X, a, 1); }
    for (int dup_ = 0; dup_ < ((MK_P0_DUP & 4) ? 2 : 1); ++dup_)
    if (m & 4) p0_filters(X, a);
    for (int dup_ = 0; dup_ < ((MK_P0_DUP & 8) ? 2 : 1); ++dup_)
    if (m & 8) {
        bf16* XN = (bf16*)(X.ws + WS_XN); const int lane = X.lane; Row8 gg; row8_load(gg, a.in[1], lane);
        int r = X.gw; Row8 cur; if (r < T) row8_load(cur, a.in[0] + (size_t)r * D, lane);
        while (r < T) { const int nr = r + X.ngw; Row8 nxt; if (nr < T) row8_load(nxt, a.in[0] + (size_t)nr * D, lane);
            const float rs = rsqrtf(wave_sum(row8_sumsq(cur)) * (1.f / D) + 1e-6f);
#pragma unroll
            for (int j = 0; j < 2; ++j) { const f32x4 y0 = cur.a[j][0] * gg.a[j][0] * rs, y1 = cur.a[j][1] * gg.a[j][1] * rs;
                v4u w; w.x = pk2(y0.x, y0.y); w.y = pk2(y0.z, y0.w); w.z = pk2(y1.x, y1.y); w.w = pk2(y1.z, y1.w); ((v4u*)(XN + (size_t)r * D))[lane + 64 * j] = w; }
            cur = nxt; r = nr; }
    }
}
}
namespace mk {
using pg8::Unit;
#ifndef MK_SIMPLE_ORDER
#define MK_SIMPLE_ORDER 0
#endif
__device__ __forceinline__ unsigned cvtpk(float lo, float hi) { unsigned r; asm volatile("v_cvt_pk_bf16_f32 %0, %1, %2" : "=v"(r) : "v"(lo), "v"(hi)); return r; }
__device__ __forceinline__ v4u pack8(f32x4 a, f32x4 b) { v4u w; w.x = cvtpk(a[0], a[1]); w.y = cvtpk(a[2], a[3]); w.z = cvtpk(b[0], b[1]); w.w = cvtpk(b[2], b[3]); return w; }
__device__ __forceinline__ void unpack8(v4u w, f32x4& a, f32x4& b) { a = (f32x4){bflo(w.x), bfhi(w.x), bflo(w.y), bfhi(w.y)}; b = (f32x4){bflo(w.z), bfhi(w.z), bflo(w.w), bfhi(w.w)}; }
__device__ __forceinline__ float fsig(float x) { return __builtin_amdgcn_rcpf(1.f + __expf(-x)); }

struct EpiWin {
    static constexpr bool PERM = true, AFTER_DRAIN = false;
    unsigned char* ws; const float* bias; const float* rope;
    __device__ __forceinline__ void operator()(const f32x4 (&acc)[2][2][4][2], const Unit& u, int wr, int wc, int fr, int fq) const {
        const int colt = u.pn * 256, row0 = u.pm * 256 + wr * 64 + fr, cin = wc * 32 + 8 * fq;
        bf16* base; int ldc, col0, mode; float sc = 1.f;
        if (colt < 1536) { base = (bf16*)(ws + WS_U); ldc = 1536; col0 = colt; mode = 0; }
        else if (colt < 2048) { base = (bf16*)(ws + WS_Q); ldc = 512; col0 = colt - 1536; mode = 1; sc = QSCALE; }
        else if (colt < 2560) { base = (bf16*)(ws + WS_K); ldc = 512; col0 = colt - 2048; mode = 1; }
        else if (colt < 3072) { base = (bf16*)(ws + WS_V); ldc = 512; col0 = colt - 2560; mode = 0; }
        else if (colt < 4096) { base = (bf16*)(ws + WS_GH); ldc = 1024; col0 = colt - 3072; mode = 2; }
        else { base = (bf16*)(ws + WS_GA); ldc = 1024; col0 = colt - 4096; mode = 2; }
        f32x4 bv[2][2];
#pragma unroll
        for (int bj = 0; bj < 2; ++bj)
#pragma unroll
            for (int n = 0; n < 2; ++n) bv[bj][n] = *(const f32x4*)(bias + colt + bj * 128 + cin + 4 * n);
#pragma unroll
        for (int ai = 0; ai < 2; ++ai)
#pragma unroll
            for (int m = 0; m < 4; ++m) {
                const int row = row0 + ai * 128 + m * 16; bf16* rowp = base + (size_t)row * ldc + col0 + cin;
#pragma unroll
                for (int bj = 0; bj < 2; ++bj) {
                    f32x4 v0 = acc[ai][bj][m][0] + bv[bj][0], v1 = acc[ai][bj][m][1] + bv[bj][1];
                    if (mode == 1) {
                        const int i = ((bj * 128 + cin) & 63) >> 3; const float* rp = rope + ((size_t)(row & (S - 1)) * 32 + 4 * i) * 2;
                        const f32x4 r0 = *(const f32x4*)rp, r1 = *(const f32x4*)(rp + 4);
                        const f32x4 cs = {r0[0], r0[2], r1[0], r1[2]}, sn = {r0[1], r0[3], r1[1], r1[3]};
                        const f32x4 o1 = (v0 * cs - v1 * sn) * sc, o2 = (v1 * cs + v0 * sn) * sc; v0 = o1; v1 = o2;
                    } else if (mode == 2) {
#pragma unroll
                        for (int e = 0; e < 4; ++e) { v0[e] = fsig(v0[e]); v1[e] = fsig(v1[e]); }
                    }
                    *(v4u*)(rowp + bj * 128) = pack8(v0, v1);
                }
            }
    }
};
struct EpiMerge2 {
    static constexpr bool PERM = true, AFTER_DRAIN = false;
    const bf16* GH; const bf16* GA; bf16* T1; bf16* MG;
    __device__ __forceinline__ void operator()(const f32x4 (&acc)[2][2][4][2], const Unit& u, int wr, int wc, int fr, int fq) const {
        const int row0 = u.pm * 256 + wr * 64 + fr, col0 = u.pn * 256 + wc * 32 + 8 * fq; const bool second = u.pa != u.pm; const bf16* G = second ? GA : GH;
#pragma unroll
        for (int ai = 0; ai < 2; ++ai)
#pragma unroll
            for (int m = 0; m < 4; ++m) { const size_t off = (size_t)(row0 + ai * 128 + m * 16) * D + col0;
#pragma unroll
                for (int bj = 0; bj < 2; ++bj) { f32x4 g0, g1; unpack8(*(const v4u*)(G + off + bj * 128), g0, g1);
                    f32x4 v0 = acc[ai][bj][m][0] * g0, v1 = acc[ai][bj][m][1] * g1;
                    if (second) { f32x4 t0, t1; unpack8(*(const v4u*)(T1 + off + bj * 128), t0, t1); v0 += t0; v1 += t1; *(v4u*)(MG + off + bj * 128) = pack8(v0, v1); }
                    else *(v4u*)(T1 + off + bj * 128) = pack8(v0, v1); } }
    }
};
struct OrderMerge {
    pg8::StaticOrder so;
    __device__ __forceinline__ bool next(int i, Unit& u) const { if (!so.next(i >> 1, u)) return false; if (i & 1) { u.pa = u.pm + T / 256; u.pb = u.pn + 4; } return true; }
    __device__ __forceinline__ void a_ready(const Unit&) const {}
    __device__ __forceinline__ void done(const Unit&) const {}
};
struct EpiOut {
    static constexpr bool PERM = false, AFTER_DRAIN = false;
    const float* xin; float* X;
    __device__ __forceinline__ void operator()(const f32x4 (&acc)[2][2][4][2], const Unit& u, int wr, int wc, int fr, int fq) const {
        const int row0 = u.pm * 256 + wr * 64 + fr, col0 = u.pn * 256 + wc * 32 + 4 * fq;
#pragma unroll
        for (int ai = 0; ai < 2; ++ai)
#pragma unroll
            for (int m = 0; m < 4; ++m) { const size_t off = (size_t)(row0 + ai * 128 + m * 16) * D + col0;
#pragma unroll
                for (int bj = 0; bj < 2; ++bj)
#pragma unroll
                    for (int n = 0; n < 2; ++n) *(f32x4*)(X + off + bj * 128 + n * 16) = *(const f32x4*)(xin + off + bj * 128 + n * 16) + acc[ai][bj][m][n]; }
    }
};
struct EpiOutR {
    static constexpr bool PERM = true, AFTER_DRAIN = true;
    const float* xin; float* X; bf16* XB; float* PART; const bf16* WRP;
    __device__ __forceinline__ void operator()(const f32x4 (&)[2][2][4][2], const Unit&, int, int, int, int) const {}
    __device__ __forceinline__ void fused(const f32x4 (&acc)[2][2][4][2], const Unit& u, int wr, int wc, int fr, int fq, LAS unsigned char* lds, int wid, int lane) const {
        LAS float* SS = (LAS float*)lds;
        LAS float* LG = (LAS float*)(lds + 16384);
        const int rowl0 = wr * 64 + fr, colw = wc * 32 + 8 * fq;
        bf16x8 whi[2], wlo[2];
#pragma unroll
        for (int bj = 0; bj < 2; ++bj) { const bf16* wp = WRP + (size_t)fr * D + u.pn * 256 + bj * 128 + colw; whi[bj] = *(const bf16x8*)wp; wlo[bj] = *(const bf16x8*)(wp + (size_t)E * D); }
#pragma unroll
        for (int ai = 0; ai < 2; ++ai)
#pragma unroll
            for (int m = 0; m < 4; ++m) { const int rowl = rowl0 + ai * 128 + m * 16; float ss = 0.f; f32x4 lg = {0.f, 0.f, 0.f, 0.f};
#pragma unroll
                for (int bj = 0; bj < 2; ++bj) { const size_t off = (size_t)(u.pm * 256 + rowl) * D + u.pn * 256 + bj * 128 + colw;
                    const f32x4 x0 = *(const f32x4*)(xin + off) + acc[ai][bj][m][0], x1 = *(const f32x4*)(xin + off + 4) + acc[ai][bj][m][1];
                    *(f32x4*)(X + off) = x0; *(f32x4*)(X + off + 4) = x1;
                    const v4u hi = pack8(x0, x1); *(v4u*)(XB + off) = hi;
                    f32x4 h0, h1; unpack8(hi, h0, h1); const v4u lo = pack8(x0 - h0, x1 - h1);
                    ss += ((x0[0] * x0[0] + x0[1] * x0[1]) + (x0[2] * x0[2] + x0[3] * x0[3])) + ((x1[0] * x1[0] + x1[1] * x1[1]) + (x1[2] * x1[2] + x1[3] * x1[3]));
                    lg = __builtin_amdgcn_mfma_f32_16x16x32_bf16(whi[bj], __builtin_bit_cast(bf16x8, hi), lg, 0, 0, 0);
                    lg = __builtin_amdgcn_mfma_f32_16x16x32_bf16(whi[bj], __builtin_bit_cast(bf16x8, lo), lg, 0, 0, 0);
                    lg = __builtin_amdgcn_mfma_f32_16x16x32_bf16(wlo[bj], __builtin_bit_cast(bf16x8, hi), lg, 0, 0, 0); }
                SS[rowl * 16 + wc * 4 + fq] = ss;
                *(LAS f32x4*)(LG + ((wc * 256 + rowl) * 16 + 4 * fq)) = lg; }
        __syncthreads();
        const int t = wid * 64 + lane;
        if (t < 256) { float s = 0.f;
#pragma unroll
            for (int i = 0; i < 4; ++i) { const f32x4 v = *(const LAS f32x4*)(SS + t * 16 + 4 * i); s += (v[0] + v[1]) + (v[2] + v[3]); }
            float* pp = PART + ((size_t)u.pn * T + u.pm * 256 + t) * 20;
            *(f32x4*)pp = (f32x4){s, 0.f, 0.f, 0.f};
#pragma unroll
            for (int i = 0; i < 4; ++i) { f32x4 a4 = *(const LAS f32x4*)(LG + (t * 16 + 4 * i));
#pragma unroll
                for (int w = 1; w < 4; ++w) a4 += *(const LAS f32x4*)(LG + ((w * 256 + t) * 16 + 4 * i));
                *(f32x4*)(pp + 4 + 4 * i) = a4; } }
        __syncthreads();
    }
};
struct EpiSwiGLU {
    static constexpr bool PERM = true, AFTER_DRAIN = false;
    bf16* HB; const float* RSL;
    __device__ __forceinline__ void operator()(const f32x4 (&acc)[2][2][4][2], const Unit& u, int wr, int wc, int fr, int fq) const {
        const int row0 = u.pm * 256 + wr * 64 + fr, col0 = u.pn * 128 + wc * 32 + 8 * fq;
#pragma unroll
        for (int ai = 0; ai < 2; ++ai)
#pragma unroll
            for (int m = 0; m < 4; ++m) { f32x4 h[2]; const float rr = RSL[row0 + ai * 128 + m * 16];
#pragma unroll
                for (int n = 0; n < 2; ++n) { const f32x4 g = acc[ai][0][m][n] * rr, up = acc[ai][1][m][n] * rr;
#pragma unroll
                    for (int e = 0; e < 4; ++e) h[n][e] = g[e] * fsig(g[e]) * up[e]; }
                *(v4u*)(HB + (size_t)(row0 + ai * 128 + m * 16) * F + col0) = pack8(h[0], h[1]); }
    }
};
struct EpiDown {
    static constexpr bool PERM = true, AFTER_DRAIN = false;
    bf16* YE; const float* gate;
    __device__ __forceinline__ void operator()(const f32x4 (&acc)[2][2][4][2], const Unit& u, int wr, int wc, int fr, int fq) const {
        const int row0 = u.pm * 256 + wr * 64 + fr, col0 = u.pn * 256 + wc * 32 + 8 * fq;
#pragma unroll
        for (int ai = 0; ai < 2; ++ai)
#pragma unroll
            for (int m = 0; m < 4; ++m) { const int row = row0 + ai * 128 + m * 16; const float g = gate[row];
#pragma unroll
                for (int bj = 0; bj < 2; ++bj) *(v4u*)(YE + (size_t)row * D + col0 + bj * 128) = pack8(acc[ai][bj][m][0] * g, acc[ai][bj][m][1] * g); }
    }
};
struct OrderMoE1 {
    int G, c;
    __device__ __forceinline__ bool next(int i, Unit& u) const {
        if (MK_SIMPLE_ORDER || G != 256) { const int L = i * G + c; if (L >= 2048) return false; const int e = L >> 7, r = L & 127; u.pm = e * 8 + (r & 7); u.pn = r >> 3; u.pb = e * 16 + u.pn; u.pa = u.pm; return true; }
        if (i >= 8) return false;
        const int ch = i * 8 + (c & 7), j = c >> 3, e = ch >> 2, ng = ch & 3; u.pm = e * 8 + (j & 7); u.pn = ng * 4 + (j >> 3); u.pb = e * 16 + u.pn; u.pa = u.pm; return true;
    }
    __device__ __forceinline__ void a_ready(const Unit&) const {}
    __device__ __forceinline__ void done(const Unit&) const {}
};
struct OrderMoE2 {
    int G, c;
    __device__ __forceinline__ bool next(int i, Unit& u) const {
        if (MK_SIMPLE_ORDER || G != 256) { const int L = i * G + c; if (L >= 512) return false; const int e = L >> 5, r = L & 31; u.pm = e * 8 + (r & 7); u.pn = r >> 3; u.pb = e * 4 + u.pn; u.pa = u.pm; return true; }
        if (i >= 2) return false;
        const int e = i * 8 + (c & 7), j = c >> 3; u.pm = e * 8 + (j & 7); u.pn = j >> 3; u.pb = e * 4 + u.pn; u.pa = u.pm; return true;
    }
    __device__ __forceinline__ void a_ready(const Unit&) const {}
    __device__ __forceinline__ void done(const Unit&) const {}
};

__device__ __forceinline__ void p6_topk(const Ctx& X, const float* __restrict__ br) {
    const float* PART = (const float*)(X.ws + WS_PART); int* rows = (int*)(X.ws + WS_ROWS); float* gate = (float*)(X.ws + WS_GATE); float* rsl = (float*)(X.ws + WS_RSL); int* inv = (int*)(X.ws + WS_INV);
    for (int p = X.bid; p < B * E; p += X.G) { const int b = p >> 4, e = p & 15, slotbase = e * 2048 + b * 512;
        LAS unsigned* ldk = (LAS unsigned*)(X.lds + 4096); LAS float* ldr = (LAS float*)(X.lds + 4096 + 16384);
        __syncthreads();
#pragma unroll 2
        for (int c = 0; c < 8; ++c) { const int ti = c * NTH + X.tid, tok = b * S + ti; f32x4 s4 = {0.f, 0.f, 0.f, 0.f}, l4[4];
#pragma unroll
            for (int j = 0; j < 4; ++j) l4[j] = (f32x4){0.f, 0.f, 0.f, 0.f};
#pragma unroll
            for (int pn = 0; pn < 4; ++pn) { const f32x4* pp = (const f32x4*)(PART + ((size_t)pn * T + tok) * 20); s4 += pp[0];
#pragma unroll
                for (int j = 0; j < 4; ++j) l4[j] += pp[1 + j]; }
            const float r = rsqrtf(s4[0] * (1.f / D) + 1e-6f); float mx = -1e30f, mine = 0.f;
#pragma unroll
            for (int j = 0; j < 4; ++j)
#pragma unroll
                for (int q = 0; q < 4; ++q) { const float v = l4[j][q] * r + br[4 * j + q]; l4[j][q] = v; mx = fmaxf(mx, v); if (4 * j + q == e) mine = v; }
            float l = 0.f;
#pragma unroll
            for (int j = 0; j < 4; ++j)
#pragma unroll
                for (int q = 0; q < 4; ++q) l += expf(l4[j][q] - mx);
            ldk[ti] = __float_as_uint(expf(mine - mx) / l); ldr[ti] = r; }
        __syncthreads();
        unsigned key[8]; float rr[8];
        { const v4u k0 = *(const LAS v4u*)(ldk + X.tid * 8), k1 = *(const LAS v4u*)(ldk + X.tid * 8 + 4); const f32x4 r0 = *(const LAS f32x4*)(ldr + X.tid * 8), r1 = *(const LAS f32x4*)(ldr + X.tid * 8 + 4);
          key[0] = k0.x; key[1] = k0.y; key[2] = k0.z; key[3] = k0.w; key[4] = k1.x; key[5] = k1.y; key[6] = k1.z; key[7] = k1.w;
          rr[0] = r0[0]; rr[1] = r0[1]; rr[2] = r0[2]; rr[3] = r0[3]; rr[4] = r1[0]; rr[5] = r1[1]; rr[6] = r1[2]; rr[7] = r1[3]; }
        tk::topk_problem(key, rr, b * S, e, slotbase, rows + slotbase, gate + slotbase, rsl + slotbase, inv, (int*)(X.lds), X.tid); }
}
__device__ __forceinline__ void p9_combine(const Ctx& X, float* Xr, const float* __restrict__ g, bool final_, float* __restrict__ out) {
    const int* inv = (const int*)(X.ws + WS_INV); const bf16* YE = (const bf16*)(X.ws + WS_YE); bf16* XN = (bf16*)(X.ws + WS_XN); const int lane = X.lane;
    Row8 gg; row8_load(gg, g, lane);
    int tok = X.gw; Row8 cur; int myinv = -1;
    if (tok < T) { row8_load(cur, Xr + (size_t)tok * D, lane); if (lane < 16) myinv = inv[(size_t)tok * E + lane]; }
    while (tok < T) {
        const int ntok = tok + X.ngw; Row8 nxt; int ninv = -1;
        if (ntok < T) { row8_load(nxt, Xr + (size_t)ntok * D, lane); if (lane < 16) ninv = inv[(size_t)ntok * E + lane]; }
        unsigned long long m = __ballot(myinv >= 0);
        while (m) {
            int sl[4];
#pragma unroll
            for (int i = 0; i < 4; ++i) { if (m) { const int e = __builtin_ctzll(m); m &= m - 1; sl[i] = __builtin_amdgcn_readlane(myinv, e); } else sl[i] = -1; }
            v4u y[4][2];
#pragma unroll
            for (int i = 0; i < 4; ++i) if (sl[i] >= 0) { const v4u* yp = (const v4u*)(YE + (size_t)sl[i] * D); y[i][0] = __builtin_nontemporal_load(yp + lane); y[i][1] = __builtin_nontemporal_load(yp + lane + 64); }
#pragma unroll
            for (int i = 0; i < 4; ++i) if (sl[i] >= 0) {
#pragma unroll
                for (int j = 0; j < 2; ++j) { f32x4 p, q; unpack8(y[i][j], p, q); cur.a[j][0] += p; cur.a[j][1] += q; } }
        }
        const float r = rsqrtf(wave_sum(row8_sumsq(cur)) * (1.f / D) + 1e-6f);
        if (final_) {
#pragma unroll
            for (int j = 0; j < 2; ++j)
#pragma unroll
                for (int h = 0; h < 2; ++h) ((f32x4*)(out + (size_t)tok * D))[2 * (lane + 64 * j) + h] = cur.a[j][h] * gg.a[j][h] * r;
        } else {
#pragma unroll
            for (int j = 0; j < 2; ++j) {
#pragma unroll
                for (int h = 0; h < 2; ++h) ((f32x4*)(Xr + (size_t)tok * D))[2 * (lane + 64 * j) + h] = cur.a[j][h];
                const f32x4 y0 = cur.a[j][0] * gg.a[j][0] * r, y1 = cur.a[j][1] * gg.a[j][1] * r;
                v4u w; w.x = pk2(y0.x, y0.y); w.y = pk2(y0.z, y0.w); w.z = pk2(y1.x, y1.y); w.w = pk2(y1.z, y1.w);
                ((v4u*)(XN + (size_t)tok * D))[lane + 64 * j] = w; }
        }
        cur = nxt; myinv = ninv; tok = ntok;
    }
}
}
namespace mk {
__device__ __forceinline__ void p1t_shortconv(const Ctx& X, const float* __restrict__ cw, const float* __restrict__ cb) {
    const bf16* U = (const bf16*)(X.ws + WS_U); bf16* UCT = (bf16*)(X.ws + WS_UCT);
    LAS float* raw = (LAS float*)(X.lds + X.wave * 17408);
    const int lane = X.lane, rq = lane >> 3, cq = lane & 7;
    constexpr int NIT = (T / 64) * 24;
    v4u w[9];
#define P1T_LOAD(it_) do { const int tt_ = (it_) / 24, cg_ = (it_) - tt_ * 24, tok0_ = tt_ * 64, tin_ = tok0_ & (S - 1); \
        _Pragma("unroll") for (int i = 0; i < 9; ++i) { const int r = 8 * i + rq, tpos = tin_ + r - 1; w[i] = (v4u){0u, 0u, 0u, 0u}; \
            if (r < 66 && tpos >= 0 && tpos < S) w[i] = *(const v4u*)(U + (size_t)(tok0_ + r - 1) * 1536 + cg_ * 64 + 8 * cq); } } while (0)
    int it = X.gw;
    if (it < NIT) P1T_LOAD(it);
    while (it < NIT) {
        const int tt = it / 24, cg = it - tt * 24, tok0 = tt * 64, ch0 = cg * 64;
#pragma unroll
        for (int i = 0; i < 9; ++i) { const int r = 8 * i + rq; if (r < 66) { LAS float* d = raw + r * 65 + 8 * cq; f32x4 p, q; unpack8(w[i], p, q);
            d[0] = p.x; d[1] = p.y; d[2] = p.z; d[3] = p.w; d[4] = q.x; d[5] = q.y; d[6] = q.z; d[7] = q.w; } }
        const int nit = it + X.ngw;
        if (nit < NIT) P1T_LOAD(nit);
        asm volatile("s_waitcnt lgkmcnt(0)" ::: "memory");
        const int chs = lane >> 3, tch = lane & 7;
#pragma unroll
        for (int g = 0; g < 8; ++g) { const int ch = 8 * g + chs, gc = ch0 + ch; const float w0 = cw[gc], w1 = cw[1536 + gc], w2 = cw[3072 + gc], bb = cb[gc];
            float v[10];
#pragma unroll
            for (int k = 0; k < 10; ++k) v[k] = raw[(8 * tch + k) * 65 + ch];
            float o[8];
#pragma unroll
            for (int k = 0; k < 8; ++k) o[k] = v[k] * w0 + v[k + 1] * w1 + v[k + 2] * w2 + bb;
            v4u pk; pk.x = pk2(o[0], o[1]); pk.y = pk2(o[2], o[3]); pk.z = pk2(o[4], o[5]); pk.w = pk2(o[6], o[7]);
            *(v4u*)(UCT + (size_t)gc * T + tok0 + 8 * tch) = pk; }
        asm volatile("s_waitcnt lgkmcnt(0)" ::: "memory");
        it = nit;
    }
#undef P1T_LOAD
}

__device__ __forceinline__ void p1t_kmax(const Ctx& X, unsigned* kmax2) {
    const bf16* K = (const bf16*)(X.ws + WS_K); const int lane = X.lane; LAS float* red = (LAS float*)(X.lds + 8 * 17408);
    const int b = X.gw / 512, t0 = X.gw % 512; float mx = 0.f;
    if (b < B) {
        v4u w[8];
#pragma unroll
        for (int i = 0; i < 8; ++i) w[i] = ((const v4u*)(K + ((size_t)b * S + t0 + 512 * i) * 512))[lane];
#pragma unroll
        for (int i = 0; i < 8; ++i) { f32x4 p, q; unpack8(w[i], p, q); float ss = (p.x * p.x + p.y * p.y) + (p.z * p.z + p.w * p.w) + (q.x * q.x + q.y * q.y) + (q.z * q.z + q.w * q.w);
            ss += xor_f<1>(ss); ss += xor_f<2>(ss); ss += xor_f<4>(ss); mx = fmaxf(mx, ss); }
    }
    __syncthreads();
    if ((lane & 7) == 0) red[X.wave * 8 + (lane >> 3)] = mx;
    __syncthreads();
    if (X.tid < 8 && b < B) { float m = red[X.tid]; for (int w_ = 1; w_ < 8; ++w_) m = fmaxf(m, red[w_ * 8 + X.tid]); atomicMax(kmax2 + b * 8 + X.tid, __float_as_uint(m)); }
}

namespace at {
constexpr int KVBLK = 64, LDK = 512;
constexpr int KPITCH = 272;
constexpr int SHM_V = 64 * 128 * 2, SHM_K = 64 * KPITCH;
constexpr int OFF_V = 0, OFF_K = 2 * SHM_V, OFF_Q = OFF_K + 2 * SHM_K, OFF_WS = OFF_Q + 256 * KPITCH, LDS_TOTAL = OFF_WS + 8 * 160 * 4;
constexpr float THR2 = 8.0f * 1.4426950408889634f;
#define KSWZ(row, colB) ((row) * KPITCH + (colB))
#define SBAR() __builtin_amdgcn_sched_barrier(0)
__device__ __forceinline__ int crow(int r, int hi) { return (r & 3) + 8 * (r >> 2) + 4 * hi; }
__device__ __forceinline__ int v_st(int k, int c) { const int kk = (k & ~0xC) | ((k & 4) << 1) | ((k & 8) >> 1); return ((kk >> 3) * 4 + (c >> 5)) * 512 + ((kk & 7) * 32 + (c & 31)) * 2; }
__device__ __forceinline__ int v_rd_base(int lane) { return ((lane & 3) << 3) | (((lane >> 2) & 3) << 6) | (((lane >> 4) & 1) << 5) | (((lane >> 5) & 1) << 8); }
constexpr int v_rd_off(int d0, int ks, int half) { return d0 * 512 + ks * 4096 + half * 2048; }
template <int OFF> __device__ __forceinline__ s16x4 tr_read(int vb) { s16x4 r; asm volatile("ds_read_b64_tr_b16 %0, %1 offset:%2" : "=&v"(r) : "v"(vb), "i"(OFF) : "memory"); return r; }

template <int CO> __device__ __forceinline__ void qkt(f32x16& p0, f32x16& p1, const char* Ks, const char* Qs, int qrow, int r32, int hi) {
    p0 = f32x16{}; p1 = f32x16{};
    const char* qp = Qs + KSWZ(qrow, (CO * 64 + hi * 8) * 2); const char* kp = Ks + KSWZ(r32, (CO * 64 + hi * 8) * 2);
#pragma unroll
    for (int d0 = 0; d0 < 4; ++d0) {
        const bf16x8 qf = *reinterpret_cast<const bf16x8*>(qp + d0 * 32);
        const bf16x8 b0 = *reinterpret_cast<const bf16x8*>(kp + d0 * 32);
        const bf16x8 b1 = *reinterpret_cast<const bf16x8*>(kp + 32 * KPITCH + d0 * 32);
        p0 = __builtin_amdgcn_mfma_f32_32x32x16_bf16(b0, qf, p0, 0, 0, 0);
        p1 = __builtin_amdgcn_mfma_f32_32x32x16_bf16(b1, qf, p1, 0, 0, 0);
        if (d0 == 1) asm volatile("" ::: "memory"); }
}
__device__ __forceinline__ void softmax_tile(f32x16& p0, f32x16& p1, float& m_reg, float& l_reg, float& alpha, bf16x8& pa0, bf16x8& pa1, bf16x8& pa2, bf16x8& pa3) {
    float pmax = p0[0];
#pragma unroll
    for (int r = 1; r < 16; ++r) pmax = fmaxf(pmax, p0[r]);
#pragma unroll
    for (int r = 0; r < 16; ++r) pmax = fmaxf(pmax, p1[r]);
    { auto rr = __builtin_amdgcn_permlane32_swap(__float_as_uint(pmax), __float_as_uint(pmax), false, false); pmax = fmaxf(__uint_as_float(rr[0]), __uint_as_float(rr[1])); }
    float mn;
    if (__builtin_expect(__all(pmax - m_reg <= THR2), 1)) { mn = m_reg; alpha = 1.f; }
    else { mn = fmaxf(m_reg, pmax); alpha = __builtin_amdgcn_exp2f(m_reg - mn); m_reg = mn; }
#pragma unroll
    for (int r = 0; r < 16; ++r) { p0[r] = __builtin_amdgcn_exp2f(p0[r] - mn); p1[r] = __builtin_amdgcn_exp2f(p1[r] - mn); }
    float ps = 0.f;
#pragma unroll
    for (int r = 0; r < 16; ++r) ps += p0[r];
#pragma unroll
    for (int r = 0; r < 16; ++r) ps += p1[r];
    { auto rr = __builtin_amdgcn_permlane32_swap(__float_as_uint(ps), __float_as_uint(ps), false, false); ps = __uint_as_float(rr[0]) + __uint_as_float(rr[1]); }
    l_reg = l_reg * alpha + ps;
#define PK4(P, BASE, OUT) do { unsigned a0 = cvtpk(P[BASE + 0], P[BASE + 1]), a1 = cvtpk(P[BASE + 2], P[BASE + 3]);   \
    unsigned b0 = cvtpk(P[BASE + 4], P[BASE + 5]), b1 = cvtpk(P[BASE + 6], P[BASE + 7]);                              \
    auto r0 = __builtin_amdgcn_permlane32_swap(a0, b0, false, false); auto r1 = __builtin_amdgcn_permlane32_swap(a1, b1, false, false); \
    v4u w = {r0[0], r1[0], r0[1], r1[1]}; OUT = *reinterpret_cast<bf16x8*>(&w); } while (0)
    PK4(p0, 0, pa0); PK4(p0, 8, pa1); PK4(p1, 0, pa2); PK4(p1, 8, pa3);
#undef PK4
}
__device__ __forceinline__ void softmax_fixed(f32x16& p0, f32x16& p1, float m, float& l_half, bf16x8& pa0, bf16x8& pa1, bf16x8& pa2, bf16x8& pa3) {
#pragma unroll
    for (int r = 0; r < 16; ++r) { p0[r] = __builtin_amdgcn_exp2f(p0[r] - m); p1[r] = __builtin_amdgcn_exp2f(p1[r] - m); }
    float ps = 0.f;
#pragma unroll
    for (int r = 0; r < 16; ++r) ps += p0[r] + p1[r];
    l_half += ps;
#define PK4(P, BASE, OUT) do { unsigned a0 = cvtpk(P[BASE + 0], P[BASE + 1]), a1 = cvtpk(P[BASE + 2], P[BASE + 3]);   \
    unsigned b0 = cvtpk(P[BASE + 4], P[BASE + 5]), b1 = cvtpk(P[BASE + 6], P[BASE + 7]);                              \
    auto r0 = __builtin_amdgcn_permlane32_swap(a0, b0, false, false); auto r1 = __builtin_amdgcn_permlane32_swap(a1, b1, false, false); \
    v4u w = {r0[0], r1[0], r0[1], r1[1]}; OUT = *reinterpret_cast<bf16x8*>(&w); } while (0)
    PK4(p0, 0, pa0); PK4(p0, 8, pa1); PK4(p1, 0, pa2); PK4(p1, 8, pa3);
#undef PK4
}
template <int D0> __device__ __forceinline__ void pv_one(f32x16& oa, int vb, const bf16x8 (&pa)[4]) {
#define PK(L, H) (bf16x8){L[0], L[1], L[2], L[3], H[0], H[1], H[2], H[3]}
    {   const s16x4 l0 = tr_read<v_rd_off(D0, 0, 0)>(vb), h0 = tr_read<v_rd_off(D0, 0, 1)>(vb), l1 = tr_read<v_rd_off(D0, 1, 0)>(vb), h1 = tr_read<v_rd_off(D0, 1, 1)>(vb);
        asm volatile("s_waitcnt lgkmcnt(0)" ::: "memory"); SBAR();
        oa = __builtin_amdgcn_mfma_f32_32x32x16_bf16(pa[0], PK(l0, h0), oa, 0, 0, 0);
        oa = __builtin_amdgcn_mfma_f32_32x32x16_bf16(pa[1], PK(l1, h1), oa, 0, 0, 0); }
    {   const s16x4 l2 = tr_read<v_rd_off(D0, 2, 0)>(vb), h2 = tr_read<v_rd_off(D0, 2, 1)>(vb), l3 = tr_read<v_rd_off(D0, 3, 0)>(vb), h3 = tr_read<v_rd_off(D0, 3, 1)>(vb);
        asm volatile("s_waitcnt lgkmcnt(0)" ::: "memory"); SBAR();
        oa = __builtin_amdgcn_mfma_f32_32x32x16_bf16(pa[2], PK(l2, h2), oa, 0, 0, 0);
        oa = __builtin_amdgcn_mfma_f32_32x32x16_bf16(pa[3], PK(l3, h3), oa, 0, 0, 0); }
#undef PK
}
template <int D0> __device__ __forceinline__ void pv_two(f32x16& oa, f32x16& ob, int vb, const bf16x8 (&pa)[4], const bf16x8 (&pb)[4]) {
#define PK(L, H) (bf16x8){L[0], L[1], L[2], L[3], H[0], H[1], H[2], H[3]}
    {   const s16x4 l0 = tr_read<v_rd_off(D0, 0, 0)>(vb), h0 = tr_read<v_rd_off(D0, 0, 1)>(vb), l1 = tr_read<v_rd_off(D0, 1, 0)>(vb), h1 = tr_read<v_rd_off(D0, 1, 1)>(vb);
        asm volatile("s_waitcnt lgkmcnt(0)" ::: "memory"); SBAR();
        const bf16x8 v0 = PK(l0, h0), v1 = PK(l1, h1);
        oa = __builtin_amdgcn_mfma_f32_32x32x16_bf16(pa[0], v0, oa, 0, 0, 0); ob = __builtin_amdgcn_mfma_f32_32x32x16_bf16(pb[0], v0, ob, 0, 0, 0);
        oa = __builtin_amdgcn_mfma_f32_32x32x16_bf16(pa[1], v1, oa, 0, 0, 0); ob = __builtin_amdgcn_mfma_f32_32x32x16_bf16(pb[1], v1, ob, 0, 0, 0); }
    {   const s16x4 l2 = tr_read<v_rd_off(D0, 2, 0)>(vb), h2 = tr_read<v_rd_off(D0, 2, 1)>(vb), l3 = tr_read<v_rd_off(D0, 3, 0)>(vb), h3 = tr_read<v_rd_off(D0, 3, 1)>(vb);
        asm volatile("s_waitcnt lgkmcnt(0)" ::: "memory"); SBAR();
        const bf16x8 v2 = PK(l2, h2), v3 = PK(l3, h3);
        oa = __builtin_amdgcn_mfma_f32_32x32x16_bf16(pa[2], v2, oa, 0, 0, 0); ob = __builtin_amdgcn_mfma_f32_32x32x16_bf16(pb[2], v2, ob, 0, 0, 0);
        oa = __builtin_amdgcn_mfma_f32_32x32x16_bf16(pa[3], v3, oa, 0, 0, 0); ob = __builtin_amdgcn_mfma_f32_32x32x16_bf16(pb[3], v3, ob, 0, 0, 0); }
#undef PK
}
__device__ __forceinline__ void rescale(f32x16 (&o)[4], float al, float* wsf, int r32, int hi) {
    if (__any(al < 1.f)) {
        if (hi == 0) wsf[r32] = al; asm volatile("s_waitcnt lgkmcnt(0)" ::: "memory");
#pragma unroll
        for (int r = 0; r < 16; ++r) { const float a = wsf[crow(r, hi)];
#pragma unroll
            for (int d = 0; d < 4; ++d) o[d][r] *= a; }
    }
}

__device__ __forceinline__ void epilogue(const Ctx& X, f32x16 (&oa)[4], f32x16 (&ob)[4], const float* wsf, int r32, int hi, int b, int h, int qb, float lam, float mul, const float* __restrict__ sg) {
    bf16* Yw = (bf16*)(X.ws + WS_YA) + ((size_t)b * S + qb * 256 + X.wave * 32) * 512 + h * 128;
    float gcol[4];
#pragma unroll
    for (int d = 0; d < 4; ++d) gcol[d] = sg[d * 32 + r32] * mul;
#pragma unroll
    for (int r = 0; r < 16; ++r) { const int orow = crow(r, hi); const float i0 = __builtin_amdgcn_rcpf(wsf[orow] + wsf[64 + orow]), i1 = lam * __builtin_amdgcn_rcpf(wsf[32 + orow] + wsf[96 + orow]);
        float v[4], ss = 0.f;
#pragma unroll
        for (int d = 0; d < 4; ++d) { v[d] = oa[d][r] * i0 - ob[d][r] * i1; ss += v[d] * v[d]; }
        ss += xor_f<1>(ss); ss += xor_f<2>(ss); ss += xor_f<4>(ss); ss += xor_f<8>(ss); ss += xor_f<16>(ss);
        const float rn = rsqrtf(ss * (1.f / 128.f) + 1e-5f);
#pragma unroll
        for (int d = 0; d < 4; ++d) Yw[(size_t)orow * 512 + d * 32 + r32] = (bf16)f2bf(v[d] * rn * gcol[d]); }
}
__device__ __forceinline__ int vkey(int T_, int lane) { const int kk = ((T_ >> 2) << 3) | ((lane & 31) >> 2); return (kk & ~0xC) | ((kk & 4) << 1) | ((kk & 8) >> 1); }
__device__ __forceinline__ int vcol(int T_, int lane) { return (T_ & 3) * 32 + (lane & 3) * 8; }
__device__ __forceinline__ void attn_unit(const Ctx& X, int b, int h, int qb, float lam, float mul, const float* __restrict__ sg, unsigned* kmax2) {
    char* lds = (char*)X.lds;
    const int tid = fresh_tid(X.wave_s);
    const int wid = X.wave, lane = tid & 63, r32 = lane & 31, hi = lane >> 5;
    const bf16* Qg = (const bf16*)(X.ws + WS_Q) + ((size_t)b * S + qb * 256) * LDK + h * 128;
    const bf16* Kh = (const bf16*)(X.ws + WS_K) + (size_t)b * S * LDK + h * 128;
    const bf16* Vh = (const bf16*)(X.ws + WS_V) + (size_t)b * S * LDK + h * 128;
    char* V_lds = lds + OFF_V; char* K_lds = lds + OFF_K; char* Q_lds = lds + OFF_Q;
    float* wsf = (float*)(lds + OFF_WS) + wid * 160;
    const int sr = tid >> 4, sc = (tid & 15) * 8, vst0 = v_st(sr, sc), vst1 = v_st(32 + sr, sc);
    const int vb0 = (int)(uintptr_t)V_lds + v_rd_base(lane);
#pragma unroll
    for (int i = 0; i < 8; ++i) { const int row = sr + 32 * i; *(bf16x8*)(Q_lds + KSWZ(row, sc * 2)) = *reinterpret_cast<const bf16x8*>(Qg + (size_t)row * LDK + sc); }
    bf16x8 st0, st1;
    const unsigned goff = (unsigned)(sr * LDK + sc) * 2u;
#define KLOAD(k0) do { const char* t_ = (const char*)Kh + (size_t)(k0) * (LDK * 2); st0 = *reinterpret_cast<const bf16x8*>(t_ + goff); st1 = *reinterpret_cast<const bf16x8*>(t_ + 32 * LDK * 2 + goff); } while (0)
#define VLOAD(k0) do { const char* t_ = (const char*)Vh + (size_t)(k0) * (LDK * 2); st0 = *reinterpret_cast<const bf16x8*>(t_ + goff); st1 = *reinterpret_cast<const bf16x8*>(t_ + 32 * LDK * 2 + goff); } while (0)
#define KWRITE(bb) do { *(bf16x8*)(K_lds + (bb) * SHM_K + KSWZ(sr, sc * 2)) = st0; *(bf16x8*)(K_lds + (bb) * SHM_K + KSWZ(32 + sr, sc * 2)) = st1; } while (0)
    const unsigned vsrc0 = (unsigned)(vkey(2 * wid + (lane >> 5), lane) * LDK + vcol(2 * wid + (lane >> 5), lane)) * 2u, vsrc1 = (unsigned)(vkey(2 * (wid + 8) + (lane >> 5), lane) * LDK + vcol(2 * (wid + 8) + (lane >> 5), lane)) * 2u;
#define VDMA(k0, bbn) do { const char* t_ = (const char*)Vh + (size_t)(k0) * (LDK * 2); LAS unsigned char* d_ = X.lds + OFF_V + (bbn) * SHM_V + wid * 1024; \
    __builtin_amdgcn_global_load_lds((const unsigned*)(t_ + vsrc0), (LAS unsigned*)d_, 16, 0, 0); __builtin_amdgcn_global_load_lds((const unsigned*)(t_ + vsrc1), (LAS unsigned*)(d_ + 8192), 16, 0, 0); } while (0)
    const unsigned ksrc = (unsigned)(wid * 8 * LDK * 2) + (unsigned)lane * 4u;
#define KDMA(k0, bbn) do { const char* t_ = (const char*)Kh + (size_t)(k0) * (LDK * 2) + ksrc; LAS unsigned char* d_ = X.lds + OFF_K + (bbn) * SHM_K + wid * 8 * KPITCH; \
    _Pragma("unroll") for (int i_ = 0; i_ < 8; ++i_) __builtin_amdgcn_global_load_lds((const unsigned*)(t_ + i_ * (LDK * 2)), (LAS unsigned*)(d_ + i_ * KPITCH), 4, 0, 0); } while (0)
#define VWRITE(bb) do { *(bf16x8*)(V_lds + (bb) * SHM_V + vst0) = st0; *(bf16x8*)(V_lds + (bb) * SHM_V + vst1) = st1; } while (0)
    float l0 = 0.f, l1 = 0.f; f32x16 oa[4] = {}, ob[4] = {};
    const int qrow = wid * 32 + r32; constexpr int NT = S / KVBLK;
    KDMA(0, 0); VDMA(0, 0); __syncthreads();
    float m0, m1;
    { float s0 = 0.f, s1 = 0.f;
#pragma unroll
      for (int d0 = 0; d0 < 8; ++d0) { const v4u w = *reinterpret_cast<const v4u*>(Q_lds + KSWZ(qrow, (d0 * 16 + hi * 8) * 2)); f32x4 p, q; unpack8(w, p, q);
          const float ss = (p.x * p.x + p.y * p.y) + (p.z * p.z + p.w * p.w) + (q.x * q.x + q.y * q.y) + (q.z * q.z + q.w * q.w); if (d0 < 4) s0 += ss; else s1 += ss; }
      wsf[hi * 64 + r32] = s0; wsf[hi * 64 + 32 + r32] = s1; asm volatile("s_waitcnt lgkmcnt(0)" ::: "memory");
      s0 += wsf[(hi ^ 1) * 64 + r32]; s1 += wsf[(hi ^ 1) * 64 + 32 + r32]; asm volatile("s_waitcnt lgkmcnt(0)" ::: "memory");
      const float k0 = __uint_as_float(__hip_atomic_load(kmax2 + b * 8 + h * 2, __ATOMIC_RELAXED, __HIP_MEMORY_SCOPE_AGENT)), k1 = __uint_as_float(__hip_atomic_load(kmax2 + b * 8 + h * 2 + 1, __ATOMIC_RELAXED, __HIP_MEMORY_SCOPE_AGENT));
      m0 = sqrtf(s0 * k0) * 1.001f + 1e-3f; m1 = sqrtf(s1 * k1) * 1.001f + 1e-3f; }
    for (int j = 0; j < NT; ++j) {
        const int bb = j & 1; const char* Ks = K_lds + bb * SHM_K;
        const int kn = (j + 1) * KVBLK;
        if (j + 1 < NT) { KDMA(kn, bb ^ 1); VDMA(kn, bb ^ 1); }
        const int vb = vb0 + bb * SHM_V;
        bf16x8 pa[4], pb[4];
        { f32x16 p0, p1, q0, q1;
          qkt<0>(p0, p1, Ks, Q_lds, qrow, r32, hi); qkt<1>(q0, q1, Ks, Q_lds, qrow, r32, hi);
          softmax_fixed(p0, p1, m0, l0, pa[0], pa[1], pa[2], pa[3]);
          softmax_fixed(q0, q1, m1, l1, pb[0], pb[1], pb[2], pb[3]); }
        SBAR();
        pv_two<0>(oa[0], ob[0], vb, pa, pb); pv_two<1>(oa[1], ob[1], vb, pa, pb); pv_two<2>(oa[2], ob[2], vb, pa, pb); pv_two<3>(oa[3], ob[3], vb, pa, pb);
        __syncthreads();
    }
#undef KLOAD
#undef VLOAD
#undef VDMA
#undef KDMA
#undef KWRITE
#undef VWRITE
    wsf[hi * 64 + r32] = l0; wsf[hi * 64 + 32 + r32] = l1; asm volatile("s_waitcnt lgkmcnt(0)" ::: "memory");
    { const int t2 = fresh_tid(X.wave_s); epilogue(X, oa, ob, wsf, t2 & 31, (t2 & 63) >> 5, b, h, qb, lam, mul, sg); }
    __syncthreads();
}
__device__ __forceinline__ void epilogue_unused() {}
#undef KSWZ
#undef SBAR
}
}
namespace mk {
namespace hy {
constexpr int CPS = 16704;
constexpr int NEL = 8352;
constexpr int OFF_Z = 4 * CPS;
constexpr int ZROW = 144, ZB = 128 * ZROW;
constexpr int LDS_TOTAL = OFF_Z + 4 * ZB;

__device__ __forceinline__ void build_hrev(const Ctx& X, const bf16* hf, const bf16* hb, float bias) {
    const int tid = X.tid;
    if (tid < 4 * 8) { const int m = tid >> 3, e = tid & 7; if (e < 5 - m) *(LAS bf16*)(X.lds + m * CPS + 2 * e) = 0; }
    for (int i = tid; i < 4 * (NEL - 8192); i += NTH) { const int m = i / (NEL - 8192), e = 8192 + (i - m * (NEL - 8192)); if (e > 8195 - m) *(LAS bf16*)(X.lds + m * CPS + 2 * e) = 0; }
#pragma unroll
    for (int half = 0; half < 2; ++half) {
        const v4u w = *(const v4u*)((half ? hb : hf) + 8 * tid);
        unsigned short v[8] = {(unsigned short)(w.x & 0xffff), (unsigned short)(w.x >> 16), (unsigned short)(w.y & 0xffff), (unsigned short)(w.y >> 16), (unsigned short)(w.z & 0xffff), (unsigned short)(w.z >> 16), (unsigned short)(w.w & 0xffff), (unsigned short)(w.w >> 16)};
        if (half == 0 && tid == 0) v[0] = (unsigned short)f2bf(bf2f(v[0]) + bias);
#pragma unroll
        for (int k = 0; k < 8; ++k) { const int d = 8 * tid + k; if (half == 1 && d == 0) continue;
            const int e0 = half ? 4100 + d : 4100 - d;
#pragma unroll
            for (int m = 0; m < 4; ++m) *(LAS bf16*)(X.lds + m * CPS + 2 * (e0 - m)) = v[k]; }
    }
}
#ifdef MK_HY_XLDS
#define HY_XL(qq) do { const v2u x0_ = *(const volatile LAS v2u*)(X.lds + baseA + 32 * (qq)), x1_ = *(const volatile LAS v2u*)(X.lds + baseA8 + 32 * (qq)); asm volatile("" :: "v"(x0_), "v"(x1_)); } while (0)
#else
#define HY_XL(qq) do {} while (0)
#endif
#define HY_LDA(dst, qq) do { HY_XL(qq); const v2u lo_ = *(const volatile LAS v2u*)(X.lds + baseA + 32 * (qq)), hi_ = *(const volatile LAS v2u*)(X.lds + baseA8 + 32 * (qq)); v4u w_ = {lo_.x, lo_.y, hi_.x, hi_.y}; dst = *reinterpret_cast<bf16x8*>(&w_); } while (0)
#define HY_LOAD_E(FA, FB, d1_, q_) do { const LAS unsigned char* zr_ = zb - (d1_) * ZROW; HY_LDA(FA[0], (q_)); HY_LDA(FA[1], (q_) + 1); \
    FB[0] = *(const LAS bf16x8*)(zr_); FB[1] = *(const LAS bf16x8*)(zr_ + 32); FB[2] = *(const LAS bf16x8*)(zr_ + 64); FB[3] = *(const LAS bf16x8*)(zr_ + 96); } while (0)
#define HY_LOAD_L(FA, q_) do { HY_LDA(FA[2], (q_) + 2); HY_LDA(FA[3], (q_) + 3); } while (0)
#ifdef MK_HY_XMFMA
#define HY_XM(A_, B_) do { dacc0 = __builtin_amdgcn_mfma_f32_32x32x16_bf16(A_, B_, dacc0, 0, 0, 0); } while (0)
#else
#define HY_XM(A_, B_) do {} while (0)
#endif
#define HY_MMA1(FA, FB, PA) do { __builtin_amdgcn_s_setprio(1); HY_XM(FA[0], FB[0]); HY_XM(PA[2], FB[0]); HY_XM(FA[1], FB[1]); HY_XM(PA[3], FB[1]); \
    acc0 = __builtin_amdgcn_mfma_f32_32x32x16_bf16(FA[0], FB[0], acc0, 0, 0, 0); acc1 = __builtin_amdgcn_mfma_f32_32x32x16_bf16(PA[2], FB[0], acc1, 0, 0, 0); \
    acc0 = __builtin_amdgcn_mfma_f32_32x32x16_bf16(FA[1], FB[1], acc0, 0, 0, 0); acc1 = __builtin_amdgcn_mfma_f32_32x32x16_bf16(PA[3], FB[1], acc1, 0, 0, 0); __builtin_amdgcn_s_setprio(0); } while (0)
#define HY_MMA2(FA, FB) do { __builtin_amdgcn_s_setprio(1); HY_XM(FA[2], FB[2]); HY_XM(FA[0], FB[2]); HY_XM(FA[3], FB[3]); HY_XM(FA[1], FB[3]); \
    acc0 = __builtin_amdgcn_mfma_f32_32x32x16_bf16(FA[2], FB[2], acc0, 0, 0, 0); acc1 = __builtin_amdgcn_mfma_f32_32x32x16_bf16(FA[0], FB[2], acc1, 0, 0, 0); \
    acc0 = __builtin_amdgcn_mfma_f32_32x32x16_bf16(FA[3], FB[3], acc0, 0, 0, 0); acc1 = __builtin_amdgcn_mfma_f32_32x32x16_bf16(FA[1], FB[3], acc1, 0, 0, 0); __builtin_amdgcn_s_setprio(0); } while (0)
template <int PAIR> __device__ __forceinline__ void channel(const Ctx& X, int l, int c, const float* __restrict__ hyb, v2u (&keep)[2][4]) {
    const bf16* UCT = (const bf16*)(X.ws + WS_UCT); const bf16* FILT = (const bf16*)(X.ws + WS_FILT) + (size_t)l * 4 * C * S; bf16* YH = (bf16*)(X.ws + WS_YH);
    const int tid = X.tid, lane = X.lane, wid = X.wave, r = lane & 31, h = lane >> 5, b = wid >> 1, jt = wid & 1;
    LAS unsigned char* zl = X.lds + OFF_Z;
    __syncthreads();
    v4u zero4 = {0u, 0u, 0u, 0u}; asm volatile("" : "+v"(zero4));
    for (int i = tid; i < 4 * 64 * 9; i += NTH) { const int bb = i / 576, rr = (i % 576) / 9, ch = i % 9; const int row = rr < 32 ? rr : 64 + rr;
        *(LAS v4u*)(zl + bb * ZB + row * ZROW + ch * 16) = zero4; }
    for (int i = tid; i < 4 * 64 * 8; i += NTH) { const int bb = i >> 9, s1 = (i >> 3) & 63, ch = i & 7;
        *(LAS v4u*)(zl + bb * ZB + (32 + s1) * ZROW + ch * 16) = *(const v4u*)(UCT + (size_t)c * T + bb * S + s1 * 64 + ch * 8); }
    const int m4 = (4 - (r & 3)) & 3;
    const int baseA = m4 * CPS + 2 * (8 * h - r + 4100 - m4);
    int baseA8 = baseA + 8; asm volatile("" : "+v"(baseA8));
    for (int o = 0; o < 2; ++o) {
        build_hrev(X, FILT + ((size_t)(2 * o) * C + c) * S, FILT + ((size_t)(2 * o + 1) * C + c) * S, hyb[(l * 2 + o) * C + c]);
#ifdef MK_HY_DUPBUILD
        asm volatile("" ::: "memory"); build_hrev(X, FILT + ((size_t)(2 * o) * C + c) * S, FILT + ((size_t)(2 * o + 1) * C + c) * S, hyb[(l * 2 + o) * C + c]);
#endif
        const bf16* gate = UCT + (size_t)((o + 1) * C + c) * T + (size_t)b * S;
        const int t1 = 32 * jt + r;
        v2u gw[2][4];
#pragma unroll
        for (int mt = 0; mt < 2; ++mt)
#pragma unroll
            for (int g = 0; g < 4; ++g) gw[mt][g] = *(const v2u*)(gate + t1 * 64 + 32 * mt + 8 * g + 4 * h);
        __syncthreads();
#ifndef MK_HY_SWEEPS
#define MK_HY_SWEEPS 1
#endif
        f32x16 acc0 = {}, acc1 = {};
#ifdef MK_HY_XMFMA
        f32x16 dacc0 = {};
#endif
        for (int rep = 0; rep < MK_HY_SWEEPS; ++rep) {
        const int d1max = 32 * jt + 31; int q = -4 * d1max;
        const LAS unsigned char* zb = zl + b * ZB + (32 + 32 * jt + r) * ZROW + 16 * h;
        bf16x8 fa0[4], fb0[4], fa1[4], fb1[4];
        HY_LDA(fa1[2], q - 2); HY_LDA(fa1[3], q - 1);
        HY_LOAD_E(fa0, fb0, d1max, q); HY_LOAD_L(fa0, q);
        int d1 = d1max;
        for (int it = 0; it < 47; ++it) {
            HY_LOAD_E(fa1, fb1, d1 - 1, q + 4);
            HY_MMA1(fa0, fb0, fa1);
            HY_LOAD_L(fa1, q + 4);
            HY_MMA2(fa0, fb0);
            HY_LOAD_E(fa0, fb0, d1 - 2, q + 8);
            HY_MMA1(fa1, fb1, fa0);
            HY_LOAD_L(fa0, q + 8);
            HY_MMA2(fa1, fb1);
            d1 -= 2; q += 8;
        }
        HY_MMA1(fa0, fb0, fa1); HY_MMA2(fa0, fb0);
        }
        if (MK_HY_SWEEPS == 2) { acc0 *= 0.5f; acc1 *= 0.5f; }
#ifdef MK_HY_XMFMA
        asm volatile("" :: "v"(dacc0));
#endif
        __syncthreads();
#pragma unroll
        for (int mt = 0; mt < 2; ++mt)
#pragma unroll
            for (int g = 0; g < 4; ++g) { const int t0 = 32 * mt + 8 * g + 4 * h; const v2u gwv = gw[mt][g];
                const f32x16& a = mt ? acc1 : acc0;
                const float y0 = a[4 * g] * bflo(gwv.x), y1 = a[4 * g + 1] * bfhi(gwv.x), y2 = a[4 * g + 2] * bflo(gwv.y), y3 = a[4 * g + 3] * bfhi(gwv.y);
                if (o == 0) { v2u w; w.x = pk2(y0, y1); w.y = pk2(y2, y3); *(LAS v2u*)(zl + b * ZB + (32 + t1) * ZROW + t0 * 2) = w; }
                else if (PAIR == 0) { keep[mt][g].x = pk2(y0, y1); keep[mt][g].y = pk2(y2, y3); }
                else { unsigned* yo = (unsigned*)(YH + ((size_t)b * S + t1 * 64 + t0) * C + (c - 1)); const v2u kp = keep[mt][g];
                    yo[0] = (kp.x & 0xffffu) | (f2bf(y0) << 16); yo[C / 2] = (kp.x >> 16) | (f2bf(y1) << 16); yo[C] = (kp.y & 0xffffu) | (f2bf(y2) << 16); yo[3 * C / 2] = (kp.y >> 16) | (f2bf(y3) << 16); } }
    }
    __syncthreads();
}
#undef HY_LDA
#undef HY_LOAD_E
#undef HY_LOAD_L
#undef HY_MMA1
#undef HY_MMA2
}
}
namespace mk {
#define GAS __attribute__((address_space(1)))
typedef GAS unsigned gu32;
typedef GAS unsigned long long gu64;
#define RLX_AGENT __ATOMIC_RELAXED, __HIP_MEMORY_SCOPE_AGENT
#define LDS_WAIT() asm volatile("s_waitcnt lgkmcnt(0)" ::: "memory")
#define VM_WAIT() asm volatile("s_waitcnt vmcnt(0)" ::: "memory")
__device__ __forceinline__ unsigned long long rt() { return __builtin_amdgcn_s_memrealtime(); }
#define XB_TMO      128
#define XB_XCNT(j)  (256  + 64 * (j))
#define XB_XSUB(j)  (1280 + 64 * (j))
#define XB_XGEN(j)  (2304 + 64 * (j))
#define XB_TOP      3328
#define XB_TOPGEN   3392
#define XCD_BAR_WORDS 3456
#define XB_SPIN_CAP (1u << 18)

__device__ __forceinline__ unsigned xb_ld(unsigned* p)              { return __hip_atomic_load(p, __ATOMIC_RELAXED, __HIP_MEMORY_SCOPE_AGENT); }
__device__ __forceinline__ unsigned xb_add(unsigned* p, unsigned v) { return __hip_atomic_fetch_add(p, v, __ATOMIC_RELAXED, __HIP_MEMORY_SCOPE_AGENT); }
__device__ __forceinline__ unsigned xb_xcc_id() { return (unsigned)__builtin_amdgcn_s_getreg((3 << 11) | 20) & 0xFu; }
#define XB_SPIN(cond, bar) do { unsigned _sp = 0; while (cond) { __builtin_amdgcn_s_sleep(1); \
    if ((++_sp & 255u) == 0u) { if (xb_ld(&(bar)[XB_TMO])) break; if (_sp > XB_SPIN_CAP) { atomicAdd(&(bar)[XB_TMO], 1u); break; } } } } while (0)

struct XcdBarrier {
    unsigned* bar; unsigned x;
    volatile LAS unsigned* st;
};

__device__ __forceinline__ XcdBarrier xcd_barrier_post(unsigned* bar, volatile LAS unsigned* st) {
    XcdBarrier b; b.bar = bar; b.x = xb_xcc_id(); b.st = st;
    if (threadIdx.x == 0) (void)xb_add(&bar[XB_XCNT(b.x)], 1u);
    return b;
}
__device__ __forceinline__ void xcd_barrier_complete(unsigned* bar, unsigned x, unsigned& nloc, unsigned& nx) {
    const unsigned G = gridDim.x * gridDim.y * gridDim.z;
    unsigned sum, cnt, mine, sp = 0u;
    for (;;) {
        sum = 0u; cnt = 0u; mine = 0u;
#pragma unroll
        for (unsigned j = 0; j < 16; ++j) { const unsigned c = xb_ld(&bar[XB_XCNT(j)]); sum += c; cnt += (c > 0u) ? 1u : 0u; mine = (j == x) ? c : mine; }
        if (sum == G) break;
        __builtin_amdgcn_s_sleep(1);
        if ((++sp & 255u) == 0u) { if (xb_ld(&bar[XB_TMO])) break; if (sp > XB_SPIN_CAP) { atomicAdd(&bar[XB_TMO], 1u); break; } }
    }
    nloc = mine > 0u ? mine : 1u; nx = cnt > 0u ? cnt : 1u;
}

__device__ __forceinline__ void xcd_barrier(const XcdBarrier& b, int wave_s) {
    asm volatile("s_waitcnt vmcnt(0)" ::: "memory");
    __syncthreads();
    if (fresh_tid(wave_s) == 0) {
        unsigned* bar = b.bar;
        __builtin_amdgcn_s_waitcnt(0);
        unsigned nloc = b.st[0], nx = b.st[1];
        if (nloc == 0u) { xcd_barrier_complete(bar, b.x, nloc, nx); b.st[0] = nloc; b.st[1] = nx; }
        const unsigned old = xb_add(&bar[XB_XSUB(b.x)], 1u);
        const unsigned gen = old / nloc;
        if (old + 1u == (gen + 1u) * nloc) {
            __builtin_amdgcn_fence(__ATOMIC_RELEASE, "agent");
            asm volatile("s_waitcnt vmcnt(0)" ::: "memory");
            const unsigned og = xb_add(&bar[XB_TOP], 1u);
            const unsigned tg = og / nx;
            if (og + 1u == (tg + 1u) * nx) xb_add(&bar[XB_TOPGEN], 1u);
            else XB_SPIN(xb_ld(&bar[XB_TOPGEN]) == tg, bar);
            __builtin_amdgcn_fence(__ATOMIC_ACQUIRE, "agent");
            xb_add(&bar[XB_XGEN(b.x)], 1u);
            asm volatile("s_waitcnt vmcnt(0)" ::: "memory");
        } else {
            XB_SPIN(xb_ld(&bar[XB_XGEN(b.x)]) == gen, bar);
            __builtin_amdgcn_fence(__ATOMIC_ACQUIRE, "agent");
            asm volatile("s_waitcnt vmcnt(0)" ::: "memory");
        }
    }
    __syncthreads();
}

}
namespace mk {
namespace cg = cooperative_groups;
constexpr int PH_PER_LAYER = 9, N_PHASES = 1 + 2 * PH_PER_LAYER;

__device__ __forceinline__ float lam_of(const Args& a, int l, float lam_init) {
    const float *q1 = a.in[14] + l * 64, *k1 = a.in[15] + l * 64, *q2 = a.in[16] + l * 64, *k2 = a.in[17] + l * 64;
    float s1 = 0.f, s2 = 0.f; for (int i = 0; i < 64; ++i) { s1 += q1[i] * k1[i]; s2 += q2[i] * k2[i]; }
    return expf(s1) - expf(s2) + lam_init;
}

typedef const __attribute__((address_space(4))) Args* KArgPtr;
__global__ void __launch_bounds__(NTH, 2) fwd(Args a_byval) {
    extern __shared__ __attribute__((aligned(16))) unsigned char lds_raw[];
    cg::grid_group grid = cg::this_grid();
    const int ph_lo = a_byval.ph_lo, ph_hi = a_byval.ph_hi;
    const int wave_s = __builtin_amdgcn_readfirstlane((int)threadIdx.x >> 6);
    volatile LAS unsigned* bar_st = (volatile LAS unsigned*)((LAS unsigned char*)lds_raw + LDS_BYTES - 64);
    if (threadIdx.x == 0) { bar_st[0] = 0u; bar_st[1] = 0u; }
    __syncthreads();
    const XcdBarrier bar = xcd_barrier_post((unsigned*)a_byval.ws, bar_st);
    int rep_flag = 0;
    for (int ph = ph_lo; ph < ph_hi; ++ph) {
        KArgPtr ap = (KArgPtr)__builtin_amdgcn_kernarg_segment_ptr(); asm volatile("" : "+s"(ap));
        const Args a = *(const Args*)ap;
        float* Xr = (float*)(a.ws + WS_X);
        Ctx X; X.wave_s = wave_s; X.wave = wave_s; X.tid = 0; X.lane = 0;
#define FRESH() do { X.tid = fresh_tid(wave_s); X.lane = X.tid & 63; } while (0)
        { int g_ = gridDim.x, b_ = blockIdx.x; asm volatile("" : "+s"(g_), "+s"(b_)); X.G = g_; X.bid = b_; }
        { const int bx = X.bid; X.vcu = (X.G % 8 == 0) ? (bx % 8) * (X.G / 8) + bx / 8 : bx; }
        X.gw = X.vcu * NWAVES + X.wave; X.ngw = X.G * NWAVES; X.lds = (LAS unsigned char*)lds_raw; X.ws = a.ws;
#ifndef MK_EN
#define MK_EN 0xFFFF
#endif
#ifndef MK_ATT
#define MK_ATT 3
#endif
#ifndef MK_REP_SP
#define MK_REP_SP 99
#endif
        if (ph == 0) { if (MK_EN & 512) { FRESH(); p0_prologue(X, a); } }
        else {
            const int l = (ph - 1) / PH_PER_LAYER, sp = (ph - 1) % PH_PER_LAYER;
            const float lam_init = 0.8f - 0.6f * expf(-0.3f * (float)l);
            if (0) {}
#if MK_EN & 1
            else if (sp == 0) {
                FRESH();
                pg8::Gemm g{(const bf16*)(a.ws + WS_XN), (const bf16*)(a.ws + WS_WIN) + (size_t)l * INW * D, T, INW, D};
                pg8::StaticOrder So; So.init(T, INW, X.G, X.bid);
                EpiWin Ep{a.ws, (const float*)(a.ws + WS_BINP) + l * INW, (const float*)(a.ws + WS_ROPE)};
                pg8::gemm_phase<EpiWin, pg8::StaticOrder, true, true>(X.lds, g, So, Ep, X.tid);
            }
#endif
#if MK_EN & 2
            else if (sp == 1) {
                FRESH();
                p1t_shortconv(X, a.in[4] + l * 3 * 1536, a.in[5] + l * 1536);
                p1t_kmax(X, (unsigned*)(a.ws + 14336) + l * 32);
            }
#endif
#if MK_EN & 4
            else if (sp == 2) {
                FRESH();
                const float lam = lam_of(a, l, lam_init);
                const int c = X.bid;
#ifndef MK_REP_ATT
#define MK_REP_ATT 1
#endif
#ifndef MK_CONV_REP
#define MK_CONV_REP 1
#endif
#ifndef MK_REP_HY
#define MK_REP_HY 1
#endif
                const int cg_ = X.vcu & 3;
                if (cg_ == 0) { __syncthreads(); p0_experts(relaunder(X), a, l); if (MK_CONV_REP > 1) { __syncthreads(); p0_experts(relaunder(X), a, l); } __syncthreads(); }
                for (int rep = 0; rep < MK_REP_ATT; ++rep) for (int u = c; u < 256; u += X.G) { const int bh = 2 * (u & 7) + ((u >> 3) >> 4), qb = (u >> 3) & 15; at::attn_unit(X, bh >> 2, bh & 3, qb, lam, 1.0f - lam_init, a.in[18] + l * 128, (unsigned*)(a.ws + 14336) + l * 32); }
                if (cg_ == 1) { __syncthreads(); p0_experts(relaunder(X), a, l); if (MK_CONV_REP > 1) { __syncthreads(); p0_experts(relaunder(X), a, l); } __syncthreads(); }
                for (int rep = 0; rep < MK_REP_HY; ++rep) for (int u = c; u < 256; u += X.G) { const int ch = 64 * (u & 7) + 2 * (u >> 3); v2u keep[2][4]; hy::channel<0>(relaunder(X), l, ch, a.in[13], keep);
                    if (cg_ == 2) { __syncthreads(); p0_experts(relaunder(X), a, l); if (MK_CONV_REP > 1) { __syncthreads(); p0_experts(relaunder(X), a, l); } __syncthreads(); }
                    hy::channel<1>(relaunder(X), l, ch + 1, a.in[13], keep); }
                if (cg_ == 3) { __syncthreads(); p0_experts(relaunder(X), a, l); if (MK_CONV_REP > 1) { __syncthreads(); p0_experts(relaunder(X), a, l); } __syncthreads(); }
            }
#endif
#if MK_EN & 8
            else if (sp == 3) {
                FRESH();
                OrderMerge So; So.so.init(T, D, X.G, X.bid);
                pg8::Gemm g{(const bf16*)(a.ws + WS_YH), (const bf16*)(a.ws + WS_WUH) + (size_t)l * 2 * D * C, 2 * T, 2 * D, C};
                EpiMerge2 Ep{(const bf16*)(a.ws + WS_GH), (const bf16*)(a.ws + WS_GA), (bf16*)(a.ws + WS_T1), (bf16*)(a.ws + WS_MG)};
                pg8::gemm_phase<EpiMerge2, OrderMerge, true, true>(X.lds, g, So, Ep, X.tid);
            }
#endif
#if MK_EN & 16
            else if (sp == 4) {
                FRESH();
                pg8::Gemm g{(const bf16*)(a.ws + WS_MG), (const bf16*)(a.ws + WS_WOUT) + (size_t)l * D * D, T, D, D};
                pg8::StaticOrder So; So.init(T, D, X.G, X.bid);
                EpiOutR Ep{l == 0 ? a.in[0] : Xr, Xr, (bf16*)(a.ws + WS_XN), (float*)(a.ws + WS_PART), (const bf16*)(a.ws + WS_WRP) + (size_t)l * 2 * E * D};
                pg8::gemm_phase<EpiOutR, pg8::StaticOrder, true, true>(X.lds, g, So, Ep, X.tid);
            }
#endif
#if MK_EN & 32
            else if (sp == 5) { FRESH(); p6_topk(X, a.in[24] + l * E);
            }
#endif
#if MK_EN & 64
            else if (sp == 6) {
                FRESH();
                pg8::Gemm g{(const bf16*)(a.ws + WS_XN), (const bf16*)(a.ws + WS_WGU) + (size_t)l * E * 2 * F * D, E * 2048, 2 * F, D, 2 * F, 4, (size_t)2 * F * D * 2, (const int*)(a.ws + WS_ROWS)};
                OrderMoE1 So{X.G, X.bid}; EpiSwiGLU Ep{(bf16*)(a.ws + WS_HB), (const float*)(a.ws + WS_RSL)};
                pg8::gemm_phase<EpiSwiGLU, OrderMoE1, true, true, true, true>(X.lds, g, So, Ep, X.tid);
            }
#endif
#if MK_EN & 128
            else if (sp == 7) {
                FRESH();
                pg8::Gemm g{(const bf16*)(a.ws + WS_HB), (const bf16*)(a.ws + WS_WD) + (size_t)l * E * D * F, E * 2048, D, F, D, 2, (size_t)D * F * 2};
                OrderMoE2 So{X.G, X.bid}; EpiDown Ep{(bf16*)(a.ws + WS_YE), (const float*)(a.ws + WS_GATE)};
                pg8::gemm_phase<EpiDown, OrderMoE2, true, true, true>(X.lds, g, So, Ep, X.tid);
            }
#endif
#if MK_EN & 256
            else if (sp == 8) {
                FRESH();
                p9_combine(X, Xr, l == 0 ? a.in[1] + D : a.in[28], l == 1, a.out);
            }
#endif
        }
#ifndef MK_EXTRA_SYNC
#define MK_EXTRA_SYNC 0
#endif
        if (ph + 1 < ph_hi) { if (ph_hi > 4096) grid.sync(); else xcd_barrier(bar, wave_s); }
        for (int es = 0; es < MK_EXTRA_SYNC; ++es) xcd_barrier(bar, wave_s);
        if (MK_REP_SP != 99) { const int sp_ = ph == 0 ? -1 : (ph - 1) % PH_PER_LAYER; if (sp_ == MK_REP_SP && rep_flag == 0) { rep_flag = 1; --ph; } else rep_flag = 0; }
    }
}

static int g_grid = 0;
static bool mega_setup() {
    if (g_grid) return g_grid > 0;
    int dev = 0, cus = 0, per_cu = 0;
    if (hipGetDevice(&dev) != hipSuccess || hipDeviceGetAttribute(&cus, hipDeviceAttributeMultiprocessorCount, dev) != hipSuccess) { g_grid = -1; return false; }
    if (hipFuncSetAttribute((const void*)fwd, hipFuncAttributeMaxDynamicSharedMemorySize, LDS_BYTES) != hipSuccess) { fprintf(stderr, "hipFuncSetAttribute failed\n"); g_grid = -1; return false; }
    if (hipOccupancyMaxActiveBlocksPerMultiprocessor(&per_cu, (const void*)fwd, NTH, LDS_BYTES) != hipSuccess || per_cu < 1) { fprintf(stderr, "occupancy query failed (%d)\n", per_cu); g_grid = -1; return false; }
    g_grid = cus * 1;
    return true;
}
static void mega_launch(hipStream_t st, void* const* d_in, float* d_out, unsigned char* ws, int ph_lo, int ph_hi, int p0_mask) {
    if (!mega_setup()) return;
    Args a{};
    for (int i = 0; i < 29; ++i) a.in[i] = (const float*)d_in[i];
    a.out = d_out; a.ws = ws; a.ph_lo = ph_lo; a.ph_hi = ph_hi; a.p0_mask = p0_mask; a.pad = 0;
    if (hipMemsetAsync(ws, 0, 16384, st) != hipSuccess) { fprintf(stderr, "memset of the barrier words failed\n"); return; }
    void* args[] = {&a};
    const hipError_t e = hipLaunchCooperativeKernel((const void*)fwd, dim3(g_grid), dim3(NTH), args, LDS_BYTES, st);
    if (e != hipSuccess) fprintf(stderr, "cooperative launch failed: %s (grid %d)\n", hipGetErrorString(e), g_grid);
}
}
extern "C" void kernel_launch(void* const* d_in, const int* in_sizes, int n_in, void* d_out, int out_size, void* d_ws, size_t ws_size, hipStream_t stream) {
    if (n_in != 29 || out_size != mk::T * mk::D || ws_size < mk::WS_END) { fprintf(stderr, "kernel_launch: unexpected sizes n_in %d out %d ws %zu\n", n_in, out_size, ws_size); return; }
    mk::mega_launch(stream, d_in, (float*)d_out, (unsigned char*)d_ws, 0, mk::N_PHASES, 13);
}
```

```cpp
#include <hip/hip_runtime.h>
#include <hip/hip_cooperative_groups.h>
#include <cstdio>
#include <cstdint>
#include <cmath>
namespace tk {
constexpr int S = 4096, E = 16, CAP = 512, NT = 512;
__device__ __forceinline__ void topk_problem(const unsigned (&key)[8], const float (&rr)[8], int tokbase, int e, int slotbase, int* __restrict__ rows, float* __restrict__ gate, float* __restrict__ rsl, int* __restrict__ inv, int* sm, int tid) {
    const int lane = tid & 63, wid = tid >> 6;
    int* hist = sm; int* ctl = sm + 256;
    unsigned prefix = 0u, mask = 0u; int kth = CAP;
    for (int pass = 3; pass >= 0; --pass) {
        __syncthreads();
        if (tid < 256) hist[tid] = 0;
        __syncthreads();
#pragma unroll
        for (int i = 0; i < 8; ++i) if ((key[i] & mask) == prefix) atomicAdd(&hist[(key[i] >> (8 * pass)) & 255u], 1);
        __syncthreads();
        if (tid < 64) {
            const int b0 = hist[4 * lane], b1 = hist[4 * lane + 1], b2 = hist[4 * lane + 2], b3 = hist[4 * lane + 3];
            const int tot = b0 + b1 + b2 + b3;
            int suf = tot;
#pragma unroll
            for (int o = 1; o < 64; o <<= 1) { const int v = __builtin_amdgcn_ds_bpermute(((lane + o) & 63) << 2, suf); if (lane + o < 64) suf += v; }
            const int above = suf - tot;
            if (above < kth && kth <= above + tot) {
                int cum = above, bin, k2;
                if (cum + b3 >= kth) { bin = 4 * lane + 3; k2 = kth - cum; }
                else { cum += b3; if (cum + b2 >= kth) { bin = 4 * lane + 2; k2 = kth - cum; }
                else { cum += b2; if (cum + b1 >= kth) { bin = 4 * lane + 1; k2 = kth - cum; }
                else { cum += b1; bin = 4 * lane; k2 = kth - cum; } } }
                ctl[0] = bin; ctl[1] = k2;
            }
        }
        __syncthreads();
        prefix |= ((unsigned)ctl[0]) << (8 * pass); mask |= 0xFFu << (8 * pass); kth = ctl[1];
    }
    const unsigned thr = prefix; const int need_eq = kth; const int n_gt = CAP - need_eq;
    int cg = 0, ce = 0;
#pragma unroll
    for (int i = 0; i < 8; ++i) { cg += key[i] > thr; ce += key[i] == thr; }
    int sg = cg, se = ce;
#pragma unroll
    for (int o = 1; o < 64; o <<= 1) { const int a = __builtin_amdgcn_ds_bpermute(((lane - o) & 63) << 2, sg), b = __builtin_amdgcn_ds_bpermute(((lane - o) & 63) << 2, se); if (lane >= o) { sg += a; se += b; } }
    __syncthreads();
    if (lane == 63) { ctl[8 + wid] = sg; ctl[16 + wid] = se; }
    __syncthreads();
    int og = sg - cg, oe = se - ce;
    for (int w = 0; w < wid; ++w) { og += ctl[8 + w]; oe += ctl[16 + w]; }
#pragma unroll
    for (int i = 0; i < 8; ++i) {
        const int idx = tid * 8 + i; int slot = -1;
        if (key[i] > thr) slot = og++;
        else if (key[i] == thr) { if (oe < need_eq) slot = n_gt + oe; ++oe; }
        if (slot >= 0) { rows[slot] = tokbase + idx; gate[slot] = __uint_as_float(key[i]); rsl[slot] = rr[i]; }
        inv[(size_t)(tokbase + idx) * E + e] = slot >= 0 ? slotbase + slot : -1;
    }
    __syncthreads();
}
}
namespace pg8 {
#define PG8_LAS __attribute__((address_space(3)))
typedef unsigned short bf16_t;
typedef short bf16x8 __attribute__((ext_vector_type(8)));
typedef float f32x4 __attribute__((ext_vector_type(4)));
typedef unsigned u32x4 __attribute__((ext_vector_type(4)));
typedef short s16x4 __attribute__((ext_vector_type(4)));
constexpr int BM = 256, BK = 64, HALF = 128, HTB = HALF * BK * 2  , STAGE_BYTES = 8 * HTB, NXCD = 8, WGM = 8;

__host__ __device__ __forceinline__ int lds_byte(int r, int c) { const int st = (r >> 4) * 2 + (c >> 5), rr = r & 15, cc = c & 31, ob = rr * 64 + cc * 2; return st * 1024 + (ob ^ (((ob >> 9) & 1) << 5)); }
__host__ __device__ __forceinline__ void stage_rc(int b, int& R, int& C) { const int st = b / 1024, sb = b % 1024, swz = sb ^ (((sb >> 9) & 1) << 5); R = (st >> 1) * 16 + swz / 64; C = (st & 1) * 32 + (swz % 64) / 2; }
__host__ __device__ __forceinline__ int perm32(int rho) { const int n = rho >> 4, i = rho & 15; return 8 * (i >> 2) + 4 * n + (i & 3); }

struct Unit { int pm, pn, pb, pa; };
struct Gemm { const bf16_t* A; const bf16_t* Bt; int M, N, K; int bN = 0, bsh = 0; size_t bes = 0; const int* arows = nullptr; };

struct StaticOrder {
    int nM, nN, nwg, G, c;
    __host__ __device__ void init(int M, int N, int G_, int c_) { nM = M / BM; nN = N / BM; nwg = nM * nN; G = G_; c = c_; }
    __host__ __device__ bool next(int i, Unit& u) const {
        const long L = (long)i * G + c; if (L >= nwg) return false;
        int wgid = (int)L; { const int q = nwg / NXCD, r = nwg % NXCD, xcd = wgid % NXCD, off = wgid / NXCD; wgid = (xcd < r ? xcd * (q + 1) : r * (q + 1) + (xcd - r) * q) + off; }
        const int nig = WGM * nN, gid = wgid / nig, fm = gid * WGM, gsz = (nM - fm) < WGM ? (nM - fm) : WGM;
        u.pm = fm + ((wgid % nig) % gsz); u.pn = (wgid % nig) / gsz; u.pb = u.pn; u.pa = u.pm; return true;
    }
    __device__ __forceinline__ void a_ready(const Unit&) const {}
    __device__ __forceinline__ void done(const Unit&) const {}
};

template <class Epi, class Sched, bool ALIGN_EPI = false, bool SP2 = false, bool BT = false, bool GA = false>
__device__ __forceinline__ void gemm_phase(PG8_LAS unsigned char* lds, const Gemm g, const Sched& S, const Epi& E, int tid) {
    asm volatile("" : "+v"(tid));
    const int wid = __builtin_amdgcn_readfirstlane(tid >> 6), lane = tid & 63, wr = wid >> 2, wc = wid & 3, fr = lane & 15, fq = lane >> 4;
    const int K = g.K, nt = K / BK;
    unsigned voffA[2], voffB[2];
#pragma unroll
    for (int i = 0; i < 2; ++i) { int R, C; stage_rc(tid * 16 + i * 8192, R, C); const int Rb = Epi::PERM ? ((R & ~31) + perm32(R & 31)) : R;
        voffA[i] = (unsigned)(R * K + C) * 2u; voffB[i] = (unsigned)(Rb * K + C) * 2u; if constexpr (GA) voffA[i] = (unsigned)C * 2u;
        if constexpr (BT) { const int p = i * 512 + tid, row = ((p >> 7) << 3) | ((p >> 2) & 7), ch = (((p >> 5) & 3) << 2) | ((p & 3) ^ ((row >> 2) & 3));
            voffB[i] = (unsigned)(row * g.bN + 8 * ch) * 2u; } }
    const size_t kstep = (size_t)(BK * 2);
    const size_t hstep = (size_t)HALF * K * 2;
    const size_t tstep = 2 * hstep;
    const size_t kstepB = BT ? (size_t)BK * g.bN * 2 : kstep, hstepB = BT ? (size_t)HALF * 2 : hstep;
    const size_t hstepA = GA ? 0 : hstep;
    unsigned curA[2][2] = {{0u, 0u}, {0u, 0u}};
    PG8_LAS int* rowtab0 = (PG8_LAS int*)(lds + STAGE_BYTES);
#define PG8_ROWTAB (rowtab0 + ((ui + 1) & 1) * 512)
#define PG8_NXTOFF(o_, h) do { int t_ = tid; asm volatile("" : "+v"(t_)); _Pragma("unroll") for (int i_ = 0; i_ < 2; ++i_) { int R_, C_; stage_rc(t_ * 16 + i_ * 8192, R_, C_); \
        o_[i_] = (unsigned)PG8_ROWTAB[(h) * 128 + R_] * (unsigned)(K * 2) + (unsigned)C_ * 2u; } } while (0)
#define PG8_STAGE_A(bufoff, kbase, h, nx) do { if constexpr (GA) { if (nx) { unsigned o_[2]; PG8_NXTOFF(o_, h); PG8_STAGE(bufoff, kbase, o_); } else PG8_STAGE(bufoff, kbase, curA[h]); } \
        else PG8_STAGE(bufoff, (kbase) + ((h) ? hstep : 0), voffA); } while (0)
#define PG8_BBASE(pb) ((const char*)g.Bt + (BT ? (size_t)((pb) >> g.bsh) * g.bes + (size_t)((pb) & ((1 << g.bsh) - 1)) * 512 : (size_t)(pb) * tstep))
    const unsigned ldsw = (unsigned)wid * 1024u;
    const int aoff = lds_byte(wr * 64 + fr, fq * 8), boff = lds_byte(wc * 32 + fr, fq * 8);
    int tr0 = 0, tr1 = 0;
    if constexpr (BT) { static_assert(Epi::PERM, "BT needs the PERM column order"); const int q_ = (lane >> 2) & 3, p_ = lane & 3, f1_ = fq & 1;
        const int L_ = (int)(size_t)lds + 2048 * fq + 512 * wc + 64 * q_ + 32 * ((p_ >> 1) ^ f1_); tr0 = L_ + 16 * (p_ & 1); tr1 = L_ + 256 + 16 * (1 - (p_ & 1)); }
#define PG8_SA(b, h) (((b) * 2 + (h)) * HTB)
#define PG8_SB(b, h) ((4 + (b) * 2 + (h)) * HTB)
#define PG8_STAGE(bufoff, gbase, voff) do { _Pragma("unroll") for (int _i = 0; _i < 2; ++_i) \
        __builtin_amdgcn_global_load_lds((const unsigned*)((const char*)(gbase) + (voff)[_i]), (PG8_LAS unsigned*)(lds + (bufoff) + ldsw + _i * 8192), 16, 0, 0); } while (0)
#define PG8_LDA(dst, b, h) do { _Pragma("unroll") for (int m = 0; m < 4; ++m) _Pragma("unroll") for (int k = 0; k < 2; ++k) dst[m][k] = *(const PG8_LAS bf16x8*)(lds + PG8_SA(b, h) + aoff + m * 2048 + k * 1024); } while (0)
#define PG8_TR(dst4, addr, OFF) asm volatile("ds_read_b64_tr_b16 %0, %1 offset:%2" : "=&v"(dst4) : "v"(addr), "i"(OFF) : "memory")
#define PG8_TRF(dst8, a0, a1, OFF) do { s16x4 lo_, hi_; PG8_TR(lo_, a0, OFF); PG8_TR(hi_, a1, OFF); dst8 = __builtin_shufflevector(lo_, hi_, 0, 1, 2, 3, 4, 5, 6, 7); } while (0)
#define PG8_LDB(dst, b, h) do { if constexpr (BT) { const int a0_ = tr0 + PG8_SB(b, h), a1_ = tr1 + PG8_SB(b, h); \
        PG8_TRF(dst[0][0], a0_, a1_, 0); PG8_TRF(dst[0][1], a0_, a1_, 8192); PG8_TRF(dst[1][0], a0_, a1_, 8); PG8_TRF(dst[1][1], a0_, a1_, 8200); } else { \
    _Pragma("unroll") for (int n = 0; n < 2; ++n) _Pragma("unroll") for (int k = 0; k < 2; ++k) dst[n][k] = *(const PG8_LAS bf16x8*)(lds + PG8_SB(b, h) + boff + n * 2048 + k * 1024); } } while (0)
#define PG8_MMA(ai, bj, At, Bt) do { __builtin_amdgcn_s_setprio(1); _Pragma("unroll") for (int m = 0; m < 4; ++m) _Pragma("unroll") for (int n = 0; n < 2; ++n) _Pragma("unroll") for (int k = 0; k < 2; ++k) \
        acc[ai][bj][m][n] = __builtin_amdgcn_mfma_f32_16x16x32_bf16(Bt[n][k], At[m][k], acc[ai][bj][m][n], 0, 0, 0); __builtin_amdgcn_s_setprio(0); } while (0)
#define PG8_WAIT_V(n) asm volatile("s_waitcnt vmcnt(" #n ")" ::: "memory")
#define PG8_WAIT_L(n) asm volatile("s_waitcnt lgkmcnt(" #n ")" ::: "memory")
#define PG8_BAR __builtin_amdgcn_s_barrier()
#define PG8_SCHED __builtin_amdgcn_sched_barrier(0)
    Unit cur, nxt; int ui = 0;
    if (!S.next(0, cur)) return;
    f32x4 acc[2][2][4][2];
#pragma unroll
    for (int a = 0; a < 2; ++a)
#pragma unroll
        for (int b = 0; b < 2; ++b)
#pragma unroll
            for (int m = 0; m < 4; ++m)
#pragma unroll
                for (int n = 0; n < 2; ++n) acc[a][b][m][n] = (f32x4){0.f, 0.f, 0.f, 0.f};
    bf16x8 At[4][2], B0[2][2], B1[2][2];
    const char* cA = (const char*)g.A + (GA ? 0 : (size_t)cur.pa * tstep); const char* cB = PG8_BBASE(cur.pb);
    if constexpr (GA) {
#pragma unroll
        for (int h = 0; h < 2; ++h)
#pragma unroll
            for (int i = 0; i < 2; ++i) { int R, C; stage_rc(tid * 16 + i * 8192, R, C);
                curA[h][i] = (unsigned)__hip_atomic_load(g.arows + cur.pa * 256 + h * 128 + R, __ATOMIC_RELAXED, __HIP_MEMORY_SCOPE_AGENT) * (unsigned)(K * 2) + (unsigned)C * 2u; } }
    S.a_ready(cur);
    if constexpr (SP2) {
        PG8_STAGE(PG8_SB(0, 0), cB, voffB); PG8_STAGE(PG8_SB(0, 1), cB + hstepB, voffB); PG8_STAGE_A(PG8_SA(0, 0), cA, 0, false); PG8_STAGE_A(PG8_SA(0, 1), cA, 1, false);
        if (wr == 1) PG8_BAR;
        PG8_WAIT_V(2); PG8_BAR;
        PG8_STAGE(PG8_SB(1, 0), cB + kstepB, voffB); PG8_STAGE_A(PG8_SA(1, 0), cA + kstep, 0, false); PG8_STAGE(PG8_SB(1, 1), cB + hstepB + kstepB, voffB);
        PG8_WAIT_V(6); PG8_BAR;
    } else {
        PG8_STAGE(PG8_SB(0, 0), cB, voffB); PG8_STAGE_A(PG8_SA(0, 0), cA, 0, false); PG8_STAGE(PG8_SB(0, 1), cB + hstepB, voffB); PG8_STAGE_A(PG8_SA(0, 1), cA, 1, false);
        if (wr == 1) PG8_BAR;
        PG8_WAIT_V(4); PG8_BAR;
        PG8_STAGE(PG8_SB(1, 0), cB + kstepB, voffB); PG8_STAGE_A(PG8_SA(1, 0), cA + kstep, 0, false); PG8_STAGE(PG8_SB(1, 1), cB + hstepB + kstepB, voffB);
        PG8_WAIT_V(6); PG8_BAR;
    }
    for (;;) {
        const bool has_next = S.next(ui + 1, nxt);
        const char* nA = (has_next && !GA) ? (const char*)g.A + (size_t)nxt.pa * tstep : cA; const char* nB = has_next ? PG8_BBASE(nxt.pb) : cB;
        for (int t = 0; t < nt; t += 2) {
            const bool last = (t == nt - 2);
            const char* a1 = cA + (size_t)(t + 1) * kstep;
            const char* a2 = last ? nA : cA + (size_t)(t + 2) * kstep; const char* b2 = last ? nB : cB + (size_t)(t + 2) * kstepB;
            const char* a3 = a2 + kstep; const char* b3 = b2 + kstepB;
            if (last && has_next) S.a_ready(nxt);
            const bool nx = GA && last && has_next;
            if constexpr (GA) {
                if (t == 0 && has_next) { int l_ = lane; asm volatile("" : "+v"(l_)); __builtin_amdgcn_global_load_lds((const unsigned*)(g.arows + nxt.pa * 256 + (wid & 3) * 64 + l_), (PG8_LAS unsigned*)(PG8_ROWTAB + wid * 64), 4, 0, 0); }
            }
            if constexpr (SP2) {
            PG8_LDB(B0, 0, 0); PG8_LDB(B1, 0, 1); PG8_SCHED; PG8_LDA(At, 0, 0); PG8_STAGE_A(PG8_SA(1, 1), a1, 1, false);
            PG8_WAIT_V(8); PG8_WAIT_L(0); PG8_BAR; PG8_MMA(0, 0, At, B0); PG8_MMA(0, 1, At, B1); PG8_BAR; PG8_SCHED;
            PG8_LDA(At, 0, 1); PG8_STAGE(PG8_SB(0, 0), b2, voffB); PG8_STAGE(PG8_SB(0, 1), b2 + hstepB, voffB); PG8_STAGE_A(PG8_SA(0, 0), a2, 0, nx);
            PG8_WAIT_V(8); PG8_WAIT_L(0); PG8_BAR; PG8_MMA(1, 0, At, B0); PG8_MMA(1, 1, At, B1); PG8_BAR; PG8_SCHED;
            PG8_LDB(B0, 1, 0); PG8_LDB(B1, 1, 1); PG8_SCHED; PG8_LDA(At, 1, 0); PG8_STAGE_A(PG8_SA(0, 1), a2, 1, nx);
            PG8_WAIT_V(8); PG8_WAIT_L(0); PG8_BAR; PG8_MMA(0, 0, At, B0); PG8_MMA(0, 1, At, B1); PG8_BAR; PG8_SCHED;
            PG8_LDA(At, 1, 1); PG8_STAGE(PG8_SB(1, 0), b3, voffB); PG8_STAGE(PG8_SB(1, 1), b3 + hstepB, voffB); PG8_STAGE_A(PG8_SA(1, 0), a3, 0, nx);
            PG8_WAIT_V(8); PG8_WAIT_L(0); PG8_BAR; PG8_MMA(1, 0, At, B0); PG8_MMA(1, 1, At, B1); PG8_BAR; PG8_SCHED;
            } else {
            PG8_LDB(B0, 0, 0); PG8_SCHED; PG8_LDA(At, 0, 0); PG8_STAGE_A(PG8_SA(1, 1), a1, 1, false);
            PG8_WAIT_L(8); PG8_BAR; PG8_WAIT_L(0); PG8_MMA(0, 0, At, B0); PG8_BAR; PG8_SCHED;
            PG8_LDB(B1, 0, 1); PG8_STAGE(PG8_SB(0, 0), b2, voffB);
            PG8_BAR; PG8_WAIT_L(0); PG8_MMA(0, 1, At, B1); PG8_BAR;
            PG8_LDA(At, 0, 1); PG8_STAGE_A(PG8_SA(0, 0), a2, 0, nx);
            PG8_BAR; PG8_WAIT_L(0); PG8_MMA(1, 0, At, B0); PG8_BAR; PG8_SCHED;
            PG8_STAGE(PG8_SB(0, 1), b2 + hstepB, voffB);
            PG8_WAIT_V(6); PG8_BAR; PG8_MMA(1, 1, At, B1); PG8_BAR;
            PG8_LDB(B0, 1, 0); PG8_SCHED; PG8_LDA(At, 1, 0); PG8_STAGE_A(PG8_SA(0, 1), a2, 1, nx);
            PG8_WAIT_L(8); PG8_BAR; PG8_WAIT_L(0); PG8_MMA(0, 0, At, B0); PG8_BAR; PG8_SCHED;
            PG8_LDB(B1, 1, 1); PG8_STAGE(PG8_SB(1, 0), b3, voffB);
            PG8_BAR; PG8_WAIT_L(0); PG8_MMA(0, 1, At, B1); PG8_BAR;
            PG8_LDA(At, 1, 1); PG8_STAGE_A(PG8_SA(1, 0), a3, 0, nx);
            PG8_BAR; PG8_WAIT_L(0); PG8_MMA(1, 0, At, B0); PG8_BAR; PG8_SCHED;
            PG8_STAGE(PG8_SB(1, 1), b3 + hstepB, voffB);
            PG8_WAIT_V(6); PG8_BAR; PG8_MMA(1, 1, At, B1); PG8_BAR;
            }
        }
        if constexpr (ALIGN_EPI) { if (wr == 0) PG8_BAR; }
        if constexpr (!Epi::AFTER_DRAIN) { E(acc, cur, wr, wc, fr, fq); S.done(cur); }
        if (!has_next) break;
#pragma unroll
        for (int a = 0; a < 2; ++a)
#pragma unroll
            for (int b = 0; b < 2; ++b)
#pragma unroll
                for (int m = 0; m < 4; ++m)
#pragma unroll
                    for (int n = 0; n < 2; ++n) acc[a][b][m][n] = (f32x4){0.f, 0.f, 0.f, 0.f};
        if constexpr (GA) { PG8_NXTOFF(curA[0], 0); PG8_NXTOFF(curA[1], 1); }
        cur = nxt; cA = nA; cB = nB; ++ui;
        if constexpr (ALIGN_EPI) { if (wr == 1) PG8_BAR; }
    }
    PG8_WAIT_V(0);
    if constexpr (!ALIGN_EPI) { if (wr == 0) PG8_BAR; }
    PG8_BAR;
    if constexpr (Epi::AFTER_DRAIN) { E.fused(acc, cur, wr, wc, fr, fq, lds, wid, lane); S.done(cur); }
#undef PG8_SA
#undef PG8_SB
#undef PG8_STAGE
#undef PG8_STAGE_A
#undef PG8_NXTOFF
#undef PG8_ROWTAB
#undef PG8_LDA
#undef PG8_LDB
#undef PG8_TR
#undef PG8_TRF
#undef PG8_BBASE
#undef PG8_MMA
#undef PG8_WAIT_V
#undef PG8_WAIT_L
#undef PG8_BAR
#undef PG8_SCHED
}
}

namespace mk {
constexpr int D = 1024, B = 4, S = 4096, T = B * S, C = 512, INW = 5120, E = 16, CAP = 512, F = 2048, NTH = 512, NWAVES = 8;
typedef unsigned short bf16;
#define LAS __attribute__((address_space(3)))
typedef unsigned v4u __attribute__((ext_vector_type(4)));
typedef unsigned v2u __attribute__((ext_vector_type(2)));
typedef float f32x4 __attribute__((ext_vector_type(4)));
typedef short bf16x8 __attribute__((ext_vector_type(8)));
typedef float f32x16 __attribute__((ext_vector_type(16)));
typedef short s16x4 __attribute__((ext_vector_type(4)));

constexpr size_t MiB = 1u << 20;
constexpr size_t WS_WIN = 2 * MiB;
constexpr size_t WS_WUH = 22 * MiB;
constexpr size_t WS_WUA = 23 * MiB;
constexpr size_t WS_WOUT = 26 * MiB;
constexpr size_t WS_BINP = 30 * MiB;
constexpr size_t WS_WRP = 30 * MiB + 512 * 1024;
constexpr size_t WS_ROPE = 31 * MiB;
constexpr size_t WS_AFFT = 32 * MiB;
constexpr size_t WS_INV = 33 * MiB;
constexpr size_t WS_ROWS = 34 * MiB;
constexpr size_t WS_GATE = 34 * MiB + 512 * 1024;
constexpr size_t WS_RTOK = 35 * MiB + 512 * 1024;
constexpr size_t WS_RSL = 35 * MiB;
constexpr size_t WS_FILT = 36 * MiB;
constexpr size_t WS_X = 68 * MiB;
constexpr size_t WS_XN = 132 * MiB;
constexpr size_t WS_SH = 164 * MiB;
constexpr size_t WS_U = WS_SH;
constexpr size_t WS_UCT = WS_SH + 48 * MiB;
constexpr size_t WS_Q = WS_SH + 96 * MiB;
constexpr size_t WS_K = WS_SH + 112 * MiB;
constexpr size_t WS_V = WS_SH + 128 * MiB;
constexpr size_t WS_GH = WS_SH + 144 * MiB;
constexpr size_t WS_GA = WS_SH + 176 * MiB;
constexpr size_t WS_YH = WS_SH + 208 * MiB;
constexpr size_t WS_YA = WS_SH + 224 * MiB;
constexpr size_t WS_T1 = WS_U;
constexpr size_t WS_MG = WS_UCT;
constexpr size_t WS_PART = WS_SH;
constexpr size_t WS_HB = WS_SH + 64 * MiB;
constexpr size_t WS_YE = WS_SH + 192 * MiB;
constexpr size_t WS_WGU = 420 * MiB;
constexpr size_t WS_WD = 676 * MiB;
constexpr size_t WS_END = 804 * MiB;

constexpr int LDS_BYTES = 155648;
constexpr float QSCALE = 0.125f * 1.4426950408889634f;

struct Args {
    const float* in[29]; float* out; unsigned char* ws; int ph_lo, ph_hi; int p0_mask, pad;
};

__device__ __forceinline__ unsigned f2bf(float f) { unsigned u = __builtin_bit_cast(unsigned, f); return (u + 0x7fffu + ((u >> 16) & 1u)) >> 16; }
__device__ __forceinline__ unsigned pk2(float lo, float hi) { return f2bf(lo) | (f2bf(hi) << 16); }
__device__ __forceinline__ float bf2f(unsigned h) { return __builtin_bit_cast(float, h << 16); }
__device__ __forceinline__ float bflo(unsigned w) { return __builtin_bit_cast(float, w << 16); }
__device__ __forceinline__ float bfhi(unsigned w) { return __builtin_bit_cast(float, w & 0xffff0000u); }
template <int O> __device__ __forceinline__ float xor_f(float v) { return __builtin_bit_cast(float, __builtin_amdgcn_ds_swizzle(__builtin_bit_cast(int, v), (O << 10) | 0x1f)); }
__device__ __forceinline__ float wave_sum(float v) { v += xor_f<1>(v); v += xor_f<2>(v); v += xor_f<4>(v); v += xor_f<8>(v); v += xor_f<16>(v);
    const int b = __builtin_bit_cast(int, v); return __builtin_bit_cast(float, __builtin_amdgcn_readlane(b, 0)) + __builtin_bit_cast(float, __builtin_amdgcn_readlane(b, 32)); }

__device__ __forceinline__ float sigm(float x) { return 1.f / (1.f + __expf(-x)); }

struct Ctx { int tid, lane, wave, gw, ngw, vcu, G, bid, wave_s; LAS unsigned char* lds; unsigned char* ws; };

__device__ __forceinline__ int fresh_tid(int wave_s) { int l; asm volatile("v_mbcnt_lo_u32_b32 %0, -1, 0\n\tv_mbcnt_hi_u32_b32 %0, -1, %0" : "=v"(l)); return (wave_s << 6) | l; }
__device__ __forceinline__ Ctx relaunder(const Ctx& X) { Ctx Y = X; const int t = fresh_tid(X.wave_s); Y.tid = t; Y.lane = t & 63; return Y; }

template <int MAP> __device__ __forceinline__ int rowmap(int n) {
    if (MAP == 1) {
        if (n < 1536 || n >= 2560) return n;
        const int hb = (n - 1536) & ~63, d = (n - 1536) & 63, i = (d & 31) >> 2, j = d & 3;
        return 1536 + hb + 8 * i + ((d >> 5) << 2) + j;
    }
    if (MAP == 2) return ((n >> 7) << 8) + (n & 127);
    if (MAP == 3) return ((n >> 7) << 8) + 128 + (n & 127);
    return n;
}
__device__ __forceinline__ unsigned cvtpk_(float lo, float hi) { unsigned r; asm volatile("v_cvt_pk_bf16_f32 %0, %1, %2" : "=v"(r) : "v"(lo), "v"(hi)); return r; }
struct TrItem { const float* src; bf16* dst; };
template <int MAP> __device__ __forceinline__ void p0_transpose(const Ctx& X, const float* W, int K, int N, bf16* WT, int nmat, size_t sstride, size_t dstride) {
    LAS float* scr = (LAS float*)(X.lds + X.wave * 16640);
    const int nblk = N / 64, per = (K / 64) * nblk, tot = per * nmat, lane = X.lane;
    const int nq = lane & 15, kr = lane >> 4, c = lane & 7, nsub = lane >> 3;
    f32x4 v[16];
    int it = X.gw;
#define TR_SRC(it_) (W + (size_t)((it_) / per) * sstride + (size_t)(64 * (((it_) % per) / nblk) + kr) * N + 64 * (((it_) % per) % nblk) + 4 * nq)
    if (it < tot) { const float* s = TR_SRC(it);
#pragma unroll
        for (int i = 0; i < 16; ++i) v[i] = __builtin_nontemporal_load((const f32x4*)(s + (size_t)(4 * i) * N)); }
    while (it < tot) {
#pragma unroll
        for (int i = 0; i < 16; ++i) { LAS float* d = scr + (4 * i + kr) * 65 + 4 * nq; d[0] = v[i][0]; d[1] = v[i][1]; d[2] = v[i][2]; d[3] = v[i][3]; }
        const int nit = it + X.ngw;
        if (nit < tot) { const float* s = TR_SRC(nit);
#pragma unroll
            for (int i = 0; i < 16; ++i) v[i] = __builtin_nontemporal_load((const f32x4*)(s + (size_t)(4 * i) * N)); }
        asm volatile("s_waitcnt lgkmcnt(0)" ::: "memory");
        const int m = it / per, r = it - m * per, k0 = 64 * (r / nblk), n0 = 64 * (r % nblk);
        bf16* dst = WT + (size_t)m * dstride;
#pragma unroll
        for (int j = 0; j < 8; ++j) { const int n = nsub + 8 * j; const LAS float* s = scr + (8 * c) * 65 + n;
            v4u o; o.x = cvtpk_(s[0 * 65], s[1 * 65]); o.y = cvtpk_(s[2 * 65], s[3 * 65]); o.z = cvtpk_(s[4 * 65], s[5 * 65]); o.w = cvtpk_(s[6 * 65], s[7 * 65]);
            __builtin_nontemporal_store(o, (v4u*)(dst + (size_t)rowmap<MAP>(n0 + n) * K + k0 + 8 * c)); }
        asm volatile("s_waitcnt lgkmcnt(0)" ::: "memory");
        it = nit;
    }
#undef TR_SRC
}
struct Row8 { f32x4 a[2][2]; };
__device__ __forceinline__ void row8_load(Row8& r, const float* p, int lane) {
#pragma unroll
    for (int j = 0; j < 2; ++j) { const f32x4* q = (const f32x4*)p + 2 * (lane + 64 * j); r.a[j][0] = q[0]; r.a[j][1] = q[1]; }
}
__device__ __forceinline__ float row8_sumsq(const Row8& r) {
    float s = 0.f;
#pragma unroll
    for (int j = 0; j < 2; ++j)
#pragma unroll
        for (int h = 0; h < 2; ++h) s += (r.a[j][h].x * r.a[j][h].x + r.a[j][h].y * r.a[j][h].y) + (r.a[j][h].z * r.a[j][h].z + r.a[j][h].w * r.a[j][h].w);
    return s;
}
__device__ __forceinline__ void rms_row_to_bf16(const float* __restrict__ xrow, const float* __restrict__ g, bf16* __restrict__ orow, int lane) {
    const f32x4* xr = (const f32x4*)xrow + lane; f32x4 v[4]; float s = 0.f;
#pragma unroll
    for (int j = 0; j < 4; ++j) { v[j] = xr[64 * j]; s += (v[j].x * v[j].x + v[j].y * v[j].y) + (v[j].z * v[j].z + v[j].w * v[j].w); }
    const float r = rsqrtf(wave_sum(s) * (1.f / D) + 1e-6f);
    v2u* o8 = (v2u*)orow + lane;
#pragma unroll
    for (int j = 0; j < 4; ++j) { const f32x4 gg = ((const f32x4*)g)[lane + 64 * j]; v2u w; w.x = pk2(v[j].x * r * gg.x, v[j].y * r * gg.y); w.y = pk2(v[j].z * r * gg.z, v[j].w * r * gg.w); o8[64 * j] = w; }
}
__device__ __forceinline__ void p0_filters(const Ctx& X, const Args& a) {
    LAS float* z = (LAS float*)X.lds;
    LAS float* h1 = z + 32 * 36;
    LAS float* h2T = h1 + 32 * 64;
    LAS float* w1s = h2T + 64 * 32;
    LAS float* w2s = w1s + 33 * 64;
    bf16* FILT = (bf16*)(X.ws + WS_FILT);
    const float min_decay = logf(1e-2f) / 0.3f, max_decay = logf(1e-2f) / 1.5f;
    for (int it = X.bid; it < 2 * (S / 32); it += X.G) {
        int tid = X.tid; asm volatile("" : "+v"(tid));
        const int j = tid & 63, tq = tid >> 6;
        const int l = it / (S / 32), t0 = (it % (S / 32)) * 32;
        const float *w1 = a.in[6] + l * 33 * 64, *b1 = a.in[7] + l * 64, *f1 = a.in[8] + l * 64, *w2 = a.in[9] + l * 64 * 64, *b2 = a.in[10] + l * 64, *f2 = a.in[11] + l * 64, *w3 = a.in[12] + (size_t)l * 64 * 2048;
        __syncthreads();
        for (int e = tid; e < 33 * 64; e += NTH) w1s[e] = w1[e];
        for (int e = tid; e < 64 * 64; e += NTH) w2s[e] = w2[e];
        for (int e = tid; e < 32 * 33; e += NTH) { const int tt = e / 33, jj0 = e - tt * 33, t = t0 + tt; float v;
            if (jj0 == 0) v = (float)t / (float)(S - 1);
            else { const int jj = (jj0 - 1) & 15; const float w = 2.0f * 3.14159265358979323846f * (float)t / (float)S; const float fr = 1e-4f + (float)jj * ((15.0f - 1e-4f) / 15.0f); const float ang = w * fr; v = (jj0 <= 16) ? cosf(ang) : -sinf(ang); }
            z[tt * 36 + jj0] = v; }
        const float bb1 = b1[j], ff1 = f1[j], bb2 = b2[j], ff2 = f2[j];
        __syncthreads();
        { float acc[4] = {bb1, bb1, bb1, bb1};
          for (int i = 0; i < 33; ++i) { const float w = w1s[i * 64 + j];
#pragma unroll
              for (int k = 0; k < 4; ++k) acc[k] += z[(tq + 8 * k) * 36 + i] * w; }
#pragma unroll
          for (int k = 0; k < 4; ++k) h1[(tq + 8 * k) * 64 + j] = sinf(ff1 * acc[k]); }
        __syncthreads();
        { float acc[4] = {bb2, bb2, bb2, bb2};
          for (int i = 0; i < 64; ++i) { const float w = w2s[i * 64 + j];
#pragma unroll
              for (int k = 0; k < 4; ++k) acc[k] += h1[(tq + 8 * k) * 64 + i] * w; }
#pragma unroll
          for (int k = 0; k < 4; ++k) h2T[j * 32 + tq + 8 * k] = sinf(ff2 * acc[k]); }
        __syncthreads();
        { const int n0 = 4 * tid; f32x4 acc[32];
#pragma unroll
            for (int q = 0; q < 32; ++q) acc[q] = (f32x4){0.f, 0.f, 0.f, 0.f};
#pragma unroll 1
            for (int i0 = 0; i0 < 64; i0 += 16) { f32x4 w[16];
#pragma unroll
                for (int u = 0; u < 16; ++u) w[u] = *(const f32x4*)(w3 + (i0 + u) * 2048 + n0);
#pragma unroll
                for (int u = 0; u < 16; ++u) {
#pragma unroll
                    for (int g = 0; g < 8; ++g) { const f32x4 hh = *(const LAS f32x4*)(h2T + (i0 + u) * 32 + 4 * g); acc[4 * g] += w[u] * hh.x; acc[4 * g + 1] += w[u] * hh.y; acc[4 * g + 2] += w[u] * hh.z; acc[4 * g + 3] += w[u] * hh.w; } } }
            const int c0 = n0 & 511, od = n0 >> 9;
#pragma unroll
            for (int e = 0; e < 4; ++e) { const float delta = fabsf(min_decay + (float)(c0 + e) * ((max_decay - min_decay) / 511.0f));
#pragma unroll
                for (int g = 0; g < 4; ++g) { float o8[8];
#pragma unroll
                    for (int q = 0; q < 8; ++q) o8[q] = acc[8 * g + q][e] * expf(-((float)(t0 + 8 * g + q) / (float)(S - 1)) * delta);
                    v4u o; o.x = pk2(o8[0], o8[1]); o.y = pk2(o8[2], o8[3]); o.z = pk2(o8[4], o8[5]); o.w = pk2(o8[6], o8[7]);
                    *(v4u*)(FILT + (((size_t)l * 4 + od) * C + c0 + e) * S + t0 + 8 * g) = o; } } }
    }
    __syncthreads();
}
template <int MAP> __device__ __forceinline__ void p0_convert(const Ctx& X, const float* W, int K, int N, bf16* WB, int dN, int nmat, size_t sstride, size_t dstride, const float* __restrict__ rscale = nullptr) {
    const int nblk = N / 256, per = (K / 16) * nblk, tot = per * nmat, lane = X.lane;
    f32x4 v[16];
    int it = X.gw;
#define CV_SRC(it_) (W + (size_t)((it_) / per) * sstride + (size_t)(16 * (((it_) % per) / nblk)) * N + 256 * (((it_) % per) % nblk) + 4 * lane)
    if (it < tot) { const float* s = CV_SRC(it);
#pragma unroll
        for (int i = 0; i < 16; ++i) v[i] = __builtin_nontemporal_load((const f32x4*)(s + (size_t)i * N)); }
    while (it < tot) {
        v2u o[16];
        if (rscale) { const int k0s = 16 * ((it % per) / nblk);
#pragma unroll
            for (int i = 0; i < 16; ++i) { const float sc = rscale[k0s + i]; o[i].x = cvtpk_(v[i][0] * sc, v[i][1] * sc); o[i].y = cvtpk_(v[i][2] * sc, v[i][3] * sc); } }
        else {
#pragma unroll
        for (int i = 0; i < 16; ++i) { o[i].x = cvtpk_(v[i][0], v[i][1]); o[i].y = cvtpk_(v[i][2], v[i][3]); } }
        const int nit = it + X.ngw;
        if (nit < tot) { const float* s = CV_SRC(nit);
#pragma unroll
            for (int i = 0; i < 16; ++i) v[i] = __builtin_nontemporal_load((const f32x4*)(s + (size_t)i * N)); }
        const int mi = it / per, r = it - mi * per, k0 = 16 * (r / nblk), n = 256 * (r % nblk) + 4 * lane;
        const int dc = MAP == 0 ? n : (((n >> 7) << 8) + (n & 127) + (MAP == 3 ? 128 : 0));
        bf16* dst = WB + (size_t)mi * dstride + (size_t)k0 * dN + dc;
#pragma unroll
        for (int i = 0; i < 16; ++i) __builtin_nontemporal_store(o[i], (v2u*)(dst + (size_t)i * dN));
        it = nit;
    }
#undef CV_SRC
}
__device__ __forceinline__ void p0_experts(const Ctx& X, const Args& a, int l) {
    bf16* wgu = (bf16*)(X.ws + WS_WGU) + (size_t)l * E * 2 * F * D; bf16* wd = (bf16*)(X.ws + WS_WD) + (size_t)l * E * F * D;
    p0_convert<2>(X, a.in[25] + (size_t)l * E * D * F, D, F, wgu, 2 * F, E, (size_t)D * F, (size_t)2 * F * D, a.in[22] + l * D);
    p0_convert<3>(X, a.in[26] + (size_t)l * E * D * F, D, F, wgu, 2 * F, E, (size_t)D * F, (size_t)2 * F * D, a.in[22] + l * D);
    p0_convert<0>(X, a.in[27] + (size_t)l * E * D * F, F, D, wd, D, E, (size_t)F * D, (size_t)F * D);
}
#ifndef MK_P0_DUP
#define MK_P0_DUP 0
#endif
__device__ __forceinline__ void p0_prologue(const Ctx& X, const Args& a) {
    const int m = a.p0_mask;
    for (int dup_ = 0; dup_ < ((MK_P0_DUP & 1) ? 2 : 1); ++dup_)
    if (m & 1) {
        p0_transpose<1>(X, a.in[2], D, INW, (bf16*)(X.ws + WS_WIN), 2, (size_t)D * INW, (size_t)D * INW);
        p0_transpose<0>(X, a.in[19], C, D, (bf16*)(X.ws + WS_WUH), 2, (size_t)C * D, (size_t)2 * C * D);
        p0_transpose<0>(X, a.in[20], C, D, (bf16*)(X.ws + WS_WUA), 2, (size_t)C * D, (size_t)2 * C * D);
        p0_transpose<0>(X, a.in[21], D, D, (bf16*)(X.ws + WS_WOUT), 2, (size_t)D * D, (size_t)D * D);
        float* binp = (float*)(X.ws + WS_BINP);
        for (int i = X.gw * 64 + X.lane; i < 2 * INW; i += X.ngw * 64) { const int l = i / INW, n = i - l * INW; binp[l * INW + rowmap<1>(n)] = a.in[3][i]; }
        { bf16* wrp = (bf16*)(X.ws + WS_WRP);
          for (int i = X.gw * 64 + X.lane; i < 2 * E * D; i += X.ngw * 64) { const int l = i / (E * D), e = (i / D) % E, k = i % D; const float v = a.in[22][l * D + k] * a.in[23][((size_t)l * D + k) * E + e];
              const unsigned hi = f2bf(v); const float lo = v - __builtin_bit_cast(float, hi << 16); wrp[((l * 2 + 0) * E + e) * D + k] = (bf16)hi; wrp[((l * 2 + 1) * E + e) * D + k] = (bf16)f2bf(lo); } }
        float* rope = (float*)(X.ws + WS_ROPE);
        for (int i = X.gw * 64 + X.lane; i < S * 32; i += X.ngw * 64) { const int pos = i >> 5, j = i & 31; const float inv = powf(10000.0f, -(float)j * 2.0f / 64.0f); float sn, cs; sincosf((float)pos * inv, &sn, &cs); rope[2 * i] = cs; rope[2 * i + 1] = sn; }
    }
    if (m & 2) { p0_experts(X, a, 0); p0_experts(X, a, 1); }
    for (int dup_ = 0; dup_ < ((MK_P0_DUP & 4) ? 2 : 1); ++dup_)
    if (m & 4) p0_filters(X, a);
    for (int dup_ = 0; dup_ < ((MK_P0_DUP & 8) ? 2 : 1); ++dup_)
    if (m & 8) {
        bf16* XN = (bf16*)(X.ws + WS_XN); const int lane = X.lane; Row8 gg; row8_load(gg, a.in[1], lane);
        int r = X.gw; Row8 cur; if (r < T) row8_load(cur, a.in[0] + (size_t)r * D, lane);
        while (r < T) { const int nr = r + X.ngw; Row8 nxt; if (nr < T) row8_load(nxt, a.in[0] + (size_t)nr * D, lane);
            const float rs = rsqrtf(wave_sum(row8_sumsq(cur)) * (1.f / D) + 1e-6f);
#pragma unroll
            for (int j = 0; j < 2; ++j) { const f32x4 y0 = cur.a[j][0] * gg.a[j][0] * rs, y1 = cur.a[j][1] * gg.a[j][1] * rs;
                v4u w; w.x = pk2(y0.x, y0.y); w.y = pk2(y0.z, y0.w); w.z = pk2(y1.x, y1.y); w.w = pk2(y1.z, y1.w); ((v4u*)(XN + (size_t)r * D))[lane + 64 * j] = w; }
            cur = nxt; r = nr; }
    }
}
}
namespace mk {
using pg8::Unit;
#ifndef MK_SIMPLE_ORDER
#define MK_SIMPLE_ORDER 0
#endif
__device__ __forceinline__ unsigned cvtpk(float lo, float hi) { unsigned r; asm volatile("v_cvt_pk_bf16_f32 %0, %1, %2" : "=v"(r) : "v"(lo), "v"(hi)); return r; }
__device__ __forceinline__ v4u pack8(f32x4 a, f32x4 b) { v4u w; w.x = cvtpk(a[0], a[1]); w.y = cvtpk(a[2], a[3]); w.z = cvtpk(b[0], b[1]); w.w = cvtpk(b[2], b[3]); return w; }
__device__ __forceinline__ void unpack8(v4u w, f32x4& a, f32x4& b) { a = (f32x4){bflo(w.x), bfhi(w.x), bflo(w.y), bfhi(w.y)}; b = (f32x4){bflo(w.z), bfhi(w.z), bflo(w.w), bfhi(w.w)}; }
__device__ __forceinline__ float fsig(float x) { return __builtin_amdgcn_rcpf(1.f + __expf(-x)); }

struct EpiWin {
    static constexpr bool PERM = true, AFTER_DRAIN = false;
    unsigned char* ws; const float* bias; const float* rope;
    __device__ __forceinline__ void operator()(const f32x4 (&acc)[2][2][4][2], const Unit& u, int wr, int wc, int fr, int fq) const {
        const int colt = u.pn * 256, row0 = u.pm * 256 + wr * 64 + fr, cin = wc * 32 + 8 * fq;
        bf16* base; int ldc, col0, mode; float sc = 1.f;
        if (colt < 1536) { base = (bf16*)(ws + WS_U); ldc = 1536; col0 = colt; mode = 0; }
        else if (colt < 2048) { base = (bf16*)(ws + WS_Q); ldc = 512; col0 = colt - 1536; mode = 1; sc = QSCALE; }
        else if (colt < 2560) { base = (bf16*)(ws + WS_K); ldc = 512; col0 = colt - 2048; mode = 1; }
        else if (colt < 3072) { base = (bf16*)(ws + WS_V); ldc = 512; col0 = colt - 2560; mode = 0; }
        else if (colt < 4096) { base = (bf16*)(ws + WS_GH); ldc = 1024; col0 = colt - 3072; mode = 2; }
        else { base = (bf16*)(ws + WS_GA); ldc = 1024; col0 = colt - 4096; mode = 2; }
        f32x4 bv[2][2];
#pragma unroll
        for (int bj = 0; bj < 2; ++bj)
#pragma unroll
            for (int n = 0; n < 2; ++n) bv[bj][n] = *(const f32x4*)(bias + colt + bj * 128 + cin + 4 * n);
#pragma unroll
        for (int ai = 0; ai < 2; ++ai)
#pragma unroll
            for (int m = 0; m < 4; ++m) {
                const int row = row0 + ai * 128 + m * 16; bf16* rowp = base + (size_t)row * ldc + col0 + cin;
#pragma unroll
                for (int bj = 0; bj < 2; ++bj) {
                    f32x4 v0 = acc[ai][bj][m][0] + bv[bj][0], v1 = acc[ai][bj][m][1] + bv[bj][1];
                    if (mode == 1) {
                        const int i = ((bj * 128 + cin) & 63) >> 3; const float* rp = rope + ((size_t)(row & (S - 1)) * 32 + 4 * i) * 2;
                        const f32x4 r0 = *(const f32x4*)rp, r1 = *(const f32x4*)(rp + 4);
                        const f32x4 cs = {r0[0], r0[2], r1[0], r1[2]}, sn = {r0[1], r0[3], r1[1], r1[3]};
                        const f32x4 o1 = (v0 * cs - v1 * sn) * sc, o2 = (v1 * cs + v0 * sn) * sc; v0 = o1; v1 = o2;
                    } else if (mode == 2) {
#pragma unroll
                        for (int e = 0; e < 4; ++e) { v0[e] = fsig(v0[e]); v1[e] = fsig(v1[e]); }
                    }
                    *(v4u*)(rowp + bj * 128) = pack8(v0, v1);
                }
            }
    }
};
struct EpiMerge2 {
    static constexpr bool PERM = true, AFTER_DRAIN = false;
    const bf16* GH; const bf16* GA; bf16* T1; bf16* MG;
    __device__ __forceinline__ void operator()(const f32x4 (&acc)[2][2][4][2], const Unit& u, int wr, int wc, int fr, int fq) const {
        const int row0 = u.pm * 256 + wr * 64 + fr, col0 = u.pn * 256 + wc * 32 + 8 * fq; const bool second = u.pa != u.pm; const bf16* G = second ? GA : GH;
#pragma unroll
        for (int ai = 0; ai < 2; ++ai)
#pragma unroll
            for (int m = 0; m < 4; ++m) { const size_t off = (size_t)(row0 + ai * 128 + m * 16) * D + col0;
#pragma unroll
                for (int bj = 0; bj < 2; ++bj) { f32x4 g0, g1; unpack8(*(const v4u*)(G + off + bj * 128), g0, g1);
                    f32x4 v0 = acc[ai][bj][m][0] * g0, v1 = acc[ai][bj][m][1] * g1;
                    if (second) { f32x4 t0, t1; unpack8(*(const v4u*)(T1 + off + bj * 128), t0, t1); v0 += t0; v1 += t1; *(v4u*)(MG + off + bj * 128) = pack8(v0, v1); }
                    else *(v4u*)(T1 + off + bj * 128) = pack8(v0, v1); } }
    }
};
struct OrderMerge {
    pg8::StaticOrder so;
    __device__ __forceinline__ bool next(int i, Unit& u) const { if (!so.next(i >> 1, u)) return false; if (i & 1) { u.pa = u.pm + T / 256; u.pb = u.pn + 4; } return true; }
    __device__ __forceinline__ void a_ready(const Unit&) const {}
    __device__ __forceinline__ void done(const Unit&) const {}
};
struct EpiOut {
    static constexpr bool PERM = false, AFTER_DRAIN = false;
    const float* xin; float* X;
    __device__ __forceinline__ void operator()(const f32x4 (&acc)[2][2][4][2], const Unit& u, int wr, int wc, int fr, int fq) const {
        const int row0 = u.pm * 256 + wr * 64 + fr, col0 = u.pn * 256 + wc * 32 + 4 * fq;
#pragma unroll
        for (int ai = 0; ai < 2; ++ai)
#pragma unroll
            for (int m = 0; m < 4; ++m) { const size_t off = (size_t)(row0 + ai * 128 + m * 16) * D + col0;
#pragma unroll
                for (int bj = 0; bj < 2; ++bj)
#pragma unroll
                    for (int n = 0; n < 2; ++n) *(f32x4*)(X + off + bj * 128 + n * 16) = *(const f32x4*)(xin + off + bj * 128 + n * 16) + acc[ai][bj][m][n]; }
    }
};
struct EpiOutR {
    static constexpr bool PERM = true, AFTER_DRAIN = true;
    const float* xin; float* X; bf16* XB; float* PART; const bf16* WRP; unsigned* tick; float* AFFT; float* RTOK; const float* br;
    __device__ __forceinline__ void operator()(const f32x4 (&)[2][2][4][2], const Unit&, int, int, int, int) const {}
    __device__ __forceinline__ void fused(const f32x4 (&acc)[2][2][4][2], const Unit& u, int wr, int wc, int fr, int fq, LAS unsigned char* lds, int wid, int lane) const {
        LAS float* SS = (LAS float*)lds;
        LAS float* LG = (LAS float*)(lds + 16384);
        const int rowl0 = wr * 64 + fr, colw = wc * 32 + 8 * fq;
        bf16x8 whi[2], wlo[2];
#pragma unroll
        for (int bj = 0; bj < 2; ++bj) { const bf16* wp = WRP + (size_t)fr * D + u.pn * 256 + bj * 128 + colw; whi[bj] = *(const bf16x8*)wp; wlo[bj] = *(const bf16x8*)(wp + (size_t)E * D); }
#pragma unroll
        for (int ai = 0; ai < 2; ++ai)
#pragma unroll
            for (int m = 0; m < 4; ++m) { const int rowl = rowl0 + ai * 128 + m * 16; float ss = 0.f; f32x4 lg = {0.f, 0.f, 0.f, 0.f};
#pragma unroll
                for (int bj = 0; bj < 2; ++bj) { const size_t off = (size_t)(u.pm * 256 + rowl) * D + u.pn * 256 + bj * 128 + colw;
                    const f32x4 x0 = *(const f32x4*)(xin + off) + acc[ai][bj][m][0], x1 = *(const f32x4*)(xin + off + 4) + acc[ai][bj][m][1];
                    *(f32x4*)(X + off) = x0; *(f32x4*)(X + off + 4) = x1;
                    const v4u hi = pack8(x0, x1); *(v4u*)(XB + off) = hi;
                    f32x4 h0, h1; unpack8(hi, h0, h1); const v4u lo = pack8(x0 - h0, x1 - h1);
                    ss += ((x0[0] * x0[0] + x0[1] * x0[1]) + (x0[2] * x0[2] + x0[3] * x0[3])) + ((x1[0] * x1[0] + x1[1] * x1[1]) + (x1[2] * x1[2] + x1[3] * x1[3]));
                    lg = __builtin_amdgcn_mfma_f32_16x16x32_bf16(whi[bj], __builtin_bit_cast(bf16x8, hi), lg, 0, 0, 0);
                    lg = __builtin_amdgcn_mfma_f32_16x16x32_bf16(whi[bj], __builtin_bit_cast(bf16x8, lo), lg, 0, 0, 0);
                    lg = __builtin_amdgcn_mfma_f32_16x16x32_bf16(wlo[bj], __builtin_bit_cast(bf16x8, hi), lg, 0, 0, 0); }
                SS[rowl * 16 + wc * 4 + fq] = ss;
                *(LAS f32x4*)(LG + ((wc * 256 + rowl) * 16 + 4 * fq)) = lg; }
        __syncthreads();
        const int t = wid * 64 + lane;
        if (t < 256) { float s = 0.f;
#pragma unroll
            for (int i = 0; i < 4; ++i) { const f32x4 v = *(const LAS f32x4*)(SS + t * 16 + 4 * i); s += (v[0] + v[1]) + (v[2] + v[3]); }
            float* pp = PART + ((size_t)u.pn * T + u.pm * 256 + t) * 20;
            __hip_atomic_store(pp, s, __ATOMIC_RELAXED, __HIP_MEMORY_SCOPE_AGENT);
#pragma unroll
            for (int i = 0; i < 4; ++i) { f32x4 a4 = *(const LAS f32x4*)(LG + (t * 16 + 4 * i));
#pragma unroll
                for (int w = 1; w < 4; ++w) a4 += *(const LAS f32x4*)(LG + ((w * 256 + t) * 16 + 4 * i));
#pragma unroll
                for (int q = 0; q < 4; ++q) __hip_atomic_store(pp + 4 + 4 * i + q, a4[q], __ATOMIC_RELAXED, __HIP_MEMORY_SCOPE_AGENT); } }
        asm volatile("s_waitcnt vmcnt(0)" ::: "memory");
        __syncthreads();
        LAS int* flag = (LAS int*)(lds + 16384 + 65536);
        if (t == 0) flag[0] = (int)__hip_atomic_fetch_add(tick + u.pm, 1u, __ATOMIC_RELAXED, __HIP_MEMORY_SCOPE_AGENT);
        __syncthreads();
        if (flag[0] == 3) {
            if (t < 256) { const int tok = u.pm * 256 + t; f32x4 s4 = {0.f, 0.f, 0.f, 0.f}, l4[4];
#pragma unroll
                for (int j = 0; j < 4; ++j) l4[j] = (f32x4){0.f, 0.f, 0.f, 0.f};
#pragma unroll
                for (int pn = 0; pn < 4; ++pn) { const float* pq = PART + ((size_t)pn * T + tok) * 20; s4[0] += __hip_atomic_load(pq, __ATOMIC_RELAXED, __HIP_MEMORY_SCOPE_AGENT);
#pragma unroll
                    for (int j = 0; j < 4; ++j)
#pragma unroll
                        for (int q = 0; q < 4; ++q) l4[j][q] += __hip_atomic_load(pq + 4 + 4 * j + q, __ATOMIC_RELAXED, __HIP_MEMORY_SCOPE_AGENT); }
                const float r = rsqrtf(s4[0] * (1.f / D) + 1e-6f); float mx = -1e30f;
#pragma unroll
                for (int j = 0; j < 4; ++j)
#pragma unroll
                    for (int q = 0; q < 4; ++q) { const float v = l4[j][q] * r + br[4 * j + q]; l4[j][q] = v; mx = fmaxf(mx, v); }
                float l = 0.f;
#pragma unroll
                for (int j = 0; j < 4; ++j)
#pragma unroll
                    for (int q = 0; q < 4; ++q) { l4[j][q] = expf(l4[j][q] - mx); l += l4[j][q]; }
                const int b = tok >> 12, s_ = tok & (S - 1);
#pragma unroll
                for (int j = 0; j < 4; ++j)
#pragma unroll
                    for (int q = 0; q < 4; ++q) AFFT[((size_t)b * E + 4 * j + q) * S + s_] = l4[j][q] / l;
                RTOK[tok] = r; } }
        __syncthreads();
    }
};
struct EpiSwiGLU {
    static constexpr bool PERM = true, AFTER_DRAIN = false;
    bf16* HB; const float* RSL;
    __device__ __forceinline__ void operator()(const f32x4 (&acc)[2][2][4][2], const Unit& u, int wr, int wc, int fr, int fq) const {
        const int row0 = u.pm * 256 + wr * 64 + fr, col0 = u.pn * 128 + wc * 32 + 8 * fq;
#pragma unroll
        for (int ai = 0; ai < 2; ++ai)
#pragma unroll
            for (int m = 0; m < 4; ++m) { f32x4 h[2]; const float rr = RSL[row0 + ai * 128 + m * 16];
#pragma unroll
                for (int n = 0; n < 2; ++n) { const f32x4 g = acc[ai][0][m][n] * rr, up = acc[ai][1][m][n] * rr;
#pragma unroll
                    for (int e = 0; e < 4; ++e) h[n][e] = g[e] * fsig(g[e]) * up[e]; }
                *(v4u*)(HB + (size_t)(row0 + ai * 128 + m * 16) * F + col0) = pack8(h[0], h[1]); }
    }
};
struct EpiDown {
    static constexpr bool PERM = true, AFTER_DRAIN = false;
    bf16* YE; const float* gate;
    __device__ __forceinline__ void operator()(const f32x4 (&acc)[2][2][4][2], const Unit& u, int wr, int wc, int fr, int fq) const {
        const int row0 = u.pm * 256 + wr * 64 + fr, col0 = u.pn * 256 + wc * 32 + 8 * fq;
#pragma unroll
        for (int ai = 0; ai < 2; ++ai)
#pragma unroll
            for (int m = 0; m < 4; ++m) { const int row = row0 + ai * 128 + m * 16; const float g = gate[row];
#pragma unroll
                for (int bj = 0; bj < 2; ++bj) *(v4u*)(YE + (size_t)row * D + col0 + bj * 128) = pack8(acc[ai][bj][m][0] * g, acc[ai][bj][m][1] * g); }
    }
};
struct OrderMoE1 {
    int G, c;
    __device__ __forceinline__ bool next(int i, Unit& u) const {
        if (MK_SIMPLE_ORDER || G != 256) { const int L = i * G + c; if (L >= 2048) return false; const int e = L >> 7, r = L & 127; u.pm = e * 8 + (r & 7); u.pn = r >> 3; u.pb = e * 16 + u.pn; u.pa = u.pm; return true; }
        if (i >= 8) return false;
        const int ch = i * 8 + (c & 7), j = c >> 3, e = ch >> 2, ng = ch & 3; u.pm = e * 8 + (j & 7); u.pn = ng * 4 + (j >> 3); u.pb = e * 16 + u.pn; u.pa = u.pm; return true;
    }
    __device__ __forceinline__ void a_ready(const Unit&) const {}
    __device__ __forceinline__ void done(const Unit&) const {}
};
struct OrderMoE2 {
    int G, c;
    __device__ __forceinline__ bool next(int i, Unit& u) const {
        if (MK_SIMPLE_ORDER || G != 256) { const int L = i * G + c; if (L >= 512) return false; const int e = L >> 5, r = L & 31; u.pm = e * 8 + (r & 7); u.pn = r >> 3; u.pb = e * 4 + u.pn; u.pa = u.pm; return true; }
        if (i >= 2) return false;
        const int e = i * 8 + (c & 7), j = c >> 3; u.pm = e * 8 + (j & 7); u.pn = j >> 3; u.pb = e * 4 + u.pn; u.pa = u.pm; return true;
    }
    __device__ __forceinline__ void a_ready(const Unit&) const {}
    __device__ __forceinline__ void done(const Unit&) const {}
};

__device__ __forceinline__ void p6_topk(const Ctx& X) {
    const float* afft = (const float*)(X.ws + WS_AFFT); const float* rtok = (const float*)(X.ws + WS_RTOK); int* rows = (int*)(X.ws + WS_ROWS); float* gate = (float*)(X.ws + WS_GATE); float* rsl = (float*)(X.ws + WS_RSL); int* inv = (int*)(X.ws + WS_INV);
    for (int p = X.bid; p < B * E; p += X.G) { const int b = p >> 4, e = p & 15, slotbase = e * 2048 + b * 512;
        unsigned key[8]; float rr[8];
        { const uint4 k0 = ((const uint4*)(afft + (size_t)p * S))[X.tid * 2], k1 = ((const uint4*)(afft + (size_t)p * S))[X.tid * 2 + 1]; const f32x4 r0 = ((const f32x4*)(rtok + b * S))[X.tid * 2], r1 = ((const f32x4*)(rtok + b * S))[X.tid * 2 + 1];
          key[0] = k0.x; key[1] = k0.y; key[2] = k0.z; key[3] = k0.w; key[4] = k1.x; key[5] = k1.y; key[6] = k1.z; key[7] = k1.w;
          rr[0] = r0[0]; rr[1] = r0[1]; rr[2] = r0[2]; rr[3] = r0[3]; rr[4] = r1[0]; rr[5] = r1[1]; rr[6] = r1[2]; rr[7] = r1[3]; }
        tk::topk_problem(key, rr, b * S, e, slotbase, rows + slotbase, gate + slotbase, rsl + slotbase, inv, (int*)(X.lds), X.tid); }
}
__device__ __forceinline__ void p9_combine(const Ctx& X, float* Xr, const float* __restrict__ g, bool final_, float* __restrict__ out) {
    const int* inv = (const int*)(X.ws + WS_INV); const bf16* YE = (const bf16*)(X.ws + WS_YE); bf16* XN = (bf16*)(X.ws + WS_XN); const int lane = X.lane;
    Row8 gg; row8_load(gg, g, lane);
    int tok = X.gw; Row8 cur; int myinv = -1;
    if (tok < T) { row8_load(cur, Xr + (size_t)tok * D, lane); if (lane < 16) myinv = inv[(size_t)tok * E + lane]; }
    while (tok < T) {
        const int ntok = tok + X.ngw; Row8 nxt; int ninv = -1;
        if (ntok < T) { row8_load(nxt, Xr + (size_t)ntok * D, lane); if (lane < 16) ninv = inv[(size_t)ntok * E + lane]; }
        unsigned long long m = __ballot(myinv >= 0);
        while (m) {
            int sl[4];
#pragma unroll
            for (int i = 0; i < 4; ++i) { if (m) { const int e = __builtin_ctzll(m); m &= m - 1; sl[i] = __builtin_amdgcn_readlane(myinv, e); } else sl[i] = -1; }
            v4u y[4][2];
#pragma unroll
            for (int i = 0; i < 4; ++i) if (sl[i] >= 0) { const v4u* yp = (const v4u*)(YE + (size_t)sl[i] * D); y[i][0] = __builtin_nontemporal_load(yp + lane); y[i][1] = __builtin_nontemporal_load(yp + lane + 64); }
#pragma unroll
            for (int i = 0; i < 4; ++i) if (sl[i] >= 0) {
#pragma unroll
                for (int j = 0; j < 2; ++j) { f32x4 p, q; unpack8(y[i][j], p, q); cur.a[j][0] += p; cur.a[j][1] += q; } }
        }
        const float r = rsqrtf(wave_sum(row8_sumsq(cur)) * (1.f / D) + 1e-6f);
        if (final_) {
#pragma unroll
            for (int j = 0; j < 2; ++j)
#pragma unroll
                for (int h = 0; h < 2; ++h) ((f32x4*)(out + (size_t)tok * D))[2 * (lane + 64 * j) + h] = cur.a[j][h] * gg.a[j][h] * r;
        } else {
#pragma unroll
            for (int j = 0; j < 2; ++j) {
#pragma unroll
                for (int h = 0; h < 2; ++h) ((f32x4*)(Xr + (size_t)tok * D))[2 * (lane + 64 * j) + h] = cur.a[j][h];
                const f32x4 y0 = cur.a[j][0] * gg.a[j][0] * r, y1 = cur.a[j][1] * gg.a[j][1] * r;
                v4u w; w.x = pk2(y0.x, y0.y); w.y = pk2(y0.z, y0.w); w.z = pk2(y1.x, y1.y); w.w = pk2(y1.z, y1.w);
                ((v4u*)(XN + (size_t)tok * D))[lane + 64 * j] = w; }
        }
        cur = nxt; myinv = ninv; tok = ntok;
    }
}
}
namespace mk {
__device__ __forceinline__ void p1t_shortconv(const Ctx& X, const float* __restrict__ cw, const float* __restrict__ cb) {
    const bf16* U = (const bf16*)(X.ws + WS_U); bf16* UCT = (bf16*)(X.ws + WS_UCT);
    LAS float* raw = (LAS float*)(X.lds + X.wave * 17408);
    const int lane = X.lane, rq = lane >> 3, cq = lane & 7;
    constexpr int NIT = (T / 64) * 24;
    v4u w[9];
#define P1T_LOAD(it_) do { const int tt_ = (it_) / 24, cg_ = (it_) - tt_ * 24, tok0_ = tt_ * 64, tin_ = tok0_ & (S - 1); \
        _Pragma("unroll") for (int i = 0; i < 9; ++i) { const int r = 8 * i + rq, tpos = tin_ + r - 1; w[i] = (v4u){0u, 0u, 0u, 0u}; \
            if (r < 66 && tpos >= 0 && tpos < S) w[i] = *(const v4u*)(U + (size_t)(tok0_ + r - 1) * 1536 + cg_ * 64 + 8 * cq); } } while (0)
    int it = X.gw;
    if (it < NIT) P1T_LOAD(it);
    while (it < NIT) {
        const int tt = it / 24, cg = it - tt * 24, tok0 = tt * 64, ch0 = cg * 64;
#pragma unroll
        for (int i = 0; i < 9; ++i) { const int r = 8 * i + rq; if (r < 66) { LAS float* d = raw + r * 65 + 8 * cq; f32x4 p, q; unpack8(w[i], p, q);
            d[0] = p.x; d[1] = p.y; d[2] = p.z; d[3] = p.w; d[4] = q.x; d[5] = q.y; d[6] = q.z; d[7] = q.w; } }
        const int nit = it + X.ngw;
        if (nit < NIT) P1T_LOAD(nit);
        asm volatile("s_waitcnt lgkmcnt(0)" ::: "memory");
        const int chs = lane >> 3, tch = lane & 7;
#pragma unroll
        for (int g = 0; g < 8; ++g) { const int ch = 8 * g + chs, gc = ch0 + ch; const float w0 = cw[gc], w1 = cw[1536 + gc], w2 = cw[3072 + gc], bb = cb[gc];
            float v[10];
#pragma unroll
            for (int k = 0; k < 10; ++k) v[k] = raw[(8 * tch + k) * 65 + ch];
            float o[8];
#pragma unroll
            for (int k = 0; k < 8; ++k) o[k] = v[k] * w0 + v[k + 1] * w1 + v[k + 2] * w2 + bb;
            v4u pk; pk.x = pk2(o[0], o[1]); pk.y = pk2(o[2], o[3]); pk.z = pk2(o[4], o[5]); pk.w = pk2(o[6], o[7]);
            *(v4u*)(UCT + (size_t)gc * T + tok0 + 8 * tch) = pk; }
        asm volatile("s_waitcnt lgkmcnt(0)" ::: "memory");
        it = nit;
    }
#undef P1T_LOAD
}

__device__ __forceinline__ void p1t_kmax(const Ctx& X, unsigned* kmax2) {
    const bf16* K = (const bf16*)(X.ws + WS_K); const int lane = X.lane; LAS float* red = (LAS float*)(X.lds + 8 * 17408);
    const int b = X.gw / 512, t0 = X.gw % 512; float mx = 0.f;
    if (b < B) {
        v4u w[8];
#pragma unroll
        for (int i = 0; i < 8; ++i) w[i] = ((const v4u*)(K + ((size_t)b * S + t0 + 512 * i) * 512))[lane];
#pragma unroll
        for (int i = 0; i < 8; ++i) { f32x4 p, q; unpack8(w[i], p, q); float ss = (p.x * p.x + p.y * p.y) + (p.z * p.z + p.w * p.w) + (q.x * q.x + q.y * q.y) + (q.z * q.z + q.w * q.w);
            ss += xor_f<1>(ss); ss += xor_f<2>(ss); ss += xor_f<4>(ss); mx = fmaxf(mx, ss); }
    }
    __syncthreads();
    if ((lane & 7) == 0) red[X.wave * 8 + (lane >> 3)] = mx;
    __syncthreads();
    if (X.tid < 8 && b < B) { float m = red[X.tid]; for (int w_ = 1; w_ < 8; ++w_) m = fmaxf(m, red[w_ * 8 + X.tid]); atomicMax(kmax2 + b * 8 + X.tid, __float_as_uint(m)); }
}

namespace at {
constexpr int KVBLK = 64, LDK = 512;
constexpr int KPITCH = 272;
constexpr int SHM_V = 64 * 128 * 2, SHM_K = 64 * KPITCH;
constexpr int OFF_V = 0, OFF_K = 2 * SHM_V, OFF_Q = OFF_K + 2 * SHM_K, OFF_WS = OFF_Q + 256 * KPITCH, LDS_TOTAL = OFF_WS + 8 * 160 * 4;
constexpr float THR2 = 8.0f * 1.4426950408889634f;
#define KSWZ(row, colB) ((row) * KPITCH + (colB))
#define SBAR() __builtin_amdgcn_sched_barrier(0)
__device__ __forceinline__ int crow(int r, int hi) { return (r & 3) + 8 * (r >> 2) + 4 * hi; }
__device__ __forceinline__ int v_st(int k, int c) { const int kk = (k & ~0xC) | ((k & 4) << 1) | ((k & 8) >> 1); return ((kk >> 3) * 4 + (c >> 5)) * 512 + ((kk & 7) * 32 + (c & 31)) * 2; }
__device__ __forceinline__ int v_rd_base(int lane) { return ((lane & 3) << 3) | (((lane >> 2) & 3) << 6) | (((lane >> 4) & 1) << 5) | (((lane >> 5) & 1) << 8); }
constexpr int v_rd_off(int d0, int ks, int half) { return d0 * 512 + ks * 4096 + half * 2048; }
template <int OFF> __device__ __forceinline__ s16x4 tr_read(int vb) { s16x4 r; asm volatile("ds_read_b64_tr_b16 %0, %1 offset:%2" : "=&v"(r) : "v"(vb), "i"(OFF) : "memory"); return r; }

template <int CO> __device__ __forceinline__ void qkt(f32x16& p0, f32x16& p1, const char* Ks, const char* Qs, int qrow, int r32, int hi) {
    p0 = f32x16{}; p1 = f32x16{};
    const char* qp = Qs + KSWZ(qrow, (CO * 64 + hi * 8) * 2); const char* kp = Ks + KSWZ(r32, (CO * 64 + hi * 8) * 2);
#pragma unroll
    for (int d0 = 0; d0 < 4; ++d0) {
        const bf16x8 qf = *reinterpret_cast<const bf16x8*>(qp + d0 * 32);
        const bf16x8 b0 = *reinterpret_cast<const bf16x8*>(kp + d0 * 32);
        const bf16x8 b1 = *reinterpret_cast<const bf16x8*>(kp + 32 * KPITCH + d0 * 32);
        p0 = __builtin_amdgcn_mfma_f32_32x32x16_bf16(b0, qf, p0, 0, 0, 0);
        p1 = __builtin_amdgcn_mfma_f32_32x32x16_bf16(b1, qf, p1, 0, 0, 0);
        if (d0 == 1) asm volatile("" ::: "memory"); }
}
__device__ __forceinline__ void softmax_tile(f32x16& p0, f32x16& p1, float& m_reg, float& l_reg, float& alpha, bf16x8& pa0, bf16x8& pa1, bf16x8& pa2, bf16x8& pa3) {
    float pmax = p0[0];
#pragma unroll
    for (int r = 1; r < 16; ++r) pmax = fmaxf(pmax, p0[r]);
#pragma unroll
    for (int r = 0; r < 16; ++r) pmax = fmaxf(pmax, p1[r]);
    { auto rr = __builtin_amdgcn_permlane32_swap(__float_as_uint(pmax), __float_as_uint(pmax), false, false); pmax = fmaxf(__uint_as_float(rr[0]), __uint_as_float(rr[1])); }
    float mn;
    if (__builtin_expect(__all(pmax - m_reg <= THR2), 1)) { mn = m_reg; alpha = 1.f; }
    else { mn = fmaxf(m_reg, pmax); alpha = __builtin_amdgcn_exp2f(m_reg - mn); m_reg = mn; }
#pragma unroll
    for (int r = 0; r < 16; ++r) { p0[r] = __builtin_amdgcn_exp2f(p0[r] - mn); p1[r] = __builtin_amdgcn_exp2f(p1[r] - mn); }
    float ps = 0.f;
#pragma unroll
    for (int r = 0; r < 16; ++r) ps += p0[r];
#pragma unroll
    for (int r = 0; r < 16; ++r) ps += p1[r];
    { auto rr = __builtin_amdgcn_permlane32_swap(__float_as_uint(ps), __float_as_uint(ps), false, false); ps = __uint_as_float(rr[0]) + __uint_as_float(rr[1]); }
    l_reg = l_reg * alpha + ps;
#define PK4(P, BASE, OUT) do { unsigned a0 = cvtpk(P[BASE + 0], P[BASE + 1]), a1 = cvtpk(P[BASE + 2], P[BASE + 3]);   \
    unsigned b0 = cvtpk(P[BASE + 4], P[BASE + 5]), b1 = cvtpk(P[BASE + 6], P[BASE + 7]);                              \
    auto r0 = __builtin_amdgcn_permlane32_swap(a0, b0, false, false); auto r1 = __builtin_amdgcn_permlane32_swap(a1, b1, false, false); \
    v4u w = {r0[0], r1[0], r0[1], r1[1]}; OUT = *reinterpret_cast<bf16x8*>(&w); } while (0)
    PK4(p0, 0, pa0); PK4(p0, 8, pa1); PK4(p1, 0, pa2); PK4(p1, 8, pa3);
#undef PK4
}
__device__ __forceinline__ void softmax_fixed(f32x16& p0, f32x16& p1, float m, float& l_half, bf16x8& pa0, bf16x8& pa1, bf16x8& pa2, bf16x8& pa3) {
#pragma unroll
    for (int r = 0; r < 16; ++r) { p0[r] = __builtin_amdgcn_exp2f(p0[r] - m); p1[r] = __builtin_amdgcn_exp2f(p1[r] - m); }
    float ps = 0.f;
#pragma unroll
    for (int r = 0; r < 16; ++r) ps += p0[r] + p1[r];
    l_half += ps;
#define PK4(P, BASE, OUT) do { unsigned a0 = cvtpk(P[BASE + 0], P[BASE + 1]), a1 = cvtpk(P[BASE + 2], P[BASE + 3]);   \
    unsigned b0 = cvtpk(P[BASE + 4], P[BASE + 5]), b1 = cvtpk(P[BASE + 6], P[BASE + 7]);                              \
    auto r0 = __builtin_amdgcn_permlane32_swap(a0, b0, false, false); auto r1 = __builtin_amdgcn_permlane32_swap(a1, b1, false, false); \
    v4u w = {r0[0], r1[0], r0[1], r1[1]}; OUT = *reinterpret_cast<bf16x8*>(&w); } while (0)
    PK4(p0, 0, pa0); PK4(p0, 8, pa1); PK4(p1, 0, pa2); PK4(p1, 8, pa3);
#undef PK4
}
template <int D0> __device__ __forceinline__ void pv_one(f32x16& oa, int vb, const bf16x8 (&pa)[4]) {
#define PK(L, H) (bf16x8){L[0], L[1], L[2], L[3], H[0], H[1], H[2], H[3]}
    {   const s16x4 l0 = tr_read<v_rd_off(D0, 0, 0)>(vb), h0 = tr_read<v_rd_off(D0, 0, 1)>(vb), l1 = tr_read<v_rd_off(D0, 1, 0)>(vb), h1 = tr_read<v_rd_off(D0, 1, 1)>(vb);
        asm volatile("s_waitcnt lgkmcnt(0)" ::: "memory"); SBAR();
        oa = __builtin_amdgcn_mfma_f32_32x32x16_bf16(pa[0], PK(l0, h0), oa, 0, 0, 0);
        oa = __builtin_amdgcn_mfma_f32_32x32x16_bf16(pa[1], PK(l1, h1), oa, 0, 0, 0); }
    {   const s16x4 l2 = tr_read<v_rd_off(D0, 2, 0)>(vb), h2 = tr_read<v_rd_off(D0, 2, 1)>(vb), l3 = tr_read<v_rd_off(D0, 3, 0)>(vb), h3 = tr_read<v_rd_off(D0, 3, 1)>(vb);
        asm volatile("s_waitcnt lgkmcnt(0)" ::: "memory"); SBAR();
        oa = __builtin_amdgcn_mfma_f32_32x32x16_bf16(pa[2], PK(l2, h2), oa, 0, 0, 0);
        oa = __builtin_amdgcn_mfma_f32_32x32x16_bf16(pa[3], PK(l3, h3), oa, 0, 0, 0); }
#undef PK
}
template <int D0> __device__ __forceinline__ void pv_two(f32x16& oa, f32x16& ob, int vb, const bf16x8 (&pa)[4], const bf16x8 (&pb)[4]) {
#define PK(L, H) (bf16x8){L[0], L[1], L[2], L[3], H[0], H[1], H[2], H[3]}
    {   const s16x4 l0 = tr_read<v_rd_off(D0, 0, 0)>(vb), h0 = tr_read<v_rd_off(D0, 0, 1)>(vb), l1 = tr_read<v_rd_off(D0, 1, 0)>(vb), h1 = tr_read<v_rd_off(D0, 1, 1)>(vb);
        asm volatile("s_waitcnt lgkmcnt(0)" ::: "memory"); SBAR();
        const bf16x8 v0 = PK(l0, h0), v1 = PK(l1, h1);
        oa = __builtin_amdgcn_mfma_f32_32x32x16_bf16(pa[0], v0, oa, 0, 0, 0); ob = __builtin_amdgcn_mfma_f32_32x32x16_bf16(pb[0], v0, ob, 0, 0, 0);
        oa = __builtin_amdgcn_mfma_f32_32x32x16_bf16(pa[1], v1, oa, 0, 0, 0); ob = __builtin_amdgcn_mfma_f32_32x32x16_bf16(pb[1], v1, ob, 0, 0, 0); }
    {   const s16x4 l2 = tr_read<v_rd_off(D0, 2, 0)>(vb), h2 = tr_read<v_rd_off(D0, 2, 1)>(vb), l3 = tr_read<v_rd_off(D0, 3, 0)>(vb), h3 = tr_read<v_rd_off(D0, 3, 1)>(vb);
        asm volatile("s_waitcnt lgkmcnt(0)" ::: "memory"); SBAR();
        const bf16x8 v2 = PK(l2, h2), v3 = PK(l3, h3);
        oa = __builtin_amdgcn_mfma_f32_32x32x16_bf16(pa[2], v2, oa, 0, 0, 0); ob = __builtin_amdgcn_mfma_f32_32x32x16_bf16(pb[2], v2, ob, 0, 0, 0);
        oa = __builtin_amdgcn_mfma_f32_32x32x16_bf16(pa[3], v3, oa, 0, 0, 0); ob = __builtin_amdgcn_mfma_f32_32x32x16_bf16(pb[3], v3, ob, 0, 0, 0); }
#undef PK
}
__device__ __forceinline__ void rescale(f32x16 (&o)[4], float al, float* wsf, int r32, int hi) {
    if (__any(al < 1.f)) {
        if (hi == 0) wsf[r32] = al; asm volatile("s_waitcnt lgkmcnt(0)" ::: "memory");
#pragma unroll
        for (int r = 0; r < 16; ++r) { const float a = wsf[crow(r, hi)];
#pragma unroll
            for (int d = 0; d < 4; ++d) o[d][r] *= a; }
    }
}

__device__ __forceinline__ void epilogue(const Ctx& X, f32x16 (&oa)[4], f32x16 (&ob)[4], const float* wsf, int r32, int hi, int b, int h, int qb, float lam, float mul, const float* __restrict__ sg) {
    bf16* Yw = (bf16*)(X.ws + WS_YA) + ((size_t)b * S + qb * 256 + X.wave * 32) * 512 + h * 128;
    float gcol[4];
#pragma unroll
    for (int d = 0; d < 4; ++d) gcol[d] = sg[d * 32 + r32] * mul;
#pragma unroll
    for (int r = 0; r < 16; ++r) { const int orow = crow(r, hi); const float i0 = __builtin_amdgcn_rcpf(wsf[orow] + wsf[64 + orow]), i1 = lam * __builtin_amdgcn_rcpf(wsf[32 + orow] + wsf[96 + orow]);
        float v[4], ss = 0.f;
#pragma unroll
        for (int d = 0; d < 4; ++d) { v[d] = oa[d][r] * i0 - ob[d][r] * i1; ss += v[d] * v[d]; }
        ss += xor_f<1>(ss); ss += xor_f<2>(ss); ss += xor_f<4>(ss); ss += xor_f<8>(ss); ss += xor_f<16>(ss);
        const float rn = rsqrtf(ss * (1.f / 128.f) + 1e-5f);
#pragma unroll
        for (int d = 0; d < 4; ++d) Yw[(size_t)orow * 512 + d * 32 + r32] = (bf16)f2bf(v[d] * rn * gcol[d]); }
}
__device__ __forceinline__ int vkey(int T_, int lane) { const int kk = ((T_ >> 2) << 3) | ((lane & 31) >> 2); return (kk & ~0xC) | ((kk & 4) << 1) | ((kk & 8) >> 1); }
__device__ __forceinline__ int vcol(int T_, int lane) { return (T_ & 3) * 32 + (lane & 3) * 8; }
__device__ __forceinline__ void attn_unit(const Ctx& X, int b, int h, int qb, float lam, float mul, const float* __restrict__ sg, unsigned* kmax2) {
    char* lds = (char*)X.lds;
    const int tid = fresh_tid(X.wave_s);
    const int wid = X.wave, lane = tid & 63, r32 = lane & 31, hi = lane >> 5;
    const bf16* Qg = (const bf16*)(X.ws + WS_Q) + ((size_t)b * S + qb * 256) * LDK + h * 128;
    const bf16* Kh = (const bf16*)(X.ws + WS_K) + (size_t)b * S * LDK + h * 128;
    const bf16* Vh = (const bf16*)(X.ws + WS_V) + (size_t)b * S * LDK + h * 128;
    char* V_lds = lds + OFF_V; char* K_lds = lds + OFF_K; char* Q_lds = lds + OFF_Q;
    float* wsf = (float*)(lds + OFF_WS) + wid * 160;
    const int sr = tid >> 4, sc = (tid & 15) * 8, vst0 = v_st(sr, sc), vst1 = v_st(32 + sr, sc);
    const int vb0 = (int)(uintptr_t)V_lds + v_rd_base(lane);
#pragma unroll
    for (int i = 0; i < 8; ++i) { const int row = sr + 32 * i; *(bf16x8*)(Q_lds + KSWZ(row, sc * 2)) = *reinterpret_cast<const bf16x8*>(Qg + (size_t)row * LDK + sc); }
    bf16x8 st0, st1;
    const unsigned goff = (unsigned)(sr * LDK + sc) * 2u;
#define KLOAD(k0) do { const char* t_ = (const char*)Kh + (size_t)(k0) * (LDK * 2); st0 = *reinterpret_cast<const bf16x8*>(t_ + goff); st1 = *reinterpret_cast<const bf16x8*>(t_ + 32 * LDK * 2 + goff); } while (0)
#define VLOAD(k0) do { const char* t_ = (const char*)Vh + (size_t)(k0) * (LDK * 2); st0 = *reinterpret_cast<const bf16x8*>(t_ + goff); st1 = *reinterpret_cast<const bf16x8*>(t_ + 32 * LDK * 2 + goff); } while (0)
#define KWRITE(bb) do { *(bf16x8*)(K_lds + (bb) * SHM_K + KSWZ(sr, sc * 2)) = st0; *(bf16x8*)(K_lds + (bb) * SHM_K + KSWZ(32 + sr, sc * 2)) = st1; } while (0)
    const unsigned vsrc0 = (unsigned)(vkey(2 * wid + (lane >> 5), lane) * LDK + vcol(2 * wid + (lane >> 5), lane)) * 2u, vsrc1 = (unsigned)(vkey(2 * (wid + 8) + (lane >> 5), lane) * LDK + vcol(2 * (wid + 8) + (lane >> 5), lane)) * 2u;
#define VDMA(k0, bbn) do { const char* t_ = (const char*)Vh + (size_t)(k0) * (LDK * 2); LAS unsigned char* d_ = X.lds + OFF_V + (bbn) * SHM_V + wid * 1024; \
    __builtin_amdgcn_global_load_lds((const unsigned*)(t_ + vsrc0), (LAS unsigned*)d_, 16, 0, 0); __builtin_amdgcn_global_load_lds((const unsigned*)(t_ + vsrc1), (LAS unsigned*)(d_ + 8192), 16, 0, 0); } while (0)
    const unsigned ksrc = (unsigned)(wid * 8 * LDK * 2) + (unsigned)lane * 4u;
#define KDMA(k0, bbn) do { const char* t_ = (const char*)Kh + (size_t)(k0) * (LDK * 2) + ksrc; LAS unsigned char* d_ = X.lds + OFF_K + (bbn) * SHM_K + wid * 8 * KPITCH; \
    _Pragma("unroll") for (int i_ = 0; i_ < 8; ++i_) __builtin_amdgcn_global_load_lds((const unsigned*)(t_ + i_ * (LDK * 2)), (LAS unsigned*)(d_ + i_ * KPITCH), 4, 0, 0); } while (0)
#define VWRITE(bb) do { *(bf16x8*)(V_lds + (bb) * SHM_V + vst0) = st0; *(bf16x8*)(V_lds + (bb) * SHM_V + vst1) = st1; } while (0)
    float l0 = 0.f, l1 = 0.f; f32x16 oa[4] = {}, ob[4] = {};
    const int qrow = wid * 32 + r32; constexpr int NT = S / KVBLK;
    KDMA(0, 0); VDMA(0, 0); __syncthreads();
    float m0, m1;
    { float s0 = 0.f, s1 = 0.f;
#pragma unroll
      for (int d0 = 0; d0 < 8; ++d0) { const v4u w = *reinterpret_cast<const v4u*>(Q_lds + KSWZ(qrow, (d0 * 16 + hi * 8) * 2)); f32x4 p, q; unpack8(w, p, q);
          const float ss = (p.x * p.x + p.y * p.y) + (p.z * p.z + p.w * p.w) + (q.x * q.x + q.y * q.y) + (q.z * q.z + q.w * q.w); if (d0 < 4) s0 += ss; else s1 += ss; }
      wsf[hi * 64 + r32] = s0; wsf[hi * 64 + 32 + r32] = s1; asm volatile("s_waitcnt lgkmcnt(0)" ::: "memory");
      s0 += wsf[(hi ^ 1) * 64 + r32]; s1 += wsf[(hi ^ 1) * 64 + 32 + r32]; asm volatile("s_waitcnt lgkmcnt(0)" ::: "memory");
      const float k0 = __uint_as_float(__hip_atomic_load(kmax2 + b * 8 + h * 2, __ATOMIC_RELAXED, __HIP_MEMORY_SCOPE_AGENT)), k1 = __uint_as_float(__hip_atomic_load(kmax2 + b * 8 + h * 2 + 1, __ATOMIC_RELAXED, __HIP_MEMORY_SCOPE_AGENT));
      m0 = sqrtf(s0 * k0) * 1.001f + 1e-3f; m1 = sqrtf(s1 * k1) * 1.001f + 1e-3f; }
    for (int j = 0; j < NT; ++j) {
        const int bb = j & 1; const char* Ks = K_lds + bb * SHM_K;
        const int kn = (j + 1) * KVBLK;
        if (j + 1 < NT) { KDMA(kn, bb ^ 1); VDMA(kn, bb ^ 1); }
        const int vb = vb0 + bb * SHM_V;
        bf16x8 pa[4], pb[4];
        { f32x16 p0, p1, q0, q1;
          qkt<0>(p0, p1, Ks, Q_lds, qrow, r32, hi); qkt<1>(q0, q1, Ks, Q_lds, qrow, r32, hi);
          softmax_fixed(p0, p1, m0, l0, pa[0], pa[1], pa[2], pa[3]);
          softmax_fixed(q0, q1, m1, l1, pb[0], pb[1], pb[2], pb[3]); }
        SBAR();
        pv_two<0>(oa[0], ob[0], vb, pa, pb); pv_two<1>(oa[1], ob[1], vb, pa, pb); pv_two<2>(oa[2], ob[2], vb, pa, pb); pv_two<3>(oa[3], ob[3], vb, pa, pb);
        __syncthreads();
    }
#undef KLOAD
#undef VLOAD
#undef VDMA
#undef KDMA
#undef KWRITE
#undef VWRITE
    wsf[hi * 64 + r32] = l0; wsf[hi * 64 + 32 + r32] = l1; asm volatile("s_waitcnt lgkmcnt(0)" ::: "memory");
    { const int t2 = fresh_tid(X.wave_s); epilogue(X, oa, ob, wsf, t2 & 31, (t2 & 63) >> 5, b, h, qb, lam, mul, sg); }
    __syncthreads();
}
__device__ __forceinline__ void epilogue_unused() {}
#undef KSWZ
#undef SBAR
}
}
namespace mk {
namespace hy {
constexpr int CPS = 16704;
constexpr int NEL = 8352;
constexpr int OFF_Z = 4 * CPS;
constexpr int ZROW = 144, ZB = 128 * ZROW;
constexpr int LDS_TOTAL = OFF_Z + 4 * ZB;

__device__ __forceinline__ void build_hrev(const Ctx& X, const bf16* hf, const bf16* hb, float bias) {
    const int tid = X.tid;
    if (tid < 4 * 8) { const int m = tid >> 3, e = tid & 7; if (e < 5 - m) *(LAS bf16*)(X.lds + m * CPS + 2 * e) = 0; }
    for (int i = tid; i < 4 * (NEL - 8192); i += NTH) { const int m = i / (NEL - 8192), e = 8192 + (i - m * (NEL - 8192)); if (e > 8195 - m) *(LAS bf16*)(X.lds + m * CPS + 2 * e) = 0; }
#pragma unroll
    for (int half = 0; half < 2; ++half) {
        const v4u w = *(const v4u*)((half ? hb : hf) + 8 * tid);
        unsigned short v[8] = {(unsigned short)(w.x & 0xffff), (unsigned short)(w.x >> 16), (unsigned short)(w.y & 0xffff), (unsigned short)(w.y >> 16), (unsigned short)(w.z & 0xffff), (unsigned short)(w.z >> 16), (unsigned short)(w.w & 0xffff), (unsigned short)(w.w >> 16)};
        if (half == 0 && tid == 0) v[0] = (unsigned short)f2bf(bf2f(v[0]) + bias);
#pragma unroll
        for (int k = 0; k < 8; ++k) { const int d = 8 * tid + k; if (half == 1 && d == 0) continue;
            const int e0 = half ? 4100 + d : 4100 - d;
#pragma unroll
            for (int m = 0; m < 4; ++m) *(LAS bf16*)(X.lds + m * CPS + 2 * (e0 - m)) = v[k]; }
    }
}
#ifdef MK_HY_XLDS
#define HY_XL(qq) do { const v2u x0_ = *(const volatile LAS v2u*)(X.lds + baseA + 32 * (qq)), x1_ = *(const volatile LAS v2u*)(X.lds + baseA8 + 32 * (qq)); asm volatile("" :: "v"(x0_), "v"(x1_)); } while (0)
#else
#define HY_XL(qq) do {} while (0)
#endif
#define HY_LDA(dst, qq) do { HY_XL(qq); const v2u lo_ = *(const volatile LAS v2u*)(X.lds + baseA + 32 * (qq)), hi_ = *(const volatile LAS v2u*)(X.lds + baseA8 + 32 * (qq)); v4u w_ = {lo_.x, lo_.y, hi_.x, hi_.y}; dst = *reinterpret_cast<bf16x8*>(&w_); } while (0)
#define HY_LOAD_E(FA, FB, d1_, q_) do { const LAS unsigned char* zr_ = zb - (d1_) * ZROW; HY_LDA(FA[0], (q_)); HY_LDA(FA[1], (q_) + 1); \
    FB[0] = *(const LAS bf16x8*)(zr_); FB[1] = *(const LAS bf16x8*)(zr_ + 32); FB[2] = *(const LAS bf16x8*)(zr_ + 64); FB[3] = *(const LAS bf16x8*)(zr_ + 96); } while (0)
#define HY_LOAD_L(FA, q_) do { HY_LDA(FA[2], (q_) + 2); HY_LDA(FA[3], (q_) + 3); } while (0)
#ifdef MK_HY_XMFMA
#define HY_XM(A_, B_) do { dacc0 = __builtin_amdgcn_mfma_f32_32x32x16_bf16(A_, B_, dacc0, 0, 0, 0); } while (0)
#else
#define HY_XM(A_, B_) do {} while (0)
#endif
#define HY_MMA1(FA, FB, PA) do { __builtin_amdgcn_s_setprio(1); HY_XM(FA[0], FB[0]); HY_XM(PA[2], FB[0]); HY_XM(FA[1], FB[1]); HY_XM(PA[3], FB[1]); \
    acc0 = __builtin_amdgcn_mfma_f32_32x32x16_bf16(FA[0], FB[0], acc0, 0, 0, 0); acc1 = __builtin_amdgcn_mfma_f32_32x32x16_bf16(PA[2], FB[0], acc1, 0, 0, 0); \
    acc0 = __builtin_amdgcn_mfma_f32_32x32x16_bf16(FA[1], FB[1], acc0, 0, 0, 0); acc1 = __builtin_amdgcn_mfma_f32_32x32x16_bf16(PA[3], FB[1], acc1, 0, 0, 0); __builtin_amdgcn_s_setprio(0); } while (0)
#define HY_MMA2(FA, FB) do { __builtin_amdgcn_s_setprio(1); HY_XM(FA[2], FB[2]); HY_XM(FA[0], FB[2]); HY_XM(FA[3], FB[3]); HY_XM(FA[1], FB[3]); \
    acc0 = __builtin_amdgcn_mfma_f32_32x32x16_bf16(FA[2], FB[2], acc0, 0, 0, 0); acc1 = __builtin_amdgcn_mfma_f32_32x32x16_bf16(FA[0], FB[2], acc1, 0, 0, 0); \
    acc0 = __builtin_amdgcn_mfma_f32_32x32x16_bf16(FA[3], FB[3], acc0, 0, 0, 0); acc1 = __builtin_amdgcn_mfma_f32_32x32x16_bf16(FA[1], FB[3], acc1, 0, 0, 0); __builtin_amdgcn_s_setprio(0); } while (0)
template <int PAIR> __device__ __forceinline__ void channel(const Ctx& X, int l, int c, const float* __restrict__ hyb, v2u (&keep)[2][4]) {
    const bf16* UCT = (const bf16*)(X.ws + WS_UCT); const bf16* FILT = (const bf16*)(X.ws + WS_FILT) + (size_t)l * 4 * C * S; bf16* YH = (bf16*)(X.ws + WS_YH);
    const int tid = X.tid, lane = X.lane, wid = X.wave, r = lane & 31, h = lane >> 5, b = wid >> 1, jt = wid & 1;
    LAS unsigned char* zl = X.lds + OFF_Z;
    __syncthreads();
    v4u zero4 = {0u, 0u, 0u, 0u}; asm volatile("" : "+v"(zero4));
    for (int i = tid; i < 4 * 64 * 9; i += NTH) { const int bb = i / 576, rr = (i % 576) / 9, ch = i % 9; const int row = rr < 32 ? rr : 64 + rr;
        *(LAS v4u*)(zl + bb * ZB + row * ZROW + ch * 16) = zero4; }
    for (int i = tid; i < 4 * 64 * 8; i += NTH) { const int bb = i >> 9, s1 = (i >> 3) & 63, ch = i & 7;
        *(LAS v4u*)(zl + bb * ZB + (32 + s1) * ZROW + ch * 16) = *(const v4u*)(UCT + (size_t)c * T + bb * S + s1 * 64 + ch * 8); }
    const int m4 = (4 - (r & 3)) & 3;
    const int baseA = m4 * CPS + 2 * (8 * h - r + 4100 - m4);
    int baseA8 = baseA + 8; asm volatile("" : "+v"(baseA8));
    for (int o = 0; o < 2; ++o) {
        build_hrev(X, FILT + ((size_t)(2 * o) * C + c) * S, FILT + ((size_t)(2 * o + 1) * C + c) * S, hyb[(l * 2 + o) * C + c]);
#ifdef MK_HY_DUPBUILD
        asm volatile("" ::: "memory"); build_hrev(X, FILT + ((size_t)(2 * o) * C + c) * S, FILT + ((size_t)(2 * o + 1) * C + c) * S, hyb[(l * 2 + o) * C + c]);
#endif
        const bf16* gate = UCT + (size_t)((o + 1) * C + c) * T + (size_t)b * S;
        const int t1 = 32 * jt + r;
        v2u gw[2][4];
#pragma unroll
        for (int mt = 0; mt < 2; ++mt)
#pragma unroll
            for (int g = 0; g < 4; ++g) gw[mt][g] = *(const v2u*)(gate + t1 * 64 + 32 * mt + 8 * g + 4 * h);
        __syncthreads();
#ifndef MK_HY_SWEEPS
#define MK_HY_SWEEPS 1
#endif
        f32x16 acc0 = {}, acc1 = {};
#ifdef MK_HY_XMFMA
        f32x16 dacc0 = {};
#endif
        for (int rep = 0; rep < MK_HY_SWEEPS; ++rep) {
        const int d1max = 32 * jt + 31; int q = -4 * d1max;
        const LAS unsigned char* zb = zl + b * ZB + (32 + 32 * jt + r) * ZROW + 16 * h;
        bf16x8 fa0[4], fb0[4], fa1[4], fb1[4];
        HY_LDA(fa1[2], q - 2); HY_LDA(fa1[3], q - 1);
        HY_LOAD_E(fa0, fb0, d1max, q); HY_LOAD_L(fa0, q);
        int d1 = d1max;
        for (int it = 0; it < 47; ++it) {
            HY_LOAD_E(fa1, fb1, d1 - 1, q + 4);
            HY_MMA1(fa0, fb0, fa1);
            HY_LOAD_L(fa1, q + 4);
            HY_MMA2(fa0, fb0);
            HY_LOAD_E(fa0, fb0, d1 - 2, q + 8);
            HY_MMA1(fa1, fb1, fa0);
            HY_LOAD_L(fa0, q + 8);
            HY_MMA2(fa1, fb1);
            d1 -= 2; q += 8;
        }
        HY_MMA1(fa0, fb0, fa1); HY_MMA2(fa0, fb0);
        }
        if (MK_HY_SWEEPS == 2) { acc0 *= 0.5f; acc1 *= 0.5f; }
#ifdef MK_HY_XMFMA
        asm volatile("" :: "v"(dacc0));
#endif
        __syncthreads();
#pragma unroll
        for (int mt = 0; mt < 2; ++mt)
#pragma unroll
            for (int g = 0; g < 4; ++g) { const int t0 = 32 * mt + 8 * g + 4 * h; const v2u gwv = gw[mt][g];
                const f32x16& a = mt ? acc1 : acc0;
                const float y0 = a[4 * g] * bflo(gwv.x), y1 = a[4 * g + 1] * bfhi(gwv.x), y2 = a[4 * g + 2] * bflo(gwv.y), y3 = a[4 * g + 3] * bfhi(gwv.y);
                if (o == 0) { v2u w; w.x = pk2(y0, y1); w.y = pk2(y2, y3); *(LAS v2u*)(zl + b * ZB + (32 + t1) * ZROW + t0 * 2) = w; }
                else if (PAIR == 0) { keep[mt][g].x = pk2(y0, y1); keep[mt][g].y = pk2(y2, y3); }
                else { unsigned* yo = (unsigned*)(YH + ((size_t)b * S + t1 * 64 + t0) * C + (c - 1)); const v2u kp = keep[mt][g];
                    yo[0] = (kp.x & 0xffffu) | (f2bf(y0) << 16); yo[C / 2] = (kp.x >> 16) | (f2bf(y1) << 16); yo[C] = (kp.y & 0xffffu) | (f2bf(y2) << 16); yo[3 * C / 2] = (kp.y >> 16) | (f2bf(y3) << 16); } }
    }
    __syncthreads();
}
#undef HY_LDA
#undef HY_LOAD_E
#undef HY_LOAD_L
#undef HY_MMA1
#undef HY_MMA2
}
}
namespace mk {
#define GAS __attribute__((address_space(1)))
typedef GAS unsigned gu32;
typedef GAS unsigned long long gu64;
#define RLX_AGENT __ATOMIC_RELAXED, __HIP_MEMORY_SCOPE_AGENT
#define LDS_WAIT() asm volatile("s_waitcnt lgkmcnt(0)" ::: "memory")
#define VM_WAIT() asm volatile("s_waitcnt vmcnt(0)" ::: "memory")
__device__ __forceinline__ unsigned long long rt() { return __builtin_amdgcn_s_memrealtime(); }
#define XB_TMO      128
#define XB_XCNT(j)  (256  + 64 * (j))
#define XB_XSUB(j)  (1280 + 64 * (j))
#define XB_XGEN(j)  (2304 + 64 * (j))
#define XB_TOP      3328
#define XB_TOPGEN   3392
#define XCD_BAR_WORDS 3456
#define XB_SPIN_CAP (1u << 18)

__device__ __forceinline__ unsigned xb_ld(unsigned* p)              { return __hip_atomic_load(p, __ATOMIC_RELAXED, __HIP_MEMORY_SCOPE_AGENT); }
__device__ __forceinline__ unsigned xb_add(unsigned* p, unsigned v) { return __hip_atomic_fetch_add(p, v, __ATOMIC_RELAXED, __HIP_MEMORY_SCOPE_AGENT); }
__device__ __forceinline__ unsigned xb_xcc_id() { return (unsigned)__builtin_amdgcn_s_getreg((3 << 11) | 20) & 0xFu; }
#define XB_SPIN(cond, bar) do { unsigned _sp = 0; while (cond) { __builtin_amdgcn_s_sleep(1); \
    if ((++_sp & 255u) == 0u) { if (xb_ld(&(bar)[XB_TMO])) break; if (_sp > XB_SPIN_CAP) { atomicAdd(&(bar)[XB_TMO], 1u); break; } } } } while (0)

struct XcdBarrier {
    unsigned* bar; unsigned x;
    volatile LAS unsigned* st;
};

__device__ __forceinline__ XcdBarrier xcd_barrier_post(unsigned* bar, volatile LAS unsigned* st) {
    XcdBarrier b; b.bar = bar; b.x = xb_xcc_id(); b.st = st;
    if (threadIdx.x == 0) (void)xb_add(&bar[XB_XCNT(b.x)], 1u);
    return b;
}
__device__ __forceinline__ void xcd_barrier_complete(unsigned* bar, unsigned x, unsigned& nloc, unsigned& nx) {
    const unsigned G = gridDim.x * gridDim.y * gridDim.z;
    unsigned sum, cnt, mine, sp = 0u;
    for (;;) {
        sum = 0u; cnt = 0u; mine = 0u;
#pragma unroll
        for (unsigned j = 0; j < 16; ++j) { const unsigned c = xb_ld(&bar[XB_XCNT(j)]); sum += c; cnt += (c > 0u) ? 1u : 0u; mine = (j == x) ? c : mine; }
        if (sum == G) break;
        __builtin_amdgcn_s_sleep(1);
        if ((++sp & 255u) == 0u) { if (xb_ld(&bar[XB_TMO])) break; if (sp > XB_SPIN_CAP) { atomicAdd(&bar[XB_TMO], 1u); break; } }
    }
    nloc = mine > 0u ? mine : 1u; nx = cnt > 0u ? cnt : 1u;
}

__device__ __forceinline__ void xcd_barrier(const XcdBarrier& b, int wave_s) {
    asm volatile("s_waitcnt vmcnt(0)" ::: "memory");
    __syncthreads();
    if (fresh_tid(wave_s) == 0) {
        unsigned* bar = b.bar;
        __builtin_amdgcn_s_waitcnt(0);
        unsigned nloc = b.st[0], nx = b.st[1];
        if (nloc == 0u) { xcd_barrier_complete(bar, b.x, nloc, nx); b.st[0] = nloc; b.st[1] = nx; }
        const unsigned old = xb_add(&bar[XB_XSUB(b.x)], 1u);
        const unsigned gen = old / nloc;
        if (old + 1u == (gen + 1u) * nloc) {
            __builtin_amdgcn_fence(__ATOMIC_RELEASE, "agent");
            asm volatile("s_waitcnt vmcnt(0)" ::: "memory");
            const unsigned og = xb_add(&bar[XB_TOP], 1u);
            const unsigned tg = og / nx;
            if (og + 1u == (tg + 1u) * nx) xb_add(&bar[XB_TOPGEN], 1u);
            else XB_SPIN(xb_ld(&bar[XB_TOPGEN]) == tg, bar);
            __builtin_amdgcn_fence(__ATOMIC_ACQUIRE, "agent");
            xb_add(&bar[XB_XGEN(b.x)], 1u);
            asm volatile("s_waitcnt vmcnt(0)" ::: "memory");
        } else {
            XB_SPIN(xb_ld(&bar[XB_XGEN(b.x)]) == gen, bar);
            __builtin_amdgcn_fence(__ATOMIC_ACQUIRE, "agent");
            asm volatile("s_waitcnt vmcnt(0)" ::: "memory");
        }
    }
    __syncthreads();
}

}
namespace mk {
namespace cg = cooperative_groups;
constexpr int PH_PER_LAYER = 9, N_PHASES = 1 + 2 * PH_PER_LAYER;

__device__ __forceinline__ float lam_of(const Args& a, int l, float lam_init) {
    const float *q1 = a.in[14] + l * 64, *k1 = a.in[15] + l * 64, *q2 = a.in[16] + l * 64, *k2 = a.in[17] + l * 64;
    float s1 = 0.f, s2 = 0.f; for (int i = 0; i < 64; ++i) { s1 += q1[i] * k1[i]; s2 += q2[i] * k2[i]; }
    return expf(s1) - expf(s2) + lam_init;
}

typedef const __attribute__((address_space(4))) Args* KArgPtr;
__global__ void __launch_bounds__(NTH, 2) fwd(Args a_byval) {
    extern __shared__ __attribute__((aligned(16))) unsigned char lds_raw[];
    cg::grid_group grid = cg::this_grid();
    const int ph_lo = a_byval.ph_lo, ph_hi = a_byval.ph_hi;
    const int wave_s = __builtin_amdgcn_readfirstlane((int)threadIdx.x >> 6);
    volatile LAS unsigned* bar_st = (volatile LAS unsigned*)((LAS unsigned char*)lds_raw + LDS_BYTES - 64);
    if (threadIdx.x == 0) { bar_st[0] = 0u; bar_st[1] = 0u; }
    __syncthreads();
    const XcdBarrier bar = xcd_barrier_post((unsigned*)a_byval.ws, bar_st);
    int rep_flag = 0;
    for (int ph = ph_lo; ph < ph_hi; ++ph) {
        KArgPtr ap = (KArgPtr)__builtin_amdgcn_kernarg_segment_ptr(); asm volatile("" : "+s"(ap));
        const Args a = *(const Args*)ap;
        float* Xr = (float*)(a.ws + WS_X);
        Ctx X; X.wave_s = wave_s; X.wave = wave_s; X.tid = 0; X.lane = 0;
#define FRESH() do { X.tid = fresh_tid(wave_s); X.lane = X.tid & 63; } while (0)
        { int g_ = gridDim.x, b_ = blockIdx.x; asm volatile("" : "+s"(g_), "+s"(b_)); X.G = g_; X.bid = b_; }
        { const int bx = X.bid; X.vcu = (X.G % 8 == 0) ? (bx % 8) * (X.G / 8) + bx / 8 : bx; }
        X.gw = X.vcu * NWAVES + X.wave; X.ngw = X.G * NWAVES; X.lds = (LAS unsigned char*)lds_raw; X.ws = a.ws;
#ifndef MK_EN
#define MK_EN 0xFFFF
#endif
#ifndef MK_ATT
#define MK_ATT 3
#endif
#ifndef MK_REP_SP
#define MK_REP_SP 99
#endif
        if (ph == 0) { if (MK_EN & 512) { FRESH(); p0_prologue(X, a); } }
        else {
            const int l = (ph - 1) / PH_PER_LAYER, sp = (ph - 1) % PH_PER_LAYER;
            const float lam_init = 0.8f - 0.6f * expf(-0.3f * (float)l);
            if (0) {}
#if MK_EN & 1
            else if (sp == 0) {
                FRESH();
                pg8::Gemm g{(const bf16*)(a.ws + WS_XN), (const bf16*)(a.ws + WS_WIN) + (size_t)l * INW * D, T, INW, D};
                pg8::StaticOrder So; So.init(T, INW, X.G, X.bid);
                EpiWin Ep{a.ws, (const float*)(a.ws + WS_BINP) + l * INW, (const float*)(a.ws + WS_ROPE)};
                pg8::gemm_phase<EpiWin, pg8::StaticOrder, true, true>(X.lds, g, So, Ep, X.tid);
            }
#endif
#if MK_EN & 2
            else if (sp == 1) {
                FRESH();
                p1t_shortconv(X, a.in[4] + l * 3 * 1536, a.in[5] + l * 1536);
                p1t_kmax(X, (unsigned*)(a.ws + 14336) + l * 32);
            }
#endif
#if MK_EN & 4
            else if (sp == 2) {
                FRESH();
                const float lam = lam_of(a, l, lam_init);
                const int c = X.bid;
#ifndef MK_REP_ATT
#define MK_REP_ATT 1
#endif
#ifndef MK_CONV_REP
#define MK_CONV_REP 1
#endif
#ifndef MK_REP_HY
#define MK_REP_HY 1
#endif
                const int cg_ = X.vcu & 3;
                if (cg_ == 0) { __syncthreads(); p0_experts(relaunder(X), a, l); if (MK_CONV_REP > 1) { __syncthreads(); p0_experts(relaunder(X), a, l); } __syncthreads(); }
                for (int rep = 0; rep < MK_REP_ATT; ++rep) for (int u = c; u < 256; u += X.G) { const int bh = 2 * (u & 7) + ((u >> 3) >> 4), qb = (u >> 3) & 15; at::attn_unit(X, bh >> 2, bh & 3, qb, lam, 1.0f - lam_init, a.in[18] + l * 128, (unsigned*)(a.ws + 14336) + l * 32); }
                if (cg_ == 1) { __syncthreads(); p0_experts(relaunder(X), a, l); if (MK_CONV_REP > 1) { __syncthreads(); p0_experts(relaunder(X), a, l); } __syncthreads(); }
                for (int rep = 0; rep < MK_REP_HY; ++rep) for (int u = c; u < 256; u += X.G) { const int ch = 64 * (u & 7) + 2 * (u >> 3); v2u keep[2][4]; hy::channel<0>(relaunder(X), l, ch, a.in[13], keep);
                    if (cg_ == 2) { __syncthreads(); p0_experts(relaunder(X), a, l); if (MK_CONV_REP > 1) { __syncthreads(); p0_experts(relaunder(X), a, l); } __syncthreads(); }
                    hy::channel<1>(relaunder(X), l, ch + 1, a.in[13], keep); }
                if (cg_ == 3) { __syncthreads(); p0_experts(relaunder(X), a, l); if (MK_CONV_REP > 1) { __syncthreads(); p0_experts(relaunder(X), a, l); } __syncthreads(); }
            }
#endif
#if MK_EN & 8
            else if (sp == 3) {
                FRESH();
                OrderMerge So; So.so.init(T, D, X.G, X.bid);
                pg8::Gemm g{(const bf16*)(a.ws + WS_YH), (const bf16*)(a.ws + WS_WUH) + (size_t)l * 2 * D * C, 2 * T, 2 * D, C};
                EpiMerge2 Ep{(const bf16*)(a.ws + WS_GH), (const bf16*)(a.ws + WS_GA), (bf16*)(a.ws + WS_T1), (bf16*)(a.ws + WS_MG)};
                pg8::gemm_phase<EpiMerge2, OrderMerge, true, true>(X.lds, g, So, Ep, X.tid);
            }
#endif
#if MK_EN & 16
            else if (sp == 4) {
                FRESH();
                pg8::Gemm g{(const bf16*)(a.ws + WS_MG), (const bf16*)(a.ws + WS_WOUT) + (size_t)l * D * D, T, D, D};
                pg8::StaticOrder So; So.init(T, D, X.G, X.bid);
                EpiOutR Ep{l == 0 ? a.in[0] : Xr, Xr, (bf16*)(a.ws + WS_XN), (float*)(a.ws + WS_PART), (const bf16*)(a.ws + WS_WRP) + (size_t)l * 2 * E * D, (unsigned*)(a.ws + 15360) + l * 64, (float*)(a.ws + WS_AFFT), (float*)(a.ws + WS_RTOK), a.in[24] + l * E};
                pg8::gemm_phase<EpiOutR, pg8::StaticOrder, true, true>(X.lds, g, So, Ep, X.tid);
            }
#endif
#if MK_EN & 32
            else if (sp == 5) { FRESH(); p6_topk(X);
            }
#endif
#if MK_EN & 64
            else if (sp == 6) {
                FRESH();
                pg8::Gemm g{(const bf16*)(a.ws + WS_XN), (const bf16*)(a.ws + WS_WGU) + (size_t)l * E * 2 * F * D, E * 2048, 2 * F, D, 2 * F, 4, (size_t)2 * F * D * 2, (const int*)(a.ws + WS_ROWS)};
                OrderMoE1 So{X.G, X.bid}; EpiSwiGLU Ep{(bf16*)(a.ws + WS_HB), (const float*)(a.ws + WS_RSL)};
                pg8::gemm_phase<EpiSwiGLU, OrderMoE1, true, true, true, true>(X.lds, g, So, Ep, X.tid);
            }
#endif
#if MK_EN & 128
            else if (sp == 7) {
                FRESH();
                pg8::Gemm g{(const bf16*)(a.ws + WS_HB), (const bf16*)(a.ws + WS_WD) + (size_t)l * E * D * F, E * 2048, D, F, D, 2, (size_t)D * F * 2};
                OrderMoE2 So{X.G, X.bid}; EpiDown Ep{(bf16*)(a.ws + WS_YE), (const float*)(a.ws + WS_GATE)};
                pg8::gemm_phase<EpiDown, OrderMoE2, true, true, true>(X.lds, g, So, Ep, X.tid);
            }
#endif
#if MK_EN & 256
            else if (sp == 8) {
                FRESH();
                p9_combine(X, Xr, l == 0 ? a.in[1] + D : a.in[28], l == 1, a.out);
            }
#endif
        }
#ifndef MK_EXTRA_SYNC
#define MK_EXTRA_SYNC 0
#endif
        if (ph + 1 < ph_hi) { if (ph_hi > 4096) grid.sync(); else xcd_barrier(bar, wave_s); }
        for (int es = 0; es < MK_EXTRA_SYNC; ++es) xcd_barrier(bar, wave_s);
        if (MK_REP_SP != 99) { const int sp_ = ph == 0 ? -1 : (ph - 1) % PH_PER_LAYER; if (sp_ == MK_REP_SP && rep_flag == 0) { rep_flag = 1; --ph; } else rep_flag = 0; }
    }
}

static int g_grid = 0;
static bool mega_setup() {
    if (g_grid) return g_grid > 0;
    int dev = 0, cus = 0, per_cu = 0;
    if (hipGetDevice(&dev) != hipSuccess || hipDeviceGetAttribute(&cus, hipDeviceAttributeMultiprocessorCount, dev) != hipSuccess) { g_grid = -1; return false; }
    if (hipFuncSetAttribute((const void*)fwd, hipFuncAttributeMaxDynamicSharedMemorySize, LDS_BYTES) != hipSuccess) { fprintf(stderr, "hipFuncSetAttribute failed\n"); g_grid = -1; return false; }
    if (hipOccupancyMaxActiveBlocksPerMultiprocessor(&per_cu, (const void*)fwd, NTH, LDS_BYTES) != hipSuccess || per_cu < 1) { fprintf(stderr, "occupancy query failed (%d)\n", per_cu); g_grid = -1; return false; }
    g_grid = cus * 1;
    return true;
}
static void mega_launch(hipStream_t st, void* const* d_in, float* d_out, unsigned char* ws, int ph_lo, int ph_hi, int p0_mask) {
    if (!mega_setup()) return;
    Args a{};
    for (int i = 0; i < 29; ++i) a.in[i] = (const float*)d_in[i];
    a.out = d_out; a.ws = ws; a.ph_lo = ph_lo; a.ph_hi = ph_hi; a.p0_mask = p0_mask; a.pad = 0;
    if (hipMemsetAsync(ws, 0, 16384, st) != hipSuccess) { fprintf(stderr, "memset of the barrier words failed\n"); return; }
    void* args[] = {&a};
    const hipError_t e = hipLaunchCooperativeKernel((const void*)fwd, dim3(g_grid), dim3(NTH), args, LDS_BYTES, st);
    if (e != hipSuccess) fprintf(stderr, "cooperative launch failed: %s (grid %d)\n", hipGetErrorString(e), g_grid);
}
}
extern "C" void kernel_launch(void* const* d_in, const int* in_sizes, int n_in, void* d_out, int out_size, void* d_ws, size_t ws_size, hipStream_t stream) {
    if (n_in != 29 || out_size != mk::T * mk::D || ws_size < mk::WS_END) { fprintf(stderr, "kernel_launch: unexpected sizes n_in %d out %d ws %zu\n", n_in, out_size, ws_size); return; }
    mk::mega_launch(stream, d_in, (float*)d_out, (unsigned char*)d_ws, 0, mk::N_PHASES, 13);
}
```

```cpp
#include <hip/hip_runtime.h>
#include <hip/hip_cooperative_groups.h>
#include <cstdio>
#include <cstdint>
#include <cmath>
namespace tk {
constexpr int S = 4096, E = 16, CAP = 512, NT = 512;
__device__ __forceinline__ void topk_problem(const unsigned (&key)[8], const float (&rr)[8], int tokbase, int e, int slotbase, int* __restrict__ rows, float* __restrict__ gate, float* __restrict__ rsl, int* __restrict__ inv, int* sm, int tid) {
    const int lane = tid & 63, wid = tid >> 6;
    int* hist = sm; int* ctl = sm + 256;
    unsigned prefix = 0u, mask = 0u; int kth = CAP;
    for (int pass = 3; pass >= 0; --pass) {
        __syncthreads();
        if (tid < 256) hist[tid] = 0;
        __syncthreads();
#pragma unroll
        for (int i = 0; i < 8; ++i) if ((key[i] & mask) == prefix) atomicAdd(&hist[(key[i] >> (8 * pass)) & 255u], 1);
        __syncthreads();
        if (tid < 64) {
            const int b0 = hist[4 * lane], b1 = hist[4 * lane + 1], b2 = hist[4 * lane + 2], b3 = hist[4 * lane + 3];
            const int tot = b0 + b1 + b2 + b3;
            int suf = tot;
#pragma unroll
            for (int o = 1; o < 64; o <<= 1) { const int v = __builtin_amdgcn_ds_bpermute(((lane + o) & 63) << 2, suf); if (lane + o < 64) suf += v; }
            const int above = suf - tot;
            if (above < kth && kth <= above + tot) {
                int cum = above, bin, k2;
                if (cum + b3 >= kth) { bin = 4 * lane + 3; k2 = kth - cum; }
                else { cum += b3; if (cum + b2 >= kth) { bin = 4 * lane + 2; k2 = kth - cum; }
                else { cum += b2; if (cum + b1 >= kth) { bin = 4 * lane + 1; k2 = kth - cum; }
                else { cum += b1; bin = 4 * lane; k2 = kth - cum; } } }
                ctl[0] = bin; ctl[1] = k2;
            }
        }
        __syncthreads();
        prefix |= ((unsigned)ctl[0]) << (8 * pass); mask |= 0xFFu << (8 * pass); kth = ctl[1];
    }
    const unsigned thr = prefix; const int need_eq = kth; const int n_gt = CAP - need_eq;
    int cg = 0, ce = 0;
#pragma unroll
    for (int i = 0; i < 8; ++i) { cg += key[i] > thr; ce += key[i] == thr; }
    int sg = cg, se = ce;
#pragma unroll
    for (int o = 1; o < 64; o <<= 1) { const int a = __builtin_amdgcn_ds_bpermute(((lane - o) & 63) << 2, sg), b = __builtin_amdgcn_ds_bpermute(((lane - o) & 63) << 2, se); if (lane >= o) { sg += a; se += b; } }
    __syncthreads();
    if (lane == 63) { ctl[8 + wid] = sg; ctl[16 + wid] = se; }
    __syncthreads();
    int og = sg - cg, oe = se - ce;
    for (int w = 0; w < wid; ++w) { og += ctl[8 + w]; oe += ctl[16 + w]; }
#pragma unroll
    for (int i = 0; i < 8; ++i) {
        const int idx = tid * 8 + i; int slot = -1;
        if (key[i] > thr) slot = og++;
        else if (key[i] == thr) { if (oe < need_eq) slot = n_gt + oe; ++oe; }
        if (slot >= 0) { rows[slot] = tokbase + idx; gate[slot] = __uint_as_float(key[i]); rsl[slot] = rr[i]; }
        inv[(size_t)(tokbase + idx) * E + e] = slot >= 0 ? slotbase + slot : -1;
    }
    __syncthreads();
}
}
namespace pg8 {
#define PG8_LAS __attribute__((address_space(3)))
typedef unsigned short bf16_t;
typedef short bf16x8 __attribute__((ext_vector_type(8)));
typedef float f32x4 __attribute__((ext_vector_type(4)));
typedef unsigned u32x4 __attribute__((ext_vector_type(4)));
typedef short s16x4 __attribute__((ext_vector_type(4)));
constexpr int BM = 256, BK = 64, HALF = 128, HTB = HALF * BK * 2  , STAGE_BYTES = 8 * HTB, NXCD = 8, WGM = 8;

__host__ __device__ __forceinline__ int lds_byte(int r, int c) { const int st = (r >> 4) * 2 + (c >> 5), rr = r & 15, cc = c & 31, ob = rr * 64 + cc * 2; return st * 1024 + (ob ^ (((ob >> 9) & 1) << 5)); }
__host__ __device__ __forceinline__ void stage_rc(int b, int& R, int& C) { const int st = b / 1024, sb = b % 1024, swz = sb ^ (((sb >> 9) & 1) << 5); R = (st >> 1) * 16 + swz / 64; C = (st & 1) * 32 + (swz % 64) / 2; }
__host__ __device__ __forceinline__ int perm32(int rho) { const int n = rho >> 4, i = rho & 15; return 8 * (i >> 2) + 4 * n + (i & 3); }

struct Unit { int pm, pn, pb, pa; };
struct Gemm { const bf16_t* A; const bf16_t* Bt; int M, N, K; int bN = 0, bsh = 0; size_t bes = 0; const int* arows = nullptr; };

struct StaticOrder {
    int nM, nN, nwg, G, c;
    __host__ __device__ void init(int M, int N, int G_, int c_) { nM = M / BM; nN = N / BM; nwg = nM * nN; G = G_; c = c_; }
    __host__ __device__ bool next(int i, Unit& u) const {
        const long L = (long)i * G + c; if (L >= nwg) return false;
        int wgid = (int)L; { const int q = nwg / NXCD, r = nwg % NXCD, xcd = wgid % NXCD, off = wgid / NXCD; wgid = (xcd < r ? xcd * (q + 1) : r * (q + 1) + (xcd - r) * q) + off; }
        const int nig = WGM * nN, gid = wgid / nig, fm = gid * WGM, gsz = (nM - fm) < WGM ? (nM - fm) : WGM;
        u.pm = fm + ((wgid % nig) % gsz); u.pn = (wgid % nig) / gsz; u.pb = u.pn; u.pa = u.pm; return true;
    }
    __device__ __forceinline__ void a_ready(const Unit&) const {}
    __device__ __forceinline__ void done(const Unit&) const {}
};

template <class Epi, class Sched, bool ALIGN_EPI = false, bool SP2 = false, bool BT = false, bool GA = false>
__device__ __forceinline__ void gemm_phase(PG8_LAS unsigned char* lds, const Gemm g, const Sched& S, const Epi& E, int tid) {
    asm volatile("" : "+v"(tid));
    const int wid = __builtin_amdgcn_readfirstlane(tid >> 6), lane = tid & 63, wr = wid >> 2, wc = wid & 3, fr = lane & 15, fq = lane >> 4;
    const int K = g.K, nt = K / BK;
    unsigned voffA[2], voffB[2];
#pragma unroll
    for (int i = 0; i < 2; ++i) { int R, C; stage_rc(tid * 16 + i * 8192, R, C); const int Rb = Epi::PERM ? ((R & ~31) + perm32(R & 31)) : R;
        voffA[i] = (unsigned)(R * K + C) * 2u; voffB[i] = (unsigned)(Rb * K + C) * 2u; if constexpr (GA) voffA[i] = (unsigned)C * 2u;
        if constexpr (BT) { const int p = i * 512 + tid, row = ((p >> 7) << 3) | ((p >> 2) & 7), ch = (((p >> 5) & 3) << 2) | ((p & 3) ^ ((row >> 2) & 3));
            voffB[i] = (unsigned)(row * g.bN + 8 * ch) * 2u; } }
    const size_t kstep = (size_t)(BK * 2);
    const size_t hstep = (size_t)HALF * K * 2;
    const size_t tstep = 2 * hstep;
    const size_t kstepB = BT ? (size_t)BK * g.bN * 2 : kstep, hstepB = BT ? (size_t)HALF * 2 : hstep;
    const size_t hstepA = GA ? 0 : hstep;
    unsigned curA[2][2] = {{0u, 0u}, {0u, 0u}};
    PG8_LAS int* rowtab0 = (PG8_LAS int*)(lds + STAGE_BYTES);
#define PG8_ROWTAB (rowtab0 + ((ui + 1) & 1) * 512)
#define PG8_NXTOFF(o_, h) do { int t_ = tid; asm volatile("" : "+v"(t_)); _Pragma("unroll") for (int i_ = 0; i_ < 2; ++i_) { int R_, C_; stage_rc(t_ * 16 + i_ * 8192, R_, C_); \
        o_[i_] = (unsigned)PG8_ROWTAB[(h) * 128 + R_] * (unsigned)(K * 2) + (unsigned)C_ * 2u; } } while (0)
#define PG8_STAGE_A(bufoff, kbase, h, nx) do { if constexpr (GA) { if (nx) { unsigned o_[2]; PG8_NXTOFF(o_, h); PG8_STAGE(bufoff, kbase, o_); } else PG8_STAGE(bufoff, kbase, curA[h]); } \
        else PG8_STAGE(bufoff, (kbase) + ((h) ? hstep : 0), voffA); } while (0)
#define PG8_BBASE(pb) ((const char*)g.Bt + (BT ? (size_t)((pb) >> g.bsh) * g.bes + (size_t)((pb) & ((1 << g.bsh) - 1)) * 512 : (size_t)(pb) * tstep))
    const unsigned ldsw = (unsigned)wid * 1024u;
    const int aoff = lds_byte(wr * 64 + fr, fq * 8), boff = lds_byte(wc * 32 + fr, fq * 8);
    int tr0 = 0, tr1 = 0;
    if constexpr (BT) { static_assert(Epi::PERM, "BT needs the PERM column order"); const int q_ = (lane >> 2) & 3, p_ = lane & 3, f1_ = fq & 1;
        const int L_ = (int)(size_t)lds + 2048 * fq + 512 * wc + 64 * q_ + 32 * ((p_ >> 1) ^ f1_); tr0 = L_ + 16 * (p_ & 1); tr1 = L_ + 256 + 16 * (1 - (p_ & 1)); }
#define PG8_SA(b, h) (((b) * 2 + (h)) * HTB)
#define PG8_SB(b, h) ((4 + (b) * 2 + (h)) * HTB)
#define PG8_STAGE(bufoff, gbase, voff) do { _Pragma("unroll") for (int _i = 0; _i < 2; ++_i) \
        __builtin_amdgcn_global_load_lds((const unsigned*)((const char*)(gbase) + (voff)[_i]), (PG8_LAS unsigned*)(lds + (bufoff) + ldsw + _i * 8192), 16, 0, 0); } while (0)
#define PG8_LDA(dst, b, h) do { _Pragma("unroll") for (int m = 0; m < 4; ++m) _Pragma("unroll") for (int k = 0; k < 2; ++k) dst[m][k] = *(const PG8_LAS bf16x8*)(lds + PG8_SA(b, h) + aoff + m * 2048 + k * 1024); } while (0)
#define PG8_TR(dst4, addr, OFF) asm volatile("ds_read_b64_tr_b16 %0, %1 offset:%2" : "=&v"(dst4) : "v"(addr), "i"(OFF) : "memory")
#define PG8_TRF(dst8, a0, a1, OFF) do { s16x4 lo_, hi_; PG8_TR(lo_, a0, OFF); PG8_TR(hi_, a1, OFF); dst8 = __builtin_shufflevector(lo_, hi_, 0, 1, 2, 3, 4, 5, 6, 7); } while (0)
#define PG8_LDB(dst, b, h) do { if constexpr (BT) { const int a0_ = tr0 + PG8_SB(b, h), a1_ = tr1 + PG8_SB(b, h); \
        PG8_TRF(dst[0][0], a0_, a1_, 0); PG8_TRF(dst[0][1], a0_, a1_, 8192); PG8_TRF(dst[1][0], a0_, a1_, 8); PG8_TRF(dst[1][1], a0_, a1_, 8200); } else { \
    _Pragma("unroll") for (int n = 0; n < 2; ++n) _Pragma("unroll") for (int k = 0; k < 2; ++k) dst[n][k] = *(const PG8_LAS bf16x8*)(lds + PG8_SB(b, h) + boff + n * 2048 + k * 1024); } } while (0)
#define PG8_MMA(ai, bj, At, Bt) do { __builtin_amdgcn_s_setprio(1); _Pragma("unroll") for (int m = 0; m < 4; ++m) _Pragma("unroll") for (int n = 0; n < 2; ++n) _Pragma("unroll") for (int k = 0; k < 2; ++k) \
        acc[ai][bj][m][n] = __builtin_amdgcn_mfma_f32_16x16x32_bf16(Bt[n][k], At[m][k], acc[ai][bj][m][n], 0, 0, 0); __builtin_amdgcn_s_setprio(0); } while (0)
#define PG8_WAIT_V(n) asm volatile("s_waitcnt vmcnt(" #n ")" ::: "memory")
#define PG8_WAIT_L(n) asm volatile("s_waitcnt lgkmcnt(" #n ")" ::: "memory")
#define PG8_BAR __builtin_amdgcn_s_barrier()
#define PG8_SCHED __builtin_amdgcn_sched_barrier(0)
    Unit cur, nxt; int ui = 0;
    if (!S.next(0, cur)) return;
    f32x4 acc[2][2][4][2];
#pragma unroll
    for (int a = 0; a < 2; ++a)
#pragma unroll
        for (int b = 0; b < 2; ++b)
#pragma unroll
            for (int m = 0; m < 4; ++m)
#pragma unroll
                for (int n = 0; n < 2; ++n) acc[a][b][m][n] = (f32x4){0.f, 0.f, 0.f, 0.f};
    bf16x8 At[4][2], B0[2][2], B1[2][2];
    const char* cA = (const char*)g.A + (GA ? 0 : (size_t)cur.pa * tstep); const char* cB = PG8_BBASE(cur.pb);
    if constexpr (GA) {
#pragma unroll
        for (int h = 0; h < 2; ++h)
#pragma unroll
            for (int i = 0; i < 2; ++i) { int R, C; stage_rc(tid * 16 + i * 8192, R, C);
                curA[h][i] = (unsigned)__hip_atomic_load(g.arows + cur.pa * 256 + h * 128 + R, __ATOMIC_RELAXED, __HIP_MEMORY_SCOPE_AGENT) * (unsigned)(K * 2) + (unsigned)C * 2u; } }
    S.a_ready(cur);
    if constexpr (SP2) {
        PG8_STAGE(PG8_SB(0, 0), cB, voffB); PG8_STAGE(PG8_SB(0, 1), cB + hstepB, voffB); PG8_STAGE_A(PG8_SA(0, 0), cA, 0, false); PG8_STAGE_A(PG8_SA(0, 1), cA, 1, false);
        if (wr == 1) PG8_BAR;
        PG8_WAIT_V(2); PG8_BAR;
        PG8_STAGE(PG8_SB(1, 0), cB + kstepB, voffB); PG8_STAGE_A(PG8_SA(1, 0), cA + kstep, 0, false); PG8_STAGE(PG8_SB(1, 1), cB + hstepB + kstepB, voffB);
        PG8_WAIT_V(6); PG8_BAR;
    } else {
        PG8_STAGE(PG8_SB(0, 0), cB, voffB); PG8_STAGE_A(PG8_SA(0, 0), cA, 0, false); PG8_STAGE(PG8_SB(0, 1), cB + hstepB, voffB); PG8_STAGE_A(PG8_SA(0, 1), cA, 1, false);
        if (wr == 1) PG8_BAR;
        PG8_WAIT_V(4); PG8_BAR;
        PG8_STAGE(PG8_SB(1, 0), cB + kstepB, voffB); PG8_STAGE_A(PG8_SA(1, 0), cA + kstep, 0, false); PG8_STAGE(PG8_SB(1, 1), cB + hstepB + kstepB, voffB);
        PG8_WAIT_V(6); PG8_BAR;
    }
    for (;;) {
        const bool has_next = S.next(ui + 1, nxt);
        const char* nA = (has_next && !GA) ? (const char*)g.A + (size_t)nxt.pa * tstep : cA; const char* nB = has_next ? PG8_BBASE(nxt.pb) : cB;
        for (int t = 0; t < nt; t += 2) {
            const bool last = (t == nt - 2);
            const char* a1 = cA + (size_t)(t + 1) * kstep;
            const char* a2 = last ? nA : cA + (size_t)(t + 2) * kstep; const char* b2 = last ? nB : cB + (size_t)(t + 2) * kstepB;
            const char* a3 = a2 + kstep; const char* b3 = b2 + kstepB;
            if (last && has_next) S.a_ready(nxt);
            const bool nx = GA && last && has_next;
            if constexpr (GA) {
                if (t == 0 && has_next) { int l_ = lane; asm volatile("" : "+v"(l_)); __builtin_amdgcn_global_load_lds((const unsigned*)(g.arows + nxt.pa * 256 + (wid & 3) * 64 + l_), (PG8_LAS unsigned*)(PG8_ROWTAB + wid * 64), 4, 0, 0); }
            }
            if constexpr (SP2) {
            PG8_LDB(B0, 0, 0); PG8_LDB(B1, 0, 1); PG8_SCHED; PG8_LDA(At, 0, 0); PG8_STAGE_A(PG8_SA(1, 1), a1, 1, false);
            PG8_WAIT_V(8); PG8_WAIT_L(0); PG8_BAR; PG8_MMA(0, 0, At, B0); PG8_MMA(0, 1, At, B1); PG8_BAR; PG8_SCHED;
            PG8_LDA(At, 0, 1); PG8_STAGE(PG8_SB(0, 0), b2, voffB); PG8_STAGE(PG8_SB(0, 1), b2 + hstepB, voffB); PG8_STAGE_A(PG8_SA(0, 0), a2, 0, nx);
            PG8_WAIT_V(8); PG8_WAIT_L(0); PG8_BAR; PG8_MMA(1, 0, At, B0); PG8_MMA(1, 1, At, B1); PG8_BAR; PG8_SCHED;
            PG8_LDB(B0, 1, 0); PG8_LDB(B1, 1, 1); PG8_SCHED; PG8_LDA(At, 1, 0); PG8_STAGE_A(PG8_SA(0, 1), a2, 1, nx);
            PG8_WAIT_V(8); PG8_WAIT_L(0); PG8_BAR; PG8_MMA(0, 0, At, B0); PG8_MMA(0, 1, At, B1); PG8_BAR; PG8_SCHED;
            PG8_LDA(At, 1, 1); PG8_STAGE(PG8_SB(1, 0), b3, voffB); PG8_STAGE(PG8_SB(1, 1), b3 + hstepB, voffB); PG8_STAGE_A(PG8_SA(1, 0), a3, 0, nx);
            PG8_WAIT_V(8); PG8_WAIT_L(0); PG8_BAR; PG8_MMA(1, 0, At, B0); PG8_MMA(1, 1, At, B1); PG8_BAR; PG8_SCHED;
            } else {
            PG8_LDB(B0, 0, 0); PG8_SCHED; PG8_LDA(At, 0, 0); PG8_STAGE_A(PG8_SA(1, 1), a1, 1, false);
            PG8_WAIT_L(8); PG8_BAR; PG8_WAIT_L(0); PG8_MMA(0, 0, At, B0); PG8_BAR; PG8_SCHED;
            PG8_LDB(B1, 0, 1); PG8_STAGE(PG8_SB(0, 0), b2, voffB);
            PG8_BAR; PG8_WAIT_L(0); PG8_MMA(0, 1, At, B1); PG8_BAR;
            PG8_LDA(At, 0, 1); PG8_STAGE_A(PG8_SA(0, 0), a2, 0, nx);
            PG8_BAR; PG8_WAIT_L(0); PG8_MMA(1, 0, At, B0); PG8_BAR; PG8_SCHED;
            PG8_STAGE(PG8_SB(0, 1), b2 + hstepB, voffB);
            PG8_WAIT_V(6); PG8_BAR; PG8_MMA(1, 1, At, B1); PG8_BAR;
            PG8_LDB(B0, 1, 0); PG8_SCHED; PG8_LDA(At, 1, 0); PG8_STAGE_A(PG8_SA(0, 1), a2, 1, nx);
            PG8_WAIT_L(8); PG8_BAR; PG8_WAIT_L(0); PG8_MMA(0, 0, At, B0); PG8_BAR; PG8_SCHED;
            PG8_LDB(B1, 1, 1); PG8_STAGE(PG8_SB(1, 0), b3, voffB);
            PG8_BAR; PG8_WAIT_L(0); PG8_MMA(0, 1, At, B1); PG8_BAR;
            PG8_LDA(At, 1, 1); PG8_STAGE_A(PG8_SA(1, 0), a3, 0, nx);
            PG8_BAR; PG8_WAIT_L(0); PG8_MMA(1, 0, At, B0); PG8_BAR; PG8_SCHED;
            PG8_STAGE(PG8_SB(1, 1), b3 + hstepB, voffB);
            PG8_WAIT_V(6); PG8_BAR; PG8_MMA(1, 1, At, B1); PG8_BAR;
            }
        }
        if constexpr (ALIGN_EPI) { if (wr == 0) PG8_BAR; }
        if constexpr (!Epi::AFTER_DRAIN) { E(acc, cur, wr, wc, fr, fq); S.done(cur); }
        if (!has_next) break;
#pragma unroll
        for (int a = 0; a < 2; ++a)
#pragma unroll
            for (int b = 0; b < 2; ++b)
#pragma unroll
                for (int m = 0; m < 4; ++m)
#pragma unroll
                    for (int n = 0; n < 2; ++n) acc[a][b][m][n] = (f32x4){0.f, 0.f, 0.f, 0.f};
        if constexpr (GA) { PG8_NXTOFF(curA[0], 0); PG8_NXTOFF(curA[1], 1); }
        cur = nxt; cA = nA; cB = nB; ++ui;
        if constexpr (ALIGN_EPI) { if (wr == 1) PG8_BAR; }
    }
    PG8_WAIT_V(0);
    if constexpr (!ALIGN_EPI) { if (wr == 0) PG8_BAR; }
    PG8_BAR;
    if constexpr (Epi::AFTER_DRAIN) { E.fused(acc, cur, wr, wc, fr, fq, lds, wid, lane); S.done(cur); }
#undef PG8_SA
#undef PG8_SB
#undef PG8_STAGE
#undef PG8_STAGE_A
#undef PG8_NXTOFF
#undef PG8_ROWTAB
#undef PG8_LDA
#undef PG8_LDB
#undef PG8_TR
#undef PG8_TRF
#undef PG8_BBASE
#undef PG8_MMA
#undef PG8_WAIT_V
#undef PG8_WAIT_L
#undef PG8_BAR
#undef PG8_SCHED
}
}

namespace mk {
constexpr int D = 1024, B = 4, S = 4096, T = B * S, C = 512, INW = 5120, E = 16, CAP = 512, F = 2048, NTH = 512, NWAVES = 8;
typedef unsigned short bf16;
#define LAS __attribute__((address_space(3)))
typedef unsigned v4u __attribute__((ext_vector_type(4)));
typedef unsigned v2u __attribute__((ext_vector_type(2)));
typedef float f32x4 __attribute__((ext_vector_type(4)));
typedef short bf16x8 __attribute__((ext_vector_type(8)));
typedef float f32x16 __attribute__((ext_vector_type(16)));
typedef short s16x4 __attribute__((ext_vector_type(4)));

constexpr size_t MiB = 1u << 20;
constexpr size_t WS_WIN = 2 * MiB;
constexpr size_t WS_WUH = 22 * MiB;
constexpr size_t WS_WUA = 23 * MiB;
constexpr size_t WS_WOUT = 26 * MiB;
constexpr size_t WS_BINP = 30 * MiB;
constexpr size_t WS_WRP = 30 * MiB + 512 * 1024;
constexpr size_t WS_ROPE = 31 * MiB;
constexpr size_t WS_AFFT = 32 * MiB;
constexpr size_t WS_INV = 33 * MiB;
constexpr size_t WS_ROWS = 34 * MiB;
constexpr size_t WS_GATE = 34 * MiB + 512 * 1024;
constexpr size_t WS_RTOK = 35 * MiB + 512 * 1024;
constexpr size_t WS_RSL = 35 * MiB;
constexpr size_t WS_FILT = 36 * MiB;
constexpr size_t WS_X = 68 * MiB;
constexpr size_t WS_XN = 132 * MiB;
constexpr size_t WS_SH = 164 * MiB;
constexpr size_t WS_U = WS_SH;
constexpr size_t WS_UCT = WS_SH + 48 * MiB;
constexpr size_t WS_Q = WS_SH + 96 * MiB;
constexpr size_t WS_K = WS_SH + 112 * MiB;
constexpr size_t WS_V = WS_SH + 128 * MiB;
constexpr size_t WS_GH = WS_SH + 144 * MiB;
constexpr size_t WS_GA = WS_SH + 176 * MiB;
constexpr size_t WS_YH = WS_SH + 208 * MiB;
constexpr size_t WS_YA = WS_SH + 224 * MiB;
constexpr size_t WS_T1 = WS_U;
constexpr size_t WS_MG = WS_UCT;
constexpr size_t WS_PART = WS_SH;
constexpr size_t WS_HB = WS_SH + 64 * MiB;
constexpr size_t WS_YE = WS_SH + 192 * MiB;
constexpr size_t WS_WGU = 420 * MiB;
constexpr size_t WS_WD = 676 * MiB;
constexpr size_t WS_END = 804 * MiB;

constexpr int LDS_BYTES = 155648;
constexpr float QSCALE = 0.125f * 1.4426950408889634f;

struct Args {
    const float* in[29]; float* out; unsigned char* ws; int ph_lo, ph_hi; int p0_mask, pad;
};

__device__ __forceinline__ unsigned f2bf(float f) { unsigned u = __builtin_bit_cast(unsigned, f); return (u + 0x7fffu + ((u >> 16) & 1u)) >> 16; }
__device__ __forceinline__ unsigned pk2(float lo, float hi) { return f2bf(lo) | (f2bf(hi) << 16); }
__device__ __forceinline__ float bf2f(unsigned h) { return __builtin_bit_cast(float, h << 16); }
__device__ __forceinline__ float bflo(unsigned w) { return __builtin_bit_cast(float, w << 16); }
__device__ __forceinline__ float bfhi(unsigned w) { return __builtin_bit_cast(float, w & 0xffff0000u); }
template <int O> __device__ __forceinline__ float xor_f(float v) { return __builtin_bit_cast(float, __builtin_amdgcn_ds_swizzle(__builtin_bit_cast(int, v), (O << 10) | 0x1f)); }
__device__ __forceinline__ float wave_sum(float v) { v += xor_f<1>(v); v += xor_f<2>(v); v += xor_f<4>(v); v += xor_f<8>(v); v += xor_f<16>(v);
    const int b = __builtin_bit_cast(int, v); return __builtin_bit_cast(float, __builtin_amdgcn_readlane(b, 0)) + __builtin_bit_cast(float, __builtin_amdgcn_readlane(b, 32)); }

__device__ __forceinline__ float sigm(float x) { return 1.f / (1.f + __expf(-x)); }

struct Ctx { int tid, lane, wave, gw, ngw, vcu, G, bid, wave_s; LAS unsigned char* lds; unsigned char* ws; };

__device__ __forceinline__ int fresh_tid(int wave_s) { int l; asm volatile("v_mbcnt_lo_u32_b32 %0, -1, 0\n\tv_mbcnt_hi_u32_b32 %0, -1, %0" : "=v"(l)); return (wave_s << 6) | l; }
__device__ __forceinline__ Ctx relaunder(const Ctx& X) { Ctx Y = X; const int t = fresh_tid(X.wave_s); Y.tid = t; Y.lane = t & 63; return Y; }

template <int MAP> __device__ __forceinline__ int rowmap(int n) {
    if (MAP == 1) {
        if (n < 1536 || n >= 2560) return n;
        const int hb = (n - 1536) & ~63, d = (n - 1536) & 63, i = (d & 31) >> 2, j = d & 3;
        return 1536 + hb + 8 * i + ((d >> 5) << 2) + j;
    }
    if (MAP == 2) return ((n >> 7) << 8) + (n & 127);
    if (MAP == 3) return ((n >> 7) << 8) + 128 + (n & 127);
    return n;
}
__device__ __forceinline__ unsigned cvtpk_(float lo, float hi) { unsigned r; asm volatile("v_cvt_pk_bf16_f32 %0, %1, %2" : "=v"(r) : "v"(lo), "v"(hi)); return r; }
struct TrItem { const float* src; bf16* dst; };
template <int MAP> __device__ __forceinline__ void p0_transpose(const Ctx& X, const float* W, int K, int N, bf16* WT, int nmat, size_t sstride, size_t dstride) {
    LAS float* scr = (LAS float*)(X.lds + X.wave * 16640);
    const int nblk = N / 64, per = (K / 64) * nblk, tot = per * nmat, lane = X.lane;
    const int nq = lane & 15, kr = lane >> 4, c = lane & 7, nsub = lane >> 3;
    f32x4 v[16];
    int it = X.gw;
#define TR_SRC(it_) (W + (size_t)((it_) / per) * sstride + (size_t)(64 * (((it_) % per) / nblk) + kr) * N + 64 * (((it_) % per) % nblk) + 4 * nq)
    if (it < tot) { const float* s = TR_SRC(it);
#pragma unroll
        for (int i = 0; i < 16; ++i) v[i] = __builtin_nontemporal_load((const f32x4*)(s + (size_t)(4 * i) * N)); }
    while (it < tot) {
#pragma unroll
        for (int i = 0; i < 16; ++i) { LAS float* d = scr + (4 * i + kr) * 65 + 4 * nq; d[0] = v[i][0]; d[1] = v[i][1]; d[2] = v[i][2]; d[3] = v[i][3]; }
        const int nit = it + X.ngw;
        if (nit < tot) { const float* s = TR_SRC(nit);
#pragma unroll
            for (int i = 0; i < 16; ++i) v[i] = __builtin_nontemporal_load((const f32x4*)(s + (size_t)(4 * i) * N)); }
        asm volatile("s_waitcnt lgkmcnt(0)" ::: "memory");
        const int m = it / per, r = it - m * per, k0 = 64 * (r / nblk), n0 = 64 * (r % nblk);
        bf16* dst = WT + (size_t)m * dstride;
#pragma unroll
        for (int j = 0; j < 8; ++j) { const int n = nsub + 8 * j; const LAS float* s = scr + (8 * c) * 65 + n;
            v4u o; o.x = cvtpk_(s[0 * 65], s[1 * 65]); o.y = cvtpk_(s[2 * 65], s[3 * 65]); o.z = cvtpk_(s[4 * 65], s[5 * 65]); o.w = cvtpk_(s[6 * 65], s[7 * 65]);
            __builtin_nontemporal_store(o, (v4u*)(dst + (size_t)rowmap<MAP>(n0 + n) * K + k0 + 8 * c)); }
        asm volatile("s_waitcnt lgkmcnt(0)" ::: "memory");
        it = nit;
    }
#undef TR_SRC
}
struct Row8 { f32x4 a[2][2]; };
__device__ __forceinline__ void row8_load(Row8& r, const float* p, int lane) {
#pragma unroll
    for (int j = 0; j < 2; ++j) { const f32x4* q = (const f32x4*)p + 2 * (lane + 64 * j); r.a[j][0] = q[0]; r.a[j][1] = q[1]; }
}
__device__ __forceinline__ float row8_sumsq(const Row8& r) {
    float s = 0.f;
#pragma unroll
    for (int j = 0; j < 2; ++j)
#pragma unroll
        for (int h = 0; h < 2; ++h) s += (r.a[j][h].x * r.a[j][h].x + r.a[j][h].y * r.a[j][h].y) + (r.a[j][h].z * r.a[j][h].z + r.a[j][h].w * r.a[j][h].w);
    return s;
}
__device__ __forceinline__ void rms_row_to_bf16(const float* __restrict__ xrow, const float* __restrict__ g, bf16* __restrict__ orow, int lane) {
    const f32x4* xr = (const f32x4*)xrow + lane; f32x4 v[4]; float s = 0.f;
#pragma unroll
    for (int j = 0; j < 4; ++j) { v[j] = xr[64 * j]; s += (v[j].x * v[j].x + v[j].y * v[j].y) + (v[j].z * v[j].z + v[j].w * v[j].w); }
    const float r = rsqrtf(wave_sum(s) * (1.f / D) + 1e-6f);
    v2u* o8 = (v2u*)orow + lane;
#pragma unroll
    for (int j = 0; j < 4; ++j) { const f32x4 gg = ((const f32x4*)g)[lane + 64 * j]; v2u w; w.x = pk2(v[j].x * r * gg.x, v[j].y * r * gg.y); w.y = pk2(v[j].z * r * gg.z, v[j].w * r * gg.w); o8[64 * j] = w; }
}
__device__ __forceinline__ void p0_filters(const Ctx& X, const Args& a) {
    LAS float* z = (LAS float*)X.lds;
    LAS float* h1 = z + 32 * 36;
    LAS float* h2r = h1 + 32 * 64;
    LAS float* w1s = h2r + 32 * 68;
    LAS float* w2s = w1s + 33 * 64;
    bf16* FILT = (bf16*)(X.ws + WS_FILT);
    const float min_decay = logf(1e-2f) / 0.3f, max_decay = logf(1e-2f) / 1.5f;
    for (int it = X.bid; it < 2 * (S / 32); it += X.G) {
        int tid = X.tid; asm volatile("" : "+v"(tid));
        const int j = tid & 63, tq = tid >> 6;
        const int l = it / (S / 32), t0 = (it % (S / 32)) * 32;
        const float *w1 = a.in[6] + l * 33 * 64, *b1 = a.in[7] + l * 64, *f1 = a.in[8] + l * 64, *w2 = a.in[9] + l * 64 * 64, *b2 = a.in[10] + l * 64, *f2 = a.in[11] + l * 64, *w3 = a.in[12] + (size_t)l * 64 * 2048;
        __syncthreads();
        for (int e = tid; e < 33 * 64; e += NTH) w1s[e] = w1[e];
        for (int e = tid; e < 64 * 64; e += NTH) w2s[e] = w2[e];
        for (int e = tid; e < 32 * 33; e += NTH) { const int tt = e / 33, jj0 = e - tt * 33, t = t0 + tt; float v;
            if (jj0 == 0) v = (float)t / (float)(S - 1);
            else { const int jj = (jj0 - 1) & 15; const float w = 2.0f * 3.14159265358979323846f * (float)t / (float)S; const float fr = 1e-4f + (float)jj * ((15.0f - 1e-4f) / 15.0f); const float ang = w * fr; v = (jj0 <= 16) ? cosf(ang) : -sinf(ang); }
            z[tt * 36 + jj0] = v; }
        const float bb1 = b1[j], ff1 = f1[j], bb2 = b2[j], ff2 = f2[j];
        __syncthreads();
        { float acc[4] = {bb1, bb1, bb1, bb1};
          for (int i = 0; i < 33; ++i) { const float w = w1s[i * 64 + j];
#pragma unroll
              for (int k = 0; k < 4; ++k) acc[k] += z[(tq + 8 * k) * 36 + i] * w; }
#pragma unroll
          for (int k = 0; k < 4; ++k) h1[(tq + 8 * k) * 64 + j] = sinf(ff1 * acc[k]); }
        __syncthreads();
        { float acc[4] = {bb2, bb2, bb2, bb2};
          for (int i = 0; i < 64; ++i) { const float w = w2s[i * 64 + j];
#pragma unroll
              for (int k = 0; k < 4; ++k) acc[k] += h1[(tq + 8 * k) * 64 + i] * w; }
#pragma unroll
          for (int k = 0; k < 4; ++k) h2r[(tq + 8 * k) * 68 + j] = sinf(ff2 * acc[k]); }
        __syncthreads();
        { const int wv = tid >> 6, ln = tid & 63, tl = ln & 31, kh = ln >> 5;
#define FSPLIT(HI, LO, V0, V1) do { v4u h_; h_.x = cvtpk_((V0)[0], (V0)[1]); h_.y = cvtpk_((V0)[2], (V0)[3]); h_.z = cvtpk_((V1)[0], (V1)[1]); h_.w = cvtpk_((V1)[2], (V1)[3]); \
            v4u l_; l_.x = cvtpk_((V0)[0] - bflo(h_.x), (V0)[1] - bfhi(h_.x)); l_.y = cvtpk_((V0)[2] - bflo(h_.y), (V0)[3] - bfhi(h_.y)); l_.z = cvtpk_((V1)[0] - bflo(h_.z), (V1)[1] - bfhi(h_.z)); l_.w = cvtpk_((V1)[2] - bflo(h_.w), (V1)[3] - bfhi(h_.w)); \
            HI = __builtin_bit_cast(bf16x8, h_); LO = __builtin_bit_cast(bf16x8, l_); } while (0)
            bf16x8 ah[4], al[4];
#pragma unroll
            for (int kb = 0; kb < 4; ++kb) { const f32x4 v0 = *(const LAS f32x4*)(h2r + tl * 68 + 16 * kb + 8 * kh), v1 = *(const LAS f32x4*)(h2r + tl * 68 + 16 * kb + 8 * kh + 4); FSPLIT(ah[kb], al[kb], v0, v1); }
            const float* wl = w3 + (size_t)(8 * kh) * 2048 + wv * 256 + tl;
            f32x4 wq[2][4][2];
#define FLOADW(BUF, NT) do { _Pragma("unroll") for (int kb_ = 0; kb_ < 4; ++kb_) _Pragma("unroll") for (int j_ = 0; j_ < 8; ++j_) wq[BUF][kb_][j_ >> 2][j_ & 3] = wl[(size_t)(16 * kb_ + j_) * 2048 + 32 * (NT)]; } while (0)
#define FTILE(BUF, NT) do { f32x16 d_ = {}; _Pragma("unroll") for (int kb_ = 0; kb_ < 4; ++kb_) { bf16x8 bh_, bl_; FSPLIT(bh_, bl_, wq[BUF][kb_][0], wq[BUF][kb_][1]); \
                d_ = __builtin_amdgcn_mfma_f32_32x32x16_bf16(ah[kb_], bh_, d_, 0, 0, 0); d_ = __builtin_amdgcn_mfma_f32_32x32x16_bf16(al[kb_], bh_, d_, 0, 0, 0); d_ = __builtin_amdgcn_mfma_f32_32x32x16_bf16(ah[kb_], bl_, d_, 0, 0, 0); } \
              const int n_ = wv * 256 + 32 * (NT) + tl, c_ = n_ & 511, od_ = n_ >> 9; const float dl_ = fabsf(min_decay + (float)c_ * ((max_decay - min_decay) / 511.0f)) * (1.0f / (float)(S - 1)); \
              bf16* fo_ = FILT + (((size_t)l * 4 + od_) * C + c_) * S + t0 + 4 * kh; \
              _Pragma("unroll") for (int g_ = 0; g_ < 4; ++g_) { const float tb_ = (float)(t0 + 8 * g_ + 4 * kh); v2u o_; \
                  o_.x = pk2(d_[4 * g_] * expf(-tb_ * dl_), d_[4 * g_ + 1] * expf(-(tb_ + 1.f) * dl_)); o_.y = pk2(d_[4 * g_ + 2] * expf(-(tb_ + 2.f) * dl_), d_[4 * g_ + 3] * expf(-(tb_ + 3.f) * dl_)); \
                  *(v2u*)(fo_ + 8 * g_) = o_; } } while (0)
            FLOADW(0, 0);
#pragma unroll 1
            for (int nt = 0; nt < 8; nt += 2) { FLOADW(1, nt + 1); FTILE(0, nt); if (nt + 2 < 8) FLOADW(0, nt + 2); FTILE(1, nt + 1); }
#undef FSPLIT
#undef FLOADW
#undef FTILE
        }
    }
    __syncthreads();
}
template <int MAP> __device__ __forceinline__ void p0_convert(const Ctx& X, const float* W, int K, int N, bf16* WB, int dN, int nmat, size_t sstride, size_t dstride, const float* __restrict__ rscale = nullptr) {
    const int nblk = N / 256, per = (K / 16) * nblk, tot = per * nmat, lane = X.lane;
    f32x4 v[16];
    int it = X.gw;
#define CV_SRC(it_) (W + (size_t)((it_) / per) * sstride + (size_t)(16 * (((it_) % per) / nblk)) * N + 256 * (((it_) % per) % nblk) + 4 * lane)
    if (it < tot) { const float* s = CV_SRC(it);
#pragma unroll
        for (int i = 0; i < 16; ++i) v[i] = __builtin_nontemporal_load((const f32x4*)(s + (size_t)i * N)); }
    while (it < tot) {
        v2u o[16];
        if (rscale) { const int k0s = 16 * ((it % per) / nblk);
#pragma unroll
            for (int i = 0; i < 16; ++i) { const float sc = rscale[k0s + i]; o[i].x = cvtpk_(v[i][0] * sc, v[i][1] * sc); o[i].y = cvtpk_(v[i][2] * sc, v[i][3] * sc); } }
        else {
#pragma unroll
        for (int i = 0; i < 16; ++i) { o[i].x = cvtpk_(v[i][0], v[i][1]); o[i].y = cvtpk_(v[i][2], v[i][3]); } }
        const int nit = it + X.ngw;
        if (nit < tot) { const float* s = CV_SRC(nit);
#pragma unroll
            for (int i = 0; i < 16; ++i) v[i] = __builtin_nontemporal_load((const f32x4*)(s + (size_t)i * N)); }
        const int mi = it / per, r = it - mi * per, k0 = 16 * (r / nblk), n = 256 * (r % nblk) + 4 * lane;
        const int dc = MAP == 0 ? n : (((n >> 7) << 8) + (n & 127) + (MAP == 3 ? 128 : 0));
        bf16* dst = WB + (size_t)mi * dstride + (size_t)k0 * dN + dc;
#pragma unroll
        for (int i = 0; i < 16; ++i) __builtin_nontemporal_store(o[i], (v2u*)(dst + (size_t)i * dN));
        it = nit;
    }
#undef CV_SRC
}
__device__ __forceinline__ void p0_experts(const Ctx& X, const Args& a, int l) {
    bf16* wgu = (bf16*)(X.ws + WS_WGU) + (size_t)l * E * 2 * F * D; bf16* wd = (bf16*)(X.ws + WS_WD) + (size_t)l * E * F * D;
    p0_convert<2>(X, a.in[25] + (size_t)l * E * D * F, D, F, wgu, 2 * F, E, (size_t)D * F, (size_t)2 * F * D, a.in[22] + l * D);
    p0_convert<3>(X, a.in[26] + (size_t)l * E * D * F, D, F, wgu, 2 * F, E, (size_t)D * F, (size_t)2 * F * D, a.in[22] + l * D);
    p0_convert<0>(X, a.in[27] + (size_t)l * E * D * F, F, D, wd, D, E, (size_t)F * D, (size_t)F * D);
}
#ifndef MK_P0_DUP
#define MK_P0_DUP 0
#endif
__device__ __forceinline__ void p0_prologue(const Ctx& X, const Args& a) {
    const int m = a.p0_mask;
    for (int dup_ = 0; dup_ < ((MK_P0_DUP & 1) ? 2 : 1); ++dup_)
    if (m & 1) {
        p0_transpose<1>(X, a.in[2], D, INW, (bf16*)(X.ws + WS_WIN), 2, (size_t)D * INW, (size_t)D * INW);
        p0_transpose<0>(X, a.in[19], C, D, (bf16*)(X.ws + WS_WUH), 2, (size_t)C * D, (size_t)2 * C * D);
        p0_transpose<0>(X, a.in[20], C, D, (bf16*)(X.ws + WS_WUA), 2, (size_t)C * D, (size_t)2 * C * D);
        p0_transpose<0>(X, a.in[21], D, D, (bf16*)(X.ws + WS_WOUT), 2, (size_t)D * D, (size_t)D * D);
        float* binp = (float*)(X.ws + WS_BINP);
        for (int i = X.gw * 64 + X.lane; i < 2 * INW; i += X.ngw * 64) { const int l = i / INW, n = i - l * INW; binp[l * INW + rowmap<1>(n)] = a.in[3][i]; }
        { bf16* wrp = (bf16*)(X.ws + WS_WRP);
          for (int i = X.gw * 64 + X.lane; i < 2 * E * D; i += X.ngw * 64) { const int l = i / (E * D), e = (i / D) % E, k = i % D; const float v = a.in[22][l * D + k] * a.in[23][((size_t)l * D + k) * E + e];
              const unsigned hi = f2bf(v); const float lo = v - __builtin_bit_cast(float, hi << 16); wrp[((l * 2 + 0) * E + e) * D + k] = (bf16)hi; wrp[((l * 2 + 1) * E + e) * D + k] = (bf16)f2bf(lo); } }
        float* rope = (float*)(X.ws + WS_ROPE);
        for (int i = X.gw * 64 + X.lane; i < S * 32; i += X.ngw * 64) { const int pos = i >> 5, j = i & 31; const float inv = powf(10000.0f, -(float)j * 2.0f / 64.0f); float sn, cs; sincosf((float)pos * inv, &sn, &cs); rope[2 * i] = cs; rope[2 * i + 1] = sn; }
    }
    if (m & 2) { p0_experts(X, a, 0); p0_experts(X, a, 1); }
    for (int dup_ = 0; dup_ < ((MK_P0_DUP & 4) ? 2 : 1); ++dup_)
    if (m & 4) p0_filters(X, a);
    for (int dup_ = 0; dup_ < ((MK_P0_DUP & 8) ? 2 : 1); ++dup_)
    if (m & 8) {
        bf16* XN = (bf16*)(X.ws + WS_XN); const int lane = X.lane; Row8 gg; row8_load(gg, a.in[1], lane);
        int r = X.gw; Row8 cur; if (r < T) row8_load(cur, a.in[0] + (size_t)r * D, lane);
        while (r < T) { const int nr = r + X.ngw; Row8 nxt; if (nr < T) row8_load(nxt, a.in[0] + (size_t)nr * D, lane);
            const float rs = rsqrtf(wave_sum(row8_sumsq(cur)) * (1.f / D) + 1e-6f);
#pragma unroll
            for (int j = 0; j < 2; ++j) { const f32x4 y0 = cur.a[j][0] * gg.a[j][0] * rs, y1 = cur.a[j][1] * gg.a[j][1] * rs;
                v4u w; w.x = pk2(y0.x, y0.y); w.y = pk2(y0.z, y0.w); w.z = pk2(y1.x, y1.y); w.w = pk2(y1.z, y1.w); ((v4u*)(XN + (size_t)r * D))[lane + 64 * j] = w; }
            cur = nxt; r = nr; }
    }
}
}
namespace mk {
using pg8::Unit;
#ifndef MK_SIMPLE_ORDER
#define MK_SIMPLE_ORDER 0
#endif
__device__ __forceinline__ unsigned cvtpk(float lo, float hi) { unsigned r; asm volatile("v_cvt_pk_bf16_f32 %0, %1, %2" : "=v"(r) : "v"(lo), "v"(hi)); return r; }
__device__ __forceinline__ v4u pack8(f32x4 a, f32x4 b) { v4u w; w.x = cvtpk(a[0], a[1]); w.y = cvtpk(a[2], a[3]); w.z = cvtpk(b[0], b[1]); w.w = cvtpk(b[2], b[3]); return w; }
__device__ __forceinline__ void unpack8(v4u w, f32x4& a, f32x4& b) { a = (f32x4){bflo(w.x), bfhi(w.x), bflo(w.y), bfhi(w.y)}; b = (f32x4){bflo(w.z), bfhi(w.z), bflo(w.w), bfhi(w.w)}; }
__device__ __forceinline__ float fsig(float x) { return __builtin_amdgcn_rcpf(1.f + __expf(-x)); }

struct EpiWin {
    static constexpr bool PERM = true, AFTER_DRAIN = false;
    unsigned char* ws; const float* bias; const float* rope;
    __device__ __forceinline__ void operator()(const f32x4 (&acc)[2][2][4][2], const Unit& u, int wr, int wc, int fr, int fq) const {
        const int colt = u.pn * 256, row0 = u.pm * 256 + wr * 64 + fr, cin = wc * 32 + 8 * fq;
        bf16* base; int ldc, col0, mode; float sc = 1.f;
        if (colt < 1536) { base = (bf16*)(ws + WS_U); ldc = 1536; col0 = colt; mode = 0; }
        else if (colt < 2048) { base = (bf16*)(ws + WS_Q); ldc = 512; col0 = colt - 1536; mode = 1; sc = QSCALE; }
        else if (colt < 2560) { base = (bf16*)(ws + WS_K); ldc = 512; col0 = colt - 2048; mode = 1; }
        else if (colt < 3072) { base = (bf16*)(ws + WS_V); ldc = 512; col0 = colt - 2560; mode = 0; }
        else if (colt < 4096) { base = (bf16*)(ws + WS_GH); ldc = 1024; col0 = colt - 3072; mode = 2; }
        else { base = (bf16*)(ws + WS_GA); ldc = 1024; col0 = colt - 4096; mode = 2; }
        f32x4 bv[2][2];
#pragma unroll
        for (int bj = 0; bj < 2; ++bj)
#pragma unroll
            for (int n = 0; n < 2; ++n) bv[bj][n] = *(const f32x4*)(bias + colt + bj * 128 + cin + 4 * n);
#pragma unroll
        for (int ai = 0; ai < 2; ++ai)
#pragma unroll
            for (int m = 0; m < 4; ++m) {
                const int row = row0 + ai * 128 + m * 16; bf16* rowp = base + (size_t)row * ldc + col0 + cin;
#pragma unroll
                for (int bj = 0; bj < 2; ++bj) {
                    f32x4 v0 = acc[ai][bj][m][0] + bv[bj][0], v1 = acc[ai][bj][m][1] + bv[bj][1];
                    if (mode == 1) {
                        const int i = ((bj * 128 + cin) & 63) >> 3; const float* rp = rope + ((size_t)(row & (S - 1)) * 32 + 4 * i) * 2;
                        const f32x4 r0 = *(const f32x4*)rp, r1 = *(const f32x4*)(rp + 4);
                        const f32x4 cs = {r0[0], r0[2], r1[0], r1[2]}, sn = {r0[1], r0[3], r1[1], r1[3]};
                        const f32x4 o1 = (v0 * cs - v1 * sn) * sc, o2 = (v1 * cs + v0 * sn) * sc; v0 = o1; v1 = o2;
                    } else if (mode == 2) {
#pragma unroll
                        for (int e = 0; e < 4; ++e) { v0[e] = fsig(v0[e]); v1[e] = fsig(v1[e]); }
                    }
                    *(v4u*)(rowp + bj * 128) = pack8(v0, v1);
                }
            }
    }
};
struct EpiMerge2 {
    static constexpr bool PERM = true, AFTER_DRAIN = false;
    const bf16* GH; const bf16* GA; bf16* T1; bf16* MG;
    __device__ __forceinline__ void operator()(const f32x4 (&acc)[2][2][4][2], const Unit& u, int wr, int wc, int fr, int fq) const {
        const int row0 = u.pm * 256 + wr * 64 + fr, col0 = u.pn * 256 + wc * 32 + 8 * fq; const bool second = u.pa != u.pm; const bf16* G = second ? GA : GH;
#pragma unroll
        for (int ai = 0; ai < 2; ++ai)
#pragma unroll
            for (int m = 0; m < 4; ++m) { const size_t off = (size_t)(row0 + ai * 128 + m * 16) * D + col0;
#pragma unroll
                for (int bj = 0; bj < 2; ++bj) { f32x4 g0, g1; unpack8(*(const v4u*)(G + off + bj * 128), g0, g1);
                    f32x4 v0 = acc[ai][bj][m][0] * g0, v1 = acc[ai][bj][m][1] * g1;
                    if (second) { f32x4 t0, t1; unpack8(*(const v4u*)(T1 + off + bj * 128), t0, t1); v0 += t0; v1 += t1; *(v4u*)(MG + off + bj * 128) = pack8(v0, v1); }
                    else *(v4u*)(T1 + off + bj * 128) = pack8(v0, v1); } }
    }
};
struct OrderMerge {
    pg8::StaticOrder so;
    __device__ __forceinline__ bool next(int i, Unit& u) const { if (!so.next(i >> 1, u)) return false; if (i & 1) { u.pa = u.pm + T / 256; u.pb = u.pn + 4; } return true; }
    __device__ __forceinline__ void a_ready(const Unit&) const {}
    __device__ __forceinline__ void done(const Unit&) const {}
};
struct EpiOut {
    static constexpr bool PERM = false, AFTER_DRAIN = false;
    const float* xin; float* X;
    __device__ __forceinline__ void operator()(const f32x4 (&acc)[2][2][4][2], const Unit& u, int wr, int wc, int fr, int fq) const {
        const int row0 = u.pm * 256 + wr * 64 + fr, col0 = u.pn * 256 + wc * 32 + 4 * fq;
#pragma unroll
        for (int ai = 0; ai < 2; ++ai)
#pragma unroll
            for (int m = 0; m < 4; ++m) { const size_t off = (size_t)(row0 + ai * 128 + m * 16) * D + col0;
#pragma unroll
                for (int bj = 0; bj < 2; ++bj)
#pragma unroll
                    for (int n = 0; n < 2; ++n) *(f32x4*)(X + off + bj * 128 + n * 16) = *(const f32x4*)(xin + off + bj * 128 + n * 16) + acc[ai][bj][m][n]; }
    }
};
struct EpiOutR {
    static constexpr bool PERM = true, AFTER_DRAIN = true;
    const float* xin; float* X; bf16* XB; float* PART; const bf16* WRP; unsigned* tick; float* AFFT; float* RTOK; const float* br;
    __device__ __forceinline__ void operator()(const f32x4 (&)[2][2][4][2], const Unit&, int, int, int, int) const {}
    __device__ __forceinline__ void fused(const f32x4 (&acc)[2][2][4][2], const Unit& u, int wr, int wc, int fr, int fq, LAS unsigned char* lds, int wid, int lane) const {
        LAS float* SS = (LAS float*)lds;
        LAS float* LG = (LAS float*)(lds + 16384);
        const int rowl0 = wr * 64 + fr, colw = wc * 32 + 8 * fq;
        bf16x8 whi[2], wlo[2];
#pragma unroll
        for (int bj = 0; bj < 2; ++bj) { const bf16* wp = WRP + (size_t)fr * D + u.pn * 256 + bj * 128 + colw; whi[bj] = *(const bf16x8*)wp; wlo[bj] = *(const bf16x8*)(wp + (size_t)E * D); }
#pragma unroll
        for (int ai = 0; ai < 2; ++ai)
#pragma unroll
            for (int m = 0; m < 4; ++m) { const int rowl = rowl0 + ai * 128 + m * 16; float ss = 0.f; f32x4 lg = {0.f, 0.f, 0.f, 0.f};
#pragma unroll
                for (int bj = 0; bj < 2; ++bj) { const size_t off = (size_t)(u.pm * 256 + rowl) * D + u.pn * 256 + bj * 128 + colw;
                    const f32x4 x0 = *(const f32x4*)(xin + off) + acc[ai][bj][m][0], x1 = *(const f32x4*)(xin + off + 4) + acc[ai][bj][m][1];
                    *(f32x4*)(X + off) = x0; *(f32x4*)(X + off + 4) = x1;
                    const v4u hi = pack8(x0, x1); *(v4u*)(XB + off) = hi;
                    f32x4 h0, h1; unpack8(hi, h0, h1); const v4u lo = pack8(x0 - h0, x1 - h1);
                    ss += ((x0[0] * x0[0] + x0[1] * x0[1]) + (x0[2] * x0[2] + x0[3] * x0[3])) + ((x1[0] * x1[0] + x1[1] * x1[1]) + (x1[2] * x1[2] + x1[3] * x1[3]));
                    lg = __builtin_amdgcn_mfma_f32_16x16x32_bf16(whi[bj], __builtin_bit_cast(bf16x8, hi), lg, 0, 0, 0);
                    lg = __builtin_amdgcn_mfma_f32_16x16x32_bf16(whi[bj], __builtin_bit_cast(bf16x8, lo), lg, 0, 0, 0);
                    lg = __builtin_amdgcn_mfma_f32_16x16x32_bf16(wlo[bj], __builtin_bit_cast(bf16x8, hi), lg, 0, 0, 0); }
                SS[rowl * 16 + wc * 4 + fq] = ss;
                *(LAS f32x4*)(LG + ((wc * 256 + rowl) * 16 + 4 * fq)) = lg; }
        __syncthreads();
        const int t = wid * 64 + lane;
        if (t < 256) { float s = 0.f;
#pragma unroll
            for (int i = 0; i < 4; ++i) { const f32x4 v = *(const LAS f32x4*)(SS + t * 16 + 4 * i); s += (v[0] + v[1]) + (v[2] + v[3]); }
            float* pp = PART + ((size_t)u.pn * T + u.pm * 256 + t) * 20;
            __hip_atomic_store(pp, s, __ATOMIC_RELAXED, __HIP_MEMORY_SCOPE_AGENT);
#pragma unroll
            for (int i = 0; i < 4; ++i) { f32x4 a4 = *(const LAS f32x4*)(LG + (t * 16 + 4 * i));
#pragma unroll
                for (int w = 1; w < 4; ++w) a4 += *(const LAS f32x4*)(LG + ((w * 256 + t) * 16 + 4 * i));
#pragma unroll
                for (int q = 0; q < 4; ++q) __hip_atomic_store(pp + 4 + 4 * i + q, a4[q], __ATOMIC_RELAXED, __HIP_MEMORY_SCOPE_AGENT); } }
        asm volatile("s_waitcnt vmcnt(0)" ::: "memory");
        __syncthreads();
        LAS int* flag = (LAS int*)(lds + 16384 + 65536);
        if (t == 0) flag[0] = (int)__hip_atomic_fetch_add(tick + u.pm, 1u, __ATOMIC_RELAXED, __HIP_MEMORY_SCOPE_AGENT);
        __syncthreads();
        if (flag[0] == 3) {
            if (t < 256) { const int tok = u.pm * 256 + t; f32x4 s4 = {0.f, 0.f, 0.f, 0.f}, l4[4];
#pragma unroll
                for (int j = 0; j < 4; ++j) l4[j] = (f32x4){0.f, 0.f, 0.f, 0.f};
#pragma unroll
                for (int pn = 0; pn < 4; ++pn) { const float* pq = PART + ((size_t)pn * T + tok) * 20; s4[0] += __hip_atomic_load(pq, __ATOMIC_RELAXED, __HIP_MEMORY_SCOPE_AGENT);
#pragma unroll
                    for (int j = 0; j < 4; ++j)
#pragma unroll
                        for (int q = 0; q < 4; ++q) l4[j][q] += __hip_atomic_load(pq + 4 + 4 * j + q, __ATOMIC_RELAXED, __HIP_MEMORY_SCOPE_AGENT); }
                const float r = rsqrtf(s4[0] * (1.f / D) + 1e-6f); float mx = -1e30f;
#pragma unroll
                for (int j = 0; j < 4; ++j)
#pragma unroll
                    for (int q = 0; q < 4; ++q) { const float v = l4[j][q] * r + br[4 * j + q]; l4[j][q] = v; mx = fmaxf(mx, v); }
                float l = 0.f;
#pragma unroll
                for (int j = 0; j < 4; ++j)
#pragma unroll
                    for (int q = 0; q < 4; ++q) { l4[j][q] = expf(l4[j][q] - mx); l += l4[j][q]; }
                const int b = tok >> 12, s_ = tok & (S - 1);
#pragma unroll
                for (int j = 0; j < 4; ++j)
#pragma unroll
                    for (int q = 0; q < 4; ++q) AFFT[((size_t)b * E + 4 * j + q) * S + s_] = l4[j][q] / l;
                RTOK[tok] = r; } }
        __syncthreads();
    }
};
struct EpiSwiGLU {
    static constexpr bool PERM = true, AFTER_DRAIN = false;
    bf16* HB; const float* RSL;
    __device__ __forceinline__ void operator()(const f32x4 (&acc)[2][2][4][2], const Unit& u, int wr, int wc, int fr, int fq) const {
        const int row0 = u.pm * 256 + wr * 64 + fr, col0 = u.pn * 128 + wc * 32 + 8 * fq;
#pragma unroll
        for (int ai = 0; ai < 2; ++ai)
#pragma unroll
            for (int m = 0; m < 4; ++m) { f32x4 h[2]; const float rr = RSL[row0 + ai * 128 + m * 16];
#pragma unroll
                for (int n = 0; n < 2; ++n) { const f32x4 g = acc[ai][0][m][n] * rr, up = acc[ai][1][m][n] * rr;
#pragma unroll
                    for (int e = 0; e < 4; ++e) h[n][e] = g[e] * fsig(g[e]) * up[e]; }
                *(v4u*)(HB + (size_t)(row0 + ai * 128 + m * 16) * F + col0) = pack8(h[0], h[1]); }
    }
};
struct EpiDown {
    static constexpr bool PERM = true, AFTER_DRAIN = false;
    bf16* YE; const float* gate;
    __device__ __forceinline__ void operator()(const f32x4 (&acc)[2][2][4][2], const Unit& u, int wr, int wc, int fr, int fq) const {
        const int row0 = u.pm * 256 + wr * 64 + fr, col0 = u.pn * 256 + wc * 32 + 8 * fq;
#pragma unroll
        for (int ai = 0; ai < 2; ++ai)
#pragma unroll
            for (int m = 0; m < 4; ++m) { const int row = row0 + ai * 128 + m * 16; const float g = gate[row];
#pragma unroll
                for (int bj = 0; bj < 2; ++bj) *(v4u*)(YE + (size_t)row * D + col0 + bj * 128) = pack8(acc[ai][bj][m][0] * g, acc[ai][bj][m][1] * g); }
    }
};
struct OrderMoE1 {
    int G, c;
    __device__ __forceinline__ bool next(int i, Unit& u) const {
        if (MK_SIMPLE_ORDER || G != 256) { const int L = i * G + c; if (L >= 2048) return false; const int e = L >> 7, r = L & 127; u.pm = e * 8 + (r & 7); u.pn = r >> 3; u.pb = e * 16 + u.pn; u.pa = u.pm; return true; }
        if (i >= 8) return false;
        const int ch = i * 8 + (c & 7), j = c >> 3, e = ch >> 2, ng = ch & 3; u.pm = e * 8 + (j & 7); u.pn = ng * 4 + (j >> 3); u.pb = e * 16 + u.pn; u.pa = u.pm; return true;
    }
    __device__ __forceinline__ void a_ready(const Unit&) const {}
    __device__ __forceinline__ void done(const Unit&) const {}
};
struct OrderMoE2 {
    int G, c;
    __device__ __forceinline__ bool next(int i, Unit& u) const {
        if (MK_SIMPLE_ORDER || G != 256) { const int L = i * G + c; if (L >= 512) return false; const int e = L >> 5, r = L & 31; u.pm = e * 8 + (r & 7); u.pn = r >> 3; u.pb = e * 4 + u.pn; u.pa = u.pm; return true; }
        if (i >= 2) return false;
        const int e = i * 8 + (c & 7), j = c >> 3; u.pm = e * 8 + (j & 7); u.pn = j >> 3; u.pb = e * 4 + u.pn; u.pa = u.pm; return true;
    }
    __device__ __forceinline__ void a_ready(const Unit&) const {}
    __device__ __forceinline__ void done(const Unit&) const {}
};

__device__ __forceinline__ void p6_topk(const Ctx& X) {
    const float* afft = (const float*)(X.ws + WS_AFFT); const float* rtok = (const float*)(X.ws + WS_RTOK); int* rows = (int*)(X.ws + WS_ROWS); float* gate = (float*)(X.ws + WS_GATE); float* rsl = (float*)(X.ws + WS_RSL); int* inv = (int*)(X.ws + WS_INV);
    for (int p = X.bid; p < B * E; p += X.G) { const int b = p >> 4, e = p & 15, slotbase = e * 2048 + b * 512;
        unsigned key[8]; float rr[8];
        { const uint4 k0 = ((const uint4*)(afft + (size_t)p * S))[X.tid * 2], k1 = ((const uint4*)(afft + (size_t)p * S))[X.tid * 2 + 1]; const f32x4 r0 = ((const f32x4*)(rtok + b * S))[X.tid * 2], r1 = ((const f32x4*)(rtok + b * S))[X.tid * 2 + 1];
          key[0] = k0.x; key[1] = k0.y; key[2] = k0.z; key[3] = k0.w; key[4] = k1.x; key[5] = k1.y; key[6] = k1.z; key[7] = k1.w;
          rr[0] = r0[0]; rr[1] = r0[1]; rr[2] = r0[2]; rr[3] = r0[3]; rr[4] = r1[0]; rr[5] = r1[1]; rr[6] = r1[2]; rr[7] = r1[3]; }
        tk::topk_problem(key, rr, b * S, e, slotbase, rows + slotbase, gate + slotbase, rsl + slotbase, inv, (int*)(X.lds), X.tid); }
}
__device__ __forceinline__ void p9_combine(const Ctx& X, float* Xr, const float* __restrict__ g, bool final_, float* __restrict__ out) {
    const int* inv = (const int*)(X.ws + WS_INV); const bf16* YE = (const bf16*)(X.ws + WS_YE); bf16* XN = (bf16*)(X.ws + WS_XN); const int lane = X.lane;
    Row8 gg; row8_load(gg, g, lane);
    int tok = X.gw; Row8 cur; int myinv = -1;
    if (tok < T) { row8_load(cur, Xr + (size_t)tok * D, lane); if (lane < 16) myinv = inv[(size_t)tok * E + lane]; }
    while (tok < T) {
        const int ntok = tok + X.ngw; Row8 nxt; int ninv = -1;
        if (ntok < T) { row8_load(nxt, Xr + (size_t)ntok * D, lane); if (lane < 16) ninv = inv[(size_t)ntok * E + lane]; }
        unsigned long long m = __ballot(myinv >= 0);
        while (m) {
            int sl[4];
#pragma unroll
            for (int i = 0; i < 4; ++i) { if (m) { const int e = __builtin_ctzll(m); m &= m - 1; sl[i] = __builtin_amdgcn_readlane(myinv, e); } else sl[i] = -1; }
            v4u y[4][2];
#pragma unroll
            for (int i = 0; i < 4; ++i) if (sl[i] >= 0) { const v4u* yp = (const v4u*)(YE + (size_t)sl[i] * D); y[i][0] = __builtin_nontemporal_load(yp + lane); y[i][1] = __builtin_nontemporal_load(yp + lane + 64); }
#pragma unroll
            for (int i = 0; i < 4; ++i) if (sl[i] >= 0) {
#pragma unroll
                for (int j = 0; j < 2; ++j) { f32x4 p, q; unpack8(y[i][j], p, q); cur.a[j][0] += p; cur.a[j][1] += q; } }
        }
        const float r = rsqrtf(wave_sum(row8_sumsq(cur)) * (1.f / D) + 1e-6f);
        if (final_) {
#pragma unroll
            for (int j = 0; j < 2; ++j)
#pragma unroll
                for (int h = 0; h < 2; ++h) ((f32x4*)(out + (size_t)tok * D))[2 * (lane + 64 * j) + h] = cur.a[j][h] * gg.a[j][h] * r;
        } else {
#pragma unroll
            for (int j = 0; j < 2; ++j) {
#pragma unroll
                for (int h = 0; h < 2; ++h) ((f32x4*)(Xr + (size_t)tok * D))[2 * (lane + 64 * j) + h] = cur.a[j][h];
                const f32x4 y0 = cur.a[j][0] * gg.a[j][0] * r, y1 = cur.a[j][1] * gg.a[j][1] * r;
                v4u w; w.x = pk2(y0.x, y0.y); w.y = pk2(y0.z, y0.w); w.z = pk2(y1.x, y1.y); w.w = pk2(y1.z, y1.w);
                ((v4u*)(XN + (size_t)tok * D))[lane + 64 * j] = w; }
        }
        cur = nxt; myinv = ninv; tok = ntok;
    }
}
}
namespace mk {
__device__ __forceinline__ void p1t_shortconv(const Ctx& X, const float* __restrict__ cw, const float* __restrict__ cb) {
    const bf16* U = (const bf16*)(X.ws + WS_U); bf16* UCT = (bf16*)(X.ws + WS_UCT);
    LAS float* raw = (LAS float*)(X.lds + X.wave * 17408);
    const int lane = X.lane, rq = lane >> 3, cq = lane & 7;
    constexpr int NIT = (T / 64) * 24;
    v4u w[9];
#define P1T_LOAD(it_) do { const int tt_ = (it_) / 24, cg_ = (it_) - tt_ * 24, tok0_ = tt_ * 64, tin_ = tok0_ & (S - 1); \
        _Pragma("unroll") for (int i = 0; i < 9; ++i) { const int r = 8 * i + rq, tpos = tin_ + r - 1; w[i] = (v4u){0u, 0u, 0u, 0u}; \
            if (r < 66 && tpos >= 0 && tpos < S) w[i] = *(const v4u*)(U + (size_t)(tok0_ + r - 1) * 1536 + cg_ * 64 + 8 * cq); } } while (0)
    int it = X.gw;
    if (it < NIT) P1T_LOAD(it);
    while (it < NIT) {
        const int tt = it / 24, cg = it - tt * 24, tok0 = tt * 64, ch0 = cg * 64;
#pragma unroll
        for (int i = 0; i < 9; ++i) { const int r = 8 * i + rq; if (r < 66) { LAS float* d = raw + r * 65 + 8 * cq; f32x4 p, q; unpack8(w[i], p, q);
            d[0] = p.x; d[1] = p.y; d[2] = p.z; d[3] = p.w; d[4] = q.x; d[5] = q.y; d[6] = q.z; d[7] = q.w; } }
        const int nit = it + X.ngw;
        if (nit < NIT) P1T_LOAD(nit);
        asm volatile("s_waitcnt lgkmcnt(0)" ::: "memory");
        const int chs = lane >> 3, tch = lane & 7;
#pragma unroll
        for (int g = 0; g < 8; ++g) { const int ch = 8 * g + chs, gc = ch0 + ch; const float w0 = cw[gc], w1 = cw[1536 + gc], w2 = cw[3072 + gc], bb = cb[gc];
            float v[10];
#pragma unroll
            for (int k = 0; k < 10; ++k) v[k] = raw[(8 * tch + k) * 65 + ch];
            float o[8];
#pragma unroll
            for (int k = 0; k < 8; ++k) o[k] = v[k] * w0 + v[k + 1] * w1 + v[k + 2] * w2 + bb;
            v4u pk; pk.x = pk2(o[0], o[1]); pk.y = pk2(o[2], o[3]); pk.z = pk2(o[4], o[5]); pk.w = pk2(o[6], o[7]);
            *(v4u*)(UCT + (size_t)gc * T + tok0 + 8 * tch) = pk; }
        asm volatile("s_waitcnt lgkmcnt(0)" ::: "memory");
        it = nit;
    }
#undef P1T_LOAD
}

__device__ __forceinline__ void p1t_kmax(const Ctx& X, unsigned* kmax2) {
    const bf16* K = (const bf16*)(X.ws + WS_K); const int lane = X.lane; LAS float* red = (LAS float*)(X.lds + 8 * 17408);
    const int b = X.gw / 512, t0 = X.gw % 512; float mx = 0.f;
    if (b < B) {
        v4u w[8];
#pragma unroll
        for (int i = 0; i < 8; ++i) w[i] = ((const v4u*)(K + ((size_t)b * S + t0 + 512 * i) * 512))[lane];
#pragma unroll
        for (int i = 0; i < 8; ++i) { f32x4 p, q; unpack8(w[i], p, q); float ss = (p.x * p.x + p.y * p.y) + (p.z * p.z + p.w * p.w) + (q.x * q.x + q.y * q.y) + (q.z * q.z + q.w * q.w);
            ss += xor_f<1>(ss); ss += xor_f<2>(ss); ss += xor_f<4>(ss); mx = fmaxf(mx, ss); }
    }
    __syncthreads();
    if ((lane & 7) == 0) red[X.wave * 8 + (lane >> 3)] = mx;
    __syncthreads();
    if (X.tid < 8 && b < B) { float m = red[X.tid]; for (int w_ = 1; w_ < 8; ++w_) m = fmaxf(m, red[w_ * 8 + X.tid]); atomicMax(kmax2 + b * 8 + X.tid, __float_as_uint(m)); }
}

namespace at {
constexpr int KVBLK = 64, LDK = 512;
constexpr int KPITCH = 272;
constexpr int SHM_V = 64 * 128 * 2, SHM_K = 64 * KPITCH;
constexpr int OFF_V = 0, OFF_K = 2 * SHM_V, OFF_Q = OFF_K + 2 * SHM_K, OFF_WS = OFF_Q + 256 * KPITCH, LDS_TOTAL = OFF_WS + 8 * 160 * 4;
constexpr float THR2 = 8.0f * 1.4426950408889634f;
#define KSWZ(row, colB) ((row) * KPITCH + (colB))
#define SBAR() __builtin_amdgcn_sched_barrier(0)
__device__ __forceinline__ int crow(int r, int hi) { return (r & 3) + 8 * (r >> 2) + 4 * hi; }
__device__ __forceinline__ int v_st(int k, int c) { const int kk = (k & ~0xC) | ((k & 4) << 1) | ((k & 8) >> 1); return ((kk >> 3) * 4 + (c >> 5)) * 512 + ((kk & 7) * 32 + (c & 31)) * 2; }
__device__ __forceinline__ int v_rd_base(int lane) { return ((lane & 3) << 3) | (((lane >> 2) & 3) << 6) | (((lane >> 4) & 1) << 5) | (((lane >> 5) & 1) << 8); }
constexpr int v_rd_off(int d0, int ks, int half) { return d0 * 512 + ks * 4096 + half * 2048; }
template <int OFF> __device__ __forceinline__ s16x4 tr_read(int vb) { s16x4 r; asm volatile("ds_read_b64_tr_b16 %0, %1 offset:%2" : "=&v"(r) : "v"(vb), "i"(OFF) : "memory"); return r; }

template <int CO> __device__ __forceinline__ void qkt(f32x16& p0, f32x16& p1, const char* Ks, const char* Qs, int qrow, int r32, int hi) {
    p0 = f32x16{}; p1 = f32x16{};
    const char* qp = Qs + KSWZ(qrow, (CO * 64 + hi * 8) * 2); const char* kp = Ks + KSWZ(r32, (CO * 64 + hi * 8) * 2);
#pragma unroll
    for (int d0 = 0; d0 < 4; ++d0) {
        const bf16x8 qf = *reinterpret_cast<const bf16x8*>(qp + d0 * 32);
        const bf16x8 b0 = *reinterpret_cast<const bf16x8*>(kp + d0 * 32);
        const bf16x8 b1 = *reinterpret_cast<const bf16x8*>(kp + 32 * KPITCH + d0 * 32);
        p0 = __builtin_amdgcn_mfma_f32_32x32x16_bf16(b0, qf, p0, 0, 0, 0);
        p1 = __builtin_amdgcn_mfma_f32_32x32x16_bf16(b1, qf, p1, 0, 0, 0);
        if (d0 == 1) asm volatile("" ::: "memory"); }
}
__device__ __forceinline__ void softmax_tile(f32x16& p0, f32x16& p1, float& m_reg, float& l_reg, float& alpha, bf16x8& pa0, bf16x8& pa1, bf16x8& pa2, bf16x8& pa3) {
    float pmax = p0[0];
#pragma unroll
    for (int r = 1; r < 16; ++r) pmax = fmaxf(pmax, p0[r]);
#pragma unroll
    for (int r = 0; r < 16; ++r) pmax = fmaxf(pmax, p1[r]);
    { auto rr = __builtin_amdgcn_permlane32_swap(__float_as_uint(pmax), __float_as_uint(pmax), false, false); pmax = fmaxf(__uint_as_float(rr[0]), __uint_as_float(rr[1])); }
    float mn;
    if (__builtin_expect(__all(pmax - m_reg <= THR2), 1)) { mn = m_reg; alpha = 1.f; }
    else { mn = fmaxf(m_reg, pmax); alpha = __builtin_amdgcn_exp2f(m_reg - mn); m_reg = mn; }
#pragma unroll
    for (int r = 0; r < 16; ++r) { p0[r] = __builtin_amdgcn_exp2f(p0[r] - mn); p1[r] = __builtin_amdgcn_exp2f(p1[r] - mn); }
    float ps = 0.f;
#pragma unroll
    for (int r = 0; r < 16; ++r) ps += p0[r];
#pragma unroll
    for (int r = 0; r < 16; ++r) ps += p1[r];
    { auto rr = __builtin_amdgcn_permlane32_swap(__float_as_uint(ps), __float_as_uint(ps), false, false); ps = __uint_as_float(rr[0]) + __uint_as_float(rr[1]); }
    l_reg = l_reg * alpha + ps;
#define PK4(P, BASE, OUT) do { unsigned a0 = cvtpk(P[BASE + 0], P[BASE + 1]), a1 = cvtpk(P[BASE + 2], P[BASE + 3]);   \
    unsigned b0 = cvtpk(P[BASE + 4], P[BASE + 5]), b1 = cvtpk(P[BASE + 6], P[BASE + 7]);                              \
    auto r0 = __builtin_amdgcn_permlane32_swap(a0, b0, false, false); auto r1 = __builtin_amdgcn_permlane32_swap(a1, b1, false, false); \
    v4u w = {r0[0], r1[0], r0[1], r1[1]}; OUT = *reinterpret_cast<bf16x8*>(&w); } while (0)
    PK4(p0, 0, pa0); PK4(p0, 8, pa1); PK4(p1, 0, pa2); PK4(p1, 8, pa3);
#undef PK4
}
__device__ __forceinline__ void softmax_fixed(f32x16& p0, f32x16& p1, float m, float& l_half, bf16x8& pa0, bf16x8& pa1, bf16x8& pa2, bf16x8& pa3) {
#pragma unroll
    for (int r = 0; r < 16; ++r) { p0[r] = __builtin_amdgcn_exp2f(p0[r] - m); p1[r] = __builtin_amdgcn_exp2f(p1[r] - m); }
    float ps = 0.f;
#pragma unroll
    for (int r = 0; r < 16; ++r) ps += p0[r] + p1[r];
    l_half += ps;
#define PK4(P, BASE, OUT) do { unsigned a0 = cvtpk(P[BASE + 0], P[BASE + 1]), a1 = cvtpk(P[BASE + 2], P[BASE + 3]);   \
    unsigned b0 = cvtpk(P[BASE + 4], P[BASE + 5]), b1 = cvtpk(P[BASE + 6], P[BASE + 7]);                              \
    auto r0 = __builtin_amdgcn_permlane32_swap(a0, b0, false, false); auto r1 = __builtin_amdgcn_permlane32_swap(a1, b1, false, false); \
    v4u w = {r0[0], r1[0], r0[1], r1[1]}; OUT = *reinterpret_cast<bf16x8*>(&w); } while (0)
    PK4(p0, 0, pa0); PK4(p0, 8, pa1); PK4(p1, 0, pa2); PK4(p1, 8, pa3);
#undef PK4
}
template <int D0> __device__ __forceinline__ void pv_one(f32x16& oa, int vb, const bf16x8 (&pa)[4]) {
#define PK(L, H) (bf16x8){L[0], L[1], L[2], L[3], H[0], H[1], H[2], H[3]}
    {   const s16x4 l0 = tr_read<v_rd_off(D0, 0, 0)>(vb), h0 = tr_read<v_rd_off(D0, 0, 1)>(vb), l1 = tr_read<v_rd_off(D0, 1, 0)>(vb), h1 = tr_read<v_rd_off(D0, 1, 1)>(vb);
        asm volatile("s_waitcnt lgkmcnt(0)" ::: "memory"); SBAR();
        oa = __builtin_amdgcn_mfma_f32_32x32x16_bf16(pa[0], PK(l0, h0), oa, 0, 0, 0);
        oa = __builtin_amdgcn_mfma_f32_32x32x16_bf16(pa[1], PK(l1, h1), oa, 0, 0, 0); }
    {   const s16x4 l2 = tr_read<v_rd_off(D0, 2, 0)>(vb), h2 = tr_read<v_rd_off(D0, 2, 1)>(vb), l3 = tr_read<v_rd_off(D0, 3, 0)>(vb), h3 = tr_read<v_rd_off(D0, 3, 1)>(vb);
        asm volatile("s_waitcnt lgkmcnt(0)" ::: "memory"); SBAR();
        oa = __builtin_amdgcn_mfma_f32_32x32x16_bf16(pa[2], PK(l2, h2), oa, 0, 0, 0);
        oa = __builtin_amdgcn_mfma_f32_32x32x16_bf16(pa[3], PK(l3, h3), oa, 0, 0, 0); }
#undef PK
}
template <int D0> __device__ __forceinline__ void pv_two(f32x16& oa, f32x16& ob, int vb, const bf16x8 (&pa)[4], const bf16x8 (&pb)[4]) {
#define PK(L, H) (bf16x8){L[0], L[1], L[2], L[3], H[0], H[1], H[2], H[3]}
    {   const s16x4 l0 = tr_read<v_rd_off(D0, 0, 0)>(vb), h0 = tr_read<v_rd_off(D0, 0, 1)>(vb), l1 = tr_read<v_rd_off(D0, 1, 0)>(vb), h1 = tr_read<v_rd_off(D0, 1, 1)>(vb);
        asm volatile("s_waitcnt lgkmcnt(0)" ::: "memory"); SBAR();
        const bf16x8 v0 = PK(l0, h0), v1 = PK(l1, h1);
        oa = __builtin_amdgcn_mfma_f32_32x32x16_bf16(pa[0], v0, oa, 0, 0, 0); ob = __builtin_amdgcn_mfma_f32_32x32x16_bf16(pb[0], v0, ob, 0, 0, 0);
        oa = __builtin_amdgcn_mfma_f32_32x32x16_bf16(pa[1], v1, oa, 0, 0, 0); ob = __builtin_amdgcn_mfma_f32_32x32x16_bf16(pb[1], v1, ob, 0, 0, 0); }
    {   const s16x4 l2 = tr_read<v_rd_off(D0, 2, 0)>(vb), h2 = tr_read<v_rd_off(D0, 2, 1)>(vb), l3 = tr_read<v_rd_off(D0, 3, 0)>(vb), h3 = tr_read<v_rd_off(D0, 3, 1)>(vb);
        asm volatile("s_waitcnt lgkmcnt(0)" ::: "memory"); SBAR();
        const bf16x8 v2 = PK(l2, h2), v3 = PK(l3, h3);
        oa = __builtin_amdgcn_mfma_f32_32x32x16_bf16(pa[2], v2, oa, 0, 0, 0); ob = __builtin_amdgcn_mfma_f32_32x32x16_bf16(pb[2], v2, ob, 0, 0, 0);
        oa = __builtin_amdgcn_mfma_f32_32x32x16_bf16(pa[3], v3, oa, 0, 0, 0); ob = __builtin_amdgcn_mfma_f32_32x32x16_bf16(pb[3], v3, ob, 0, 0, 0); }
#undef PK
}
__device__ __forceinline__ void rescale(f32x16 (&o)[4], float al, float* wsf, int r32, int hi) {
    if (__any(al < 1.f)) {
        if (hi == 0) wsf[r32] = al; asm volatile("s_waitcnt lgkmcnt(0)" ::: "memory");
#pragma unroll
        for (int r = 0; r < 16; ++r) { const float a = wsf[crow(r, hi)];
#pragma unroll
            for (int d = 0; d < 4; ++d) o[d][r] *= a; }
    }
}

__device__ __forceinline__ void epilogue(const Ctx& X, f32x16 (&oa)[4], f32x16 (&ob)[4], const float* wsf, int r32, int hi, int b, int h, int qb, float lam, float mul, const float* __restrict__ sg) {
    bf16* Yw = (bf16*)(X.ws + WS_YA) + ((size_t)b * S + qb * 256 + X.wave * 32) * 512 + h * 128;
    float gcol[4];
#pragma unroll
    for (int d = 0; d < 4; ++d) gcol[d] = sg[d * 32 + r32] * mul;
#pragma unroll
    for (int r = 0; r < 16; ++r) { const int orow = crow(r, hi); const float i0 = __builtin_amdgcn_rcpf(wsf[orow] + wsf[64 + orow]), i1 = lam * __builtin_amdgcn_rcpf(wsf[32 + orow] + wsf[96 + orow]);
        float v[4], ss = 0.f;
#pragma unroll
        for (int d = 0; d < 4; ++d) { v[d] = oa[d][r] * i0 - ob[d][r] * i1; ss += v[d] * v[d]; }
        ss += xor_f<1>(ss); ss += xor_f<2>(ss); ss += xor_f<4>(ss); ss += xor_f<8>(ss); ss += xor_f<16>(ss);
        const float rn = rsqrtf(ss * (1.f / 128.f) + 1e-5f);
#pragma unroll
        for (int d = 0; d < 4; ++d) Yw[(size_t)orow * 512 + d * 32 + r32] = (bf16)f2bf(v[d] * rn * gcol[d]); }
}
__device__ __forceinline__ int vkey(int T_, int lane) { const int kk = ((T_ >> 2) << 3) | ((lane & 31) >> 2); return (kk & ~0xC) | ((kk & 4) << 1) | ((kk & 8) >> 1); }
__device__ __forceinline__ int vcol(int T_, int lane) { return (T_ & 3) * 32 + (lane & 3) * 8; }
__device__ __forceinline__ void attn_unit(const Ctx& X, int b, int h, int qb, float lam, float mul, const float* __restrict__ sg, unsigned* kmax2) {
    char* lds = (char*)X.lds;
    const int tid = fresh_tid(X.wave_s);
    const int wid = X.wave, lane = tid & 63, r32 = lane & 31, hi = lane >> 5;
    const bf16* Qg = (const bf16*)(X.ws + WS_Q) + ((size_t)b * S + qb * 256) * LDK + h * 128;
    const bf16* Kh = (const bf16*)(X.ws + WS_K) + (size_t)b * S * LDK + h * 128;
    const bf16* Vh = (const bf16*)(X.ws + WS_V) + (size_t)b * S * LDK + h * 128;
    char* V_lds = lds + OFF_V; char* K_lds = lds + OFF_K; char* Q_lds = lds + OFF_Q;
    float* wsf = (float*)(lds + OFF_WS) + wid * 160;
    const int sr = tid >> 4, sc = (tid & 15) * 8, vst0 = v_st(sr, sc), vst1 = v_st(32 + sr, sc);
    const int vb0 = (int)(uintptr_t)V_lds + v_rd_base(lane);
#pragma unroll
    for (int i = 0; i < 8; ++i) { const int row = sr + 32 * i; *(bf16x8*)(Q_lds + KSWZ(row, sc * 2)) = *reinterpret_cast<const bf16x8*>(Qg + (size_t)row * LDK + sc); }
    bf16x8 st0, st1;
    const unsigned goff = (unsigned)(sr * LDK + sc) * 2u;
#define KLOAD(k0) do { const char* t_ = (const char*)Kh + (size_t)(k0) * (LDK * 2); st0 = *reinterpret_cast<const bf16x8*>(t_ + goff); st1 = *reinterpret_cast<const bf16x8*>(t_ + 32 * LDK * 2 + goff); } while (0)
#define VLOAD(k0) do { const char* t_ = (const char*)Vh + (size_t)(k0) * (LDK * 2); st0 = *reinterpret_cast<const bf16x8*>(t_ + goff); st1 = *reinterpret_cast<const bf16x8*>(t_ + 32 * LDK * 2 + goff); } while (0)
#define KWRITE(bb) do { *(bf16x8*)(K_lds + (bb) * SHM_K + KSWZ(sr, sc * 2)) = st0; *(bf16x8*)(K_lds + (bb) * SHM_K + KSWZ(32 + sr, sc * 2)) = st1; } while (0)
    const unsigned vsrc0 = (unsigned)(vkey(2 * wid + (lane >> 5), lane) * LDK + vcol(2 * wid + (lane >> 5), lane)) * 2u, vsrc1 = (unsigned)(vkey(2 * (wid + 8) + (lane >> 5), lane) * LDK + vcol(2 * (wid + 8) + (lane >> 5), lane)) * 2u;
#define VDMA(k0, bbn) do { const char* t_ = (const char*)Vh + (size_t)(k0) * (LDK * 2); LAS unsigned char* d_ = X.lds + OFF_V + (bbn) * SHM_V + wid * 1024; \
    __builtin_amdgcn_global_load_lds((const unsigned*)(t_ + vsrc0), (LAS unsigned*)d_, 16, 0, 0); __builtin_amdgcn_global_load_lds((const unsigned*)(t_ + vsrc1), (LAS unsigned*)(d_ + 8192), 16, 0, 0); } while (0)
    const unsigned ksrc = (unsigned)(wid * 8 * LDK * 2) + (unsigned)lane * 4u;
#define KDMA(k0, bbn) do { const char* t_ = (const char*)Kh + (size_t)(k0) * (LDK * 2) + ksrc; LAS unsigned char* d_ = X.lds + OFF_K + (bbn) * SHM_K + wid * 8 * KPITCH; \
    _Pragma("unroll") for (int i_ = 0; i_ < 8; ++i_) __builtin_amdgcn_global_load_lds((const unsigned*)(t_ + i_ * (LDK * 2)), (LAS unsigned*)(d_ + i_ * KPITCH), 4, 0, 0); } while (0)
#define VWRITE(bb) do { *(bf16x8*)(V_lds + (bb) * SHM_V + vst0) = st0; *(bf16x8*)(V_lds + (bb) * SHM_V + vst1) = st1; } while (0)
    float l0 = 0.f, l1 = 0.f; f32x16 oa[4] = {}, ob[4] = {};
    const int qrow = wid * 32 + r32; constexpr int NT = S / KVBLK;
    KDMA(0, 0); VDMA(0, 0); __syncthreads();
    float m0, m1;
    { float s0 = 0.f, s1 = 0.f;
#pragma unroll
      for (int d0 = 0; d0 < 8; ++d0) { const v4u w = *reinterpret_cast<const v4u*>(Q_lds + KSWZ(qrow, (d0 * 16 + hi * 8) * 2)); f32x4 p, q; unpack8(w, p, q);
          const float ss = (p.x * p.x + p.y * p.y) + (p.z * p.z + p.w * p.w) + (q.x * q.x + q.y * q.y) + (q.z * q.z + q.w * q.w); if (d0 < 4) s0 += ss; else s1 += ss; }
      wsf[hi * 64 + r32] = s0; wsf[hi * 64 + 32 + r32] = s1; asm volatile("s_waitcnt lgkmcnt(0)" ::: "memory");
      s0 += wsf[(hi ^ 1) * 64 + r32]; s1 += wsf[(hi ^ 1) * 64 + 32 + r32]; asm volatile("s_waitcnt lgkmcnt(0)" ::: "memory");
      const float k0 = __uint_as_float(__hip_atomic_load(kmax2 + b * 8 + h * 2, __ATOMIC_RELAXED, __HIP_MEMORY_SCOPE_AGENT)), k1 = __uint_as_float(__hip_atomic_load(kmax2 + b * 8 + h * 2 + 1, __ATOMIC_RELAXED, __HIP_MEMORY_SCOPE_AGENT));
      m0 = sqrtf(s0 * k0) * 1.001f + 1e-3f; m1 = sqrtf(s1 * k1) * 1.001f + 1e-3f; }
    for (int j = 0; j < NT; ++j) {
        const int bb = j & 1; const char* Ks = K_lds + bb * SHM_K;
        const int kn = (j + 1) * KVBLK;
        if (j + 1 < NT) { KDMA(kn, bb ^ 1); VDMA(kn, bb ^ 1); }
        const int vb = vb0 + bb * SHM_V;
        bf16x8 pa[4], pb[4];
        { f32x16 p0, p1, q0, q1;
          qkt<0>(p0, p1, Ks, Q_lds, qrow, r32, hi); qkt<1>(q0, q1, Ks, Q_lds, qrow, r32, hi);
          softmax_fixed(p0, p1, m0, l0, pa[0], pa[1], pa[2], pa[3]);
          softmax_fixed(q0, q1, m1, l1, pb[0], pb[1], pb[2], pb[3]); }
        SBAR();
        pv_two<0>(oa[0], ob[0], vb, pa, pb); pv_two<1>(oa[1], ob[1], vb, pa, pb); pv_two<2>(oa[2], ob[2], vb, pa, pb); pv_two<3>(oa[3], ob[3], vb, pa, pb);
        __syncthreads();
    }
#undef KLOAD
#undef VLOAD
#undef VDMA
#undef KDMA
#undef KWRITE
#undef VWRITE
    wsf[hi * 64 + r32] = l0; wsf[hi * 64 + 32 + r32] = l1; asm volatile("s_waitcnt lgkmcnt(0)" ::: "memory");
    { const int t2 = fresh_tid(X.wave_s); epilogue(X, oa, ob, wsf, t2 & 31, (t2 & 63) >> 5, b, h, qb, lam, mul, sg); }
    __syncthreads();
}
__device__ __forceinline__ void epilogue_unused() {}
#undef KSWZ
#undef SBAR
}
}
namespace mk {
namespace hy {
constexpr int CPS = 16704;
constexpr int NEL = 8352;
constexpr int OFF_Z = 4 * CPS;
constexpr int ZROW = 144, ZB = 128 * ZROW;
constexpr int LDS_TOTAL = OFF_Z + 4 * ZB;

__device__ __forceinline__ void build_hrev(const Ctx& X, const bf16* hf, const bf16* hb, float bias) {
    const int tid = X.tid;
    if (tid < 4 * 8) { const int m = tid >> 3, e = tid & 7; if (e < 5 - m) *(LAS bf16*)(X.lds + m * CPS + 2 * e) = 0; }
    for (int i = tid; i < 4 * (NEL - 8192); i += NTH) { const int m = i / (NEL - 8192), e = 8192 + (i - m * (NEL - 8192)); if (e > 8195 - m) *(LAS bf16*)(X.lds + m * CPS + 2 * e) = 0; }
#pragma unroll
    for (int half = 0; half < 2; ++half) {
        const v4u w = *(const v4u*)((half ? hb : hf) + 8 * tid);
        unsigned short v[8] = {(unsigned short)(w.x & 0xffff), (unsigned short)(w.x >> 16), (unsigned short)(w.y & 0xffff), (unsigned short)(w.y >> 16), (unsigned short)(w.z & 0xffff), (unsigned short)(w.z >> 16), (unsigned short)(w.w & 0xffff), (unsigned short)(w.w >> 16)};
        if (half == 0 && tid == 0) v[0] = (unsigned short)f2bf(bf2f(v[0]) + bias);
#pragma unroll
        for (int k = 0; k < 8; ++k) { const int d = 8 * tid + k; if (half == 1 && d == 0) continue;
            const int e0 = half ? 4100 + d : 4100 - d;
#pragma unroll
            for (int m = 0; m < 4; ++m) *(LAS bf16*)(X.lds + m * CPS + 2 * (e0 - m)) = v[k]; }
    }
}
#ifdef MK_HY_XLDS
#define HY_XL(qq) do { const v2u x0_ = *(const volatile LAS v2u*)(X.lds + baseA + 32 * (qq)), x1_ = *(const volatile LAS v2u*)(X.lds + baseA8 + 32 * (qq)); asm volatile("" :: "v"(x0_), "v"(x1_)); } while (0)
#else
#define HY_XL(qq) do {} while (0)
#endif
#define HY_LDA(dst, qq) do { HY_XL(qq); const v2u lo_ = *(const volatile LAS v2u*)(X.lds + baseA + 32 * (qq)), hi_ = *(const volatile LAS v2u*)(X.lds + baseA8 + 32 * (qq)); v4u w_ = {lo_.x, lo_.y, hi_.x, hi_.y}; dst = *reinterpret_cast<bf16x8*>(&w_); } while (0)
#define HY_LOAD_E(FA, FB, d1_, q_) do { const LAS unsigned char* zr_ = zb - (d1_) * ZROW; HY_LDA(FA[0], (q_)); HY_LDA(FA[1], (q_) + 1); \
    FB[0] = *(const LAS bf16x8*)(zr_); FB[1] = *(const LAS bf16x8*)(zr_ + 32); FB[2] = *(const LAS bf16x8*)(zr_ + 64); FB[3] = *(const LAS bf16x8*)(zr_ + 96); } while (0)
#define HY_LOAD_L(FA, q_) do { HY_LDA(FA[2], (q_) + 2); HY_LDA(FA[3], (q_) + 3); } while (0)
#ifdef MK_HY_XMFMA
#define HY_XM(A_, B_) do { dacc0 = __builtin_amdgcn_mfma_f32_32x32x16_bf16(A_, B_, dacc0, 0, 0, 0); } while (0)
#else
#define HY_XM(A_, B_) do {} while (0)
#endif
#define HY_MMA1(FA, FB, PA) do { __builtin_amdgcn_s_setprio(1); HY_XM(FA[0], FB[0]); HY_XM(PA[2], FB[0]); HY_XM(FA[1], FB[1]); HY_XM(PA[3], FB[1]); \
    acc0 = __builtin_amdgcn_mfma_f32_32x32x16_bf16(FA[0], FB[0], acc0, 0, 0, 0); acc1 = __builtin_amdgcn_mfma_f32_32x32x16_bf16(PA[2], FB[0], acc1, 0, 0, 0); \
    acc0 = __builtin_amdgcn_mfma_f32_32x32x16_bf16(FA[1], FB[1], acc0, 0, 0, 0); acc1 = __builtin_amdgcn_mfma_f32_32x32x16_bf16(PA[3], FB[1], acc1, 0, 0, 0); __builtin_amdgcn_s_setprio(0); } while (0)
#define HY_MMA2(FA, FB) do { __builtin_amdgcn_s_setprio(1); HY_XM(FA[2], FB[2]); HY_XM(FA[0], FB[2]); HY_XM(FA[3], FB[3]); HY_XM(FA[1], FB[3]); \
    acc0 = __builtin_amdgcn_mfma_f32_32x32x16_bf16(FA[2], FB[2], acc0, 0, 0, 0); acc1 = __builtin_amdgcn_mfma_f32_32x32x16_bf16(FA[0], FB[2], acc1, 0, 0, 0); \
    acc0 = __builtin_amdgcn_mfma_f32_32x32x16_bf16(FA[3], FB[3], acc0, 0, 0, 0); acc1 = __builtin_amdgcn_mfma_f32_32x32x16_bf16(FA[1], FB[3], acc1, 0, 0, 0); __builtin_amdgcn_s_setprio(0); } while (0)
template <int PAIR> __device__ __forceinline__ void channel(const Ctx& X, int l, int c, const float* __restrict__ hyb, v2u (&keep)[2][4]) {
    const bf16* UCT = (const bf16*)(X.ws + WS_UCT); const bf16* FILT = (const bf16*)(X.ws + WS_FILT) + (size_t)l * 4 * C * S; bf16* YH = (bf16*)(X.ws + WS_YH);
    const int tid = X.tid, lane = X.lane, wid = X.wave, r = lane & 31, h = lane >> 5, b = wid >> 1, jt = wid & 1;
    LAS unsigned char* zl = X.lds + OFF_Z;
    __syncthreads();
    v4u zero4 = {0u, 0u, 0u, 0u}; asm volatile("" : "+v"(zero4));
    for (int i = tid; i < 4 * 64 * 9; i += NTH) { const int bb = i / 576, rr = (i % 576) / 9, ch = i % 9; const int row = rr < 32 ? rr : 64 + rr;
        *(LAS v4u*)(zl + bb * ZB + row * ZROW + ch * 16) = zero4; }
    for (int i = tid; i < 4 * 64 * 8; i += NTH) { const int bb = i >> 9, s1 = (i >> 3) & 63, ch = i & 7;
        *(LAS v4u*)(zl + bb * ZB + (32 + s1) * ZROW + ch * 16) = *(const v4u*)(UCT + (size_t)c * T + bb * S + s1 * 64 + ch * 8); }
    const int m4 = (4 - (r & 3)) & 3;
    const int baseA = m4 * CPS + 2 * (8 * h - r + 4100 - m4);
    int baseA8 = baseA + 8; asm volatile("" : "+v"(baseA8));
    for (int o = 0; o < 2; ++o) {
        build_hrev(X, FILT + ((size_t)(2 * o) * C + c) * S, FILT + ((size_t)(2 * o + 1) * C + c) * S, hyb[(l * 2 + o) * C + c]);
#ifdef MK_HY_DUPBUILD
        asm volatile("" ::: "memory"); build_hrev(X, FILT + ((size_t)(2 * o) * C + c) * S, FILT + ((size_t)(2 * o + 1) * C + c) * S, hyb[(l * 2 + o) * C + c]);
#endif
        const bf16* gate = UCT + (size_t)((o + 1) * C + c) * T + (size_t)b * S;
        const int t1 = 32 * jt + r;
        v2u gw[2][4];
#pragma unroll
        for (int mt = 0; mt < 2; ++mt)
#pragma unroll
            for (int g = 0; g < 4; ++g) gw[mt][g] = *(const v2u*)(gate + t1 * 64 + 32 * mt + 8 * g + 4 * h);
        __syncthreads();
#ifndef MK_HY_SWEEPS
#define MK_HY_SWEEPS 1
#endif
        f32x16 acc0 = {}, acc1 = {};
#ifdef MK_HY_XMFMA
        f32x16 dacc0 = {};
#endif
        for (int rep = 0; rep < MK_HY_SWEEPS; ++rep) {
        const int d1max = 32 * jt + 31; int q = -4 * d1max;
        const LAS unsigned char* zb = zl + b * ZB + (32 + 32 * jt + r) * ZROW + 16 * h;
        bf16x8 fa0[4], fb0[4], fa1[4], fb1[4];
        HY_LDA(fa1[2], q - 2); HY_LDA(fa1[3], q - 1);
        HY_LOAD_E(fa0, fb0, d1max, q); HY_LOAD_L(fa0, q);
        int d1 = d1max;
        for (int it = 0; it < 47; ++it) {
            HY_LOAD_E(fa1, fb1, d1 - 1, q + 4);
            HY_MMA1(fa0, fb0, fa1);
            HY_LOAD_L(fa1, q + 4);
            HY_MMA2(fa0, fb0);
            HY_LOAD_E(fa0, fb0, d1 - 2, q + 8);
            HY_MMA1(fa1, fb1, fa0);
            HY_LOAD_L(fa0, q + 8);
            HY_MMA2(fa1, fb1);
            d1 -= 2; q += 8;
        }
        HY_MMA1(fa0, fb0, fa1); HY_MMA2(fa0, fb0);
        }
        if (MK_HY_SWEEPS == 2) { acc0 *= 0.5f; acc1 *= 0.5f; }
#ifdef MK_HY_XMFMA
        asm volatile("" :: "v"(dacc0));
#endif
        __syncthreads();
#pragma unroll
        for (int mt = 0; mt < 2; ++mt)
#pragma unroll
            for (int g = 0; g < 4; ++g) { const int t0 = 32 * mt + 8 * g + 4 * h; const v2u gwv = gw[mt][g];
                const f32x16& a = mt ? acc1 : acc0;
                const float y0 = a[4 * g] * bflo(gwv.x), y1 = a[4 * g + 1] * bfhi(gwv.x), y2 = a[4 * g + 2] * bflo(gwv.y), y3 = a[4 * g + 3] * bfhi(gwv.y);
                if (o == 0) { v2u w; w.x = pk2(y0, y1); w.y = pk2(y2, y3); *(LAS v2u*)(zl + b * ZB + (32 + t1) * ZROW + t0 * 2) = w; }
                else if (PAIR == 0) { keep[mt][g].x = pk2(y0, y1); keep[mt][g].y = pk2(y2, y3); }
                else { unsigned* yo = (unsigned*)(YH + ((size_t)b * S + t1 * 64 + t0) * C + (c - 1)); const v2u kp = keep[mt][g];
                    yo[0] = (kp.x & 0xffffu) | (f2bf(y0) << 16); yo[C / 2] = (kp.x >> 16) | (f2bf(y1) << 16); yo[C] = (kp.y & 0xffffu) | (f2bf(y2) << 16); yo[3 * C / 2] = (kp.y >> 16) | (f2bf(y3) << 16); } }
    }
    __syncthreads();
}
#undef HY_LDA
#undef HY_LOAD_E
#undef HY_LOAD_L
#undef HY_MMA1
#undef HY_MMA2
}
}
namespace mk {
#define GAS __attribute__((address_space(1)))
typedef GAS unsigned gu32;
typedef GAS unsigned long long gu64;
#define RLX_AGENT __ATOMIC_RELAXED, __HIP_MEMORY_SCOPE_AGENT
#define LDS_WAIT() asm volatile("s_waitcnt lgkmcnt(0)" ::: "memory")
#define VM_WAIT() asm volatile("s_waitcnt vmcnt(0)" ::: "memory")
__device__ __forceinline__ unsigned long long rt() { return __builtin_amdgcn_s_memrealtime(); }
#define XB_TMO      128
#define XB_XCNT(j)  (256  + 64 * (j))
#define XB_XSUB(j)  (1280 + 64 * (j))
#define XB_XGEN(j)  (2304 + 64 * (j))
#define XB_TOP      3328
#define XB_TOPGEN   3392
#define XCD_BAR_WORDS 3456
#define XB_SPIN_CAP (1u << 18)

__device__ __forceinline__ unsigned xb_ld(unsigned* p)              { return __hip_atomic_load(p, __ATOMIC_RELAXED, __HIP_MEMORY_SCOPE_AGENT); }
__device__ __forceinline__ unsigned xb_add(unsigned* p, unsigned v) { return __hip_atomic_fetch_add(p, v, __ATOMIC_RELAXED, __HIP_MEMORY_SCOPE_AGENT); }
__device__ __forceinline__ unsigned xb_xcc_id() { return (unsigned)__builtin_amdgcn_s_getreg((3 << 11) | 20) & 0xFu; }
#define XB_SPIN(cond, bar) do { unsigned _sp = 0; while (cond) { __builtin_amdgcn_s_sleep(1); \
    if ((++_sp & 255u) == 0u) { if (xb_ld(&(bar)[XB_TMO])) break; if (_sp > XB_SPIN_CAP) { atomicAdd(&(bar)[XB_TMO], 1u); break; } } } } while (0)

struct XcdBarrier {
    unsigned* bar; unsigned x;
    volatile LAS unsigned* st;
};

__device__ __forceinline__ XcdBarrier xcd_barrier_post(unsigned* bar, volatile LAS unsigned* st) {
    XcdBarrier b; b.bar = bar; b.x = xb_xcc_id(); b.st = st;
    if (threadIdx.x == 0) (void)xb_add(&bar[XB_XCNT(b.x)], 1u);
    return b;
}
__device__ __forceinline__ void xcd_barrier_complete(unsigned* bar, unsigned x, unsigned& nloc, unsigned& nx) {
    const unsigned G = gridDim.x * gridDim.y * gridDim.z;
    unsigned sum, cnt, mine, sp = 0u;
    for (;;) {
        sum = 0u; cnt = 0u; mine = 0u;
#pragma unroll
        for (unsigned j = 0; j < 16; ++j) { const unsigned c = xb_ld(&bar[XB_XCNT(j)]); sum += c; cnt += (c > 0u) ? 1u : 0u; mine = (j == x) ? c : mine; }
        if (sum == G) break;
        __builtin_amdgcn_s_sleep(1);
        if ((++sp & 255u) == 0u) { if (xb_ld(&bar[XB_TMO])) break; if (sp > XB_SPIN_CAP) { atomicAdd(&bar[XB_TMO], 1u); break; } }
    }
    nloc = mine > 0u ? mine : 1u; nx = cnt > 0u ? cnt : 1u;
}

__device__ __forceinline__ void xcd_barrier(const XcdBarrier& b, int wave_s) {
    asm volatile("s_waitcnt vmcnt(0)" ::: "memory");
    __syncthreads();
    if (fresh_tid(wave_s) == 0) {
        unsigned* bar = b.bar;
        __builtin_amdgcn_s_waitcnt(0);
        unsigned nloc = b.st[0], nx = b.st[1];
        if (nloc == 0u) { xcd_barrier_complete(bar, b.x, nloc, nx); b.st[0] = nloc; b.st[1] = nx; }
        const unsigned old = xb_add(&bar[XB_XSUB(b.x)], 1u);
        const unsigned gen = old / nloc;
        if (old + 1u == (gen + 1u) * nloc) {
            __builtin_amdgcn_fence(__ATOMIC_RELEASE, "agent");
            asm volatile("s_waitcnt vmcnt(0)" ::: "memory");
            const unsigned og = xb_add(&bar[XB_TOP], 1u);
            const unsigned tg = og / nx;
            if (og + 1u == (tg + 1u) * nx) xb_add(&bar[XB_TOPGEN], 1u);
            else XB_SPIN(xb_ld(&bar[XB_TOPGEN]) == tg, bar);
            __builtin_amdgcn_fence(__ATOMIC_ACQUIRE, "agent");
            xb_add(&bar[XB_XGEN(b.x)], 1u);
            asm volatile("s_waitcnt vmcnt(0)" ::: "memory");
        } else {
            XB_SPIN(xb_ld(&bar[XB_XGEN(b.x)]) == gen, bar);
            __builtin_amdgcn_fence(__ATOMIC_ACQUIRE, "agent");
            asm volatile("s_waitcnt vmcnt(0)" ::: "memory");
        }
    }
    __syncthreads();
}

}
namespace mk {
namespace cg = cooperative_groups;
constexpr int PH_PER_LAYER = 9, N_PHASES = 1 + 2 * PH_PER_LAYER;

__device__ __forceinline__ float lam_of(const Args& a, int l, float lam_init) {
    const float *q1 = a.in[14] + l * 64, *k1 = a.in[15] + l * 64, *q2 = a.in[16] + l * 64, *k2 = a.in[17] + l * 64;
    float s1 = 0.f, s2 = 0.f; for (int i = 0; i < 64; ++i) { s1 += q1[i] * k1[i]; s2 += q2[i] * k2[i]; }
    return expf(s1) - expf(s2) + lam_init;
}

typedef const __attribute__((address_space(4))) Args* KArgPtr;
__global__ void __launch_bounds__(NTH, 2) fwd(Args a_byval) {
    extern __shared__ __attribute__((aligned(16))) unsigned char lds_raw[];
    cg::grid_group grid = cg::this_grid();
    const int ph_lo = a_byval.ph_lo, ph_hi = a_byval.ph_hi;
    const int wave_s = __builtin_amdgcn_readfirstlane((int)threadIdx.x >> 6);
    volatile LAS unsigned* bar_st = (volatile LAS unsigned*)((LAS unsigned char*)lds_raw + LDS_BYTES - 64);
    if (threadIdx.x == 0) { bar_st[0] = 0u; bar_st[1] = 0u; }
    __syncthreads();
    const XcdBarrier bar = xcd_barrier_post((unsigned*)a_byval.ws, bar_st);
    int rep_flag = 0;
    for (int ph = ph_lo; ph < ph_hi; ++ph) {
        KArgPtr ap = (KArgPtr)__builtin_amdgcn_kernarg_segment_ptr(); asm volatile("" : "+s"(ap));
        const Args a = *(const Args*)ap;
        float* Xr = (float*)(a.ws + WS_X);
        Ctx X; X.wave_s = wave_s; X.wave = wave_s; X.tid = 0; X.lane = 0;
#define FRESH() do { X.tid = fresh_tid(wave_s); X.lane = X.tid & 63; } while (0)
        { int g_ = gridDim.x, b_ = blockIdx.x; asm volatile("" : "+s"(g_), "+s"(b_)); X.G = g_; X.bid = b_; }
        { const int bx = X.bid; X.vcu = (X.G % 8 == 0) ? (bx % 8) * (X.G / 8) + bx / 8 : bx; }
        X.gw = X.vcu * NWAVES + X.wave; X.ngw = X.G * NWAVES; X.lds = (LAS unsigned char*)lds_raw; X.ws = a.ws;
#ifndef MK_EN
#define MK_EN 0xFFFF
#endif
#ifndef MK_ATT
#define MK_ATT 3
#endif
#ifndef MK_REP_SP
#define MK_REP_SP 99
#endif
        if (ph == 0) { if (MK_EN & 512) { FRESH(); p0_prologue(X, a); } }
        else {
            const int l = (ph - 1) / PH_PER_LAYER, sp = (ph - 1) % PH_PER_LAYER;
            const float lam_init = 0.8f - 0.6f * expf(-0.3f * (float)l);
            if (0) {}
#if MK_EN & 1
            else if (sp == 0) {
                FRESH();
                pg8::Gemm g{(const bf16*)(a.ws + WS_XN), (const bf16*)(a.ws + WS_WIN) + (size_t)l * INW * D, T, INW, D};
                pg8::StaticOrder So; So.init(T, INW, X.G, X.bid);
                EpiWin Ep{a.ws, (const float*)(a.ws + WS_BINP) + l * INW, (const float*)(a.ws + WS_ROPE)};
                pg8::gemm_phase<EpiWin, pg8::StaticOrder, true, true>(X.lds, g, So, Ep, X.tid);
            }
#endif
#if MK_EN & 2
            else if (sp == 1) {
                FRESH();
                p1t_shortconv(X, a.in[4] + l * 3 * 1536, a.in[5] + l * 1536);
                p1t_kmax(X, (unsigned*)(a.ws + 14336) + l * 32);
            }
#endif
#if MK_EN & 4
            else if (sp == 2) {
                FRESH();
                const float lam = lam_of(a, l, lam_init);
                const int c = X.bid;
#ifndef MK_REP_ATT
#define MK_REP_ATT 1
#endif
#ifndef MK_CONV_REP
#define MK_CONV_REP 1
#endif
#ifndef MK_REP_HY
#define MK_REP_HY 1
#endif
                const int cg_ = X.vcu & 3;
                if (cg_ == 0) { __syncthreads(); p0_experts(relaunder(X), a, l); if (MK_CONV_REP > 1) { __syncthreads(); p0_experts(relaunder(X), a, l); } __syncthreads(); }
                for (int rep = 0; rep < MK_REP_ATT; ++rep) for (int u = c; u < 256; u += X.G) { const int bh = 2 * (u & 7) + ((u >> 3) >> 4), qb = (u >> 3) & 15; at::attn_unit(X, bh >> 2, bh & 3, qb, lam, 1.0f - lam_init, a.in[18] + l * 128, (unsigned*)(a.ws + 14336) + l * 32); }
                if (cg_ == 1) { __syncthreads(); p0_experts(relaunder(X), a, l); if (MK_CONV_REP > 1) { __syncthreads(); p0_experts(relaunder(X), a, l); } __syncthreads(); }
                for (int rep = 0; rep < MK_REP_HY; ++rep) for (int u = c; u < 256; u += X.G) { const int ch = 64 * (u & 7) + 2 * (u >> 3); v2u keep[2][4]; hy::channel<0>(relaunder(X), l, ch, a.in[13], keep);
                    if (cg_ == 2) { __syncthreads(); p0_experts(relaunder(X), a, l); if (MK_CONV_REP > 1) { __syncthreads(); p0_experts(relaunder(X), a, l); } __syncthreads(); }
                    hy::channel<1>(relaunder(X), l, ch + 1, a.in[13], keep); }
                if (cg_ == 3) { __syncthreads(); p0_experts(relaunder(X), a, l); if (MK_CONV_REP > 1) { __syncthreads(); p0_experts(relaunder(X), a, l); } __syncthreads(); }
            }
#endif
#if MK_EN & 8
            else if (sp == 3) {
                FRESH();
                OrderMerge So; So.so.init(T, D, X.G, X.bid);
                pg8::Gemm g{(const bf16*)(a.ws + WS_YH), (const bf16*)(a.ws + WS_WUH) + (size_t)l * 2 * D * C, 2 * T, 2 * D, C};
                EpiMerge2 Ep{(const bf16*)(a.ws + WS_GH), (const bf16*)(a.ws + WS_GA), (bf16*)(a.ws + WS_T1), (bf16*)(a.ws + WS_MG)};
                pg8::gemm_phase<EpiMerge2, OrderMerge, true, true>(X.lds, g, So, Ep, X.tid);
            }
#endif
#if MK_EN & 16
            else if (sp == 4) {
                FRESH();
                pg8::Gemm g{(const bf16*)(a.ws + WS_MG), (const bf16*)(a.ws + WS_WOUT) + (size_t)l * D * D, T, D, D};
                pg8::StaticOrder So; So.init(T, D, X.G, X.bid);
                EpiOutR Ep{l == 0 ? a.in[0] : Xr, Xr, (bf16*)(a.ws + WS_XN), (float*)(a.ws + WS_PART), (const bf16*)(a.ws + WS_WRP) + (size_t)l * 2 * E * D, (unsigned*)(a.ws + 15360) + l * 64, (float*)(a.ws + WS_AFFT), (float*)(a.ws + WS_RTOK), a.in[24] + l * E};
                pg8::gemm_phase<EpiOutR, pg8::StaticOrder, true, true>(X.lds, g, So, Ep, X.tid);
            }
#endif
#if MK_EN & 32
            else if (sp == 5) { FRESH(); p6_topk(X);
            }
#endif
#if MK_EN & 64
            else if (sp == 6) {
                FRESH();
                pg8::Gemm g{(const bf16*)(a.ws + WS_XN), (const bf16*)(a.ws + WS_WGU) + (size_t)l * E * 2 * F * D, E * 2048, 2 * F, D, 2 * F, 4, (size_t)2 * F * D * 2, (const int*)(a.ws + WS_ROWS)};
                OrderMoE1 So{X.G, X.bid}; EpiSwiGLU Ep{(bf16*)(a.ws + WS_HB), (const float*)(a.ws + WS_RSL)};
                pg8::gemm_phase<EpiSwiGLU, OrderMoE1, true, true, true, true>(X.lds, g, So, Ep, X.tid);
            }
#endif
#if MK_EN & 128
            else if (sp == 7) {
                FRESH();
                pg8::Gemm g{(const bf16*)(a.ws + WS_HB), (const bf16*)(a.ws + WS_WD) + (size_t)l * E * D * F, E * 2048, D, F, D, 2, (size_t)D * F * 2};
                OrderMoE2 So{X.G, X.bid}; EpiDown Ep{(bf16*)(a.ws + WS_YE), (const float*)(a.ws + WS_GATE)};
                pg8::gemm_phase<EpiDown, OrderMoE2, true, true, true>(X.lds, g, So, Ep, X.tid);
            }
#endif
#if MK_EN & 256
            else if (sp == 8) {
                FRESH();
                p9_combine(X, Xr, l == 0 ? a.in[1] + D : a.in[28], l == 1, a.out);
            }
#endif
        }
#ifndef MK_EXTRA_SYNC
#define MK_EXTRA_SYNC 0
#endif
        if (ph + 1 < ph_hi) { if (ph_hi > 4096) grid.sync(); else xcd_barrier(bar, wave_s); }
        for (int es = 0; es < MK_EXTRA_SYNC; ++es) xcd_barrier(bar, wave_s);
        if (MK_REP_SP != 99) { const int sp_ = ph == 0 ? -1 : (ph - 1) % PH_PER_LAYER; if (sp_ == MK_REP_SP && rep_flag == 0) { rep_flag = 1; --ph; } else rep_flag = 0; }
    }
}

static int g_grid = 0;
static bool mega_setup() {
    if (g_grid) return g_grid > 0;
    int dev = 0, cus = 0, per_cu = 0;
    if (hipGetDevice(&dev) != hipSuccess || hipDeviceGetAttribute(&cus, hipDeviceAttributeMultiprocessorCount, dev) != hipSuccess) { g_grid = -1; return false; }
    if (hipFuncSetAttribute((const void*)fwd, hipFuncAttributeMaxDynamicSharedMemorySize, LDS_BYTES) != hipSuccess) { fprintf(stderr, "hipFuncSetAttribute failed\n"); g_grid = -1; return false; }
    if (hipOccupancyMaxActiveBlocksPerMultiprocessor(&per_cu, (const void*)fwd, NTH, LDS_BYTES) != hipSuccess || per_cu < 1) { fprintf(stderr, "occupancy query failed (%d)\n", per_cu); g_grid = -1; return false; }
    g_grid = cus * 1;
    return true;
}
static void mega_launch(hipStream_t st, void* const* d_in, float* d_out, unsigned char* ws, int ph_lo, int ph_hi, int p0_mask) {
    if (!mega_setup()) return;
    Args a{};
    for (int i = 0; i < 29; ++i) a.in[i] = (const float*)d_in[i];
    a.out = d_out; a.ws = ws; a.ph_lo = ph_lo; a.ph_hi = ph_hi; a.p0_mask = p0_mask; a.pad = 0;
    if (hipMemsetAsync(ws, 0, 16384, st) != hipSuccess) { fprintf(stderr, "memset of the barrier words failed\n"); return; }
    void* args[] = {&a};
    const hipError_t e = hipLaunchCooperativeKernel((const void*)fwd, dim3(g_grid), dim3(NTH), args, LDS_BYTES, st);
    if (e != hipSuccess) fprintf(stderr, "cooperative launch failed: %s (grid %d)\n", hipGetErrorString(e), g_grid);
}
}
extern "C" void kernel_launch(void* const* d_in, const int* in_sizes, int n_in, void* d_out, int out_size, void* d_ws, size_t ws_size, hipStream_t stream) {
    if (n_in != 29 || out_size != mk::T * mk::D || ws_size < mk::WS_END) { fprintf(stderr, "kernel_launch: unexpected sizes n_in %d out %d ws %zu\n", n_in, out_size, ws_size); return; }
    mk::mega_launch(stream, d_in, (float*)d_out, (unsigned char*)d_ws, 0, mk::N_PHASES, 13);
}
```

```cpp
#include <hip/hip_runtime.h>
#include <hip/hip_cooperative_groups.h>
#include <cstdio>
#include <cstdint>
#include <cmath>
namespace tk {
constexpr int S = 4096, E = 16, CAP = 512, NT = 512;
__device__ __forceinline__ void topk_problem(const unsigned (&key)[8], const float (&rr)[8], int tokbase, int e, int slotbase, int* __restrict__ rows, float* __restrict__ gate, float* __restrict__ rsl, int* __restrict__ inv, int* sm, int tid) {
    const int lane = tid & 63, wid = tid >> 6;
    int* hist = sm; int* ctl = sm + 256;
    unsigned prefix = 0u, mask = 0u; int kth = CAP;
    for (int pass = 3; pass >= 0; --pass) {
        __syncthreads();
        if (tid < 256) hist[tid] = 0;
        __syncthreads();
#pragma unroll
        for (int i = 0; i < 8; ++i) if ((key[i] & mask) == prefix) atomicAdd(&hist[(key[i] >> (8 * pass)) & 255u], 1);
        __syncthreads();
        if (tid < 64) {
            const int b0 = hist[4 * lane], b1 = hist[4 * lane + 1], b2 = hist[4 * lane + 2], b3 = hist[4 * lane + 3];
            const int tot = b0 + b1 + b2 + b3;
            int suf = tot;
#pragma unroll
            for (int o = 1; o < 64; o <<= 1) { const int v = __builtin_amdgcn_ds_bpermute(((lane + o) & 63) << 2, suf); if (lane + o < 64) suf += v; }
            const int above = suf - tot;
            if (above < kth && kth <= above + tot) {
                int cum = above, bin, k2;
                if (cum + b3 >= kth) { bin = 4 * lane + 3; k2 = kth - cum; }
                else { cum += b3; if (cum + b2 >= kth) { bin = 4 * lane + 2; k2 = kth - cum; }
                else { cum += b2; if (cum + b1 >= kth) { bin = 4 * lane + 1; k2 = kth - cum; }
                else { cum += b1; bin = 4 * lane; k2 = kth - cum; } } }
                ctl[0] = bin; ctl[1] = k2;
            }
        }
        __syncthreads();
        prefix |= ((unsigned)ctl[0]) << (8 * pass); mask |= 0xFFu << (8 * pass); kth = ctl[1];
    }
    const unsigned thr = prefix; const int need_eq = kth; const int n_gt = CAP - need_eq;
    int cg = 0, ce = 0;
#pragma unroll
    for (int i = 0; i < 8; ++i) { cg += key[i] > thr; ce += key[i] == thr; }
    int sg = cg, se = ce;
#pragma unroll
    for (int o = 1; o < 64; o <<= 1) { const int a = __builtin_amdgcn_ds_bpermute(((lane - o) & 63) << 2, sg), b = __builtin_amdgcn_ds_bpermute(((lane - o) & 63) << 2, se); if (lane >= o) { sg += a; se += b; } }
    __syncthreads();
    if (lane == 63) { ctl[8 + wid] = sg; ctl[16 + wid] = se; }
    __syncthreads();
    int og = sg - cg, oe = se - ce;
    for (int w = 0; w < wid; ++w) { og += ctl[8 + w]; oe += ctl[16 + w]; }
#pragma unroll
    for (int i = 0; i < 8; ++i) {
        const int idx = tid * 8 + i; int slot = -1;
        if (key[i] > thr) slot = og++;
        else if (key[i] == thr) { if (oe < need_eq) slot = n_gt + oe; ++oe; }
        if (slot >= 0) { rows[slot] = tokbase + idx; gate[slot] = __uint_as_float(key[i]); rsl[slot] = rr[i]; }
        inv[(size_t)(tokbase + idx) * E + e] = slot >= 0 ? slotbase + slot : -1;
    }
    __syncthreads();
}
}
namespace pg8 {
#define PG8_LAS __attribute__((address_space(3)))
typedef unsigned short bf16_t;
typedef short bf16x8 __attribute__((ext_vector_type(8)));
typedef float f32x4 __attribute__((ext_vector_type(4)));
typedef unsigned u32x4 __attribute__((ext_vector_type(4)));
typedef short s16x4 __attribute__((ext_vector_type(4)));
constexpr int BM = 256, BK = 64, HALF = 128, HTB = HALF * BK * 2  , STAGE_BYTES = 8 * HTB, NXCD = 8, WGM = 8;

__host__ __device__ __forceinline__ int lds_byte(int r, int c) { const int st = (r >> 4) * 2 + (c >> 5), rr = r & 15, cc = c & 31, ob = rr * 64 + cc * 2; return st * 1024 + (ob ^ (((ob >> 9) & 1) << 5)); }
__host__ __device__ __forceinline__ void stage_rc(int b, int& R, int& C) { const int st = b / 1024, sb = b % 1024, swz = sb ^ (((sb >> 9) & 1) << 5); R = (st >> 1) * 16 + swz / 64; C = (st & 1) * 32 + (swz % 64) / 2; }
__host__ __device__ __forceinline__ int perm32(int rho) { const int n = rho >> 4, i = rho & 15; return 8 * (i >> 2) + 4 * n + (i & 3); }

struct Unit { int pm, pn, pb, pa; };
struct Gemm { const bf16_t* A; const bf16_t* Bt; int M, N, K; int bN = 0, bsh = 0; size_t bes = 0; const int* arows = nullptr; };

struct StaticOrder {
    int nM, nN, nwg, G, c;
    __host__ __device__ void init(int M, int N, int G_, int c_) { nM = M / BM; nN = N / BM; nwg = nM * nN; G = G_; c = c_; }
    __host__ __device__ bool next(int i, Unit& u) const {
        const long L = (long)i * G + c; if (L >= nwg) return false;
        int wgid = (int)L; { const int q = nwg / NXCD, r = nwg % NXCD, xcd = wgid % NXCD, off = wgid / NXCD; wgid = (xcd < r ? xcd * (q + 1) : r * (q + 1) + (xcd - r) * q) + off; }
        const int nig = WGM * nN, gid = wgid / nig, fm = gid * WGM, gsz = (nM - fm) < WGM ? (nM - fm) : WGM;
        u.pm = fm + ((wgid % nig) % gsz); u.pn = (wgid % nig) / gsz; u.pb = u.pn; u.pa = u.pm; return true;
    }
    __device__ __forceinline__ void a_ready(const Unit&) const {}
    __device__ __forceinline__ void done(const Unit&) const {}
};

template <class Epi, class Sched, bool ALIGN_EPI = false, bool SP2 = false, bool BT = false, bool GA = false>
__device__ __forceinline__ void gemm_phase(PG8_LAS unsigned char* lds, const Gemm g, const Sched& S, const Epi& E, int tid) {
    asm volatile("" : "+v"(tid));
    const int wid = __builtin_amdgcn_readfirstlane(tid >> 6), lane = tid & 63, wr = wid >> 2, wc = wid & 3, fr = lane & 15, fq = lane >> 4;
    const int K = g.K, nt = K / BK;
    unsigned voffA[2], voffB[2];
#pragma unroll
    for (int i = 0; i < 2; ++i) { int R, C; stage_rc(tid * 16 + i * 8192, R, C); const int Rb = Epi::PERM ? ((R & ~31) + perm32(R & 31)) : R;
        voffA[i] = (unsigned)(R * K + C) * 2u; voffB[i] = (unsigned)(Rb * K + C) * 2u; if constexpr (GA) voffA[i] = (unsigned)C * 2u;
        if constexpr (BT) { const int p = i * 512 + tid, row = ((p >> 7) << 3) | ((p >> 2) & 7), ch = (((p >> 5) & 3) << 2) | ((p & 3) ^ ((row >> 2) & 3));
            voffB[i] = (unsigned)(row * g.bN + 8 * ch) * 2u; } }
    const size_t kstep = (size_t)(BK * 2);
    const size_t hstep = (size_t)HALF * K * 2;
    const size_t tstep = 2 * hstep;
    const size_t kstepB = BT ? (size_t)BK * g.bN * 2 : kstep, hstepB = BT ? (size_t)HALF * 2 : hstep;
    const size_t hstepA = GA ? 0 : hstep;
    unsigned curA[2][2] = {{0u, 0u}, {0u, 0u}};
    PG8_LAS int* rowtab0 = (PG8_LAS int*)(lds + STAGE_BYTES);
#define PG8_ROWTAB (rowtab0 + ((ui + 1) & 1) * 512)
#define PG8_NXTOFF(o_, h) do { int t_ = tid; asm volatile("" : "+v"(t_)); _Pragma("unroll") for (int i_ = 0; i_ < 2; ++i_) { int R_, C_; stage_rc(t_ * 16 + i_ * 8192, R_, C_); \
        o_[i_] = (unsigned)PG8_ROWTAB[(h) * 128 + R_] * (unsigned)(K * 2) + (unsigned)C_ * 2u; } } while (0)
#define PG8_STAGE_A(bufoff, kbase, h, nx) do { if constexpr (GA) { if (nx) { unsigned o_[2]; PG8_NXTOFF(o_, h); PG8_STAGE(bufoff, kbase, o_); } else PG8_STAGE(bufoff, kbase, curA[h]); } \
        else PG8_STAGE(bufoff, (kbase) + ((h) ? hstep : 0), voffA); } while (0)
#define PG8_BBASE(pb) ((const char*)g.Bt + (BT ? (size_t)((pb) >> g.bsh) * g.bes + (size_t)((pb) & ((1 << g.bsh) - 1)) * 512 : (size_t)(pb) * tstep))
    const unsigned ldsw = (unsigned)wid * 1024u;
    const int aoff = lds_byte(wr * 64 + fr, fq * 8), boff = lds_byte(wc * 32 + fr, fq * 8);
    int tr0 = 0, tr1 = 0;
    if constexpr (BT) { static_assert(Epi::PERM, "BT needs the PERM column order"); const int q_ = (lane >> 2) & 3, p_ = lane & 3, f1_ = fq & 1;
        const int L_ = (int)(size_t)lds + 2048 * fq + 512 * wc + 64 * q_ + 32 * ((p_ >> 1) ^ f1_); tr0 = L_ + 16 * (p_ & 1); tr1 = L_ + 256 + 16 * (1 - (p_ & 1)); }
#define PG8_SA(b, h) (((b) * 2 + (h)) * HTB)
#define PG8_SB(b, h) ((4 + (b) * 2 + (h)) * HTB)
#define PG8_STAGE(bufoff, gbase, voff) do { _Pragma("unroll") for (int _i = 0; _i < 2; ++_i) \
        __builtin_amdgcn_global_load_lds((const unsigned*)((const char*)(gbase) + (voff)[_i]), (PG8_LAS unsigned*)(lds + (bufoff) + ldsw + _i * 8192), 16, 0, 0); } while (0)
#define PG8_LDA(dst, b, h) do { _Pragma("unroll") for (int m = 0; m < 4; ++m) _Pragma("unroll") for (int k = 0; k < 2; ++k) dst[m][k] = *(const PG8_LAS bf16x8*)(lds + PG8_SA(b, h) + aoff + m * 2048 + k * 1024); } while (0)
#define PG8_TR(dst4, addr, OFF) asm volatile("ds_read_b64_tr_b16 %0, %1 offset:%2" : "=&v"(dst4) : "v"(addr), "i"(OFF) : "memory")
#define PG8_TRF(dst8, a0, a1, OFF) do { s16x4 lo_, hi_; PG8_TR(lo_, a0, OFF); PG8_TR(hi_, a1, OFF); dst8 = __builtin_shufflevector(lo_, hi_, 0, 1, 2, 3, 4, 5, 6, 7); } while (0)
#define PG8_LDB(dst, b, h) do { if constexpr (BT) { const int a0_ = tr0 + PG8_SB(b, h), a1_ = tr1 + PG8_SB(b, h); \
        PG8_TRF(dst[0][0], a0_, a1_, 0); PG8_TRF(dst[0][1], a0_, a1_, 8192); PG8_TRF(dst[1][0], a0_, a1_, 8); PG8_TRF(dst[1][1], a0_, a1_, 8200); } else { \
    _Pragma("unroll") for (int n = 0; n < 2; ++n) _Pragma("unroll") for (int k = 0; k < 2; ++k) dst[n][k] = *(const PG8_LAS bf16x8*)(lds + PG8_SB(b, h) + boff + n * 2048 + k * 1024); } } while (0)
#define PG8_MMA(ai, bj, At, Bt) do { __builtin_amdgcn_s_setprio(1); _Pragma("unroll") for (int m = 0; m < 4; ++m) _Pragma("unroll") for (int n = 0; n < 2; ++n) _Pragma("unroll") for (int k = 0; k < 2; ++k) \
        acc[ai][bj][m][n] = __builtin_amdgcn_mfma_f32_16x16x32_bf16(Bt[n][k], At[m][k], acc[ai][bj][m][n], 0, 0, 0); __builtin_amdgcn_s_setprio(0); } while (0)
#define PG8_WAIT_V(n) asm volatile("s_waitcnt vmcnt(" #n ")" ::: "memory")
#define PG8_WAIT_L(n) asm volatile("s_waitcnt lgkmcnt(" #n ")" ::: "memory")
#define PG8_BAR __builtin_amdgcn_s_barrier()
#define PG8_SCHED __builtin_amdgcn_sched_barrier(0)
    Unit cur, nxt; int ui = 0;
    if (!S.next(0, cur)) return;
    f32x4 acc[2][2][4][2];
#pragma unroll
    for (int a = 0; a < 2; ++a)
#pragma unroll
        for (int b = 0; b < 2; ++b)
#pragma unroll
            for (int m = 0; m < 4; ++m)
#pragma unroll
                for (int n = 0; n < 2; ++n) acc[a][b][m][n] = (f32x4){0.f, 0.f, 0.f, 0.f};
    bf16x8 At[4][2], B0[2][2], B1[2][2];
    const char* cA = (const char*)g.A + (GA ? 0 : (size_t)cur.pa * tstep); const char* cB = PG8_BBASE(cur.pb);
    if constexpr (GA) {
#pragma unroll
        for (int h = 0; h < 2; ++h)
#pragma unroll
            for (int i = 0; i < 2; ++i) { int R, C; stage_rc(tid * 16 + i * 8192, R, C);
                curA[h][i] = (unsigned)__hip_atomic_load(g.arows + cur.pa * 256 + h * 128 + R, __ATOMIC_RELAXED, __HIP_MEMORY_SCOPE_AGENT) * (unsigned)(K * 2) + (unsigned)C * 2u; } }
    S.a_ready(cur);
    if constexpr (SP2) {
        PG8_STAGE(PG8_SB(0, 0), cB, voffB); PG8_STAGE(PG8_SB(0, 1), cB + hstepB, voffB); PG8_STAGE_A(PG8_SA(0, 0), cA, 0, false); PG8_STAGE_A(PG8_SA(0, 1), cA, 1, false);
        if (wr == 1) PG8_BAR;
        PG8_WAIT_V(2); PG8_BAR;
        PG8_STAGE(PG8_SB(1, 0), cB + kstepB, voffB); PG8_STAGE_A(PG8_SA(1, 0), cA + kstep, 0, false); PG8_STAGE(PG8_SB(1, 1), cB + hstepB + kstepB, voffB);
        PG8_WAIT_V(6); PG8_BAR;
    } else {
        PG8_STAGE(PG8_SB(0, 0), cB, voffB); PG8_STAGE_A(PG8_SA(0, 0), cA, 0, false); PG8_STAGE(PG8_SB(0, 1), cB + hstepB, voffB); PG8_STAGE_A(PG8_SA(0, 1), cA, 1, false);
        if (wr == 1) PG8_BAR;
        PG8_WAIT_V(4); PG8_BAR;
        PG8_STAGE(PG8_SB(1, 0), cB + kstepB, voffB); PG8_STAGE_A(PG8_SA(1, 0), cA + kstep, 0, false); PG8_STAGE(PG8_SB(1, 1), cB + hstepB + kstepB, voffB);
        PG8_WAIT_V(6); PG8_BAR;
    }
    for (;;) {
        const bool has_next = S.next(ui + 1, nxt);
        const char* nA = (has_next && !GA) ? (const char*)g.A + (size_t)nxt.pa * tstep : cA; const char* nB = has_next ? PG8_BBASE(nxt.pb) : cB;
        for (int t = 0; t < nt; t += 2) {
            const bool last = (t == nt - 2);
            const char* a1 = cA + (size_t)(t + 1) * kstep;
            const char* a2 = last ? nA : cA + (size_t)(t + 2) * kstep; const char* b2 = last ? nB : cB + (size_t)(t + 2) * kstepB;
            const char* a3 = a2 + kstep; const char* b3 = b2 + kstepB;
            if (last && has_next) S.a_ready(nxt);
            const bool nx = GA && last && has_next;
            if constexpr (GA) {
                if (t == 0 && has_next) { int l_ = lane; asm volatile("" : "+v"(l_)); __builtin_amdgcn_global_load_lds((const unsigned*)(g.arows + nxt.pa * 256 + (wid & 3) * 64 + l_), (PG8_LAS unsigned*)(PG8_ROWTAB + wid * 64), 4, 0, 0); }
            }
            if constexpr (SP2) {
            PG8_LDB(B0, 0, 0); PG8_LDB(B1, 0, 1); PG8_SCHED; PG8_LDA(At, 0, 0); PG8_STAGE_A(PG8_SA(1, 1), a1, 1, false);
            PG8_WAIT_V(8); PG8_WAIT_L(0); PG8_BAR; PG8_MMA(0, 0, At, B0); PG8_MMA(0, 1, At, B1); PG8_BAR; PG8_SCHED;
            PG8_LDA(At, 0, 1); PG8_STAGE(PG8_SB(0, 0), b2, voffB); PG8_STAGE(PG8_SB(0, 1), b2 + hstepB, voffB); PG8_STAGE_A(PG8_SA(0, 0), a2, 0, nx);
            PG8_WAIT_V(8); PG8_WAIT_L(0); PG8_BAR; PG8_MMA(1, 0, At, B0); PG8_MMA(1, 1, At, B1); PG8_BAR; PG8_SCHED;
            PG8_LDB(B0, 1, 0); PG8_LDB(B1, 1, 1); PG8_SCHED; PG8_LDA(At, 1, 0); PG8_STAGE_A(PG8_SA(0, 1), a2, 1, nx);
            PG8_WAIT_V(8); PG8_WAIT_L(0); PG8_BAR; PG8_MMA(0, 0, At, B0); PG8_MMA(0, 1, At, B1); PG8_BAR; PG8_SCHED;
            PG8_LDA(At, 1, 1); PG8_STAGE(PG8_SB(1, 0), b3, voffB); PG8_STAGE(PG8_SB(1, 1), b3 + hstepB, voffB); PG8_STAGE_A(PG8_SA(1, 0), a3, 0, nx);
            PG8_WAIT_V(8); PG8_WAIT_L(0); PG8_BAR; PG8_MMA(1, 0, At, B0); PG8_MMA(1, 1, At, B1); PG8_BAR; PG8_SCHED;
            } else {
            PG8_LDB(B0, 0, 0); PG8_SCHED; PG8_LDA(At, 0, 0); PG8_STAGE_A(PG8_SA(1, 1), a1, 1, false);
            PG8_WAIT_L(8); PG8_BAR; PG8_WAIT_L(0); PG8_MMA(0, 0, At, B0); PG8_BAR; PG8_SCHED;
            PG8_LDB(B1, 0, 1); PG8_STAGE(PG8_SB(0, 0), b2, voffB);
            PG8_BAR; PG8_WAIT_L(0); PG8_MMA(0, 1, At, B1); PG8_BAR;
            PG8_LDA(At, 0, 1); PG8_STAGE_A(PG8_SA(0, 0), a2, 0, nx);
            PG8_BAR; PG8_WAIT_L(0); PG8_MMA(1, 0, At, B0); PG8_BAR; PG8_SCHED;
            PG8_STAGE(PG8_SB(0, 1), b2 + hstepB, voffB);
            PG8_WAIT_V(6); PG8_BAR; PG8_MMA(1, 1, At, B1); PG8_BAR;
            PG8_LDB(B0, 1, 0); PG8_SCHED; PG8_LDA(At, 1, 0); PG8_STAGE_A(PG8_SA(0, 1), a2, 1, nx);
            PG8_WAIT_L(8); PG8_BAR; PG8_WAIT_L(0); PG8_MMA(0, 0, At, B0); PG8_BAR; PG8_SCHED;
            PG8_LDB(B1, 1, 1); PG8_STAGE(PG8_SB(1, 0), b3, voffB);
            PG8_BAR; PG8_WAIT_L(0); PG8_MMA(0, 1, At, B1); PG8_BAR;
            PG8_LDA(At, 1, 1); PG8_STAGE_A(PG8_SA(1, 0), a3, 0, nx);
            PG8_BAR; PG8_WAIT_L(0); PG8_MMA(1, 0, At, B0); PG8_BAR; PG8_SCHED;
            PG8_STAGE(PG8_SB(1, 1), b3 + hstepB, voffB);
            PG8_WAIT_V(6); PG8_BAR; PG8_MMA(1, 1, At, B1); PG8_BAR;
            }
        }
        if constexpr (ALIGN_EPI) { if (wr == 0) PG8_BAR; }
        if constexpr (!Epi::AFTER_DRAIN) { E(acc, cur, wr, wc, fr, fq); S.done(cur); }
        if (!has_next) break;
#pragma unroll
        for (int a = 0; a < 2; ++a)
#pragma unroll
            for (int b = 0; b < 2; ++b)
#pragma unroll
                for (int m = 0; m < 4; ++m)
#pragma unroll
                    for (int n = 0; n < 2; ++n) acc[a][b][m][n] = (f32x4){0.f, 0.f, 0.f, 0.f};
        if constexpr (GA) { PG8_NXTOFF(curA[0], 0); PG8_NXTOFF(curA[1], 1); }
        cur = nxt; cA = nA; cB = nB; ++ui;
        if constexpr (ALIGN_EPI) { if (wr == 1) PG8_BAR; }
    }
    PG8_WAIT_V(0);
    if constexpr (!ALIGN_EPI) { if (wr == 0) PG8_BAR; }
    PG8_BAR;
    if constexpr (Epi::AFTER_DRAIN) { E.fused(acc, cur, wr, wc, fr, fq, lds, wid, lane); S.done(cur); }
#undef PG8_SA
#undef PG8_SB
#undef PG8_STAGE
#undef PG8_STAGE_A
#undef PG8_NXTOFF
#undef PG8_ROWTAB
#undef PG8_LDA
#undef PG8_LDB
#undef PG8_TR
#undef PG8_TRF
#undef PG8_BBASE
#undef PG8_MMA
#undef PG8_WAIT_V
#undef PG8_WAIT_L
#undef PG8_BAR
#undef PG8_SCHED
}
}

namespace mk {
constexpr int D = 1024, B = 4, S = 4096, T = B * S, C = 512, INW = 5120, E = 16, CAP = 512, F = 2048, NTH = 512, NWAVES = 8;
typedef unsigned short bf16;
#define LAS __attribute__((address_space(3)))
typedef unsigned v4u __attribute__((ext_vector_type(4)));
typedef unsigned v2u __attribute__((ext_vector_type(2)));
typedef float f32x4 __attribute__((ext_vector_type(4)));
typedef short bf16x8 __attribute__((ext_vector_type(8)));
typedef float f32x16 __attribute__((ext_vector_type(16)));
typedef short s16x4 __attribute__((ext_vector_type(4)));

constexpr size_t MiB = 1u << 20;
constexpr size_t WS_WIN = 2 * MiB;
constexpr size_t WS_WUH = 22 * MiB;
constexpr size_t WS_WUA = 23 * MiB;
constexpr size_t WS_WOUT = 26 * MiB;
constexpr size_t WS_BINP = 30 * MiB;
constexpr size_t WS_WRP = 30 * MiB + 512 * 1024;
constexpr size_t WS_ROPE = 31 * MiB;
constexpr size_t WS_AFFT = 32 * MiB;
constexpr size_t WS_INV = 33 * MiB;
constexpr size_t WS_ROWS = 34 * MiB;
constexpr size_t WS_GATE = 34 * MiB + 512 * 1024;
constexpr size_t WS_RTOK = 35 * MiB + 512 * 1024;
constexpr size_t WS_RSL = 35 * MiB;
constexpr size_t WS_FILT = 36 * MiB;
constexpr size_t WS_X = 68 * MiB;
constexpr size_t WS_XN = 132 * MiB;
constexpr size_t WS_SH = 164 * MiB;
constexpr size_t WS_U = WS_SH;
constexpr size_t WS_UCT = WS_SH + 48 * MiB;
constexpr size_t WS_Q = WS_SH + 96 * MiB;
constexpr size_t WS_K = WS_SH + 112 * MiB;
constexpr size_t WS_V = WS_SH + 128 * MiB;
constexpr size_t WS_GH = WS_SH + 144 * MiB;
constexpr size_t WS_GA = WS_SH + 176 * MiB;
constexpr size_t WS_YH = WS_SH + 208 * MiB;
constexpr size_t WS_YA = WS_SH + 224 * MiB;
constexpr size_t WS_T1 = WS_U;
constexpr size_t WS_MG = WS_UCT;
constexpr size_t WS_PART = WS_SH;
constexpr size_t WS_HB = WS_SH + 64 * MiB;
constexpr size_t WS_YE = WS_SH + 192 * MiB;
constexpr size_t WS_WGU = 420 * MiB;
constexpr size_t WS_WD = 676 * MiB;
constexpr size_t WS_END = 804 * MiB;

constexpr int LDS_BYTES = 155648;
constexpr float QSCALE = 0.125f * 1.4426950408889634f;

struct Args {
    const float* in[29]; float* out; unsigned char* ws; int ph_lo, ph_hi; int p0_mask, pad;
};

__device__ __forceinline__ unsigned f2bf(float f) { unsigned u = __builtin_bit_cast(unsigned, f); return (u + 0x7fffu + ((u >> 16) & 1u)) >> 16; }
__device__ __forceinline__ unsigned pk2(float lo, float hi) { return f2bf(lo) | (f2bf(hi) << 16); }
__device__ __forceinline__ float bf2f(unsigned h) { return __builtin_bit_cast(float, h << 16); }
__device__ __forceinline__ float bflo(unsigned w) { return __builtin_bit_cast(float, w << 16); }
__device__ __forceinline__ float bfhi(unsigned w) { return __builtin_bit_cast(float, w & 0xffff0000u); }
template <int O> __device__ __forceinline__ float xor_f(float v) { return __builtin_bit_cast(float, __builtin_amdgcn_ds_swizzle(__builtin_bit_cast(int, v), (O << 10) | 0x1f)); }
__device__ __forceinline__ float wave_sum(float v) { v += xor_f<1>(v); v += xor_f<2>(v); v += xor_f<4>(v); v += xor_f<8>(v); v += xor_f<16>(v);
    const int b = __builtin_bit_cast(int, v); return __builtin_bit_cast(float, __builtin_amdgcn_readlane(b, 0)) + __builtin_bit_cast(float, __builtin_amdgcn_readlane(b, 32)); }

__device__ __forceinline__ float sigm(float x) { return 1.f / (1.f + __expf(-x)); }

struct Ctx { int tid, lane, wave, gw, ngw, vcu, G, bid, wave_s; LAS unsigned char* lds; unsigned char* ws; };

__device__ __forceinline__ int fresh_tid(int wave_s) { int l; asm volatile("v_mbcnt_lo_u32_b32 %0, -1, 0\n\tv_mbcnt_hi_u32_b32 %0, -1, %0" : "=v"(l)); return (wave_s << 6) | l; }
__device__ __forceinline__ Ctx relaunder(const Ctx& X) { Ctx Y = X; const int t = fresh_tid(X.wave_s); Y.tid = t; Y.lane = t & 63; return Y; }

template <int MAP> __device__ __forceinline__ int rowmap(int n) {
    if (MAP == 1) {
        if (n < 1536 || n >= 2560) return n;
        const int hb = (n - 1536) & ~63, d = (n - 1536) & 63, i = (d & 31) >> 2, j = d & 3;
        return 1536 + hb + 8 * i + ((d >> 5) << 2) + j;
    }
    if (MAP == 2) return ((n >> 7) << 8) + (n & 127);
    if (MAP == 3) return ((n >> 7) << 8) + 128 + (n & 127);
    return n;
}
__device__ __forceinline__ unsigned cvtpk_(float lo, float hi) { unsigned r; asm volatile("v_cvt_pk_bf16_f32 %0, %1, %2" : "=v"(r) : "v"(lo), "v"(hi)); return r; }
struct TrItem { const float* src; bf16* dst; };
template <int MAP> __device__ __forceinline__ void p0_transpose(const Ctx& X, const float* W, int K, int N, bf16* WT, int nmat, size_t sstride, size_t dstride, int rot = 0) {
    LAS float* scr = (LAS float*)(X.lds + X.wave * 16640);
    const int nblk = N / 64, per = (K / 64) * nblk, tot = per * nmat, lane = X.lane;
    const int nq = lane & 15, kr = lane >> 4, c = lane & 7, nsub = lane >> 3;
    f32x4 v[16];
    int it = X.gw - rot; if (it < 0) it += X.ngw;
#define TR_SRC(it_) (W + (size_t)((it_) / per) * sstride + (size_t)(64 * (((it_) % per) / nblk) + kr) * N + 64 * (((it_) % per) % nblk) + 4 * nq)
    if (it < tot) { const float* s = TR_SRC(it);
#pragma unroll
        for (int i = 0; i < 16; ++i) v[i] = __builtin_nontemporal_load((const f32x4*)(s + (size_t)(4 * i) * N)); }
    while (it < tot) {
#pragma unroll
        for (int i = 0; i < 16; ++i) { LAS float* d = scr + (4 * i + kr) * 65 + 4 * nq; d[0] = v[i][0]; d[1] = v[i][1]; d[2] = v[i][2]; d[3] = v[i][3]; }
        const int nit = it + X.ngw;
        if (nit < tot) { const float* s = TR_SRC(nit);
#pragma unroll
            for (int i = 0; i < 16; ++i) v[i] = __builtin_nontemporal_load((const f32x4*)(s + (size_t)(4 * i) * N)); }
        asm volatile("s_waitcnt lgkmcnt(0)" ::: "memory");
        const int m = it / per, r = it - m * per, k0 = 64 * (r / nblk), n0 = 64 * (r % nblk);
        bf16* dst = WT + (size_t)m * dstride;
#pragma unroll
        for (int j = 0; j < 8; ++j) { const int n = nsub + 8 * j; const LAS float* s = scr + (8 * c) * 65 + n;
            v4u o; o.x = cvtpk_(s[0 * 65], s[1 * 65]); o.y = cvtpk_(s[2 * 65], s[3 * 65]); o.z = cvtpk_(s[4 * 65], s[5 * 65]); o.w = cvtpk_(s[6 * 65], s[7 * 65]);
            __builtin_nontemporal_store(o, (v4u*)(dst + (size_t)rowmap<MAP>(n0 + n) * K + k0 + 8 * c)); }
        asm volatile("s_waitcnt lgkmcnt(0)" ::: "memory");
        it = nit;
    }
#undef TR_SRC
}
struct Row8 { f32x4 a[2][2]; };
__device__ __forceinline__ void row8_load(Row8& r, const float* p, int lane) {
#pragma unroll
    for (int j = 0; j < 2; ++j) { const f32x4* q = (const f32x4*)p + 2 * (lane + 64 * j); r.a[j][0] = q[0]; r.a[j][1] = q[1]; }
}
__device__ __forceinline__ float row8_sumsq(const Row8& r) {
    float s = 0.f;
#pragma unroll
    for (int j = 0; j < 2; ++j)
#pragma unroll
        for (int h = 0; h < 2; ++h) s += (r.a[j][h].x * r.a[j][h].x + r.a[j][h].y * r.a[j][h].y) + (r.a[j][h].z * r.a[j][h].z + r.a[j][h].w * r.a[j][h].w);
    return s;
}
__device__ __forceinline__ void rms_row_to_bf16(const float* __restrict__ xrow, const float* __restrict__ g, bf16* __restrict__ orow, int lane) {
    const f32x4* xr = (const f32x4*)xrow + lane; f32x4 v[4]; float s = 0.f;
#pragma unroll
    for (int j = 0; j < 4; ++j) { v[j] = xr[64 * j]; s += (v[j].x * v[j].x + v[j].y * v[j].y) + (v[j].z * v[j].z + v[j].w * v[j].w); }
    const float r = rsqrtf(wave_sum(s) * (1.f / D) + 1e-6f);
    v2u* o8 = (v2u*)orow + lane;
#pragma unroll
    for (int j = 0; j < 4; ++j) { const f32x4 gg = ((const f32x4*)g)[lane + 64 * j]; v2u w; w.x = pk2(v[j].x * r * gg.x, v[j].y * r * gg.y); w.y = pk2(v[j].z * r * gg.z, v[j].w * r * gg.w); o8[64 * j] = w; }
}
__device__ __forceinline__ void p0_filters(const Ctx& X, const Args& a) {
    LAS float* z = (LAS float*)X.lds;
    LAS float* h1 = z + 32 * 36;
    LAS float* h2r = h1 + 32 * 64;
    LAS float* w1s = h2r + 32 * 68;
    LAS float* w2s = w1s + 33 * 64;
    bf16* FILT = (bf16*)(X.ws + WS_FILT);
    const float min_decay = logf(1e-2f) / 0.3f, max_decay = logf(1e-2f) / 1.5f;
    for (int it = X.bid; it < 2 * (S / 32); it += X.G) {
        int tid = X.tid; asm volatile("" : "+v"(tid));
        const int j = tid & 63, tq = tid >> 6;
        const int l = it / (S / 32), t0 = (it % (S / 32)) * 32;
        const float *w1 = a.in[6] + l * 33 * 64, *b1 = a.in[7] + l * 64, *f1 = a.in[8] + l * 64, *w2 = a.in[9] + l * 64 * 64, *b2 = a.in[10] + l * 64, *f2 = a.in[11] + l * 64, *w3 = a.in[12] + (size_t)l * 64 * 2048;
        __syncthreads();
        for (int e = tid; e < 33 * 64; e += NTH) w1s[e] = w1[e];
        for (int e = tid; e < 64 * 64; e += NTH) w2s[e] = w2[e];
        for (int e = tid; e < 32 * 33; e += NTH) { const int tt = e / 33, jj0 = e - tt * 33, t = t0 + tt; float v;
            if (jj0 == 0) v = (float)t / (float)(S - 1);
            else { const int jj = (jj0 - 1) & 15; const float w = 2.0f * 3.14159265358979323846f * (float)t / (float)S; const float fr = 1e-4f + (float)jj * ((15.0f - 1e-4f) / 15.0f); const float ang = w * fr; v = (jj0 <= 16) ? cosf(ang) : -sinf(ang); }
            z[tt * 36 + jj0] = v; }
        const float bb1 = b1[j], ff1 = f1[j], bb2 = b2[j], ff2 = f2[j];
        __syncthreads();
        { float acc[4] = {bb1, bb1, bb1, bb1};
          for (int i = 0; i < 33; ++i) { const float w = w1s[i * 64 + j];
#pragma unroll
              for (int k = 0; k < 4; ++k) acc[k] += z[(tq + 8 * k) * 36 + i] * w; }
#pragma unroll
          for (int k = 0; k < 4; ++k) h1[(tq + 8 * k) * 64 + j] = sinf(ff1 * acc[k]); }
        __syncthreads();
        { float acc[4] = {bb2, bb2, bb2, bb2};
          for (int i = 0; i < 64; ++i) { const float w = w2s[i * 64 + j];
#pragma unroll
              for (int k = 0; k < 4; ++k) acc[k] += h1[(tq + 8 * k) * 64 + i] * w; }
#pragma unroll
          for (int k = 0; k < 4; ++k) h2r[(tq + 8 * k) * 68 + j] = sinf(ff2 * acc[k]); }
        __syncthreads();
        { const int wv = tid >> 6, ln = tid & 63, tl = ln & 31, kh = ln >> 5;
#define FSPLIT(HI, LO, V0, V1) do { v4u h_; h_.x = cvtpk_((V0)[0], (V0)[1]); h_.y = cvtpk_((V0)[2], (V0)[3]); h_.z = cvtpk_((V1)[0], (V1)[1]); h_.w = cvtpk_((V1)[2], (V1)[3]); \
            v4u l_; l_.x = cvtpk_((V0)[0] - bflo(h_.x), (V0)[1] - bfhi(h_.x)); l_.y = cvtpk_((V0)[2] - bflo(h_.y), (V0)[3] - bfhi(h_.y)); l_.z = cvtpk_((V1)[0] - bflo(h_.z), (V1)[1] - bfhi(h_.z)); l_.w = cvtpk_((V1)[2] - bflo(h_.w), (V1)[3] - bfhi(h_.w)); \
            HI = __builtin_bit_cast(bf16x8, h_); LO = __builtin_bit_cast(bf16x8, l_); } while (0)
            bf16x8 ah[4], al[4];
#pragma unroll
            for (int kb = 0; kb < 4; ++kb) { const f32x4 v0 = *(const LAS f32x4*)(h2r + tl * 68 + 16 * kb + 8 * kh), v1 = *(const LAS f32x4*)(h2r + tl * 68 + 16 * kb + 8 * kh + 4); FSPLIT(ah[kb], al[kb], v0, v1); }
            const float* wl = w3 + (size_t)(8 * kh) * 2048 + wv * 256 + tl;
            f32x4 wq[2][4][2];
#define FLOADW(BUF, NT) do { _Pragma("unroll") for (int kb_ = 0; kb_ < 4; ++kb_) _Pragma("unroll") for (int j_ = 0; j_ < 8; ++j_) wq[BUF][kb_][j_ >> 2][j_ & 3] = wl[(size_t)(16 * kb_ + j_) * 2048 + 32 * (NT)]; } while (0)
#define FTILE(BUF, NT) do { f32x16 d_ = {}; _Pragma("unroll") for (int kb_ = 0; kb_ < 4; ++kb_) { bf16x8 bh_, bl_; FSPLIT(bh_, bl_, wq[BUF][kb_][0], wq[BUF][kb_][1]); \
                d_ = __builtin_amdgcn_mfma_f32_32x32x16_bf16(ah[kb_], bh_, d_, 0, 0, 0); d_ = __builtin_amdgcn_mfma_f32_32x32x16_bf16(al[kb_], bh_, d_, 0, 0, 0); d_ = __builtin_amdgcn_mfma_f32_32x32x16_bf16(ah[kb_], bl_, d_, 0, 0, 0); } \
              const int n_ = wv * 256 + 32 * (NT) + tl, c_ = n_ & 511, od_ = n_ >> 9; const float dl_ = fabsf(min_decay + (float)c_ * ((max_decay - min_decay) / 511.0f)) * (1.0f / (float)(S - 1)); \
              bf16* fo_ = FILT + (((size_t)l * 4 + od_) * C + c_) * S + t0 + 4 * kh; \
              _Pragma("unroll") for (int g_ = 0; g_ < 4; ++g_) { const float tb_ = (float)(t0 + 8 * g_ + 4 * kh); v2u o_; \
                  o_.x = pk2(d_[4 * g_] * expf(-tb_ * dl_), d_[4 * g_ + 1] * expf(-(tb_ + 1.f) * dl_)); o_.y = pk2(d_[4 * g_ + 2] * expf(-(tb_ + 2.f) * dl_), d_[4 * g_ + 3] * expf(-(tb_ + 3.f) * dl_)); \
                  *(v2u*)(fo_ + 8 * g_) = o_; } } while (0)
            FLOADW(0, 0);
#pragma unroll 1
            for (int nt = 0; nt < 8; nt += 2) { FLOADW(1, nt + 1); FTILE(0, nt); if (nt + 2 < 8) FLOADW(0, nt + 2); FTILE(1, nt + 1); }
#undef FSPLIT
#undef FLOADW
#undef FTILE
        }
    }
    __syncthreads();
}
template <int MAP> __device__ __forceinline__ void p0_convert(const Ctx& X, const float* W, int K, int N, bf16* WB, int dN, int nmat, size_t sstride, size_t dstride, const float* __restrict__ rscale = nullptr) {
    const int nblk = N / 256, per = (K / 16) * nblk, tot = per * nmat, lane = X.lane;
    f32x4 v[16];
    int it = X.gw;
#define CV_SRC(it_) (W + (size_t)((it_) / per) * sstride + (size_t)(16 * (((it_) % per) / nblk)) * N + 256 * (((it_) % per) % nblk) + 4 * lane)
    if (it < tot) { const float* s = CV_SRC(it);
#pragma unroll
        for (int i = 0; i < 16; ++i) v[i] = __builtin_nontemporal_load((const f32x4*)(s + (size_t)i * N)); }
    while (it < tot) {
        v2u o[16];
        if (rscale) { const int k0s = 16 * ((it % per) / nblk);
#pragma unroll
            for (int i = 0; i < 16; ++i) { const float sc = rscale[k0s + i]; o[i].x = cvtpk_(v[i][0] * sc, v[i][1] * sc); o[i].y = cvtpk_(v[i][2] * sc, v[i][3] * sc); } }
        else {
#pragma unroll
        for (int i = 0; i < 16; ++i) { o[i].x = cvtpk_(v[i][0], v[i][1]); o[i].y = cvtpk_(v[i][2], v[i][3]); } }
        const int nit = it + X.ngw;
        if (nit < tot) { const float* s = CV_SRC(nit);
#pragma unroll
            for (int i = 0; i < 16; ++i) v[i] = __builtin_nontemporal_load((const f32x4*)(s + (size_t)i * N)); }
        const int mi = it / per, r = it - mi * per, k0 = 16 * (r / nblk), n = 256 * (r % nblk) + 4 * lane;
        const int dc = MAP == 0 ? n : (((n >> 7) << 8) + (n & 127) + (MAP == 3 ? 128 : 0));
        bf16* dst = WB + (size_t)mi * dstride + (size_t)k0 * dN + dc;
#pragma unroll
        for (int i = 0; i < 16; ++i) __builtin_nontemporal_store(o[i], (v2u*)(dst + (size_t)i * dN));
        it = nit;
    }
#undef CV_SRC
}
__device__ __forceinline__ void p0_experts(const Ctx& X, const Args& a, int l) {
    bf16* wgu = (bf16*)(X.ws + WS_WGU) + (size_t)l * E * 2 * F * D; bf16* wd = (bf16*)(X.ws + WS_WD) + (size_t)l * E * F * D;
    p0_convert<2>(X, a.in[25] + (size_t)l * E * D * F, D, F, wgu, 2 * F, E, (size_t)D * F, (size_t)2 * F * D, a.in[22] + l * D);
    p0_convert<3>(X, a.in[26] + (size_t)l * E * D * F, D, F, wgu, 2 * F, E, (size_t)D * F, (size_t)2 * F * D, a.in[22] + l * D);
    p0_convert<0>(X, a.in[27] + (size_t)l * E * D * F, F, D, wd, D, E, (size_t)F * D, (size_t)F * D);
}
__device__ __forceinline__ void p0_experts_rest(const Ctx& X, const Args& a, int l, int me0) {
    bf16* wgu = (bf16*)(X.ws + WS_WGU) + (size_t)l * E * 2 * F * D; bf16* wd = (bf16*)(X.ws + WS_WD) + (size_t)l * E * F * D;
    const int g0 = me0 < 16 ? me0 : 16, u0 = me0 < 16 ? 0 : (me0 < 32 ? me0 - 16 : 16), d0 = me0 < 32 ? 0 : me0 - 32;
    if (g0 < 16) p0_convert<2>(X, a.in[25] + ((size_t)l * E + g0) * D * F, D, F, wgu + (size_t)g0 * 2 * F * D, 2 * F, E - g0, (size_t)D * F, (size_t)2 * F * D, a.in[22] + l * D);
    if (u0 < 16) p0_convert<3>(X, a.in[26] + ((size_t)l * E + u0) * D * F, D, F, wgu + (size_t)u0 * 2 * F * D, 2 * F, E - u0, (size_t)D * F, (size_t)2 * F * D, a.in[22] + l * D);
    if (d0 < 16) p0_convert<0>(X, a.in[27] + ((size_t)l * E + d0) * D * F, F, D, wd + (size_t)d0 * F * D, D, E - d0, (size_t)F * D, (size_t)F * D);
}
#ifndef MK_P0_DUP
#define MK_P0_DUP 0
#endif
__device__ __forceinline__ void p0_prologue(const Ctx& X, const Args& a) {
    const int m = a.p0_mask;
    for (int dup_ = 0; dup_ < ((MK_P0_DUP & 1) ? 2 : 1); ++dup_)
    if (m & 1) {
        p0_transpose<1>(X, a.in[2], D, INW, (bf16*)(X.ws + WS_WIN), 2, (size_t)D * INW, (size_t)D * INW);
        p0_transpose<0>(X, a.in[19], C, D, (bf16*)(X.ws + WS_WUH), 2, (size_t)C * D, (size_t)2 * C * D, 512 % X.ngw);
        p0_transpose<0>(X, a.in[20], C, D, (bf16*)(X.ws + WS_WUA), 2, (size_t)C * D, (size_t)2 * C * D, 768 % X.ngw);
        p0_transpose<0>(X, a.in[21], D, D, (bf16*)(X.ws + WS_WOUT), 2, (size_t)D * D, (size_t)D * D, 1024 % X.ngw);
        float* binp = (float*)(X.ws + WS_BINP);
        for (int i = X.gw * 64 + X.lane; i < 2 * INW; i += X.ngw * 64) { const int l = i / INW, n = i - l * INW; binp[l * INW + rowmap<1>(n)] = a.in[3][i]; }
        { bf16* wrp = (bf16*)(X.ws + WS_WRP);
          for (int i = X.gw * 64 + X.lane; i < 2 * E * D; i += X.ngw * 64) { const int l = i / (E * D), e = (i / D) % E, k = i % D; const float v = a.in[22][l * D + k] * a.in[23][((size_t)l * D + k) * E + e];
              const unsigned hi = f2bf(v); const float lo = v - __builtin_bit_cast(float, hi << 16); wrp[((l * 2 + 0) * E + e) * D + k] = (bf16)hi; wrp[((l * 2 + 1) * E + e) * D + k] = (bf16)f2bf(lo); } }
        float* rope = (float*)(X.ws + WS_ROPE);
        for (int i = X.gw * 64 + X.lane; i < S * 32; i += X.ngw * 64) { const int pos = i >> 5, j = i & 31; const float inv = powf(10000.0f, -(float)j * 2.0f / 64.0f); float sn, cs; sincosf((float)pos * inv, &sn, &cs); rope[2 * i] = cs; rope[2 * i + 1] = sn; }
    }
    if (m & 2) { p0_experts(X, a, 0); p0_experts(X, a, 1); }
    for (int dup_ = 0; dup_ < ((MK_P0_DUP & 4) ? 2 : 1); ++dup_)
    if (m & 4) p0_filters(X, a);
    for (int dup_ = 0; dup_ < ((MK_P0_DUP & 8) ? 2 : 1); ++dup_)
    if (m & 8) {
        bf16* XN = (bf16*)(X.ws + WS_XN); const int lane = X.lane; Row8 gg; row8_load(gg, a.in[1], lane);
        int r = X.gw; Row8 cur; if (r < T) row8_load(cur, a.in[0] + (size_t)r * D, lane);
        while (r < T) { const int nr = r + X.ngw; Row8 nxt; if (nr < T) row8_load(nxt, a.in[0] + (size_t)nr * D, lane);
            const float rs = rsqrtf(wave_sum(row8_sumsq(cur)) * (1.f / D) + 1e-6f);
#pragma unroll
            for (int j = 0; j < 2; ++j) { const f32x4 y0 = cur.a[j][0] * gg.a[j][0] * rs, y1 = cur.a[j][1] * gg.a[j][1] * rs;
                v4u w; w.x = pk2(y0.x, y0.y); w.y = pk2(y0.z, y0.w); w.z = pk2(y1.x, y1.y); w.w = pk2(y1.z, y1.w); ((v4u*)(XN + (size_t)r * D))[lane + 64 * j] = w; }
            cur = nxt; r = nr; }
    }
}
}
namespace mk {
using pg8::Unit;
#ifndef MK_SIMPLE_ORDER
#define MK_SIMPLE_ORDER 0
#endif
__device__ __forceinline__ unsigned cvtpk(float lo, float hi) { unsigned r; asm volatile("v_cvt_pk_bf16_f32 %0, %1, %2" : "=v"(r) : "v"(lo), "v"(hi)); return r; }
__device__ __forceinline__ v4u pack8(f32x4 a, f32x4 b) { v4u w; w.x = cvtpk(a[0], a[1]); w.y = cvtpk(a[2], a[3]); w.z = cvtpk(b[0], b[1]); w.w = cvtpk(b[2], b[3]); return w; }
__device__ __forceinline__ void unpack8(v4u w, f32x4& a, f32x4& b) { a = (f32x4){bflo(w.x), bfhi(w.x), bflo(w.y), bfhi(w.y)}; b = (f32x4){bflo(w.z), bfhi(w.z), bflo(w.w), bfhi(w.w)}; }
__device__ __forceinline__ float fsig(float x) { return __builtin_amdgcn_rcpf(1.f + __expf(-x)); }

struct EpiWin {
    static constexpr bool PERM = true, AFTER_DRAIN = false;
    unsigned char* ws; const float* bias; const float* rope;
    __device__ __forceinline__ void operator()(const f32x4 (&acc)[2][2][4][2], const Unit& u, int wr, int wc, int fr, int fq) const {
        const int colt = u.pn * 256, row0 = u.pm * 256 + wr * 64 + fr, cin = wc * 32 + 8 * fq;
        bf16* base; int ldc, col0, mode; float sc = 1.f;
        if (colt < 1536) { base = (bf16*)(ws + WS_U); ldc = 1536; col0 = colt; mode = 0; }
        else if (colt < 2048) { base = (bf16*)(ws + WS_Q); ldc = 512; col0 = colt - 1536; mode = 1; sc = QSCALE; }
        else if (colt < 2560) { base = (bf16*)(ws + WS_K); ldc = 512; col0 = colt - 2048; mode = 1; }
        else if (colt < 3072) { base = (bf16*)(ws + WS_V); ldc = 512; col0 = colt - 2560; mode = 0; }
        else if (colt < 4096) { base = (bf16*)(ws + WS_GH); ldc = 1024; col0 = colt - 3072; mode = 2; }
        else { base = (bf16*)(ws + WS_GA); ldc = 1024; col0 = colt - 4096; mode = 2; }
        f32x4 bv[2][2];
#pragma unroll
        for (int bj = 0; bj < 2; ++bj)
#pragma unroll
            for (int n = 0; n < 2; ++n) bv[bj][n] = *(const f32x4*)(bias + colt + bj * 128 + cin + 4 * n);
#pragma unroll
        for (int ai = 0; ai < 2; ++ai)
#pragma unroll
            for (int m = 0; m < 4; ++m) {
                const int row = row0 + ai * 128 + m * 16; bf16* rowp = base + (size_t)row * ldc + col0 + cin;
#pragma unroll
                for (int bj = 0; bj < 2; ++bj) {
                    f32x4 v0 = acc[ai][bj][m][0] + bv[bj][0], v1 = acc[ai][bj][m][1] + bv[bj][1];
                    if (mode == 1) {
                        const int i = ((bj * 128 + cin) & 63) >> 3; const float* rp = rope + ((size_t)(row & (S - 1)) * 32 + 4 * i) * 2;
                        const f32x4 r0 = *(const f32x4*)rp, r1 = *(const f32x4*)(rp + 4);
                        const f32x4 cs = {r0[0], r0[2], r1[0], r1[2]}, sn = {r0[1], r0[3], r1[1], r1[3]};
                        const f32x4 o1 = (v0 * cs - v1 * sn) * sc, o2 = (v1 * cs + v0 * sn) * sc; v0 = o1; v1 = o2;
                    } else if (mode == 2) {
#pragma unroll
                        for (int e = 0; e < 4; ++e) { v0[e] = fsig(v0[e]); v1[e] = fsig(v1[e]); }
                    }
                    *(v4u*)(rowp + bj * 128) = pack8(v0, v1);
                }
            }
    }
};
struct EpiMerge2 {
    static constexpr bool PERM = true, AFTER_DRAIN = false;
    const bf16* GH; const bf16* GA; bf16* T1; bf16* MG;
    __device__ __forceinline__ void operator()(const f32x4 (&acc)[2][2][4][2], const Unit& u, int wr, int wc, int fr, int fq) const {
        const int row0 = u.pm * 256 + wr * 64 + fr, col0 = u.pn * 256 + wc * 32 + 8 * fq; const bool second = u.pa != u.pm; const bf16* G = second ? GA : GH;
#pragma unroll
        for (int ai = 0; ai < 2; ++ai)
#pragma unroll
            for (int m = 0; m < 4; ++m) { const size_t off = (size_t)(row0 + ai * 128 + m * 16) * D + col0;
#pragma unroll
                for (int bj = 0; bj < 2; ++bj) { f32x4 g0, g1; unpack8(*(const v4u*)(G + off + bj * 128), g0, g1);
                    f32x4 v0 = acc[ai][bj][m][0] * g0, v1 = acc[ai][bj][m][1] * g1;
                    if (second) { f32x4 t0, t1; unpack8(*(const v4u*)(T1 + off + bj * 128), t0, t1); v0 += t0; v1 += t1; *(v4u*)(MG + off + bj * 128) = pack8(v0, v1); }
                    else *(v4u*)(T1 + off + bj * 128) = pack8(v0, v1); } }
    }
};
struct OrderMerge {
    pg8::StaticOrder so;
    __device__ __forceinline__ bool next(int i, Unit& u) const { if (!so.next(i >> 1, u)) return false; if (i & 1) { u.pa = u.pm + T / 256; u.pb = u.pn + 4; } return true; }
    __device__ __forceinline__ void a_ready(const Unit&) const {}
    __device__ __forceinline__ void done(const Unit&) const {}
};
struct EpiOut {
    static constexpr bool PERM = false, AFTER_DRAIN = false;
    const float* xin; float* X;
    __device__ __forceinline__ void operator()(const f32x4 (&acc)[2][2][4][2], const Unit& u, int wr, int wc, int fr, int fq) const {
        const int row0 = u.pm * 256 + wr * 64 + fr, col0 = u.pn * 256 + wc * 32 + 4 * fq;
#pragma unroll
        for (int ai = 0; ai < 2; ++ai)
#pragma unroll
            for (int m = 0; m < 4; ++m) { const size_t off = (size_t)(row0 + ai * 128 + m * 16) * D + col0;
#pragma unroll
                for (int bj = 0; bj < 2; ++bj)
#pragma unroll
                    for (int n = 0; n < 2; ++n) *(f32x4*)(X + off + bj * 128 + n * 16) = *(const f32x4*)(xin + off + bj * 128 + n * 16) + acc[ai][bj][m][n]; }
    }
};
struct EpiOutR {
    static constexpr bool PERM = true, AFTER_DRAIN = true;
    const float* xin; float* X; bf16* XB; float* PART; const bf16* WRP; unsigned* tick; float* AFFT; float* RTOK; const float* br;
    __device__ __forceinline__ void operator()(const f32x4 (&)[2][2][4][2], const Unit&, int, int, int, int) const {}
    __device__ __forceinline__ void fused(const f32x4 (&acc)[2][2][4][2], const Unit& u, int wr, int wc, int fr, int fq, LAS unsigned char* lds, int wid, int lane) const {
        LAS float* SS = (LAS float*)lds;
        LAS float* LG = (LAS float*)(lds + 16384);
        const int rowl0 = wr * 64 + fr, colw = wc * 32 + 8 * fq;
        bf16x8 whi[2], wlo[2];
#pragma unroll
        for (int bj = 0; bj < 2; ++bj) { const bf16* wp = WRP + (size_t)fr * D + u.pn * 256 + bj * 128 + colw; whi[bj] = *(const bf16x8*)wp; wlo[bj] = *(const bf16x8*)(wp + (size_t)E * D); }
#pragma unroll
        for (int ai = 0; ai < 2; ++ai)
#pragma unroll
            for (int m = 0; m < 4; ++m) { const int rowl = rowl0 + ai * 128 + m * 16; float ss = 0.f; f32x4 lg = {0.f, 0.f, 0.f, 0.f};
#pragma unroll
                for (int bj = 0; bj < 2; ++bj) { const size_t off = (size_t)(u.pm * 256 + rowl) * D + u.pn * 256 + bj * 128 + colw;
                    const f32x4 x0 = *(const f32x4*)(xin + off) + acc[ai][bj][m][0], x1 = *(const f32x4*)(xin + off + 4) + acc[ai][bj][m][1];
                    *(f32x4*)(X + off) = x0; *(f32x4*)(X + off + 4) = x1;
                    const v4u hi = pack8(x0, x1); *(v4u*)(XB + off) = hi;
                    f32x4 h0, h1; unpack8(hi, h0, h1); const v4u lo = pack8(x0 - h0, x1 - h1);
                    ss += ((x0[0] * x0[0] + x0[1] * x0[1]) + (x0[2] * x0[2] + x0[3] * x0[3])) + ((x1[0] * x1[0] + x1[1] * x1[1]) + (x1[2] * x1[2] + x1[3] * x1[3]));
                    lg = __builtin_amdgcn_mfma_f32_16x16x32_bf16(whi[bj], __builtin_bit_cast(bf16x8, hi), lg, 0, 0, 0);
                    lg = __builtin_amdgcn_mfma_f32_16x16x32_bf16(whi[bj], __builtin_bit_cast(bf16x8, lo), lg, 0, 0, 0);
                    lg = __builtin_amdgcn_mfma_f32_16x16x32_bf16(wlo[bj], __builtin_bit_cast(bf16x8, hi), lg, 0, 0, 0); }
                SS[rowl * 16 + wc * 4 + fq] = ss;
                *(LAS f32x4*)(LG + ((wc * 256 + rowl) * 16 + 4 * fq)) = lg; }
        __syncthreads();
        const int t = wid * 64 + lane;
        if (t < 256) { float s = 0.f;
#pragma unroll
            for (int i = 0; i < 4; ++i) { const f32x4 v = *(const LAS f32x4*)(SS + t * 16 + 4 * i); s += (v[0] + v[1]) + (v[2] + v[3]); }
            float* pp = PART + ((size_t)u.pn * T + u.pm * 256 + t) * 20;
            __hip_atomic_store(pp, s, __ATOMIC_RELAXED, __HIP_MEMORY_SCOPE_AGENT);
#pragma unroll
            for (int i = 0; i < 4; ++i) { f32x4 a4 = *(const LAS f32x4*)(LG + (t * 16 + 4 * i));
#pragma unroll
                for (int w = 1; w < 4; ++w) a4 += *(const LAS f32x4*)(LG + ((w * 256 + t) * 16 + 4 * i));
#pragma unroll
                for (int q = 0; q < 4; ++q) __hip_atomic_store(pp + 4 + 4 * i + q, a4[q], __ATOMIC_RELAXED, __HIP_MEMORY_SCOPE_AGENT); } }
        asm volatile("s_waitcnt vmcnt(0)" ::: "memory");
        __syncthreads();
        LAS int* flag = (LAS int*)(lds + 16384 + 65536);
        if (t == 0) flag[0] = (int)__hip_atomic_fetch_add(tick + u.pm, 1u, __ATOMIC_RELAXED, __HIP_MEMORY_SCOPE_AGENT);
        __syncthreads();
        if (flag[0] == 3) {
            if (t < 256) { const int tok = u.pm * 256 + t; f32x4 s4 = {0.f, 0.f, 0.f, 0.f}, l4[4];
#pragma unroll
                for (int j = 0; j < 4; ++j) l4[j] = (f32x4){0.f, 0.f, 0.f, 0.f};
#pragma unroll
                for (int pn = 0; pn < 4; ++pn) { const float* pq = PART + ((size_t)pn * T + tok) * 20; s4[0] += __hip_atomic_load(pq, __ATOMIC_RELAXED, __HIP_MEMORY_SCOPE_AGENT);
#pragma unroll
                    for (int j = 0; j < 4; ++j)
#pragma unroll
                        for (int q = 0; q < 4; ++q) l4[j][q] += __hip_atomic_load(pq + 4 + 4 * j + q, __ATOMIC_RELAXED, __HIP_MEMORY_SCOPE_AGENT); }
                const float r = rsqrtf(s4[0] * (1.f / D) + 1e-6f); float mx = -1e30f;
#pragma unroll
                for (int j = 0; j < 4; ++j)
#pragma unroll
                    for (int q = 0; q < 4; ++q) { const float v = l4[j][q] * r + br[4 * j + q]; l4[j][q] = v; mx = fmaxf(mx, v); }
                float l = 0.f;
#pragma unroll
                for (int j = 0; j < 4; ++j)
#pragma unroll
                    for (int q = 0; q < 4; ++q) { l4[j][q] = expf(l4[j][q] - mx); l += l4[j][q]; }
                const int b = tok >> 12, s_ = tok & (S - 1);
#pragma unroll
                for (int j = 0; j < 4; ++j)
#pragma unroll
                    for (int q = 0; q < 4; ++q) AFFT[((size_t)b * E + 4 * j + q) * S + s_] = l4[j][q] / l;
                RTOK[tok] = r; } }
        __syncthreads();
    }
};
struct EpiSwiGLU {
    static constexpr bool PERM = true, AFTER_DRAIN = false;
    bf16* HB; const float* RSL;
    __device__ __forceinline__ void operator()(const f32x4 (&acc)[2][2][4][2], const Unit& u, int wr, int wc, int fr, int fq) const {
        const int row0 = u.pm * 256 + wr * 64 + fr, col0 = u.pn * 128 + wc * 32 + 8 * fq;
#pragma unroll
        for (int ai = 0; ai < 2; ++ai)
#pragma unroll
            for (int m = 0; m < 4; ++m) { f32x4 h[2]; const float rr = RSL[row0 + ai * 128 + m * 16];
#pragma unroll
                for (int n = 0; n < 2; ++n) { const f32x4 g = acc[ai][0][m][n] * rr, up = acc[ai][1][m][n] * rr;
#pragma unroll
                    for (int e = 0; e < 4; ++e) h[n][e] = g[e] * fsig(g[e]) * up[e]; }
                *(v4u*)(HB + (size_t)(row0 + ai * 128 + m * 16) * F + col0) = pack8(h[0], h[1]); }
    }
};
struct EpiDown {
    static constexpr bool PERM = true, AFTER_DRAIN = false;
    bf16* YE; const float* gate;
    __device__ __forceinline__ void operator()(const f32x4 (&acc)[2][2][4][2], const Unit& u, int wr, int wc, int fr, int fq) const {
        const int row0 = u.pm * 256 + wr * 64 + fr, col0 = u.pn * 256 + wc * 32 + 8 * fq;
#pragma unroll
        for (int ai = 0; ai < 2; ++ai)
#pragma unroll
            for (int m = 0; m < 4; ++m) { const int row = row0 + ai * 128 + m * 16; const float g = gate[row];
#pragma unroll
                for (int bj = 0; bj < 2; ++bj) *(v4u*)(YE + (size_t)row * D + col0 + bj * 128) = pack8(acc[ai][bj][m][0] * g, acc[ai][bj][m][1] * g); }
    }
};
struct OrderMoE1 {
    int G, c;
    __device__ __forceinline__ bool next(int i, Unit& u) const {
        if (MK_SIMPLE_ORDER || G != 256) { const int L = i * G + c; if (L >= 2048) return false; const int e = L >> 7, r = L & 127; u.pm = e * 8 + (r & 7); u.pn = r >> 3; u.pb = e * 16 + u.pn; u.pa = u.pm; return true; }
        if (i >= 8) return false;
        const int ch = i * 8 + (c & 7), j = c >> 3, e = ch >> 2, ng = ch & 3; u.pm = e * 8 + (j & 7); u.pn = ng * 4 + (j >> 3); u.pb = e * 16 + u.pn; u.pa = u.pm; return true;
    }
    __device__ __forceinline__ void a_ready(const Unit&) const {}
    __device__ __forceinline__ void done(const Unit&) const {}
};
struct OrderMoE2 {
    int G, c;
    __device__ __forceinline__ bool next(int i, Unit& u) const {
        if (MK_SIMPLE_ORDER || G != 256) { const int L = i * G + c; if (L >= 512) return false; const int e = L >> 5, r = L & 31; u.pm = e * 8 + (r & 7); u.pn = r >> 3; u.pb = e * 4 + u.pn; u.pa = u.pm; return true; }
        if (i >= 2) return false;
        const int e = i * 8 + (c & 7), j = c >> 3; u.pm = e * 8 + (j & 7); u.pn = j >> 3; u.pb = e * 4 + u.pn; u.pa = u.pm; return true;
    }
    __device__ __forceinline__ void a_ready(const Unit&) const {}
    __device__ __forceinline__ void done(const Unit&) const {}
};

__device__ __forceinline__ void p6_topk(const Ctx& X) {
    const float* afft = (const float*)(X.ws + WS_AFFT); const float* rtok = (const float*)(X.ws + WS_RTOK); int* rows = (int*)(X.ws + WS_ROWS); float* gate = (float*)(X.ws + WS_GATE); float* rsl = (float*)(X.ws + WS_RSL); int* inv = (int*)(X.ws + WS_INV);
    for (int p = X.bid; p < B * E; p += X.G) { const int b = p >> 4, e = p & 15, slotbase = e * 2048 + b * 512;
        unsigned key[8]; float rr[8];
        { const uint4 k0 = ((const uint4*)(afft + (size_t)p * S))[X.tid * 2], k1 = ((const uint4*)(afft + (size_t)p * S))[X.tid * 2 + 1]; const f32x4 r0 = ((const f32x4*)(rtok + b * S))[X.tid * 2], r1 = ((const f32x4*)(rtok + b * S))[X.tid * 2 + 1];
          key[0] = k0.x; key[1] = k0.y; key[2] = k0.z; key[3] = k0.w; key[4] = k1.x; key[5] = k1.y; key[6] = k1.z; key[7] = k1.w;
          rr[0] = r0[0]; rr[1] = r0[1]; rr[2] = r0[2]; rr[3] = r0[3]; rr[4] = r1[0]; rr[5] = r1[1]; rr[6] = r1[2]; rr[7] = r1[3]; }
        tk::topk_problem(key, rr, b * S, e, slotbase, rows + slotbase, gate + slotbase, rsl + slotbase, inv, (int*)(X.lds), X.tid); }
}
__device__ __forceinline__ void p9_combine(const Ctx& X, float* Xr, const float* __restrict__ g, bool final_, float* __restrict__ out) {
    const int* inv = (const int*)(X.ws + WS_INV); const bf16* YE = (const bf16*)(X.ws + WS_YE); bf16* XN = (bf16*)(X.ws + WS_XN); const int lane = X.lane;
    Row8 gg; row8_load(gg, g, lane);
    int tok = X.gw; Row8 cur; int myinv = -1;
    if (tok < T) { row8_load(cur, Xr + (size_t)tok * D, lane); if (lane < 16) myinv = inv[(size_t)tok * E + lane]; }
    while (tok < T) {
        const int ntok = tok + X.ngw; Row8 nxt; int ninv = -1;
        if (ntok < T) { row8_load(nxt, Xr + (size_t)ntok * D, lane); if (lane < 16) ninv = inv[(size_t)ntok * E + lane]; }
        unsigned long long m = __ballot(myinv >= 0);
        while (m) {
            int sl[4];
#pragma unroll
            for (int i = 0; i < 4; ++i) { if (m) { const int e = __builtin_ctzll(m); m &= m - 1; sl[i] = __builtin_amdgcn_readlane(myinv, e); } else sl[i] = -1; }
            v4u y[4][2];
#pragma unroll
            for (int i = 0; i < 4; ++i) if (sl[i] >= 0) { const v4u* yp = (const v4u*)(YE + (size_t)sl[i] * D); y[i][0] = __builtin_nontemporal_load(yp + lane); y[i][1] = __builtin_nontemporal_load(yp + lane + 64); }
#pragma unroll
            for (int i = 0; i < 4; ++i) if (sl[i] >= 0) {
#pragma unroll
                for (int j = 0; j < 2; ++j) { f32x4 p, q; unpack8(y[i][j], p, q); cur.a[j][0] += p; cur.a[j][1] += q; } }
        }
        const float r = rsqrtf(wave_sum(row8_sumsq(cur)) * (1.f / D) + 1e-6f);
        if (final_) {
#pragma unroll
            for (int j = 0; j < 2; ++j)
#pragma unroll
                for (int h = 0; h < 2; ++h) ((f32x4*)(out + (size_t)tok * D))[2 * (lane + 64 * j) + h] = cur.a[j][h] * gg.a[j][h] * r;
        } else {
#pragma unroll
            for (int j = 0; j < 2; ++j) {
#pragma unroll
                for (int h = 0; h < 2; ++h) ((f32x4*)(Xr + (size_t)tok * D))[2 * (lane + 64 * j) + h] = cur.a[j][h];
                const f32x4 y0 = cur.a[j][0] * gg.a[j][0] * r, y1 = cur.a[j][1] * gg.a[j][1] * r;
                v4u w; w.x = pk2(y0.x, y0.y); w.y = pk2(y0.z, y0.w); w.z = pk2(y1.x, y1.y); w.w = pk2(y1.z, y1.w);
                ((v4u*)(XN + (size_t)tok * D))[lane + 64 * j] = w; }
        }
        cur = nxt; myinv = ninv; tok = ntok;
    }
}
}
namespace mk {
__device__ __forceinline__ void p1t_shortconv(const Ctx& X, const float* __restrict__ cw, const float* __restrict__ cb) {
    const bf16* U = (const bf16*)(X.ws + WS_U); bf16* UCT = (bf16*)(X.ws + WS_UCT);
    LAS float* raw = (LAS float*)(X.lds + X.wave * 17408);
    const int lane = X.lane, rq = lane >> 3, cq = lane & 7;
    constexpr int NIT = (T / 64) * 24;
    v4u w[9];
#define P1T_LOAD(it_) do { const int tt_ = (it_) / 24, cg_ = (it_) - tt_ * 24, tok0_ = tt_ * 64, tin_ = tok0_ & (S - 1); \
        _Pragma("unroll") for (int i = 0; i < 9; ++i) { const int r = 8 * i + rq, tpos = tin_ + r - 1; w[i] = (v4u){0u, 0u, 0u, 0u}; \
            if (r < 66 && tpos >= 0 && tpos < S) w[i] = *(const v4u*)(U + (size_t)(tok0_ + r - 1) * 1536 + cg_ * 64 + 8 * cq); } } while (0)
    int it = X.gw;
    if (it < NIT) P1T_LOAD(it);
    while (it < NIT) {
        const int tt = it / 24, cg = it - tt * 24, tok0 = tt * 64, ch0 = cg * 64;
#pragma unroll
        for (int i = 0; i < 9; ++i) { const int r = 8 * i + rq; if (r < 66) { LAS float* d = raw + r * 65 + 8 * cq; f32x4 p, q; unpack8(w[i], p, q);
            d[0] = p.x; d[1] = p.y; d[2] = p.z; d[3] = p.w; d[4] = q.x; d[5] = q.y; d[6] = q.z; d[7] = q.w; } }
        const int nit = it + X.ngw;
        if (nit < NIT) P1T_LOAD(nit);
        asm volatile("s_waitcnt lgkmcnt(0)" ::: "memory");
        const int chs = lane >> 3, tch = lane & 7;
#pragma unroll
        for (int g = 0; g < 8; ++g) { const int ch = 8 * g + chs, gc = ch0 + ch; const float w0 = cw[gc], w1 = cw[1536 + gc], w2 = cw[3072 + gc], bb = cb[gc];
            float v[10];
#pragma unroll
            for (int k = 0; k < 10; ++k) v[k] = raw[(8 * tch + k) * 65 + ch];
            float o[8];
#pragma unroll
            for (int k = 0; k < 8; ++k) o[k] = v[k] * w0 + v[k + 1] * w1 + v[k + 2] * w2 + bb;
            v4u pk; pk.x = pk2(o[0], o[1]); pk.y = pk2(o[2], o[3]); pk.z = pk2(o[4], o[5]); pk.w = pk2(o[6], o[7]);
            *(v4u*)(UCT + (size_t)gc * T + tok0 + 8 * tch) = pk; }
        asm volatile("s_waitcnt lgkmcnt(0)" ::: "memory");
        it = nit;
    }
#undef P1T_LOAD
}

__device__ __forceinline__ void p1t_kmax(const Ctx& X, unsigned* kmax2) {
    const bf16* K = (const bf16*)(X.ws + WS_K); const int lane = X.lane; LAS float* red = (LAS float*)(X.lds + 8 * 17408);
    const int b = X.gw / 512, t0 = X.gw % 512; float mx = 0.f;
    if (b < B) {
        v4u w[8];
#pragma unroll
        for (int i = 0; i < 8; ++i) w[i] = ((const v4u*)(K + ((size_t)b * S + t0 + 512 * i) * 512))[lane];
#pragma unroll
        for (int i = 0; i < 8; ++i) { f32x4 p, q; unpack8(w[i], p, q); float ss = (p.x * p.x + p.y * p.y) + (p.z * p.z + p.w * p.w) + (q.x * q.x + q.y * q.y) + (q.z * q.z + q.w * q.w);
            ss += xor_f<1>(ss); ss += xor_f<2>(ss); ss += xor_f<4>(ss); mx = fmaxf(mx, ss); }
    }
    __syncthreads();
    if ((lane & 7) == 0) red[X.wave * 8 + (lane >> 3)] = mx;
    __syncthreads();
    if (X.tid < 8 && b < B) { float m = red[X.tid]; for (int w_ = 1; w_ < 8; ++w_) m = fmaxf(m, red[w_ * 8 + X.tid]); atomicMax(kmax2 + b * 8 + X.tid, __float_as_uint(m)); }
}

namespace at {
constexpr int KVBLK = 64, LDK = 512;
constexpr int KPITCH = 272;
constexpr int SHM_V = 64 * 128 * 2, SHM_K = 64 * KPITCH;
constexpr int OFF_V = 0, OFF_K = 2 * SHM_V, OFF_Q = OFF_K + 2 * SHM_K, OFF_WS = OFF_Q + 256 * KPITCH, LDS_TOTAL = OFF_WS + 8 * 160 * 4;
constexpr float THR2 = 8.0f * 1.4426950408889634f;
#define KSWZ(row, colB) ((row) * KPITCH + (colB))
#define SBAR() __builtin_amdgcn_sched_barrier(0)
__device__ __forceinline__ int crow(int r, int hi) { return (r & 3) + 8 * (r >> 2) + 4 * hi; }
__device__ __forceinline__ int v_st(int k, int c) { const int kk = (k & ~0xC) | ((k & 4) << 1) | ((k & 8) >> 1); return ((kk >> 3) * 4 + (c >> 5)) * 512 + ((kk & 7) * 32 + (c & 31)) * 2; }
__device__ __forceinline__ int v_rd_base(int lane) { return ((lane & 3) << 3) | (((lane >> 2) & 3) << 6) | (((lane >> 4) & 1) << 5) | (((lane >> 5) & 1) << 8); }
constexpr int v_rd_off(int d0, int ks, int half) { return d0 * 512 + ks * 4096 + half * 2048; }
template <int OFF> __device__ __forceinline__ s16x4 tr_read(int vb) { s16x4 r; asm volatile("ds_read_b64_tr_b16 %0, %1 offset:%2" : "=&v"(r) : "v"(vb), "i"(OFF) : "memory"); return r; }

template <int CO> __device__ __forceinline__ void qkt(f32x16& p0, f32x16& p1, const char* Ks, const char* Qs, int qrow, int r32, int hi) {
    p0 = f32x16{}; p1 = f32x16{};
    const char* qp = Qs + KSWZ(qrow, (CO * 64 + hi * 8) * 2); const char* kp = Ks + KSWZ(r32, (CO * 64 + hi * 8) * 2);
#pragma unroll
    for (int d0 = 0; d0 < 4; ++d0) {
        const bf16x8 qf = *reinterpret_cast<const bf16x8*>(qp + d0 * 32);
        const bf16x8 b0 = *reinterpret_cast<const bf16x8*>(kp + d0 * 32);
        const bf16x8 b1 = *reinterpret_cast<const bf16x8*>(kp + 32 * KPITCH + d0 * 32);
        p0 = __builtin_amdgcn_mfma_f32_32x32x16_bf16(b0, qf, p0, 0, 0, 0);
        p1 = __builtin_amdgcn_mfma_f32_32x32x16_bf16(b1, qf, p1, 0, 0, 0);
        if (d0 == 1) asm volatile("" ::: "memory"); }
}
__device__ __forceinline__ void softmax_tile(f32x16& p0, f32x16& p1, float& m_reg, float& l_reg, float& alpha, bf16x8& pa0, bf16x8& pa1, bf16x8& pa2, bf16x8& pa3) {
    float pmax = p0[0];
#pragma unroll
    for (int r = 1; r < 16; ++r) pmax = fmaxf(pmax, p0[r]);
#pragma unroll
    for (int r = 0; r < 16; ++r) pmax = fmaxf(pmax, p1[r]);
    { auto rr = __builtin_amdgcn_permlane32_swap(__float_as_uint(pmax), __float_as_uint(pmax), false, false); pmax = fmaxf(__uint_as_float(rr[0]), __uint_as_float(rr[1])); }
    float mn;
    if (__builtin_expect(__all(pmax - m_reg <= THR2), 1)) { mn = m_reg; alpha = 1.f; }
    else { mn = fmaxf(m_reg, pmax); alpha = __builtin_amdgcn_exp2f(m_reg - mn); m_reg = mn; }
#pragma unroll
    for (int r = 0; r < 16; ++r) { p0[r] = __builtin_amdgcn_exp2f(p0[r] - mn); p1[r] = __builtin_amdgcn_exp2f(p1[r] - mn); }
    float ps = 0.f;
#pragma unroll
    for (int r = 0; r < 16; ++r) ps += p0[r];
#pragma unroll
    for (int r = 0; r < 16; ++r) ps += p1[r];
    { auto rr = __builtin_amdgcn_permlane32_swap(__float_as_uint(ps), __float_as_uint(ps), false, false); ps = __uint_as_float(rr[0]) + __uint_as_float(rr[1]); }
    l_reg = l_reg * alpha + ps;
#define PK4(P, BASE, OUT) do { unsigned a0 = cvtpk(P[BASE + 0], P[BASE + 1]), a1 = cvtpk(P[BASE + 2], P[BASE + 3]);   \
    unsigned b0 = cvtpk(P[BASE + 4], P[BASE + 5]), b1 = cvtpk(P[BASE + 6], P[BASE + 7]);                              \
    auto r0 = __builtin_amdgcn_permlane32_swap(a0, b0, false, false); auto r1 = __builtin_amdgcn_permlane32_swap(a1, b1, false, false); \
    v4u w = {r0[0], r1[0], r0[1], r1[1]}; OUT = *reinterpret_cast<bf16x8*>(&w); } while (0)
    PK4(p0, 0, pa0); PK4(p0, 8, pa1); PK4(p1, 0, pa2); PK4(p1, 8, pa3);
#undef PK4
}
__device__ __forceinline__ void softmax_fixed(f32x16& p0, f32x16& p1, float m, float& l_half, bf16x8& pa0, bf16x8& pa1, bf16x8& pa2, bf16x8& pa3) {
#pragma unroll
    for (int r = 0; r < 16; ++r) { p0[r] = __builtin_amdgcn_exp2f(p0[r] - m); p1[r] = __builtin_amdgcn_exp2f(p1[r] - m); }
    float ps = 0.f;
#pragma unroll
    for (int r = 0; r < 16; ++r) ps += p0[r] + p1[r];
    l_half += ps;
#define PK4(P, BASE, OUT) do { unsigned a0 = cvtpk(P[BASE + 0], P[BASE + 1]), a1 = cvtpk(P[BASE + 2], P[BASE + 3]);   \
    unsigned b0 = cvtpk(P[BASE + 4], P[BASE + 5]), b1 = cvtpk(P[BASE + 6], P[BASE + 7]);                              \
    auto r0 = __builtin_amdgcn_permlane32_swap(a0, b0, false, false); auto r1 = __builtin_amdgcn_permlane32_swap(a1, b1, false, false); \
    v4u w = {r0[0], r1[0], r0[1], r1[1]}; OUT = *reinterpret_cast<bf16x8*>(&w); } while (0)
    PK4(p0, 0, pa0); PK4(p0, 8, pa1); PK4(p1, 0, pa2); PK4(p1, 8, pa3);
#undef PK4
}
template <int D0> __device__ __forceinline__ void pv_one(f32x16& oa, int vb, const bf16x8 (&pa)[4]) {
#define PK(L, H) (bf16x8){L[0], L[1], L[2], L[3], H[0], H[1], H[2], H[3]}
    {   const s16x4 l0 = tr_read<v_rd_off(D0, 0, 0)>(vb), h0 = tr_read<v_rd_off(D0, 0, 1)>(vb), l1 = tr_read<v_rd_off(D0, 1, 0)>(vb), h1 = tr_read<v_rd_off(D0, 1, 1)>(vb);
        asm volatile("s_waitcnt lgkmcnt(0)" ::: "memory"); SBAR();
        oa = __builtin_amdgcn_mfma_f32_32x32x16_bf16(pa[0], PK(l0, h0), oa, 0, 0, 0);
        oa = __builtin_amdgcn_mfma_f32_32x32x16_bf16(pa[1], PK(l1, h1), oa, 0, 0, 0); }
    {   const s16x4 l2 = tr_read<v_rd_off(D0, 2, 0)>(vb), h2 = tr_read<v_rd_off(D0, 2, 1)>(vb), l3 = tr_read<v_rd_off(D0, 3, 0)>(vb), h3 = tr_read<v_rd_off(D0, 3, 1)>(vb);
        asm volatile("s_waitcnt lgkmcnt(0)" ::: "memory"); SBAR();
        oa = __builtin_amdgcn_mfma_f32_32x32x16_bf16(pa[2], PK(l2, h2), oa, 0, 0, 0);
        oa = __builtin_amdgcn_mfma_f32_32x32x16_bf16(pa[3], PK(l3, h3), oa, 0, 0, 0); }
#undef PK
}
template <int D0> __device__ __forceinline__ void pv_two(f32x16& oa, f32x16& ob, int vb, const bf16x8 (&pa)[4], const bf16x8 (&pb)[4]) {
#define PK(L, H) (bf16x8){L[0], L[1], L[2], L[3], H[0], H[1], H[2], H[3]}
    {   const s16x4 l0 = tr_read<v_rd_off(D0, 0, 0)>(vb), h0 = tr_read<v_rd_off(D0, 0, 1)>(vb), l1 = tr_read<v_rd_off(D0, 1, 0)>(vb), h1 = tr_read<v_rd_off(D0, 1, 1)>(vb);
        asm volatile("s_waitcnt lgkmcnt(0)" ::: "memory"); SBAR();
        const bf16x8 v0 = PK(l0, h0), v1 = PK(l1, h1);
        oa = __builtin_amdgcn_mfma_f32_32x32x16_bf16(pa[0], v0, oa, 0, 0, 0); ob = __builtin_amdgcn_mfma_f32_32x32x16_bf16(pb[0], v0, ob, 0, 0, 0);
        oa = __builtin_amdgcn_mfma_f32_32x32x16_bf16(pa[1], v1, oa, 0, 0, 0); ob = __builtin_amdgcn_mfma_f32_32x32x16_bf16(pb[1], v1, ob, 0, 0, 0); }
    {   const s16x4 l2 = tr_read<v_rd_off(D0, 2, 0)>(vb), h2 = tr_read<v_rd_off(D0, 2, 1)>(vb), l3 = tr_read<v_rd_off(D0, 3, 0)>(vb), h3 = tr_read<v_rd_off(D0, 3, 1)>(vb);
        asm volatile("s_waitcnt lgkmcnt(0)" ::: "memory"); SBAR();
        const bf16x8 v2 = PK(l2, h2), v3 = PK(l3, h3);
        oa = __builtin_amdgcn_mfma_f32_32x32x16_bf16(pa[2], v2, oa, 0, 0, 0); ob = __builtin_amdgcn_mfma_f32_32x32x16_bf16(pb[2], v2, ob, 0, 0, 0);
        oa = __builtin_amdgcn_mfma_f32_32x32x16_bf16(pa[3], v3, oa, 0, 0, 0); ob = __builtin_amdgcn_mfma_f32_32x32x16_bf16(pb[3], v3, ob, 0, 0, 0); }
#undef PK
}
__device__ __forceinline__ void rescale(f32x16 (&o)[4], float al, float* wsf, int r32, int hi) {
    if (__any(al < 1.f)) {
        if (hi == 0) wsf[r32] = al; asm volatile("s_waitcnt lgkmcnt(0)" ::: "memory");
#pragma unroll
        for (int r = 0; r < 16; ++r) { const float a = wsf[crow(r, hi)];
#pragma unroll
            for (int d = 0; d < 4; ++d) o[d][r] *= a; }
    }
}

__device__ __forceinline__ void epilogue(const Ctx& X, f32x16 (&oa)[4], f32x16 (&ob)[4], const float* wsf, int r32, int hi, int b, int h, int qb, float lam, float mul, const float* __restrict__ sg) {
    bf16* Yw = (bf16*)(X.ws + WS_YA) + ((size_t)b * S + qb * 256 + X.wave * 32) * 512 + h * 128;
    float gcol[4];
#pragma unroll
    for (int d = 0; d < 4; ++d) gcol[d] = sg[d * 32 + r32] * mul;
#pragma unroll
    for (int r = 0; r < 16; ++r) { const int orow = crow(r, hi); const float i0 = __builtin_amdgcn_rcpf(wsf[orow] + wsf[64 + orow]), i1 = lam * __builtin_amdgcn_rcpf(wsf[32 + orow] + wsf[96 + orow]);
        float v[4], ss = 0.f;
#pragma unroll
        for (int d = 0; d < 4; ++d) { v[d] = oa[d][r] * i0 - ob[d][r] * i1; ss += v[d] * v[d]; }
        ss += xor_f<1>(ss); ss += xor_f<2>(ss); ss += xor_f<4>(ss); ss += xor_f<8>(ss); ss += xor_f<16>(ss);
        const float rn = rsqrtf(ss * (1.f / 128.f) + 1e-5f);
#pragma unroll
        for (int d = 0; d < 4; ++d) Yw[(size_t)orow * 512 + d * 32 + r32] = (bf16)f2bf(v[d] * rn * gcol[d]); }
}
__device__ __forceinline__ int vkey(int T_, int lane) { const int kk = ((T_ >> 2) << 3) | ((lane & 31) >> 2); return (kk & ~0xC) | ((kk & 4) << 1) | ((kk & 8) >> 1); }
__device__ __forceinline__ int vcol(int T_, int lane) { return (T_ & 3) * 32 + (lane & 3) * 8; }
__device__ __forceinline__ void attn_unit(const Ctx& X, int b, int h, int qb, float lam, float mul, const float* __restrict__ sg, unsigned* kmax2) {
    char* lds = (char*)X.lds;
    const int tid = fresh_tid(X.wave_s);
    const int wid = X.wave, lane = tid & 63, r32 = lane & 31, hi = lane >> 5;
    const bf16* Qg = (const bf16*)(X.ws + WS_Q) + ((size_t)b * S + qb * 256) * LDK + h * 128;
    const bf16* Kh = (const bf16*)(X.ws + WS_K) + (size_t)b * S * LDK + h * 128;
    const bf16* Vh = (const bf16*)(X.ws + WS_V) + (size_t)b * S * LDK + h * 128;
    char* V_lds = lds + OFF_V; char* K_lds = lds + OFF_K; char* Q_lds = lds + OFF_Q;
    float* wsf = (float*)(lds + OFF_WS) + wid * 160;
    const int sr = tid >> 4, sc = (tid & 15) * 8, vst0 = v_st(sr, sc), vst1 = v_st(32 + sr, sc);
    const int vb0 = (int)(uintptr_t)V_lds + v_rd_base(lane);
#pragma unroll
    for (int i = 0; i < 8; ++i) { const int row = sr + 32 * i; *(bf16x8*)(Q_lds + KSWZ(row, sc * 2)) = *reinterpret_cast<const bf16x8*>(Qg + (size_t)row * LDK + sc); }
    bf16x8 st0, st1;
    const unsigned goff = (unsigned)(sr * LDK + sc) * 2u;
#define KLOAD(k0) do { const char* t_ = (const char*)Kh + (size_t)(k0) * (LDK * 2); st0 = *reinterpret_cast<const bf16x8*>(t_ + goff); st1 = *reinterpret_cast<const bf16x8*>(t_ + 32 * LDK * 2 + goff); } while (0)
#define VLOAD(k0) do { const char* t_ = (const char*)Vh + (size_t)(k0) * (LDK * 2); st0 = *reinterpret_cast<const bf16x8*>(t_ + goff); st1 = *reinterpret_cast<const bf16x8*>(t_ + 32 * LDK * 2 + goff); } while (0)
#define KWRITE(bb) do { *(bf16x8*)(K_lds + (bb) * SHM_K + KSWZ(sr, sc * 2)) = st0; *(bf16x8*)(K_lds + (bb) * SHM_K + KSWZ(32 + sr, sc * 2)) = st1; } while (0)
    const unsigned vsrc0 = (unsigned)(vkey(2 * wid + (lane >> 5), lane) * LDK + vcol(2 * wid + (lane >> 5), lane)) * 2u, vsrc1 = (unsigned)(vkey(2 * (wid + 8) + (lane >> 5), lane) * LDK + vcol(2 * (wid + 8) + (lane >> 5), lane)) * 2u;
#define VDMA(k0, bbn) do { const char* t_ = (const char*)Vh + (size_t)(k0) * (LDK * 2); LAS unsigned char* d_ = X.lds + OFF_V + (bbn) * SHM_V + wid * 1024; \
    __builtin_amdgcn_global_load_lds((const unsigned*)(t_ + vsrc0), (LAS unsigned*)d_, 16, 0, 0); __builtin_amdgcn_global_load_lds((const unsigned*)(t_ + vsrc1), (LAS unsigned*)(d_ + 8192), 16, 0, 0); } while (0)
    const unsigned ksrc = (unsigned)(wid * 8 * LDK * 2) + (unsigned)lane * 4u;
#define KDMA(k0, bbn) do { const char* t_ = (const char*)Kh + (size_t)(k0) * (LDK * 2) + ksrc; LAS unsigned char* d_ = X.lds + OFF_K + (bbn) * SHM_K + wid * 8 * KPITCH; \
    _Pragma("unroll") for (int i_ = 0; i_ < 8; ++i_) __builtin_amdgcn_global_load_lds((const unsigned*)(t_ + i_ * (LDK * 2)), (LAS unsigned*)(d_ + i_ * KPITCH), 4, 0, 0); } while (0)
#define VWRITE(bb) do { *(bf16x8*)(V_lds + (bb) * SHM_V + vst0) = st0; *(bf16x8*)(V_lds + (bb) * SHM_V + vst1) = st1; } while (0)
    float l0 = 0.f, l1 = 0.f; f32x16 oa[4] = {}, ob[4] = {};
    const int qrow = wid * 32 + r32; constexpr int NT = S / KVBLK;
    KDMA(0, 0); VDMA(0, 0); __syncthreads();
    float m0, m1;
    { float s0 = 0.f, s1 = 0.f;
#pragma unroll
      for (int d0 = 0; d0 < 8; ++d0) { const v4u w = *reinterpret_cast<const v4u*>(Q_lds + KSWZ(qrow, (d0 * 16 + hi * 8) * 2)); f32x4 p, q; unpack8(w, p, q);
          const float ss = (p.x * p.x + p.y * p.y) + (p.z * p.z + p.w * p.w) + (q.x * q.x + q.y * q.y) + (q.z * q.z + q.w * q.w); if (d0 < 4) s0 += ss; else s1 += ss; }
      wsf[hi * 64 + r32] = s0; wsf[hi * 64 + 32 + r32] = s1; asm volatile("s_waitcnt lgkmcnt(0)" ::: "memory");
      s0 += wsf[(hi ^ 1) * 64 + r32]; s1 += wsf[(hi ^ 1) * 64 + 32 + r32]; asm volatile("s_waitcnt lgkmcnt(0)" ::: "memory");
      const float k0 = __uint_as_float(__hip_atomic_load(kmax2 + b * 8 + h * 2, __ATOMIC_RELAXED, __HIP_MEMORY_SCOPE_AGENT)), k1 = __uint_as_float(__hip_atomic_load(kmax2 + b * 8 + h * 2 + 1, __ATOMIC_RELAXED, __HIP_MEMORY_SCOPE_AGENT));
      m0 = sqrtf(s0 * k0) * 1.001f + 1e-3f; m1 = sqrtf(s1 * k1) * 1.001f + 1e-3f; }
    for (int j = 0; j < NT; ++j) {
        const int bb = j & 1; const char* Ks = K_lds + bb * SHM_K;
        const int kn = (j + 1) * KVBLK;
        if (j + 1 < NT) { KDMA(kn, bb ^ 1); VDMA(kn, bb ^ 1); }
        const int vb = vb0 + bb * SHM_V;
        bf16x8 pa[4], pb[4];
        { f32x16 p0, p1, q0, q1;
          qkt<0>(p0, p1, Ks, Q_lds, qrow, r32, hi); qkt<1>(q0, q1, Ks, Q_lds, qrow, r32, hi);
          softmax_fixed(p0, p1, m0, l0, pa[0], pa[1], pa[2], pa[3]);
          softmax_fixed(q0, q1, m1, l1, pb[0], pb[1], pb[2], pb[3]); }
        SBAR();
        pv_two<0>(oa[0], ob[0], vb, pa, pb); pv_two<1>(oa[1], ob[1], vb, pa, pb); pv_two<2>(oa[2], ob[2], vb, pa, pb); pv_two<3>(oa[3], ob[3], vb, pa, pb);
        __syncthreads();
    }
#undef KLOAD
#undef VLOAD
#undef VDMA
#undef KDMA
#undef KWRITE
#undef VWRITE
    wsf[hi * 64 + r32] = l0; wsf[hi * 64 + 32 + r32] = l1; asm volatile("s_waitcnt lgkmcnt(0)" ::: "memory");
    { const int t2 = fresh_tid(X.wave_s); epilogue(X, oa, ob, wsf, t2 & 31, (t2 & 63) >> 5, b, h, qb, lam, mul, sg); }
    __syncthreads();
}
__device__ __forceinline__ void epilogue_unused() {}
#undef KSWZ
#undef SBAR
}
}
namespace mk {
namespace hy {
struct CvSet { int have; f32x4 ld0, ld1, ld2, ld3; float sc; };
struct CvState { int next, stride, nlim, cnt, par; CvSet a, b; };
#define CV_PDECL const float* cwg, const float* cwu, const float* cwd, bf16* ctgu, bf16* ctd, const float* cgn
#define CV_PARGS cwg, cwu, cwd, ctgu, ctd, cgn
constexpr int CV_TILES = 3 * 16 * 2048;
#ifndef CV_EVERY
#define CV_EVERY 5
#endif
__device__ __forceinline__ void cv_issue(CvState& s, CvSet& q, int lane, CV_PDECL) {
    if (s.next < s.nlim) { asm volatile("" : "+v"(lane));
        const int t = s.next, me = t >> 11, rr = t & 2047, mat = me >> 4, e = me & 15;
        const float* W = (mat == 0 ? cwg : (mat == 1 ? cwu : cwd)) + (size_t)e * D * F + rr * 1024 + 4 * lane;
        q.ld0 = __builtin_nontemporal_load((const f32x4*)W); q.ld1 = __builtin_nontemporal_load((const f32x4*)(W + 256)); q.ld2 = __builtin_nontemporal_load((const f32x4*)(W + 512)); q.ld3 = __builtin_nontemporal_load((const f32x4*)(W + 768));
        { const float g_ = cgn[mat < 2 ? (rr >> 1) : 0]; q.sc = mat < 2 ? g_ : 1.f; }
        q.have = t; s.next = t + s.stride; }
    else q.have = -1;
}
__device__ __forceinline__ void cv_finish_set(CvState& s, CvSet& q, int lane, CV_PDECL) {
    const int t = q.have; v2u o0 = {0u, 0u}, o1 = {0u, 0u}, o2 = {0u, 0u}, o3 = {0u, 0u};
    if (t >= 0) { const float sc = q.sc;
        o0.x = cvtpk_(q.ld0[0] * sc, q.ld0[1] * sc); o0.y = cvtpk_(q.ld0[2] * sc, q.ld0[3] * sc); o1.x = cvtpk_(q.ld1[0] * sc, q.ld1[1] * sc); o1.y = cvtpk_(q.ld1[2] * sc, q.ld1[3] * sc);
        o2.x = cvtpk_(q.ld2[0] * sc, q.ld2[1] * sc); o2.y = cvtpk_(q.ld2[2] * sc, q.ld2[3] * sc); o3.x = cvtpk_(q.ld3[0] * sc, q.ld3[1] * sc); o3.y = cvtpk_(q.ld3[2] * sc, q.ld3[3] * sc); }
    cv_issue(s, q, lane, CV_PARGS);
    if (t >= 0) { asm volatile("" : "+v"(lane)); const int me = t >> 11, rr = t & 2047, mat = me >> 4, e = me & 15;
        bf16* dst; int qs;
        if (mat == 2) { dst = ctd + (size_t)e * D * F + rr * 1024 + 4 * lane; qs = 256; }
        else { const int k = rr >> 1, n = (rr & 1) * 1024 + 4 * lane; dst = ctgu + ((size_t)e * D + k) * (2 * F) + 2 * (n & ~127) + (n & 127) + 128 * mat; qs = 512; }
        __builtin_nontemporal_store(o0, (v2u*)dst); __builtin_nontemporal_store(o1, (v2u*)(dst + qs)); __builtin_nontemporal_store(o2, (v2u*)(dst + 2 * qs)); __builtin_nontemporal_store(o3, (v2u*)(dst + 3 * qs)); }
}
__device__ __forceinline__ void cv_finish(CvState& s, int lane, CV_PDECL) { if (s.par) cv_finish_set(s, s.b, lane, CV_PARGS); else cv_finish_set(s, s.a, lane, CV_PARGS); s.par ^= 1; }

constexpr int CPS = 16704;
constexpr int NEL = 8352;
constexpr int OFF_Z = 4 * CPS;
constexpr int ZROW = 144, ZB = 128 * ZROW;
constexpr int LDS_TOTAL = OFF_Z + 4 * ZB;

__device__ __forceinline__ void build_hrev(const Ctx& X, const bf16* hf, const bf16* hb, float bias) {
    const int tid = X.tid;
    if (tid < 4 * 8) { const int m = tid >> 3, e = tid & 7; if (e < 5 - m) *(LAS bf16*)(X.lds + m * CPS + 2 * e) = 0; }
    for (int i = tid; i < 4 * (NEL - 8192); i += NTH) { const int m = i / (NEL - 8192), e = 8192 + (i - m * (NEL - 8192)); if (e > 8195 - m) *(LAS bf16*)(X.lds + m * CPS + 2 * e) = 0; }
#pragma unroll
    for (int half = 0; half < 2; ++half) {
        const v4u w = *(const v4u*)((half ? hb : hf) + 8 * tid);
        unsigned short v[8] = {(unsigned short)(w.x & 0xffff), (unsigned short)(w.x >> 16), (unsigned short)(w.y & 0xffff), (unsigned short)(w.y >> 16), (unsigned short)(w.z & 0xffff), (unsigned short)(w.z >> 16), (unsigned short)(w.w & 0xffff), (unsigned short)(w.w >> 16)};
        if (half == 0 && tid == 0) v[0] = (unsigned short)f2bf(bf2f(v[0]) + bias);
#pragma unroll
        for (int k = 0; k < 8; ++k) { const int d = 8 * tid + k; if (half == 1 && d == 0) continue;
            const int e0 = half ? 4100 + d : 4100 - d;
#pragma unroll
            for (int m = 0; m < 4; ++m) *(LAS bf16*)(X.lds + m * CPS + 2 * (e0 - m)) = v[k]; }
    }
}
#ifdef MK_HY_XLDS
#define HY_XL(qq) do { const v2u x0_ = *(const volatile LAS v2u*)(X.lds + baseA + 32 * (qq)), x1_ = *(const volatile LAS v2u*)(X.lds + baseA8 + 32 * (qq)); asm volatile("" :: "v"(x0_), "v"(x1_)); } while (0)
#else
#define HY_XL(qq) do {} while (0)
#endif
#define HY_LDA(dst, qq) do { HY_XL(qq); const v2u lo_ = *(const volatile LAS v2u*)(X.lds + baseA + 32 * (qq)), hi_ = *(const volatile LAS v2u*)(X.lds + baseA8 + 32 * (qq)); v4u w_ = {lo_.x, lo_.y, hi_.x, hi_.y}; dst = *reinterpret_cast<bf16x8*>(&w_); } while (0)
#define HY_LOAD_E(FA, FB, d1_, q_) do { const LAS unsigned char* zr_ = zb - (d1_) * ZROW; HY_LDA(FA[0], (q_)); HY_LDA(FA[1], (q_) + 1); \
    FB[0] = *(const LAS bf16x8*)(zr_); FB[1] = *(const LAS bf16x8*)(zr_ + 32); FB[2] = *(const LAS bf16x8*)(zr_ + 64); FB[3] = *(const LAS bf16x8*)(zr_ + 96); } while (0)
#define HY_LOAD_L(FA, q_) do { HY_LDA(FA[2], (q_) + 2); HY_LDA(FA[3], (q_) + 3); } while (0)
#ifdef MK_HY_XMFMA
#define HY_XM(A_, B_) do { dacc0 = __builtin_amdgcn_mfma_f32_32x32x16_bf16(A_, B_, dacc0, 0, 0, 0); } while (0)
#else
#define HY_XM(A_, B_) do {} while (0)
#endif
#define HY_MMA1(FA, FB, PA) do { __builtin_amdgcn_s_setprio(1); HY_XM(FA[0], FB[0]); HY_XM(PA[2], FB[0]); HY_XM(FA[1], FB[1]); HY_XM(PA[3], FB[1]); \
    acc0 = __builtin_amdgcn_mfma_f32_32x32x16_bf16(FA[0], FB[0], acc0, 0, 0, 0); acc1 = __builtin_amdgcn_mfma_f32_32x32x16_bf16(PA[2], FB[0], acc1, 0, 0, 0); \
    acc0 = __builtin_amdgcn_mfma_f32_32x32x16_bf16(FA[1], FB[1], acc0, 0, 0, 0); acc1 = __builtin_amdgcn_mfma_f32_32x32x16_bf16(PA[3], FB[1], acc1, 0, 0, 0); __builtin_amdgcn_s_setprio(0); } while (0)
#define HY_MMA2(FA, FB) do { __builtin_amdgcn_s_setprio(1); HY_XM(FA[2], FB[2]); HY_XM(FA[0], FB[2]); HY_XM(FA[3], FB[3]); HY_XM(FA[1], FB[3]); \
    acc0 = __builtin_amdgcn_mfma_f32_32x32x16_bf16(FA[2], FB[2], acc0, 0, 0, 0); acc1 = __builtin_amdgcn_mfma_f32_32x32x16_bf16(FA[0], FB[2], acc1, 0, 0, 0); \
    acc0 = __builtin_amdgcn_mfma_f32_32x32x16_bf16(FA[3], FB[3], acc0, 0, 0, 0); acc1 = __builtin_amdgcn_mfma_f32_32x32x16_bf16(FA[1], FB[3], acc1, 0, 0, 0); __builtin_amdgcn_s_setprio(0); } while (0)
template <int PAIR> __device__ __forceinline__ void channel(const Ctx& X, int l, int c, const float* __restrict__ hyb, CvState& cs, CV_PDECL) {
    const bf16* UCT = (const bf16*)(X.ws + WS_UCT); const bf16* FILT = (const bf16*)(X.ws + WS_FILT) + (size_t)l * 4 * C * S; bf16* YH = (bf16*)(X.ws + WS_YH);
    const int tid = X.tid, lane = X.lane, wid = X.wave, r = lane & 31, h = lane >> 5, b = wid >> 1, jt = wid & 1;
    LAS unsigned char* zl = X.lds + OFF_Z;
    v2u* const stash0 = (v2u*)(X.ws + WS_XN) + (size_t)X.bid * 8 * NTH;
    __syncthreads();
    v4u zero4 = {0u, 0u, 0u, 0u}; asm volatile("" : "+v"(zero4));
    for (int i = tid; i < 4 * 64 * 9; i += NTH) { const int bb = i / 576, rr = (i % 576) / 9, ch = i % 9; const int row = rr < 32 ? rr : 64 + rr;
        *(LAS v4u*)(zl + bb * ZB + row * ZROW + ch * 16) = zero4; }
    for (int i = tid; i < 4 * 64 * 8; i += NTH) { const int bb = i >> 9, s1 = (i >> 3) & 63, ch = i & 7;
        *(LAS v4u*)(zl + bb * ZB + (32 + s1) * ZROW + ch * 16) = *(const v4u*)(UCT + (size_t)c * T + bb * S + s1 * 64 + ch * 8); }
    const int m4 = (4 - (r & 3)) & 3;
    const int baseA = m4 * CPS + 2 * (8 * h - r + 4100 - m4);
    int baseA8 = baseA + 8; asm volatile("" : "+v"(baseA8));
    for (int o = 0; o < 2; ++o) {
        build_hrev(X, FILT + ((size_t)(2 * o) * C + c) * S, FILT + ((size_t)(2 * o + 1) * C + c) * S, hyb[(l * 2 + o) * C + c]);
#ifdef MK_HY_DUPBUILD
        asm volatile("" ::: "memory"); build_hrev(X, FILT + ((size_t)(2 * o) * C + c) * S, FILT + ((size_t)(2 * o + 1) * C + c) * S, hyb[(l * 2 + o) * C + c]);
#endif
        const bf16* gate = UCT + (size_t)((o + 1) * C + c) * T + (size_t)b * S;
        const int t1 = 32 * jt + r;
        __syncthreads();
#ifndef MK_HY_SWEEPS
#define MK_HY_SWEEPS 1
#endif
        f32x16 acc0 = {}, acc1 = {};
#ifdef MK_HY_XMFMA
        f32x16 dacc0 = {};
#endif
        for (int rep = 0; rep < MK_HY_SWEEPS; ++rep) {
        const int d1max = 32 * jt + 31; int q = -4 * d1max;
        const LAS unsigned char* zb = zl + b * ZB + (32 + 32 * jt + r) * ZROW + 16 * h;
        bf16x8 fa0[4], fb0[4], fa1[4], fb1[4];
        HY_LDA(fa1[2], q - 2); HY_LDA(fa1[3], q - 1);
        HY_LOAD_E(fa0, fb0, d1max, q); HY_LOAD_L(fa0, q);
        int d1 = d1max;
        for (int it = 0; it < 47; ++it) {
            HY_LOAD_E(fa1, fb1, d1 - 1, q + 4);
            HY_MMA1(fa0, fb0, fa1);
            HY_LOAD_L(fa1, q + 4);
            HY_MMA2(fa0, fb0);
            HY_LOAD_E(fa0, fb0, d1 - 2, q + 8);
            HY_MMA1(fa1, fb1, fa0);
            HY_LOAD_L(fa0, q + 8);
            HY_MMA2(fa1, fb1);
            d1 -= 2; q += 8;
            if (++cs.cnt == CV_EVERY) { cs.cnt = 0; cv_finish(cs, lane, CV_PARGS); }
        }
        HY_MMA1(fa0, fb0, fa1); HY_MMA2(fa0, fb0);
        }
        if (MK_HY_SWEEPS == 2) { acc0 *= 0.5f; acc1 *= 0.5f; }
#ifdef MK_HY_XMFMA
        asm volatile("" :: "v"(dacc0));
#endif
        asm volatile("" ::: "memory");
        v2u gw[2][4];
#pragma unroll
        for (int mt = 0; mt < 2; ++mt)
#pragma unroll
            for (int g = 0; g < 4; ++g) gw[mt][g] = *(const v2u*)(gate + t1 * 64 + 32 * mt + 8 * g + 4 * h);
        v2u kpv[2][4]; v2u* stash;
        { int st = tid * 8; asm volatile("" : "+v"(st)); stash = stash0 + st; }
        if (PAIR == 1 && o == 1) {
#pragma unroll
            for (int i = 0; i < 4; ++i) { const v4u w = ((const v4u*)stash)[i]; kpv[i >> 1][2 * (i & 1)] = v2u{w.x, w.y}; kpv[i >> 1][2 * (i & 1) + 1] = v2u{w.z, w.w}; } }
        __syncthreads();
#pragma unroll
        for (int mt = 0; mt < 2; ++mt)
#pragma unroll
            for (int g = 0; g < 4; ++g) { const int t0 = 32 * mt + 8 * g + 4 * h; const v2u gwv = gw[mt][g];
                const f32x16& a = mt ? acc1 : acc0;
                const float y0 = a[4 * g] * bflo(gwv.x), y1 = a[4 * g + 1] * bfhi(gwv.x), y2 = a[4 * g + 2] * bflo(gwv.y), y3 = a[4 * g + 3] * bfhi(gwv.y);
                if (o == 0) { v2u w; w.x = pk2(y0, y1); w.y = pk2(y2, y3); *(LAS v2u*)(zl + b * ZB + (32 + t1) * ZROW + t0 * 2) = w; }
                else if (PAIR == 0) { v2u w; w.x = pk2(y0, y1); w.y = pk2(y2, y3); stash[mt * 4 + g] = w; }
                else { unsigned* yo = (unsigned*)(YH + ((size_t)b * S + t1 * 64 + t0) * C + (c - 1)); const v2u kp = kpv[mt][g];
                    yo[0] = (kp.x & 0xffffu) | (f2bf(y0) << 16); yo[C / 2] = (kp.x >> 16) | (f2bf(y1) << 16); yo[C] = (kp.y & 0xffffu) | (f2bf(y2) << 16); yo[3 * C / 2] = (kp.y >> 16) | (f2bf(y3) << 16); } }
    }
    __syncthreads();
}
#undef HY_LDA
#undef HY_LOAD_E
#undef HY_LOAD_L
#undef HY_MMA1
#undef HY_MMA2
}
}
namespace mk {
#define GAS __attribute__((address_space(1)))
typedef GAS unsigned gu32;
typedef GAS unsigned long long gu64;
#define RLX_AGENT __ATOMIC_RELAXED, __HIP_MEMORY_SCOPE_AGENT
#define LDS_WAIT() asm volatile("s_waitcnt lgkmcnt(0)" ::: "memory")
#define VM_WAIT() asm volatile("s_waitcnt vmcnt(0)" ::: "memory")
__device__ __forceinline__ unsigned long long rt() { return __builtin_amdgcn_s_memrealtime(); }
#define XB_TMO      128
#define XB_XCNT(j)  (256  + 64 * (j))
#define XB_XSUB(j)  (1280 + 64 * (j))
#define XB_XGEN(j)  (2304 + 64 * (j))
#define XB_TOP      3328
#define XB_TOPGEN   3392
#define XCD_BAR_WORDS 3456
#define XB_SPIN_CAP (1u << 18)

__device__ __forceinline__ unsigned xb_ld(unsigned* p)              { return __hip_atomic_load(p, __ATOMIC_RELAXED, __HIP_MEMORY_SCOPE_AGENT); }
__device__ __forceinline__ unsigned xb_add(unsigned* p, unsigned v) { return __hip_atomic_fetch_add(p, v, __ATOMIC_RELAXED, __HIP_MEMORY_SCOPE_AGENT); }
__device__ __forceinline__ unsigned xb_xcc_id() { return (unsigned)__builtin_amdgcn_s_getreg((3 << 11) | 20) & 0xFu; }
#define XB_SPIN(cond, bar) do { unsigned _sp = 0; while (cond) { __builtin_amdgcn_s_sleep(1); \
    if ((++_sp & 255u) == 0u) { if (xb_ld(&(bar)[XB_TMO])) break; if (_sp > XB_SPIN_CAP) { atomicAdd(&(bar)[XB_TMO], 1u); break; } } } } while (0)

struct XcdBarrier {
    unsigned* bar; unsigned x;
    volatile LAS unsigned* st;
};

__device__ __forceinline__ XcdBarrier xcd_barrier_post(unsigned* bar, volatile LAS unsigned* st) {
    XcdBarrier b; b.bar = bar; b.x = xb_xcc_id(); b.st = st;
    if (threadIdx.x == 0) (void)xb_add(&bar[XB_XCNT(b.x)], 1u);
    return b;
}
__device__ __forceinline__ void xcd_barrier_complete(unsigned* bar, unsigned x, unsigned& nloc, unsigned& nx) {
    const unsigned G = gridDim.x * gridDim.y * gridDim.z;
    unsigned sum, cnt, mine, sp = 0u;
    for (;;) {
        sum = 0u; cnt = 0u; mine = 0u;
#pragma unroll
        for (unsigned j = 0; j < 16; ++j) { const unsigned c = xb_ld(&bar[XB_XCNT(j)]); sum += c; cnt += (c > 0u) ? 1u : 0u; mine = (j == x) ? c : mine; }
        if (sum == G) break;
        __builtin_amdgcn_s_sleep(1);
        if ((++sp & 255u) == 0u) { if (xb_ld(&bar[XB_TMO])) break; if (sp > XB_SPIN_CAP) { atomicAdd(&bar[XB_TMO], 1u); break; } }
    }
    nloc = mine > 0u ? mine : 1u; nx = cnt > 0u ? cnt : 1u;
}

__device__ __forceinline__ void xcd_barrier(const XcdBarrier& b, int wave_s) {
    asm volatile("s_waitcnt vmcnt(0)" ::: "memory");
    __syncthreads();
    if (fresh_tid(wave_s) == 0) {
        unsigned* bar = b.bar;
        __builtin_amdgcn_s_waitcnt(0);
        unsigned nloc = b.st[0], nx = b.st[1];
        if (nloc == 0u) { xcd_barrier_complete(bar, b.x, nloc, nx); b.st[0] = nloc; b.st[1] = nx; }
        const unsigned old = xb_add(&bar[XB_XSUB(b.x)], 1u);
        const unsigned gen = old / nloc;
        if (old + 1u == (gen + 1u) * nloc) {
            __builtin_amdgcn_fence(__ATOMIC_RELEASE, "agent");
            asm volatile("s_waitcnt vmcnt(0)" ::: "memory");
            const unsigned og = xb_add(&bar[XB_TOP], 1u);
            const unsigned tg = og / nx;
            if (og + 1u == (tg + 1u) * nx) xb_add(&bar[XB_TOPGEN], 1u);
            else XB_SPIN(xb_ld(&bar[XB_TOPGEN]) == tg, bar);
            __builtin_amdgcn_fence(__ATOMIC_ACQUIRE, "agent");
            xb_add(&bar[XB_XGEN(b.x)], 1u);
            asm volatile("s_waitcnt vmcnt(0)" ::: "memory");
        } else {
            XB_SPIN(xb_ld(&bar[XB_XGEN(b.x)]) == gen, bar);
            __builtin_amdgcn_fence(__ATOMIC_ACQUIRE, "agent");
            asm volatile("s_waitcnt vmcnt(0)" ::: "memory");
        }
    }
    __syncthreads();
}

}
namespace mk {
namespace cg = cooperative_groups;
constexpr int PH_PER_LAYER = 9, N_PHASES = 1 + 2 * PH_PER_LAYER;

__device__ __forceinline__ float lam_of(const Args& a, int l, float lam_init) {
    const float *q1 = a.in[14] + l * 64, *k1 = a.in[15] + l * 64, *q2 = a.in[16] + l * 64, *k2 = a.in[17] + l * 64;
    float s1 = 0.f, s2 = 0.f; for (int i = 0; i < 64; ++i) { s1 += q1[i] * k1[i]; s2 += q2[i] * k2[i]; }
    return expf(s1) - expf(s2) + lam_init;
}

typedef const __attribute__((address_space(4))) Args* KArgPtr;
__global__ void __launch_bounds__(NTH, 2) fwd(Args a_byval) {
    extern __shared__ __attribute__((aligned(16))) unsigned char lds_raw[];
    cg::grid_group grid = cg::this_grid();
    const int ph_lo = a_byval.ph_lo, ph_hi = a_byval.ph_hi;
    const int wave_s = __builtin_amdgcn_readfirstlane((int)threadIdx.x >> 6);
    volatile LAS unsigned* bar_st = (volatile LAS unsigned*)((LAS unsigned char*)lds_raw + LDS_BYTES - 64);
    if (threadIdx.x == 0) { bar_st[0] = 0u; bar_st[1] = 0u; }
    __syncthreads();
    const XcdBarrier bar = xcd_barrier_post((unsigned*)a_byval.ws, bar_st);
    int rep_flag = 0;
    for (int ph = ph_lo; ph < ph_hi; ++ph) {
        KArgPtr ap = (KArgPtr)__builtin_amdgcn_kernarg_segment_ptr(); asm volatile("" : "+s"(ap));
        const Args a = *(const Args*)ap;
        float* Xr = (float*)(a.ws + WS_X);
        Ctx X; X.wave_s = wave_s; X.wave = wave_s; X.tid = 0; X.lane = 0;
#define FRESH() do { X.tid = fresh_tid(wave_s); X.lane = X.tid & 63; } while (0)
        { int g_ = gridDim.x, b_ = blockIdx.x; asm volatile("" : "+s"(g_), "+s"(b_)); X.G = g_; X.bid = b_; }
        { const int bx = X.bid; X.vcu = (X.G % 8 == 0) ? (bx % 8) * (X.G / 8) + bx / 8 : bx; }
        X.gw = X.vcu * NWAVES + X.wave; X.ngw = X.G * NWAVES; X.lds = (LAS unsigned char*)lds_raw; X.ws = a.ws;
#ifndef MK_EN
#define MK_EN 0xFFFF
#endif
#ifndef MK_ATT
#define MK_ATT 3
#endif
#ifndef MK_REP_SP
#define MK_REP_SP 99
#endif
        if (ph == 0) { if (MK_EN & 512) { FRESH(); p0_prologue(X, a); } }
        else {
            const int l = (ph - 1) / PH_PER_LAYER, sp = (ph - 1) % PH_PER_LAYER;
            const float lam_init = 0.8f - 0.6f * expf(-0.3f * (float)l);
            if (0) {}
#if MK_EN & 1
            else if (sp == 0) {
                FRESH();
                pg8::Gemm g{(const bf16*)(a.ws + WS_XN), (const bf16*)(a.ws + WS_WIN) + (size_t)l * INW * D, T, INW, D};
                pg8::StaticOrder So; So.init(T, INW, X.G, X.bid);
                EpiWin Ep{a.ws, (const float*)(a.ws + WS_BINP) + l * INW, (const float*)(a.ws + WS_ROPE)};
                pg8::gemm_phase<EpiWin, pg8::StaticOrder, true, true>(X.lds, g, So, Ep, X.tid);
            }
#endif
#if MK_EN & 2
            else if (sp == 1) {
                FRESH();
                p1t_shortconv(X, a.in[4] + l * 3 * 1536, a.in[5] + l * 1536);
                p1t_kmax(X, (unsigned*)(a.ws + 14336) + l * 32);
            }
#endif
#if MK_EN & 4
            else if (sp == 2) {
                FRESH();
                const float lam = lam_of(a, l, lam_init);
                const int c = X.bid;
#ifndef MK_REP_ATT
#define MK_REP_ATT 1
#endif
#ifndef MK_CONV_REP
#define MK_CONV_REP 1
#endif
#ifndef MK_REP_HY
#define MK_REP_HY 1
#endif
#ifndef CV_ME_SWEEP
#define CV_ME_SWEEP 32
#endif
                const int cg_ = X.vcu & 3;
                if (cg_ == 0) { __syncthreads(); p0_experts_rest(relaunder(X), a, l, CV_ME_SWEEP); __syncthreads(); }
                for (int rep = 0; rep < MK_REP_ATT; ++rep) for (int u = c; u < 256; u += X.G) { const int bh = 2 * (u & 7) + ((u >> 3) >> 4), qb = (u >> 3) & 15; at::attn_unit(X, bh >> 2, bh & 3, qb, lam, 1.0f - lam_init, a.in[18] + l * 128, (unsigned*)(a.ws + 14336) + l * 32); }
                if (cg_ == 1) { __syncthreads(); p0_experts_rest(relaunder(X), a, l, CV_ME_SWEEP); __syncthreads(); }
                hy::CvState cs; const float* cwg = a.in[25] + (size_t)l * E * D * F; const float* cwu = a.in[26] + (size_t)l * E * D * F; const float* cwd = a.in[27] + (size_t)l * E * D * F; const float* cgn = a.in[22] + l * D;
                bf16* ctgu = (bf16*)(a.ws + WS_WGU) + (size_t)l * E * 2 * F * D; bf16* ctd = (bf16*)(a.ws + WS_WD) + (size_t)l * E * F * D;
                cs.next = __builtin_amdgcn_readfirstlane(X.bid * NWAVES + wave_s); cs.stride = __builtin_amdgcn_readfirstlane(X.G * NWAVES); cs.nlim = CV_ME_SWEEP * 2048; cs.cnt = 0; cs.par = 0;
                cs.a.have = cs.b.have = -1; cs.a.ld0 = cs.a.ld1 = cs.a.ld2 = cs.a.ld3 = cs.b.ld0 = cs.b.ld1 = cs.b.ld2 = cs.b.ld3 = f32x4{0.f, 0.f, 0.f, 0.f}; cs.a.sc = cs.b.sc = 1.f;
                hy::cv_issue(cs, cs.a, fresh_tid(wave_s) & 63, CV_PARGS); hy::cv_issue(cs, cs.b, fresh_tid(wave_s) & 63, CV_PARGS);
                for (int rep = 0; rep < MK_REP_HY; ++rep) for (int u = c; u < 256; u += X.G) { const int ch = 64 * (u & 7) + 2 * (u >> 3); hy::channel<0>(relaunder(X), l, ch, a.in[13], cs, CV_PARGS);
                    if (cg_ == 2) { __syncthreads(); p0_experts_rest(relaunder(X), a, l, CV_ME_SWEEP); __syncthreads(); }
                    hy::channel<1>(relaunder(X), l, ch + 1, a.in[13], cs, CV_PARGS); }
                while (cs.a.have >= 0 || cs.b.have >= 0) hy::cv_finish(cs, fresh_tid(wave_s) & 63, CV_PARGS);
                if (cg_ == 3) { __syncthreads(); p0_experts_rest(relaunder(X), a, l, CV_ME_SWEEP); __syncthreads(); }
            }
#endif
#if MK_EN & 8
            else if (sp == 3) {
                FRESH();
                OrderMerge So; So.so.init(T, D, X.G, X.bid);
                pg8::Gemm g{(const bf16*)(a.ws + WS_YH), (const bf16*)(a.ws + WS_WUH) + (size_t)l * 2 * D * C, 2 * T, 2 * D, C};
                EpiMerge2 Ep{(const bf16*)(a.ws + WS_GH), (const bf16*)(a.ws + WS_GA), (bf16*)(a.ws + WS_T1), (bf16*)(a.ws + WS_MG)};
                pg8::gemm_phase<EpiMerge2, OrderMerge, true, true>(X.lds, g, So, Ep, X.tid);
            }
#endif
#if MK_EN & 16
            else if (sp == 4) {
                FRESH();
                pg8::Gemm g{(const bf16*)(a.ws + WS_MG), (const bf16*)(a.ws + WS_WOUT) + (size_t)l * D * D, T, D, D};
                pg8::StaticOrder So; So.init(T, D, X.G, X.bid);
                EpiOutR Ep{l == 0 ? a.in[0] : Xr, Xr, (bf16*)(a.ws + WS_XN), (float*)(a.ws + WS_PART), (const bf16*)(a.ws + WS_WRP) + (size_t)l * 2 * E * D, (unsigned*)(a.ws + 15360) + l * 64, (float*)(a.ws + WS_AFFT), (float*)(a.ws + WS_RTOK), a.in[24] + l * E};
                pg8::gemm_phase<EpiOutR, pg8::StaticOrder, true, true>(X.lds, g, So, Ep, X.tid);
            }
#endif
#if MK_EN & 32
            else if (sp == 5) { FRESH(); p6_topk(X);
            }
#endif
#if MK_EN & 64
            else if (sp == 6) {
                FRESH();
                pg8::Gemm g{(const bf16*)(a.ws + WS_XN), (const bf16*)(a.ws + WS_WGU) + (size_t)l * E * 2 * F * D, E * 2048, 2 * F, D, 2 * F, 4, (size_t)2 * F * D * 2, (const int*)(a.ws + WS_ROWS)};
                OrderMoE1 So{X.G, X.bid}; EpiSwiGLU Ep{(bf16*)(a.ws + WS_HB), (const float*)(a.ws + WS_RSL)};
                pg8::gemm_phase<EpiSwiGLU, OrderMoE1, true, true, true, true>(X.lds, g, So, Ep, X.tid);
            }
#endif
#if MK_EN & 128
            else if (sp == 7) {
                FRESH();
                pg8::Gemm g{(const bf16*)(a.ws + WS_HB), (const bf16*)(a.ws + WS_WD) + (size_t)l * E * D * F, E * 2048, D, F, D, 2, (size_t)D * F * 2};
                OrderMoE2 So{X.G, X.bid}; EpiDown Ep{(bf16*)(a.ws + WS_YE), (const float*)(a.ws + WS_GATE)};
                pg8::gemm_phase<EpiDown, OrderMoE2, true, true, true>(X.lds, g, So, Ep, X.tid);
            }
#endif
#if MK_EN & 256
            else if (sp == 8) {
                FRESH();
                p9_combine(X, Xr, l == 0 ? a.in[1] + D : a.in[28], l == 1, a.out);
            }
#endif
        }
#ifndef MK_EXTRA_SYNC
#define MK_EXTRA_SYNC 0
#endif
        if (ph + 1 < ph_hi) { if (ph_hi > 4096) grid.sync(); else xcd_barrier(bar, wave_s); }
        for (int es = 0; es < MK_EXTRA_SYNC; ++es) xcd_barrier(bar, wave_s);
        if (MK_REP_SP != 99) { const int sp_ = ph == 0 ? -1 : (ph - 1) % PH_PER_LAYER; if (sp_ == MK_REP_SP && rep_flag == 0) { rep_flag = 1; --ph; } else rep_flag = 0; }
    }
}

static int g_grid = 0;
static bool mega_setup() {
    if (g_grid) return g_grid > 0;
    int dev = 0, cus = 0, per_cu = 0;
    if (hipGetDevice(&dev) != hipSuccess || hipDeviceGetAttribute(&cus, hipDeviceAttributeMultiprocessorCount, dev) != hipSuccess) { g_grid = -1; return false; }
    if (hipFuncSetAttribute((const void*)fwd, hipFuncAttributeMaxDynamicSharedMemorySize, LDS_BYTES) != hipSuccess) { fprintf(stderr, "hipFuncSetAttribute failed\n"); g_grid = -1; return false; }
    if (hipOccupancyMaxActiveBlocksPerMultiprocessor(&per_cu, (const void*)fwd, NTH, LDS_BYTES) != hipSuccess || per_cu < 1) { fprintf(stderr, "occupancy query failed (%d)\n", per_cu); g_grid = -1; return false; }
    g_grid = cus * 1;
    return true;
}
static void mega_launch(hipStream_t st, void* const* d_in, float* d_out, unsigned char* ws, int ph_lo, int ph_hi, int p0_mask) {
    if (!mega_setup()) return;
    Args a{};
    for (int i = 0; i < 29; ++i) a.in[i] = (const float*)d_in[i];
    a.out = d_out; a.ws = ws; a.ph_lo = ph_lo; a.ph_hi = ph_hi; a.p0_mask = p0_mask; a.pad = 0;
    if (hipMemsetAsync(ws, 0, 16384, st) != hipSuccess) { fprintf(stderr, "memset of the barrier words failed\n"); return; }
    void* args[] = {&a};
    const hipError_t e = hipLaunchCooperativeKernel((const void*)fwd, dim3(g_grid), dim3(NTH), args, LDS_BYTES, st);
    if (e != hipSuccess) fprintf(stderr, "cooperative launch failed: %s (grid %d)\n", hipGetErrorString(e), g_grid);
}
}
extern "C" void kernel_launch(void* const* d_in, const int* in_sizes, int n_in, void* d_out, int out_size, void* d_ws, size_t ws_size, hipStream_t stream) {
    if (n_in != 29 || out_size != mk::T * mk::D || ws_size < mk::WS_END) { fprintf(stderr, "kernel_launch: unexpected sizes n_in %d out %d ws %zu\n", n_in, out_size, ws_size); return; }
    mk::mega_launch(stream, d_in, (float*)d_out, (unsigned char*)d_ws, 0, mk::N_PHASES, 13);
}
```

```cpp
#include <hip/hip_runtime.h>
#include <hip/hip_cooperative_groups.h>
#include <cstdio>
#include <cstdint>
#include <cmath>
namespace tk {
constexpr int S = 4096, E = 16, CAP = 512, NT = 512;
__device__ __forceinline__ void topk_problem(const unsigned (&key)[8], const float (&rr)[8], int tokbase, int e, int slotbase, int* __restrict__ rows, float* __restrict__ gate, float* __restrict__ rsl, int* __restrict__ inv, int* sm, int tid) {
    const int lane = tid & 63, wid = tid >> 6;
    int* hist = sm; int* ctl = sm + 256;
    unsigned prefix = 0u, mask = 0u; int kth = CAP;
    for (int pass = 3; pass >= 0; --pass) {
        __syncthreads();
        if (tid < 256) hist[tid] = 0;
        __syncthreads();
#pragma unroll
        for (int i = 0; i < 8; ++i) if ((key[i] & mask) == prefix) atomicAdd(&hist[(key[i] >> (8 * pass)) & 255u], 1);
        __syncthreads();
        if (tid < 64) {
            const int b0 = hist[4 * lane], b1 = hist[4 * lane + 1], b2 = hist[4 * lane + 2], b3 = hist[4 * lane + 3];
            const int tot = b0 + b1 + b2 + b3;
            int suf = tot;
#pragma unroll
            for (int o = 1; o < 64; o <<= 1) { const int v = __builtin_amdgcn_ds_bpermute(((lane + o) & 63) << 2, suf); if (lane + o < 64) suf += v; }
            const int above = suf - tot;
            if (above < kth && kth <= above + tot) {
                int cum = above, bin, k2;
                if (cum + b3 >= kth) { bin = 4 * lane + 3; k2 = kth - cum; }
                else { cum += b3; if (cum + b2 >= kth) { bin = 4 * lane + 2; k2 = kth - cum; }
                else { cum += b2; if (cum + b1 >= kth) { bin = 4 * lane + 1; k2 = kth - cum; }
                else { cum += b1; bin = 4 * lane; k2 = kth - cum; } } }
                ctl[0] = bin; ctl[1] = k2;
            }
        }
        __syncthreads();
        prefix |= ((unsigned)ctl[0]) << (8 * pass); mask |= 0xFFu << (8 * pass); kth = ctl[1];
    }
    const unsigned thr = prefix; const int need_eq = kth; const int n_gt = CAP - need_eq;
    int cg = 0, ce = 0;
#pragma unroll
    for (int i = 0; i < 8; ++i) { cg += key[i] > thr; ce += key[i] == thr; }
    int sg = cg, se = ce;
#pragma unroll
    for (int o = 1; o < 64; o <<= 1) { const int a = __builtin_amdgcn_ds_bpermute(((lane - o) & 63) << 2, sg), b = __builtin_amdgcn_ds_bpermute(((lane - o) & 63) << 2, se); if (lane >= o) { sg += a; se += b; } }
    __syncthreads();
    if (lane == 63) { ctl[8 + wid] = sg; ctl[16 + wid] = se; }
    __syncthreads();
    int og = sg - cg, oe = se - ce;
    for (int w = 0; w < wid; ++w) { og += ctl[8 + w]; oe += ctl[16 + w]; }
#pragma unroll
    for (int i = 0; i < 8; ++i) {
        const int idx = tid * 8 + i; int slot = -1;
        if (key[i] > thr) slot = og++;
        else if (key[i] == thr) { if (oe < need_eq) slot = n_gt + oe; ++oe; }
        if (slot >= 0) { rows[slot] = tokbase + idx; gate[slot] = __uint_as_float(key[i]); rsl[slot] = rr[i]; }
        inv[(size_t)(tokbase + idx) * E + e] = slot >= 0 ? slotbase + slot : -1;
    }
    __syncthreads();
}
}
namespace pg8 {
#define PG8_LAS __attribute__((address_space(3)))
typedef unsigned short bf16_t;
typedef short bf16x8 __attribute__((ext_vector_type(8)));
typedef float f32x4 __attribute__((ext_vector_type(4)));
typedef unsigned u32x4 __attribute__((ext_vector_type(4)));
typedef short s16x4 __attribute__((ext_vector_type(4)));
constexpr int BM = 256, BK = 64, HALF = 128, HTB = HALF * BK * 2  , STAGE_BYTES = 8 * HTB, NXCD = 8, WGM = 8;

__host__ __device__ __forceinline__ int lds_byte(int r, int c) { const int st = (r >> 4) * 2 + (c >> 5), rr = r & 15, cc = c & 31, ob = rr * 64 + cc * 2; return st * 1024 + (ob ^ (((ob >> 9) & 1) << 5)); }
__host__ __device__ __forceinline__ void stage_rc(int b, int& R, int& C) { const int st = b / 1024, sb = b % 1024, swz = sb ^ (((sb >> 9) & 1) << 5); R = (st >> 1) * 16 + swz / 64; C = (st & 1) * 32 + (swz % 64) / 2; }
__host__ __device__ __forceinline__ int perm32(int rho) { const int n = rho >> 4, i = rho & 15; return 8 * (i >> 2) + 4 * n + (i & 3); }

struct Unit { int pm, pn, pb, pa; };
struct Gemm { const bf16_t* A; const bf16_t* Bt; int M, N, K; int bN = 0, bsh = 0; size_t bes = 0; const int* arows = nullptr; };

struct StaticOrder {
    int nM, nN, nwg, G, c;
    __host__ __device__ void init(int M, int N, int G_, int c_) { nM = M / BM; nN = N / BM; nwg = nM * nN; G = G_; c = c_; }
    __host__ __device__ bool next(int i, Unit& u) const {
        const long L = (long)i * G + c; if (L >= nwg) return false;
        int wgid = (int)L; { const int q = nwg / NXCD, r = nwg % NXCD, xcd = wgid % NXCD, off = wgid / NXCD; wgid = (xcd < r ? xcd * (q + 1) : r * (q + 1) + (xcd - r) * q) + off; }
        const int nig = WGM * nN, gid = wgid / nig, fm = gid * WGM, gsz = (nM - fm) < WGM ? (nM - fm) : WGM;
        u.pm = fm + ((wgid % nig) % gsz); u.pn = (wgid % nig) / gsz; u.pb = u.pn; u.pa = u.pm; return true;
    }
    __device__ __forceinline__ void a_ready(const Unit&) const {}
    __device__ __forceinline__ void done(const Unit&) const {}
};

template <class Epi, class Sched, bool ALIGN_EPI = false, bool SP2 = false, bool BT = false, bool GA = false>
__device__ __forceinline__ void gemm_phase(PG8_LAS unsigned char* lds, const Gemm g, const Sched& S, const Epi& E, int tid) {
    asm volatile("" : "+v"(tid));
    const int wid = __builtin_amdgcn_readfirstlane(tid >> 6), lane = tid & 63, wr = wid >> 2, wc = wid & 3, fr = lane & 15, fq = lane >> 4;
    const int K = g.K, nt = K / BK;
    unsigned voffA[2], voffB[2];
#pragma unroll
    for (int i = 0; i < 2; ++i) { int R, C; stage_rc(tid * 16 + i * 8192, R, C); const int Rb = Epi::PERM ? ((R & ~31) + perm32(R & 31)) : R;
        voffA[i] = (unsigned)(R * K + C) * 2u; voffB[i] = (unsigned)(Rb * K + C) * 2u; if constexpr (GA) voffA[i] = (unsigned)C * 2u;
        if constexpr (BT) { const int p = i * 512 + tid, row = ((p >> 7) << 3) | ((p >> 2) & 7), ch = (((p >> 5) & 3) << 2) | ((p & 3) ^ ((row >> 2) & 3));
            voffB[i] = (unsigned)(row * g.bN + 8 * ch) * 2u; } }
    const size_t kstep = (size_t)(BK * 2);
    const size_t hstep = (size_t)HALF * K * 2;
    const size_t tstep = 2 * hstep;
    const size_t kstepB = BT ? (size_t)BK * g.bN * 2 : kstep, hstepB = BT ? (size_t)HALF * 2 : hstep;
    const size_t hstepA = GA ? 0 : hstep;
    unsigned curA[2][2] = {{0u, 0u}, {0u, 0u}};
    PG8_LAS int* rowtab0 = (PG8_LAS int*)(lds + STAGE_BYTES);
#define PG8_ROWTAB (rowtab0 + ((ui + 1) & 1) * 512)
#define PG8_NXTOFF(o_, h) do { int t_ = tid; asm volatile("" : "+v"(t_)); _Pragma("unroll") for (int i_ = 0; i_ < 2; ++i_) { int R_, C_; stage_rc(t_ * 16 + i_ * 8192, R_, C_); \
        o_[i_] = (unsigned)PG8_ROWTAB[(h) * 128 + R_] * (unsigned)(K * 2) + (unsigned)C_ * 2u; } } while (0)
#define PG8_STAGE_A(bufoff, kbase, h, nx) do { if constexpr (GA) { if (nx) { unsigned o_[2]; PG8_NXTOFF(o_, h); PG8_STAGE(bufoff, kbase, o_); } else PG8_STAGE(bufoff, kbase, curA[h]); } \
        else PG8_STAGE(bufoff, (kbase) + ((h) ? hstep : 0), voffA); } while (0)
#define PG8_BBASE(pb) ((const char*)g.Bt + (BT ? (size_t)((pb) >> g.bsh) * g.bes + (size_t)((pb) & ((1 << g.bsh) - 1)) * 512 : (size_t)(pb) * tstep))
    const unsigned ldsw = (unsigned)wid * 1024u;
    const int aoff = lds_byte(wr * 64 + fr, fq * 8), boff = lds_byte(wc * 32 + fr, fq * 8);
    int tr0 = 0, tr1 = 0;
    if constexpr (BT) { static_assert(Epi::PERM, "BT needs the PERM column order"); const int q_ = (lane >> 2) & 3, p_ = lane & 3, f1_ = fq & 1;
        const int L_ = (int)(size_t)lds + 2048 * fq + 512 * wc + 64 * q_ + 32 * ((p_ >> 1) ^ f1_); tr0 = L_ + 16 * (p_ & 1); tr1 = L_ + 256 + 16 * (1 - (p_ & 1)); }
#define PG8_SA(b, h) (((b) * 2 + (h)) * HTB)
#define PG8_SB(b, h) ((4 + (b) * 2 + (h)) * HTB)
#define PG8_STAGE(bufoff, gbase, voff) do { _Pragma("unroll") for (int _i = 0; _i < 2; ++_i) \
        __builtin_amdgcn_global_load_lds((const unsigned*)((const char*)(gbase) + (voff)[_i]), (PG8_LAS unsigned*)(lds + (bufoff) + ldsw + _i * 8192), 16, 0, 0); } while (0)
#define PG8_LDA(dst, b, h) do { _Pragma("unroll") for (int m = 0; m < 4; ++m) _Pragma("unroll") for (int k = 0; k < 2; ++k) dst[m][k] = *(const PG8_LAS bf16x8*)(lds + PG8_SA(b, h) + aoff + m * 2048 + k * 1024); } while (0)
#define PG8_TR(dst4, addr, OFF) asm volatile("ds_read_b64_tr_b16 %0, %1 offset:%2" : "=&v"(dst4) : "v"(addr), "i"(OFF) : "memory")
#define PG8_TRF(dst8, a0, a1, OFF) do { s16x4 lo_, hi_; PG8_TR(lo_, a0, OFF); PG8_TR(hi_, a1, OFF); dst8 = __builtin_shufflevector(lo_, hi_, 0, 1, 2, 3, 4, 5, 6, 7); } while (0)
#define PG8_LDB(dst, b, h) do { if constexpr (BT) { const int a0_ = tr0 + PG8_SB(b, h), a1_ = tr1 + PG8_SB(b, h); \
        PG8_TRF(dst[0][0], a0_, a1_, 0); PG8_TRF(dst[0][1], a0_, a1_, 8192); PG8_TRF(dst[1][0], a0_, a1_, 8); PG8_TRF(dst[1][1], a0_, a1_, 8200); } else { \
    _Pragma("unroll") for (int n = 0; n < 2; ++n) _Pragma("unroll") for (int k = 0; k < 2; ++k) dst[n][k] = *(const PG8_LAS bf16x8*)(lds + PG8_SB(b, h) + boff + n * 2048 + k * 1024); } } while (0)
#define PG8_MMA(ai, bj, At, Bt) do { __builtin_amdgcn_s_setprio(1); _Pragma("unroll") for (int m = 0; m < 4; ++m) _Pragma("unroll") for (int n = 0; n < 2; ++n) _Pragma("unroll") for (int k = 0; k < 2; ++k) \
        acc[ai][bj][m][n] = __builtin_amdgcn_mfma_f32_16x16x32_bf16(Bt[n][k], At[m][k], acc[ai][bj][m][n], 0, 0, 0); __builtin_amdgcn_s_setprio(0); } while (0)
#define PG8_WAIT_V(n) asm volatile("s_waitcnt vmcnt(" #n ")" ::: "memory")
#define PG8_WAIT_L(n) asm volatile("s_waitcnt lgkmcnt(" #n ")" ::: "memory")
#define PG8_BAR __builtin_amdgcn_s_barrier()
#define PG8_SCHED __builtin_amdgcn_sched_barrier(0)
    Unit cur, nxt; int ui = 0;
    if (!S.next(0, cur)) return;
    f32x4 acc[2][2][4][2];
#pragma unroll
    for (int a = 0; a < 2; ++a)
#pragma unroll
        for (int b = 0; b < 2; ++b)
#pragma unroll
            for (int m = 0; m < 4; ++m)
#pragma unroll
                for (int n = 0; n < 2; ++n) acc[a][b][m][n] = (f32x4){0.f, 0.f, 0.f, 0.f};
    bf16x8 At[4][2], B0[2][2], B1[2][2];
    const char* cA = (const char*)g.A + (GA ? 0 : (size_t)cur.pa * tstep); const char* cB = PG8_BBASE(cur.pb);
    if constexpr (GA) {
#pragma unroll
        for (int h = 0; h < 2; ++h)
#pragma unroll
            for (int i = 0; i < 2; ++i) { int R, C; stage_rc(tid * 16 + i * 8192, R, C);
                curA[h][i] = (unsigned)__hip_atomic_load(g.arows + cur.pa * 256 + h * 128 + R, __ATOMIC_RELAXED, __HIP_MEMORY_SCOPE_AGENT) * (unsigned)(K * 2) + (unsigned)C * 2u; } }
    S.a_ready(cur);
    if constexpr (SP2) {
        PG8_STAGE(PG8_SB(0, 0), cB, voffB); PG8_STAGE(PG8_SB(0, 1), cB + hstepB, voffB); PG8_STAGE_A(PG8_SA(0, 0), cA, 0, false); PG8_STAGE_A(PG8_SA(0, 1), cA, 1, false);
        if (wr == 1) PG8_BAR;
        PG8_WAIT_V(2); PG8_BAR;
        PG8_STAGE(PG8_SB(1, 0), cB + kstepB, voffB); PG8_STAGE_A(PG8_SA(1, 0), cA + kstep, 0, false); PG8_STAGE(PG8_SB(1, 1), cB + hstepB + kstepB, voffB);
        PG8_WAIT_V(6); PG8_BAR;
    } else {
        PG8_STAGE(PG8_SB(0, 0), cB, voffB); PG8_STAGE_A(PG8_SA(0, 0), cA, 0, false); PG8_STAGE(PG8_SB(0, 1), cB + hstepB, voffB); PG8_STAGE_A(PG8_SA(0, 1), cA, 1, false);
        if (wr == 1) PG8_BAR;
        PG8_WAIT_V(4); PG8_BAR;
        PG8_STAGE(PG8_SB(1, 0), cB + kstepB, voffB); PG8_STAGE_A(PG8_SA(1, 0), cA + kstep, 0, false); PG8_STAGE(PG8_SB(1, 1), cB + hstepB + kstepB, voffB);
        PG8_WAIT_V(6); PG8_BAR;
    }
    for (;;) {
        const bool has_next = S.next(ui + 1, nxt);
        const char* nA = (has_next && !GA) ? (const char*)g.A + (size_t)nxt.pa * tstep : cA; const char* nB = has_next ? PG8_BBASE(nxt.pb) : cB;
        for (int t = 0; t < nt; t += 2) {
            const bool last = (t == nt - 2);
            const char* a1 = cA + (size_t)(t + 1) * kstep;
            const char* a2 = last ? nA : cA + (size_t)(t + 2) * kstep; const char* b2 = last ? nB : cB + (size_t)(t + 2) * kstepB;
            const char* a3 = a2 + kstep; const char* b3 = b2 + kstepB;
            if (last && has_next) S.a_ready(nxt);
            const bool nx = GA && last && has_next;
            if constexpr (GA) {
                if (t == 0 && has_next) { int l_ = lane; asm volatile("" : "+v"(l_)); __builtin_amdgcn_global_load_lds((const unsigned*)(g.arows + nxt.pa * 256 + (wid & 3) * 64 + l_), (PG8_LAS unsigned*)(PG8_ROWTAB + wid * 64), 4, 0, 0); }
            }
            if constexpr (SP2) {
            PG8_LDB(B0, 0, 0); PG8_LDB(B1, 0, 1); PG8_SCHED; PG8_LDA(At, 0, 0); PG8_STAGE_A(PG8_SA(1, 1), a1, 1, false);
            PG8_WAIT_V(8); PG8_WAIT_L(0); PG8_BAR; PG8_MMA(0, 0, At, B0); PG8_MMA(0, 1, At, B1); PG8_BAR; PG8_SCHED;
            PG8_LDA(At, 0, 1); PG8_STAGE(PG8_SB(0, 0), b2, voffB); PG8_STAGE(PG8_SB(0, 1), b2 + hstepB, voffB); PG8_STAGE_A(PG8_SA(0, 0), a2, 0, nx);
            PG8_WAIT_V(8); PG8_WAIT_L(0); PG8_BAR; PG8_MMA(1, 0, At, B0); PG8_MMA(1, 1, At, B1); PG8_BAR; PG8_SCHED;
            PG8_LDB(B0, 1, 0); PG8_LDB(B1, 1, 1); PG8_SCHED; PG8_LDA(At, 1, 0); PG8_STAGE_A(PG8_SA(0, 1), a2, 1, nx);
            PG8_WAIT_V(8); PG8_WAIT_L(0); PG8_BAR; PG8_MMA(0, 0, At, B0); PG8_MMA(0, 1, At, B1); PG8_BAR; PG8_SCHED;
            PG8_LDA(At, 1, 1); PG8_STAGE(PG8_SB(1, 0), b3, voffB); PG8_STAGE(PG8_SB(1, 1), b3 + hstepB, voffB); PG8_STAGE_A(PG8_SA(1, 0), a3, 0, nx);
            PG8_WAIT_V(8); PG8_WAIT_L(0); PG8_BAR; PG8_MMA(1, 0, At, B0); PG8_MMA(1, 1, At, B1); PG8_BAR; PG8_SCHED;
            } else {
            PG8_LDB(B0, 0, 0); PG8_SCHED; PG8_LDA(At, 0, 0); PG8_STAGE_A(PG8_SA(1, 1), a1, 1, false);
            PG8_WAIT_L(8); PG8_BAR; PG8_WAIT_L(0); PG8_MMA(0, 0, At, B0); PG8_BAR; PG8_SCHED;
            PG8_LDB(B1, 0, 1); PG8_STAGE(PG8_SB(0, 0), b2, voffB);
            PG8_BAR; PG8_WAIT_L(0); PG8_MMA(0, 1, At, B1); PG8_BAR;
            PG8_LDA(At, 0, 1); PG8_STAGE_A(PG8_SA(0, 0), a2, 0, nx);
            PG8_BAR; PG8_WAIT_L(0); PG8_MMA(1, 0, At, B0); PG8_BAR; PG8_SCHED;
            PG8_STAGE(PG8_SB(0, 1), b2 + hstepB, voffB);
            PG8_WAIT_V(6); PG8_BAR; PG8_MMA(1, 1, At, B1); PG8_BAR;
            PG8_LDB(B0, 1, 0); PG8_SCHED; PG8_LDA(At, 1, 0); PG8_STAGE_A(PG8_SA(0, 1), a2, 1, nx);
            PG8_WAIT_L(8); PG8_BAR; PG8_WAIT_L(0); PG8_MMA(0, 0, At, B0); PG8_BAR; PG8_SCHED;
            PG8_LDB(B1, 1, 1); PG8_STAGE(PG8_SB(1, 0), b3, voffB);
            PG8_BAR; PG8_WAIT_L(0); PG8_MMA(0, 1, At, B1); PG8_BAR;
            PG8_LDA(At, 1, 1); PG8_STAGE_A(PG8_SA(1, 0), a3, 0, nx);
            PG8_BAR; PG8_WAIT_L(0); PG8_MMA(1, 0, At, B0); PG8_BAR; PG8_SCHED;
            PG8_STAGE(PG8_SB(1, 1), b3 + hstepB, voffB);
            PG8_WAIT_V(6); PG8_BAR; PG8_MMA(1, 1, At, B1); PG8_BAR;
            }
        }
        if constexpr (ALIGN_EPI) { if (wr == 0) PG8_BAR; }
        if constexpr (!Epi::AFTER_DRAIN) { int l2_ = lane; asm volatile("" : "+v"(l2_)); E(acc, cur, wr, wc, l2_ & 15, l2_ >> 4); S.done(cur); }
        if (!has_next) break;
#pragma unroll
        for (int a = 0; a < 2; ++a)
#pragma unroll
            for (int b = 0; b < 2; ++b)
#pragma unroll
                for (int m = 0; m < 4; ++m)
#pragma unroll
                    for (int n = 0; n < 2; ++n) acc[a][b][m][n] = (f32x4){0.f, 0.f, 0.f, 0.f};
        if constexpr (GA) { PG8_NXTOFF(curA[0], 0); PG8_NXTOFF(curA[1], 1); }
        cur = nxt; cA = nA; cB = nB; ++ui;
        if constexpr (ALIGN_EPI) { if (wr == 1) PG8_BAR; }
    }
    PG8_WAIT_V(0);
    if constexpr (!ALIGN_EPI) { if (wr == 0) PG8_BAR; }
    PG8_BAR;
    if constexpr (Epi::AFTER_DRAIN) { E.fused(acc, cur, wr, wc, fr, fq, lds, wid, lane); S.done(cur); }
#undef PG8_SA
#undef PG8_SB
#undef PG8_STAGE
#undef PG8_STAGE_A
#undef PG8_NXTOFF
#undef PG8_ROWTAB
#undef PG8_LDA
#undef PG8_LDB
#undef PG8_TR
#undef PG8_TRF
#undef PG8_BBASE
#undef PG8_MMA
#undef PG8_WAIT_V
#undef PG8_WAIT_L
#undef PG8_BAR
#undef PG8_SCHED
}
}

namespace mk {
constexpr int D = 1024, B = 4, S = 4096, T = B * S, C = 512, INW = 5120, E = 16, CAP = 512, F = 2048, NTH = 512, NWAVES = 8;
typedef unsigned short bf16;
#define LAS __attribute__((address_space(3)))
typedef unsigned v4u __attribute__((ext_vector_type(4)));
typedef unsigned v2u __attribute__((ext_vector_type(2)));
typedef float f32x4 __attribute__((ext_vector_type(4)));
typedef short bf16x8 __attribute__((ext_vector_type(8)));
typedef float f32x16 __attribute__((ext_vector_type(16)));
typedef short s16x4 __attribute__((ext_vector_type(4)));

constexpr size_t MiB = 1u << 20;
constexpr size_t WS_WIN = 2 * MiB;
constexpr size_t WS_WUH = 22 * MiB;
constexpr size_t WS_WUA = 23 * MiB;
constexpr size_t WS_WOUT = 26 * MiB;
constexpr size_t WS_BINP = 30 * MiB;
constexpr size_t WS_WRP = 30 * MiB + 512 * 1024;
constexpr size_t WS_ROPE = 31 * MiB;
constexpr size_t WS_AFFT = 32 * MiB;
constexpr size_t WS_INV = 33 * MiB;
constexpr size_t WS_ROWS = 34 * MiB;
constexpr size_t WS_GATE = 34 * MiB + 512 * 1024;
constexpr size_t WS_RTOK = 35 * MiB + 512 * 1024;
constexpr size_t WS_RSL = 35 * MiB;
constexpr size_t WS_FILT = 36 * MiB;
constexpr size_t WS_X = 68 * MiB;
constexpr size_t WS_XN = 132 * MiB;
constexpr size_t WS_SH = 164 * MiB;
constexpr size_t WS_U = WS_SH;
constexpr size_t WS_UCT = WS_SH + 48 * MiB;
constexpr size_t WS_Q = WS_SH + 96 * MiB;
constexpr size_t WS_K = WS_SH + 112 * MiB;
constexpr size_t WS_V = WS_SH + 128 * MiB;
constexpr size_t WS_GH = WS_SH + 144 * MiB;
constexpr size_t WS_GA = WS_SH + 176 * MiB;
constexpr size_t WS_YH = WS_SH + 208 * MiB;
constexpr size_t WS_YA = WS_SH + 224 * MiB;
constexpr size_t WS_T1 = WS_U;
constexpr size_t WS_MG = WS_UCT;
constexpr size_t WS_PART = WS_SH;
constexpr size_t WS_HB = WS_SH + 64 * MiB;
constexpr size_t WS_YE = WS_SH + 192 * MiB;
constexpr size_t WS_WGU = 420 * MiB;
constexpr size_t WS_WD = 676 * MiB;
constexpr size_t WS_END = 804 * MiB;

constexpr int LDS_BYTES = 155648;
constexpr float QSCALE = 0.125f * 1.4426950408889634f;

struct Args {
    const float* in[29]; float* out; unsigned char* ws; int ph_lo, ph_hi; int p0_mask, pad;
};

__device__ __forceinline__ unsigned f2bf(float f) { unsigned u = __builtin_bit_cast(unsigned, f); return (u + 0x7fffu + ((u >> 16) & 1u)) >> 16; }
__device__ __forceinline__ unsigned pk2(float lo, float hi) { return f2bf(lo) | (f2bf(hi) << 16); }
__device__ __forceinline__ float bf2f(unsigned h) { return __builtin_bit_cast(float, h << 16); }
__device__ __forceinline__ float bflo(unsigned w) { return __builtin_bit_cast(float, w << 16); }
__device__ __forceinline__ float bfhi(unsigned w) { return __builtin_bit_cast(float, w & 0xffff0000u); }
template <int O> __device__ __forceinline__ float xor_f(float v) { return __builtin_bit_cast(float, __builtin_amdgcn_ds_swizzle(__builtin_bit_cast(int, v), (O << 10) | 0x1f)); }
__device__ __forceinline__ float wave_sum(float v) { v += xor_f<1>(v); v += xor_f<2>(v); v += xor_f<4>(v); v += xor_f<8>(v); v += xor_f<16>(v);
    const int b = __builtin_bit_cast(int, v); return __builtin_bit_cast(float, __builtin_amdgcn_readlane(b, 0)) + __builtin_bit_cast(float, __builtin_amdgcn_readlane(b, 32)); }

__device__ __forceinline__ float sigm(float x) { return 1.f / (1.f + __expf(-x)); }

struct Ctx { int tid, lane, wave, gw, ngw, vcu, G, bid, wave_s; LAS unsigned char* lds; unsigned char* ws; };

__device__ __forceinline__ int fresh_tid(int wave_s) { int l; asm volatile("v_mbcnt_lo_u32_b32 %0, -1, 0\n\tv_mbcnt_hi_u32_b32 %0, -1, %0" : "=v"(l)); return (wave_s << 6) | l; }
__device__ __forceinline__ Ctx relaunder(const Ctx& X) { Ctx Y = X; const int t = fresh_tid(X.wave_s); Y.tid = t; Y.lane = t & 63; return Y; }

template <int MAP> __device__ __forceinline__ int rowmap(int n) {
    if (MAP == 1) {
        if (n < 1536 || n >= 2560) return n;
        const int hb = (n - 1536) & ~63, d = (n - 1536) & 63, i = (d & 31) >> 2, j = d & 3;
        return 1536 + hb + 8 * i + ((d >> 5) << 2) + j;
    }
    if (MAP == 2) return ((n >> 7) << 8) + (n & 127);
    if (MAP == 3) return ((n >> 7) << 8) + 128 + (n & 127);
    return n;
}
__device__ __forceinline__ unsigned cvtpk_(float lo, float hi) { unsigned r; asm volatile("v_cvt_pk_bf16_f32 %0, %1, %2" : "=v"(r) : "v"(lo), "v"(hi)); return r; }
struct TrItem { const float* src; bf16* dst; };
template <int MAP> __device__ __forceinline__ void p0_transpose(const Ctx& X, const float* W, int K, int N, bf16* WT, int nmat, size_t sstride, size_t dstride, int rot = 0) {
    LAS float* scr = (LAS float*)(X.lds + X.wave * 16640);
    const int nblk = N / 64, per = (K / 64) * nblk, tot = per * nmat, lane = X.lane;
    const int nq = lane & 15, kr = lane >> 4, c = lane & 7, nsub = lane >> 3;
    f32x4 v[16];
    int it = X.gw - rot; if (it < 0) it += X.ngw;
#define TR_SRC(it_) (W + (size_t)((it_) / per) * sstride + (size_t)(64 * (((it_) % per) / nblk) + kr) * N + 64 * (((it_) % per) % nblk) + 4 * nq)
    if (it < tot) { const float* s = TR_SRC(it);
#pragma unroll
        for (int i = 0; i < 16; ++i) v[i] = __builtin_nontemporal_load((const f32x4*)(s + (size_t)(4 * i) * N)); }
    while (it < tot) {
#pragma unroll
        for (int i = 0; i < 16; ++i) { LAS float* d = scr + (4 * i + kr) * 65 + 4 * nq; d[0] = v[i][0]; d[1] = v[i][1]; d[2] = v[i][2]; d[3] = v[i][3]; }
        const int nit = it + X.ngw;
        if (nit < tot) { const float* s = TR_SRC(nit);
#pragma unroll
            for (int i = 0; i < 16; ++i) v[i] = __builtin_nontemporal_load((const f32x4*)(s + (size_t)(4 * i) * N)); }
        asm volatile("s_waitcnt lgkmcnt(0)" ::: "memory");
        const int m = it / per, r = it - m * per, k0 = 64 * (r / nblk), n0 = 64 * (r % nblk);
        bf16* dst = WT + (size_t)m * dstride;
#pragma unroll
        for (int j = 0; j < 8; ++j) { const int n = nsub + 8 * j; const LAS float* s = scr + (8 * c) * 65 + n;
            v4u o; o.x = cvtpk_(s[0 * 65], s[1 * 65]); o.y = cvtpk_(s[2 * 65], s[3 * 65]); o.z = cvtpk_(s[4 * 65], s[5 * 65]); o.w = cvtpk_(s[6 * 65], s[7 * 65]);
            __builtin_nontemporal_store(o, (v4u*)(dst + (size_t)rowmap<MAP>(n0 + n) * K + k0 + 8 * c)); }
        asm volatile("s_waitcnt lgkmcnt(0)" ::: "memory");
        it = nit;
    }
#undef TR_SRC
}
struct Row8 { f32x4 a[2][2]; };
__device__ __forceinline__ void row8_load(Row8& r, const float* p, int lane) {
#pragma unroll
    for (int j = 0; j < 2; ++j) { const f32x4* q = (const f32x4*)p + 2 * (lane + 64 * j); r.a[j][0] = q[0]; r.a[j][1] = q[1]; }
}
__device__ __forceinline__ float row8_sumsq(const Row8& r) {
    float s = 0.f;
#pragma unroll
    for (int j = 0; j < 2; ++j)
#pragma unroll
        for (int h = 0; h < 2; ++h) s += (r.a[j][h].x * r.a[j][h].x + r.a[j][h].y * r.a[j][h].y) + (r.a[j][h].z * r.a[j][h].z + r.a[j][h].w * r.a[j][h].w);
    return s;
}
__device__ __forceinline__ void rms_row_to_bf16(const float* __restrict__ xrow, const float* __restrict__ g, bf16* __restrict__ orow, int lane) {
    const f32x4* xr = (const f32x4*)xrow + lane; f32x4 v[4]; float s = 0.f;
#pragma unroll
    for (int j = 0; j < 4; ++j) { v[j] = xr[64 * j]; s += (v[j].x * v[j].x + v[j].y * v[j].y) + (v[j].z * v[j].z + v[j].w * v[j].w); }
    const float r = rsqrtf(wave_sum(s) * (1.f / D) + 1e-6f);
    v2u* o8 = (v2u*)orow + lane;
#pragma unroll
    for (int j = 0; j < 4; ++j) { const f32x4 gg = ((const f32x4*)g)[lane + 64 * j]; v2u w; w.x = pk2(v[j].x * r * gg.x, v[j].y * r * gg.y); w.y = pk2(v[j].z * r * gg.z, v[j].w * r * gg.w); o8[64 * j] = w; }
}
__device__ __forceinline__ void p0_filters(const Ctx& X, const Args& a) {
    LAS float* z = (LAS float*)X.lds;
    LAS float* h1 = z + 32 * 36;
    LAS float* h2r = h1 + 32 * 64;
    LAS float* w1s = h2r + 32 * 68;
    LAS float* w2s = w1s + 33 * 64;
    bf16* FILT = (bf16*)(X.ws + WS_FILT);
    const float min_decay = logf(1e-2f) / 0.3f, max_decay = logf(1e-2f) / 1.5f;
    for (int it = X.bid; it < 2 * (S / 32); it += X.G) {
        int tid = X.tid; asm volatile("" : "+v"(tid));
        const int j = tid & 63, tq = tid >> 6;
        const int l = it / (S / 32), t0 = (it % (S / 32)) * 32;
        const float *w1 = a.in[6] + l * 33 * 64, *b1 = a.in[7] + l * 64, *f1 = a.in[8] + l * 64, *w2 = a.in[9] + l * 64 * 64, *b2 = a.in[10] + l * 64, *f2 = a.in[11] + l * 64, *w3 = a.in[12] + (size_t)l * 64 * 2048;
        __syncthreads();
        for (int e = tid; e < 33 * 64; e += NTH) w1s[e] = w1[e];
        for (int e = tid; e < 64 * 64; e += NTH) w2s[e] = w2[e];
        for (int e = tid; e < 32 * 33; e += NTH) { const int tt = e / 33, jj0 = e - tt * 33, t = t0 + tt; float v;
            if (jj0 == 0) v = (float)t / (float)(S - 1);
            else { const int jj = (jj0 - 1) & 15; const float w = 2.0f * 3.14159265358979323846f * (float)t / (float)S; const float fr = 1e-4f + (float)jj * ((15.0f - 1e-4f) / 15.0f); const float ang = w * fr; v = (jj0 <= 16) ? cosf(ang) : -sinf(ang); }
            z[tt * 36 + jj0] = v; }
        const float bb1 = b1[j], ff1 = f1[j], bb2 = b2[j], ff2 = f2[j];
        __syncthreads();
        { float acc[4] = {bb1, bb1, bb1, bb1};
          for (int i = 0; i < 33; ++i) { const float w = w1s[i * 64 + j];
#pragma unroll
              for (int k = 0; k < 4; ++k) acc[k] += z[(tq + 8 * k) * 36 + i] * w; }
#pragma unroll
          for (int k = 0; k < 4; ++k) h1[(tq + 8 * k) * 64 + j] = sinf(ff1 * acc[k]); }
        __syncthreads();
        { float acc[4] = {bb2, bb2, bb2, bb2};
          for (int i = 0; i < 64; ++i) { const float w = w2s[i * 64 + j];
#pragma unroll
              for (int k = 0; k < 4; ++k) acc[k] += h1[(tq + 8 * k) * 64 + i] * w; }
#pragma unroll
          for (int k = 0; k < 4; ++k) h2r[(tq + 8 * k) * 68 + j] = sinf(ff2 * acc[k]); }
        __syncthreads();
        { const int wv = tid >> 6, ln = tid & 63, tl = ln & 31, kh = ln >> 5;
#define FSPLIT(HI, LO, V0, V1) do { v4u h_; h_.x = cvtpk_((V0)[0], (V0)[1]); h_.y = cvtpk_((V0)[2], (V0)[3]); h_.z = cvtpk_((V1)[0], (V1)[1]); h_.w = cvtpk_((V1)[2], (V1)[3]); \
            v4u l_; l_.x = cvtpk_((V0)[0] - bflo(h_.x), (V0)[1] - bfhi(h_.x)); l_.y = cvtpk_((V0)[2] - bflo(h_.y), (V0)[3] - bfhi(h_.y)); l_.z = cvtpk_((V1)[0] - bflo(h_.z), (V1)[1] - bfhi(h_.z)); l_.w = cvtpk_((V1)[2] - bflo(h_.w), (V1)[3] - bfhi(h_.w)); \
            HI = __builtin_bit_cast(bf16x8, h_); LO = __builtin_bit_cast(bf16x8, l_); } while (0)
            bf16x8 ah[4], al[4];
#pragma unroll
            for (int kb = 0; kb < 4; ++kb) { const f32x4 v0 = *(const LAS f32x4*)(h2r + tl * 68 + 16 * kb + 8 * kh), v1 = *(const LAS f32x4*)(h2r + tl * 68 + 16 * kb + 8 * kh + 4); FSPLIT(ah[kb], al[kb], v0, v1); }
            const float* wl = w3 + (size_t)(8 * kh) * 2048 + wv * 256 + tl;
            f32x4 wq[2][4][2];
#define FLOADW(BUF, NT) do { _Pragma("unroll") for (int kb_ = 0; kb_ < 4; ++kb_) _Pragma("unroll") for (int j_ = 0; j_ < 8; ++j_) wq[BUF][kb_][j_ >> 2][j_ & 3] = wl[(size_t)(16 * kb_ + j_) * 2048 + 32 * (NT)]; } while (0)
#define FTILE(BUF, NT) do { f32x16 d_ = {}; _Pragma("unroll") for (int kb_ = 0; kb_ < 4; ++kb_) { bf16x8 bh_, bl_; FSPLIT(bh_, bl_, wq[BUF][kb_][0], wq[BUF][kb_][1]); \
                d_ = __builtin_amdgcn_mfma_f32_32x32x16_bf16(ah[kb_], bh_, d_, 0, 0, 0); d_ = __builtin_amdgcn_mfma_f32_32x32x16_bf16(al[kb_], bh_, d_, 0, 0, 0); d_ = __builtin_amdgcn_mfma_f32_32x32x16_bf16(ah[kb_], bl_, d_, 0, 0, 0); } \
              const int n_ = wv * 256 + 32 * (NT) + tl, c_ = n_ & 511, od_ = n_ >> 9; const float dl_ = fabsf(min_decay + (float)c_ * ((max_decay - min_decay) / 511.0f)) * (1.0f / (float)(S - 1)); \
              bf16* fo_ = FILT + (((size_t)l * 4 + od_) * C + c_) * S + t0 + 4 * kh; \
              _Pragma("unroll") for (int g_ = 0; g_ < 4; ++g_) { const float tb_ = (float)(t0 + 8 * g_ + 4 * kh); v2u o_; \
                  o_.x = pk2(d_[4 * g_] * expf(-tb_ * dl_), d_[4 * g_ + 1] * expf(-(tb_ + 1.f) * dl_)); o_.y = pk2(d_[4 * g_ + 2] * expf(-(tb_ + 2.f) * dl_), d_[4 * g_ + 3] * expf(-(tb_ + 3.f) * dl_)); \
                  *(v2u*)(fo_ + 8 * g_) = o_; } } while (0)
            FLOADW(0, 0);
#pragma unroll 1
            for (int nt = 0; nt < 8; nt += 2) { FLOADW(1, nt + 1); FTILE(0, nt); if (nt + 2 < 8) FLOADW(0, nt + 2); FTILE(1, nt + 1); }
#undef FSPLIT
#undef FLOADW
#undef FTILE
        }
    }
    __syncthreads();
}
template <int MAP> __device__ __forceinline__ void p0_convert(const Ctx& X, const float* W, int K, int N, bf16* WB, int dN, int nmat, size_t sstride, size_t dstride, const float* __restrict__ rscale = nullptr) {
    const int nblk = N / 256, per = (K / 16) * nblk, tot = per * nmat, lane = X.lane;
    f32x4 v[16];
    int it = X.gw;
#define CV_SRC(it_) (W + (size_t)((it_) / per) * sstride + (size_t)(16 * (((it_) % per) / nblk)) * N + 256 * (((it_) % per) % nblk) + 4 * lane)
    if (it < tot) { const float* s = CV_SRC(it);
#pragma unroll
        for (int i = 0; i < 16; ++i) v[i] = __builtin_nontemporal_load((const f32x4*)(s + (size_t)i * N)); }
    while (it < tot) {
        v2u o[16];
        if (rscale) { const int k0s = 16 * ((it % per) / nblk);
#pragma unroll
            for (int i = 0; i < 16; ++i) { const float sc = rscale[k0s + i]; o[i].x = cvtpk_(v[i][0] * sc, v[i][1] * sc); o[i].y = cvtpk_(v[i][2] * sc, v[i][3] * sc); } }
        else {
#pragma unroll
        for (int i = 0; i < 16; ++i) { o[i].x = cvtpk_(v[i][0], v[i][1]); o[i].y = cvtpk_(v[i][2], v[i][3]); } }
        const int nit = it + X.ngw;
        if (nit < tot) { const float* s = CV_SRC(nit);
#pragma unroll
            for (int i = 0; i < 16; ++i) v[i] = __builtin_nontemporal_load((const f32x4*)(s + (size_t)i * N)); }
        const int mi = it / per, r = it - mi * per, k0 = 16 * (r / nblk), n = 256 * (r % nblk) + 4 * lane;
        const int dc = MAP == 0 ? n : (((n >> 7) << 8) + (n & 127) + (MAP == 3 ? 128 : 0));
        bf16* dst = WB + (size_t)mi * dstride + (size_t)k0 * dN + dc;
#pragma unroll
        for (int i = 0; i < 16; ++i) __builtin_nontemporal_store(o[i], (v2u*)(dst + (size_t)i * dN));
        it = nit;
    }
#undef CV_SRC
}
__device__ __forceinline__ void p0_experts(const Ctx& X, const Args& a, int l) {
    bf16* wgu = (bf16*)(X.ws + WS_WGU) + (size_t)l * E * 2 * F * D; bf16* wd = (bf16*)(X.ws + WS_WD) + (size_t)l * E * F * D;
    p0_convert<2>(X, a.in[25] + (size_t)l * E * D * F, D, F, wgu, 2 * F, E, (size_t)D * F, (size_t)2 * F * D, a.in[22] + l * D);
    p0_convert<3>(X, a.in[26] + (size_t)l * E * D * F, D, F, wgu, 2 * F, E, (size_t)D * F, (size_t)2 * F * D, a.in[22] + l * D);
    p0_convert<0>(X, a.in[27] + (size_t)l * E * D * F, F, D, wd, D, E, (size_t)F * D, (size_t)F * D);
}
__device__ __forceinline__ void p0_experts_rest(const Ctx& X, const Args& a, int l, int me0) {
    bf16* wgu = (bf16*)(X.ws + WS_WGU) + (size_t)l * E * 2 * F * D; bf16* wd = (bf16*)(X.ws + WS_WD) + (size_t)l * E * F * D;
    const int g0 = me0 < 16 ? me0 : 16, u0 = me0 < 16 ? 0 : (me0 < 32 ? me0 - 16 : 16), d0 = me0 < 32 ? 0 : me0 - 32;
    if (g0 < 16) p0_convert<2>(X, a.in[25] + ((size_t)l * E + g0) * D * F, D, F, wgu + (size_t)g0 * 2 * F * D, 2 * F, E - g0, (size_t)D * F, (size_t)2 * F * D, a.in[22] + l * D);
    if (u0 < 16) p0_convert<3>(X, a.in[26] + ((size_t)l * E + u0) * D * F, D, F, wgu + (size_t)u0 * 2 * F * D, 2 * F, E - u0, (size_t)D * F, (size_t)2 * F * D, a.in[22] + l * D);
    if (d0 < 16) p0_convert<0>(X, a.in[27] + ((size_t)l * E + d0) * D * F, F, D, wd + (size_t)d0 * F * D, D, E - d0, (size_t)F * D, (size_t)F * D);
}
#ifndef MK_P0_DUP
#define MK_P0_DUP 0
#endif
__device__ __forceinline__ void p0_prologue(const Ctx& X, const Args& a) {
    const int m = a.p0_mask;
    for (int dup_ = 0; dup_ < ((MK_P0_DUP & 1) ? 2 : 1); ++dup_)
    if (m & 1) {
        p0_transpose<1>(X, a.in[2], D, INW, (bf16*)(X.ws + WS_WIN), 2, (size_t)D * INW, (size_t)D * INW);
        p0_transpose<0>(X, a.in[19], C, D, (bf16*)(X.ws + WS_WUH), 2, (size_t)C * D, (size_t)2 * C * D, 512 % X.ngw);
        p0_transpose<0>(X, a.in[20], C, D, (bf16*)(X.ws + WS_WUA), 2, (size_t)C * D, (size_t)2 * C * D, 768 % X.ngw);
        p0_transpose<0>(X, a.in[21], D, D, (bf16*)(X.ws + WS_WOUT), 2, (size_t)D * D, (size_t)D * D, 1024 % X.ngw);
        float* binp = (float*)(X.ws + WS_BINP);
        for (int i = X.gw * 64 + X.lane; i < 2 * INW; i += X.ngw * 64) { const int l = i / INW, n = i - l * INW; binp[l * INW + rowmap<1>(n)] = a.in[3][i]; }
        { bf16* wrp = (bf16*)(X.ws + WS_WRP);
          for (int i = X.gw * 64 + X.lane; i < 2 * E * D; i += X.ngw * 64) { const int l = i / (E * D), e = (i / D) % E, k = i % D; const float v = a.in[22][l * D + k] * a.in[23][((size_t)l * D + k) * E + e];
              const unsigned hi = f2bf(v); const float lo = v - __builtin_bit_cast(float, hi << 16); wrp[((l * 2 + 0) * E + e) * D + k] = (bf16)hi; wrp[((l * 2 + 1) * E + e) * D + k] = (bf16)f2bf(lo); } }
        float* rope = (float*)(X.ws + WS_ROPE);
        for (int i = X.gw * 64 + X.lane; i < S * 32; i += X.ngw * 64) { const int pos = i >> 5, j = i & 31; const float inv = powf(10000.0f, -(float)j * 2.0f / 64.0f); float sn, cs; sincosf((float)pos * inv, &sn, &cs); rope[2 * i] = cs; rope[2 * i + 1] = sn; }
    }
    if (m & 2) { p0_experts(X, a, 0); p0_experts(X, a, 1); }
    for (int dup_ = 0; dup_ < ((MK_P0_DUP & 4) ? 2 : 1); ++dup_)
    if (m & 4) p0_filters(X, a);
    for (int dup_ = 0; dup_ < ((MK_P0_DUP & 8) ? 2 : 1); ++dup_)
    if (m & 8) {
        bf16* XN = (bf16*)(X.ws + WS_XN); const int lane = X.lane; Row8 gg; row8_load(gg, a.in[1], lane);
        int r = X.gw; Row8 cur; if (r < T) row8_load(cur, a.in[0] + (size_t)r * D, lane);
        while (r < T) { const int nr = r + X.ngw; Row8 nxt; if (nr < T) row8_load(nxt, a.in[0] + (size_t)nr * D, lane);
            const float rs = rsqrtf(wave_sum(row8_sumsq(cur)) * (1.f / D) + 1e-6f);
#pragma unroll
            for (int j = 0; j < 2; ++j) { const f32x4 y0 = cur.a[j][0] * gg.a[j][0] * rs, y1 = cur.a[j][1] * gg.a[j][1] * rs;
                v4u w; w.x = pk2(y0.x, y0.y); w.y = pk2(y0.z, y0.w); w.z = pk2(y1.x, y1.y); w.w = pk2(y1.z, y1.w); ((v4u*)(XN + (size_t)r * D))[lane + 64 * j] = w; }
            cur = nxt; r = nr; }
    }
}
}
namespace mk {
using pg8::Unit;
#ifndef MK_SIMPLE_ORDER
#define MK_SIMPLE_ORDER 0
#endif
__device__ __forceinline__ unsigned cvtpk(float lo, float hi) { unsigned r; asm volatile("v_cvt_pk_bf16_f32 %0, %1, %2" : "=v"(r) : "v"(lo), "v"(hi)); return r; }
__device__ __forceinline__ v4u pack8(f32x4 a, f32x4 b) { v4u w; w.x = cvtpk(a[0], a[1]); w.y = cvtpk(a[2], a[3]); w.z = cvtpk(b[0], b[1]); w.w = cvtpk(b[2], b[3]); return w; }
__device__ __forceinline__ void unpack8(v4u w, f32x4& a, f32x4& b) { a = (f32x4){bflo(w.x), bfhi(w.x), bflo(w.y), bfhi(w.y)}; b = (f32x4){bflo(w.z), bfhi(w.z), bflo(w.w), bfhi(w.w)}; }
__device__ __forceinline__ float fsig(float x) { return __builtin_amdgcn_rcpf(1.f + __expf(-x)); }

struct EpiWin {
    static constexpr bool PERM = true, AFTER_DRAIN = false;
    unsigned char* ws; const float* bias; const float* rope;
    __device__ __forceinline__ void operator()(const f32x4 (&acc)[2][2][4][2], const Unit& u, int wr, int wc, int fr, int fq) const {
        const int colt = u.pn * 256, row0 = u.pm * 256 + wr * 64 + fr, cin = wc * 32 + 8 * fq;
        bf16* base; int ldc, col0, mode; float sc = 1.f;
        if (colt < 1536) { base = (bf16*)(ws + WS_U); ldc = 1536; col0 = colt; mode = 0; }
        else if (colt < 2048) { base = (bf16*)(ws + WS_Q); ldc = 512; col0 = colt - 1536; mode = 1; sc = QSCALE; }
        else if (colt < 2560) { base = (bf16*)(ws + WS_K); ldc = 512; col0 = colt - 2048; mode = 1; }
        else if (colt < 3072) { base = (bf16*)(ws + WS_V); ldc = 512; col0 = colt - 2560; mode = 0; }
        else if (colt < 4096) { base = (bf16*)(ws + WS_GH); ldc = 1024; col0 = colt - 3072; mode = 2; }
        else { base = (bf16*)(ws + WS_GA); ldc = 1024; col0 = colt - 4096; mode = 2; }
        f32x4 bv[2][2];
#pragma unroll
        for (int bj = 0; bj < 2; ++bj)
#pragma unroll
            for (int n = 0; n < 2; ++n) bv[bj][n] = *(const f32x4*)(bias + colt + bj * 128 + cin + 4 * n);
#pragma unroll
        for (int ai = 0; ai < 2; ++ai)
#pragma unroll
            for (int m = 0; m < 4; ++m) {
                const int row = row0 + ai * 128 + m * 16; bf16* rowp = base + (size_t)row * ldc + col0 + cin;
                f32x4 rq[2][2];
                if (mode == 1) {
#pragma unroll
                    for (int bj = 0; bj < 2; ++bj) { const int i = ((bj * 128 + cin) & 63) >> 3; const float* rp = rope + ((size_t)(row & (S - 1)) * 32 + 4 * i) * 2; rq[bj][0] = *(const f32x4*)rp; rq[bj][1] = *(const f32x4*)(rp + 4); } }
#pragma unroll
                for (int bj = 0; bj < 2; ++bj) {
                    f32x4 v0 = acc[ai][bj][m][0] + bv[bj][0], v1 = acc[ai][bj][m][1] + bv[bj][1];
                    if (mode == 1) {
                        const f32x4 r0 = rq[bj][0], r1 = rq[bj][1];
                        const f32x4 cs = {r0[0], r0[2], r1[0], r1[2]}, sn = {r0[1], r0[3], r1[1], r1[3]};
                        const f32x4 o1 = (v0 * cs - v1 * sn) * sc, o2 = (v1 * cs + v0 * sn) * sc; v0 = o1; v1 = o2;
                    } else if (mode == 2) {
#pragma unroll
                        for (int e = 0; e < 4; ++e) { v0[e] = fsig(v0[e]); v1[e] = fsig(v1[e]); }
                    }
                    *(v4u*)(rowp + bj * 128) = pack8(v0, v1);
                }
            }
    }
};
struct EpiMerge2 {
    static constexpr bool PERM = true, AFTER_DRAIN = false;
    const bf16* GH; const bf16* GA; bf16* T1; bf16* MG;
    __device__ __forceinline__ void operator()(const f32x4 (&acc)[2][2][4][2], const Unit& u, int wr, int wc, int fr, int fq) const {
        const int row0 = u.pm * 256 + wr * 64 + fr, col0 = u.pn * 256 + wc * 32 + 8 * fq; const bool second = u.pa != u.pm; const bf16* G = second ? GA : GH;
#pragma unroll
        for (int ai = 0; ai < 2; ++ai)
#pragma unroll
            for (int mp = 0; mp < 4; mp += 2) {
                v4u gq[2][2], tq[2][2];
#pragma unroll
                for (int mm = 0; mm < 2; ++mm)
#pragma unroll
                    for (int bj = 0; bj < 2; ++bj) { const size_t off = (size_t)(row0 + ai * 128 + (mp + mm) * 16) * D + col0 + bj * 128; gq[mm][bj] = *(const v4u*)(G + off); if (second) tq[mm][bj] = *(const v4u*)(T1 + off); }
#pragma unroll
                for (int mm = 0; mm < 2; ++mm) { const int m = mp + mm; const size_t off = (size_t)(row0 + ai * 128 + m * 16) * D + col0;
#pragma unroll
                    for (int bj = 0; bj < 2; ++bj) { f32x4 g0, g1; unpack8(gq[mm][bj], g0, g1);
                        f32x4 v0 = acc[ai][bj][m][0] * g0, v1 = acc[ai][bj][m][1] * g1;
                        if (second) { f32x4 t0, t1; unpack8(tq[mm][bj], t0, t1); v0 += t0; v1 += t1; *(v4u*)(MG + off + bj * 128) = pack8(v0, v1); }
                        else *(v4u*)(T1 + off + bj * 128) = pack8(v0, v1); } } }
    }
};
struct OrderMerge {
    pg8::StaticOrder so;
    __device__ __forceinline__ bool next(int i, Unit& u) const { if (!so.next(i >> 1, u)) return false; if (i & 1) { u.pa = u.pm + T / 256; u.pb = u.pn + 4; } return true; }
    __device__ __forceinline__ void a_ready(const Unit&) const {}
    __device__ __forceinline__ void done(const Unit&) const {}
};
struct EpiOut {
    static constexpr bool PERM = false, AFTER_DRAIN = false;
    const float* xin; float* X;
    __device__ __forceinline__ void operator()(const f32x4 (&acc)[2][2][4][2], const Unit& u, int wr, int wc, int fr, int fq) const {
        const int row0 = u.pm * 256 + wr * 64 + fr, col0 = u.pn * 256 + wc * 32 + 4 * fq;
#pragma unroll
        for (int ai = 0; ai < 2; ++ai)
#pragma unroll
            for (int m = 0; m < 4; ++m) { const size_t off = (size_t)(row0 + ai * 128 + m * 16) * D + col0;
#pragma unroll
                for (int bj = 0; bj < 2; ++bj)
#pragma unroll
                    for (int n = 0; n < 2; ++n) *(f32x4*)(X + off + bj * 128 + n * 16) = *(const f32x4*)(xin + off + bj * 128 + n * 16) + acc[ai][bj][m][n]; }
    }
};
struct EpiOutR {
    static constexpr bool PERM = true, AFTER_DRAIN = true;
    const float* xin; float* X; bf16* XB; float* PART; const bf16* WRP; unsigned* tick; float* AFFT; float* RTOK; const float* br;
    __device__ __forceinline__ void operator()(const f32x4 (&)[2][2][4][2], const Unit&, int, int, int, int) const {}
    __device__ __forceinline__ void fused(const f32x4 (&acc)[2][2][4][2], const Unit& u, int wr, int wc, int fr, int fq, LAS unsigned char* lds, int wid, int lane) const {
        LAS float* SS = (LAS float*)lds;
        LAS float* LG = (LAS float*)(lds + 16384);
        const int rowl0 = wr * 64 + fr, colw = wc * 32 + 8 * fq;
        bf16x8 whi[2], wlo[2];
#pragma unroll
        for (int bj = 0; bj < 2; ++bj) { const bf16* wp = WRP + (size_t)fr * D + u.pn * 256 + bj * 128 + colw; whi[bj] = *(const bf16x8*)wp; wlo[bj] = *(const bf16x8*)(wp + (size_t)E * D); }
#pragma unroll
        for (int ai = 0; ai < 2; ++ai)
#pragma unroll
            for (int m = 0; m < 4; ++m) { const int rowl = rowl0 + ai * 128 + m * 16; float ss = 0.f; f32x4 lg = {0.f, 0.f, 0.f, 0.f};
                f32x4 xq[2][2];
#pragma unroll
                for (int bj = 0; bj < 2; ++bj) { const size_t off = (size_t)(u.pm * 256 + rowl) * D + u.pn * 256 + bj * 128 + colw; xq[bj][0] = *(const f32x4*)(xin + off); xq[bj][1] = *(const f32x4*)(xin + off + 4); }
#pragma unroll
                for (int bj = 0; bj < 2; ++bj) { const size_t off = (size_t)(u.pm * 256 + rowl) * D + u.pn * 256 + bj * 128 + colw;
                    const f32x4 x0 = xq[bj][0] + acc[ai][bj][m][0], x1 = xq[bj][1] + acc[ai][bj][m][1];
                    *(f32x4*)(X + off) = x0; *(f32x4*)(X + off + 4) = x1;
                    const v4u hi = pack8(x0, x1); *(v4u*)(XB + off) = hi;
                    f32x4 h0, h1; unpack8(hi, h0, h1); const v4u lo = pack8(x0 - h0, x1 - h1);
                    ss += ((x0[0] * x0[0] + x0[1] * x0[1]) + (x0[2] * x0[2] + x0[3] * x0[3])) + ((x1[0] * x1[0] + x1[1] * x1[1]) + (x1[2] * x1[2] + x1[3] * x1[3]));
                    lg = __builtin_amdgcn_mfma_f32_16x16x32_bf16(whi[bj], __builtin_bit_cast(bf16x8, hi), lg, 0, 0, 0);
                    lg = __builtin_amdgcn_mfma_f32_16x16x32_bf16(whi[bj], __builtin_bit_cast(bf16x8, lo), lg, 0, 0, 0);
                    lg = __builtin_amdgcn_mfma_f32_16x16x32_bf16(wlo[bj], __builtin_bit_cast(bf16x8, hi), lg, 0, 0, 0); }
                SS[rowl * 16 + wc * 4 + fq] = ss;
                *(LAS f32x4*)(LG + ((wc * 256 + rowl) * 16 + 4 * fq)) = lg; }
        __syncthreads();
        const int t = wid * 64 + lane;
        if (t < 256) { float s = 0.f;
#pragma unroll
            for (int i = 0; i < 4; ++i) { const f32x4 v = *(const LAS f32x4*)(SS + t * 16 + 4 * i); s += (v[0] + v[1]) + (v[2] + v[3]); }
            float* pp = PART + ((size_t)u.pn * T + u.pm * 256 + t) * 20;
            __hip_atomic_store(pp, s, __ATOMIC_RELAXED, __HIP_MEMORY_SCOPE_AGENT);
#pragma unroll
            for (int i = 0; i < 4; ++i) { f32x4 a4 = *(const LAS f32x4*)(LG + (t * 16 + 4 * i));
#pragma unroll
                for (int w = 1; w < 4; ++w) a4 += *(const LAS f32x4*)(LG + ((w * 256 + t) * 16 + 4 * i));
#pragma unroll
                for (int q = 0; q < 4; ++q) __hip_atomic_store(pp + 4 + 4 * i + q, a4[q], __ATOMIC_RELAXED, __HIP_MEMORY_SCOPE_AGENT); } }
        asm volatile("s_waitcnt vmcnt(0)" ::: "memory");
        __syncthreads();
        LAS int* flag = (LAS int*)(lds + 16384 + 65536);
        if (t == 0) flag[0] = (int)__hip_atomic_fetch_add(tick + u.pm, 1u, __ATOMIC_RELAXED, __HIP_MEMORY_SCOPE_AGENT);
        __syncthreads();
        if (flag[0] == 3) {
            if (t < 256) { const int tok = u.pm * 256 + t; f32x4 s4 = {0.f, 0.f, 0.f, 0.f}, l4[4];
#pragma unroll
                for (int j = 0; j < 4; ++j) l4[j] = (f32x4){0.f, 0.f, 0.f, 0.f};
#pragma unroll
                for (int pn = 0; pn < 4; ++pn) { const float* pq = PART + ((size_t)pn * T + tok) * 20; s4[0] += __hip_atomic_load(pq, __ATOMIC_RELAXED, __HIP_MEMORY_SCOPE_AGENT);
#pragma unroll
                    for (int j = 0; j < 4; ++j)
#pragma unroll
                        for (int q = 0; q < 4; ++q) l4[j][q] += __hip_atomic_load(pq + 4 + 4 * j + q, __ATOMIC_RELAXED, __HIP_MEMORY_SCOPE_AGENT); }
                const float r = rsqrtf(s4[0] * (1.f / D) + 1e-6f); float mx = -1e30f;
#pragma unroll
                for (int j = 0; j < 4; ++j)
#pragma unroll
                    for (int q = 0; q < 4; ++q) { const float v = l4[j][q] * r + br[4 * j + q]; l4[j][q] = v; mx = fmaxf(mx, v); }
                float l = 0.f;
#pragma unroll
                for (int j = 0; j < 4; ++j)
#pragma unroll
                    for (int q = 0; q < 4; ++q) { l4[j][q] = expf(l4[j][q] - mx); l += l4[j][q]; }
                const int b = tok >> 12, s_ = tok & (S - 1);
#pragma unroll
                for (int j = 0; j < 4; ++j)
#pragma unroll
                    for (int q = 0; q < 4; ++q) AFFT[((size_t)b * E + 4 * j + q) * S + s_] = l4[j][q] / l;
                RTOK[tok] = r; } }
        __syncthreads();
    }
};
struct EpiSwiGLU {
    static constexpr bool PERM = true, AFTER_DRAIN = false;
    bf16* HB; const float* RSL;
    __device__ __forceinline__ void operator()(const f32x4 (&acc)[2][2][4][2], const Unit& u, int wr, int wc, int fr, int fq) const {
        const int row0 = u.pm * 256 + wr * 64 + fr, col0 = u.pn * 128 + wc * 32 + 8 * fq;
        float rrv[2][4];
#pragma unroll
        for (int ai = 0; ai < 2; ++ai)
#pragma unroll
            for (int m = 0; m < 4; ++m) rrv[ai][m] = RSL[row0 + ai * 128 + m * 16];
#pragma unroll
        for (int ai = 0; ai < 2; ++ai)
#pragma unroll
            for (int m = 0; m < 4; ++m) { f32x4 h[2]; const float rr = rrv[ai][m];
#pragma unroll
                for (int n = 0; n < 2; ++n) { const f32x4 g = acc[ai][0][m][n] * rr, up = acc[ai][1][m][n] * rr;
#pragma unroll
                    for (int e = 0; e < 4; ++e) h[n][e] = g[e] * fsig(g[e]) * up[e]; }
                *(v4u*)(HB + (size_t)(row0 + ai * 128 + m * 16) * F + col0) = pack8(h[0], h[1]); }
    }
};
struct EpiDown {
    static constexpr bool PERM = true, AFTER_DRAIN = false;
    bf16* YE; const float* gate;
    __device__ __forceinline__ void operator()(const f32x4 (&acc)[2][2][4][2], const Unit& u, int wr, int wc, int fr, int fq) const {
        const int row0 = u.pm * 256 + wr * 64 + fr, col0 = u.pn * 256 + wc * 32 + 8 * fq;
        float gv[2][4];
#pragma unroll
        for (int ai = 0; ai < 2; ++ai)
#pragma unroll
            for (int m = 0; m < 4; ++m) gv[ai][m] = gate[row0 + ai * 128 + m * 16];
#pragma unroll
        for (int ai = 0; ai < 2; ++ai)
#pragma unroll
            for (int m = 0; m < 4; ++m) { const int row = row0 + ai * 128 + m * 16; const float g = gv[ai][m];
#pragma unroll
                for (int bj = 0; bj < 2; ++bj) *(v4u*)(YE + (size_t)row * D + col0 + bj * 128) = pack8(acc[ai][bj][m][0] * g, acc[ai][bj][m][1] * g); }
    }
};
struct OrderMoE1 {
    int G, c;
    __device__ __forceinline__ bool next(int i, Unit& u) const {
        if (MK_SIMPLE_ORDER || G != 256) { const int L = i * G + c; if (L >= 2048) return false; const int e = L >> 7, r = L & 127; u.pm = e * 8 + (r & 7); u.pn = r >> 3; u.pb = e * 16 + u.pn; u.pa = u.pm; return true; }
        if (i >= 8) return false;
        const int ch = i * 8 + (c & 7), j = c >> 3, e = ch >> 2, ng = ch & 3; u.pm = e * 8 + (j & 7); u.pn = ng * 4 + (j >> 3); u.pb = e * 16 + u.pn; u.pa = u.pm; return true;
    }
    __device__ __forceinline__ void a_ready(const Unit&) const {}
    __device__ __forceinline__ void done(const Unit&) const {}
};
struct OrderMoE2 {
    int G, c;
    __device__ __forceinline__ bool next(int i, Unit& u) const {
        if (MK_SIMPLE_ORDER || G != 256) { const int L = i * G + c; if (L >= 512) return false; const int e = L >> 5, r = L & 31; u.pm = e * 8 + (r & 7); u.pn = r >> 3; u.pb = e * 4 + u.pn; u.pa = u.pm; return true; }
        if (i >= 2) return false;
        const int e = i * 8 + (c & 7), j = c >> 3; u.pm = e * 8 + (j & 7); u.pn = j >> 3; u.pb = e * 4 + u.pn; u.pa = u.pm; return true;
    }
    __device__ __forceinline__ void a_ready(const Unit&) const {}
    __device__ __forceinline__ void done(const Unit&) const {}
};

__device__ __forceinline__ void p6_topk(const Ctx& X) {
    const float* afft = (const float*)(X.ws + WS_AFFT); const float* rtok = (const float*)(X.ws + WS_RTOK); int* rows = (int*)(X.ws + WS_ROWS); float* gate = (float*)(X.ws + WS_GATE); float* rsl = (float*)(X.ws + WS_RSL); int* inv = (int*)(X.ws + WS_INV);
    for (int p = X.bid; p < B * E; p += X.G) { const int b = p >> 4, e = p & 15, slotbase = e * 2048 + b * 512;
        unsigned key[8]; float rr[8];
        { const uint4 k0 = ((const uint4*)(afft + (size_t)p * S))[X.tid * 2], k1 = ((const uint4*)(afft + (size_t)p * S))[X.tid * 2 + 1]; const f32x4 r0 = ((const f32x4*)(rtok + b * S))[X.tid * 2], r1 = ((const f32x4*)(rtok + b * S))[X.tid * 2 + 1];
          key[0] = k0.x; key[1] = k0.y; key[2] = k0.z; key[3] = k0.w; key[4] = k1.x; key[5] = k1.y; key[6] = k1.z; key[7] = k1.w;
          rr[0] = r0[0]; rr[1] = r0[1]; rr[2] = r0[2]; rr[3] = r0[3]; rr[4] = r1[0]; rr[5] = r1[1]; rr[6] = r1[2]; rr[7] = r1[3]; }
        tk::topk_problem(key, rr, b * S, e, slotbase, rows + slotbase, gate + slotbase, rsl + slotbase, inv, (int*)(X.lds), X.tid); }
}
__device__ __forceinline__ void p9_combine(const Ctx& X, float* Xr, const float* __restrict__ g, bool final_, float* __restrict__ out) {
    const int* inv = (const int*)(X.ws + WS_INV); const bf16* YE = (const bf16*)(X.ws + WS_YE); bf16* XN = (bf16*)(X.ws + WS_XN); const int lane = X.lane;
    Row8 gg; row8_load(gg, g, lane);
    int tok = X.gw; Row8 cur; int myinv = -1;
    if (tok < T) { row8_load(cur, Xr + (size_t)tok * D, lane); if (lane < 16) myinv = inv[(size_t)tok * E + lane]; }
    while (tok < T) {
        const int ntok = tok + X.ngw; Row8 nxt; int ninv = -1;
        if (ntok < T) { row8_load(nxt, Xr + (size_t)ntok * D, lane); if (lane < 16) ninv = inv[(size_t)ntok * E + lane]; }
        unsigned long long m = __ballot(myinv >= 0);
        while (m) {
            int sl[4];
#pragma unroll
            for (int i = 0; i < 4; ++i) { if (m) { const int e = __builtin_ctzll(m); m &= m - 1; sl[i] = __builtin_amdgcn_readlane(myinv, e); } else sl[i] = -1; }
            v4u y[4][2];
#pragma unroll
            for (int i = 0; i < 4; ++i) if (sl[i] >= 0) { const v4u* yp = (const v4u*)(YE + (size_t)sl[i] * D); y[i][0] = __builtin_nontemporal_load(yp + lane); y[i][1] = __builtin_nontemporal_load(yp + lane + 64); }
#pragma unroll
            for (int i = 0; i < 4; ++i) if (sl[i] >= 0) {
#pragma unroll
                for (int j = 0; j < 2; ++j) { f32x4 p, q; unpack8(y[i][j], p, q); cur.a[j][0] += p; cur.a[j][1] += q; } }
        }
        const float r = rsqrtf(wave_sum(row8_sumsq(cur)) * (1.f / D) + 1e-6f);
        if (final_) {
#pragma unroll
            for (int j = 0; j < 2; ++j)
#pragma unroll
                for (int h = 0; h < 2; ++h) ((f32x4*)(out + (size_t)tok * D))[2 * (lane + 64 * j) + h] = cur.a[j][h] * gg.a[j][h] * r;
        } else {
#pragma unroll
            for (int j = 0; j < 2; ++j) {
#pragma unroll
                for (int h = 0; h < 2; ++h) ((f32x4*)(Xr + (size_t)tok * D))[2 * (lane + 64 * j) + h] = cur.a[j][h];
                const f32x4 y0 = cur.a[j][0] * gg.a[j][0] * r, y1 = cur.a[j][1] * gg.a[j][1] * r;
                v4u w; w.x = pk2(y0.x, y0.y); w.y = pk2(y0.z, y0.w); w.z = pk2(y1.x, y1.y); w.w = pk2(y1.z, y1.w);
                ((v4u*)(XN + (size_t)tok * D))[lane + 64 * j] = w; }
        }
        cur = nxt; myinv = ninv; tok = ntok;
    }
}
}
namespace mk {
__device__ __forceinline__ void p1t_shortconv(const Ctx& X, const float* __restrict__ cw, const float* __restrict__ cb) {
    const bf16* U = (const bf16*)(X.ws + WS_U); bf16* UCT = (bf16*)(X.ws + WS_UCT);
    LAS float* raw = (LAS float*)(X.lds + X.wave * 17408);
    const int lane = X.lane, rq = lane >> 3, cq = lane & 7;
    constexpr int NIT = (T / 64) * 24;
    v4u w[9];
#define P1T_LOAD(it_) do { const int tt_ = (it_) / 24, cg_ = (it_) - tt_ * 24, tok0_ = tt_ * 64, tin_ = tok0_ & (S - 1); \
        _Pragma("unroll") for (int i = 0; i < 9; ++i) { const int r = 8 * i + rq, tpos = tin_ + r - 1; w[i] = (v4u){0u, 0u, 0u, 0u}; \
            if (r < 66 && tpos >= 0 && tpos < S) w[i] = *(const v4u*)(U + (size_t)(tok0_ + r - 1) * 1536 + cg_ * 64 + 8 * cq); } } while (0)
    int it = X.gw;
    if (it < NIT) P1T_LOAD(it);
    while (it < NIT) {
        const int tt = it / 24, cg = it - tt * 24, tok0 = tt * 64, ch0 = cg * 64;
#pragma unroll
        for (int i = 0; i < 9; ++i) { const int r = 8 * i + rq; if (r < 66) { LAS float* d = raw + r * 65 + 8 * cq; f32x4 p, q; unpack8(w[i], p, q);
            d[0] = p.x; d[1] = p.y; d[2] = p.z; d[3] = p.w; d[4] = q.x; d[5] = q.y; d[6] = q.z; d[7] = q.w; } }
        const int nit = it + X.ngw;
        if (nit < NIT) P1T_LOAD(nit);
        asm volatile("s_waitcnt lgkmcnt(0)" ::: "memory");
        const int chs = lane >> 3, tch = lane & 7;
#pragma unroll
        for (int g = 0; g < 8; ++g) { const int ch = 8 * g + chs, gc = ch0 + ch; const float w0 = cw[gc], w1 = cw[1536 + gc], w2 = cw[3072 + gc], bb = cb[gc];
            float v[10];
#pragma unroll
            for (int k = 0; k < 10; ++k) v[k] = raw[(8 * tch + k) * 65 + ch];
            float o[8];
#pragma unroll
            for (int k = 0; k < 8; ++k) o[k] = v[k] * w0 + v[k + 1] * w1 + v[k + 2] * w2 + bb;
            v4u pk; pk.x = pk2(o[0], o[1]); pk.y = pk2(o[2], o[3]); pk.z = pk2(o[4], o[5]); pk.w = pk2(o[6], o[7]);
            *(v4u*)(UCT + (size_t)gc * T + tok0 + 8 * tch) = pk; }
        asm volatile("s_waitcnt lgkmcnt(0)" ::: "memory");
        it = nit;
    }
#undef P1T_LOAD
}

__device__ __forceinline__ void p1t_kmax(const Ctx& X, unsigned* kmax2) {
    const bf16* K = (const bf16*)(X.ws + WS_K); const int lane = X.lane; LAS float* red = (LAS float*)(X.lds + 8 * 17408);
    const int b = X.gw / 512, t0 = X.gw % 512; float mx = 0.f;
    if (b < B) {
        v4u w[8];
#pragma unroll
        for (int i = 0; i < 8; ++i) w[i] = ((const v4u*)(K + ((size_t)b * S + t0 + 512 * i) * 512))[lane];
#pragma unroll
        for (int i = 0; i < 8; ++i) { f32x4 p, q; unpack8(w[i], p, q); float ss = (p.x * p.x + p.y * p.y) + (p.z * p.z + p.w * p.w) + (q.x * q.x + q.y * q.y) + (q.z * q.z + q.w * q.w);
            ss += xor_f<1>(ss); ss += xor_f<2>(ss); ss += xor_f<4>(ss); mx = fmaxf(mx, ss); }
    }
    __syncthreads();
    if ((lane & 7) == 0) red[X.wave * 8 + (lane >> 3)] = mx;
    __syncthreads();
    if (X.tid < 8 && b < B) { float m = red[X.tid]; for (int w_ = 1; w_ < 8; ++w_) m = fmaxf(m, red[w_ * 8 + X.tid]); atomicMax(kmax2 + b * 8 + X.tid, __float_as_uint(m)); }
}

namespace at {
constexpr int KVBLK = 64, LDK = 512;
constexpr int KPITCH = 272;
constexpr int SHM_V = 64 * 128 * 2, SHM_K = 64 * KPITCH;
constexpr int OFF_V = 0, OFF_K = 2 * SHM_V, OFF_Q = OFF_K + 2 * SHM_K, OFF_WS = OFF_Q + 256 * KPITCH, LDS_TOTAL = OFF_WS + 8 * 160 * 4;
constexpr float THR2 = 8.0f * 1.4426950408889634f;
#define KSWZ(row, colB) ((row) * KPITCH + (colB))
#define SBAR() __builtin_amdgcn_sched_barrier(0)
__device__ __forceinline__ int crow(int r, int hi) { return (r & 3) + 8 * (r >> 2) + 4 * hi; }
__device__ __forceinline__ int v_st(int k, int c) { const int kk = (k & ~0xC) | ((k & 4) << 1) | ((k & 8) >> 1); return ((kk >> 3) * 4 + (c >> 5)) * 512 + ((kk & 7) * 32 + (c & 31)) * 2; }
__device__ __forceinline__ int v_rd_base(int lane) { return ((lane & 3) << 3) | (((lane >> 2) & 3) << 6) | (((lane >> 4) & 1) << 5) | (((lane >> 5) & 1) << 8); }
constexpr int v_rd_off(int d0, int ks, int half) { return d0 * 512 + ks * 4096 + half * 2048; }
template <int OFF> __device__ __forceinline__ s16x4 tr_read(int vb) { s16x4 r; asm volatile("ds_read_b64_tr_b16 %0, %1 offset:%2" : "=&v"(r) : "v"(vb), "i"(OFF) : "memory"); return r; }

template <int CO> __device__ __forceinline__ void qkt(f32x16& p0, f32x16& p1, const char* Ks, const char* Qs, int qrow, int r32, int hi) {
    p0 = f32x16{}; p1 = f32x16{};
    const char* qp = Qs + KSWZ(qrow, (CO * 64 + hi * 8) * 2); const char* kp = Ks + KSWZ(r32, (CO * 64 + hi * 8) * 2);
#pragma unroll
    for (int d0 = 0; d0 < 4; ++d0) {
        const bf16x8 qf = *reinterpret_cast<const bf16x8*>(qp + d0 * 32);
        const bf16x8 b0 = *reinterpret_cast<const bf16x8*>(kp + d0 * 32);
        const bf16x8 b1 = *reinterpret_cast<const bf16x8*>(kp + 32 * KPITCH + d0 * 32);
        p0 = __builtin_amdgcn_mfma_f32_32x32x16_bf16(b0, qf, p0, 0, 0, 0);
        p1 = __builtin_amdgcn_mfma_f32_32x32x16_bf16(b1, qf, p1, 0, 0, 0);
        if (d0 == 1) asm volatile("" ::: "memory"); }
}
__device__ __forceinline__ void softmax_tile(f32x16& p0, f32x16& p1, float& m_reg, float& l_reg, float& alpha, bf16x8& pa0, bf16x8& pa1, bf16x8& pa2, bf16x8& pa3) {
    float pmax = p0[0];
#pragma unroll
    for (int r = 1; r < 16; ++r) pmax = fmaxf(pmax, p0[r]);
#pragma unroll
    for (int r = 0; r < 16; ++r) pmax = fmaxf(pmax, p1[r]);
    { auto rr = __builtin_amdgcn_permlane32_swap(__float_as_uint(pmax), __float_as_uint(pmax), false, false); pmax = fmaxf(__uint_as_float(rr[0]), __uint_as_float(rr[1])); }
    float mn;
    if (__builtin_expect(__all(pmax - m_reg <= THR2), 1)) { mn = m_reg; alpha = 1.f; }
    else { mn = fmaxf(m_reg, pmax); alpha = __builtin_amdgcn_exp2f(m_reg - mn); m_reg = mn; }
#pragma unroll
    for (int r = 0; r < 16; ++r) { p0[r] = __builtin_amdgcn_exp2f(p0[r] - mn); p1[r] = __builtin_amdgcn_exp2f(p1[r] - mn); }
    float ps = 0.f;
#pragma unroll
    for (int r = 0; r < 16; ++r) ps += p0[r];
#pragma unroll
    for (int r = 0; r < 16; ++r) ps += p1[r];
    { auto rr = __builtin_amdgcn_permlane32_swap(__float_as_uint(ps), __float_as_uint(ps), false, false); ps = __uint_as_float(rr[0]) + __uint_as_float(rr[1]); }
    l_reg = l_reg * alpha + ps;
#define PK4(P, BASE, OUT) do { unsigned a0 = cvtpk(P[BASE + 0], P[BASE + 1]), a1 = cvtpk(P[BASE + 2], P[BASE + 3]);   \
    unsigned b0 = cvtpk(P[BASE + 4], P[BASE + 5]), b1 = cvtpk(P[BASE + 6], P[BASE + 7]);                              \
    auto r0 = __builtin_amdgcn_permlane32_swap(a0, b0, false, false); auto r1 = __builtin_amdgcn_permlane32_swap(a1, b1, false, false); \
    v4u w = {r0[0], r1[0], r0[1], r1[1]}; OUT = *reinterpret_cast<bf16x8*>(&w); } while (0)
    PK4(p0, 0, pa0); PK4(p0, 8, pa1); PK4(p1, 0, pa2); PK4(p1, 8, pa3);
#undef PK4
}
__device__ __forceinline__ void softmax_fixed(f32x16& p0, f32x16& p1, float m, float& l_half, bf16x8& pa0, bf16x8& pa1, bf16x8& pa2, bf16x8& pa3) {
#pragma unroll
    for (int r = 0; r < 16; ++r) { p0[r] = __builtin_amdgcn_exp2f(p0[r] - m); p1[r] = __builtin_amdgcn_exp2f(p1[r] - m); }
    float ps = 0.f;
#pragma unroll
    for (int r = 0; r < 16; ++r) ps += p0[r] + p1[r];
    l_half += ps;
#define PK4(P, BASE, OUT) do { unsigned a0 = cvtpk(P[BASE + 0], P[BASE + 1]), a1 = cvtpk(P[BASE + 2], P[BASE + 3]);   \
    unsigned b0 = cvtpk(P[BASE + 4], P[BASE + 5]), b1 = cvtpk(P[BASE + 6], P[BASE + 7]);                              \
    auto r0 = __builtin_amdgcn_permlane32_swap(a0, b0, false, false); auto r1 = __builtin_amdgcn_permlane32_swap(a1, b1, false, false); \
    v4u w = {r0[0], r1[0], r0[1], r1[1]}; OUT = *reinterpret_cast<bf16x8*>(&w); } while (0)
    PK4(p0, 0, pa0); PK4(p0, 8, pa1); PK4(p1, 0, pa2); PK4(p1, 8, pa3);
#undef PK4
}
template <int D0> __device__ __forceinline__ void pv_one(f32x16& oa, int vb, const bf16x8 (&pa)[4]) {
#define PK(L, H) (bf16x8){L[0], L[1], L[2], L[3], H[0], H[1], H[2], H[3]}
    {   const s16x4 l0 = tr_read<v_rd_off(D0, 0, 0)>(vb), h0 = tr_read<v_rd_off(D0, 0, 1)>(vb), l1 = tr_read<v_rd_off(D0, 1, 0)>(vb), h1 = tr_read<v_rd_off(D0, 1, 1)>(vb);
        asm volatile("s_waitcnt lgkmcnt(0)" ::: "memory"); SBAR();
        oa = __builtin_amdgcn_mfma_f32_32x32x16_bf16(pa[0], PK(l0, h0), oa, 0, 0, 0);
        oa = __builtin_amdgcn_mfma_f32_32x32x16_bf16(pa[1], PK(l1, h1), oa, 0, 0, 0); }
    {   const s16x4 l2 = tr_read<v_rd_off(D0, 2, 0)>(vb), h2 = tr_read<v_rd_off(D0, 2, 1)>(vb), l3 = tr_read<v_rd_off(D0, 3, 0)>(vb), h3 = tr_read<v_rd_off(D0, 3, 1)>(vb);
        asm volatile("s_waitcnt lgkmcnt(0)" ::: "memory"); SBAR();
        oa = __builtin_amdgcn_mfma_f32_32x32x16_bf16(pa[2], PK(l2, h2), oa, 0, 0, 0);
        oa = __builtin_amdgcn_mfma_f32_32x32x16_bf16(pa[3], PK(l3, h3), oa, 0, 0, 0); }
#undef PK
}
template <int D0> __device__ __forceinline__ void pv_two(f32x16& oa, f32x16& ob, int vb, const bf16x8 (&pa)[4], const bf16x8 (&pb)[4]) {
#define PK(L, H) (bf16x8){L[0], L[1], L[2], L[3], H[0], H[1], H[2], H[3]}
    {   const s16x4 l0 = tr_read<v_rd_off(D0, 0, 0)>(vb), h0 = tr_read<v_rd_off(D0, 0, 1)>(vb), l1 = tr_read<v_rd_off(D0, 1, 0)>(vb), h1 = tr_read<v_rd_off(D0, 1, 1)>(vb);
        asm volatile("s_waitcnt lgkmcnt(0)" ::: "memory"); SBAR();
        const bf16x8 v0 = PK(l0, h0), v1 = PK(l1, h1);
        oa = __builtin_amdgcn_mfma_f32_32x32x16_bf16(pa[0], v0, oa, 0, 0, 0); ob = __builtin_amdgcn_mfma_f32_32x32x16_bf16(pb[0], v0, ob, 0, 0, 0);
        oa = __builtin_amdgcn_mfma_f32_32x32x16_bf16(pa[1], v1, oa, 0, 0, 0); ob = __builtin_amdgcn_mfma_f32_32x32x16_bf16(pb[1], v1, ob, 0, 0, 0); }
    {   const s16x4 l2 = tr_read<v_rd_off(D0, 2, 0)>(vb), h2 = tr_read<v_rd_off(D0, 2, 1)>(vb), l3 = tr_read<v_rd_off(D0, 3, 0)>(vb), h3 = tr_read<v_rd_off(D0, 3, 1)>(vb);
        asm volatile("s_waitcnt lgkmcnt(0)" ::: "memory"); SBAR();
        const bf16x8 v2 = PK(l2, h2), v3 = PK(l3, h3);
        oa = __builtin_amdgcn_mfma_f32_32x32x16_bf16(pa[2], v2, oa, 0, 0, 0); ob = __builtin_amdgcn_mfma_f32_32x32x16_bf16(pb[2], v2, ob, 0, 0, 0);
        oa = __builtin_amdgcn_mfma_f32_32x32x16_bf16(pa[3], v3, oa, 0, 0, 0); ob = __builtin_amdgcn_mfma_f32_32x32x16_bf16(pb[3], v3, ob, 0, 0, 0); }
#undef PK
}
__device__ __forceinline__ void rescale(f32x16 (&o)[4], float al, float* wsf, int r32, int hi) {
    if (__any(al < 1.f)) {
        if (hi == 0) wsf[r32] = al; asm volatile("s_waitcnt lgkmcnt(0)" ::: "memory");
#pragma unroll
        for (int r = 0; r < 16; ++r) { const float a = wsf[crow(r, hi)];
#pragma unroll
            for (int d = 0; d < 4; ++d) o[d][r] *= a; }
    }
}

__device__ __forceinline__ void epilogue(const Ctx& X, f32x16 (&oa)[4], f32x16 (&ob)[4], const float* wsf, int r32, int hi, int b, int h, int qb, float lam, float mul, const float* __restrict__ sg) {
    bf16* Yw = (bf16*)(X.ws + WS_YA) + ((size_t)b * S + qb * 256 + X.wave * 32) * 512 + h * 128;
    float gcol[4];
#pragma unroll
    for (int d = 0; d < 4; ++d) gcol[d] = sg[d * 32 + r32] * mul;
#pragma unroll
    for (int r = 0; r < 16; ++r) { const int orow = crow(r, hi); const float i0 = __builtin_amdgcn_rcpf(wsf[orow] + wsf[64 + orow]), i1 = lam * __builtin_amdgcn_rcpf(wsf[32 + orow] + wsf[96 + orow]);
        float v[4], ss = 0.f;
#pragma unroll
        for (int d = 0; d < 4; ++d) { v[d] = oa[d][r] * i0 - ob[d][r] * i1; ss += v[d] * v[d]; }
        ss += xor_f<1>(ss); ss += xor_f<2>(ss); ss += xor_f<4>(ss); ss += xor_f<8>(ss); ss += xor_f<16>(ss);
        const float rn = rsqrtf(ss * (1.f / 128.f) + 1e-5f);
#pragma unroll
        for (int d = 0; d < 4; ++d) Yw[(size_t)orow * 512 + d * 32 + r32] = (bf16)f2bf(v[d] * rn * gcol[d]); }
}
__device__ __forceinline__ int vkey(int T_, int lane) { const int kk = ((T_ >> 2) << 3) | ((lane & 31) >> 2); return (kk & ~0xC) | ((kk & 4) << 1) | ((kk & 8) >> 1); }
__device__ __forceinline__ int vcol(int T_, int lane) { return (T_ & 3) * 32 + (lane & 3) * 8; }
__device__ __forceinline__ void attn_unit(const Ctx& X, int b, int h, int qb, float lam, float mul, const float* __restrict__ sg, unsigned* kmax2) {
    char* lds = (char*)X.lds;
    const int tid = fresh_tid(X.wave_s);
    const int wid = X.wave, lane = tid & 63, r32 = lane & 31, hi = lane >> 5;
    const bf16* Qg = (const bf16*)(X.ws + WS_Q) + ((size_t)b * S + qb * 256) * LDK + h * 128;
    const bf16* Kh = (const bf16*)(X.ws + WS_K) + (size_t)b * S * LDK + h * 128;
    const bf16* Vh = (const bf16*)(X.ws + WS_V) + (size_t)b * S * LDK + h * 128;
    char* V_lds = lds + OFF_V; char* K_lds = lds + OFF_K; char* Q_lds = lds + OFF_Q;
    float* wsf = (float*)(lds + OFF_WS) + wid * 160;
    const int sr = tid >> 4, sc = (tid & 15) * 8, vst0 = v_st(sr, sc), vst1 = v_st(32 + sr, sc);
    const int vb0 = (int)(uintptr_t)V_lds + v_rd_base(lane);
#pragma unroll
    for (int i = 0; i < 8; ++i) { const int row = sr + 32 * i; *(bf16x8*)(Q_lds + KSWZ(row, sc * 2)) = *reinterpret_cast<const bf16x8*>(Qg + (size_t)row * LDK + sc); }
    bf16x8 st0, st1;
    const unsigned goff = (unsigned)(sr * LDK + sc) * 2u;
#define KLOAD(k0) do { const char* t_ = (const char*)Kh + (size_t)(k0) * (LDK * 2); st0 = *reinterpret_cast<const bf16x8*>(t_ + goff); st1 = *reinterpret_cast<const bf16x8*>(t_ + 32 * LDK * 2 + goff); } while (0)
#define VLOAD(k0) do { const char* t_ = (const char*)Vh + (size_t)(k0) * (LDK * 2); st0 = *reinterpret_cast<const bf16x8*>(t_ + goff); st1 = *reinterpret_cast<const bf16x8*>(t_ + 32 * LDK * 2 + goff); } while (0)
#define KWRITE(bb) do { *(bf16x8*)(K_lds + (bb) * SHM_K + KSWZ(sr, sc * 2)) = st0; *(bf16x8*)(K_lds + (bb) * SHM_K + KSWZ(32 + sr, sc * 2)) = st1; } while (0)
    const unsigned vsrc0 = (unsigned)(vkey(2 * wid + (lane >> 5), lane) * LDK + vcol(2 * wid + (lane >> 5), lane)) * 2u, vsrc1 = (unsigned)(vkey(2 * (wid + 8) + (lane >> 5), lane) * LDK + vcol(2 * (wid + 8) + (lane >> 5), lane)) * 2u;
#define VDMA(k0, bbn) do { const char* t_ = (const char*)Vh + (size_t)(k0) * (LDK * 2); LAS unsigned char* d_ = X.lds + OFF_V + (bbn) * SHM_V + wid * 1024; \
    __builtin_amdgcn_global_load_lds((const unsigned*)(t_ + vsrc0), (LAS unsigned*)d_, 16, 0, 0); __builtin_amdgcn_global_load_lds((const unsigned*)(t_ + vsrc1), (LAS unsigned*)(d_ + 8192), 16, 0, 0); } while (0)
    const unsigned ksrc = (unsigned)(wid * 8 * LDK * 2) + (unsigned)lane * 4u;
#define KDMA(k0, bbn) do { const char* t_ = (const char*)Kh + (size_t)(k0) * (LDK * 2) + ksrc; LAS unsigned char* d_ = X.lds + OFF_K + (bbn) * SHM_K + wid * 8 * KPITCH; \
    _Pragma("unroll") for (int i_ = 0; i_ < 8; ++i_) __builtin_amdgcn_global_load_lds((const unsigned*)(t_ + i_ * (LDK * 2)), (LAS unsigned*)(d_ + i_ * KPITCH), 4, 0, 0); } while (0)
#define VWRITE(bb) do { *(bf16x8*)(V_lds + (bb) * SHM_V + vst0) = st0; *(bf16x8*)(V_lds + (bb) * SHM_V + vst1) = st1; } while (0)
    float l0 = 0.f, l1 = 0.f; f32x16 oa[4] = {}, ob[4] = {};
    const int qrow = wid * 32 + r32; constexpr int NT = S / KVBLK;
    KDMA(0, 0); VDMA(0, 0); __syncthreads();
    float m0, m1;
    { float s0 = 0.f, s1 = 0.f;
#pragma unroll
      for (int d0 = 0; d0 < 8; ++d0) { const v4u w = *reinterpret_cast<const v4u*>(Q_lds + KSWZ(qrow, (d0 * 16 + hi * 8) * 2)); f32x4 p, q; unpack8(w, p, q);
          const float ss = (p.x * p.x + p.y * p.y) + (p.z * p.z + p.w * p.w) + (q.x * q.x + q.y * q.y) + (q.z * q.z + q.w * q.w); if (d0 < 4) s0 += ss; else s1 += ss; }
      wsf[hi * 64 + r32] = s0; wsf[hi * 64 + 32 + r32] = s1; asm volatile("s_waitcnt lgkmcnt(0)" ::: "memory");
      s0 += wsf[(hi ^ 1) * 64 + r32]; s1 += wsf[(hi ^ 1) * 64 + 32 + r32]; asm volatile("s_waitcnt lgkmcnt(0)" ::: "memory");
      const float k0 = __uint_as_float(__hip_atomic_load(kmax2 + b * 8 + h * 2, __ATOMIC_RELAXED, __HIP_MEMORY_SCOPE_AGENT)), k1 = __uint_as_float(__hip_atomic_load(kmax2 + b * 8 + h * 2 + 1, __ATOMIC_RELAXED, __HIP_MEMORY_SCOPE_AGENT));
      m0 = sqrtf(s0 * k0) * 1.001f + 1e-3f; m1 = sqrtf(s1 * k1) * 1.001f + 1e-3f; }
    for (int j = 0; j < NT; ++j) {
        const int bb = j & 1; const char* Ks = K_lds + bb * SHM_K;
        const int kn = (j + 1) * KVBLK;
        if (j + 1 < NT) { KDMA(kn, bb ^ 1); VDMA(kn, bb ^ 1); }
        const int vb = vb0 + bb * SHM_V;
        bf16x8 pa[4], pb[4];
        { f32x16 p0, p1, q0, q1;
          qkt<0>(p0, p1, Ks, Q_lds, qrow, r32, hi); qkt<1>(q0, q1, Ks, Q_lds, qrow, r32, hi);
          softmax_fixed(p0, p1, m0, l0, pa[0], pa[1], pa[2], pa[3]);
          softmax_fixed(q0, q1, m1, l1, pb[0], pb[1], pb[2], pb[3]); }
        SBAR();
        pv_two<0>(oa[0], ob[0], vb, pa, pb); pv_two<1>(oa[1], ob[1], vb, pa, pb); pv_two<2>(oa[2], ob[2], vb, pa, pb); pv_two<3>(oa[3], ob[3], vb, pa, pb);
        __syncthreads();
    }
#undef KLOAD
#undef VLOAD
#undef VDMA
#undef KDMA
#undef KWRITE
#undef VWRITE
    wsf[hi * 64 + r32] = l0; wsf[hi * 64 + 32 + r32] = l1; asm volatile("s_waitcnt lgkmcnt(0)" ::: "memory");
    { const int t2 = fresh_tid(X.wave_s); epilogue(X, oa, ob, wsf, t2 & 31, (t2 & 63) >> 5, b, h, qb, lam, mul, sg); }
    __syncthreads();
}
__device__ __forceinline__ void epilogue_unused() {}
#undef KSWZ
#undef SBAR
}
}
namespace mk {
namespace hy {
struct CvSet { int have; f32x4 ld0, ld1, ld2, ld3; float sc; };
struct CvState { int next, stride, nlim, cnt, par; CvSet a, b; };
#define CV_PDECL const float* cwg, const float* cwu, const float* cwd, bf16* ctgu, bf16* ctd, const float* cgn
#define CV_PARGS cwg, cwu, cwd, ctgu, ctd, cgn
constexpr int CV_TILES = 3 * 16 * 2048;
#ifndef CV_EVERY
#define CV_EVERY 5
#endif
__device__ __forceinline__ void cv_issue(CvState& s, CvSet& q, int lane, CV_PDECL) {
    if (s.next < s.nlim) { asm volatile("" : "+v"(lane));
        const int t = s.next, me = t >> 11, rr = t & 2047, mat = me >> 4, e = me & 15;
        const float* W = (mat == 0 ? cwg : (mat == 1 ? cwu : cwd)) + (size_t)e * D * F + rr * 1024 + 4 * lane;
        q.ld0 = __builtin_nontemporal_load((const f32x4*)W); q.ld1 = __builtin_nontemporal_load((const f32x4*)(W + 256)); q.ld2 = __builtin_nontemporal_load((const f32x4*)(W + 512)); q.ld3 = __builtin_nontemporal_load((const f32x4*)(W + 768));
        { const float g_ = cgn[mat < 2 ? (rr >> 1) : 0]; q.sc = mat < 2 ? g_ : 1.f; }
        q.have = t; s.next = t + s.stride; }
    else q.have = -1;
}
__device__ __forceinline__ void cv_finish_set(CvState& s, CvSet& q, int lane, CV_PDECL) {
    const int t = q.have; v2u o0 = {0u, 0u}, o1 = {0u, 0u}, o2 = {0u, 0u}, o3 = {0u, 0u};
    if (t >= 0) { const float sc = q.sc;
        o0.x = cvtpk_(q.ld0[0] * sc, q.ld0[1] * sc); o0.y = cvtpk_(q.ld0[2] * sc, q.ld0[3] * sc); o1.x = cvtpk_(q.ld1[0] * sc, q.ld1[1] * sc); o1.y = cvtpk_(q.ld1[2] * sc, q.ld1[3] * sc);
        o2.x = cvtpk_(q.ld2[0] * sc, q.ld2[1] * sc); o2.y = cvtpk_(q.ld2[2] * sc, q.ld2[3] * sc); o3.x = cvtpk_(q.ld3[0] * sc, q.ld3[1] * sc); o3.y = cvtpk_(q.ld3[2] * sc, q.ld3[3] * sc); }
    cv_issue(s, q, lane, CV_PARGS);
    if (t >= 0) { asm volatile("" : "+v"(lane)); const int me = t >> 11, rr = t & 2047, mat = me >> 4, e = me & 15;
        bf16* dst; int qs;
        if (mat == 2) { dst = ctd + (size_t)e * D * F + rr * 1024 + 4 * lane; qs = 256; }
        else { const int k = rr >> 1, n = (rr & 1) * 1024 + 4 * lane; dst = ctgu + ((size_t)e * D + k) * (2 * F) + 2 * (n & ~127) + (n & 127) + 128 * mat; qs = 512; }
        __builtin_nontemporal_store(o0, (v2u*)dst); __builtin_nontemporal_store(o1, (v2u*)(dst + qs)); __builtin_nontemporal_store(o2, (v2u*)(dst + 2 * qs)); __builtin_nontemporal_store(o3, (v2u*)(dst + 3 * qs)); }
}
__device__ __forceinline__ void cv_finish(CvState& s, int lane, CV_PDECL) { if (s.par) cv_finish_set(s, s.b, lane, CV_PARGS); else cv_finish_set(s, s.a, lane, CV_PARGS); s.par ^= 1; }

constexpr int CPS = 16704;
constexpr int NEL = 8352;
constexpr int OFF_Z = 4 * CPS;
constexpr int ZROW = 144, ZB = 128 * ZROW;
constexpr int LDS_TOTAL = OFF_Z + 4 * ZB;

__device__ __forceinline__ void build_hrev(const Ctx& X, const bf16* hf, const bf16* hb, float bias) {
    const int tid = X.tid;
    if (tid < 4 * 8) { const int m = tid >> 3, e = tid & 7; if (e < 5 - m) *(LAS bf16*)(X.lds + m * CPS + 2 * e) = 0; }
    for (int i = tid; i < 4 * (NEL - 8192); i += NTH) { const int m = i / (NEL - 8192), e = 8192 + (i - m * (NEL - 8192)); if (e > 8195 - m) *(LAS bf16*)(X.lds + m * CPS + 2 * e) = 0; }
#pragma unroll
    for (int half = 0; half < 2; ++half) {
        const v4u w = *(const v4u*)((half ? hb : hf) + 8 * tid);
        unsigned short v[8] = {(unsigned short)(w.x & 0xffff), (unsigned short)(w.x >> 16), (unsigned short)(w.y & 0xffff), (unsigned short)(w.y >> 16), (unsigned short)(w.z & 0xffff), (unsigned short)(w.z >> 16), (unsigned short)(w.w & 0xffff), (unsigned short)(w.w >> 16)};
        if (half == 0 && tid == 0) v[0] = (unsigned short)f2bf(bf2f(v[0]) + bias);
#pragma unroll
        for (int k = 0; k < 8; ++k) { const int d = 8 * tid + k; if (half == 1 && d == 0) continue;
            const int e0 = half ? 4100 + d : 4100 - d;
#pragma unroll
            for (int m = 0; m < 4; ++m) *(LAS bf16*)(X.lds + m * CPS + 2 * (e0 - m)) = v[k]; }
    }
}
#ifdef MK_HY_XLDS
#define HY_XL(qq) do { const v2u x0_ = *(const volatile LAS v2u*)(X.lds + baseA + 32 * (qq)), x1_ = *(const volatile LAS v2u*)(X.lds + baseA8 + 32 * (qq)); asm volatile("" :: "v"(x0_), "v"(x1_)); } while (0)
#else
#define HY_XL(qq) do {} while (0)
#endif
#define HY_LDA(dst, qq) do { HY_XL(qq); const v2u lo_ = *(const volatile LAS v2u*)(X.lds + baseA + 32 * (qq)), hi_ = *(const volatile LAS v2u*)(X.lds + baseA8 + 32 * (qq)); v4u w_ = {lo_.x, lo_.y, hi_.x, hi_.y}; dst = *reinterpret_cast<bf16x8*>(&w_); } while (0)
#define HY_LOAD_E(FA, FB, d1_, q_) do { const LAS unsigned char* zr_ = zb - (d1_) * ZROW; HY_LDA(FA[0], (q_)); HY_LDA(FA[1], (q_) + 1); \
    FB[0] = *(const LAS bf16x8*)(zr_); FB[1] = *(const LAS bf16x8*)(zr_ + 32); FB[2] = *(const LAS bf16x8*)(zr_ + 64); FB[3] = *(const LAS bf16x8*)(zr_ + 96); } while (0)
#define HY_LOAD_L(FA, q_) do { HY_LDA(FA[2], (q_) + 2); HY_LDA(FA[3], (q_) + 3); } while (0)
#ifdef MK_HY_XMFMA
#define HY_XM(A_, B_) do { dacc0 = __builtin_amdgcn_mfma_f32_32x32x16_bf16(A_, B_, dacc0, 0, 0, 0); } while (0)
#else
#define HY_XM(A_, B_) do {} while (0)
#endif
#define HY_MMA1(FA, FB, PA) do { __builtin_amdgcn_s_setprio(1); HY_XM(FA[0], FB[0]); HY_XM(PA[2], FB[0]); HY_XM(FA[1], FB[1]); HY_XM(PA[3], FB[1]); \
    acc0 = __builtin_amdgcn_mfma_f32_32x32x16_bf16(FA[0], FB[0], acc0, 0, 0, 0); acc1 = __builtin_amdgcn_mfma_f32_32x32x16_bf16(PA[2], FB[0], acc1, 0, 0, 0); \
    acc0 = __builtin_amdgcn_mfma_f32_32x32x16_bf16(FA[1], FB[1], acc0, 0, 0, 0); acc1 = __builtin_amdgcn_mfma_f32_32x32x16_bf16(PA[3], FB[1], acc1, 0, 0, 0); __builtin_amdgcn_s_setprio(0); } while (0)
#define HY_MMA2(FA, FB) do { __builtin_amdgcn_s_setprio(1); HY_XM(FA[2], FB[2]); HY_XM(FA[0], FB[2]); HY_XM(FA[3], FB[3]); HY_XM(FA[1], FB[3]); \
    acc0 = __builtin_amdgcn_mfma_f32_32x32x16_bf16(FA[2], FB[2], acc0, 0, 0, 0); acc1 = __builtin_amdgcn_mfma_f32_32x32x16_bf16(FA[0], FB[2], acc1, 0, 0, 0); \
    acc0 = __builtin_amdgcn_mfma_f32_32x32x16_bf16(FA[3], FB[3], acc0, 0, 0, 0); acc1 = __builtin_amdgcn_mfma_f32_32x32x16_bf16(FA[1], FB[3], acc1, 0, 0, 0); __builtin_amdgcn_s_setprio(0); } while (0)
template <int PAIR> __device__ __forceinline__ void channel(const Ctx& X, int l, int c, const float* __restrict__ hyb, CvState& cs, CV_PDECL) {
    const bf16* UCT = (const bf16*)(X.ws + WS_UCT); const bf16* FILT = (const bf16*)(X.ws + WS_FILT) + (size_t)l * 4 * C * S; bf16* YH = (bf16*)(X.ws + WS_YH);
    const int tid = X.tid, lane = X.lane, wid = X.wave, r = lane & 31, h = lane >> 5, b = wid >> 1, jt = wid & 1;
    LAS unsigned char* zl = X.lds + OFF_Z;
    v2u* const stash0 = (v2u*)(X.ws + WS_XN) + (size_t)X.bid * 8 * NTH;
    __syncthreads();
    v4u zero4 = {0u, 0u, 0u, 0u}; asm volatile("" : "+v"(zero4));
    for (int i = tid; i < 4 * 64 * 9; i += NTH) { const int bb = i / 576, rr = (i % 576) / 9, ch = i % 9; const int row = rr < 32 ? rr : 64 + rr;
        *(LAS v4u*)(zl + bb * ZB + row * ZROW + ch * 16) = zero4; }
    for (int i = tid; i < 4 * 64 * 8; i += NTH) { const int bb = i >> 9, s1 = (i >> 3) & 63, ch = i & 7;
        *(LAS v4u*)(zl + bb * ZB + (32 + s1) * ZROW + ch * 16) = *(const v4u*)(UCT + (size_t)c * T + bb * S + s1 * 64 + ch * 8); }
    const int m4 = (4 - (r & 3)) & 3;
    const int baseA = m4 * CPS + 2 * (8 * h - r + 4100 - m4);
    int baseA8 = baseA + 8; asm volatile("" : "+v"(baseA8));
    for (int o = 0; o < 2; ++o) {
        build_hrev(X, FILT + ((size_t)(2 * o) * C + c) * S, FILT + ((size_t)(2 * o + 1) * C + c) * S, hyb[(l * 2 + o) * C + c]);
#ifdef MK_HY_DUPBUILD
        asm volatile("" ::: "memory"); build_hrev(X, FILT + ((size_t)(2 * o) * C + c) * S, FILT + ((size_t)(2 * o + 1) * C + c) * S, hyb[(l * 2 + o) * C + c]);
#endif
        const bf16* gate = UCT + (size_t)((o + 1) * C + c) * T + (size_t)b * S;
        const int t1 = 32 * jt + r;
        __syncthreads();
#ifndef MK_HY_SWEEPS
#define MK_HY_SWEEPS 1
#endif
        f32x16 acc0 = {}, acc1 = {};
#ifdef MK_HY_XMFMA
        f32x16 dacc0 = {};
#endif
        for (int rep = 0; rep < MK_HY_SWEEPS; ++rep) {
        const int d1max = 32 * jt + 31; int q = -4 * d1max;
        const LAS unsigned char* zb = zl + b * ZB + (32 + 32 * jt + r) * ZROW + 16 * h;
        bf16x8 fa0[4], fb0[4], fa1[4], fb1[4];
        HY_LDA(fa1[2], q - 2); HY_LDA(fa1[3], q - 1);
        HY_LOAD_E(fa0, fb0, d1max, q); HY_LOAD_L(fa0, q);
        int d1 = d1max;
        for (int it = 0; it < 47; ++it) {
            HY_LOAD_E(fa1, fb1, d1 - 1, q + 4);
            HY_MMA1(fa0, fb0, fa1);
            HY_LOAD_L(fa1, q + 4);
            HY_MMA2(fa0, fb0);
            HY_LOAD_E(fa0, fb0, d1 - 2, q + 8);
            HY_MMA1(fa1, fb1, fa0);
            HY_LOAD_L(fa0, q + 8);
            HY_MMA2(fa1, fb1);
            d1 -= 2; q += 8;
            if (++cs.cnt == CV_EVERY) { cs.cnt = 0; cv_finish(cs, lane, CV_PARGS); }
        }
        HY_MMA1(fa0, fb0, fa1); HY_MMA2(fa0, fb0);
        }
        if (MK_HY_SWEEPS == 2) { acc0 *= 0.5f; acc1 *= 0.5f; }
#ifdef MK_HY_XMFMA
        asm volatile("" :: "v"(dacc0));
#endif
        asm volatile("" ::: "memory");
        v2u gw[2][4];
#pragma unroll
        for (int mt = 0; mt < 2; ++mt)
#pragma unroll
            for (int g = 0; g < 4; ++g) gw[mt][g] = *(const v2u*)(gate + t1 * 64 + 32 * mt + 8 * g + 4 * h);
        v2u kpv[2][4]; v2u* stash;
        { int st = tid * 8; asm volatile("" : "+v"(st)); stash = stash0 + st; }
        if (PAIR == 1 && o == 1) {
#pragma unroll
            for (int i = 0; i < 4; ++i) { const v4u w = ((const v4u*)stash)[i]; kpv[i >> 1][2 * (i & 1)] = v2u{w.x, w.y}; kpv[i >> 1][2 * (i & 1) + 1] = v2u{w.z, w.w}; } }
        __syncthreads();
#pragma unroll
        for (int mt = 0; mt < 2; ++mt)
#pragma unroll
            for (int g = 0; g < 4; ++g) { const int t0 = 32 * mt + 8 * g + 4 * h; const v2u gwv = gw[mt][g];
                const f32x16& a = mt ? acc1 : acc0;
                const float y0 = a[4 * g] * bflo(gwv.x), y1 = a[4 * g + 1] * bfhi(gwv.x), y2 = a[4 * g + 2] * bflo(gwv.y), y3 = a[4 * g + 3] * bfhi(gwv.y);
                if (o == 0) { v2u w; w.x = pk2(y0, y1); w.y = pk2(y2, y3); *(LAS v2u*)(zl + b * ZB + (32 + t1) * ZROW + t0 * 2) = w; }
                else if (PAIR == 0) { v2u w; w.x = pk2(y0, y1); w.y = pk2(y2, y3); stash[mt * 4 + g] = w; }
                else { unsigned* yo = (unsigned*)(YH + ((size_t)b * S + t1 * 64 + t0) * C + (c - 1)); const v2u kp = kpv[mt][g];
                    yo[0] = (kp.x & 0xffffu) | (f2bf(y0) << 16); yo[C / 2] = (kp.x >> 16) | (f2bf(y1) << 16); yo[C] = (kp.y & 0xffffu) | (f2bf(y2) << 16); yo[3 * C / 2] = (kp.y >> 16) | (f2bf(y3) << 16); } }
    }
    __syncthreads();
}
#undef HY_LDA
#undef HY_LOAD_E
#undef HY_LOAD_L
#undef HY_MMA1
#undef HY_MMA2
}
}
namespace mk {
#define GAS __attribute__((address_space(1)))
typedef GAS unsigned gu32;
typedef GAS unsigned long long gu64;
#define RLX_AGENT __ATOMIC_RELAXED, __HIP_MEMORY_SCOPE_AGENT
#define LDS_WAIT() asm volatile("s_waitcnt lgkmcnt(0)" ::: "memory")
#define VM_WAIT() asm volatile("s_waitcnt vmcnt(0)" ::: "memory")
__device__ __forceinline__ unsigned long long rt() { return __builtin_amdgcn_s_memrealtime(); }
#define XB_TMO      128
#define XB_XCNT(j)  (256  + 64 * (j))
#define XB_XSUB(j)  (1280 + 64 * (j))
#define XB_XGEN(j)  (2304 + 64 * (j))
#define XB_TOP      3328
#define XB_TOPGEN   3392
#define XCD_BAR_WORDS 3456
#define XB_SPIN_CAP (1u << 18)

__device__ __forceinline__ unsigned xb_ld(unsigned* p)              { return __hip_atomic_load(p, __ATOMIC_RELAXED, __HIP_MEMORY_SCOPE_AGENT); }
__device__ __forceinline__ unsigned xb_add(unsigned* p, unsigned v) { return __hip_atomic_fetch_add(p, v, __ATOMIC_RELAXED, __HIP_MEMORY_SCOPE_AGENT); }
__device__ __forceinline__ unsigned xb_xcc_id() { return (unsigned)__builtin_amdgcn_s_getreg((3 << 11) | 20) & 0xFu; }
#define XB_SPIN(cond, bar) do { unsigned _sp = 0; while (cond) { __builtin_amdgcn_s_sleep(1); \
    if ((++_sp & 255u) == 0u) { if (xb_ld(&(bar)[XB_TMO])) break; if (_sp > XB_SPIN_CAP) { atomicAdd(&(bar)[XB_TMO], 1u); break; } } } } while (0)

struct XcdBarrier {
    unsigned* bar; unsigned x;
    volatile LAS unsigned* st;
};

__device__ __forceinline__ XcdBarrier xcd_barrier_post(unsigned* bar, volatile LAS unsigned* st) {
    XcdBarrier b; b.bar = bar; b.x = xb_xcc_id(); b.st = st;
    if (threadIdx.x == 0) (void)xb_add(&bar[XB_XCNT(b.x)], 1u);
    return b;
}
__device__ __forceinline__ void xcd_barrier_complete(unsigned* bar, unsigned x, unsigned& nloc, unsigned& nx) {
    const unsigned G = gridDim.x * gridDim.y * gridDim.z;
    unsigned sum, cnt, mine, sp = 0u;
    for (;;) {
        sum = 0u; cnt = 0u; mine = 0u;
#pragma unroll
        for (unsigned j = 0; j < 16; ++j) { const unsigned c = xb_ld(&bar[XB_XCNT(j)]); sum += c; cnt += (c > 0u) ? 1u : 0u; mine = (j == x) ? c : mine; }
        if (sum == G) break;
        __builtin_amdgcn_s_sleep(1);
        if ((++sp & 255u) == 0u) { if (xb_ld(&bar[XB_TMO])) break; if (sp > XB_SPIN_CAP) { atomicAdd(&bar[XB_TMO], 1u); break; } }
    }
    nloc = mine > 0u ? mine : 1u; nx = cnt > 0u ? cnt : 1u;
}

__device__ __forceinline__ void xcd_barrier(const XcdBarrier& b, int wave_s) {
    asm volatile("s_waitcnt vmcnt(0)" ::: "memory");
    __syncthreads();
    if (fresh_tid(wave_s) == 0) {
        unsigned* bar = b.bar;
        __builtin_amdgcn_s_waitcnt(0);
        unsigned nloc = b.st[0], nx = b.st[1];
        if (nloc == 0u) { xcd_barrier_complete(bar, b.x, nloc, nx); b.st[0] = nloc; b.st[1] = nx; }
        const unsigned old = xb_add(&bar[XB_XSUB(b.x)], 1u);
        const unsigned gen = old / nloc;
        if (old + 1u == (gen + 1u) * nloc) {
            __builtin_amdgcn_fence(__ATOMIC_RELEASE, "agent");
            asm volatile("s_waitcnt vmcnt(0)" ::: "memory");
            const unsigned og = xb_add(&bar[XB_TOP], 1u);
            const unsigned tg = og / nx;
            if (og + 1u == (tg + 1u) * nx) xb_add(&bar[XB_TOPGEN], 1u);
            else XB_SPIN(xb_ld(&bar[XB_TOPGEN]) == tg, bar);
            __builtin_amdgcn_fence(__ATOMIC_ACQUIRE, "agent");
            xb_add(&bar[XB_XGEN(b.x)], 1u);
            asm volatile("s_waitcnt vmcnt(0)" ::: "memory");
        } else {
            XB_SPIN(xb_ld(&bar[XB_XGEN(b.x)]) == gen, bar);
            __builtin_amdgcn_fence(__ATOMIC_ACQUIRE, "agent");
            asm volatile("s_waitcnt vmcnt(0)" ::: "memory");
        }
    }
    __syncthreads();
}

}
namespace mk {
namespace cg = cooperative_groups;
constexpr int PH_PER_LAYER = 9, N_PHASES = 1 + 2 * PH_PER_LAYER;

__device__ __forceinline__ float lam_of(const Args& a, int l, float lam_init) {
    const float *q1 = a.in[14] + l * 64, *k1 = a.in[15] + l * 64, *q2 = a.in[16] + l * 64, *k2 = a.in[17] + l * 64;
    float s1 = 0.f, s2 = 0.f; for (int i = 0; i < 64; ++i) { s1 += q1[i] * k1[i]; s2 += q2[i] * k2[i]; }
    return expf(s1) - expf(s2) + lam_init;
}

typedef const __attribute__((address_space(4))) Args* KArgPtr;
__global__ void __launch_bounds__(NTH, 2) fwd(Args a_byval) {
    extern __shared__ __attribute__((aligned(16))) unsigned char lds_raw[];
    cg::grid_group grid = cg::this_grid();
    const int ph_lo = a_byval.ph_lo, ph_hi = a_byval.ph_hi;
    const int wave_s = __builtin_amdgcn_readfirstlane((int)threadIdx.x >> 6);
    volatile LAS unsigned* bar_st = (volatile LAS unsigned*)((LAS unsigned char*)lds_raw + LDS_BYTES - 64);
    if (threadIdx.x == 0) { bar_st[0] = 0u; bar_st[1] = 0u; }
    __syncthreads();
    const XcdBarrier bar = xcd_barrier_post((unsigned*)a_byval.ws, bar_st);
    int rep_flag = 0;
    for (int ph = ph_lo; ph < ph_hi; ++ph) {
        KArgPtr ap = (KArgPtr)__builtin_amdgcn_kernarg_segment_ptr(); asm volatile("" : "+s"(ap));
        const Args a = *(const Args*)ap;
        float* Xr = (float*)(a.ws + WS_X);
        Ctx X; X.wave_s = wave_s; X.wave = wave_s; X.tid = 0; X.lane = 0;
#define FRESH() do { X.tid = fresh_tid(wave_s); X.lane = X.tid & 63; } while (0)
        { int g_ = gridDim.x, b_ = blockIdx.x; asm volatile("" : "+s"(g_), "+s"(b_)); X.G = g_; X.bid = b_; }
        { const int bx = X.bid; X.vcu = (X.G % 8 == 0) ? (bx % 8) * (X.G / 8) + bx / 8 : bx; }
        X.gw = X.vcu * NWAVES + X.wave; X.ngw = X.G * NWAVES; X.lds = (LAS unsigned char*)lds_raw; X.ws = a.ws;
#ifndef MK_EN
#define MK_EN 0xFFFF
#endif
#ifndef MK_ATT
#define MK_ATT 3
#endif
#ifndef MK_REP_SP
#define MK_REP_SP 99
#endif
        if (ph == 0) { if (MK_EN & 512) { FRESH(); p0_prologue(X, a); } }
        else {
            const int l = (ph - 1) / PH_PER_LAYER, sp = (ph - 1) % PH_PER_LAYER;
            const float lam_init = 0.8f - 0.6f * expf(-0.3f * (float)l);
            if (0) {}
#if MK_EN & 1
            else if (sp == 0) {
                FRESH();
                pg8::Gemm g{(const bf16*)(a.ws + WS_XN), (const bf16*)(a.ws + WS_WIN) + (size_t)l * INW * D, T, INW, D};
                pg8::StaticOrder So; So.init(T, INW, X.G, X.bid);
                EpiWin Ep{a.ws, (const float*)(a.ws + WS_BINP) + l * INW, (const float*)(a.ws + WS_ROPE)};
                pg8::gemm_phase<EpiWin, pg8::StaticOrder, true, true>(X.lds, g, So, Ep, X.tid);
            }
#endif
#if MK_EN & 2
            else if (sp == 1) {
                FRESH();
                p1t_shortconv(X, a.in[4] + l * 3 * 1536, a.in[5] + l * 1536);
                p1t_kmax(X, (unsigned*)(a.ws + 14336) + l * 32);
            }
#endif
#if MK_EN & 4
            else if (sp == 2) {
                FRESH();
                const float lam = lam_of(a, l, lam_init);
                const int c = X.bid;
#ifndef MK_REP_ATT
#define MK_REP_ATT 1
#endif
#ifndef MK_CONV_REP
#define MK_CONV_REP 1
#endif
#ifndef MK_REP_HY
#define MK_REP_HY 1
#endif
#ifndef CV_ME_SWEEP
#define CV_ME_SWEEP 32
#endif
                const int cg_ = X.vcu & 3;
                if (cg_ == 0) { __syncthreads(); p0_experts_rest(relaunder(X), a, l, CV_ME_SWEEP); __syncthreads(); }
                for (int rep = 0; rep < MK_REP_ATT; ++rep) for (int u = c; u < 256; u += X.G) { const int bh = 2 * (u & 7) + ((u >> 3) >> 4), qb = (u >> 3) & 15; at::attn_unit(X, bh >> 2, bh & 3, qb, lam, 1.0f - lam_init, a.in[18] + l * 128, (unsigned*)(a.ws + 14336) + l * 32); }
                if (cg_ == 1) { __syncthreads(); p0_experts_rest(relaunder(X), a, l, CV_ME_SWEEP); __syncthreads(); }
                hy::CvState cs; const float* cwg = a.in[25] + (size_t)l * E * D * F; const float* cwu = a.in[26] + (size_t)l * E * D * F; const float* cwd = a.in[27] + (size_t)l * E * D * F; const float* cgn = a.in[22] + l * D;
                bf16* ctgu = (bf16*)(a.ws + WS_WGU) + (size_t)l * E * 2 * F * D; bf16* ctd = (bf16*)(a.ws + WS_WD) + (size_t)l * E * F * D;
                cs.next = __builtin_amdgcn_readfirstlane(X.bid * NWAVES + wave_s); cs.stride = __builtin_amdgcn_readfirstlane(X.G * NWAVES); cs.nlim = CV_ME_SWEEP * 2048; cs.cnt = 0; cs.par = 0;
                cs.a.have = cs.b.have = -1; cs.a.ld0 = cs.a.ld1 = cs.a.ld2 = cs.a.ld3 = cs.b.ld0 = cs.b.ld1 = cs.b.ld2 = cs.b.ld3 = f32x4{0.f, 0.f, 0.f, 0.f}; cs.a.sc = cs.b.sc = 1.f;
                hy::cv_issue(cs, cs.a, fresh_tid(wave_s) & 63, CV_PARGS); hy::cv_issue(cs, cs.b, fresh_tid(wave_s) & 63, CV_PARGS);
                for (int rep = 0; rep < MK_REP_HY; ++rep) for (int u = c; u < 256; u += X.G) { const int ch = 64 * (u & 7) + 2 * (u >> 3); hy::channel<0>(relaunder(X), l, ch, a.in[13], cs, CV_PARGS);
                    if (cg_ == 2) { __syncthreads(); p0_experts_rest(relaunder(X), a, l, CV_ME_SWEEP); __syncthreads(); }
                    hy::channel<1>(relaunder(X), l, ch + 1, a.in[13], cs, CV_PARGS); }
                while (cs.a.have >= 0 || cs.b.have >= 0) hy::cv_finish(cs, fresh_tid(wave_s) & 63, CV_PARGS);
                if (cg_ == 3) { __syncthreads(); p0_experts_rest(relaunder(X), a, l, CV_ME_SWEEP); __syncthreads(); }
            }
#endif
#if MK_EN & 8
            else if (sp == 3) {
                FRESH();
                OrderMerge So; So.so.init(T, D, X.G, X.bid);
                pg8::Gemm g{(const bf16*)(a.ws + WS_YH), (const bf16*)(a.ws + WS_WUH) + (size_t)l * 2 * D * C, 2 * T, 2 * D, C};
                EpiMerge2 Ep{(const bf16*)(a.ws + WS_GH), (const bf16*)(a.ws + WS_GA), (bf16*)(a.ws + WS_T1), (bf16*)(a.ws + WS_MG)};
                pg8::gemm_phase<EpiMerge2, OrderMerge, true, true>(X.lds, g, So, Ep, X.tid);
            }
#endif
#if MK_EN & 16
            else if (sp == 4) {
                FRESH();
                pg8::Gemm g{(const bf16*)(a.ws + WS_MG), (const bf16*)(a.ws + WS_WOUT) + (size_t)l * D * D, T, D, D};
                pg8::StaticOrder So; So.init(T, D, X.G, X.bid);
                EpiOutR Ep{l == 0 ? a.in[0] : Xr, Xr, (bf16*)(a.ws + WS_XN), (float*)(a.ws + WS_PART), (const bf16*)(a.ws + WS_WRP) + (size_t)l * 2 * E * D, (unsigned*)(a.ws + 15360) + l * 64, (float*)(a.ws + WS_AFFT), (float*)(a.ws + WS_RTOK), a.in[24] + l * E};
                pg8::gemm_phase<EpiOutR, pg8::StaticOrder, true, true>(X.lds, g, So, Ep, X.tid);
            }
#endif
#if MK_EN & 32
            else if (sp == 5) { FRESH(); p6_topk(X);
            }
#endif
#if MK_EN & 64
            else if (sp == 6) {
                FRESH();
                pg8::Gemm g{(const bf16*)(a.ws + WS_XN), (const bf16*)(a.ws + WS_WGU) + (size_t)l * E * 2 * F * D, E * 2048, 2 * F, D, 2 * F, 4, (size_t)2 * F * D * 2, (const int*)(a.ws + WS_ROWS)};
                OrderMoE1 So{X.G, X.bid}; EpiSwiGLU Ep{(bf16*)(a.ws + WS_HB), (const float*)(a.ws + WS_RSL)};
                pg8::gemm_phase<EpiSwiGLU, OrderMoE1, true, true, true, true>(X.lds, g, So, Ep, X.tid);
            }
#endif
#if MK_EN & 128
            else if (sp == 7) {
                FRESH();
                pg8::Gemm g{(const bf16*)(a.ws + WS_HB), (const bf16*)(a.ws + WS_WD) + (size_t)l * E * D * F, E * 2048, D, F, D, 2, (size_t)D * F * 2};
                OrderMoE2 So{X.G, X.bid}; EpiDown Ep{(bf16*)(a.ws + WS_YE), (const float*)(a.ws + WS_GATE)};
                pg8::gemm_phase<EpiDown, OrderMoE2, true, true, true>(X.lds, g, So, Ep, X.tid);
            }
#endif
#if MK_EN & 256
            else if (sp == 8) {
                FRESH();
                p9_combine(X, Xr, l == 0 ? a.in[1] + D : a.in[28], l == 1, a.out);
            }
#endif
        }
#ifndef MK_EXTRA_SYNC
#define MK_EXTRA_SYNC 0
#endif
        if (ph + 1 < ph_hi) { if (ph_hi > 4096) grid.sync(); else xcd_barrier(bar, wave_s); }
        for (int es = 0; es < MK_EXTRA_SYNC; ++es) xcd_barrier(bar, wave_s);
        if (MK_REP_SP != 99) { const int sp_ = ph == 0 ? -1 : (ph - 1) % PH_PER_LAYER; if (sp_ == MK_REP_SP && rep_flag == 0) { rep_flag = 1; --ph; } else rep_flag = 0; }
    }
}

static int g_grid = 0;
static bool mega_setup() {
    if (g_grid) return g_grid > 0;
    int dev = 0, cus = 0, per_cu = 0;
    if (hipGetDevice(&dev) != hipSuccess || hipDeviceGetAttribute(&cus, hipDeviceAttributeMultiprocessorCount, dev) != hipSuccess) { g_grid = -1; return false; }
    if (hipFuncSetAttribute((const void*)fwd, hipFuncAttributeMaxDynamicSharedMemorySize, LDS_BYTES) != hipSuccess) { fprintf(stderr, "hipFuncSetAttribute failed\n"); g_grid = -1; return false; }
    if (hipOccupancyMaxActiveBlocksPerMultiprocessor(&per_cu, (const void*)fwd, NTH, LDS_BYTES) != hipSuccess || per_cu < 1) { fprintf(stderr, "occupancy query failed (%d)\n", per_cu); g_grid = -1; return false; }
    g_grid = cus * 1;
    return true;
}
static void mega_launch(hipStream_t st, void* const* d_in, float* d_out, unsigned char* ws, int ph_lo, int ph_hi, int p0_mask) {
    if (!mega_setup()) return;
    Args a{};
    for (int i = 0; i < 29; ++i) a.in[i] = (const float*)d_in[i];
    a.out = d_out; a.ws = ws; a.ph_lo = ph_lo; a.ph_hi = ph_hi; a.p0_mask = p0_mask; a.pad = 0;
    if (hipMemsetAsync(ws, 0, 16384, st) != hipSuccess) { fprintf(stderr, "memset of the barrier words failed\n"); return; }
    void* args[] = {&a};
    const hipError_t e = hipLaunchCooperativeKernel((const void*)fwd, dim3(g_grid), dim3(NTH), args, LDS_BYTES, st);
    if (e != hipSuccess) fprintf(stderr, "cooperative launch failed: %s (grid %d)\n", hipGetErrorString(e), g_grid);
}
}
extern "C" void kernel_launch(void* const* d_in, const int* in_sizes, int n_in, void* d_out, int out_size, void* d_ws, size_t ws_size, hipStream_t stream) {
    if (n_in != 29 || out_size != mk::T * mk::D || ws_size < mk::WS_END) { fprintf(stderr, "kernel_launch: unexpected sizes n_in %d out %d ws %zu\n", n_in, out_size, ws_size); return; }
    mk::mega_launch(stream, d_in, (float*)d_out, (unsigned char*)d_ws, 0, mk::N_PHASES, 13);
}
```

```cpp
#include <hip/hip_runtime.h>
#include <hip/hip_cooperative_groups.h>
#include <cstdio>
#include <cstdint>
#include <cmath>
namespace tk {
constexpr int S = 4096, E = 16, CAP = 512, NT = 512;
__device__ __forceinline__ void topk_problem(const unsigned (&key)[8], const float (&rr)[8], int tokbase, int e, int slotbase, int* __restrict__ rows, float* __restrict__ gate, float* __restrict__ rsl, int* __restrict__ inv, int* sm, int tid) {
    const int lane = tid & 63, wid = tid >> 6;
    int* hist = sm; int* ctl = sm + 256;
    unsigned prefix = 0u, mask = 0u; int kth = CAP;
    for (int pass = 3; pass >= 0; --pass) {
        __syncthreads();
        if (tid < 256) hist[tid] = 0;
        __syncthreads();
#pragma unroll
        for (int i = 0; i < 8; ++i) if ((key[i] & mask) == prefix) atomicAdd(&hist[(key[i] >> (8 * pass)) & 255u], 1);
        __syncthreads();
        if (tid < 64) {
            const int b0 = hist[4 * lane], b1 = hist[4 * lane + 1], b2 = hist[4 * lane + 2], b3 = hist[4 * lane + 3];
            const int tot = b0 + b1 + b2 + b3;
            int suf = tot;
#pragma unroll
            for (int o = 1; o < 64; o <<= 1) { const int v = __builtin_amdgcn_ds_bpermute(((lane + o) & 63) << 2, suf); if (lane + o < 64) suf += v; }
            const int above = suf - tot;
            if (above < kth && kth <= above + tot) {
                int cum = above, bin, k2;
                if (cum + b3 >= kth) { bin = 4 * lane + 3; k2 = kth - cum; }
                else { cum += b3; if (cum + b2 >= kth) { bin = 4 * lane + 2; k2 = kth - cum; }
                else { cum += b2; if (cum + b1 >= kth) { bin = 4 * lane + 1; k2 = kth - cum; }
                else { cum += b1; bin = 4 * lane; k2 = kth - cum; } } }
                ctl[0] = bin; ctl[1] = k2;
            }
        }
        __syncthreads();
        prefix |= ((unsigned)ctl[0]) << (8 * pass); mask |= 0xFFu << (8 * pass); kth = ctl[1];
    }
    const unsigned thr = prefix; const int need_eq = kth; const int n_gt = CAP - need_eq;
    int cg = 0, ce = 0;
#pragma unroll
    for (int i = 0; i < 8; ++i) { cg += key[i] > thr; ce += key[i] == thr; }
    int sg = cg, se = ce;
#pragma unroll
    for (int o = 1; o < 64; o <<= 1) { const int a = __builtin_amdgcn_ds_bpermute(((lane - o) & 63) << 2, sg), b = __builtin_amdgcn_ds_bpermute(((lane - o) & 63) << 2, se); if (lane >= o) { sg += a; se += b; } }
    __syncthreads();
    if (lane == 63) { ctl[8 + wid] = sg; ctl[16 + wid] = se; }
    __syncthreads();
    int og = sg - cg, oe = se - ce;
    for (int w = 0; w < wid; ++w) { og += ctl[8 + w]; oe += ctl[16 + w]; }
#pragma unroll
    for (int i = 0; i < 8; ++i) {
        const int idx = tid * 8 + i; int slot = -1;
        if (key[i] > thr) slot = og++;
        else if (key[i] == thr) { if (oe < need_eq) slot = n_gt + oe; ++oe; }
        if (slot >= 0) { rows[slot] = tokbase + idx; gate[slot] = __uint_as_float(key[i]); rsl[slot] = rr[i]; }
        inv[(size_t)(tokbase + idx) * E + e] = slot >= 0 ? slotbase + slot : -1;
    }
    __syncthreads();
}
}
namespace pg8 {
#define PG8_LAS __attribute__((address_space(3)))
typedef unsigned short bf16_t;
typedef short bf16x8 __attribute__((ext_vector_type(8)));
typedef float f32x4 __attribute__((ext_vector_type(4)));
typedef unsigned u32x4 __attribute__((ext_vector_type(4)));
typedef short s16x4 __attribute__((ext_vector_type(4)));
constexpr int BM = 256, BK = 64, HALF = 128, HTB = HALF * BK * 2  , STAGE_BYTES = 8 * HTB, NXCD = 8, WGM = 8;

__host__ __device__ __forceinline__ int lds_byte(int r, int c) { const int st = (r >> 4) * 2 + (c >> 5), rr = r & 15, cc = c & 31, ob = rr * 64 + cc * 2; return st * 1024 + (ob ^ (((ob >> 9) & 1) << 5)); }
__host__ __device__ __forceinline__ void stage_rc(int b, int& R, int& C) { const int st = b / 1024, sb = b % 1024, swz = sb ^ (((sb >> 9) & 1) << 5); R = (st >> 1) * 16 + swz / 64; C = (st & 1) * 32 + (swz % 64) / 2; }
__host__ __device__ __forceinline__ int perm32(int rho) { const int n = rho >> 4, i = rho & 15; return 8 * (i >> 2) + 4 * n + (i & 3); }

struct Unit { int pm, pn, pb, pa; };
struct Gemm { const bf16_t* A; const bf16_t* Bt; int M, N, K; int bN = 0, bsh = 0; size_t bes = 0; const int* arows = nullptr; };

struct StaticOrder {
    int nM, nN, nwg, G, c;
    __host__ __device__ void init(int M, int N, int G_, int c_) { nM = M / BM; nN = N / BM; nwg = nM * nN; G = G_; c = c_; }
    __host__ __device__ bool next(int i, Unit& u) const {
        const long L = (long)i * G + c; if (L >= nwg) return false;
        int wgid = (int)L; { const int q = nwg / NXCD, r = nwg % NXCD, xcd = wgid % NXCD, off = wgid / NXCD; wgid = (xcd < r ? xcd * (q + 1) : r * (q + 1) + (xcd - r) * q) + off; }
        const int nig = WGM * nN, gid = wgid / nig, fm = gid * WGM, gsz = (nM - fm) < WGM ? (nM - fm) : WGM;
        u.pm = fm + ((wgid % nig) % gsz); u.pn = (wgid % nig) / gsz; u.pb = u.pn; u.pa = u.pm; return true;
    }
    __device__ __forceinline__ void a_ready(const Unit&) const {}
    __device__ __forceinline__ void done(const Unit&) const {}
};

template <class Epi, class Sched, bool ALIGN_EPI = false, bool SP2 = false, bool BT = false, bool GA = false>
__device__ __forceinline__ void gemm_phase(PG8_LAS unsigned char* lds, const Gemm g, const Sched& S, const Epi& E, int tid) {
    asm volatile("" : "+v"(tid));
    const int wid = __builtin_amdgcn_readfirstlane(tid >> 6), lane = tid & 63, wr = wid >> 2, wc = wid & 3, fr = lane & 15, fq = lane >> 4;
    const int K = g.K, nt = K / BK;
    unsigned voffA[2], voffB[2];
#pragma unroll
    for (int i = 0; i < 2; ++i) { int R, C; stage_rc(tid * 16 + i * 8192, R, C); const int Rb = Epi::PERM ? ((R & ~31) + perm32(R & 31)) : R;
        voffA[i] = (unsigned)(R * K + C) * 2u; voffB[i] = (unsigned)(Rb * K + C) * 2u; if constexpr (GA) voffA[i] = (unsigned)C * 2u;
        if constexpr (BT) { const int p = i * 512 + tid, row = ((p >> 7) << 3) | ((p >> 2) & 7), ch = (((p >> 5) & 3) << 2) | ((p & 3) ^ ((row >> 2) & 3));
            voffB[i] = (unsigned)(row * g.bN + 8 * ch) * 2u; } }
    const size_t kstep = (size_t)(BK * 2);
    const size_t hstep = (size_t)HALF * K * 2;
    const size_t tstep = 2 * hstep;
    const size_t kstepB = BT ? (size_t)BK * g.bN * 2 : kstep, hstepB = BT ? (size_t)HALF * 2 : hstep;
    const size_t hstepA = GA ? 0 : hstep;
    unsigned curA[2][2] = {{0u, 0u}, {0u, 0u}};
    PG8_LAS int* rowtab0 = (PG8_LAS int*)(lds + STAGE_BYTES);
#define PG8_ROWTAB (rowtab0 + ((ui + 1) & 1) * 512)
#define PG8_NXTOFF(o_, h) do { int t_ = tid; asm volatile("" : "+v"(t_)); _Pragma("unroll") for (int i_ = 0; i_ < 2; ++i_) { int R_, C_; stage_rc(t_ * 16 + i_ * 8192, R_, C_); \
        o_[i_] = (unsigned)PG8_ROWTAB[(h) * 128 + R_] * (unsigned)(K * 2) + (unsigned)C_ * 2u; } } while (0)
#define PG8_STAGE_A(bufoff, kbase, h, nx) do { if constexpr (GA) { if (nx) { unsigned o_[2]; PG8_NXTOFF(o_, h); PG8_STAGE(bufoff, kbase, o_); } else PG8_STAGE(bufoff, kbase, curA[h]); } \
        else PG8_STAGE(bufoff, (kbase) + ((h) ? hstep : 0), voffA); } while (0)
#define PG8_BBASE(pb) ((const char*)g.Bt + (BT ? (size_t)((pb) >> g.bsh) * g.bes + (size_t)((pb) & ((1 << g.bsh) - 1)) * 512 : (size_t)(pb) * tstep))
    const unsigned ldsw = (unsigned)wid * 1024u;
    const int aoff = lds_byte(wr * 64 + fr, fq * 8), boff = lds_byte(wc * 32 + fr, fq * 8);
    int tr0 = 0, tr1 = 0;
    if constexpr (BT) { static_assert(Epi::PERM, "BT needs the PERM column order"); const int q_ = (lane >> 2) & 3, p_ = lane & 3, f1_ = fq & 1;
        const int L_ = (int)(size_t)lds + 2048 * fq + 512 * wc + 64 * q_ + 32 * ((p_ >> 1) ^ f1_); tr0 = L_ + 16 * (p_ & 1); tr1 = L_ + 256 + 16 * (1 - (p_ & 1)); }
#define PG8_SA(b, h) (((b) * 2 + (h)) * HTB)
#define PG8_SB(b, h) ((4 + (b) * 2 + (h)) * HTB)
#define PG8_STAGE(bufoff, gbase, voff) do { _Pragma("unroll") for (int _i = 0; _i < 2; ++_i) \
        __builtin_amdgcn_global_load_lds((const unsigned*)((const char*)(gbase) + (voff)[_i]), (PG8_LAS unsigned*)(lds + (bufoff) + ldsw + _i * 8192), 16, 0, 0); } while (0)
#define PG8_LDA(dst, b, h) do { _Pragma("unroll") for (int m = 0; m < 4; ++m) _Pragma("unroll") for (int k = 0; k < 2; ++k) dst[m][k] = *(const PG8_LAS bf16x8*)(lds + PG8_SA(b, h) + aoff + m * 2048 + k * 1024); } while (0)
#define PG8_TR(dst4, addr, OFF) asm volatile("ds_read_b64_tr_b16 %0, %1 offset:%2" : "=&v"(dst4) : "v"(addr), "i"(OFF) : "memory")
#define PG8_TRF(dst8, a0, a1, OFF) do { s16x4 lo_, hi_; PG8_TR(lo_, a0, OFF); PG8_TR(hi_, a1, OFF); dst8 = __builtin_shufflevector(lo_, hi_, 0, 1, 2, 3, 4, 5, 6, 7); } while (0)
#define PG8_LDB(dst, b, h) do { if constexpr (BT) { const int a0_ = tr0 + PG8_SB(b, h), a1_ = tr1 + PG8_SB(b, h); \
        PG8_TRF(dst[0][0], a0_, a1_, 0); PG8_TRF(dst[0][1], a0_, a1_, 8192); PG8_TRF(dst[1][0], a0_, a1_, 8); PG8_TRF(dst[1][1], a0_, a1_, 8200); } else { \
    _Pragma("unroll") for (int n = 0; n < 2; ++n) _Pragma("unroll") for (int k = 0; k < 2; ++k) dst[n][k] = *(const PG8_LAS bf16x8*)(lds + PG8_SB(b, h) + boff + n * 2048 + k * 1024); } } while (0)
#define PG8_MMA(ai, bj, At, Bt) do { __builtin_amdgcn_s_setprio(1); _Pragma("unroll") for (int m = 0; m < 4; ++m) _Pragma("unroll") for (int n = 0; n < 2; ++n) _Pragma("unroll") for (int k = 0; k < 2; ++k) \
        acc[ai][bj][m][n] = __builtin_amdgcn_mfma_f32_16x16x32_bf16(Bt[n][k], At[m][k], acc[ai][bj][m][n], 0, 0, 0); __builtin_amdgcn_s_setprio(0); } while (0)
#define PG8_WAIT_V(n) asm volatile("s_waitcnt vmcnt(" #n ")" ::: "memory")
#define PG8_WAIT_L(n) asm volatile("s_waitcnt lgkmcnt(" #n ")" ::: "memory")
#define PG8_BAR __builtin_amdgcn_s_barrier()
#define PG8_SCHED __builtin_amdgcn_sched_barrier(0)
    Unit cur, nxt; int ui = 0;
    if (!S.next(0, cur)) return;
    f32x4 acc[2][2][4][2];
#pragma unroll
    for (int a = 0; a < 2; ++a)
#pragma unroll
        for (int b = 0; b < 2; ++b)
#pragma unroll
            for (int m = 0; m < 4; ++m)
#pragma unroll
                for (int n = 0; n < 2; ++n) acc[a][b][m][n] = (f32x4){0.f, 0.f, 0.f, 0.f};
    bf16x8 At[4][2], B0[2][2], B1[2][2];
    const char* cA = (const char*)g.A + (GA ? 0 : (size_t)cur.pa * tstep); const char* cB = PG8_BBASE(cur.pb);
    if constexpr (GA) {
#pragma unroll
        for (int h = 0; h < 2; ++h)
#pragma unroll
            for (int i = 0; i < 2; ++i) { int R, C; stage_rc(tid * 16 + i * 8192, R, C);
                curA[h][i] = (unsigned)__hip_atomic_load(g.arows + cur.pa * 256 + h * 128 + R, __ATOMIC_RELAXED, __HIP_MEMORY_SCOPE_AGENT) * (unsigned)(K * 2) + (unsigned)C * 2u; } }
    S.a_ready(cur);
    if constexpr (SP2) {
        PG8_STAGE(PG8_SB(0, 0), cB, voffB); PG8_STAGE(PG8_SB(0, 1), cB + hstepB, voffB); PG8_STAGE_A(PG8_SA(0, 0), cA, 0, false); PG8_STAGE_A(PG8_SA(0, 1), cA, 1, false);
        if (wr == 1) PG8_BAR;
        PG8_WAIT_V(2); PG8_BAR;
        PG8_STAGE(PG8_SB(1, 0), cB + kstepB, voffB); PG8_STAGE_A(PG8_SA(1, 0), cA + kstep, 0, false); PG8_STAGE(PG8_SB(1, 1), cB + hstepB + kstepB, voffB);
        PG8_WAIT_V(6); PG8_BAR;
    } else {
        PG8_STAGE(PG8_SB(0, 0), cB, voffB); PG8_STAGE_A(PG8_SA(0, 0), cA, 0, false); PG8_STAGE(PG8_SB(0, 1), cB + hstepB, voffB); PG8_STAGE_A(PG8_SA(0, 1), cA, 1, false);
        if (wr == 1) PG8_BAR;
        PG8_WAIT_V(4); PG8_BAR;
        PG8_STAGE(PG8_SB(1, 0), cB + kstepB, voffB); PG8_STAGE_A(PG8_SA(1, 0), cA + kstep, 0, false); PG8_STAGE(PG8_SB(1, 1), cB + hstepB + kstepB, voffB);
        PG8_WAIT_V(6); PG8_BAR;
    }
    for (;;) {
        const bool has_next = S.next(ui + 1, nxt);
        const char* nA = (has_next && !GA) ? (const char*)g.A + (size_t)nxt.pa * tstep : cA; const char* nB = has_next ? PG8_BBASE(nxt.pb) : cB;
        for (int t = 0; t < nt; t += 2) {
            const bool last = (t == nt - 2);
            const char* a1 = cA + (size_t)(t + 1) * kstep;
            const char* a2 = last ? nA : cA + (size_t)(t + 2) * kstep; const char* b2 = last ? nB : cB + (size_t)(t + 2) * kstepB;
            const char* a3 = a2 + kstep; const char* b3 = b2 + kstepB;
            if (last && has_next) S.a_ready(nxt);
            const bool nx = GA && last && has_next;
            if constexpr (GA) {
                if (t == 0 && has_next) { int l_ = lane; asm volatile("" : "+v"(l_)); __builtin_amdgcn_global_load_lds((const unsigned*)(g.arows + nxt.pa * 256 + (wid & 3) * 64 + l_), (PG8_LAS unsigned*)(PG8_ROWTAB + wid * 64), 4, 0, 0); }
            }
            if constexpr (SP2) {
            PG8_LDB(B0, 0, 0); PG8_LDB(B1, 0, 1); PG8_SCHED; PG8_LDA(At, 0, 0); PG8_STAGE_A(PG8_SA(1, 1), a1, 1, false);
            PG8_WAIT_V(8); PG8_WAIT_L(0); PG8_BAR; PG8_MMA(0, 0, At, B0); PG8_MMA(0, 1, At, B1); PG8_BAR; PG8_SCHED;
            PG8_LDA(At, 0, 1); PG8_STAGE(PG8_SB(0, 0), b2, voffB); PG8_STAGE(PG8_SB(0, 1), b2 + hstepB, voffB); PG8_STAGE_A(PG8_SA(0, 0), a2, 0, nx);
            PG8_WAIT_V(8); PG8_WAIT_L(0); PG8_BAR; PG8_MMA(1, 0, At, B0); PG8_MMA(1, 1, At, B1); PG8_BAR; PG8_SCHED;
            PG8_LDB(B0, 1, 0); PG8_LDB(B1, 1, 1); PG8_SCHED; PG8_LDA(At, 1, 0); PG8_STAGE_A(PG8_SA(0, 1), a2, 1, nx);
            PG8_WAIT_V(8); PG8_WAIT_L(0); PG8_BAR; PG8_MMA(0, 0, At, B0); PG8_MMA(0, 1, At, B1); PG8_BAR; PG8_SCHED;
            PG8_LDA(At, 1, 1); PG8_STAGE(PG8_SB(1, 0), b3, voffB); PG8_STAGE(PG8_SB(1, 1), b3 + hstepB, voffB); PG8_STAGE_A(PG8_SA(1, 0), a3, 0, nx);
            PG8_WAIT_V(8); PG8_WAIT_L(0); PG8_BAR; PG8_MMA(1, 0, At, B0); PG8_MMA(1, 1, At, B1); PG8_BAR; PG8_SCHED;
            } else {
            PG8_LDB(B0, 0, 0); PG8_SCHED; PG8_LDA(At, 0, 0); PG8_STAGE_A(PG8_SA(1, 1), a1, 1, false);
            PG8_WAIT_L(8); PG8_BAR; PG8_WAIT_L(0); PG8_MMA(0, 0, At, B0); PG8_BAR; PG8_SCHED;
            PG8_LDB(B1, 0, 1); PG8_STAGE(PG8_SB(0, 0), b2, voffB);
            PG8_BAR; PG8_WAIT_L(0); PG8_MMA(0, 1, At, B1); PG8_BAR;
            PG8_LDA(At, 0, 1); PG8_STAGE_A(PG8_SA(0, 0), a2, 0, nx);
            PG8_BAR; PG8_WAIT_L(0); PG8_MMA(1, 0, At, B0); PG8_BAR; PG8_SCHED;
            PG8_STAGE(PG8_SB(0, 1), b2 + hstepB, voffB);
            PG8_WAIT_V(6); PG8_BAR; PG8_MMA(1, 1, At, B1); PG8_BAR;
            PG8_LDB(B0, 1, 0); PG8_SCHED; PG8_LDA(At, 1, 0); PG8_STAGE_A(PG8_SA(0, 1), a2, 1, nx);
            PG8_WAIT_L(8); PG8_BAR; PG8_WAIT_L(0); PG8_MMA(0, 0, At, B0); PG8_BAR; PG8_SCHED;
            PG8_LDB(B1, 1, 1); PG8_STAGE(PG8_SB(1, 0), b3, voffB);
            PG8_BAR; PG8_WAIT_L(0); PG8_MMA(0, 1, At, B1); PG8_BAR;
            PG8_LDA(At, 1, 1); PG8_STAGE_A(PG8_SA(1, 0), a3, 0, nx);
            PG8_BAR; PG8_WAIT_L(0); PG8_MMA(1, 0, At, B0); PG8_BAR; PG8_SCHED;
            PG8_STAGE(PG8_SB(1, 1), b3 + hstepB, voffB);
            PG8_WAIT_V(6); PG8_BAR; PG8_MMA(1, 1, At, B1); PG8_BAR;
            }
        }
        if constexpr (ALIGN_EPI) { if (wr == 0) PG8_BAR; }
        if constexpr (!Epi::AFTER_DRAIN) { int l2_ = lane; asm volatile("" : "+v"(l2_)); E(acc, cur, wr, wc, l2_ & 15, l2_ >> 4); S.done(cur); }
        if (!has_next) break;
#pragma unroll
        for (int a = 0; a < 2; ++a)
#pragma unroll
            for (int b = 0; b < 2; ++b)
#pragma unroll
                for (int m = 0; m < 4; ++m)
#pragma unroll
                    for (int n = 0; n < 2; ++n) acc[a][b][m][n] = (f32x4){0.f, 0.f, 0.f, 0.f};
        if constexpr (GA) { PG8_NXTOFF(curA[0], 0); PG8_NXTOFF(curA[1], 1); }
        cur = nxt; cA = nA; cB = nB; ++ui;
        if constexpr (ALIGN_EPI) { if (wr == 1) PG8_BAR; }
    }
    PG8_WAIT_V(0);
    if constexpr (!ALIGN_EPI) { if (wr == 0) PG8_BAR; }
    PG8_BAR;
    if constexpr (Epi::AFTER_DRAIN) { E.fused(acc, cur, wr, wc, fr, fq, lds, wid, lane); S.done(cur); }
#undef PG8_SA
#undef PG8_SB
#undef PG8_STAGE
#undef PG8_STAGE_A
#undef PG8_NXTOFF
#undef PG8_ROWTAB
#undef PG8_LDA
#undef PG8_LDB
#undef PG8_TR
#undef PG8_TRF
#undef PG8_BBASE
#undef PG8_MMA
#undef PG8_WAIT_V
#undef PG8_WAIT_L
#undef PG8_BAR
#undef PG8_SCHED
}
}

namespace mk {
constexpr int D = 1024, B = 4, S = 4096, T = B * S, C = 512, INW = 5120, E = 16, CAP = 512, F = 2048, NTH = 512, NWAVES = 8;
typedef unsigned short bf16;
#define LAS __attribute__((address_space(3)))
typedef unsigned v4u __attribute__((ext_vector_type(4)));
typedef unsigned v2u __attribute__((ext_vector_type(2)));
typedef float f32x4 __attribute__((ext_vector_type(4)));
typedef short bf16x8 __attribute__((ext_vector_type(8)));
typedef float f32x16 __attribute__((ext_vector_type(16)));
typedef short s16x4 __attribute__((ext_vector_type(4)));

constexpr size_t MiB = 1u << 20;
constexpr size_t WS_WIN = 2 * MiB;
constexpr size_t WS_WUH = 22 * MiB;
constexpr size_t WS_WUA = 23 * MiB;
constexpr size_t WS_WOUT = 26 * MiB;
constexpr size_t WS_BINP = 30 * MiB;
constexpr size_t WS_WRP = 30 * MiB + 512 * 1024;
constexpr size_t WS_ROPE = 31 * MiB;
constexpr size_t WS_AFFT = 32 * MiB;
constexpr size_t WS_INV = 33 * MiB;
constexpr size_t WS_ROWS = 34 * MiB;
constexpr size_t WS_GATE = 34 * MiB + 512 * 1024;
constexpr size_t WS_RTOK = 35 * MiB + 512 * 1024;
constexpr size_t WS_RSL = 35 * MiB;
constexpr size_t WS_FILT = 36 * MiB;
constexpr size_t WS_X = 68 * MiB;
constexpr size_t WS_XN = 132 * MiB;
constexpr size_t WS_SH = 164 * MiB;
constexpr size_t WS_U = WS_SH;
constexpr size_t WS_UCT = WS_SH + 48 * MiB;
constexpr size_t WS_Q = WS_SH + 96 * MiB;
constexpr size_t WS_K = WS_SH + 112 * MiB;
constexpr size_t WS_V = WS_SH + 128 * MiB;
constexpr size_t WS_GH = WS_SH + 144 * MiB;
constexpr size_t WS_GA = WS_SH + 176 * MiB;
constexpr size_t WS_YH = WS_SH + 208 * MiB;
constexpr size_t WS_YA = WS_SH + 224 * MiB;
constexpr size_t WS_T1 = WS_U;
constexpr size_t WS_MG = WS_UCT;
constexpr size_t WS_PART = WS_SH;
constexpr size_t WS_HB = WS_SH + 64 * MiB;
constexpr size_t WS_YE = WS_SH + 192 * MiB;
constexpr size_t WS_WGU = 420 * MiB;
constexpr size_t WS_WD = 676 * MiB;
constexpr size_t WS_END = 804 * MiB;

constexpr int LDS_BYTES = 155648;
constexpr float QSCALE = 0.125f * 1.4426950408889634f;

struct Args {
    const float* in[29]; float* out; unsigned char* ws; int ph_lo, ph_hi; int p0_mask, pad;
};

__device__ __forceinline__ unsigned f2bf(float f) { unsigned u = __builtin_bit_cast(unsigned, f); return (u + 0x7fffu + ((u >> 16) & 1u)) >> 16; }
__device__ __forceinline__ unsigned pk2(float lo, float hi) { return f2bf(lo) | (f2bf(hi) << 16); }
__device__ __forceinline__ float bf2f(unsigned h) { return __builtin_bit_cast(float, h << 16); }
__device__ __forceinline__ float bflo(unsigned w) { return __builtin_bit_cast(float, w << 16); }
__device__ __forceinline__ float bfhi(unsigned w) { return __builtin_bit_cast(float, w & 0xffff0000u); }
template <int O> __device__ __forceinline__ float xor_f(float v) { return __builtin_bit_cast(float, __builtin_amdgcn_ds_swizzle(__builtin_bit_cast(int, v), (O << 10) | 0x1f)); }
__device__ __forceinline__ float wave_sum(float v) { v += xor_f<1>(v); v += xor_f<2>(v); v += xor_f<4>(v); v += xor_f<8>(v); v += xor_f<16>(v);
    const int b = __builtin_bit_cast(int, v); return __builtin_bit_cast(float, __builtin_amdgcn_readlane(b, 0)) + __builtin_bit_cast(float, __builtin_amdgcn_readlane(b, 32)); }

__device__ __forceinline__ float sigm(float x) { return 1.f / (1.f + __expf(-x)); }

struct Ctx { int tid, lane, wave, gw, ngw, vcu, G, bid, wave_s; LAS unsigned char* lds; unsigned char* ws; };

__device__ __forceinline__ int fresh_tid(int wave_s) { int l; asm volatile("v_mbcnt_lo_u32_b32 %0, -1, 0\n\tv_mbcnt_hi_u32_b32 %0, -1, %0" : "=v"(l)); return (wave_s << 6) | l; }
__device__ __forceinline__ Ctx relaunder(const Ctx& X) { Ctx Y = X; const int t = fresh_tid(X.wave_s); Y.tid = t; Y.lane = t & 63; return Y; }

template <int MAP> __device__ __forceinline__ int rowmap(int n) {
    if (MAP == 1) {
        if (n < 1536 || n >= 2560) return n;
        const int hb = (n - 1536) & ~63, d = (n - 1536) & 63, i = (d & 31) >> 2, j = d & 3;
        return 1536 + hb + 8 * i + ((d >> 5) << 2) + j;
    }
    if (MAP == 2) return ((n >> 7) << 8) + (n & 127);
    if (MAP == 3) return ((n >> 7) << 8) + 128 + (n & 127);
    return n;
}
__device__ __forceinline__ unsigned cvtpk_(float lo, float hi) { unsigned r; asm volatile("v_cvt_pk_bf16_f32 %0, %1, %2" : "=v"(r) : "v"(lo), "v"(hi)); return r; }
struct TrItem { const float* src; bf16* dst; };
template <int MAP> __device__ __forceinline__ void p0_transpose(const Ctx& X, const float* W, int K, int N, bf16* WT, int nmat, size_t sstride, size_t dstride, int rot = 0) {
    LAS float* scr = (LAS float*)(X.lds + X.wave * 16640);
    const int nblk = N / 64, per = (K / 64) * nblk, tot = per * nmat, lane = X.lane;
    const int nq = lane & 15, kr = lane >> 4, c = lane & 7, nsub = lane >> 3;
    f32x4 v[16];
    int it = X.gw - rot; if (it < 0) it += X.ngw;
#define TR_SRC(it_) (W + (size_t)((it_) / per) * sstride + (size_t)(64 * (((it_) % per) / nblk) + kr) * N + 64 * (((it_) % per) % nblk) + 4 * nq)
    if (it < tot) { const float* s = TR_SRC(it);
#pragma unroll
        for (int i = 0; i < 16; ++i) v[i] = __builtin_nontemporal_load((const f32x4*)(s + (size_t)(4 * i) * N)); }
    while (it < tot) {
#pragma unroll
        for (int i = 0; i < 16; ++i) { LAS float* d = scr + (4 * i + kr) * 65 + 4 * nq; d[0] = v[i][0]; d[1] = v[i][1]; d[2] = v[i][2]; d[3] = v[i][3]; }
        const int nit = it + X.ngw;
        if (nit < tot) { const float* s = TR_SRC(nit);
#pragma unroll
            for (int i = 0; i < 16; ++i) v[i] = __builtin_nontemporal_load((const f32x4*)(s + (size_t)(4 * i) * N)); }
        asm volatile("s_waitcnt lgkmcnt(0)" ::: "memory");
        const int m = it / per, r = it - m * per, k0 = 64 * (r / nblk), n0 = 64 * (r % nblk);
        bf16* dst = WT + (size_t)m * dstride;
#pragma unroll
        for (int j = 0; j < 8; ++j) { const int n = nsub + 8 * j; const LAS float* s = scr + (8 * c) * 65 + n;
            v4u o; o.x = cvtpk_(s[0 * 65], s[1 * 65]); o.y = cvtpk_(s[2 * 65], s[3 * 65]); o.z = cvtpk_(s[4 * 65], s[5 * 65]); o.w = cvtpk_(s[6 * 65], s[7 * 65]);
            __builtin_nontemporal_store(o, (v4u*)(dst + (size_t)rowmap<MAP>(n0 + n) * K + k0 + 8 * c)); }
        asm volatile("s_waitcnt lgkmcnt(0)" ::: "memory");
        it = nit;
    }
#undef TR_SRC
}
struct Row8 { f32x4 a[2][2]; };
__device__ __forceinline__ void row8_load(Row8& r, const float* p, int lane) {
#pragma unroll
    for (int j = 0; j < 2; ++j) { const f32x4* q = (const f32x4*)p + 2 * (lane + 64 * j); r.a[j][0] = q[0]; r.a[j][1] = q[1]; }
}
__device__ __forceinline__ void row8_load16(Row8& r, const bf16* p, int lane) {
#pragma unroll
    for (int j = 0; j < 2; ++j) { const v4u w = ((const v4u*)p)[lane + 64 * j];
        r.a[j][0] = (f32x4){bflo(w.x), bfhi(w.x), bflo(w.y), bfhi(w.y)}; r.a[j][1] = (f32x4){bflo(w.z), bfhi(w.z), bflo(w.w), bfhi(w.w)}; }
}
__device__ __forceinline__ float row8_sumsq(const Row8& r) {
    float s = 0.f;
#pragma unroll
    for (int j = 0; j < 2; ++j)
#pragma unroll
        for (int h = 0; h < 2; ++h) s += (r.a[j][h].x * r.a[j][h].x + r.a[j][h].y * r.a[j][h].y) + (r.a[j][h].z * r.a[j][h].z + r.a[j][h].w * r.a[j][h].w);
    return s;
}
__device__ __forceinline__ void rms_row_to_bf16(const float* __restrict__ xrow, const float* __restrict__ g, bf16* __restrict__ orow, int lane) {
    const f32x4* xr = (const f32x4*)xrow + lane; f32x4 v[4]; float s = 0.f;
#pragma unroll
    for (int j = 0; j < 4; ++j) { v[j] = xr[64 * j]; s += (v[j].x * v[j].x + v[j].y * v[j].y) + (v[j].z * v[j].z + v[j].w * v[j].w); }
    const float r = rsqrtf(wave_sum(s) * (1.f / D) + 1e-6f);
    v2u* o8 = (v2u*)orow + lane;
#pragma unroll
    for (int j = 0; j < 4; ++j) { const f32x4 gg = ((const f32x4*)g)[lane + 64 * j]; v2u w; w.x = pk2(v[j].x * r * gg.x, v[j].y * r * gg.y); w.y = pk2(v[j].z * r * gg.z, v[j].w * r * gg.w); o8[64 * j] = w; }
}
__device__ __forceinline__ void p0_filters(const Ctx& X, const Args& a) {
    LAS float* z = (LAS float*)X.lds;
    LAS float* h1 = z + 32 * 36;
    LAS float* h2r = h1 + 32 * 64;
    LAS float* w1s = h2r + 32 * 68;
    LAS float* w2s = w1s + 33 * 64;
    bf16* FILT = (bf16*)(X.ws + WS_FILT);
    const float min_decay = logf(1e-2f) / 0.3f, max_decay = logf(1e-2f) / 1.5f;
    for (int it = X.bid; it < 2 * (S / 32); it += X.G) {
        int tid = X.tid; asm volatile("" : "+v"(tid));
        const int j = tid & 63, tq = tid >> 6;
        const int l = it / (S / 32), t0 = (it % (S / 32)) * 32;
        const float *w1 = a.in[6] + l * 33 * 64, *b1 = a.in[7] + l * 64, *f1 = a.in[8] + l * 64, *w2 = a.in[9] + l * 64 * 64, *b2 = a.in[10] + l * 64, *f2 = a.in[11] + l * 64, *w3 = a.in[12] + (size_t)l * 64 * 2048;
        __syncthreads();
        for (int e = tid; e < 33 * 64; e += NTH) w1s[e] = w1[e];
        for (int e = tid; e < 64 * 64; e += NTH) w2s[e] = w2[e];
        for (int e = tid; e < 32 * 33; e += NTH) { const int tt = e / 33, jj0 = e - tt * 33, t = t0 + tt; float v;
            if (jj0 == 0) v = (float)t / (float)(S - 1);
            else { const int jj = (jj0 - 1) & 15; const float w = 2.0f * 3.14159265358979323846f * (float)t / (float)S; const float fr = 1e-4f + (float)jj * ((15.0f - 1e-4f) / 15.0f); const float ang = w * fr; v = (jj0 <= 16) ? cosf(ang) : -sinf(ang); }
            z[tt * 36 + jj0] = v; }
        const float bb1 = b1[j], ff1 = f1[j], bb2 = b2[j], ff2 = f2[j];
        __syncthreads();
        { float acc[4] = {bb1, bb1, bb1, bb1};
          for (int i = 0; i < 33; ++i) { const float w = w1s[i * 64 + j];
#pragma unroll
              for (int k = 0; k < 4; ++k) acc[k] += z[(tq + 8 * k) * 36 + i] * w; }
#pragma unroll
          for (int k = 0; k < 4; ++k) h1[(tq + 8 * k) * 64 + j] = sinf(ff1 * acc[k]); }
        __syncthreads();
        { float acc[4] = {bb2, bb2, bb2, bb2};
          for (int i = 0; i < 64; ++i) { const float w = w2s[i * 64 + j];
#pragma unroll
              for (int k = 0; k < 4; ++k) acc[k] += h1[(tq + 8 * k) * 64 + i] * w; }
#pragma unroll
          for (int k = 0; k < 4; ++k) h2r[(tq + 8 * k) * 68 + j] = sinf(ff2 * acc[k]); }
        __syncthreads();
        { const int wv = tid >> 6, ln = tid & 63, tl = ln & 31, kh = ln >> 5;
#define FSPLIT(HI, LO, V0, V1) do { v4u h_; h_.x = cvtpk_((V0)[0], (V0)[1]); h_.y = cvtpk_((V0)[2], (V0)[3]); h_.z = cvtpk_((V1)[0], (V1)[1]); h_.w = cvtpk_((V1)[2], (V1)[3]); \
            v4u l_; l_.x = cvtpk_((V0)[0] - bflo(h_.x), (V0)[1] - bfhi(h_.x)); l_.y = cvtpk_((V0)[2] - bflo(h_.y), (V0)[3] - bfhi(h_.y)); l_.z = cvtpk_((V1)[0] - bflo(h_.z), (V1)[1] - bfhi(h_.z)); l_.w = cvtpk_((V1)[2] - bflo(h_.w), (V1)[3] - bfhi(h_.w)); \
            HI = __builtin_bit_cast(bf16x8, h_); LO = __builtin_bit_cast(bf16x8, l_); } while (0)
            bf16x8 ah[4], al[4];
#pragma unroll
            for (int kb = 0; kb < 4; ++kb) { const f32x4 v0 = *(const LAS f32x4*)(h2r + tl * 68 + 16 * kb + 8 * kh), v1 = *(const LAS f32x4*)(h2r + tl * 68 + 16 * kb + 8 * kh + 4); FSPLIT(ah[kb], al[kb], v0, v1); }
            const float* wl = w3 + (size_t)(8 * kh) * 2048 + wv * 256 + tl;
            f32x4 wq[2][4][2];
#define FLOADW(BUF, NT) do { _Pragma("unroll") for (int kb_ = 0; kb_ < 4; ++kb_) _Pragma("unroll") for (int j_ = 0; j_ < 8; ++j_) wq[BUF][kb_][j_ >> 2][j_ & 3] = wl[(size_t)(16 * kb_ + j_) * 2048 + 32 * (NT)]; } while (0)
#define FTILE(BUF, NT) do { f32x16 d_ = {}; _Pragma("unroll") for (int kb_ = 0; kb_ < 4; ++kb_) { bf16x8 bh_, bl_; FSPLIT(bh_, bl_, wq[BUF][kb_][0], wq[BUF][kb_][1]); \
                d_ = __builtin_amdgcn_mfma_f32_32x32x16_bf16(ah[kb_], bh_, d_, 0, 0, 0); d_ = __builtin_amdgcn_mfma_f32_32x32x16_bf16(al[kb_], bh_, d_, 0, 0, 0); d_ = __builtin_amdgcn_mfma_f32_32x32x16_bf16(ah[kb_], bl_, d_, 0, 0, 0); } \
              const int n_ = wv * 256 + 32 * (NT) + tl, c_ = n_ & 511, od_ = n_ >> 9; const float dl_ = fabsf(min_decay + (float)c_ * ((max_decay - min_decay) / 511.0f)) * (1.0f / (float)(S - 1)); \
              bf16* fo_ = FILT + (((size_t)l * 4 + od_) * C + c_) * S + t0 + 4 * kh; \
              _Pragma("unroll") for (int g_ = 0; g_ < 4; ++g_) { const float tb_ = (float)(t0 + 8 * g_ + 4 * kh); v2u o_; \
                  o_.x = pk2(d_[4 * g_] * expf(-tb_ * dl_), d_[4 * g_ + 1] * expf(-(tb_ + 1.f) * dl_)); o_.y = pk2(d_[4 * g_ + 2] * expf(-(tb_ + 2.f) * dl_), d_[4 * g_ + 3] * expf(-(tb_ + 3.f) * dl_)); \
                  *(v2u*)(fo_ + 8 * g_) = o_; } } while (0)
            FLOADW(0, 0);
#pragma unroll 1
            for (int nt = 0; nt < 8; nt += 2) { FLOADW(1, nt + 1); FTILE(0, nt); if (nt + 2 < 8) FLOADW(0, nt + 2); FTILE(1, nt + 1); }
#undef FSPLIT
#undef FLOADW
#undef FTILE
        }
    }
    __syncthreads();
}
template <int MAP> __device__ __forceinline__ void p0_convert(const Ctx& X, const float* W, int K, int N, bf16* WB, int dN, int nmat, size_t sstride, size_t dstride, const float* __restrict__ rscale = nullptr) {
    const int nblk = N / 256, per = (K / 16) * nblk, tot = per * nmat, lane = X.lane;
    f32x4 v[16];
    int it = X.gw;
#define CV_SRC(it_) (W + (size_t)((it_) / per) * sstride + (size_t)(16 * (((it_) % per) / nblk)) * N + 256 * (((it_) % per) % nblk) + 4 * lane)
    if (it < tot) { const float* s = CV_SRC(it);
#pragma unroll
        for (int i = 0; i < 16; ++i) v[i] = __builtin_nontemporal_load((const f32x4*)(s + (size_t)i * N)); }
    while (it < tot) {
        v2u o[16];
        if (rscale) { const int k0s = 16 * ((it % per) / nblk);
#pragma unroll
            for (int i = 0; i < 16; ++i) { const float sc = rscale[k0s + i]; o[i].x = cvtpk_(v[i][0] * sc, v[i][1] * sc); o[i].y = cvtpk_(v[i][2] * sc, v[i][3] * sc); } }
        else {
#pragma unroll
        for (int i = 0; i < 16; ++i) { o[i].x = cvtpk_(v[i][0], v[i][1]); o[i].y = cvtpk_(v[i][2], v[i][3]); } }
        const int nit = it + X.ngw;
        if (nit < tot) { const float* s = CV_SRC(nit);
#pragma unroll
            for (int i = 0; i < 16; ++i) v[i] = __builtin_nontemporal_load((const f32x4*)(s + (size_t)i * N)); }
        const int mi = it / per, r = it - mi * per, k0 = 16 * (r / nblk), n = 256 * (r % nblk) + 4 * lane;
        const int dc = MAP == 0 ? n : (((n >> 7) << 8) + (n & 127) + (MAP == 3 ? 128 : 0));
        bf16* dst = WB + (size_t)mi * dstride + (size_t)k0 * dN + dc;
#pragma unroll
        for (int i = 0; i < 16; ++i) __builtin_nontemporal_store(o[i], (v2u*)(dst + (size_t)i * dN));
        it = nit;
    }
#undef CV_SRC
}
__device__ __forceinline__ void p0_experts(const Ctx& X, const Args& a, int l) {
    bf16* wgu = (bf16*)(X.ws + WS_WGU) + (size_t)l * E * 2 * F * D; bf16* wd = (bf16*)(X.ws + WS_WD) + (size_t)l * E * F * D;
    p0_convert<2>(X, a.in[25] + (size_t)l * E * D * F, D, F, wgu, 2 * F, E, (size_t)D * F, (size_t)2 * F * D, a.in[22] + l * D);
    p0_convert<3>(X, a.in[26] + (size_t)l * E * D * F, D, F, wgu, 2 * F, E, (size_t)D * F, (size_t)2 * F * D, a.in[22] + l * D);
    p0_convert<0>(X, a.in[27] + (size_t)l * E * D * F, F, D, wd, D, E, (size_t)F * D, (size_t)F * D);
}
__device__ __forceinline__ void p0_experts_rest(const Ctx& X, const Args& a, int l, int me0) {
    bf16* wgu = (bf16*)(X.ws + WS_WGU) + (size_t)l * E * 2 * F * D; bf16* wd = (bf16*)(X.ws + WS_WD) + (size_t)l * E * F * D;
    const int g0 = me0 < 16 ? me0 : 16, u0 = me0 < 16 ? 0 : (me0 < 32 ? me0 - 16 : 16), d0 = me0 < 32 ? 0 : me0 - 32;
    if (g0 < 16) p0_convert<2>(X, a.in[25] + ((size_t)l * E + g0) * D * F, D, F, wgu + (size_t)g0 * 2 * F * D, 2 * F, E - g0, (size_t)D * F, (size_t)2 * F * D, a.in[22] + l * D);
    if (u0 < 16) p0_convert<3>(X, a.in[26] + ((size_t)l * E + u0) * D * F, D, F, wgu + (size_t)u0 * 2 * F * D, 2 * F, E - u0, (size_t)D * F, (size_t)2 * F * D, a.in[22] + l * D);
    if (d0 < 16) p0_convert<0>(X, a.in[27] + ((size_t)l * E + d0) * D * F, F, D, wd + (size_t)d0 * F * D, D, E - d0, (size_t)F * D, (size_t)F * D);
}
#ifndef MK_P0_DUP
#define MK_P0_DUP 0
#endif
__device__ __forceinline__ void p0_prologue(const Ctx& X, const Args& a) {
    const int m = a.p0_mask;
    for (int dup_ = 0; dup_ < ((MK_P0_DUP & 1) ? 2 : 1); ++dup_)
    if (m & 1) {
        p0_transpose<1>(X, a.in[2], D, INW, (bf16*)(X.ws + WS_WIN), 2, (size_t)D * INW, (size_t)D * INW);
        p0_transpose<0>(X, a.in[19], C, D, (bf16*)(X.ws + WS_WUH), 2, (size_t)C * D, (size_t)2 * C * D, 512 % X.ngw);
        p0_transpose<0>(X, a.in[20], C, D, (bf16*)(X.ws + WS_WUA), 2, (size_t)C * D, (size_t)2 * C * D, 768 % X.ngw);
        p0_transpose<0>(X, a.in[21], D, D, (bf16*)(X.ws + WS_WOUT), 2, (size_t)D * D, (size_t)D * D, 1024 % X.ngw);
        float* binp = (float*)(X.ws + WS_BINP);
        for (int i = X.gw * 64 + X.lane; i < 2 * INW; i += X.ngw * 64) { const int l = i / INW, n = i - l * INW; binp[l * INW + rowmap<1>(n)] = a.in[3][i]; }
        { bf16* wrp = (bf16*)(X.ws + WS_WRP);
          for (int i = X.gw * 64 + X.lane; i < 2 * E * D; i += X.ngw * 64) { const int l = i / (E * D), e = (i / D) % E, k = i % D; const float v = a.in[22][l * D + k] * a.in[23][((size_t)l * D + k) * E + e];
              const unsigned hi = f2bf(v); const float lo = v - __builtin_bit_cast(float, hi << 16); wrp[((l * 2 + 0) * E + e) * D + k] = (bf16)hi; wrp[((l * 2 + 1) * E + e) * D + k] = (bf16)f2bf(lo); } }
        float* rope = (float*)(X.ws + WS_ROPE);
        for (int i = X.gw * 64 + X.lane; i < S * 32; i += X.ngw * 64) { const int pos = i >> 5, j = i & 31; const float inv = powf(10000.0f, -(float)j * 2.0f / 64.0f); float sn, cs; sincosf((float)pos * inv, &sn, &cs); rope[2 * i] = cs; rope[2 * i + 1] = sn; }
    }
    if (m & 2) { p0_experts(X, a, 0); p0_experts(X, a, 1); }
    for (int dup_ = 0; dup_ < ((MK_P0_DUP & 4) ? 2 : 1); ++dup_)
    if (m & 4) p0_filters(X, a);
    for (int dup_ = 0; dup_ < ((MK_P0_DUP & 8) ? 2 : 1); ++dup_)
    if (m & 8) {
        bf16* XN = (bf16*)(X.ws + WS_XN); const int lane = X.lane; Row8 gg; row8_load(gg, a.in[1], lane);
        int r = X.gw; Row8 cur; if (r < T) row8_load(cur, a.in[0] + (size_t)r * D, lane);
        while (r < T) { const int nr = r + X.ngw; Row8 nxt; if (nr < T) row8_load(nxt, a.in[0] + (size_t)nr * D, lane);
            const float rs = rsqrtf(wave_sum(row8_sumsq(cur)) * (1.f / D) + 1e-6f);
#pragma unroll
            for (int j = 0; j < 2; ++j) { const f32x4 y0 = cur.a[j][0] * gg.a[j][0] * rs, y1 = cur.a[j][1] * gg.a[j][1] * rs;
                v4u w; w.x = pk2(y0.x, y0.y); w.y = pk2(y0.z, y0.w); w.z = pk2(y1.x, y1.y); w.w = pk2(y1.z, y1.w); ((v4u*)(XN + (size_t)r * D))[lane + 64 * j] = w; }
            cur = nxt; r = nr; }
    }
}
}
namespace mk {
using pg8::Unit;
#ifndef MK_SIMPLE_ORDER
#define MK_SIMPLE_ORDER 0
#endif
__device__ __forceinline__ unsigned cvtpk(float lo, float hi) { unsigned r; asm volatile("v_cvt_pk_bf16_f32 %0, %1, %2" : "=v"(r) : "v"(lo), "v"(hi)); return r; }
__device__ __forceinline__ v4u pack8(f32x4 a, f32x4 b) { v4u w; w.x = cvtpk(a[0], a[1]); w.y = cvtpk(a[2], a[3]); w.z = cvtpk(b[0], b[1]); w.w = cvtpk(b[2], b[3]); return w; }
__device__ __forceinline__ void unpack8(v4u w, f32x4& a, f32x4& b) { a = (f32x4){bflo(w.x), bfhi(w.x), bflo(w.y), bfhi(w.y)}; b = (f32x4){bflo(w.z), bfhi(w.z), bflo(w.w), bfhi(w.w)}; }
__device__ __forceinline__ float fsig(float x) { return __builtin_amdgcn_rcpf(1.f + __expf(-x)); }

struct EpiWin {
    static constexpr bool PERM = true, AFTER_DRAIN = false;
    unsigned char* ws; const float* bias; const float* rope;
    __device__ __forceinline__ void operator()(const f32x4 (&acc)[2][2][4][2], const Unit& u, int wr, int wc, int fr, int fq) const {
        const int colt = u.pn * 256, row0 = u.pm * 256 + wr * 64 + fr, cin = wc * 32 + 8 * fq;
        bf16* base; int ldc, col0, mode; float sc = 1.f;
        if (colt < 1536) { base = (bf16*)(ws + WS_U); ldc = 1536; col0 = colt; mode = 0; }
        else if (colt < 2048) { base = (bf16*)(ws + WS_Q); ldc = 512; col0 = colt - 1536; mode = 1; sc = QSCALE; }
        else if (colt < 2560) { base = (bf16*)(ws + WS_K); ldc = 512; col0 = colt - 2048; mode = 1; }
        else if (colt < 3072) { base = (bf16*)(ws + WS_V); ldc = 512; col0 = colt - 2560; mode = 0; }
        else if (colt < 4096) { base = (bf16*)(ws + WS_GH); ldc = 1024; col0 = colt - 3072; mode = 2; }
        else { base = (bf16*)(ws + WS_GA); ldc = 1024; col0 = colt - 4096; mode = 2; }
        f32x4 bv[2][2];
#pragma unroll
        for (int bj = 0; bj < 2; ++bj)
#pragma unroll
            for (int n = 0; n < 2; ++n) bv[bj][n] = *(const f32x4*)(bias + colt + bj * 128 + cin + 4 * n);
#pragma unroll
        for (int ai = 0; ai < 2; ++ai)
#pragma unroll
            for (int m = 0; m < 4; ++m) {
                const int row = row0 + ai * 128 + m * 16; bf16* rowp = base + (size_t)row * ldc + col0 + cin;
                f32x4 rq[2][2];
                if (mode == 1) {
#pragma unroll
                    for (int bj = 0; bj < 2; ++bj) { const int i = ((bj * 128 + cin) & 63) >> 3; const float* rp = rope + ((size_t)(row & (S - 1)) * 32 + 4 * i) * 2; rq[bj][0] = *(const f32x4*)rp; rq[bj][1] = *(const f32x4*)(rp + 4); } }
#pragma unroll
                for (int bj = 0; bj < 2; ++bj) {
                    f32x4 v0 = acc[ai][bj][m][0] + bv[bj][0], v1 = acc[ai][bj][m][1] + bv[bj][1];
                    if (mode == 1) {
                        const f32x4 r0 = rq[bj][0], r1 = rq[bj][1];
                        const f32x4 cs = {r0[0], r0[2], r1[0], r1[2]}, sn = {r0[1], r0[3], r1[1], r1[3]};
                        const f32x4 o1 = (v0 * cs - v1 * sn) * sc, o2 = (v1 * cs + v0 * sn) * sc; v0 = o1; v1 = o2;
                    } else if (mode == 2) {
#pragma unroll
                        for (int e = 0; e < 4; ++e) { v0[e] = fsig(v0[e]); v1[e] = fsig(v1[e]); }
                    }
                    *(v4u*)(rowp + bj * 128) = pack8(v0, v1);
                }
            }
    }
};
struct EpiMerge2 {
    static constexpr bool PERM = true, AFTER_DRAIN = false;
    const bf16* GH; const bf16* GA; bf16* T1; bf16* MG;
    __device__ __forceinline__ void operator()(const f32x4 (&acc)[2][2][4][2], const Unit& u, int wr, int wc, int fr, int fq) const {
        const int row0 = u.pm * 256 + wr * 64 + fr, col0 = u.pn * 256 + wc * 32 + 8 * fq; const bool second = u.pa != u.pm; const bf16* G = second ? GA : GH;
#pragma unroll
        for (int ai = 0; ai < 2; ++ai)
#pragma unroll
            for (int mp = 0; mp < 4; mp += 2) {
                v4u gq[2][2], tq[2][2];
#pragma unroll
                for (int mm = 0; mm < 2; ++mm)
#pragma unroll
                    for (int bj = 0; bj < 2; ++bj) { const size_t off = (size_t)(row0 + ai * 128 + (mp + mm) * 16) * D + col0 + bj * 128; gq[mm][bj] = *(const v4u*)(G + off); if (second) tq[mm][bj] = *(const v4u*)(T1 + off); }
#pragma unroll
                for (int mm = 0; mm < 2; ++mm) { const int m = mp + mm; const size_t off = (size_t)(row0 + ai * 128 + m * 16) * D + col0;
#pragma unroll
                    for (int bj = 0; bj < 2; ++bj) { f32x4 g0, g1; unpack8(gq[mm][bj], g0, g1);
                        f32x4 v0 = acc[ai][bj][m][0] * g0, v1 = acc[ai][bj][m][1] * g1;
                        if (second) { f32x4 t0, t1; unpack8(tq[mm][bj], t0, t1); v0 += t0; v1 += t1; *(v4u*)(MG + off + bj * 128) = pack8(v0, v1); }
                        else *(v4u*)(T1 + off + bj * 128) = pack8(v0, v1); } } }
    }
};
struct OrderMerge {
    pg8::StaticOrder so;
    __device__ __forceinline__ bool next(int i, Unit& u) const { if (!so.next(i >> 1, u)) return false; if (i & 1) { u.pa = u.pm + T / 256; u.pb = u.pn + 4; } return true; }
    __device__ __forceinline__ void a_ready(const Unit&) const {}
    __device__ __forceinline__ void done(const Unit&) const {}
};
struct EpiOut {
    static constexpr bool PERM = false, AFTER_DRAIN = false;
    const float* xin; float* X;
    __device__ __forceinline__ void operator()(const f32x4 (&acc)[2][2][4][2], const Unit& u, int wr, int wc, int fr, int fq) const {
        const int row0 = u.pm * 256 + wr * 64 + fr, col0 = u.pn * 256 + wc * 32 + 4 * fq;
#pragma unroll
        for (int ai = 0; ai < 2; ++ai)
#pragma unroll
            for (int m = 0; m < 4; ++m) { const size_t off = (size_t)(row0 + ai * 128 + m * 16) * D + col0;
#pragma unroll
                for (int bj = 0; bj < 2; ++bj)
#pragma unroll
                    for (int n = 0; n < 2; ++n) *(f32x4*)(X + off + bj * 128 + n * 16) = *(const f32x4*)(xin + off + bj * 128 + n * 16) + acc[ai][bj][m][n]; }
    }
};
struct EpiOutR {
    static constexpr bool PERM = true, AFTER_DRAIN = true;
    const float* xin; const bf16* xin16; bf16* XB; float* PART; const bf16* WRP; unsigned* tick; float* AFFT; float* RTOK; const float* br;
    __device__ __forceinline__ void operator()(const f32x4 (&)[2][2][4][2], const Unit&, int, int, int, int) const {}
    __device__ __forceinline__ void fused(const f32x4 (&acc)[2][2][4][2], const Unit& u, int wr, int wc, int fr, int fq, LAS unsigned char* lds, int wid, int lane) const {
        LAS float* SS = (LAS float*)lds;
        LAS float* LG = (LAS float*)(lds + 16384);
        const int rowl0 = wr * 64 + fr, colw = wc * 32 + 8 * fq;
        bf16x8 whi[2], wlo[2];
#pragma unroll
        for (int bj = 0; bj < 2; ++bj) { const bf16* wp = WRP + (size_t)fr * D + u.pn * 256 + bj * 128 + colw; whi[bj] = *(const bf16x8*)wp; wlo[bj] = *(const bf16x8*)(wp + (size_t)E * D); }
#pragma unroll
        for (int ai = 0; ai < 2; ++ai)
#pragma unroll
            for (int m = 0; m < 4; ++m) { const int rowl = rowl0 + ai * 128 + m * 16; float ss = 0.f; f32x4 lg = {0.f, 0.f, 0.f, 0.f};
                f32x4 xq[2][2];
                if (xin16) {
#pragma unroll
                    for (int bj = 0; bj < 2; ++bj) { const size_t off = (size_t)(u.pm * 256 + rowl) * D + u.pn * 256 + bj * 128 + colw; unpack8(*(const v4u*)(xin16 + off), xq[bj][0], xq[bj][1]); }
                } else {
#pragma unroll
                    for (int bj = 0; bj < 2; ++bj) { const size_t off = (size_t)(u.pm * 256 + rowl) * D + u.pn * 256 + bj * 128 + colw; xq[bj][0] = *(const f32x4*)(xin + off); xq[bj][1] = *(const f32x4*)(xin + off + 4); } }
#pragma unroll
                for (int bj = 0; bj < 2; ++bj) { const size_t off = (size_t)(u.pm * 256 + rowl) * D + u.pn * 256 + bj * 128 + colw;
                    const f32x4 x0 = xq[bj][0] + acc[ai][bj][m][0], x1 = xq[bj][1] + acc[ai][bj][m][1];
                    const v4u hi = pack8(x0, x1); *(v4u*)(XB + off) = hi;
                    f32x4 h0, h1; unpack8(hi, h0, h1); const v4u lo = pack8(x0 - h0, x1 - h1);
                    ss += ((x0[0] * x0[0] + x0[1] * x0[1]) + (x0[2] * x0[2] + x0[3] * x0[3])) + ((x1[0] * x1[0] + x1[1] * x1[1]) + (x1[2] * x1[2] + x1[3] * x1[3]));
                    lg = __builtin_amdgcn_mfma_f32_16x16x32_bf16(whi[bj], __builtin_bit_cast(bf16x8, hi), lg, 0, 0, 0);
                    lg = __builtin_amdgcn_mfma_f32_16x16x32_bf16(whi[bj], __builtin_bit_cast(bf16x8, lo), lg, 0, 0, 0);
                    lg = __builtin_amdgcn_mfma_f32_16x16x32_bf16(wlo[bj], __builtin_bit_cast(bf16x8, hi), lg, 0, 0, 0); }
                SS[rowl * 16 + wc * 4 + fq] = ss;
                *(LAS f32x4*)(LG + ((wc * 256 + rowl) * 16 + 4 * fq)) = lg; }
        __syncthreads();
        const int t = wid * 64 + lane;
        if (t < 256) { float s = 0.f;
#pragma unroll
            for (int i = 0; i < 4; ++i) { const f32x4 v = *(const LAS f32x4*)(SS + t * 16 + 4 * i); s += (v[0] + v[1]) + (v[2] + v[3]); }
            float* pp = PART + ((size_t)u.pn * T + u.pm * 256 + t) * 20;
            __hip_atomic_store(pp, s, __ATOMIC_RELAXED, __HIP_MEMORY_SCOPE_AGENT);
#pragma unroll
            for (int i = 0; i < 4; ++i) { f32x4 a4 = *(const LAS f32x4*)(LG + (t * 16 + 4 * i));
#pragma unroll
                for (int w = 1; w < 4; ++w) a4 += *(const LAS f32x4*)(LG + ((w * 256 + t) * 16 + 4 * i));
#pragma unroll
                for (int q = 0; q < 4; ++q) __hip_atomic_store(pp + 4 + 4 * i + q, a4[q], __ATOMIC_RELAXED, __HIP_MEMORY_SCOPE_AGENT); } }
        asm volatile("s_waitcnt vmcnt(0)" ::: "memory");
        __syncthreads();
        LAS int* flag = (LAS int*)(lds + 16384 + 65536);
        if (t == 0) flag[0] = (int)__hip_atomic_fetch_add(tick + u.pm, 1u, __ATOMIC_RELAXED, __HIP_MEMORY_SCOPE_AGENT);
        __syncthreads();
        if (flag[0] == 3) {
            if (t < 256) { const int tok = u.pm * 256 + t; f32x4 s4 = {0.f, 0.f, 0.f, 0.f}, l4[4];
#pragma unroll
                for (int j = 0; j < 4; ++j) l4[j] = (f32x4){0.f, 0.f, 0.f, 0.f};
#pragma unroll
                for (int pn = 0; pn < 4; ++pn) { const float* pq = PART + ((size_t)pn * T + tok) * 20; s4[0] += __hip_atomic_load(pq, __ATOMIC_RELAXED, __HIP_MEMORY_SCOPE_AGENT);
#pragma unroll
                    for (int j = 0; j < 4; ++j)
#pragma unroll
                        for (int q = 0; q < 4; ++q) l4[j][q] += __hip_atomic_load(pq + 4 + 4 * j + q, __ATOMIC_RELAXED, __HIP_MEMORY_SCOPE_AGENT); }
                const float r = rsqrtf(s4[0] * (1.f / D) + 1e-6f); float mx = -1e30f;
#pragma unroll
                for (int j = 0; j < 4; ++j)
#pragma unroll
                    for (int q = 0; q < 4; ++q) { const float v = l4[j][q] * r + br[4 * j + q]; l4[j][q] = v; mx = fmaxf(mx, v); }
                float l = 0.f;
#pragma unroll
                for (int j = 0; j < 4; ++j)
#pragma unroll
                    for (int q = 0; q < 4; ++q) { l4[j][q] = expf(l4[j][q] - mx); l += l4[j][q]; }
                const int b = tok >> 12, s_ = tok & (S - 1);
#pragma unroll
                for (int j = 0; j < 4; ++j)
#pragma unroll
                    for (int q = 0; q < 4; ++q) AFFT[((size_t)b * E + 4 * j + q) * S + s_] = l4[j][q] / l;
                RTOK[tok] = r; } }
        __syncthreads();
    }
};
struct EpiSwiGLU {
    static constexpr bool PERM = true, AFTER_DRAIN = false;
    bf16* HB; const float* RSL;
    __device__ __forceinline__ void operator()(const f32x4 (&acc)[2][2][4][2], const Unit& u, int wr, int wc, int fr, int fq) const {
        const int row0 = u.pm * 256 + wr * 64 + fr, col0 = u.pn * 128 + wc * 32 + 8 * fq;
        float rrv[2][4];
#pragma unroll
        for (int ai = 0; ai < 2; ++ai)
#pragma unroll
            for (int m = 0; m < 4; ++m) rrv[ai][m] = RSL[row0 + ai * 128 + m * 16];
#pragma unroll
        for (int ai = 0; ai < 2; ++ai)
#pragma unroll
            for (int m = 0; m < 4; ++m) { f32x4 h[2]; const float rr = rrv[ai][m];
#pragma unroll
                for (int n = 0; n < 2; ++n) { const f32x4 g = acc[ai][0][m][n] * rr, up = acc[ai][1][m][n] * rr;
#pragma unroll
                    for (int e = 0; e < 4; ++e) h[n][e] = g[e] * fsig(g[e]) * up[e]; }
                *(v4u*)(HB + (size_t)(row0 + ai * 128 + m * 16) * F + col0) = pack8(h[0], h[1]); }
    }
};
struct EpiDown {
    static constexpr bool PERM = true, AFTER_DRAIN = false;
    bf16* YE; const float* gate;
    __device__ __forceinline__ void operator()(const f32x4 (&acc)[2][2][4][2], const Unit& u, int wr, int wc, int fr, int fq) const {
        const int row0 = u.pm * 256 + wr * 64 + fr, col0 = u.pn * 256 + wc * 32 + 8 * fq;
        float gv[2][4];
#pragma unroll
        for (int ai = 0; ai < 2; ++ai)
#pragma unroll
            for (int m = 0; m < 4; ++m) gv[ai][m] = gate[row0 + ai * 128 + m * 16];
#pragma unroll
        for (int ai = 0; ai < 2; ++ai)
#pragma unroll
            for (int m = 0; m < 4; ++m) { const int row = row0 + ai * 128 + m * 16; const float g = gv[ai][m];
#pragma unroll
                for (int bj = 0; bj < 2; ++bj) *(v4u*)(YE + (size_t)row * D + col0 + bj * 128) = pack8(acc[ai][bj][m][0] * g, acc[ai][bj][m][1] * g); }
    }
};
struct OrderMoE1 {
    int G, c;
    __device__ __forceinline__ bool next(int i, Unit& u) const {
        if (MK_SIMPLE_ORDER || G != 256) { const int L = i * G + c; if (L >= 2048) return false; const int e = L >> 7, r = L & 127; u.pm = e * 8 + (r & 7); u.pn = r >> 3; u.pb = e * 16 + u.pn; u.pa = u.pm; return true; }
        if (i >= 8) return false;
        const int ch = i * 8 + (c & 7), j = c >> 3, e = ch >> 2, ng = ch & 3; u.pm = e * 8 + (j & 7); u.pn = ng * 4 + (j >> 3); u.pb = e * 16 + u.pn; u.pa = u.pm; return true;
    }
    __device__ __forceinline__ void a_ready(const Unit&) const {}
    __device__ __forceinline__ void done(const Unit&) const {}
};
struct OrderMoE2 {
    int G, c;
    __device__ __forceinline__ bool next(int i, Unit& u) const {
        if (MK_SIMPLE_ORDER || G != 256) { const int L = i * G + c; if (L >= 512) return false; const int e = L >> 5, r = L & 31; u.pm = e * 8 + (r & 7); u.pn = r >> 3; u.pb = e * 4 + u.pn; u.pa = u.pm; return true; }
        if (i >= 2) return false;
        const int e = i * 8 + (c & 7), j = c >> 3; u.pm = e * 8 + (j & 7); u.pn = j >> 3; u.pb = e * 4 + u.pn; u.pa = u.pm; return true;
    }
    __device__ __forceinline__ void a_ready(const Unit&) const {}
    __device__ __forceinline__ void done(const Unit&) const {}
};

__device__ __forceinline__ void p6_topk(const Ctx& X) {
    const float* afft = (const float*)(X.ws + WS_AFFT); const float* rtok = (const float*)(X.ws + WS_RTOK); int* rows = (int*)(X.ws + WS_ROWS); float* gate = (float*)(X.ws + WS_GATE); float* rsl = (float*)(X.ws + WS_RSL); int* inv = (int*)(X.ws + WS_INV);
    for (int p = X.bid; p < B * E; p += X.G) { const int b = p >> 4, e = p & 15, slotbase = e * 2048 + b * 512;
        unsigned key[8]; float rr[8];
        { const uint4 k0 = ((const uint4*)(afft + (size_t)p * S))[X.tid * 2], k1 = ((const uint4*)(afft + (size_t)p * S))[X.tid * 2 + 1]; const f32x4 r0 = ((const f32x4*)(rtok + b * S))[X.tid * 2], r1 = ((const f32x4*)(rtok + b * S))[X.tid * 2 + 1];
          key[0] = k0.x; key[1] = k0.y; key[2] = k0.z; key[3] = k0.w; key[4] = k1.x; key[5] = k1.y; key[6] = k1.z; key[7] = k1.w;
          rr[0] = r0[0]; rr[1] = r0[1]; rr[2] = r0[2]; rr[3] = r0[3]; rr[4] = r1[0]; rr[5] = r1[1]; rr[6] = r1[2]; rr[7] = r1[3]; }
        tk::topk_problem(key, rr, b * S, e, slotbase, rows + slotbase, gate + slotbase, rsl + slotbase, inv, (int*)(X.lds), X.tid); }
}
__device__ __forceinline__ void p9_combine(const Ctx& X, bf16* XR, const float* __restrict__ g, bool final_, float* __restrict__ out) {
    const int* inv = (const int*)(X.ws + WS_INV); const bf16* YE = (const bf16*)(X.ws + WS_YE); bf16* XN = (bf16*)(X.ws + WS_XN); const int lane = X.lane;
    Row8 gg; row8_load(gg, g, lane);
    int tok = X.gw; Row8 cur; int myinv = -1;
    if (tok < T) { row8_load16(cur, XN + (size_t)tok * D, lane); if (lane < 16) myinv = inv[(size_t)tok * E + lane]; }
    while (tok < T) {
        const int ntok = tok + X.ngw; Row8 nxt; int ninv = -1;
        if (ntok < T) { row8_load16(nxt, XN + (size_t)ntok * D, lane); if (lane < 16) ninv = inv[(size_t)ntok * E + lane]; }
        unsigned long long m = __ballot(myinv >= 0);
        while (m) {
            int sl[4];
#pragma unroll
            for (int i = 0; i < 4; ++i) { if (m) { const int e = __builtin_ctzll(m); m &= m - 1; sl[i] = __builtin_amdgcn_readlane(myinv, e); } else sl[i] = -1; }
            v4u y[4][2];
#pragma unroll
            for (int i = 0; i < 4; ++i) if (sl[i] >= 0) { const v4u* yp = (const v4u*)(YE + (size_t)sl[i] * D); y[i][0] = __builtin_nontemporal_load(yp + lane); y[i][1] = __builtin_nontemporal_load(yp + lane + 64); }
#pragma unroll
            for (int i = 0; i < 4; ++i) if (sl[i] >= 0) {
#pragma unroll
                for (int j = 0; j < 2; ++j) { f32x4 p, q; unpack8(y[i][j], p, q); cur.a[j][0] += p; cur.a[j][1] += q; } }
        }
        const float r = rsqrtf(wave_sum(row8_sumsq(cur)) * (1.f / D) + 1e-6f);
        if (final_) {
#pragma unroll
            for (int j = 0; j < 2; ++j)
#pragma unroll
                for (int h = 0; h < 2; ++h) ((f32x4*)(out + (size_t)tok * D))[2 * (lane + 64 * j) + h] = cur.a[j][h] * gg.a[j][h] * r;
        } else {
#pragma unroll
            for (int j = 0; j < 2; ++j) {
                { v4u xw; xw.x = pk2(cur.a[j][0].x, cur.a[j][0].y); xw.y = pk2(cur.a[j][0].z, cur.a[j][0].w); xw.z = pk2(cur.a[j][1].x, cur.a[j][1].y); xw.w = pk2(cur.a[j][1].z, cur.a[j][1].w); ((v4u*)(XR + (size_t)tok * D))[lane + 64 * j] = xw; }
                const f32x4 y0 = cur.a[j][0] * gg.a[j][0] * r, y1 = cur.a[j][1] * gg.a[j][1] * r;
                v4u w; w.x = pk2(y0.x, y0.y); w.y = pk2(y0.z, y0.w); w.z = pk2(y1.x, y1.y); w.w = pk2(y1.z, y1.w);
                ((v4u*)(XN + (size_t)tok * D))[lane + 64 * j] = w; }
        }
        cur = nxt; myinv = ninv; tok = ntok;
    }
}
}
namespace mk {
__device__ __forceinline__ void p1t_shortconv(const Ctx& X, const float* __restrict__ cw, const float* __restrict__ cb) {
    const bf16* U = (const bf16*)(X.ws + WS_U); bf16* UCT = (bf16*)(X.ws + WS_UCT);
    LAS float* raw = (LAS float*)(X.lds + X.wave * 17408);
    const int lane = X.lane, rq = lane >> 3, cq = lane & 7;
    constexpr int NIT = (T / 64) * 24;
    v4u w[9];
#define P1T_LOAD(it_) do { const int tt_ = (it_) / 24, cg_ = (it_) - tt_ * 24, tok0_ = tt_ * 64, tin_ = tok0_ & (S - 1); \
        _Pragma("unroll") for (int i = 0; i < 9; ++i) { const int r = 8 * i + rq, tpos = tin_ + r - 1; w[i] = (v4u){0u, 0u, 0u, 0u}; \
            if (r < 66 && tpos >= 0 && tpos < S) w[i] = *(const v4u*)(U + (size_t)(tok0_ + r - 1) * 1536 + cg_ * 64 + 8 * cq); } } while (0)
    int it = X.gw;
    if (it < NIT) P1T_LOAD(it);
    while (it < NIT) {
        const int tt = it / 24, cg = it - tt * 24, tok0 = tt * 64, ch0 = cg * 64;
#pragma unroll
        for (int i = 0; i < 9; ++i) { const int r = 8 * i + rq; if (r < 66) { LAS float* d = raw + r * 65 + 8 * cq; f32x4 p, q; unpack8(w[i], p, q);
            d[0] = p.x; d[1] = p.y; d[2] = p.z; d[3] = p.w; d[4] = q.x; d[5] = q.y; d[6] = q.z; d[7] = q.w; } }
        const int nit = it + X.ngw;
        if (nit < NIT) P1T_LOAD(nit);
        asm volatile("s_waitcnt lgkmcnt(0)" ::: "memory");
        const int chs = lane >> 3, tch = lane & 7;
#pragma unroll
        for (int g = 0; g < 8; ++g) { const int ch = 8 * g + chs, gc = ch0 + ch; const float w0 = cw[gc], w1 = cw[1536 + gc], w2 = cw[3072 + gc], bb = cb[gc];
            float v[10];
#pragma unroll
            for (int k = 0; k < 10; ++k) v[k] = raw[(8 * tch + k) * 65 + ch];
            float o[8];
#pragma unroll
            for (int k = 0; k < 8; ++k) o[k] = v[k] * w0 + v[k + 1] * w1 + v[k + 2] * w2 + bb;
            v4u pk; pk.x = pk2(o[0], o[1]); pk.y = pk2(o[2], o[3]); pk.z = pk2(o[4], o[5]); pk.w = pk2(o[6], o[7]);
            *(v4u*)(UCT + (size_t)gc * T + tok0 + 8 * tch) = pk; }
        asm volatile("s_waitcnt lgkmcnt(0)" ::: "memory");
        it = nit;
    }
#undef P1T_LOAD
}

__device__ __forceinline__ void p1t_kmax(const Ctx& X, unsigned* kmax2) {
    const bf16* K = (const bf16*)(X.ws + WS_K); const int lane = X.lane; LAS float* red = (LAS float*)(X.lds + 8 * 17408);
    const int b = X.gw / 512, t0 = X.gw % 512; float mx = 0.f;
    if (b < B) {
        v4u w[8];
#pragma unroll
        for (int i = 0; i < 8; ++i) w[i] = ((const v4u*)(K + ((size_t)b * S + t0 + 512 * i) * 512))[lane];
#pragma unroll
        for (int i = 0; i < 8; ++i) { f32x4 p, q; unpack8(w[i], p, q); float ss = (p.x * p.x + p.y * p.y) + (p.z * p.z + p.w * p.w) + (q.x * q.x + q.y * q.y) + (q.z * q.z + q.w * q.w);
            ss += xor_f<1>(ss); ss += xor_f<2>(ss); ss += xor_f<4>(ss); mx = fmaxf(mx, ss); }
    }
    __syncthreads();
    if ((lane & 7) == 0) red[X.wave * 8 + (lane >> 3)] = mx;
    __syncthreads();
    if (X.tid < 8 && b < B) { float m = red[X.tid]; for (int w_ = 1; w_ < 8; ++w_) m = fmaxf(m, red[w_ * 8 + X.tid]); atomicMax(kmax2 + b * 8 + X.tid, __float_as_uint(m)); }
}

namespace at {
constexpr int KVBLK = 64, LDK = 512;
constexpr int KPITCH = 272;
constexpr int SHM_V = 64 * 128 * 2, SHM_K = 64 * KPITCH;
constexpr int OFF_V = 0, OFF_K = 2 * SHM_V, OFF_Q = OFF_K + 2 * SHM_K, OFF_WS = OFF_Q + 256 * KPITCH, LDS_TOTAL = OFF_WS + 8 * 160 * 4;
constexpr float THR2 = 8.0f * 1.4426950408889634f;
#define KSWZ(row, colB) ((row) * KPITCH + (colB))
#define SBAR() __builtin_amdgcn_sched_barrier(0)
__device__ __forceinline__ int crow(int r, int hi) { return (r & 3) + 8 * (r >> 2) + 4 * hi; }
__device__ __forceinline__ int v_st(int k, int c) { const int kk = (k & ~0xC) | ((k & 4) << 1) | ((k & 8) >> 1); return ((kk >> 3) * 4 + (c >> 5)) * 512 + ((kk & 7) * 32 + (c & 31)) * 2; }
__device__ __forceinline__ int v_rd_base(int lane) { return ((lane & 3) << 3) | (((lane >> 2) & 3) << 6) | (((lane >> 4) & 1) << 5) | (((lane >> 5) & 1) << 8); }
constexpr int v_rd_off(int d0, int ks, int half) { return d0 * 512 + ks * 4096 + half * 2048; }
template <int OFF> __device__ __forceinline__ s16x4 tr_read(int vb) { s16x4 r; asm volatile("ds_read_b64_tr_b16 %0, %1 offset:%2" : "=&v"(r) : "v"(vb), "i"(OFF) : "memory"); return r; }

template <int CO> __device__ __forceinline__ void qkt(f32x16& p0, f32x16& p1, const char* Ks, const char* Qs, int qrow, int r32, int hi) {
    p0 = f32x16{}; p1 = f32x16{};
    const char* qp = Qs + KSWZ(qrow, (CO * 64 + hi * 8) * 2); const char* kp = Ks + KSWZ(r32, (CO * 64 + hi * 8) * 2);
#pragma unroll
    for (int d0 = 0; d0 < 4; ++d0) {
        const bf16x8 qf = *reinterpret_cast<const bf16x8*>(qp + d0 * 32);
        const bf16x8 b0 = *reinterpret_cast<const bf16x8*>(kp + d0 * 32);
        const bf16x8 b1 = *reinterpret_cast<const bf16x8*>(kp + 32 * KPITCH + d0 * 32);
        p0 = __builtin_amdgcn_mfma_f32_32x32x16_bf16(b0, qf, p0, 0, 0, 0);
        p1 = __builtin_amdgcn_mfma_f32_32x32x16_bf16(b1, qf, p1, 0, 0, 0);
        if (d0 == 1) asm volatile("" ::: "memory"); }
}
__device__ __forceinline__ void softmax_tile(f32x16& p0, f32x16& p1, float& m_reg, float& l_reg, float& alpha, bf16x8& pa0, bf16x8& pa1, bf16x8& pa2, bf16x8& pa3) {
    float pmax = p0[0];
#pragma unroll
    for (int r = 1; r < 16; ++r) pmax = fmaxf(pmax, p0[r]);
#pragma unroll
    for (int r = 0; r < 16; ++r) pmax = fmaxf(pmax, p1[r]);
    { auto rr = __builtin_amdgcn_permlane32_swap(__float_as_uint(pmax), __float_as_uint(pmax), false, false); pmax = fmaxf(__uint_as_float(rr[0]), __uint_as_float(rr[1])); }
    float mn;
    if (__builtin_expect(__all(pmax - m_reg <= THR2), 1)) { mn = m_reg; alpha = 1.f; }
    else { mn = fmaxf(m_reg, pmax); alpha = __builtin_amdgcn_exp2f(m_reg - mn); m_reg = mn; }
#pragma unroll
    for (int r = 0; r < 16; ++r) { p0[r] = __builtin_amdgcn_exp2f(p0[r] - mn); p1[r] = __builtin_amdgcn_exp2f(p1[r] - mn); }
    float ps = 0.f;
#pragma unroll
    for (int r = 0; r < 16; ++r) ps += p0[r];
#pragma unroll
    for (int r = 0; r < 16; ++r) ps += p1[r];
    { auto rr = __builtin_amdgcn_permlane32_swap(__float_as_uint(ps), __float_as_uint(ps), false, false); ps = __uint_as_float(rr[0]) + __uint_as_float(rr[1]); }
    l_reg = l_reg * alpha + ps;
#define PK4(P, BASE, OUT) do { unsigned a0 = cvtpk(P[BASE + 0], P[BASE + 1]), a1 = cvtpk(P[BASE + 2], P[BASE + 3]);   \
    unsigned b0 = cvtpk(P[BASE + 4], P[BASE + 5]), b1 = cvtpk(P[BASE + 6], P[BASE + 7]);                              \
    auto r0 = __builtin_amdgcn_permlane32_swap(a0, b0, false, false); auto r1 = __builtin_amdgcn_permlane32_swap(a1, b1, false, false); \
    v4u w = {r0[0], r1[0], r0[1], r1[1]}; OUT = *reinterpret_cast<bf16x8*>(&w); } while (0)
    PK4(p0, 0, pa0); PK4(p0, 8, pa1); PK4(p1, 0, pa2); PK4(p1, 8, pa3);
#undef PK4
}
__device__ __forceinline__ void softmax_fixed(f32x16& p0, f32x16& p1, float m, float& l_half, bf16x8& pa0, bf16x8& pa1, bf16x8& pa2, bf16x8& pa3) {
#pragma unroll
    for (int r = 0; r < 16; ++r) { p0[r] = __builtin_amdgcn_exp2f(p0[r] - m); p1[r] = __builtin_amdgcn_exp2f(p1[r] - m); }
    float ps = 0.f;
#pragma unroll
    for (int r = 0; r < 16; ++r) ps += p0[r] + p1[r];
    l_half += ps;
#define PK4(P, BASE, OUT) do { unsigned a0 = cvtpk(P[BASE + 0], P[BASE + 1]), a1 = cvtpk(P[BASE + 2], P[BASE + 3]);   \
    unsigned b0 = cvtpk(P[BASE + 4], P[BASE + 5]), b1 = cvtpk(P[BASE + 6], P[BASE + 7]);                              \
    auto r0 = __builtin_amdgcn_permlane32_swap(a0, b0, false, false); auto r1 = __builtin_amdgcn_permlane32_swap(a1, b1, false, false); \
    v4u w = {r0[0], r1[0], r0[1], r1[1]}; OUT = *reinterpret_cast<bf16x8*>(&w); } while (0)
    PK4(p0, 0, pa0); PK4(p0, 8, pa1); PK4(p1, 0, pa2); PK4(p1, 8, pa3);
#undef PK4
}
template <int D0> __device__ __forceinline__ void pv_one(f32x16& oa, int vb, const bf16x8 (&pa)[4]) {
#define PK(L, H) (bf16x8){L[0], L[1], L[2], L[3], H[0], H[1], H[2], H[3]}
    {   const s16x4 l0 = tr_read<v_rd_off(D0, 0, 0)>(vb), h0 = tr_read<v_rd_off(D0, 0, 1)>(vb), l1 = tr_read<v_rd_off(D0, 1, 0)>(vb), h1 = tr_read<v_rd_off(D0, 1, 1)>(vb);
        asm volatile("s_waitcnt lgkmcnt(0)" ::: "memory"); SBAR();
        oa = __builtin_amdgcn_mfma_f32_32x32x16_bf16(pa[0], PK(l0, h0), oa, 0, 0, 0);
        oa = __builtin_amdgcn_mfma_f32_32x32x16_bf16(pa[1], PK(l1, h1), oa, 0, 0, 0); }
    {   const s16x4 l2 = tr_read<v_rd_off(D0, 2, 0)>(vb), h2 = tr_read<v_rd_off(D0, 2, 1)>(vb), l3 = tr_read<v_rd_off(D0, 3, 0)>(vb), h3 = tr_read<v_rd_off(D0, 3, 1)>(vb);
        asm volatile("s_waitcnt lgkmcnt(0)" ::: "memory"); SBAR();
        oa = __builtin_amdgcn_mfma_f32_32x32x16_bf16(pa[2], PK(l2, h2), oa, 0, 0, 0);
        oa = __builtin_amdgcn_mfma_f32_32x32x16_bf16(pa[3], PK(l3, h3), oa, 0, 0, 0); }
#undef PK
}
template <int D0> __device__ __forceinline__ void pv_two(f32x16& oa, f32x16& ob, int vb, const bf16x8 (&pa)[4], const bf16x8 (&pb)[4]) {
#define PK(L, H) (bf16x8){L[0], L[1], L[2], L[3], H[0], H[1], H[2], H[3]}
    {   const s16x4 l0 = tr_read<v_rd_off(D0, 0, 0)>(vb), h0 = tr_read<v_rd_off(D0, 0, 1)>(vb), l1 = tr_read<v_rd_off(D0, 1, 0)>(vb), h1 = tr_read<v_rd_off(D0, 1, 1)>(vb);
        asm volatile("s_waitcnt lgkmcnt(0)" ::: "memory"); SBAR();
        const bf16x8 v0 = PK(l0, h0), v1 = PK(l1, h1);
        oa = __builtin_amdgcn_mfma_f32_32x32x16_bf16(pa[0], v0, oa, 0, 0, 0); ob = __builtin_amdgcn_mfma_f32_32x32x16_bf16(pb[0], v0, ob, 0, 0, 0);
        oa = __builtin_amdgcn_mfma_f32_32x32x16_bf16(pa[1], v1, oa, 0, 0, 0); ob = __builtin_amdgcn_mfma_f32_32x32x16_bf16(pb[1], v1, ob, 0, 0, 0); }
    {   const s16x4 l2 = tr_read<v_rd_off(D0, 2, 0)>(vb), h2 = tr_read<v_rd_off(D0, 2, 1)>(vb), l3 = tr_read<v_rd_off(D0, 3, 0)>(vb), h3 = tr_read<v_rd_off(D0, 3, 1)>(vb);
        asm volatile("s_waitcnt lgkmcnt(0)" ::: "memory"); SBAR();
        const bf16x8 v2 = PK(l2, h2), v3 = PK(l3, h3);
        oa = __builtin_amdgcn_mfma_f32_32x32x16_bf16(pa[2], v2, oa, 0, 0, 0); ob = __builtin_amdgcn_mfma_f32_32x32x16_bf16(pb[2], v2, ob, 0, 0, 0);
        oa = __builtin_amdgcn_mfma_f32_32x32x16_bf16(pa[3], v3, oa, 0, 0, 0); ob = __builtin_amdgcn_mfma_f32_32x32x16_bf16(pb[3], v3, ob, 0, 0, 0); }
#undef PK
}
__device__ __forceinline__ void rescale(f32x16 (&o)[4], float al, float* wsf, int r32, int hi) {
    if (__any(al < 1.f)) {
        if (hi == 0) wsf[r32] = al; asm volatile("s_waitcnt lgkmcnt(0)" ::: "memory");
#pragma unroll
        for (int r = 0; r < 16; ++r) { const float a = wsf[crow(r, hi)];
#pragma unroll
            for (int d = 0; d < 4; ++d) o[d][r] *= a; }
    }
}

__device__ __forceinline__ void epilogue(const Ctx& X, f32x16 (&oa)[4], f32x16 (&ob)[4], const float* wsf, int r32, int hi, int b, int h, int qb, float lam, float mul, const float* __restrict__ sg) {
    bf16* Yw = (bf16*)(X.ws + WS_YA) + ((size_t)b * S + qb * 256 + X.wave * 32) * 512 + h * 128;
    float gcol[4];
#pragma unroll
    for (int d = 0; d < 4; ++d) gcol[d] = sg[d * 32 + r32] * mul;
#pragma unroll
    for (int r = 0; r < 16; ++r) { const int orow = crow(r, hi); const float i0 = __builtin_amdgcn_rcpf(wsf[orow] + wsf[64 + orow]), i1 = lam * __builtin_amdgcn_rcpf(wsf[32 + orow] + wsf[96 + orow]);
        float v[4], ss = 0.f;
#pragma unroll
        for (int d = 0; d < 4; ++d) { v[d] = oa[d][r] * i0 - ob[d][r] * i1; ss += v[d] * v[d]; }
        ss += xor_f<1>(ss); ss += xor_f<2>(ss); ss += xor_f<4>(ss); ss += xor_f<8>(ss); ss += xor_f<16>(ss);
        const float rn = rsqrtf(ss * (1.f / 128.f) + 1e-5f);
#pragma unroll
        for (int d = 0; d < 4; ++d) Yw[(size_t)orow * 512 + d * 32 + r32] = (bf16)f2bf(v[d] * rn * gcol[d]); }
}
__device__ __forceinline__ int vkey(int T_, int lane) { const int kk = ((T_ >> 2) << 3) | ((lane & 31) >> 2); return (kk & ~0xC) | ((kk & 4) << 1) | ((kk & 8) >> 1); }
__device__ __forceinline__ int vcol(int T_, int lane) { return (T_ & 3) * 32 + (lane & 3) * 8; }
__device__ __forceinline__ void attn_unit(const Ctx& X, int b, int h, int qb, float lam, float mul, const float* __restrict__ sg, unsigned* kmax2) {
    char* lds = (char*)X.lds;
    const int tid = fresh_tid(X.wave_s);
    const int wid = X.wave, lane = tid & 63, r32 = lane & 31, hi = lane >> 5;
    const bf16* Qg = (const bf16*)(X.ws + WS_Q) + ((size_t)b * S + qb * 256) * LDK + h * 128;
    const bf16* Kh = (const bf16*)(X.ws + WS_K) + (size_t)b * S * LDK + h * 128;
    const bf16* Vh = (const bf16*)(X.ws + WS_V) + (size_t)b * S * LDK + h * 128;
    char* V_lds = lds + OFF_V; char* K_lds = lds + OFF_K; char* Q_lds = lds + OFF_Q;
    float* wsf = (float*)(lds + OFF_WS) + wid * 160;
    const int sr = tid >> 4, sc = (tid & 15) * 8, vst0 = v_st(sr, sc), vst1 = v_st(32 + sr, sc);
    const int vb0 = (int)(uintptr_t)V_lds + v_rd_base(lane);
#pragma unroll
    for (int i = 0; i < 8; ++i) { const int row = sr + 32 * i; *(bf16x8*)(Q_lds + KSWZ(row, sc * 2)) = *reinterpret_cast<const bf16x8*>(Qg + (size_t)row * LDK + sc); }
    bf16x8 st0, st1;
    const unsigned goff = (unsigned)(sr * LDK + sc) * 2u;
#define KLOAD(k0) do { const char* t_ = (const char*)Kh + (size_t)(k0) * (LDK * 2); st0 = *reinterpret_cast<const bf16x8*>(t_ + goff); st1 = *reinterpret_cast<const bf16x8*>(t_ + 32 * LDK * 2 + goff); } while (0)
#define VLOAD(k0) do { const char* t_ = (const char*)Vh + (size_t)(k0) * (LDK * 2); st0 = *reinterpret_cast<const bf16x8*>(t_ + goff); st1 = *reinterpret_cast<const bf16x8*>(t_ + 32 * LDK * 2 + goff); } while (0)
#define KWRITE(bb) do { *(bf16x8*)(K_lds + (bb) * SHM_K + KSWZ(sr, sc * 2)) = st0; *(bf16x8*)(K_lds + (bb) * SHM_K + KSWZ(32 + sr, sc * 2)) = st1; } while (0)
    const unsigned vsrc0 = (unsigned)(vkey(2 * wid + (lane >> 5), lane) * LDK + vcol(2 * wid + (lane >> 5), lane)) * 2u, vsrc1 = (unsigned)(vkey(2 * (wid + 8) + (lane >> 5), lane) * LDK + vcol(2 * (wid + 8) + (lane >> 5), lane)) * 2u;
#define VDMA(k0, bbn) do { const char* t_ = (const char*)Vh + (size_t)(k0) * (LDK * 2); LAS unsigned char* d_ = X.lds + OFF_V + (bbn) * SHM_V + wid * 1024; \
    __builtin_amdgcn_global_load_lds((const unsigned*)(t_ + vsrc0), (LAS unsigned*)d_, 16, 0, 0); __builtin_amdgcn_global_load_lds((const unsigned*)(t_ + vsrc1), (LAS unsigned*)(d_ + 8192), 16, 0, 0); } while (0)
    const unsigned ksrc = (unsigned)(wid * 8 * LDK * 2) + (unsigned)lane * 4u;
#define KDMA(k0, bbn) do { const char* t_ = (const char*)Kh + (size_t)(k0) * (LDK * 2) + ksrc; LAS unsigned char* d_ = X.lds + OFF_K + (bbn) * SHM_K + wid * 8 * KPITCH; \
    _Pragma("unroll") for (int i_ = 0; i_ < 8; ++i_) __builtin_amdgcn_global_load_lds((const unsigned*)(t_ + i_ * (LDK * 2)), (LAS unsigned*)(d_ + i_ * KPITCH), 4, 0, 0); } while (0)
#define VWRITE(bb) do { *(bf16x8*)(V_lds + (bb) * SHM_V + vst0) = st0; *(bf16x8*)(V_lds + (bb) * SHM_V + vst1) = st1; } while (0)
    float l0 = 0.f, l1 = 0.f; f32x16 oa[4] = {}, ob[4] = {};
    const int qrow = wid * 32 + r32; constexpr int NT = S / KVBLK;
    KDMA(0, 0); VDMA(0, 0); __syncthreads();
    float m0, m1;
    { float s0 = 0.f, s1 = 0.f;
#pragma unroll
      for (int d0 = 0; d0 < 8; ++d0) { const v4u w = *reinterpret_cast<const v4u*>(Q_lds + KSWZ(qrow, (d0 * 16 + hi * 8) * 2)); f32x4 p, q; unpack8(w, p, q);
          const float ss = (p.x * p.x + p.y * p.y) + (p.z * p.z + p.w * p.w) + (q.x * q.x + q.y * q.y) + (q.z * q.z + q.w * q.w); if (d0 < 4) s0 += ss; else s1 += ss; }
      wsf[hi * 64 + r32] = s0; wsf[hi * 64 + 32 + r32] = s1; asm volatile("s_waitcnt lgkmcnt(0)" ::: "memory");
      s0 += wsf[(hi ^ 1) * 64 + r32]; s1 += wsf[(hi ^ 1) * 64 + 32 + r32]; asm volatile("s_waitcnt lgkmcnt(0)" ::: "memory");
      const float k0 = __uint_as_float(__hip_atomic_load(kmax2 + b * 8 + h * 2, __ATOMIC_RELAXED, __HIP_MEMORY_SCOPE_AGENT)), k1 = __uint_as_float(__hip_atomic_load(kmax2 + b * 8 + h * 2 + 1, __ATOMIC_RELAXED, __HIP_MEMORY_SCOPE_AGENT));
      m0 = sqrtf(s0 * k0) * 1.001f + 1e-3f; m1 = sqrtf(s1 * k1) * 1.001f + 1e-3f; }
    for (int j = 0; j < NT; ++j) {
        const int bb = j & 1; const char* Ks = K_lds + bb * SHM_K;
        const int kn = (j + 1) * KVBLK;
        if (j + 1 < NT) { KDMA(kn, bb ^ 1); VDMA(kn, bb ^ 1); }
        const int vb = vb0 + bb * SHM_V;
        bf16x8 pa[4], pb[4];
        { f32x16 p0, p1, q0, q1;
          qkt<0>(p0, p1, Ks, Q_lds, qrow, r32, hi); qkt<1>(q0, q1, Ks, Q_lds, qrow, r32, hi);
          softmax_fixed(p0, p1, m0, l0, pa[0], pa[1], pa[2], pa[3]);
          softmax_fixed(q0, q1, m1, l1, pb[0], pb[1], pb[2], pb[3]); }
        SBAR();
        pv_two<0>(oa[0], ob[0], vb, pa, pb); pv_two<1>(oa[1], ob[1], vb, pa, pb); pv_two<2>(oa[2], ob[2], vb, pa, pb); pv_two<3>(oa[3], ob[3], vb, pa, pb);
        __syncthreads();
    }
#undef KLOAD
#undef VLOAD
#undef VDMA
#undef KDMA
#undef KWRITE
#undef VWRITE
    wsf[hi * 64 + r32] = l0; wsf[hi * 64 + 32 + r32] = l1; asm volatile("s_waitcnt lgkmcnt(0)" ::: "memory");
    { const int t2 = fresh_tid(X.wave_s); epilogue(X, oa, ob, wsf, t2 & 31, (t2 & 63) >> 5, b, h, qb, lam, mul, sg); }
    __syncthreads();
}
__device__ __forceinline__ void epilogue_unused() {}
#undef KSWZ
#undef SBAR
}
}
namespace mk {
namespace hy {
struct CvSet { int have; f32x4 ld0, ld1, ld2, ld3; float sc; };
struct CvState { int next, stride, nlim, cnt, par; CvSet a, b; };
#define CV_PDECL const float* cwg, const float* cwu, const float* cwd, bf16* ctgu, bf16* ctd, const float* cgn
#define CV_PARGS cwg, cwu, cwd, ctgu, ctd, cgn
constexpr int CV_TILES = 3 * 16 * 2048;
#ifndef CV_EVERY
#define CV_EVERY 5
#endif
__device__ __forceinline__ void cv_issue(CvState& s, CvSet& q, int lane, CV_PDECL) {
    if (s.next < s.nlim) { asm volatile("" : "+v"(lane));
        const int t = s.next, me = t >> 11, rr = t & 2047, mat = me >> 4, e = me & 15;
        const float* W = (mat == 0 ? cwg : (mat == 1 ? cwu : cwd)) + (size_t)e * D * F + rr * 1024 + 4 * lane;
        q.ld0 = __builtin_nontemporal_load((const f32x4*)W); q.ld1 = __builtin_nontemporal_load((const f32x4*)(W + 256)); q.ld2 = __builtin_nontemporal_load((const f32x4*)(W + 512)); q.ld3 = __builtin_nontemporal_load((const f32x4*)(W + 768));
        { const float g_ = cgn[mat < 2 ? (rr >> 1) : 0]; q.sc = mat < 2 ? g_ : 1.f; }
        q.have = t; s.next = t + s.stride; }
    else q.have = -1;
}
__device__ __forceinline__ void cv_finish_set(CvState& s, CvSet& q, int lane, CV_PDECL) {
    const int t = q.have; v2u o0 = {0u, 0u}, o1 = {0u, 0u}, o2 = {0u, 0u}, o3 = {0u, 0u};
    if (t >= 0) { const float sc = q.sc;
        o0.x = cvtpk_(q.ld0[0] * sc, q.ld0[1] * sc); o0.y = cvtpk_(q.ld0[2] * sc, q.ld0[3] * sc); o1.x = cvtpk_(q.ld1[0] * sc, q.ld1[1] * sc); o1.y = cvtpk_(q.ld1[2] * sc, q.ld1[3] * sc);
        o2.x = cvtpk_(q.ld2[0] * sc, q.ld2[1] * sc); o2.y = cvtpk_(q.ld2[2] * sc, q.ld2[3] * sc); o3.x = cvtpk_(q.ld3[0] * sc, q.ld3[1] * sc); o3.y = cvtpk_(q.ld3[2] * sc, q.ld3[3] * sc); }
    cv_issue(s, q, lane, CV_PARGS);
    if (t >= 0) { asm volatile("" : "+v"(lane)); const int me = t >> 11, rr = t & 2047, mat = me >> 4, e = me & 15;
        bf16* dst; int qs;
        if (mat == 2) { dst = ctd + (size_t)e * D * F + rr * 1024 + 4 * lane; qs = 256; }
        else { const int k = rr >> 1, n = (rr & 1) * 1024 + 4 * lane; dst = ctgu + ((size_t)e * D + k) * (2 * F) + 2 * (n & ~127) + (n & 127) + 128 * mat; qs = 512; }
        __builtin_nontemporal_store(o0, (v2u*)dst); __builtin_nontemporal_store(o1, (v2u*)(dst + qs)); __builtin_nontemporal_store(o2, (v2u*)(dst + 2 * qs)); __builtin_nontemporal_store(o3, (v2u*)(dst + 3 * qs)); }
}
__device__ __forceinline__ void cv_finish(CvState& s, int lane, CV_PDECL) { if (s.par) cv_finish_set(s, s.b, lane, CV_PARGS); else cv_finish_set(s, s.a, lane, CV_PARGS); s.par ^= 1; }

constexpr int CPS = 16704;
constexpr int NEL = 8352;
constexpr int OFF_Z = 4 * CPS;
constexpr int ZROW = 144, ZB = 128 * ZROW;
constexpr int LDS_TOTAL = OFF_Z + 4 * ZB;

__device__ __forceinline__ void build_hrev(const Ctx& X, const bf16* hf, const bf16* hb, float bias) {
    const int tid = X.tid;
    if (tid < 4 * 8) { const int m = tid >> 3, e = tid & 7; if (e < 5 - m) *(LAS bf16*)(X.lds + m * CPS + 2 * e) = 0; }
    for (int i = tid; i < 4 * (NEL - 8192); i += NTH) { const int m = i / (NEL - 8192), e = 8192 + (i - m * (NEL - 8192)); if (e > 8195 - m) *(LAS bf16*)(X.lds + m * CPS + 2 * e) = 0; }
#pragma unroll
    for (int half = 0; half < 2; ++half) {
        const v4u w = *(const v4u*)((half ? hb : hf) + 8 * tid);
        unsigned short v[8] = {(unsigned short)(w.x & 0xffff), (unsigned short)(w.x >> 16), (unsigned short)(w.y & 0xffff), (unsigned short)(w.y >> 16), (unsigned short)(w.z & 0xffff), (unsigned short)(w.z >> 16), (unsigned short)(w.w & 0xffff), (unsigned short)(w.w >> 16)};
        if (half == 0 && tid == 0) v[0] = (unsigned short)f2bf(bf2f(v[0]) + bias);
#pragma unroll
        for (int k = 0; k < 8; ++k) { const int d = 8 * tid + k; if (half == 1 && d == 0) continue;
            const int e0 = half ? 4100 + d : 4100 - d;
#pragma unroll
            for (int m = 0; m < 4; ++m) *(LAS bf16*)(X.lds + m * CPS + 2 * (e0 - m)) = v[k]; }
    }
}
#ifdef MK_HY_XLDS
#define HY_XL(qq) do { const v2u x0_ = *(const volatile LAS v2u*)(X.lds + baseA + 32 * (qq)), x1_ = *(const volatile LAS v2u*)(X.lds + baseA8 + 32 * (qq)); asm volatile("" :: "v"(x0_), "v"(x1_)); } while (0)
#else
#define HY_XL(qq) do {} while (0)
#endif
#define HY_LDA(dst, qq) do { HY_XL(qq); const v2u lo_ = *(const volatile LAS v2u*)(X.lds + baseA + 32 * (qq)), hi_ = *(const volatile LAS v2u*)(X.lds + baseA8 + 32 * (qq)); v4u w_ = {lo_.x, lo_.y, hi_.x, hi_.y}; dst = *reinterpret_cast<bf16x8*>(&w_); } while (0)
#define HY_LOAD_E(FA, FB, d1_, q_) do { const LAS unsigned char* zr_ = zb - (d1_) * ZROW; HY_LDA(FA[0], (q_)); HY_LDA(FA[1], (q_) + 1); \
    FB[0] = *(const LAS bf16x8*)(zr_); FB[1] = *(const LAS bf16x8*)(zr_ + 32); FB[2] = *(const LAS bf16x8*)(zr_ + 64); FB[3] = *(const LAS bf16x8*)(zr_ + 96); } while (0)
#define HY_LOAD_L(FA, q_) do { HY_LDA(FA[2], (q_) + 2); HY_LDA(FA[3], (q_) + 3); } while (0)
#ifdef MK_HY_XMFMA
#define HY_XM(A_, B_) do { dacc0 = __builtin_amdgcn_mfma_f32_32x32x16_bf16(A_, B_, dacc0, 0, 0, 0); } while (0)
#else
#define HY_XM(A_, B_) do {} while (0)
#endif
#define HY_MMA1(FA, FB, PA) do { __builtin_amdgcn_s_setprio(1); HY_XM(FA[0], FB[0]); HY_XM(PA[2], FB[0]); HY_XM(FA[1], FB[1]); HY_XM(PA[3], FB[1]); \
    acc0 = __builtin_amdgcn_mfma_f32_32x32x16_bf16(FA[0], FB[0], acc0, 0, 0, 0); acc1 = __builtin_amdgcn_mfma_f32_32x32x16_bf16(PA[2], FB[0], acc1, 0, 0, 0); \
    acc0 = __builtin_amdgcn_mfma_f32_32x32x16_bf16(FA[1], FB[1], acc0, 0, 0, 0); acc1 = __builtin_amdgcn_mfma_f32_32x32x16_bf16(PA[3], FB[1], acc1, 0, 0, 0); __builtin_amdgcn_s_setprio(0); } while (0)
#define HY_MMA2(FA, FB) do { __builtin_amdgcn_s_setprio(1); HY_XM(FA[2], FB[2]); HY_XM(FA[0], FB[2]); HY_XM(FA[3], FB[3]); HY_XM(FA[1], FB[3]); \
    acc0 = __builtin_amdgcn_mfma_f32_32x32x16_bf16(FA[2], FB[2], acc0, 0, 0, 0); acc1 = __builtin_amdgcn_mfma_f32_32x32x16_bf16(FA[0], FB[2], acc1, 0, 0, 0); \
    acc0 = __builtin_amdgcn_mfma_f32_32x32x16_bf16(FA[3], FB[3], acc0, 0, 0, 0); acc1 = __builtin_amdgcn_mfma_f32_32x32x16_bf16(FA[1], FB[3], acc1, 0, 0, 0); __builtin_amdgcn_s_setprio(0); } while (0)
template <int PAIR> __device__ __forceinline__ void channel(const Ctx& X, int l, int c, const float* __restrict__ hyb, CvState& cs, CV_PDECL) {
    const bf16* UCT = (const bf16*)(X.ws + WS_UCT); const bf16* FILT = (const bf16*)(X.ws + WS_FILT) + (size_t)l * 4 * C * S; bf16* YH = (bf16*)(X.ws + WS_YH);
    const int tid = X.tid, lane = X.lane, wid = X.wave, r = lane & 31, h = lane >> 5, b = wid >> 1, jt = wid & 1;
    LAS unsigned char* zl = X.lds + OFF_Z;
    v2u* const stash0 = (v2u*)(X.ws + WS_XN) + (size_t)X.bid * 8 * NTH;
    __syncthreads();
    v4u zero4 = {0u, 0u, 0u, 0u}; asm volatile("" : "+v"(zero4));
    for (int i = tid; i < 4 * 64 * 9; i += NTH) { const int bb = i / 576, rr = (i % 576) / 9, ch = i % 9; const int row = rr < 32 ? rr : 64 + rr;
        *(LAS v4u*)(zl + bb * ZB + row * ZROW + ch * 16) = zero4; }
    for (int i = tid; i < 4 * 64 * 8; i += NTH) { const int bb = i >> 9, s1 = (i >> 3) & 63, ch = i & 7;
        *(LAS v4u*)(zl + bb * ZB + (32 + s1) * ZROW + ch * 16) = *(const v4u*)(UCT + (size_t)c * T + bb * S + s1 * 64 + ch * 8); }
    const int m4 = (4 - (r & 3)) & 3;
    const int baseA = m4 * CPS + 2 * (8 * h - r + 4100 - m4);
    int baseA8 = baseA + 8; asm volatile("" : "+v"(baseA8));
    for (int o = 0; o < 2; ++o) {
        build_hrev(X, FILT + ((size_t)(2 * o) * C + c) * S, FILT + ((size_t)(2 * o + 1) * C + c) * S, hyb[(l * 2 + o) * C + c]);
#ifdef MK_HY_DUPBUILD
        asm volatile("" ::: "memory"); build_hrev(X, FILT + ((size_t)(2 * o) * C + c) * S, FILT + ((size_t)(2 * o + 1) * C + c) * S, hyb[(l * 2 + o) * C + c]);
#endif
        const bf16* gate = UCT + (size_t)((o + 1) * C + c) * T + (size_t)b * S;
        const int t1 = 32 * jt + r;
        __syncthreads();
#ifndef MK_HY_SWEEPS
#define MK_HY_SWEEPS 1
#endif
        f32x16 acc0 = {}, acc1 = {};
#ifdef MK_HY_XMFMA
        f32x16 dacc0 = {};
#endif
        for (int rep = 0; rep < MK_HY_SWEEPS; ++rep) {
        const int d1max = 32 * jt + 31; int q = -4 * d1max;
        const LAS unsigned char* zb = zl + b * ZB + (32 + 32 * jt + r) * ZROW + 16 * h;
        bf16x8 fa0[4], fb0[4], fa1[4], fb1[4];
        HY_LDA(fa1[2], q - 2); HY_LDA(fa1[3], q - 1);
        HY_LOAD_E(fa0, fb0, d1max, q); HY_LOAD_L(fa0, q);
        int d1 = d1max;
        for (int it = 0; it < 47; ++it) {
            HY_LOAD_E(fa1, fb1, d1 - 1, q + 4);
            HY_MMA1(fa0, fb0, fa1);
            HY_LOAD_L(fa1, q + 4);
            HY_MMA2(fa0, fb0);
            HY_LOAD_E(fa0, fb0, d1 - 2, q + 8);
            HY_MMA1(fa1, fb1, fa0);
            HY_LOAD_L(fa0, q + 8);
            HY_MMA2(fa1, fb1);
            d1 -= 2; q += 8;
            if (++cs.cnt == CV_EVERY) { cs.cnt = 0; cv_finish(cs, lane, CV_PARGS); }
        }
        HY_MMA1(fa0, fb0, fa1); HY_MMA2(fa0, fb0);
        }
        if (MK_HY_SWEEPS == 2) { acc0 *= 0.5f; acc1 *= 0.5f; }
#ifdef MK_HY_XMFMA
        asm volatile("" :: "v"(dacc0));
#endif
        asm volatile("" ::: "memory");
        v2u gw[2][4];
#pragma unroll
        for (int mt = 0; mt < 2; ++mt)
#pragma unroll
            for (int g = 0; g < 4; ++g) gw[mt][g] = *(const v2u*)(gate + t1 * 64 + 32 * mt + 8 * g + 4 * h);
        v2u kpv[2][4]; v2u* stash;
        { int st = tid * 8; asm volatile("" : "+v"(st)); stash = stash0 + st; }
        if (PAIR == 1 && o == 1) {
#pragma unroll
            for (int i = 0; i < 4; ++i) { const v4u w = ((const v4u*)stash)[i]; kpv[i >> 1][2 * (i & 1)] = v2u{w.x, w.y}; kpv[i >> 1][2 * (i & 1) + 1] = v2u{w.z, w.w}; } }
        __syncthreads();
#pragma unroll
        for (int mt = 0; mt < 2; ++mt)
#pragma unroll
            for (int g = 0; g < 4; ++g) { const int t0 = 32 * mt + 8 * g + 4 * h; const v2u gwv = gw[mt][g];
                const f32x16& a = mt ? acc1 : acc0;
                const float y0 = a[4 * g] * bflo(gwv.x), y1 = a[4 * g + 1] * bfhi(gwv.x), y2 = a[4 * g + 2] * bflo(gwv.y), y3 = a[4 * g + 3] * bfhi(gwv.y);
                if (o == 0) { v2u w; w.x = pk2(y0, y1); w.y = pk2(y2, y3); *(LAS v2u*)(zl + b * ZB + (32 + t1) * ZROW + t0 * 2) = w; }
                else if (PAIR == 0) { v2u w; w.x = pk2(y0, y1); w.y = pk2(y2, y3); stash[mt * 4 + g] = w; }
                else { unsigned* yo = (unsigned*)(YH + ((size_t)b * S + t1 * 64 + t0) * C + (c - 1)); const v2u kp = kpv[mt][g];
                    yo[0] = (kp.x & 0xffffu) | (f2bf(y0) << 16); yo[C / 2] = (kp.x >> 16) | (f2bf(y1) << 16); yo[C] = (kp.y & 0xffffu) | (f2bf(y2) << 16); yo[3 * C / 2] = (kp.y >> 16) | (f2bf(y3) << 16); } }
    }
    __syncthreads();
}
#undef HY_LDA
#undef HY_LOAD_E
#undef HY_LOAD_L
#undef HY_MMA1
#undef HY_MMA2
}
}
namespace mk {
#define GAS __attribute__((address_space(1)))
typedef GAS unsigned gu32;
typedef GAS unsigned long long gu64;
#define RLX_AGENT __ATOMIC_RELAXED, __HIP_MEMORY_SCOPE_AGENT
#define LDS_WAIT() asm volatile("s_waitcnt lgkmcnt(0)" ::: "memory")
#define VM_WAIT() asm volatile("s_waitcnt vmcnt(0)" ::: "memory")
__device__ __forceinline__ unsigned long long rt() { return __builtin_amdgcn_s_memrealtime(); }
#define XB_TMO      128
#define XB_XCNT(j)  (256  + 64 * (j))
#define XB_XSUB(j)  (1280 + 64 * (j))
#define XB_XGEN(j)  (2304 + 64 * (j))
#define XB_TOP      3328
#define XB_TOPGEN   3392
#define XCD_BAR_WORDS 3456
#define XB_SPIN_CAP (1u << 18)

__device__ __forceinline__ unsigned xb_ld(unsigned* p)              { return __hip_atomic_load(p, __ATOMIC_RELAXED, __HIP_MEMORY_SCOPE_AGENT); }
__device__ __forceinline__ unsigned xb_add(unsigned* p, unsigned v) { return __hip_atomic_fetch_add(p, v, __ATOMIC_RELAXED, __HIP_MEMORY_SCOPE_AGENT); }
__device__ __forceinline__ unsigned xb_xcc_id() { return (unsigned)__builtin_amdgcn_s_getreg((3 << 11) | 20) & 0xFu; }
#define XB_SPIN(cond, bar) do { unsigned _sp = 0; while (cond) { __builtin_amdgcn_s_sleep(1); \
    if ((++_sp & 255u) == 0u) { if (xb_ld(&(bar)[XB_TMO])) break; if (_sp > XB_SPIN_CAP) { atomicAdd(&(bar)[XB_TMO], 1u); break; } } } } while (0)

struct XcdBarrier {
    unsigned* bar; unsigned x;
    volatile LAS unsigned* st;
};

__device__ __forceinline__ XcdBarrier xcd_barrier_post(unsigned* bar, volatile LAS unsigned* st) {
    XcdBarrier b; b.bar = bar; b.x = xb_xcc_id(); b.st = st;
    if (threadIdx.x == 0) (void)xb_add(&bar[XB_XCNT(b.x)], 1u);
    return b;
}
__device__ __forceinline__ void xcd_barrier_complete(unsigned* bar, unsigned x, unsigned& nloc, unsigned& nx) {
    const unsigned G = gridDim.x * gridDim.y * gridDim.z;
    unsigned sum, cnt, mine, sp = 0u;
    for (;;) {
        sum = 0u; cnt = 0u; mine = 0u;
#pragma unroll
        for (unsigned j = 0; j < 16; ++j) { const unsigned c = xb_ld(&bar[XB_XCNT(j)]); sum += c; cnt += (c > 0u) ? 1u : 0u; mine = (j == x) ? c : mine; }
        if (sum == G) break;
        __builtin_amdgcn_s_sleep(1);
        if ((++sp & 255u) == 0u) { if (xb_ld(&bar[XB_TMO])) break; if (sp > XB_SPIN_CAP) { atomicAdd(&bar[XB_TMO], 1u); break; } }
    }
    nloc = mine > 0u ? mine : 1u; nx = cnt > 0u ? cnt : 1u;
}

__device__ __forceinline__ void xcd_barrier(const XcdBarrier& b, int wave_s) {
    asm volatile("s_waitcnt vmcnt(0)" ::: "memory");
    __syncthreads();
    if (fresh_tid(wave_s) == 0) {
        unsigned* bar = b.bar;
        __builtin_amdgcn_s_waitcnt(0);
        unsigned nloc = b.st[0], nx = b.st[1];
        if (nloc == 0u) { xcd_barrier_complete(bar, b.x, nloc, nx); b.st[0] = nloc; b.st[1] = nx; }
        const unsigned old = xb_add(&bar[XB_XSUB(b.x)], 1u);
        const unsigned gen = old / nloc;
        if (old + 1u == (gen + 1u) * nloc) {
            __builtin_amdgcn_fence(__ATOMIC_RELEASE, "agent");
            asm volatile("s_waitcnt vmcnt(0)" ::: "memory");
            const unsigned og = xb_add(&bar[XB_TOP], 1u);
            const unsigned tg = og / nx;
            if (og + 1u == (tg + 1u) * nx) xb_add(&bar[XB_TOPGEN], 1u);
            else XB_SPIN(xb_ld(&bar[XB_TOPGEN]) == tg, bar);
            __builtin_amdgcn_fence(__ATOMIC_ACQUIRE, "agent");
            xb_add(&bar[XB_XGEN(b.x)], 1u);
            asm volatile("s_waitcnt vmcnt(0)" ::: "memory");
        } else {
            XB_SPIN(xb_ld(&bar[XB_XGEN(b.x)]) == gen, bar);
            __builtin_amdgcn_fence(__ATOMIC_ACQUIRE, "agent");
            asm volatile("s_waitcnt vmcnt(0)" ::: "memory");
        }
    }
    __syncthreads();
}

}
namespace mk {
namespace cg = cooperative_groups;
constexpr int PH_PER_LAYER = 9, N_PHASES = 1 + 2 * PH_PER_LAYER;

__device__ __forceinline__ float lam_of(const Args& a, int l, float lam_init) {
    const float *q1 = a.in[14] + l * 64, *k1 = a.in[15] + l * 64, *q2 = a.in[16] + l * 64, *k2 = a.in[17] + l * 64;
    float s1 = 0.f, s2 = 0.f; for (int i = 0; i < 64; ++i) { s1 += q1[i] * k1[i]; s2 += q2[i] * k2[i]; }
    return expf(s1) - expf(s2) + lam_init;
}

typedef const __attribute__((address_space(4))) Args* KArgPtr;
__global__ void __launch_bounds__(NTH, 2) fwd(Args a_byval) {
    extern __shared__ __attribute__((aligned(16))) unsigned char lds_raw[];
    cg::grid_group grid = cg::this_grid();
    const int ph_lo = a_byval.ph_lo, ph_hi = a_byval.ph_hi;
    const int wave_s = __builtin_amdgcn_readfirstlane((int)threadIdx.x >> 6);
    volatile LAS unsigned* bar_st = (volatile LAS unsigned*)((LAS unsigned char*)lds_raw + LDS_BYTES - 64);
    if (threadIdx.x == 0) { bar_st[0] = 0u; bar_st[1] = 0u; }
    __syncthreads();
    const XcdBarrier bar = xcd_barrier_post((unsigned*)a_byval.ws, bar_st);
    int rep_flag = 0;
    for (int ph = ph_lo; ph < ph_hi; ++ph) {
        KArgPtr ap = (KArgPtr)__builtin_amdgcn_kernarg_segment_ptr(); asm volatile("" : "+s"(ap));
        const Args a = *(const Args*)ap;
        bf16* Xr = (bf16*)(a.ws + WS_X);
        Ctx X; X.wave_s = wave_s; X.wave = wave_s; X.tid = 0; X.lane = 0;
#define FRESH() do { X.tid = fresh_tid(wave_s); X.lane = X.tid & 63; } while (0)
        { int g_ = gridDim.x, b_ = blockIdx.x; asm volatile("" : "+s"(g_), "+s"(b_)); X.G = g_; X.bid = b_; }
        { const int bx = X.bid; X.vcu = (X.G % 8 == 0) ? (bx % 8) * (X.G / 8) + bx / 8 : bx; }
        X.gw = X.vcu * NWAVES + X.wave; X.ngw = X.G * NWAVES; X.lds = (LAS unsigned char*)lds_raw; X.ws = a.ws;
#ifndef MK_EN
#define MK_EN 0xFFFF
#endif
#ifndef MK_ATT
#define MK_ATT 3
#endif
#ifndef MK_REP_SP
#define MK_REP_SP 99
#endif
        if (ph == 0) { if (MK_EN & 512) { FRESH(); p0_prologue(X, a); } }
        else {
            const int l = (ph - 1) / PH_PER_LAYER, sp = (ph - 1) % PH_PER_LAYER;
            const float lam_init = 0.8f - 0.6f * expf(-0.3f * (float)l);
            if (0) {}
#if MK_EN & 1
            else if (sp == 0) {
                FRESH();
                pg8::Gemm g{(const bf16*)(a.ws + WS_XN), (const bf16*)(a.ws + WS_WIN) + (size_t)l * INW * D, T, INW, D};
                pg8::StaticOrder So; So.init(T, INW, X.G, X.bid);
                EpiWin Ep{a.ws, (const float*)(a.ws + WS_BINP) + l * INW, (const float*)(a.ws + WS_ROPE)};
                pg8::gemm_phase<EpiWin, pg8::StaticOrder, true, true>(X.lds, g, So, Ep, X.tid);
            }
#endif
#if MK_EN & 2
            else if (sp == 1) {
                FRESH();
                p1t_shortconv(X, a.in[4] + l * 3 * 1536, a.in[5] + l * 1536);
                p1t_kmax(X, (unsigned*)(a.ws + 14336) + l * 32);
            }
#endif
#if MK_EN & 4
            else if (sp == 2) {
                FRESH();
                const float lam = lam_of(a, l, lam_init);
                const int c = X.bid;
#ifndef MK_REP_ATT
#define MK_REP_ATT 1
#endif
#ifndef MK_CONV_REP
#define MK_CONV_REP 1
#endif
#ifndef MK_REP_HY
#define MK_REP_HY 1
#endif
#ifndef CV_ME_SWEEP
#define CV_ME_SWEEP 32
#endif
                const int cg_ = X.vcu & 3;
                if (cg_ == 0) { __syncthreads(); p0_experts_rest(relaunder(X), a, l, CV_ME_SWEEP); __syncthreads(); }
                for (int rep = 0; rep < MK_REP_ATT; ++rep) for (int u = c; u < 256; u += X.G) { const int bh = 2 * (u & 7) + ((u >> 3) >> 4), qb = (u >> 3) & 15; at::attn_unit(X, bh >> 2, bh & 3, qb, lam, 1.0f - lam_init, a.in[18] + l * 128, (unsigned*)(a.ws + 14336) + l * 32); }
                if (cg_ == 1) { __syncthreads(); p0_experts_rest(relaunder(X), a, l, CV_ME_SWEEP); __syncthreads(); }
                hy::CvState cs; const float* cwg = a.in[25] + (size_t)l * E * D * F; const float* cwu = a.in[26] + (size_t)l * E * D * F; const float* cwd = a.in[27] + (size_t)l * E * D * F; const float* cgn = a.in[22] + l * D;
                bf16* ctgu = (bf16*)(a.ws + WS_WGU) + (size_t)l * E * 2 * F * D; bf16* ctd = (bf16*)(a.ws + WS_WD) + (size_t)l * E * F * D;
                cs.next = __builtin_amdgcn_readfirstlane(X.bid * NWAVES + wave_s); cs.stride = __builtin_amdgcn_readfirstlane(X.G * NWAVES); cs.nlim = CV_ME_SWEEP * 2048; cs.cnt = 0; cs.par = 0;
                cs.a.have = cs.b.have = -1; cs.a.ld0 = cs.a.ld1 = cs.a.ld2 = cs.a.ld3 = cs.b.ld0 = cs.b.ld1 = cs.b.ld2 = cs.b.ld3 = f32x4{0.f, 0.f, 0.f, 0.f}; cs.a.sc = cs.b.sc = 1.f;
                hy::cv_issue(cs, cs.a, fresh_tid(wave_s) & 63, CV_PARGS); hy::cv_issue(cs, cs.b, fresh_tid(wave_s) & 63, CV_PARGS);
                for (int rep = 0; rep < MK_REP_HY; ++rep) for (int u = c; u < 256; u += X.G) { const int ch = 64 * (u & 7) + 2 * (u >> 3); hy::channel<0>(relaunder(X), l, ch, a.in[13], cs, CV_PARGS);
                    if (cg_ == 2) { __syncthreads(); p0_experts_rest(relaunder(X), a, l, CV_ME_SWEEP); __syncthreads(); }
                    hy::channel<1>(relaunder(X), l, ch + 1, a.in[13], cs, CV_PARGS); }
                while (cs.a.have >= 0 || cs.b.have >= 0) hy::cv_finish(cs, fresh_tid(wave_s) & 63, CV_PARGS);
                if (cg_ == 3) { __syncthreads(); p0_experts_rest(relaunder(X), a, l, CV_ME_SWEEP); __syncthreads(); }
            }
#endif
#if MK_EN & 8
            else if (sp == 3) {
                FRESH();
                OrderMerge So; So.so.init(T, D, X.G, X.bid);
                pg8::Gemm g{(const bf16*)(a.ws + WS_YH), (const bf16*)(a.ws + WS_WUH) + (size_t)l * 2 * D * C, 2 * T, 2 * D, C};
                EpiMerge2 Ep{(const bf16*)(a.ws + WS_GH), (const bf16*)(a.ws + WS_GA), (bf16*)(a.ws + WS_T1), (bf16*)(a.ws + WS_MG)};
                pg8::gemm_phase<EpiMerge2, OrderMerge, true, true>(X.lds, g, So, Ep, X.tid);
            }
#endif
#if MK_EN & 16
            else if (sp == 4) {
                FRESH();
                pg8::Gemm g{(const bf16*)(a.ws + WS_MG), (const bf16*)(a.ws + WS_WOUT) + (size_t)l * D * D, T, D, D};
                pg8::StaticOrder So; So.init(T, D, X.G, X.bid);
                EpiOutR Ep{a.in[0], l == 0 ? (const bf16*)nullptr : (const bf16*)Xr, (bf16*)(a.ws + WS_XN), (float*)(a.ws + WS_PART), (const bf16*)(a.ws + WS_WRP) + (size_t)l * 2 * E * D, (unsigned*)(a.ws + 15360) + l * 64, (float*)(a.ws + WS_AFFT), (float*)(a.ws + WS_RTOK), a.in[24] + l * E};
                pg8::gemm_phase<EpiOutR, pg8::StaticOrder, true, true>(X.lds, g, So, Ep, X.tid);
            }
#endif
#if MK_EN & 32
            else if (sp == 5) { FRESH(); p6_topk(X);
            }
#endif
#if MK_EN & 64
            else if (sp == 6) {
                FRESH();
                pg8::Gemm g{(const bf16*)(a.ws + WS_XN), (const bf16*)(a.ws + WS_WGU) + (size_t)l * E * 2 * F * D, E * 2048, 2 * F, D, 2 * F, 4, (size_t)2 * F * D * 2, (const int*)(a.ws + WS_ROWS)};
                OrderMoE1 So{X.G, X.bid}; EpiSwiGLU Ep{(bf16*)(a.ws + WS_HB), (const float*)(a.ws + WS_RSL)};
                pg8::gemm_phase<EpiSwiGLU, OrderMoE1, true, true, true, true>(X.lds, g, So, Ep, X.tid);
            }
#endif
#if MK_EN & 128
            else if (sp == 7) {
                FRESH();
                pg8::Gemm g{(const bf16*)(a.ws + WS_HB), (const bf16*)(a.ws + WS_WD) + (size_t)l * E * D * F, E * 2048, D, F, D, 2, (size_t)D * F * 2};
                OrderMoE2 So{X.G, X.bid}; EpiDown Ep{(bf16*)(a.ws + WS_YE), (const float*)(a.ws + WS_GATE)};
                pg8::gemm_phase<EpiDown, OrderMoE2, true, true, true>(X.lds, g, So, Ep, X.tid);
            }
#endif
#if MK_EN & 256
            else if (sp == 8) {
                FRESH();
                p9_combine(X, Xr, l == 0 ? a.in[1] + D : a.in[28], l == 1, a.out);
            }
#endif
        }
#ifndef MK_EXTRA_SYNC
#define MK_EXTRA_SYNC 0
#endif
        if (ph + 1 < ph_hi) { if (ph_hi > 4096) grid.sync(); else xcd_barrier(bar, wave_s); }
        for (int es = 0; es < MK_EXTRA_SYNC; ++es) xcd_barrier(bar, wave_s);
        if (MK_REP_SP != 99) { const int sp_ = ph == 0 ? -1 : (ph - 1) % PH_PER_LAYER; if (sp_ == MK_REP_SP && rep_flag == 0) { rep_flag = 1; --ph; } else rep_flag = 0; }
    }
}

static int g_grid = 0;
static bool mega_setup() {
    if (g_grid) return g_grid > 0;
    int dev = 0, cus = 0, per_cu = 0;
    if (hipGetDevice(&dev) != hipSuccess || hipDeviceGetAttribute(&cus, hipDeviceAttributeMultiprocessorCount, dev) != hipSuccess) { g_grid = -1; return false; }
    if (hipFuncSetAttribute((const void*)fwd, hipFuncAttributeMaxDynamicSharedMemorySize, LDS_BYTES) != hipSuccess) { fprintf(stderr, "hipFuncSetAttribute failed\n"); g_grid = -1; return false; }
    if (hipOccupancyMaxActiveBlocksPerMultiprocessor(&per_cu, (const void*)fwd, NTH, LDS_BYTES) != hipSuccess || per_cu < 1) { fprintf(stderr, "occupancy query failed (%d)\n", per_cu); g_grid = -1; return false; }
    g_grid = cus * 1;
    return true;
}
static void mega_launch(hipStream_t st, void* const* d_in, float* d_out, unsigned char* ws, int ph_lo, int ph_hi, int p0_mask) {
    if (!mega_setup()) return;
    Args a{};
    for (int i = 0; i < 29; ++i) a.in[i] = (const float*)d_in[i];
    a.out = d_out; a.ws = ws; a.ph_lo = ph_lo; a.ph_hi = ph_hi; a.p0_mask = p0_mask; a.pad = 0;
    if (hipMemsetAsync(ws, 0, 16384, st) != hipSuccess) { fprintf(stderr, "memset of the barrier words failed\n"); return; }
    void* args[] = {&a};
    const hipError_t e = hipLaunchCooperativeKernel((const void*)fwd, dim3(g_grid), dim3(NTH), args, LDS_BYTES, st);
    if (e != hipSuccess) fprintf(stderr, "cooperative launch failed: %s (grid %d)\n", hipGetErrorString(e), g_grid);
}
}
extern "C" void kernel_launch(void* const* d_in, const int* in_sizes, int n_in, void* d_out, int out_size, void* d_ws, size_t ws_size, hipStream_t stream) {
    if (n_in != 29 || out_size != mk::T * mk::D || ws_size < mk::WS_END) { fprintf(stderr, "kernel_launch: unexpected sizes n_in %d out %d ws %zu\n", n_in, out_size, ws_size); return; }
    mk::mega_launch(stream, d_in, (float*)d_out, (unsigned char*)d_ws, 0, mk::N_PHASES, 13);
}
```

```cpp
#include <hip/hip_runtime.h>
#include <hip/hip_cooperative_groups.h>
#include <cstdio>
#include <cstdint>
#include <cmath>
namespace tk {
constexpr int S = 4096, E = 16, CAP = 512, NT = 512;
__device__ __forceinline__ void topk_problem(const unsigned (&key)[8], const float (&rr)[8], int tokbase, int e, int slotbase, int* __restrict__ rows, float* __restrict__ gate, float* __restrict__ rsl, int* __restrict__ inv, int* sm, int tid) {
    const int lane = tid & 63, wid = tid >> 6;
    int* hist = sm; int* ctl = sm + 256;
    unsigned prefix = 0u, mask = 0u; int kth = CAP;
    for (int pass = 3; pass >= 0; --pass) {
        __syncthreads();
        if (tid < 256) hist[tid] = 0;
        __syncthreads();
#pragma unroll
        for (int i = 0; i < 8; ++i) if ((key[i] & mask) == prefix) atomicAdd(&hist[(key[i] >> (8 * pass)) & 255u], 1);
        __syncthreads();
        if (tid < 64) {
            const int b0 = hist[4 * lane], b1 = hist[4 * lane + 1], b2 = hist[4 * lane + 2], b3 = hist[4 * lane + 3];
            const int tot = b0 + b1 + b2 + b3;
            int suf = tot;
#pragma unroll
            for (int o = 1; o < 64; o <<= 1) { const int v = __builtin_amdgcn_ds_bpermute(((lane + o) & 63) << 2, suf); if (lane + o < 64) suf += v; }
            const int above = suf - tot;
            if (above < kth && kth <= above + tot) {
                int cum = above, bin, k2;
                if (cum + b3 >= kth) { bin = 4 * lane + 3; k2 = kth - cum; }
                else { cum += b3; if (cum + b2 >= kth) { bin = 4 * lane + 2; k2 = kth - cum; }
                else { cum += b2; if (cum + b1 >= kth) { bin = 4 * lane + 1; k2 = kth - cum; }
                else { cum += b1; bin = 4 * lane; k2 = kth - cum; } } }
                ctl[0] = bin; ctl[1] = k2;
            }
        }
        __syncthreads();
        prefix |= ((unsigned)ctl[0]) << (8 * pass); mask |= 0xFFu << (8 * pass); kth = ctl[1];
    }
    const unsigned thr = prefix; const int need_eq = kth; const int n_gt = CAP - need_eq;
    int cg = 0, ce = 0;
#pragma unroll
    for (int i = 0; i < 8; ++i) { cg += key[i] > thr; ce += key[i] == thr; }
    int sg = cg, se = ce;
#pragma unroll
    for (int o = 1; o < 64; o <<= 1) { const int a = __builtin_amdgcn_ds_bpermute(((lane - o) & 63) << 2, sg), b = __builtin_amdgcn_ds_bpermute(((lane - o) & 63) << 2, se); if (lane >= o) { sg += a; se += b; } }
    __syncthreads();
    if (lane == 63) { ctl[8 + wid] = sg; ctl[16 + wid] = se; }
    __syncthreads();
    int og = sg - cg, oe = se - ce;
    for (int w = 0; w < wid; ++w) { og += ctl[8 + w]; oe += ctl[16 + w]; }
#pragma unroll
    for (int i = 0; i < 8; ++i) {
        const int idx = tid * 8 + i; int slot = -1;
        if (key[i] > thr) slot = og++;
        else if (key[i] == thr) { if (oe < need_eq) slot = n_gt + oe; ++oe; }
        if (slot >= 0) { rows[slot] = tokbase + idx; gate[slot] = __uint_as_float(key[i]); rsl[slot] = rr[i]; }
        inv[(size_t)(tokbase + idx) * E + e] = slot >= 0 ? slotbase + slot : -1;
    }
    __syncthreads();
}
}
namespace pg8 {
#define PG8_LAS __attribute__((address_space(3)))
typedef unsigned short bf16_t;
typedef short bf16x8 __attribute__((ext_vector_type(8)));
typedef float f32x4 __attribute__((ext_vector_type(4)));
typedef unsigned u32x4 __attribute__((ext_vector_type(4)));
typedef short s16x4 __attribute__((ext_vector_type(4)));
constexpr int BM = 256, BK = 64, HALF = 128, HTB = HALF * BK * 2  , STAGE_BYTES = 8 * HTB, NXCD = 8, WGM = 8;

__host__ __device__ __forceinline__ int lds_byte(int r, int c) { const int st = (r >> 4) * 2 + (c >> 5), rr = r & 15, cc = c & 31, ob = rr * 64 + cc * 2; return st * 1024 + (ob ^ (((ob >> 9) & 1) << 5)); }
__host__ __device__ __forceinline__ void stage_rc(int b, int& R, int& C) { const int st = b / 1024, sb = b % 1024, swz = sb ^ (((sb >> 9) & 1) << 5); R = (st >> 1) * 16 + swz / 64; C = (st & 1) * 32 + (swz % 64) / 2; }
__host__ __device__ __forceinline__ int perm32(int rho) { const int n = rho >> 4, i = rho & 15; return 8 * (i >> 2) + 4 * n + (i & 3); }

struct Unit { int pm, pn, pb, pa; };
struct Gemm { const bf16_t* A; const bf16_t* Bt; int M, N, K; int bN = 0, bsh = 0; size_t bes = 0; const int* arows = nullptr; };

struct StaticOrder {
    int nM, nN, nwg, G, c;
    __host__ __device__ void init(int M, int N, int G_, int c_) { nM = M / BM; nN = N / BM; nwg = nM * nN; G = G_; c = c_; }
    __host__ __device__ bool next(int i, Unit& u) const {
        const long L = (long)i * G + c; if (L >= nwg) return false;
        int wgid = (int)L; { const int q = nwg / NXCD, r = nwg % NXCD, xcd = wgid % NXCD, off = wgid / NXCD; wgid = (xcd < r ? xcd * (q + 1) : r * (q + 1) + (xcd - r) * q) + off; }
        const int nig = WGM * nN, gid = wgid / nig, fm = gid * WGM, gsz = (nM - fm) < WGM ? (nM - fm) : WGM;
        u.pm = fm + ((wgid % nig) % gsz); u.pn = (wgid % nig) / gsz; u.pb = u.pn; u.pa = u.pm; return true;
    }
    __device__ __forceinline__ void a_ready(const Unit&) const {}
    __device__ __forceinline__ void done(const Unit&) const {}
};

template <class Epi, class Sched, bool ALIGN_EPI = false, bool SP2 = false, bool BT = false, bool GA = false>
__device__ __forceinline__ void gemm_phase(PG8_LAS unsigned char* lds, const Gemm g, const Sched& S, const Epi& E, int tid) {
    asm volatile("" : "+v"(tid));
    const int wid = __builtin_amdgcn_readfirstlane(tid >> 6), lane = tid & 63, wr = wid >> 2, wc = wid & 3, fr = lane & 15, fq = lane >> 4;
    const int K = g.K, nt = K / BK;
    unsigned voffA[2], voffB[2];
#pragma unroll
    for (int i = 0; i < 2; ++i) { int R, C; stage_rc(tid * 16 + i * 8192, R, C); const int Rb = Epi::PERM ? ((R & ~31) + perm32(R & 31)) : R;
        voffA[i] = (unsigned)(R * K + C) * 2u; voffB[i] = (unsigned)(Rb * K + C) * 2u; if constexpr (GA) voffA[i] = (unsigned)C * 2u;
        if constexpr (BT) { const int p = i * 512 + tid, row = ((p >> 7) << 3) | ((p >> 2) & 7), ch = (((p >> 5) & 3) << 2) | ((p & 3) ^ ((row >> 2) & 3));
            voffB[i] = (unsigned)(row * g.bN + 8 * ch) * 2u; } }
    const size_t kstep = (size_t)(BK * 2);
    const size_t hstep = (size_t)HALF * K * 2;
    const size_t tstep = 2 * hstep;
    const size_t kstepB = BT ? (size_t)BK * g.bN * 2 : kstep, hstepB = BT ? (size_t)HALF * 2 : hstep;
    const size_t hstepA = GA ? 0 : hstep;
    unsigned curA[2][2] = {{0u, 0u}, {0u, 0u}};
    PG8_LAS int* rowtab0 = (PG8_LAS int*)(lds + STAGE_BYTES);
#define PG8_ROWTAB (rowtab0 + ((ui + 1) & 1) * 512)
#define PG8_NXTOFF(o_, h) do { int t_ = tid; asm volatile("" : "+v"(t_)); _Pragma("unroll") for (int i_ = 0; i_ < 2; ++i_) { int R_, C_; stage_rc(t_ * 16 + i_ * 8192, R_, C_); \
        o_[i_] = (unsigned)PG8_ROWTAB[(h) * 128 + R_] * (unsigned)(K * 2) + (unsigned)C_ * 2u; } } while (0)
#define PG8_STAGE_A(bufoff, kbase, h, nx) do { if constexpr (GA) { if (nx) { unsigned o_[2]; PG8_NXTOFF(o_, h); PG8_STAGE(bufoff, kbase, o_); } else PG8_STAGE(bufoff, kbase, curA[h]); } \
        else PG8_STAGE(bufoff, (kbase) + ((h) ? hstep : 0), voffA); } while (0)
#define PG8_BBASE(pb) ((const char*)g.Bt + (BT ? (size_t)((pb) >> g.bsh) * g.bes + (size_t)((pb) & ((1 << g.bsh) - 1)) * 512 : (size_t)(pb) * tstep))
    const unsigned ldsw = (unsigned)wid * 1024u;
    const int aoff = lds_byte(wr * 64 + fr, fq * 8), boff = lds_byte(wc * 32 + fr, fq * 8);
    int tr0 = 0, tr1 = 0;
    if constexpr (BT) { static_assert(Epi::PERM, "BT needs the PERM column order"); const int q_ = (lane >> 2) & 3, p_ = lane & 3, f1_ = fq & 1;
        const int L_ = (int)(size_t)lds + 2048 * fq + 512 * wc + 64 * q_ + 32 * ((p_ >> 1) ^ f1_); tr0 = L_ + 16 * (p_ & 1); tr1 = L_ + 256 + 16 * (1 - (p_ & 1)); }
#define PG8_SA(b, h) (((b) * 2 + (h)) * HTB)
#define PG8_SB(b, h) ((4 + (b) * 2 + (h)) * HTB)
#define PG8_STAGE(bufoff, gbase, voff) do { _Pragma("unroll") for (int _i = 0; _i < 2; ++_i) \
        __builtin_amdgcn_global_load_lds((const unsigned*)((const char*)(gbase) + (voff)[_i]), (PG8_LAS unsigned*)(lds + (bufoff) + ldsw + _i * 8192), 16, 0, 0); } while (0)
#define PG8_LDA(dst, b, h) do { _Pragma("unroll") for (int m = 0; m < 4; ++m) _Pragma("unroll") for (int k = 0; k < 2; ++k) dst[m][k] = *(const PG8_LAS bf16x8*)(lds + PG8_SA(b, h) + aoff + m * 2048 + k * 1024); } while (0)
#define PG8_TR(dst4, addr, OFF) asm volatile("ds_read_b64_tr_b16 %0, %1 offset:%2" : "=&v"(dst4) : "v"(addr), "i"(OFF) : "memory")
#define PG8_TRF(dst8, a0, a1, OFF) do { s16x4 lo_, hi_; PG8_TR(lo_, a0, OFF); PG8_TR(hi_, a1, OFF); dst8 = __builtin_shufflevector(lo_, hi_, 0, 1, 2, 3, 4, 5, 6, 7); } while (0)
#define PG8_LDB(dst, b, h) do { if constexpr (BT) { const int a0_ = tr0 + PG8_SB(b, h), a1_ = tr1 + PG8_SB(b, h); \
        PG8_TRF(dst[0][0], a0_, a1_, 0); PG8_TRF(dst[0][1], a0_, a1_, 8192); PG8_TRF(dst[1][0], a0_, a1_, 8); PG8_TRF(dst[1][1], a0_, a1_, 8200); } else { \
    _Pragma("unroll") for (int n = 0; n < 2; ++n) _Pragma("unroll") for (int k = 0; k < 2; ++k) dst[n][k] = *(const PG8_LAS bf16x8*)(lds + PG8_SB(b, h) + boff + n * 2048 + k * 1024); } } while (0)
#define PG8_MMA(ai, bj, At, Bt) do { __builtin_amdgcn_s_setprio(1); _Pragma("unroll") for (int m = 0; m < 4; ++m) _Pragma("unroll") for (int n = 0; n < 2; ++n) _Pragma("unroll") for (int k = 0; k < 2; ++k) \
        acc[ai][bj][m][n] = __builtin_amdgcn_mfma_f32_16x16x32_bf16(Bt[n][k], At[m][k], acc[ai][bj][m][n], 0, 0, 0); __builtin_amdgcn_s_setprio(0); } while (0)
#define PG8_WAIT_V(n) asm volatile("s_waitcnt vmcnt(" #n ")" ::: "memory")
#define PG8_WAIT_L(n) asm volatile("s_waitcnt lgkmcnt(" #n ")" ::: "memory")
#define PG8_BAR __builtin_amdgcn_s_barrier()
#define PG8_SCHED __builtin_amdgcn_sched_barrier(0)
    Unit cur, nxt; int ui = 0;
    if (!S.next(0, cur)) return;
    f32x4 acc[2][2][4][2];
#pragma unroll
    for (int a = 0; a < 2; ++a)
#pragma unroll
        for (int b = 0; b < 2; ++b)
#pragma unroll
            for (int m = 0; m < 4; ++m)
#pragma unroll
                for (int n = 0; n < 2; ++n) acc[a][b][m][n] = (f32x4){0.f, 0.f, 0.f, 0.f};
    bf16x8 At[4][2], B0[2][2], B1[2][2];
    const char* cA = (const char*)g.A + (GA ? 0 : (size_t)cur.pa * tstep); const char* cB = PG8_BBASE(cur.pb);
    if constexpr (GA) {
#pragma unroll
        for (int h = 0; h < 2; ++h)
#pragma unroll
            for (int i = 0; i < 2; ++i) { int R, C; stage_rc(tid * 16 + i * 8192, R, C);
                curA[h][i] = (unsigned)__hip_atomic_load(g.arows + cur.pa * 256 + h * 128 + R, __ATOMIC_RELAXED, __HIP_MEMORY_SCOPE_AGENT) * (unsigned)(K * 2) + (unsigned)C * 2u; } }
    S.a_ready(cur);
    if constexpr (SP2) {
        PG8_STAGE(PG8_SB(0, 0), cB, voffB); PG8_STAGE(PG8_SB(0, 1), cB + hstepB, voffB); PG8_STAGE_A(PG8_SA(0, 0), cA, 0, false); PG8_STAGE_A(PG8_SA(0, 1), cA, 1, false);
        if (wr == 1) PG8_BAR;
        PG8_WAIT_V(2); PG8_BAR;
        PG8_STAGE(PG8_SB(1, 0), cB + kstepB, voffB); PG8_STAGE_A(PG8_SA(1, 0), cA + kstep, 0, false); PG8_STAGE(PG8_SB(1, 1), cB + hstepB + kstepB, voffB);
        PG8_WAIT_V(6); PG8_BAR;
    } else {
        PG8_STAGE(PG8_SB(0, 0), cB, voffB); PG8_STAGE_A(PG8_SA(0, 0), cA, 0, false); PG8_STAGE(PG8_SB(0, 1), cB + hstepB, voffB); PG8_STAGE_A(PG8_SA(0, 1), cA, 1, false);
        if (wr == 1) PG8_BAR;
        PG8_WAIT_V(4); PG8_BAR;
        PG8_STAGE(PG8_SB(1, 0), cB + kstepB, voffB); PG8_STAGE_A(PG8_SA(1, 0), cA + kstep, 0, false); PG8_STAGE(PG8_SB(1, 1), cB + hstepB + kstepB, voffB);
        PG8_WAIT_V(6); PG8_BAR;
    }
    for (;;) {
        const bool has_next = S.next(ui + 1, nxt);
        const char* nA = (has_next && !GA) ? (const char*)g.A + (size_t)nxt.pa * tstep : cA; const char* nB = has_next ? PG8_BBASE(nxt.pb) : cB;
        for (int t = 0; t < nt; t += 2) {
            const bool last = (t == nt - 2);
            const char* a1 = cA + (size_t)(t + 1) * kstep;
            const char* a2 = last ? nA : cA + (size_t)(t + 2) * kstep; const char* b2 = last ? nB : cB + (size_t)(t + 2) * kstepB;
            const char* a3 = a2 + kstep; const char* b3 = b2 + kstepB;
            if (last && has_next) S.a_ready(nxt);
            const bool nx = GA && last && has_next;
            if constexpr (GA) {
                if (t == 0 && has_next) { int l_ = lane; asm volatile("" : "+v"(l_)); __builtin_amdgcn_global_load_lds((const unsigned*)(g.arows + nxt.pa * 256 + (wid & 3) * 64 + l_), (PG8_LAS unsigned*)(PG8_ROWTAB + wid * 64), 4, 0, 0); }
            }
            if constexpr (SP2) {
            PG8_LDB(B0, 0, 0); PG8_LDB(B1, 0, 1); PG8_SCHED; PG8_LDA(At, 0, 0); PG8_STAGE_A(PG8_SA(1, 1), a1, 1, false);
            PG8_WAIT_V(8); PG8_WAIT_L(0); PG8_BAR; PG8_MMA(0, 0, At, B0); PG8_MMA(0, 1, At, B1); PG8_BAR; PG8_SCHED;
            PG8_LDA(At, 0, 1); PG8_STAGE(PG8_SB(0, 0), b2, voffB); PG8_STAGE(PG8_SB(0, 1), b2 + hstepB, voffB); PG8_STAGE_A(PG8_SA(0, 0), a2, 0, nx);
            PG8_WAIT_V(8); PG8_WAIT_L(0); PG8_BAR; PG8_MMA(1, 0, At, B0); PG8_MMA(1, 1, At, B1); PG8_BAR; PG8_SCHED;
            PG8_LDB(B0, 1, 0); PG8_LDB(B1, 1, 1); PG8_SCHED; PG8_LDA(At, 1, 0); PG8_STAGE_A(PG8_SA(0, 1), a2, 1, nx);
            PG8_WAIT_V(8); PG8_WAIT_L(0); PG8_BAR; PG8_MMA(0, 0, At, B0); PG8_MMA(0, 1, At, B1); PG8_BAR; PG8_SCHED;
            PG8_LDA(At, 1, 1); PG8_STAGE(PG8_SB(1, 0), b3, voffB); PG8_STAGE(PG8_SB(1, 1), b3 + hstepB, voffB); PG8_STAGE_A(PG8_SA(1, 0), a3, 0, nx);
            PG8_WAIT_V(8); PG8_WAIT_L(0); PG8_BAR; PG8_MMA(1, 0, At, B0); PG8_MMA(1, 1, At, B1); PG8_BAR; PG8_SCHED;
            } else {
            PG8_LDB(B0, 0, 0); PG8_SCHED; PG8_LDA(At, 0, 0); PG8_STAGE_A(PG8_SA(1, 1), a1, 1, false);
            PG8_WAIT_L(8); PG8_BAR; PG8_WAIT_L(0); PG8_MMA(0, 0, At, B0); PG8_BAR; PG8_SCHED;
            PG8_LDB(B1, 0, 1); PG8_STAGE(PG8_SB(0, 0), b2, voffB);
            PG8_BAR; PG8_WAIT_L(0); PG8_MMA(0, 1, At, B1); PG8_BAR;
            PG8_LDA(At, 0, 1); PG8_STAGE_A(PG8_SA(0, 0), a2, 0, nx);
            PG8_BAR; PG8_WAIT_L(0); PG8_MMA(1, 0, At, B0); PG8_BAR; PG8_SCHED;
            PG8_STAGE(PG8_SB(0, 1), b2 + hstepB, voffB);
            PG8_WAIT_V(6); PG8_BAR; PG8_MMA(1, 1, At, B1); PG8_BAR;
            PG8_LDB(B0, 1, 0); PG8_SCHED; PG8_LDA(At, 1, 0); PG8_STAGE_A(PG8_SA(0, 1), a2, 1, nx);
            PG8_WAIT_L(8); PG8_BAR; PG8_WAIT_L(0); PG8_MMA(0, 0, At, B0); PG8_BAR; PG8_SCHED;
            PG8_LDB(B1, 1, 1); PG8_STAGE(PG8_SB(1, 0), b3, voffB);
            PG8_BAR; PG8_WAIT_L(0); PG8_MMA(0, 1, At, B1); PG8_BAR;
            PG8_LDA(At, 1, 1); PG8_STAGE_A(PG8_SA(1, 0), a3, 0, nx);
            PG8_BAR; PG8_WAIT_L(0); PG8_MMA(1, 0, At, B0); PG8_BAR; PG8_SCHED;
            PG8_STAGE(PG8_SB(1, 1), b3 + hstepB, voffB);
            PG8_WAIT_V(6); PG8_BAR; PG8_MMA(1, 1, At, B1); PG8_BAR;
            }
        }
        if constexpr (ALIGN_EPI) { if (wr == 0) PG8_BAR; }
        if constexpr (!Epi::AFTER_DRAIN) { int l2_ = lane; asm volatile("" : "+v"(l2_)); E(acc, cur, wr, wc, l2_ & 15, l2_ >> 4); S.done(cur); }
        if (!has_next) break;
#pragma unroll
        for (int a = 0; a < 2; ++a)
#pragma unroll
            for (int b = 0; b < 2; ++b)
#pragma unroll
                for (int m = 0; m < 4; ++m)
#pragma unroll
                    for (int n = 0; n < 2; ++n) acc[a][b][m][n] = (f32x4){0.f, 0.f, 0.f, 0.f};
        if constexpr (GA) { PG8_NXTOFF(curA[0], 0); PG8_NXTOFF(curA[1], 1); }
        cur = nxt; cA = nA; cB = nB; ++ui;
        if constexpr (ALIGN_EPI) { if (wr == 1) PG8_BAR; }
    }
    PG8_WAIT_V(0);
    if constexpr (!ALIGN_EPI) { if (wr == 0) PG8_BAR; }
    PG8_BAR;
    if constexpr (Epi::AFTER_DRAIN) { E.fused(acc, cur, wr, wc, fr, fq, lds, wid, lane); S.done(cur); }
#undef PG8_SA
#undef PG8_SB
#undef PG8_STAGE
#undef PG8_STAGE_A
#undef PG8_NXTOFF
#undef PG8_ROWTAB
#undef PG8_LDA
#undef PG8_LDB
#undef PG8_TR
#undef PG8_TRF
#undef PG8_BBASE
#undef PG8_MMA
#undef PG8_WAIT_V
#undef PG8_WAIT_L
#undef PG8_BAR
#undef PG8_SCHED
}
}

namespace mk {
constexpr int D = 1024, B = 4, S = 4096, T = B * S, C = 512, INW = 5120, E = 16, CAP = 512, F = 2048, NTH = 512, NWAVES = 8;
typedef unsigned short bf16;
#define LAS __attribute__((address_space(3)))
typedef unsigned v4u __attribute__((ext_vector_type(4)));
typedef unsigned v2u __attribute__((ext_vector_type(2)));
typedef float f32x4 __attribute__((ext_vector_type(4)));
typedef short bf16x8 __attribute__((ext_vector_type(8)));
typedef float f32x16 __attribute__((ext_vector_type(16)));
typedef short s16x4 __attribute__((ext_vector_type(4)));

constexpr size_t MiB = 1u << 20;
constexpr size_t WS_WIN = 2 * MiB;
constexpr size_t WS_WUH = 22 * MiB;
constexpr size_t WS_WUA = 23 * MiB;
constexpr size_t WS_WOUT = 26 * MiB;
constexpr size_t WS_BINP = 30 * MiB;
constexpr size_t WS_WRP = 30 * MiB + 512 * 1024;
constexpr size_t WS_ROPE = 31 * MiB;
constexpr size_t WS_AFFT = 32 * MiB;
constexpr size_t WS_INV = 33 * MiB;
constexpr size_t WS_ROWS = 34 * MiB;
constexpr size_t WS_GATE = 34 * MiB + 512 * 1024;
constexpr size_t WS_RTOK = 35 * MiB + 512 * 1024;
constexpr size_t WS_RMIX = 35 * MiB + 640 * 1024;
constexpr size_t WS_RSL = 35 * MiB;
constexpr size_t WS_FILT = 36 * MiB;
constexpr size_t WS_X = 68 * MiB;
constexpr size_t WS_XN = 132 * MiB;
constexpr size_t WS_SH = 164 * MiB;
constexpr size_t WS_U = WS_SH;
constexpr size_t WS_UCT = WS_SH + 48 * MiB;
constexpr size_t WS_Q = WS_SH + 96 * MiB;
constexpr size_t WS_K = WS_SH + 112 * MiB;
constexpr size_t WS_V = WS_SH + 128 * MiB;
constexpr size_t WS_GH = WS_SH + 144 * MiB;
constexpr size_t WS_GA = WS_SH + 176 * MiB;
constexpr size_t WS_YH = WS_SH + 208 * MiB;
constexpr size_t WS_YA = WS_SH + 224 * MiB;
constexpr size_t WS_T1 = WS_U;
constexpr size_t WS_MG = WS_UCT;
constexpr size_t WS_PART = WS_SH;
constexpr size_t WS_HB = WS_SH + 64 * MiB;
constexpr size_t WS_YE = WS_SH + 192 * MiB;
constexpr size_t WS_WGU = 420 * MiB;
constexpr size_t WS_WD = 676 * MiB;
constexpr size_t WS_END = 804 * MiB;

constexpr int LDS_BYTES = 155648;
constexpr float QSCALE = 0.125f * 1.4426950408889634f;

struct Args {
    const float* in[29]; float* out; unsigned char* ws; int ph_lo, ph_hi; int p0_mask, pad;
};

__device__ __forceinline__ unsigned f2bf(float f) { unsigned u = __builtin_bit_cast(unsigned, f); return (u + 0x7fffu + ((u >> 16) & 1u)) >> 16; }
__device__ __forceinline__ unsigned pk2(float lo, float hi) { return f2bf(lo) | (f2bf(hi) << 16); }
__device__ __forceinline__ float bf2f(unsigned h) { return __builtin_bit_cast(float, h << 16); }
__device__ __forceinline__ float bflo(unsigned w) { return __builtin_bit_cast(float, w << 16); }
__device__ __forceinline__ float bfhi(unsigned w) { return __builtin_bit_cast(float, w & 0xffff0000u); }
template <int O> __device__ __forceinline__ float xor_f(float v) { return __builtin_bit_cast(float, __builtin_amdgcn_ds_swizzle(__builtin_bit_cast(int, v), (O << 10) | 0x1f)); }
__device__ __forceinline__ float wave_sum(float v) { v += xor_f<1>(v); v += xor_f<2>(v); v += xor_f<4>(v); v += xor_f<8>(v); v += xor_f<16>(v);
    const int b = __builtin_bit_cast(int, v); return __builtin_bit_cast(float, __builtin_amdgcn_readlane(b, 0)) + __builtin_bit_cast(float, __builtin_amdgcn_readlane(b, 32)); }

__device__ __forceinline__ float sigm(float x) { return 1.f / (1.f + __expf(-x)); }

struct Ctx { int tid, lane, wave, gw, ngw, vcu, G, bid, wave_s; LAS unsigned char* lds; unsigned char* ws; };

__device__ __forceinline__ int fresh_tid(int wave_s) { int l; asm volatile("v_mbcnt_lo_u32_b32 %0, -1, 0\n\tv_mbcnt_hi_u32_b32 %0, -1, %0" : "=v"(l)); return (wave_s << 6) | l; }
__device__ __forceinline__ Ctx relaunder(const Ctx& X) { Ctx Y = X; const int t = fresh_tid(X.wave_s); Y.tid = t; Y.lane = t & 63; return Y; }

template <int MAP> __device__ __forceinline__ int rowmap(int n) {
    if (MAP == 1) {
        if (n < 1536 || n >= 2560) return n;
        const int hb = (n - 1536) & ~63, d = (n - 1536) & 63, i = (d & 31) >> 2, j = d & 3;
        return 1536 + hb + 8 * i + ((d >> 5) << 2) + j;
    }
    if (MAP == 2) return ((n >> 7) << 8) + (n & 127);
    if (MAP == 3) return ((n >> 7) << 8) + 128 + (n & 127);
    return n;
}
__device__ __forceinline__ unsigned cvtpk_(float lo, float hi) { unsigned r; asm volatile("v_cvt_pk_bf16_f32 %0, %1, %2" : "=v"(r) : "v"(lo), "v"(hi)); return r; }
struct TrItem { const float* src; bf16* dst; };
template <int MAP> __device__ __forceinline__ void p0_transpose(const Ctx& X, const float* W, int K, int N, bf16* WT, int nmat, size_t sstride, size_t dstride, int rot = 0, const float* __restrict__ rscale = nullptr) {
    LAS float* scr = (LAS float*)(X.lds + X.wave * 16640);
    const int nblk = N / 64, per = (K / 64) * nblk, tot = per * nmat, lane = X.lane;
    const int nq = lane & 15, kr = lane >> 4, c = lane & 7, nsub = lane >> 3;
    f32x4 v[16];
    int it = X.gw - rot; if (it < 0) it += X.ngw;
#define TR_SRC(it_) (W + (size_t)((it_) / per) * sstride + (size_t)(64 * (((it_) % per) / nblk) + kr) * N + 64 * (((it_) % per) % nblk) + 4 * nq)
    if (it < tot) { const float* s = TR_SRC(it);
#pragma unroll
        for (int i = 0; i < 16; ++i) v[i] = __builtin_nontemporal_load((const f32x4*)(s + (size_t)(4 * i) * N)); }
    while (it < tot) {
#pragma unroll
        for (int i = 0; i < 16; ++i) { LAS float* d = scr + (4 * i + kr) * 65 + 4 * nq; d[0] = v[i][0]; d[1] = v[i][1]; d[2] = v[i][2]; d[3] = v[i][3]; }
        const int nit = it + X.ngw;
        if (nit < tot) { const float* s = TR_SRC(nit);
#pragma unroll
            for (int i = 0; i < 16; ++i) v[i] = __builtin_nontemporal_load((const f32x4*)(s + (size_t)(4 * i) * N)); }
        asm volatile("s_waitcnt lgkmcnt(0)" ::: "memory");
        const int m = it / per, r = it - m * per, k0 = 64 * (r / nblk), n0 = 64 * (r % nblk);
        bf16* dst = WT + (size_t)m * dstride;
        f32x4 ga = {1.f, 1.f, 1.f, 1.f}, gb = ga; if (rscale) { const f32x4* gp = (const f32x4*)(rscale + (size_t)m * K + k0 + 8 * c); ga = gp[0]; gb = gp[1]; }
#pragma unroll
        for (int j = 0; j < 8; ++j) { const int n = nsub + 8 * j; const LAS float* s = scr + (8 * c) * 65 + n;
            v4u o; o.x = cvtpk_(s[0 * 65] * ga[0], s[1 * 65] * ga[1]); o.y = cvtpk_(s[2 * 65] * ga[2], s[3 * 65] * ga[3]); o.z = cvtpk_(s[4 * 65] * gb[0], s[5 * 65] * gb[1]); o.w = cvtpk_(s[6 * 65] * gb[2], s[7 * 65] * gb[3]);
            __builtin_nontemporal_store(o, (v4u*)(dst + (size_t)rowmap<MAP>(n0 + n) * K + k0 + 8 * c)); }
        asm volatile("s_waitcnt lgkmcnt(0)" ::: "memory");
        it = nit;
    }
#undef TR_SRC
}
struct Row8 { f32x4 a[2][2]; };
__device__ __forceinline__ void row8_load(Row8& r, const float* p, int lane) {
#pragma unroll
    for (int j = 0; j < 2; ++j) { const f32x4* q = (const f32x4*)p + 2 * (lane + 64 * j); r.a[j][0] = q[0]; r.a[j][1] = q[1]; }
}
__device__ __forceinline__ void row8_load16(Row8& r, const bf16* p, int lane) {
#pragma unroll
    for (int j = 0; j < 2; ++j) { const v4u w = ((const v4u*)p)[lane + 64 * j];
        r.a[j][0] = (f32x4){bflo(w.x), bfhi(w.x), bflo(w.y), bfhi(w.y)}; r.a[j][1] = (f32x4){bflo(w.z), bfhi(w.z), bflo(w.w), bfhi(w.w)}; }
}
__device__ __forceinline__ float row8_sumsq(const Row8& r) {
    float s = 0.f;
#pragma unroll
    for (int j = 0; j < 2; ++j)
#pragma unroll
        for (int h = 0; h < 2; ++h) s += (r.a[j][h].x * r.a[j][h].x + r.a[j][h].y * r.a[j][h].y) + (r.a[j][h].z * r.a[j][h].z + r.a[j][h].w * r.a[j][h].w);
    return s;
}
__device__ __forceinline__ void rms_row_to_bf16(const float* __restrict__ xrow, const float* __restrict__ g, bf16* __restrict__ orow, int lane) {
    const f32x4* xr = (const f32x4*)xrow + lane; f32x4 v[4]; float s = 0.f;
#pragma unroll
    for (int j = 0; j < 4; ++j) { v[j] = xr[64 * j]; s += (v[j].x * v[j].x + v[j].y * v[j].y) + (v[j].z * v[j].z + v[j].w * v[j].w); }
    const float r = rsqrtf(wave_sum(s) * (1.f / D) + 1e-6f);
    v2u* o8 = (v2u*)orow + lane;
#pragma unroll
    for (int j = 0; j < 4; ++j) { const f32x4 gg = ((const f32x4*)g)[lane + 64 * j]; v2u w; w.x = pk2(v[j].x * r * gg.x, v[j].y * r * gg.y); w.y = pk2(v[j].z * r * gg.z, v[j].w * r * gg.w); o8[64 * j] = w; }
}
__device__ __forceinline__ void p0_filters(const Ctx& X, const Args& a) {
    LAS float* z = (LAS float*)X.lds;
    LAS float* h1 = z + 32 * 36;
    LAS float* h2r = h1 + 32 * 64;
    LAS float* w1s = h2r + 32 * 68;
    LAS float* w2s = w1s + 33 * 64;
    bf16* FILT = (bf16*)(X.ws + WS_FILT);
    const float min_decay = logf(1e-2f) / 0.3f, max_decay = logf(1e-2f) / 1.5f;
    for (int it = X.bid; it < 2 * (S / 32); it += X.G) {
        int tid = X.tid; asm volatile("" : "+v"(tid));
        const int j = tid & 63, tq = tid >> 6;
        const int l = it / (S / 32), t0 = (it % (S / 32)) * 32;
        const float *w1 = a.in[6] + l * 33 * 64, *b1 = a.in[7] + l * 64, *f1 = a.in[8] + l * 64, *w2 = a.in[9] + l * 64 * 64, *b2 = a.in[10] + l * 64, *f2 = a.in[11] + l * 64, *w3 = a.in[12] + (size_t)l * 64 * 2048;
        __syncthreads();
        for (int e = tid; e < 33 * 64; e += NTH) w1s[e] = w1[e];
        for (int e = tid; e < 64 * 64; e += NTH) w2s[e] = w2[e];
        for (int e = tid; e < 32 * 33; e += NTH) { const int tt = e / 33, jj0 = e - tt * 33, t = t0 + tt; float v;
            if (jj0 == 0) v = (float)t / (float)(S - 1);
            else { const int jj = (jj0 - 1) & 15; const float w = 2.0f * 3.14159265358979323846f * (float)t / (float)S; const float fr = 1e-4f + (float)jj * ((15.0f - 1e-4f) / 15.0f); const float ang = w * fr; v = (jj0 <= 16) ? cosf(ang) : -sinf(ang); }
            z[tt * 36 + jj0] = v; }
        const float bb1 = b1[j], ff1 = f1[j], bb2 = b2[j], ff2 = f2[j];
        __syncthreads();
        { float acc[4] = {bb1, bb1, bb1, bb1};
          for (int i = 0; i < 33; ++i) { const float w = w1s[i * 64 + j];
#pragma unroll
              for (int k = 0; k < 4; ++k) acc[k] += z[(tq + 8 * k) * 36 + i] * w; }
#pragma unroll
          for (int k = 0; k < 4; ++k) h1[(tq + 8 * k) * 64 + j] = sinf(ff1 * acc[k]); }
        __syncthreads();
        { float acc[4] = {bb2, bb2, bb2, bb2};
          for (int i = 0; i < 64; ++i) { const float w = w2s[i * 64 + j];
#pragma unroll
              for (int k = 0; k < 4; ++k) acc[k] += h1[(tq + 8 * k) * 64 + i] * w; }
#pragma unroll
          for (int k = 0; k < 4; ++k) h2r[(tq + 8 * k) * 68 + j] = sinf(ff2 * acc[k]); }
        __syncthreads();
        { const int wv = tid >> 6, ln = tid & 63, tl = ln & 31, kh = ln >> 5;
#define FSPLIT(HI, LO, V0, V1) do { v4u h_; h_.x = cvtpk_((V0)[0], (V0)[1]); h_.y = cvtpk_((V0)[2], (V0)[3]); h_.z = cvtpk_((V1)[0], (V1)[1]); h_.w = cvtpk_((V1)[2], (V1)[3]); \
            v4u l_; l_.x = cvtpk_((V0)[0] - bflo(h_.x), (V0)[1] - bfhi(h_.x)); l_.y = cvtpk_((V0)[2] - bflo(h_.y), (V0)[3] - bfhi(h_.y)); l_.z = cvtpk_((V1)[0] - bflo(h_.z), (V1)[1] - bfhi(h_.z)); l_.w = cvtpk_((V1)[2] - bflo(h_.w), (V1)[3] - bfhi(h_.w)); \
            HI = __builtin_bit_cast(bf16x8, h_); LO = __builtin_bit_cast(bf16x8, l_); } while (0)
            bf16x8 ah[4], al[4];
#pragma unroll
            for (int kb = 0; kb < 4; ++kb) { const f32x4 v0 = *(const LAS f32x4*)(h2r + tl * 68 + 16 * kb + 8 * kh), v1 = *(const LAS f32x4*)(h2r + tl * 68 + 16 * kb + 8 * kh + 4); FSPLIT(ah[kb], al[kb], v0, v1); }
            const float* wl = w3 + (size_t)(8 * kh) * 2048 + wv * 256 + tl;
            f32x4 wq[2][4][2];
#define FLOADW(BUF, NT) do { _Pragma("unroll") for (int kb_ = 0; kb_ < 4; ++kb_) _Pragma("unroll") for (int j_ = 0; j_ < 8; ++j_) wq[BUF][kb_][j_ >> 2][j_ & 3] = wl[(size_t)(16 * kb_ + j_) * 2048 + 32 * (NT)]; } while (0)
#define FTILE(BUF, NT) do { f32x16 d_ = {}; _Pragma("unroll") for (int kb_ = 0; kb_ < 4; ++kb_) { bf16x8 bh_, bl_; FSPLIT(bh_, bl_, wq[BUF][kb_][0], wq[BUF][kb_][1]); \
                d_ = __builtin_amdgcn_mfma_f32_32x32x16_bf16(ah[kb_], bh_, d_, 0, 0, 0); d_ = __builtin_amdgcn_mfma_f32_32x32x16_bf16(al[kb_], bh_, d_, 0, 0, 0); d_ = __builtin_amdgcn_mfma_f32_32x32x16_bf16(ah[kb_], bl_, d_, 0, 0, 0); } \
              const int n_ = wv * 256 + 32 * (NT) + tl, c_ = n_ & 511, od_ = n_ >> 9; const float dl_ = fabsf(min_decay + (float)c_ * ((max_decay - min_decay) / 511.0f)) * (1.0f / (float)(S - 1)); \
              bf16* fo_ = FILT + (((size_t)l * 4 + od_) * C + c_) * S + t0 + 4 * kh; \
              _Pragma("unroll") for (int g_ = 0; g_ < 4; ++g_) { const float tb_ = (float)(t0 + 8 * g_ + 4 * kh); v2u o_; \
                  o_.x = pk2(d_[4 * g_] * expf(-tb_ * dl_), d_[4 * g_ + 1] * expf(-(tb_ + 1.f) * dl_)); o_.y = pk2(d_[4 * g_ + 2] * expf(-(tb_ + 2.f) * dl_), d_[4 * g_ + 3] * expf(-(tb_ + 3.f) * dl_)); \
                  *(v2u*)(fo_ + 8 * g_) = o_; } } while (0)
            FLOADW(0, 0);
#pragma unroll 1
            for (int nt = 0; nt < 8; nt += 2) { FLOADW(1, nt + 1); FTILE(0, nt); if (nt + 2 < 8) FLOADW(0, nt + 2); FTILE(1, nt + 1); }
#undef FSPLIT
#undef FLOADW
#undef FTILE
        }
    }
    __syncthreads();
}
template <int MAP> __device__ __forceinline__ void p0_convert(const Ctx& X, const float* W, int K, int N, bf16* WB, int dN, int nmat, size_t sstride, size_t dstride, const float* __restrict__ rscale = nullptr) {
    const int nblk = N / 256, per = (K / 16) * nblk, tot = per * nmat, lane = X.lane;
    f32x4 v[16];
    int it = X.gw;
#define CV_SRC(it_) (W + (size_t)((it_) / per) * sstride + (size_t)(16 * (((it_) % per) / nblk)) * N + 256 * (((it_) % per) % nblk) + 4 * lane)
    if (it < tot) { const float* s = CV_SRC(it);
#pragma unroll
        for (int i = 0; i < 16; ++i) v[i] = __builtin_nontemporal_load((const f32x4*)(s + (size_t)i * N)); }
    while (it < tot) {
        v2u o[16];
        if (rscale) { const int k0s = 16 * ((it % per) / nblk);
#pragma unroll
            for (int i = 0; i < 16; ++i) { const float sc = rscale[k0s + i]; o[i].x = cvtpk_(v[i][0] * sc, v[i][1] * sc); o[i].y = cvtpk_(v[i][2] * sc, v[i][3] * sc); } }
        else {
#pragma unroll
        for (int i = 0; i < 16; ++i) { o[i].x = cvtpk_(v[i][0], v[i][1]); o[i].y = cvtpk_(v[i][2], v[i][3]); } }
        const int nit = it + X.ngw;
        if (nit < tot) { const float* s = CV_SRC(nit);
#pragma unroll
            for (int i = 0; i < 16; ++i) v[i] = __builtin_nontemporal_load((const f32x4*)(s + (size_t)i * N)); }
        const int mi = it / per, r = it - mi * per, k0 = 16 * (r / nblk), n = 256 * (r % nblk) + 4 * lane;
        const int dc = MAP == 0 ? n : (((n >> 7) << 8) + (n & 127) + (MAP == 3 ? 128 : 0));
        bf16* dst = WB + (size_t)mi * dstride + (size_t)k0 * dN + dc;
#pragma unroll
        for (int i = 0; i < 16; ++i) __builtin_nontemporal_store(o[i], (v2u*)(dst + (size_t)i * dN));
        it = nit;
    }
#undef CV_SRC
}
__device__ __forceinline__ void p0_experts(const Ctx& X, const Args& a, int l) {
    bf16* wgu = (bf16*)(X.ws + WS_WGU) + (size_t)l * E * 2 * F * D; bf16* wd = (bf16*)(X.ws + WS_WD) + (size_t)l * E * F * D;
    p0_convert<2>(X, a.in[25] + (size_t)l * E * D * F, D, F, wgu, 2 * F, E, (size_t)D * F, (size_t)2 * F * D, a.in[22] + l * D);
    p0_convert<3>(X, a.in[26] + (size_t)l * E * D * F, D, F, wgu, 2 * F, E, (size_t)D * F, (size_t)2 * F * D, a.in[22] + l * D);
    p0_convert<0>(X, a.in[27] + (size_t)l * E * D * F, F, D, wd, D, E, (size_t)F * D, (size_t)F * D);
}
__device__ __forceinline__ void p0_experts_rest(const Ctx& X, const Args& a, int l, int me0) {
    bf16* wgu = (bf16*)(X.ws + WS_WGU) + (size_t)l * E * 2 * F * D; bf16* wd = (bf16*)(X.ws + WS_WD) + (size_t)l * E * F * D;
    const int g0 = me0 < 16 ? me0 : 16, u0 = me0 < 16 ? 0 : (me0 < 32 ? me0 - 16 : 16), d0 = me0 < 32 ? 0 : me0 - 32;
    if (g0 < 16) p0_convert<2>(X, a.in[25] + ((size_t)l * E + g0) * D * F, D, F, wgu + (size_t)g0 * 2 * F * D, 2 * F, E - g0, (size_t)D * F, (size_t)2 * F * D, a.in[22] + l * D);
    if (u0 < 16) p0_convert<3>(X, a.in[26] + ((size_t)l * E + u0) * D * F, D, F, wgu + (size_t)u0 * 2 * F * D, 2 * F, E - u0, (size_t)D * F, (size_t)2 * F * D, a.in[22] + l * D);
    if (d0 < 16) p0_convert<0>(X, a.in[27] + ((size_t)l * E + d0) * D * F, F, D, wd + (size_t)d0 * F * D, D, E - d0, (size_t)F * D, (size_t)F * D);
}
#ifndef MK_P0_DUP
#define MK_P0_DUP 0
#endif
__device__ __forceinline__ void p0_prologue(const Ctx& X, const Args& a) {
    const int m = a.p0_mask;
    for (int dup_ = 0; dup_ < ((MK_P0_DUP & 1) ? 2 : 1); ++dup_)
    if (m & 1) {
        p0_transpose<1>(X, a.in[2], D, INW, (bf16*)(X.ws + WS_WIN), 2, (size_t)D * INW, (size_t)D * INW, 0, a.in[1]);
        p0_transpose<0>(X, a.in[19], C, D, (bf16*)(X.ws + WS_WUH), 2, (size_t)C * D, (size_t)2 * C * D, 512 % X.ngw);
        p0_transpose<0>(X, a.in[20], C, D, (bf16*)(X.ws + WS_WUA), 2, (size_t)C * D, (size_t)2 * C * D, 768 % X.ngw);
        p0_transpose<0>(X, a.in[21], D, D, (bf16*)(X.ws + WS_WOUT), 2, (size_t)D * D, (size_t)D * D, 1024 % X.ngw);
        float* binp = (float*)(X.ws + WS_BINP);
        for (int i = X.gw * 64 + X.lane; i < 2 * INW; i += X.ngw * 64) { const int l = i / INW, n = i - l * INW; binp[l * INW + rowmap<1>(n)] = a.in[3][i]; }
        { bf16* wrp = (bf16*)(X.ws + WS_WRP);
          for (int i = X.gw * 64 + X.lane; i < 2 * E * D; i += X.ngw * 64) { const int l = i / (E * D), e = (i / D) % E, k = i % D; const float v = a.in[22][l * D + k] * a.in[23][((size_t)l * D + k) * E + e];
              const unsigned hi = f2bf(v); const float lo = v - __builtin_bit_cast(float, hi << 16); wrp[((l * 2 + 0) * E + e) * D + k] = (bf16)hi; wrp[((l * 2 + 1) * E + e) * D + k] = (bf16)f2bf(lo); } }
        float* rope = (float*)(X.ws + WS_ROPE);
        for (int i = X.gw * 64 + X.lane; i < S * 32; i += X.ngw * 64) { const int pos = i >> 5, j = i & 31; const float inv = powf(10000.0f, -(float)j * 2.0f / 64.0f); float sn, cs; sincosf((float)pos * inv, &sn, &cs); rope[2 * i] = cs; rope[2 * i + 1] = sn; }
    }
    if (m & 2) { p0_experts(X, a, 0); p0_experts(X, a, 1); }
    for (int dup_ = 0; dup_ < ((MK_P0_DUP & 4) ? 2 : 1); ++dup_)
    if (m & 4) p0_filters(X, a);
    for (int dup_ = 0; dup_ < ((MK_P0_DUP & 8) ? 2 : 1); ++dup_)
    if (m & 8) {
        bf16* XB = (bf16*)(X.ws + WS_XN); float* rmix = (float*)(X.ws + WS_RMIX); const int lane = X.lane;
        int r = X.gw; Row8 cur; if (r < T) row8_load(cur, a.in[0] + (size_t)r * D, lane);
        while (r < T) { const int nr = r + X.ngw; Row8 nxt; if (nr < T) row8_load(nxt, a.in[0] + (size_t)nr * D, lane);
            const float rs = rsqrtf(wave_sum(row8_sumsq(cur)) * (1.f / D) + 1e-6f);
            if (lane == 0) rmix[r] = rs;
#pragma unroll
            for (int j = 0; j < 2; ++j) { const f32x4 y0 = cur.a[j][0], y1 = cur.a[j][1];
                v4u w; w.x = pk2(y0.x, y0.y); w.y = pk2(y0.z, y0.w); w.z = pk2(y1.x, y1.y); w.w = pk2(y1.z, y1.w); ((v4u*)(XB + (size_t)r * D))[lane + 64 * j] = w; }
            cur = nxt; r = nr; }
    }
}
}
namespace mk {
using pg8::Unit;
#ifndef MK_SIMPLE_ORDER
#define MK_SIMPLE_ORDER 0
#endif
__device__ __forceinline__ unsigned cvtpk(float lo, float hi) { unsigned r; asm volatile("v_cvt_pk_bf16_f32 %0, %1, %2" : "=v"(r) : "v"(lo), "v"(hi)); return r; }
__device__ __forceinline__ v4u pack8(f32x4 a, f32x4 b) { v4u w; w.x = cvtpk(a[0], a[1]); w.y = cvtpk(a[2], a[3]); w.z = cvtpk(b[0], b[1]); w.w = cvtpk(b[2], b[3]); return w; }
__device__ __forceinline__ void unpack8(v4u w, f32x4& a, f32x4& b) { a = (f32x4){bflo(w.x), bfhi(w.x), bflo(w.y), bfhi(w.y)}; b = (f32x4){bflo(w.z), bfhi(w.z), bflo(w.w), bfhi(w.w)}; }
__device__ __forceinline__ float fsig(float x) { return __builtin_amdgcn_rcpf(1.f + __expf(-x)); }

struct EpiWin {
    static constexpr bool PERM = true, AFTER_DRAIN = false;
    unsigned char* ws; const float* bias; const float* rope; const float* rmix;
    __device__ __forceinline__ void operator()(const f32x4 (&acc)[2][2][4][2], const Unit& u, int wr, int wc, int fr, int fq) const {
        const int colt = u.pn * 256, row0 = u.pm * 256 + wr * 64 + fr, cin = wc * 32 + 8 * fq;
        bf16* base; int ldc, col0, mode; float sc = 1.f;
        if (colt < 1536) { base = (bf16*)(ws + WS_U); ldc = 1536; col0 = colt; mode = 0; }
        else if (colt < 2048) { base = (bf16*)(ws + WS_Q); ldc = 512; col0 = colt - 1536; mode = 1; sc = QSCALE; }
        else if (colt < 2560) { base = (bf16*)(ws + WS_K); ldc = 512; col0 = colt - 2048; mode = 1; }
        else if (colt < 3072) { base = (bf16*)(ws + WS_V); ldc = 512; col0 = colt - 2560; mode = 0; }
        else if (colt < 4096) { base = (bf16*)(ws + WS_GH); ldc = 1024; col0 = colt - 3072; mode = 2; }
        else { base = (bf16*)(ws + WS_GA); ldc = 1024; col0 = colt - 4096; mode = 2; }
        f32x4 bv[2][2]; float rv[2][4];
#pragma unroll
        for (int ai = 0; ai < 2; ++ai)
#pragma unroll
            for (int m = 0; m < 4; ++m) rv[ai][m] = rmix[row0 + ai * 128 + m * 16];
#pragma unroll
        for (int bj = 0; bj < 2; ++bj)
#pragma unroll
            for (int n = 0; n < 2; ++n) bv[bj][n] = *(const f32x4*)(bias + colt + bj * 128 + cin + 4 * n);
#pragma unroll
        for (int ai = 0; ai < 2; ++ai)
#pragma unroll
            for (int m = 0; m < 4; ++m) {
                const int row = row0 + ai * 128 + m * 16; bf16* rowp = base + (size_t)row * ldc + col0 + cin;
                f32x4 rq[2][2];
                if (mode == 1) {
#pragma unroll
                    for (int bj = 0; bj < 2; ++bj) { const int i = ((bj * 128 + cin) & 63) >> 3; const float* rp = rope + ((size_t)(row & (S - 1)) * 32 + 4 * i) * 2; rq[bj][0] = *(const f32x4*)rp; rq[bj][1] = *(const f32x4*)(rp + 4); } }
#pragma unroll
                for (int bj = 0; bj < 2; ++bj) {
                    f32x4 v0 = acc[ai][bj][m][0] * rv[ai][m] + bv[bj][0], v1 = acc[ai][bj][m][1] * rv[ai][m] + bv[bj][1];
                    if (mode == 1) {
                        const f32x4 r0 = rq[bj][0], r1 = rq[bj][1];
                        const f32x4 cs = {r0[0], r0[2], r1[0], r1[2]}, sn = {r0[1], r0[3], r1[1], r1[3]};
                        const f32x4 o1 = (v0 * cs - v1 * sn) * sc, o2 = (v1 * cs + v0 * sn) * sc; v0 = o1; v1 = o2;
                    } else if (mode == 2) {
#pragma unroll
                        for (int e = 0; e < 4; ++e) { v0[e] = fsig(v0[e]); v1[e] = fsig(v1[e]); }
                    }
                    *(v4u*)(rowp + bj * 128) = pack8(v0, v1);
                }
            }
    }
};
struct EpiMerge2 {
    static constexpr bool PERM = true, AFTER_DRAIN = false;
    const bf16* GH; const bf16* GA; bf16* T1; bf16* MG;
    __device__ __forceinline__ void operator()(const f32x4 (&acc)[2][2][4][2], const Unit& u, int wr, int wc, int fr, int fq) const {
        const int row0 = u.pm * 256 + wr * 64 + fr, col0 = u.pn * 256 + wc * 32 + 8 * fq; const bool second = u.pa != u.pm; const bf16* G = second ? GA : GH;
#pragma unroll
        for (int ai = 0; ai < 2; ++ai)
#pragma unroll
            for (int mp = 0; mp < 4; mp += 2) {
                v4u gq[2][2], tq[2][2];
#pragma unroll
                for (int mm = 0; mm < 2; ++mm)
#pragma unroll
                    for (int bj = 0; bj < 2; ++bj) { const size_t off = (size_t)(row0 + ai * 128 + (mp + mm) * 16) * D + col0 + bj * 128; gq[mm][bj] = *(const v4u*)(G + off); if (second) tq[mm][bj] = *(const v4u*)(T1 + off); }
#pragma unroll
                for (int mm = 0; mm < 2; ++mm) { const int m = mp + mm; const size_t off = (size_t)(row0 + ai * 128 + m * 16) * D + col0;
#pragma unroll
                    for (int bj = 0; bj < 2; ++bj) { f32x4 g0, g1; unpack8(gq[mm][bj], g0, g1);
                        f32x4 v0 = acc[ai][bj][m][0] * g0, v1 = acc[ai][bj][m][1] * g1;
                        if (second) { f32x4 t0, t1; unpack8(tq[mm][bj], t0, t1); v0 += t0; v1 += t1; *(v4u*)(MG + off + bj * 128) = pack8(v0, v1); }
                        else *(v4u*)(T1 + off + bj * 128) = pack8(v0, v1); } } }
    }
};
struct OrderMerge {
    pg8::StaticOrder so;
    __device__ __forceinline__ bool next(int i, Unit& u) const { if (!so.next(i >> 1, u)) return false; if (i & 1) { u.pa = u.pm + T / 256; u.pb = u.pn + 4; } return true; }
    __device__ __forceinline__ void a_ready(const Unit&) const {}
    __device__ __forceinline__ void done(const Unit&) const {}
};
struct EpiOut {
    static constexpr bool PERM = false, AFTER_DRAIN = false;
    const float* xin; float* X;
    __device__ __forceinline__ void operator()(const f32x4 (&acc)[2][2][4][2], const Unit& u, int wr, int wc, int fr, int fq) const {
        const int row0 = u.pm * 256 + wr * 64 + fr, col0 = u.pn * 256 + wc * 32 + 4 * fq;
#pragma unroll
        for (int ai = 0; ai < 2; ++ai)
#pragma unroll
            for (int m = 0; m < 4; ++m) { const size_t off = (size_t)(row0 + ai * 128 + m * 16) * D + col0;
#pragma unroll
                for (int bj = 0; bj < 2; ++bj)
#pragma unroll
                    for (int n = 0; n < 2; ++n) *(f32x4*)(X + off + bj * 128 + n * 16) = *(const f32x4*)(xin + off + bj * 128 + n * 16) + acc[ai][bj][m][n]; }
    }
};
struct EpiOutR {
    static constexpr bool PERM = true, AFTER_DRAIN = true;
    const bf16* xin16; bf16* XB; float* PART; const bf16* WRP; unsigned* tick; float* AFFT; float* RTOK; const float* br;
    __device__ __forceinline__ void operator()(const f32x4 (&)[2][2][4][2], const Unit&, int, int, int, int) const {}
    __device__ __forceinline__ void fused(const f32x4 (&acc)[2][2][4][2], const Unit& u, int wr, int wc, int fr, int fq, LAS unsigned char* lds, int wid, int lane) const {
        LAS float* SS = (LAS float*)lds;
        LAS float* LG = (LAS float*)(lds + 16384);
        const int rowl0 = wr * 64 + fr, colw = wc * 32 + 8 * fq;
        bf16x8 whi[2], wlo[2];
#pragma unroll
        for (int bj = 0; bj < 2; ++bj) { const bf16* wp = WRP + (size_t)fr * D + u.pn * 256 + bj * 128 + colw; whi[bj] = *(const bf16x8*)wp; wlo[bj] = *(const bf16x8*)(wp + (size_t)E * D); }
#pragma unroll
        for (int ai = 0; ai < 2; ++ai)
#pragma unroll
            for (int m = 0; m < 4; ++m) { const int rowl = rowl0 + ai * 128 + m * 16; float ss = 0.f; f32x4 lg = {0.f, 0.f, 0.f, 0.f};
                f32x4 xq[2][2];
#pragma unroll
                for (int bj = 0; bj < 2; ++bj) { const size_t off = (size_t)(u.pm * 256 + rowl) * D + u.pn * 256 + bj * 128 + colw; unpack8(*(const v4u*)(xin16 + off), xq[bj][0], xq[bj][1]); }
#pragma unroll
                for (int bj = 0; bj < 2; ++bj) { const size_t off = (size_t)(u.pm * 256 + rowl) * D + u.pn * 256 + bj * 128 + colw;
                    const f32x4 x0 = xq[bj][0] + acc[ai][bj][m][0], x1 = xq[bj][1] + acc[ai][bj][m][1];
                    const v4u hi = pack8(x0, x1); *(v4u*)(XB + off) = hi;
                    f32x4 h0, h1; unpack8(hi, h0, h1); const v4u lo = pack8(x0 - h0, x1 - h1);
                    ss += ((x0[0] * x0[0] + x0[1] * x0[1]) + (x0[2] * x0[2] + x0[3] * x0[3])) + ((x1[0] * x1[0] + x1[1] * x1[1]) + (x1[2] * x1[2] + x1[3] * x1[3]));
                    lg = __builtin_amdgcn_mfma_f32_16x16x32_bf16(whi[bj], __builtin_bit_cast(bf16x8, hi), lg, 0, 0, 0);
                    lg = __builtin_amdgcn_mfma_f32_16x16x32_bf16(whi[bj], __builtin_bit_cast(bf16x8, lo), lg, 0, 0, 0);
                    lg = __builtin_amdgcn_mfma_f32_16x16x32_bf16(wlo[bj], __builtin_bit_cast(bf16x8, hi), lg, 0, 0, 0); }
                SS[rowl * 16 + wc * 4 + fq] = ss;
                *(LAS f32x4*)(LG + ((wc * 256 + rowl) * 16 + 4 * fq)) = lg; }
        __syncthreads();
        const int t = wid * 64 + lane;
        if (t < 256) { float s = 0.f;
#pragma unroll
            for (int i = 0; i < 4; ++i) { const f32x4 v = *(const LAS f32x4*)(SS + t * 16 + 4 * i); s += (v[0] + v[1]) + (v[2] + v[3]); }
            float* pp = PART + ((size_t)u.pn * T + u.pm * 256 + t) * 20;
            __hip_atomic_store(pp, s, __ATOMIC_RELAXED, __HIP_MEMORY_SCOPE_AGENT);
#pragma unroll
            for (int i = 0; i < 4; ++i) { f32x4 a4 = *(const LAS f32x4*)(LG + (t * 16 + 4 * i));
#pragma unroll
                for (int w = 1; w < 4; ++w) a4 += *(const LAS f32x4*)(LG + ((w * 256 + t) * 16 + 4 * i));
#pragma unroll
                for (int q = 0; q < 4; ++q) __hip_atomic_store(pp + 4 + 4 * i + q, a4[q], __ATOMIC_RELAXED, __HIP_MEMORY_SCOPE_AGENT); } }
        asm volatile("s_waitcnt vmcnt(0)" ::: "memory");
        __syncthreads();
        LAS int* flag = (LAS int*)(lds + 16384 + 65536);
        if (t == 0) flag[0] = (int)__hip_atomic_fetch_add(tick + u.pm, 1u, __ATOMIC_RELAXED, __HIP_MEMORY_SCOPE_AGENT);
        __syncthreads();
        if (flag[0] == 3) {
            if (t < 256) { const int tok = u.pm * 256 + t; f32x4 s4 = {0.f, 0.f, 0.f, 0.f}, l4[4];
#pragma unroll
                for (int j = 0; j < 4; ++j) l4[j] = (f32x4){0.f, 0.f, 0.f, 0.f};
#pragma unroll
                for (int pn = 0; pn < 4; ++pn) { const float* pq = PART + ((size_t)pn * T + tok) * 20; s4[0] += __hip_atomic_load(pq, __ATOMIC_RELAXED, __HIP_MEMORY_SCOPE_AGENT);
#pragma unroll
                    for (int j = 0; j < 4; ++j)
#pragma unroll
                        for (int q = 0; q < 4; ++q) l4[j][q] += __hip_atomic_load(pq + 4 + 4 * j + q, __ATOMIC_RELAXED, __HIP_MEMORY_SCOPE_AGENT); }
                const float r = rsqrtf(s4[0] * (1.f / D) + 1e-6f); float mx = -1e30f;
#pragma unroll
                for (int j = 0; j < 4; ++j)
#pragma unroll
                    for (int q = 0; q < 4; ++q) { const float v = l4[j][q] * r + br[4 * j + q]; l4[j][q] = v; mx = fmaxf(mx, v); }
                float l = 0.f;
#pragma unroll
                for (int j = 0; j < 4; ++j)
#pragma unroll
                    for (int q = 0; q < 4; ++q) { l4[j][q] = expf(l4[j][q] - mx); l += l4[j][q]; }
                const int b = tok >> 12, s_ = tok & (S - 1);
#pragma unroll
                for (int j = 0; j < 4; ++j)
#pragma unroll
                    for (int q = 0; q < 4; ++q) AFFT[((size_t)b * E + 4 * j + q) * S + s_] = l4[j][q] / l;
                RTOK[tok] = r; } }
        __syncthreads();
    }
};
struct EpiSwiGLU {
    static constexpr bool PERM = true, AFTER_DRAIN = false;
    bf16* HB; const float* RSL;
    __device__ __forceinline__ void operator()(const f32x4 (&acc)[2][2][4][2], const Unit& u, int wr, int wc, int fr, int fq) const {
        const int row0 = u.pm * 256 + wr * 64 + fr, col0 = u.pn * 128 + wc * 32 + 8 * fq;
        float rrv[2][4];
#pragma unroll
        for (int ai = 0; ai < 2; ++ai)
#pragma unroll
            for (int m = 0; m < 4; ++m) rrv[ai][m] = RSL[row0 + ai * 128 + m * 16];
#pragma unroll
        for (int ai = 0; ai < 2; ++ai)
#pragma unroll
            for (int m = 0; m < 4; ++m) { f32x4 h[2]; const float rr = rrv[ai][m];
#pragma unroll
                for (int n = 0; n < 2; ++n) { const f32x4 g = acc[ai][0][m][n] * rr, up = acc[ai][1][m][n] * rr;
#pragma unroll
                    for (int e = 0; e < 4; ++e) h[n][e] = g[e] * fsig(g[e]) * up[e]; }
                *(v4u*)(HB + (size_t)(row0 + ai * 128 + m * 16) * F + col0) = pack8(h[0], h[1]); }
    }
};
struct EpiDown {
    static constexpr bool PERM = true, AFTER_DRAIN = false;
    bf16* YE; const float* gate;
    __device__ __forceinline__ void operator()(const f32x4 (&acc)[2][2][4][2], const Unit& u, int wr, int wc, int fr, int fq) const {
        const int row0 = u.pm * 256 + wr * 64 + fr, col0 = u.pn * 256 + wc * 32 + 8 * fq;
        float gv[2][4];
#pragma unroll
        for (int ai = 0; ai < 2; ++ai)
#pragma unroll
            for (int m = 0; m < 4; ++m) gv[ai][m] = gate[row0 + ai * 128 + m * 16];
#pragma unroll
        for (int ai = 0; ai < 2; ++ai)
#pragma unroll
            for (int m = 0; m < 4; ++m) { const int row = row0 + ai * 128 + m * 16; const float g = gv[ai][m];
#pragma unroll
                for (int bj = 0; bj < 2; ++bj) *(v4u*)(YE + (size_t)row * D + col0 + bj * 128) = pack8(acc[ai][bj][m][0] * g, acc[ai][bj][m][1] * g); }
    }
};
struct OrderMoE1 {
    int G, c;
    __device__ __forceinline__ bool next(int i, Unit& u) const {
        if (MK_SIMPLE_ORDER || G != 256) { const int L = i * G + c; if (L >= 2048) return false; const int e = L >> 7, r = L & 127; u.pm = e * 8 + (r & 7); u.pn = r >> 3; u.pb = e * 16 + u.pn; u.pa = u.pm; return true; }
        if (i >= 8) return false;
        const int ch = i * 8 + (c & 7), j = c >> 3, e = ch >> 2, ng = ch & 3; u.pm = e * 8 + (j & 7); u.pn = ng * 4 + (j >> 3); u.pb = e * 16 + u.pn; u.pa = u.pm; return true;
    }
    __device__ __forceinline__ void a_ready(const Unit&) const {}
    __device__ __forceinline__ void done(const Unit&) const {}
};
struct OrderMoE2 {
    int G, c;
    __device__ __forceinline__ bool next(int i, Unit& u) const {
        if (MK_SIMPLE_ORDER || G != 256) { const int L = i * G + c; if (L >= 512) return false; const int e = L >> 5, r = L & 31; u.pm = e * 8 + (r & 7); u.pn = r >> 3; u.pb = e * 4 + u.pn; u.pa = u.pm; return true; }
        if (i >= 2) return false;
        const int e = i * 8 + (c & 7), j = c >> 3; u.pm = e * 8 + (j & 7); u.pn = j >> 3; u.pb = e * 4 + u.pn; u.pa = u.pm; return true;
    }
    __device__ __forceinline__ void a_ready(const Unit&) const {}
    __device__ __forceinline__ void done(const Unit&) const {}
};

__device__ __forceinline__ void p6_topk(const Ctx& X) {
    const float* afft = (const float*)(X.ws + WS_AFFT); const float* rtok = (const float*)(X.ws + WS_RTOK); int* rows = (int*)(X.ws + WS_ROWS); float* gate = (float*)(X.ws + WS_GATE); float* rsl = (float*)(X.ws + WS_RSL); int* inv = (int*)(X.ws + WS_INV);
    for (int p = X.bid; p < B * E; p += X.G) { const int b = p >> 4, e = p & 15, slotbase = e * 2048 + b * 512;
        unsigned key[8]; float rr[8];
        { const uint4 k0 = ((const uint4*)(afft + (size_t)p * S))[X.tid * 2], k1 = ((const uint4*)(afft + (size_t)p * S))[X.tid * 2 + 1]; const f32x4 r0 = ((const f32x4*)(rtok + b * S))[X.tid * 2], r1 = ((const f32x4*)(rtok + b * S))[X.tid * 2 + 1];
          key[0] = k0.x; key[1] = k0.y; key[2] = k0.z; key[3] = k0.w; key[4] = k1.x; key[5] = k1.y; key[6] = k1.z; key[7] = k1.w;
          rr[0] = r0[0]; rr[1] = r0[1]; rr[2] = r0[2]; rr[3] = r0[3]; rr[4] = r1[0]; rr[5] = r1[1]; rr[6] = r1[2]; rr[7] = r1[3]; }
        tk::topk_problem(key, rr, b * S, e, slotbase, rows + slotbase, gate + slotbase, rsl + slotbase, inv, (int*)(X.lds), X.tid); }
}
__device__ __forceinline__ void p9_combine(const Ctx& X, bf16* XR, const float* __restrict__ g, bool final_, float* __restrict__ out) {
    const int* inv = (const int*)(X.ws + WS_INV); const bf16* YE = (const bf16*)(X.ws + WS_YE); bf16* XN = (bf16*)(X.ws + WS_XN); float* rmix = (float*)(X.ws + WS_RMIX); const int lane = X.lane;
    Row8 gg; row8_load(gg, g, lane);
    int tok = X.gw; Row8 cur; int myinv = -1;
    if (tok < T) { row8_load16(cur, XN + (size_t)tok * D, lane); if (lane < 16) myinv = inv[(size_t)tok * E + lane]; }
    while (tok < T) {
        const int ntok = tok + X.ngw; Row8 nxt; int ninv = -1;
        if (ntok < T) { row8_load16(nxt, XN + (size_t)ntok * D, lane); if (lane < 16) ninv = inv[(size_t)ntok * E + lane]; }
        unsigned long long m = __ballot(myinv >= 0);
        while (m) {
            int sl[4];
#pragma unroll
            for (int i = 0; i < 4; ++i) { if (m) { const int e = __builtin_ctzll(m); m &= m - 1; sl[i] = __builtin_amdgcn_readlane(myinv, e); } else sl[i] = -1; }
            v4u y[4][2];
#pragma unroll
            for (int i = 0; i < 4; ++i) if (sl[i] >= 0) { const v4u* yp = (const v4u*)(YE + (size_t)sl[i] * D); y[i][0] = __builtin_nontemporal_load(yp + lane); y[i][1] = __builtin_nontemporal_load(yp + lane + 64); }
#pragma unroll
            for (int i = 0; i < 4; ++i) if (sl[i] >= 0) {
#pragma unroll
                for (int j = 0; j < 2; ++j) { f32x4 p, q; unpack8(y[i][j], p, q); cur.a[j][0] += p; cur.a[j][1] += q; } }
        }
        const float r = rsqrtf(wave_sum(row8_sumsq(cur)) * (1.f / D) + 1e-6f);
        if (final_) {
#pragma unroll
            for (int j = 0; j < 2; ++j)
#pragma unroll
                for (int h = 0; h < 2; ++h) ((f32x4*)(out + (size_t)tok * D))[2 * (lane + 64 * j) + h] = cur.a[j][h] * gg.a[j][h] * r;
        } else {
            if (lane == 0) rmix[tok] = r;
#pragma unroll
            for (int j = 0; j < 2; ++j) { v4u xw; xw.x = pk2(cur.a[j][0].x, cur.a[j][0].y); xw.y = pk2(cur.a[j][0].z, cur.a[j][0].w); xw.z = pk2(cur.a[j][1].x, cur.a[j][1].y); xw.w = pk2(cur.a[j][1].z, cur.a[j][1].w); ((v4u*)(XR + (size_t)tok * D))[lane + 64 * j] = xw; }
        }
        cur = nxt; myinv = ninv; tok = ntok;
    }
}
}
namespace mk {
__device__ __forceinline__ void p1t_shortconv(const Ctx& X, const float* __restrict__ cw, const float* __restrict__ cb) {
    const bf16* U = (const bf16*)(X.ws + WS_U); bf16* UCT = (bf16*)(X.ws + WS_UCT);
    LAS float* raw = (LAS float*)(X.lds + X.wave * 17408);
    const int lane = X.lane, rq = lane >> 3, cq = lane & 7;
    constexpr int NIT = (T / 64) * 24;
    v4u w[9];
#define P1T_LOAD(it_) do { const int tt_ = (it_) / 24, cg_ = (it_) - tt_ * 24, tok0_ = tt_ * 64, tin_ = tok0_ & (S - 1); \
        _Pragma("unroll") for (int i = 0; i < 9; ++i) { const int r = 8 * i + rq, tpos = tin_ + r - 1; w[i] = (v4u){0u, 0u, 0u, 0u}; \
            if (r < 66 && tpos >= 0 && tpos < S) w[i] = *(const v4u*)(U + (size_t)(tok0_ + r - 1) * 1536 + cg_ * 64 + 8 * cq); } } while (0)
    int it = X.gw;
    if (it < NIT) P1T_LOAD(it);
    while (it < NIT) {
        const int tt = it / 24, cg = it - tt * 24, tok0 = tt * 64, ch0 = cg * 64;
#pragma unroll
        for (int i = 0; i < 9; ++i) { const int r = 8 * i + rq; if (r < 66) { LAS float* d = raw + r * 65 + 8 * cq; f32x4 p, q; unpack8(w[i], p, q);
            d[0] = p.x; d[1] = p.y; d[2] = p.z; d[3] = p.w; d[4] = q.x; d[5] = q.y; d[6] = q.z; d[7] = q.w; } }
        const int nit = it + X.ngw;
        if (nit < NIT) P1T_LOAD(nit);
        asm volatile("s_waitcnt lgkmcnt(0)" ::: "memory");
        const int chs = lane >> 3, tch = lane & 7;
#pragma unroll
        for (int g = 0; g < 8; ++g) { const int ch = 8 * g + chs, gc = ch0 + ch; const float w0 = cw[gc], w1 = cw[1536 + gc], w2 = cw[3072 + gc], bb = cb[gc];
            float v[10];
#pragma unroll
            for (int k = 0; k < 10; ++k) v[k] = raw[(8 * tch + k) * 65 + ch];
            float o[8];
#pragma unroll
            for (int k = 0; k < 8; ++k) o[k] = v[k] * w0 + v[k + 1] * w1 + v[k + 2] * w2 + bb;
            v4u pk; pk.x = pk2(o[0], o[1]); pk.y = pk2(o[2], o[3]); pk.z = pk2(o[4], o[5]); pk.w = pk2(o[6], o[7]);
            *(v4u*)(UCT + (size_t)gc * T + tok0 + 8 * tch) = pk; }
        asm volatile("s_waitcnt lgkmcnt(0)" ::: "memory");
        it = nit;
    }
#undef P1T_LOAD
}

__device__ __forceinline__ void p1t_kmax(const Ctx& X, unsigned* kmax2) {
    const bf16* K = (const bf16*)(X.ws + WS_K); const int lane = X.lane; LAS float* red = (LAS float*)(X.lds + 8 * 17408);
    const int b = X.gw / 512, t0 = X.gw % 512; float mx = 0.f;
    if (b < B) {
        v4u w[8];
#pragma unroll
        for (int i = 0; i < 8; ++i) w[i] = ((const v4u*)(K + ((size_t)b * S + t0 + 512 * i) * 512))[lane];
#pragma unroll
        for (int i = 0; i < 8; ++i) { f32x4 p, q; unpack8(w[i], p, q); float ss = (p.x * p.x + p.y * p.y) + (p.z * p.z + p.w * p.w) + (q.x * q.x + q.y * q.y) + (q.z * q.z + q.w * q.w);
            ss += xor_f<1>(ss); ss += xor_f<2>(ss); ss += xor_f<4>(ss); mx = fmaxf(mx, ss); }
    }
    __syncthreads();
    if ((lane & 7) == 0) red[X.wave * 8 + (lane >> 3)] = mx;
    __syncthreads();
    if (X.tid < 8 && b < B) { float m = red[X.tid]; for (int w_ = 1; w_ < 8; ++w_) m = fmaxf(m, red[w_ * 8 + X.tid]); atomicMax(kmax2 + b * 8 + X.tid, __float_as_uint(m)); }
}

namespace at {
constexpr int KVBLK = 64, LDK = 512;
constexpr int KPITCH = 272;
constexpr int SHM_V = 64 * 128 * 2, SHM_K = 64 * KPITCH;
constexpr int OFF_V = 0, OFF_K = 2 * SHM_V, OFF_Q = OFF_K + 2 * SHM_K, OFF_WS = OFF_Q + 256 * KPITCH, LDS_TOTAL = OFF_WS + 8 * 160 * 4;
constexpr float THR2 = 8.0f * 1.4426950408889634f;
#define KSWZ(row, colB) ((row) * KPITCH + (colB))
#define SBAR() __builtin_amdgcn_sched_barrier(0)
__device__ __forceinline__ int crow(int r, int hi) { return (r & 3) + 8 * (r >> 2) + 4 * hi; }
__device__ __forceinline__ int v_st(int k, int c) { const int kk = (k & ~0xC) | ((k & 4) << 1) | ((k & 8) >> 1); return ((kk >> 3) * 4 + (c >> 5)) * 512 + ((kk & 7) * 32 + (c & 31)) * 2; }
__device__ __forceinline__ int v_rd_base(int lane) { return ((lane & 3) << 3) | (((lane >> 2) & 3) << 6) | (((lane >> 4) & 1) << 5) | (((lane >> 5) & 1) << 8); }
constexpr int v_rd_off(int d0, int ks, int half) { return d0 * 512 + ks * 4096 + half * 2048; }
template <int OFF> __device__ __forceinline__ s16x4 tr_read(int vb) { s16x4 r; asm volatile("ds_read_b64_tr_b16 %0, %1 offset:%2" : "=&v"(r) : "v"(vb), "i"(OFF) : "memory"); return r; }

template <int CO> __device__ __forceinline__ void qkt(f32x16& p0, f32x16& p1, const char* Ks, const char* Qs, int qrow, int r32, int hi) {
    p0 = f32x16{}; p1 = f32x16{};
    const char* qp = Qs + KSWZ(qrow, (CO * 64 + hi * 8) * 2); const char* kp = Ks + KSWZ(r32, (CO * 64 + hi * 8) * 2);
#pragma unroll
    for (int d0 = 0; d0 < 4; ++d0) {
        const bf16x8 qf = *reinterpret_cast<const bf16x8*>(qp + d0 * 32);
        const bf16x8 b0 = *reinterpret_cast<const bf16x8*>(kp + d0 * 32);
        const bf16x8 b1 = *reinterpret_cast<const bf16x8*>(kp + 32 * KPITCH + d0 * 32);
        p0 = __builtin_amdgcn_mfma_f32_32x32x16_bf16(b0, qf, p0, 0, 0, 0);
        p1 = __builtin_amdgcn_mfma_f32_32x32x16_bf16(b1, qf, p1, 0, 0, 0);
        if (d0 == 1) asm volatile("" ::: "memory"); }
}
__device__ __forceinline__ void softmax_tile(f32x16& p0, f32x16& p1, float& m_reg, float& l_reg, float& alpha, bf16x8& pa0, bf16x8& pa1, bf16x8& pa2, bf16x8& pa3) {
    float pmax = p0[0];
#pragma unroll
    for (int r = 1; r < 16; ++r) pmax = fmaxf(pmax, p0[r]);
#pragma unroll
    for (int r = 0; r < 16; ++r) pmax = fmaxf(pmax, p1[r]);
    { auto rr = __builtin_amdgcn_permlane32_swap(__float_as_uint(pmax), __float_as_uint(pmax), false, false); pmax = fmaxf(__uint_as_float(rr[0]), __uint_as_float(rr[1])); }
    float mn;
    if (__builtin_expect(__all(pmax - m_reg <= THR2), 1)) { mn = m_reg; alpha = 1.f; }
    else { mn = fmaxf(m_reg, pmax); alpha = __builtin_amdgcn_exp2f(m_reg - mn); m_reg = mn; }
#pragma unroll
    for (int r = 0; r < 16; ++r) { p0[r] = __builtin_amdgcn_exp2f(p0[r] - mn); p1[r] = __builtin_amdgcn_exp2f(p1[r] - mn); }
    float ps = 0.f;
#pragma unroll
    for (int r = 0; r < 16; ++r) ps += p0[r];
#pragma unroll
    for (int r = 0; r < 16; ++r) ps += p1[r];
    { auto rr = __builtin_amdgcn_permlane32_swap(__float_as_uint(ps), __float_as_uint(ps), false, false); ps = __uint_as_float(rr[0]) + __uint_as_float(rr[1]); }
    l_reg = l_reg * alpha + ps;
#define PK4(P, BASE, OUT) do { unsigned a0 = cvtpk(P[BASE + 0], P[BASE + 1]), a1 = cvtpk(P[BASE + 2], P[BASE + 3]);   \
    unsigned b0 = cvtpk(P[BASE + 4], P[BASE + 5]), b1 = cvtpk(P[BASE + 6], P[BASE + 7]);                              \
    auto r0 = __builtin_amdgcn_permlane32_swap(a0, b0, false, false); auto r1 = __builtin_amdgcn_permlane32_swap(a1, b1, false, false); \
    v4u w = {r0[0], r1[0], r0[1], r1[1]}; OUT = *reinterpret_cast<bf16x8*>(&w); } while (0)
    PK4(p0, 0, pa0); PK4(p0, 8, pa1); PK4(p1, 0, pa2); PK4(p1, 8, pa3);
#undef PK4
}
__device__ __forceinline__ void softmax_fixed(f32x16& p0, f32x16& p1, float m, float& l_half, bf16x8& pa0, bf16x8& pa1, bf16x8& pa2, bf16x8& pa3) {
#pragma unroll
    for (int r = 0; r < 16; ++r) { p0[r] = __builtin_amdgcn_exp2f(p0[r] - m); p1[r] = __builtin_amdgcn_exp2f(p1[r] - m); }
    float ps = 0.f;
#pragma unroll
    for (int r = 0; r < 16; ++r) ps += p0[r] + p1[r];
    l_half += ps;
#define PK4(P, BASE, OUT) do { unsigned a0 = cvtpk(P[BASE + 0], P[BASE + 1]), a1 = cvtpk(P[BASE + 2], P[BASE + 3]);   \
    unsigned b0 = cvtpk(P[BASE + 4], P[BASE + 5]), b1 = cvtpk(P[BASE + 6], P[BASE + 7]);                              \
    auto r0 = __builtin_amdgcn_permlane32_swap(a0, b0, false, false); auto r1 = __builtin_amdgcn_permlane32_swap(a1, b1, false, false); \
    v4u w = {r0[0], r1[0], r0[1], r1[1]}; OUT = *reinterpret_cast<bf16x8*>(&w); } while (0)
    PK4(p0, 0, pa0); PK4(p0, 8, pa1); PK4(p1, 0, pa2); PK4(p1, 8, pa3);
#undef PK4
}
template <int D0> __device__ __forceinline__ void pv_one(f32x16& oa, int vb, const bf16x8 (&pa)[4]) {
#define PK(L, H) (bf16x8){L[0], L[1], L[2], L[3], H[0], H[1], H[2], H[3]}
    {   const s16x4 l0 = tr_read<v_rd_off(D0, 0, 0)>(vb), h0 = tr_read<v_rd_off(D0, 0, 1)>(vb), l1 = tr_read<v_rd_off(D0, 1, 0)>(vb), h1 = tr_read<v_rd_off(D0, 1, 1)>(vb);
        asm volatile("s_waitcnt lgkmcnt(0)" ::: "memory"); SBAR();
        oa = __builtin_amdgcn_mfma_f32_32x32x16_bf16(pa[0], PK(l0, h0), oa, 0, 0, 0);
        oa = __builtin_amdgcn_mfma_f32_32x32x16_bf16(pa[1], PK(l1, h1), oa, 0, 0, 0); }
    {   const s16x4 l2 = tr_read<v_rd_off(D0, 2, 0)>(vb), h2 = tr_read<v_rd_off(D0, 2, 1)>(vb), l3 = tr_read<v_rd_off(D0, 3, 0)>(vb), h3 = tr_read<v_rd_off(D0, 3, 1)>(vb);
        asm volatile("s_waitcnt lgkmcnt(0)" ::: "memory"); SBAR();
        oa = __builtin_amdgcn_mfma_f32_32x32x16_bf16(pa[2], PK(l2, h2), oa, 0, 0, 0);
        oa = __builtin_amdgcn_mfma_f32_32x32x16_bf16(pa[3], PK(l3, h3), oa, 0, 0, 0); }
#undef PK
}
template <int D0> __device__ __forceinline__ void pv_two(f32x16& oa, f32x16& ob, int vb, const bf16x8 (&pa)[4], const bf16x8 (&pb)[4]) {
#define PK(L, H) (bf16x8){L[0], L[1], L[2], L[3], H[0], H[1], H[2], H[3]}
    {   const s16x4 l0 = tr_read<v_rd_off(D0, 0, 0)>(vb), h0 = tr_read<v_rd_off(D0, 0, 1)>(vb), l1 = tr_read<v_rd_off(D0, 1, 0)>(vb), h1 = tr_read<v_rd_off(D0, 1, 1)>(vb);
        asm volatile("s_waitcnt lgkmcnt(0)" ::: "memory"); SBAR();
        const bf16x8 v0 = PK(l0, h0), v1 = PK(l1, h1);
        oa = __builtin_amdgcn_mfma_f32_32x32x16_bf16(pa[0], v0, oa, 0, 0, 0); ob = __builtin_amdgcn_mfma_f32_32x32x16_bf16(pb[0], v0, ob, 0, 0, 0);
        oa = __builtin_amdgcn_mfma_f32_32x32x16_bf16(pa[1], v1, oa, 0, 0, 0); ob = __builtin_amdgcn_mfma_f32_32x32x16_bf16(pb[1], v1, ob, 0, 0, 0); }
    {   const s16x4 l2 = tr_read<v_rd_off(D0, 2, 0)>(vb), h2 = tr_read<v_rd_off(D0, 2, 1)>(vb), l3 = tr_read<v_rd_off(D0, 3, 0)>(vb), h3 = tr_read<v_rd_off(D0, 3, 1)>(vb);
        asm volatile("s_waitcnt lgkmcnt(0)" ::: "memory"); SBAR();
        const bf16x8 v2 = PK(l2, h2), v3 = PK(l3, h3);
        oa = __builtin_amdgcn_mfma_f32_32x32x16_bf16(pa[2], v2, oa, 0, 0, 0); ob = __builtin_amdgcn_mfma_f32_32x32x16_bf16(pb[2], v2, ob, 0, 0, 0);
        oa = __builtin_amdgcn_mfma_f32_32x32x16_bf16(pa[3], v3, oa, 0, 0, 0); ob = __builtin_amdgcn_mfma_f32_32x32x16_bf16(pb[3], v3, ob, 0, 0, 0); }
#undef PK
}
__device__ __forceinline__ void rescale(f32x16 (&o)[4], float al, float* wsf, int r32, int hi) {
    if (__any(al < 1.f)) {
        if (hi == 0) wsf[r32] = al; asm volatile("s_waitcnt lgkmcnt(0)" ::: "memory");
#pragma unroll
        for (int r = 0; r < 16; ++r) { const float a = wsf[crow(r, hi)];
#pragma unroll
            for (int d = 0; d < 4; ++d) o[d][r] *= a; }
    }
}

__device__ __forceinline__ void epilogue(const Ctx& X, f32x16 (&oa)[4], f32x16 (&ob)[4], const float* wsf, int r32, int hi, int b, int h, int qb, float lam, float mul, const float* __restrict__ sg) {
    bf16* Yw = (bf16*)(X.ws + WS_YA) + ((size_t)b * S + qb * 256 + X.wave * 32) * 512 + h * 128;
    float gcol[4];
#pragma unroll
    for (int d = 0; d < 4; ++d) gcol[d] = sg[d * 32 + r32] * mul;
#pragma unroll
    for (int r = 0; r < 16; ++r) { const int orow = crow(r, hi); const float i0 = __builtin_amdgcn_rcpf(wsf[orow] + wsf[64 + orow]), i1 = lam * __builtin_amdgcn_rcpf(wsf[32 + orow] + wsf[96 + orow]);
        float v[4], ss = 0.f;
#pragma unroll
        for (int d = 0; d < 4; ++d) { v[d] = oa[d][r] * i0 - ob[d][r] * i1; ss += v[d] * v[d]; }
        ss += xor_f<1>(ss); ss += xor_f<2>(ss); ss += xor_f<4>(ss); ss += xor_f<8>(ss); ss += xor_f<16>(ss);
        const float rn = rsqrtf(ss * (1.f / 128.f) + 1e-5f);
#pragma unroll
        for (int d = 0; d < 4; ++d) Yw[(size_t)orow * 512 + d * 32 + r32] = (bf16)f2bf(v[d] * rn * gcol[d]); }
}
__device__ __forceinline__ int vkey(int T_, int lane) { const int kk = ((T_ >> 2) << 3) | ((lane & 31) >> 2); return (kk & ~0xC) | ((kk & 4) << 1) | ((kk & 8) >> 1); }
__device__ __forceinline__ int vcol(int T_, int lane) { return (T_ & 3) * 32 + (lane & 3) * 8; }
__device__ __forceinline__ void attn_unit(const Ctx& X, int b, int h, int qb, float lam, float mul, const float* __restrict__ sg, unsigned* kmax2) {
    char* lds = (char*)X.lds;
    const int tid = fresh_tid(X.wave_s);
    const int wid = X.wave, lane = tid & 63, r32 = lane & 31, hi = lane >> 5;
    const bf16* Qg = (const bf16*)(X.ws + WS_Q) + ((size_t)b * S + qb * 256) * LDK + h * 128;
    const bf16* Kh = (const bf16*)(X.ws + WS_K) + (size_t)b * S * LDK + h * 128;
    const bf16* Vh = (const bf16*)(X.ws + WS_V) + (size_t)b * S * LDK + h * 128;
    char* V_lds = lds + OFF_V; char* K_lds = lds + OFF_K; char* Q_lds = lds + OFF_Q;
    float* wsf = (float*)(lds + OFF_WS) + wid * 160;
    const int sr = tid >> 4, sc = (tid & 15) * 8, vst0 = v_st(sr, sc), vst1 = v_st(32 + sr, sc);
    const int vb0 = (int)(uintptr_t)V_lds + v_rd_base(lane);
#pragma unroll
    for (int i = 0; i < 8; ++i) { const int row = sr + 32 * i; *(bf16x8*)(Q_lds + KSWZ(row, sc * 2)) = *reinterpret_cast<const bf16x8*>(Qg + (size_t)row * LDK + sc); }
    bf16x8 st0, st1;
    const unsigned goff = (unsigned)(sr * LDK + sc) * 2u;
#define KLOAD(k0) do { const char* t_ = (const char*)Kh + (size_t)(k0) * (LDK * 2); st0 = *reinterpret_cast<const bf16x8*>(t_ + goff); st1 = *reinterpret_cast<const bf16x8*>(t_ + 32 * LDK * 2 + goff); } while (0)
#define VLOAD(k0) do { const char* t_ = (const char*)Vh + (size_t)(k0) * (LDK * 2); st0 = *reinterpret_cast<const bf16x8*>(t_ + goff); st1 = *reinterpret_cast<const bf16x8*>(t_ + 32 * LDK * 2 + goff); } while (0)
#define KWRITE(bb) do { *(bf16x8*)(K_lds + (bb) * SHM_K + KSWZ(sr, sc * 2)) = st0; *(bf16x8*)(K_lds + (bb) * SHM_K + KSWZ(32 + sr, sc * 2)) = st1; } while (0)
    const unsigned vsrc0 = (unsigned)(vkey(2 * wid + (lane >> 5), lane) * LDK + vcol(2 * wid + (lane >> 5), lane)) * 2u, vsrc1 = (unsigned)(vkey(2 * (wid + 8) + (lane >> 5), lane) * LDK + vcol(2 * (wid + 8) + (lane >> 5), lane)) * 2u;
#define VDMA(k0, bbn) do { const char* t_ = (const char*)Vh + (size_t)(k0) * (LDK * 2); LAS unsigned char* d_ = X.lds + OFF_V + (bbn) * SHM_V + wid * 1024; \
    __builtin_amdgcn_global_load_lds((const unsigned*)(t_ + vsrc0), (LAS unsigned*)d_, 16, 0, 0); __builtin_amdgcn_global_load_lds((const unsigned*)(t_ + vsrc1), (LAS unsigned*)(d_ + 8192), 16, 0, 0); } while (0)
    const unsigned ksrc = (unsigned)(wid * 8 * LDK * 2) + (unsigned)lane * 4u;
#define KDMA(k0, bbn) do { const char* t_ = (const char*)Kh + (size_t)(k0) * (LDK * 2) + ksrc; LAS unsigned char* d_ = X.lds + OFF_K + (bbn) * SHM_K + wid * 8 * KPITCH; \
    _Pragma("unroll") for (int i_ = 0; i_ < 8; ++i_) __builtin_amdgcn_global_load_lds((const unsigned*)(t_ + i_ * (LDK * 2)), (LAS unsigned*)(d_ + i_ * KPITCH), 4, 0, 0); } while (0)
#define VWRITE(bb) do { *(bf16x8*)(V_lds + (bb) * SHM_V + vst0) = st0; *(bf16x8*)(V_lds + (bb) * SHM_V + vst1) = st1; } while (0)
    float l0 = 0.f, l1 = 0.f; f32x16 oa[4] = {}, ob[4] = {};
    const int qrow = wid * 32 + r32; constexpr int NT = S / KVBLK;
    KDMA(0, 0); VDMA(0, 0); __syncthreads();
    float m0, m1;
    { float s0 = 0.f, s1 = 0.f;
#pragma unroll
      for (int d0 = 0; d0 < 8; ++d0) { const v4u w = *reinterpret_cast<const v4u*>(Q_lds + KSWZ(qrow, (d0 * 16 + hi * 8) * 2)); f32x4 p, q; unpack8(w, p, q);
          const float ss = (p.x * p.x + p.y * p.y) + (p.z * p.z + p.w * p.w) + (q.x * q.x + q.y * q.y) + (q.z * q.z + q.w * q.w); if (d0 < 4) s0 += ss; else s1 += ss; }
      wsf[hi * 64 + r32] = s0; wsf[hi * 64 + 32 + r32] = s1; asm volatile("s_waitcnt lgkmcnt(0)" ::: "memory");
      s0 += wsf[(hi ^ 1) * 64 + r32]; s1 += wsf[(hi ^ 1) * 64 + 32 + r32]; asm volatile("s_waitcnt lgkmcnt(0)" ::: "memory");
      const float k0 = __uint_as_float(__hip_atomic_load(kmax2 + b * 8 + h * 2, __ATOMIC_RELAXED, __HIP_MEMORY_SCOPE_AGENT)), k1 = __uint_as_float(__hip_atomic_load(kmax2 + b * 8 + h * 2 + 1, __ATOMIC_RELAXED, __HIP_MEMORY_SCOPE_AGENT));
      m0 = sqrtf(s0 * k0) * 1.001f + 1e-3f; m1 = sqrtf(s1 * k1) * 1.001f + 1e-3f; }
    for (int j = 0; j < NT; ++j) {
        const int bb = j & 1; const char* Ks = K_lds + bb * SHM_K;
        const int kn = (j + 1) * KVBLK;
        if (j + 1 < NT) { KDMA(kn, bb ^ 1); VDMA(kn, bb ^ 1); }
        const int vb = vb0 + bb * SHM_V;
        bf16x8 pa[4], pb[4];
        { f32x16 p0, p1, q0, q1;
          qkt<0>(p0, p1, Ks, Q_lds, qrow, r32, hi); qkt<1>(q0, q1, Ks, Q_lds, qrow, r32, hi);
          softmax_fixed(p0, p1, m0, l0, pa[0], pa[1], pa[2], pa[3]);
          softmax_fixed(q0, q1, m1, l1, pb[0], pb[1], pb[2], pb[3]); }
        SBAR();
        pv_two<0>(oa[0], ob[0], vb, pa, pb); pv_two<1>(oa[1], ob[1], vb, pa, pb); pv_two<2>(oa[2], ob[2], vb, pa, pb); pv_two<3>(oa[3], ob[3], vb, pa, pb);
        __syncthreads();
    }
#undef KLOAD
#undef VLOAD
#undef VDMA
#undef KDMA
#undef KWRITE
#undef VWRITE
    wsf[hi * 64 + r32] = l0; wsf[hi * 64 + 32 + r32] = l1; asm volatile("s_waitcnt lgkmcnt(0)" ::: "memory");
    { const int t2 = fresh_tid(X.wave_s); epilogue(X, oa, ob, wsf, t2 & 31, (t2 & 63) >> 5, b, h, qb, lam, mul, sg); }
    __syncthreads();
}
__device__ __forceinline__ void epilogue_unused() {}
#undef KSWZ
#undef SBAR
}
}
namespace mk {
namespace hy {
struct CvSet { int have; f32x4 ld0, ld1, ld2, ld3; float sc; };
struct CvState { int next, stride, nlim, cnt, par; CvSet a, b; };
#define CV_PDECL const float* cwg, const float* cwu, const float* cwd, bf16* ctgu, bf16* ctd, const float* cgn
#define CV_PARGS cwg, cwu, cwd, ctgu, ctd, cgn
constexpr int CV_TILES = 3 * 16 * 2048;
#ifndef CV_EVERY
#define CV_EVERY 5
#endif
__device__ __forceinline__ void cv_issue(CvState& s, CvSet& q, int lane, CV_PDECL) {
    if (s.next < s.nlim) { asm volatile("" : "+v"(lane));
        const int t = s.next, me = t >> 11, rr = t & 2047, mat = me >> 4, e = me & 15;
        const float* W = (mat == 0 ? cwg : (mat == 1 ? cwu : cwd)) + (size_t)e * D * F + rr * 1024 + 4 * lane;
        q.ld0 = __builtin_nontemporal_load((const f32x4*)W); q.ld1 = __builtin_nontemporal_load((const f32x4*)(W + 256)); q.ld2 = __builtin_nontemporal_load((const f32x4*)(W + 512)); q.ld3 = __builtin_nontemporal_load((const f32x4*)(W + 768));
        { const float g_ = cgn[mat < 2 ? (rr >> 1) : 0]; q.sc = mat < 2 ? g_ : 1.f; }
        q.have = t; s.next = t + s.stride; }
    else q.have = -1;
}
__device__ __forceinline__ void cv_finish_set(CvState& s, CvSet& q, int lane, CV_PDECL) {
    const int t = q.have; v2u o0 = {0u, 0u}, o1 = {0u, 0u}, o2 = {0u, 0u}, o3 = {0u, 0u};
    if (t >= 0) { const float sc = q.sc;
        o0.x = cvtpk_(q.ld0[0] * sc, q.ld0[1] * sc); o0.y = cvtpk_(q.ld0[2] * sc, q.ld0[3] * sc); o1.x = cvtpk_(q.ld1[0] * sc, q.ld1[1] * sc); o1.y = cvtpk_(q.ld1[2] * sc, q.ld1[3] * sc);
        o2.x = cvtpk_(q.ld2[0] * sc, q.ld2[1] * sc); o2.y = cvtpk_(q.ld2[2] * sc, q.ld2[3] * sc); o3.x = cvtpk_(q.ld3[0] * sc, q.ld3[1] * sc); o3.y = cvtpk_(q.ld3[2] * sc, q.ld3[3] * sc); }
    cv_issue(s, q, lane, CV_PARGS);
    if (t >= 0) { asm volatile("" : "+v"(lane)); const int me = t >> 11, rr = t & 2047, mat = me >> 4, e = me & 15;
        bf16* dst; int qs;
        if (mat == 2) { dst = ctd + (size_t)e * D * F + rr * 1024 + 4 * lane; qs = 256; }
        else { const int k = rr >> 1, n = (rr & 1) * 1024 + 4 * lane; dst = ctgu + ((size_t)e * D + k) * (2 * F) + 2 * (n & ~127) + (n & 127) + 128 * mat; qs = 512; }
        __builtin_nontemporal_store(o0, (v2u*)dst); __builtin_nontemporal_store(o1, (v2u*)(dst + qs)); __builtin_nontemporal_store(o2, (v2u*)(dst + 2 * qs)); __builtin_nontemporal_store(o3, (v2u*)(dst + 3 * qs)); }
}
__device__ __forceinline__ void cv_finish(CvState& s, int lane, CV_PDECL) { if (s.par) cv_finish_set(s, s.b, lane, CV_PARGS); else cv_finish_set(s, s.a, lane, CV_PARGS); s.par ^= 1; }

constexpr int CPS = 16704;
constexpr int NEL = 8352;
constexpr int OFF_Z = 4 * CPS;
constexpr int ZROW = 144, ZB = 128 * ZROW;
constexpr int LDS_TOTAL = OFF_Z + 4 * ZB;

__device__ __forceinline__ void build_hrev(const Ctx& X, const bf16* hf, const bf16* hb, float bias) {
    const int tid = X.tid;
    if (tid < 4 * 8) { const int m = tid >> 3, e = tid & 7; if (e < 5 - m) *(LAS bf16*)(X.lds + m * CPS + 2 * e) = 0; }
    for (int i = tid; i < 4 * (NEL - 8192); i += NTH) { const int m = i / (NEL - 8192), e = 8192 + (i - m * (NEL - 8192)); if (e > 8195 - m) *(LAS bf16*)(X.lds + m * CPS + 2 * e) = 0; }
#pragma unroll
    for (int half = 0; half < 2; ++half) {
        const v4u w = *(const v4u*)((half ? hb : hf) + 8 * tid);
        unsigned short v[8] = {(unsigned short)(w.x & 0xffff), (unsigned short)(w.x >> 16), (unsigned short)(w.y & 0xffff), (unsigned short)(w.y >> 16), (unsigned short)(w.z & 0xffff), (unsigned short)(w.z >> 16), (unsigned short)(w.w & 0xffff), (unsigned short)(w.w >> 16)};
        if (half == 0 && tid == 0) v[0] = (unsigned short)f2bf(bf2f(v[0]) + bias);
#pragma unroll
        for (int k = 0; k < 8; ++k) { const int d = 8 * tid + k; if (half == 1 && d == 0) continue;
            const int e0 = half ? 4100 + d : 4100 - d;
#pragma unroll
            for (int m = 0; m < 4; ++m) *(LAS bf16*)(X.lds + m * CPS + 2 * (e0 - m)) = v[k]; }
    }
}
#ifdef MK_HY_XLDS
#define HY_XL(qq) do { const v2u x0_ = *(const volatile LAS v2u*)(X.lds + baseA + 32 * (qq)), x1_ = *(const volatile LAS v2u*)(X.lds + baseA8 + 32 * (qq)); asm volatile("" :: "v"(x0_), "v"(x1_)); } while (0)
#else
#define HY_XL(qq) do {} while (0)
#endif
#define HY_LDA(dst, qq) do { HY_XL(qq); const v2u lo_ = *(const volatile LAS v2u*)(X.lds + baseA + 32 * (qq)), hi_ = *(const volatile LAS v2u*)(X.lds + baseA8 + 32 * (qq)); v4u w_ = {lo_.x, lo_.y, hi_.x, hi_.y}; dst = *reinterpret_cast<bf16x8*>(&w_); } while (0)
#define HY_LOAD_E(FA, FB, d1_, q_) do { const LAS unsigned char* zr_ = zb - (d1_) * ZROW; HY_LDA(FA[0], (q_)); HY_LDA(FA[1], (q_) + 1); \
    FB[0] = *(const LAS bf16x8*)(zr_); FB[1] = *(const LAS bf16x8*)(zr_ + 32); FB[2] = *(const LAS bf16x8*)(zr_ + 64); FB[3] = *(const LAS bf16x8*)(zr_ + 96); } while (0)
#define HY_LOAD_L(FA, q_) do { HY_LDA(FA[2], (q_) + 2); HY_LDA(FA[3], (q_) + 3); } while (0)
#ifdef MK_HY_XMFMA
#define HY_XM(A_, B_) do { dacc0 = __builtin_amdgcn_mfma_f32_32x32x16_bf16(A_, B_, dacc0, 0, 0, 0); } while (0)
#else
#define HY_XM(A_, B_) do {} while (0)
#endif
#define HY_MMA1(FA, FB, PA) do { __builtin_amdgcn_s_setprio(1); HY_XM(FA[0], FB[0]); HY_XM(PA[2], FB[0]); HY_XM(FA[1], FB[1]); HY_XM(PA[3], FB[1]); \
    acc0 = __builtin_amdgcn_mfma_f32_32x32x16_bf16(FA[0], FB[0], acc0, 0, 0, 0); acc1 = __builtin_amdgcn_mfma_f32_32x32x16_bf16(PA[2], FB[0], acc1, 0, 0, 0); \
    acc0 = __builtin_amdgcn_mfma_f32_32x32x16_bf16(FA[1], FB[1], acc0, 0, 0, 0); acc1 = __builtin_amdgcn_mfma_f32_32x32x16_bf16(PA[3], FB[1], acc1, 0, 0, 0); __builtin_amdgcn_s_setprio(0); } while (0)
#define HY_MMA2(FA, FB) do { __builtin_amdgcn_s_setprio(1); HY_XM(FA[2], FB[2]); HY_XM(FA[0], FB[2]); HY_XM(FA[3], FB[3]); HY_XM(FA[1], FB[3]); \
    acc0 = __builtin_amdgcn_mfma_f32_32x32x16_bf16(FA[2], FB[2], acc0, 0, 0, 0); acc1 = __builtin_amdgcn_mfma_f32_32x32x16_bf16(FA[0], FB[2], acc1, 0, 0, 0); \
    acc0 = __builtin_amdgcn_mfma_f32_32x32x16_bf16(FA[3], FB[3], acc0, 0, 0, 0); acc1 = __builtin_amdgcn_mfma_f32_32x32x16_bf16(FA[1], FB[3], acc1, 0, 0, 0); __builtin_amdgcn_s_setprio(0); } while (0)
template <int PAIR> __device__ __forceinline__ void channel(const Ctx& X, int l, int c, const float* __restrict__ hyb, CvState& cs, CV_PDECL) {
    const bf16* UCT = (const bf16*)(X.ws + WS_UCT); const bf16* FILT = (const bf16*)(X.ws + WS_FILT) + (size_t)l * 4 * C * S; bf16* YH = (bf16*)(X.ws + WS_YH);
    const int tid = X.tid, lane = X.lane, wid = X.wave, r = lane & 31, h = lane >> 5, b = wid >> 1, jt = wid & 1;
    LAS unsigned char* zl = X.lds + OFF_Z;
    v2u* const stash0 = (v2u*)(X.ws + WS_U) + (size_t)X.bid * 8 * NTH;
    __syncthreads();
    v4u zero4 = {0u, 0u, 0u, 0u}; asm volatile("" : "+v"(zero4));
    for (int i = tid; i < 4 * 64 * 9; i += NTH) { const int bb = i / 576, rr = (i % 576) / 9, ch = i % 9; const int row = rr < 32 ? rr : 64 + rr;
        *(LAS v4u*)(zl + bb * ZB + row * ZROW + ch * 16) = zero4; }
    for (int i = tid; i < 4 * 64 * 8; i += NTH) { const int bb = i >> 9, s1 = (i >> 3) & 63, ch = i & 7;
        *(LAS v4u*)(zl + bb * ZB + (32 + s1) * ZROW + ch * 16) = *(const v4u*)(UCT + (size_t)c * T + bb * S + s1 * 64 + ch * 8); }
    const int m4 = (4 - (r & 3)) & 3;
    const int baseA = m4 * CPS + 2 * (8 * h - r + 4100 - m4);
    int baseA8 = baseA + 8; asm volatile("" : "+v"(baseA8));
    for (int o = 0; o < 2; ++o) {
        build_hrev(X, FILT + ((size_t)(2 * o) * C + c) * S, FILT + ((size_t)(2 * o + 1) * C + c) * S, hyb[(l * 2 + o) * C + c]);
#ifdef MK_HY_DUPBUILD
        asm volatile("" ::: "memory"); build_hrev(X, FILT + ((size_t)(2 * o) * C + c) * S, FILT + ((size_t)(2 * o + 1) * C + c) * S, hyb[(l * 2 + o) * C + c]);
#endif
        const bf16* gate = UCT + (size_t)((o + 1) * C + c) * T + (size_t)b * S;
        const int t1 = 32 * jt + r;
        __syncthreads();
#ifndef MK_HY_SWEEPS
#define MK_HY_SWEEPS 1
#endif
        f32x16 acc0 = {}, acc1 = {};
#ifdef MK_HY_XMFMA
        f32x16 dacc0 = {};
#endif
        for (int rep = 0; rep < MK_HY_SWEEPS; ++rep) {
        const int d1max = 32 * jt + 31; int q = -4 * d1max;
        const LAS unsigned char* zb = zl + b * ZB + (32 + 32 * jt + r) * ZROW + 16 * h;
        bf16x8 fa0[4], fb0[4], fa1[4], fb1[4];
        HY_LDA(fa1[2], q - 2); HY_LDA(fa1[3], q - 1);
        HY_LOAD_E(fa0, fb0, d1max, q); HY_LOAD_L(fa0, q);
        int d1 = d1max;
        for (int it = 0; it < 47; ++it) {
            HY_LOAD_E(fa1, fb1, d1 - 1, q + 4);
            HY_MMA1(fa0, fb0, fa1);
            HY_LOAD_L(fa1, q + 4);
            HY_MMA2(fa0, fb0);
            HY_LOAD_E(fa0, fb0, d1 - 2, q + 8);
            HY_MMA1(fa1, fb1, fa0);
            HY_LOAD_L(fa0, q + 8);
            HY_MMA2(fa1, fb1);
            d1 -= 2; q += 8;
            if (++cs.cnt == CV_EVERY) { cs.cnt = 0; cv_finish(cs, lane, CV_PARGS); }
        }
        HY_MMA1(fa0, fb0, fa1); HY_MMA2(fa0, fb0);
        }
        if (MK_HY_SWEEPS == 2) { acc0 *= 0.5f; acc1 *= 0.5f; }
#ifdef MK_HY_XMFMA
        asm volatile("" :: "v"(dacc0));
#endif
        asm volatile("" ::: "memory");
        v2u gw[2][4];
#pragma unroll
        for (int mt = 0; mt < 2; ++mt)
#pragma unroll
            for (int g = 0; g < 4; ++g) gw[mt][g] = *(const v2u*)(gate + t1 * 64 + 32 * mt + 8 * g + 4 * h);
        v2u kpv[2][4]; v2u* stash;
        { int st = tid * 8; asm volatile("" : "+v"(st)); stash = stash0 + st; }
        if (PAIR == 1 && o == 1) {
#pragma unroll
            for (int i = 0; i < 4; ++i) { const v4u w = ((const v4u*)stash)[i]; kpv[i >> 1][2 * (i & 1)] = v2u{w.x, w.y}; kpv[i >> 1][2 * (i & 1) + 1] = v2u{w.z, w.w}; } }
        __syncthreads();
#pragma unroll
        for (int mt = 0; mt < 2; ++mt)
#pragma unroll
            for (int g = 0; g < 4; ++g) { const int t0 = 32 * mt + 8 * g + 4 * h; const v2u gwv = gw[mt][g];
                const f32x16& a = mt ? acc1 : acc0;
                const float y0 = a[4 * g] * bflo(gwv.x), y1 = a[4 * g + 1] * bfhi(gwv.x), y2 = a[4 * g + 2] * bflo(gwv.y), y3 = a[4 * g + 3] * bfhi(gwv.y);
                if (o == 0) { v2u w; w.x = pk2(y0, y1); w.y = pk2(y2, y3); *(LAS v2u*)(zl + b * ZB + (32 + t1) * ZROW + t0 * 2) = w; }
                else if (PAIR == 0) { v2u w; w.x = pk2(y0, y1); w.y = pk2(y2, y3); stash[mt * 4 + g] = w; }
                else { unsigned* yo = (unsigned*)(YH + ((size_t)b * S + t1 * 64 + t0) * C + (c - 1)); const v2u kp = kpv[mt][g];
                    yo[0] = (kp.x & 0xffffu) | (f2bf(y0) << 16); yo[C / 2] = (kp.x >> 16) | (f2bf(y1) << 16); yo[C] = (kp.y & 0xffffu) | (f2bf(y2) << 16); yo[3 * C / 2] = (kp.y >> 16) | (f2bf(y3) << 16); } }
    }
    __syncthreads();
}
#undef HY_LDA
#undef HY_LOAD_E
#undef HY_LOAD_L
#undef HY_MMA1
#undef HY_MMA2
}
}
namespace mk {
#define GAS __attribute__((address_space(1)))
typedef GAS unsigned gu32;
typedef GAS unsigned long long gu64;
#define RLX_AGENT __ATOMIC_RELAXED, __HIP_MEMORY_SCOPE_AGENT
#define LDS_WAIT() asm volatile("s_waitcnt lgkmcnt(0)" ::: "memory")
#define VM_WAIT() asm volatile("s_waitcnt vmcnt(0)" ::: "memory")
__device__ __forceinline__ unsigned long long rt() { return __builtin_amdgcn_s_memrealtime(); }
#define XB_TMO      128
#define XB_XCNT(j)  (256  + 64 * (j))
#define XB_XSUB(j)  (1280 + 64 * (j))
#define XB_XGEN(j)  (2304 + 64 * (j))
#define XB_TOP      3328
#define XB_TOPGEN   3392
#define XCD_BAR_WORDS 3456
#define XB_SPIN_CAP (1u << 18)

__device__ __forceinline__ unsigned xb_ld(unsigned* p)              { return __hip_atomic_load(p, __ATOMIC_RELAXED, __HIP_MEMORY_SCOPE_AGENT); }
__device__ __forceinline__ unsigned xb_add(unsigned* p, unsigned v) { return __hip_atomic_fetch_add(p, v, __ATOMIC_RELAXED, __HIP_MEMORY_SCOPE_AGENT); }
__device__ __forceinline__ unsigned xb_xcc_id() { return (unsigned)__builtin_amdgcn_s_getreg((3 << 11) | 20) & 0xFu; }
#define XB_SPIN(cond, bar) do { unsigned _sp = 0; while (cond) { __builtin_amdgcn_s_sleep(1); \
    if ((++_sp & 255u) == 0u) { if (xb_ld(&(bar)[XB_TMO])) break; if (_sp > XB_SPIN_CAP) { atomicAdd(&(bar)[XB_TMO], 1u); break; } } } } while (0)

struct XcdBarrier {
    unsigned* bar; unsigned x;
    volatile LAS unsigned* st;
};

__device__ __forceinline__ XcdBarrier xcd_barrier_post(unsigned* bar, volatile LAS unsigned* st) {
    XcdBarrier b; b.bar = bar; b.x = xb_xcc_id(); b.st = st;
    if (threadIdx.x == 0) (void)xb_add(&bar[XB_XCNT(b.x)], 1u);
    return b;
}
__device__ __forceinline__ void xcd_barrier_complete(unsigned* bar, unsigned x, unsigned& nloc, unsigned& nx) {
    const unsigned G = gridDim.x * gridDim.y * gridDim.z;
    unsigned sum, cnt, mine, sp = 0u;
    for (;;) {
        sum = 0u; cnt = 0u; mine = 0u;
#pragma unroll
        for (unsigned j = 0; j < 16; ++j) { const unsigned c = xb_ld(&bar[XB_XCNT(j)]); sum += c; cnt += (c > 0u) ? 1u : 0u; mine = (j == x) ? c : mine; }
        if (sum == G) break;
        __builtin_amdgcn_s_sleep(1);
        if ((++sp & 255u) == 0u) { if (xb_ld(&bar[XB_TMO])) break; if (sp > XB_SPIN_CAP) { atomicAdd(&bar[XB_TMO], 1u); break; } }
    }
    nloc = mine > 0u ? mine : 1u; nx = cnt > 0u ? cnt : 1u;
}

__device__ __forceinline__ void xcd_barrier(const XcdBarrier& b, int wave_s) {
    asm volatile("s_waitcnt vmcnt(0)" ::: "memory");
    __syncthreads();
    if (fresh_tid(wave_s) == 0) {
        unsigned* bar = b.bar;
        __builtin_amdgcn_s_waitcnt(0);
        unsigned nloc = b.st[0], nx = b.st[1];
        if (nloc == 0u) { xcd_barrier_complete(bar, b.x, nloc, nx); b.st[0] = nloc; b.st[1] = nx; }
        const unsigned old = xb_add(&bar[XB_XSUB(b.x)], 1u);
        const unsigned gen = old / nloc;
        if (old + 1u == (gen + 1u) * nloc) {
            __builtin_amdgcn_fence(__ATOMIC_RELEASE, "agent");
            asm volatile("s_waitcnt vmcnt(0)" ::: "memory");
            const unsigned og = xb_add(&bar[XB_TOP], 1u);
            const unsigned tg = og / nx;
            if (og + 1u == (tg + 1u) * nx) xb_add(&bar[XB_TOPGEN], 1u);
            else XB_SPIN(xb_ld(&bar[XB_TOPGEN]) == tg, bar);
            __builtin_amdgcn_fence(__ATOMIC_ACQUIRE, "agent");
            xb_add(&bar[XB_XGEN(b.x)], 1u);
            asm volatile("s_waitcnt vmcnt(0)" ::: "memory");
        } else {
            XB_SPIN(xb_ld(&bar[XB_XGEN(b.x)]) == gen, bar);
            __builtin_amdgcn_fence(__ATOMIC_ACQUIRE, "agent");
            asm volatile("s_waitcnt vmcnt(0)" ::: "memory");
        }
    }
    __syncthreads();
}

}
namespace mk {
namespace cg = cooperative_groups;
constexpr int PH_PER_LAYER = 9, N_PHASES = 1 + 2 * PH_PER_LAYER;

__device__ __forceinline__ float lam_of(const Args& a, int l, float lam_init) {
    const float *q1 = a.in[14] + l * 64, *k1 = a.in[15] + l * 64, *q2 = a.in[16] + l * 64, *k2 = a.in[17] + l * 64;
    float s1 = 0.f, s2 = 0.f; for (int i = 0; i < 64; ++i) { s1 += q1[i] * k1[i]; s2 += q2[i] * k2[i]; }
    return expf(s1) - expf(s2) + lam_init;
}

typedef const __attribute__((address_space(4))) Args* KArgPtr;
__global__ void __launch_bounds__(NTH, 2) fwd(Args a_byval) {
    extern __shared__ __attribute__((aligned(16))) unsigned char lds_raw[];
    cg::grid_group grid = cg::this_grid();
    const int ph_lo = a_byval.ph_lo, ph_hi = a_byval.ph_hi;
    const int wave_s = __builtin_amdgcn_readfirstlane((int)threadIdx.x >> 6);
    volatile LAS unsigned* bar_st = (volatile LAS unsigned*)((LAS unsigned char*)lds_raw + LDS_BYTES - 64);
    if (threadIdx.x == 0) { bar_st[0] = 0u; bar_st[1] = 0u; }
    __syncthreads();
    const XcdBarrier bar = xcd_barrier_post((unsigned*)a_byval.ws, bar_st);
    int rep_flag = 0;
    for (int ph = ph_lo; ph < ph_hi; ++ph) {
        KArgPtr ap = (KArgPtr)__builtin_amdgcn_kernarg_segment_ptr(); asm volatile("" : "+s"(ap));
        const Args a = *(const Args*)ap;
        bf16* Xr = (bf16*)(a.ws + WS_X);
        Ctx X; X.wave_s = wave_s; X.wave = wave_s; X.tid = 0; X.lane = 0;
#define FRESH() do { X.tid = fresh_tid(wave_s); X.lane = X.tid & 63; } while (0)
        { int g_ = gridDim.x, b_ = blockIdx.x; asm volatile("" : "+s"(g_), "+s"(b_)); X.G = g_; X.bid = b_; }
        { const int bx = X.bid; X.vcu = (X.G % 8 == 0) ? (bx % 8) * (X.G / 8) + bx / 8 : bx; }
        X.gw = X.vcu * NWAVES + X.wave; X.ngw = X.G * NWAVES; X.lds = (LAS unsigned char*)lds_raw; X.ws = a.ws;
#ifndef MK_EN
#define MK_EN 0xFFFF
#endif
#ifndef MK_ATT
#define MK_ATT 3
#endif
#ifndef MK_REP_SP
#define MK_REP_SP 99
#endif
        if (ph == 0) { if (MK_EN & 512) { FRESH(); p0_prologue(X, a); } }
        else {
            const int l = (ph - 1) / PH_PER_LAYER, sp = (ph - 1) % PH_PER_LAYER;
            const float lam_init = 0.8f - 0.6f * expf(-0.3f * (float)l);
            if (0) {}
#if MK_EN & 1
            else if (sp == 0) {
                FRESH();
                pg8::Gemm g{(const bf16*)(a.ws + (l == 0 ? WS_XN : WS_X)), (const bf16*)(a.ws + WS_WIN) + (size_t)l * INW * D, T, INW, D};
                pg8::StaticOrder So; So.init(T, INW, X.G, X.bid);
                EpiWin Ep{a.ws, (const float*)(a.ws + WS_BINP) + l * INW, (const float*)(a.ws + WS_ROPE), (const float*)(a.ws + WS_RMIX)};
                pg8::gemm_phase<EpiWin, pg8::StaticOrder, true, true>(X.lds, g, So, Ep, X.tid);
            }
#endif
#if MK_EN & 2
            else if (sp == 1) {
                FRESH();
                p1t_shortconv(X, a.in[4] + l * 3 * 1536, a.in[5] + l * 1536);
                p1t_kmax(X, (unsigned*)(a.ws + 14336) + l * 32);
            }
#endif
#if MK_EN & 4
            else if (sp == 2) {
                FRESH();
                const float lam = lam_of(a, l, lam_init);
                const int c = X.bid;
#ifndef MK_REP_ATT
#define MK_REP_ATT 1
#endif
#ifndef MK_CONV_REP
#define MK_CONV_REP 1
#endif
#ifndef MK_REP_HY
#define MK_REP_HY 1
#endif
#ifndef CV_ME_SWEEP
#define CV_ME_SWEEP 32
#endif
                const int cg_ = X.vcu & 3;
                if (cg_ == 0) { __syncthreads(); p0_experts_rest(relaunder(X), a, l, CV_ME_SWEEP); __syncthreads(); }
                for (int rep = 0; rep < MK_REP_ATT; ++rep) for (int u = c; u < 256; u += X.G) { const int bh = 2 * (u & 7) + ((u >> 3) >> 4), qb = (u >> 3) & 15; at::attn_unit(X, bh >> 2, bh & 3, qb, lam, 1.0f - lam_init, a.in[18] + l * 128, (unsigned*)(a.ws + 14336) + l * 32); }
                if (cg_ == 1) { __syncthreads(); p0_experts_rest(relaunder(X), a, l, CV_ME_SWEEP); __syncthreads(); }
                hy::CvState cs; const float* cwg = a.in[25] + (size_t)l * E * D * F; const float* cwu = a.in[26] + (size_t)l * E * D * F; const float* cwd = a.in[27] + (size_t)l * E * D * F; const float* cgn = a.in[22] + l * D;
                bf16* ctgu = (bf16*)(a.ws + WS_WGU) + (size_t)l * E * 2 * F * D; bf16* ctd = (bf16*)(a.ws + WS_WD) + (size_t)l * E * F * D;
                cs.next = __builtin_amdgcn_readfirstlane(X.bid * NWAVES + wave_s); cs.stride = __builtin_amdgcn_readfirstlane(X.G * NWAVES); cs.nlim = CV_ME_SWEEP * 2048; cs.cnt = 0; cs.par = 0;
                cs.a.have = cs.b.have = -1; cs.a.ld0 = cs.a.ld1 = cs.a.ld2 = cs.a.ld3 = cs.b.ld0 = cs.b.ld1 = cs.b.ld2 = cs.b.ld3 = f32x4{0.f, 0.f, 0.f, 0.f}; cs.a.sc = cs.b.sc = 1.f;
                hy::cv_issue(cs, cs.a, fresh_tid(wave_s) & 63, CV_PARGS); hy::cv_issue(cs, cs.b, fresh_tid(wave_s) & 63, CV_PARGS);
                for (int rep = 0; rep < MK_REP_HY; ++rep) for (int u = c; u < 256; u += X.G) { const int ch = 64 * (u & 7) + 2 * (u >> 3); hy::channel<0>(relaunder(X), l, ch, a.in[13], cs, CV_PARGS);
                    if (cg_ == 2) { __syncthreads(); p0_experts_rest(relaunder(X), a, l, CV_ME_SWEEP); __syncthreads(); }
                    hy::channel<1>(relaunder(X), l, ch + 1, a.in[13], cs, CV_PARGS); }
                while (cs.a.have >= 0 || cs.b.have >= 0) hy::cv_finish(cs, fresh_tid(wave_s) & 63, CV_PARGS);
                if (cg_ == 3) { __syncthreads(); p0_experts_rest(relaunder(X), a, l, CV_ME_SWEEP); __syncthreads(); }
            }
#endif
#if MK_EN & 8
            else if (sp == 3) {
                FRESH();
                OrderMerge So; So.so.init(T, D, X.G, X.bid);
                pg8::Gemm g{(const bf16*)(a.ws + WS_YH), (const bf16*)(a.ws + WS_WUH) + (size_t)l * 2 * D * C, 2 * T, 2 * D, C};
                EpiMerge2 Ep{(const bf16*)(a.ws + WS_GH), (const bf16*)(a.ws + WS_GA), (bf16*)(a.ws + WS_T1), (bf16*)(a.ws + WS_MG)};
                pg8::gemm_phase<EpiMerge2, OrderMerge, true, true>(X.lds, g, So, Ep, X.tid);
            }
#endif
#if MK_EN & 16
            else if (sp == 4) {
                FRESH();
                pg8::Gemm g{(const bf16*)(a.ws + WS_MG), (const bf16*)(a.ws + WS_WOUT) + (size_t)l * D * D, T, D, D};
                pg8::StaticOrder So; So.init(T, D, X.G, X.bid);
                EpiOutR Ep{l == 0 ? (const bf16*)(a.ws + WS_XN) : (const bf16*)Xr, (bf16*)(a.ws + WS_XN), (float*)(a.ws + WS_PART), (const bf16*)(a.ws + WS_WRP) + (size_t)l * 2 * E * D, (unsigned*)(a.ws + 15360) + l * 64, (float*)(a.ws + WS_AFFT), (float*)(a.ws + WS_RTOK), a.in[24] + l * E};
                pg8::gemm_phase<EpiOutR, pg8::StaticOrder, true, true>(X.lds, g, So, Ep, X.tid);
            }
#endif
#if MK_EN & 32
            else if (sp == 5) { FRESH(); p6_topk(X);
            }
#endif
#if MK_EN & 64
            else if (sp == 6) {
                FRESH();
                pg8::Gemm g{(const bf16*)(a.ws + WS_XN), (const bf16*)(a.ws + WS_WGU) + (size_t)l * E * 2 * F * D, E * 2048, 2 * F, D, 2 * F, 4, (size_t)2 * F * D * 2, (const int*)(a.ws + WS_ROWS)};
                OrderMoE1 So{X.G, X.bid}; EpiSwiGLU Ep{(bf16*)(a.ws + WS_HB), (const float*)(a.ws + WS_RSL)};
                pg8::gemm_phase<EpiSwiGLU, OrderMoE1, true, true, true, true>(X.lds, g, So, Ep, X.tid);
            }
#endif
#if MK_EN & 128
            else if (sp == 7) {
                FRESH();
                pg8::Gemm g{(const bf16*)(a.ws + WS_HB), (const bf16*)(a.ws + WS_WD) + (size_t)l * E * D * F, E * 2048, D, F, D, 2, (size_t)D * F * 2};
                OrderMoE2 So{X.G, X.bid}; EpiDown Ep{(bf16*)(a.ws + WS_YE), (const float*)(a.ws + WS_GATE)};
                pg8::gemm_phase<EpiDown, OrderMoE2, true, true, true>(X.lds, g, So, Ep, X.tid);
            }
#endif
#if MK_EN & 256
            else if (sp == 8) {
                FRESH();
                p9_combine(X, Xr, l == 0 ? a.in[1] + D : a.in[28], l == 1, a.out);
            }
#endif
        }
#ifndef MK_EXTRA_SYNC
#define MK_EXTRA_SYNC 0
#endif
        if (ph + 1 < ph_hi) { if (ph_hi > 4096) grid.sync(); else xcd_barrier(bar, wave_s); }
        for (int es = 0; es < MK_EXTRA_SYNC; ++es) xcd_barrier(bar, wave_s);
        if (MK_REP_SP != 99) { const int sp_ = ph == 0 ? -1 : (ph - 1) % PH_PER_LAYER; if (sp_ == MK_REP_SP && rep_flag == 0) { rep_flag = 1; --ph; } else rep_flag = 0; }
    }
}

static int g_grid = 0;
static bool mega_setup() {
    if (g_grid) return g_grid > 0;
    int dev = 0, cus = 0, per_cu = 0;
    if (hipGetDevice(&dev) != hipSuccess || hipDeviceGetAttribute(&cus, hipDeviceAttributeMultiprocessorCount, dev) != hipSuccess) { g_grid = -1; return false; }
    if (hipFuncSetAttribute((const void*)fwd, hipFuncAttributeMaxDynamicSharedMemorySize, LDS_BYTES) != hipSuccess) { fprintf(stderr, "hipFuncSetAttribute failed\n"); g_grid = -1; return false; }
    if (hipOccupancyMaxActiveBlocksPerMultiprocessor(&per_cu, (const void*)fwd, NTH, LDS_BYTES) != hipSuccess || per_cu < 1) { fprintf(stderr, "occupancy query failed (%d)\n", per_cu); g_grid = -1; return false; }
    g_grid = cus * 1;
    return true;
}
static void mega_launch(hipStream_t st, void* const* d_in, float* d_out, unsigned char* ws, int ph_lo, int ph_hi, int p0_mask) {
    if (!mega_setup()) return;
    Args a{};
    for (int i = 0; i < 29; ++i) a.in[i] = (const float*)d_in[i];
    a.out = d_out; a.ws = ws; a.ph_lo = ph_lo; a.ph_hi = ph_hi; a.p0_mask = p0_mask; a.pad = 0;
    if (hipMemsetAsync(ws, 0, 16384, st) != hipSuccess) { fprintf(stderr, "memset of the barrier words failed\n"); return; }
    void* args[] = {&a};
    const hipError_t e = hipLaunchCooperativeKernel((const void*)fwd, dim3(g_grid), dim3(NTH), args, LDS_BYTES, st);
    if (e != hipSuccess) fprintf(stderr, "cooperative launch failed: %s (grid %d)\n", hipGetErrorString(e), g_grid);
}
}
extern "C" void kernel_launch(void* const* d_in, const int* in_sizes, int n_in, void* d_out, int out_size, void* d_ws, size_t ws_size, hipStream_t stream) {
    if (n_in != 29 || out_size != mk::T * mk::D || ws_size < mk::WS_END) { fprintf(stderr, "kernel_launch: unexpected sizes n_in %d out %d ws %zu\n", n_in, out_size, ws_size); return; }
    mk::mega_launch(stream, d_in, (float*)d_out, (unsigned char*)d_ws, 0, mk::N_PHASES, 13);
}
```

```cpp
#include <hip/hip_runtime.h>
#include <hip/hip_cooperative_groups.h>
#include <cstdio>
#include <cstdint>
#include <cmath>
namespace tk {
constexpr int S = 4096, E = 16, CAP = 512, NT = 512;
__device__ __forceinline__ void topk_problem(const unsigned (&key)[8], const float (&rr)[8], int tokbase, int e, int slotbase, int* __restrict__ rows, float* __restrict__ gate, float* __restrict__ rsl, int* __restrict__ inv, int* sm, int tid) {
    const int lane = tid & 63, wid = tid >> 6;
    int* hist = sm; int* ctl = sm + 256;
    unsigned prefix = 0u, mask = 0u; int kth = CAP;
    for (int pass = 3; pass >= 0; --pass) {
        __syncthreads();
        if (tid < 256) hist[tid] = 0;
        __syncthreads();
#pragma unroll
        for (int i = 0; i < 8; ++i) if ((key[i] & mask) == prefix) atomicAdd(&hist[(key[i] >> (8 * pass)) & 255u], 1);
        __syncthreads();
        if (tid < 64) {
            const int b0 = hist[4 * lane], b1 = hist[4 * lane + 1], b2 = hist[4 * lane + 2], b3 = hist[4 * lane + 3];
            const int tot = b0 + b1 + b2 + b3;
            int suf = tot;
#pragma unroll
            for (int o = 1; o < 64; o <<= 1) { const int v = __builtin_amdgcn_ds_bpermute(((lane + o) & 63) << 2, suf); if (lane + o < 64) suf += v; }
            const int above = suf - tot;
            if (above < kth && kth <= above + tot) {
                int cum = above, bin, k2;
                if (cum + b3 >= kth) { bin = 4 * lane + 3; k2 = kth - cum; }
                else { cum += b3; if (cum + b2 >= kth) { bin = 4 * lane + 2; k2 = kth - cum; }
                else { cum += b2; if (cum + b1 >= kth) { bin = 4 * lane + 1; k2 = kth - cum; }
                else { cum += b1; bin = 4 * lane; k2 = kth - cum; } } }
                ctl[0] = bin; ctl[1] = k2;
            }
        }
        __syncthreads();
        prefix |= ((unsigned)ctl[0]) << (8 * pass); mask |= 0xFFu << (8 * pass); kth = ctl[1];
    }
    const unsigned thr = prefix; const int need_eq = kth; const int n_gt = CAP - need_eq;
    int cg = 0, ce = 0;
#pragma unroll
    for (int i = 0; i < 8; ++i) { cg += key[i] > thr; ce += key[i] == thr; }
    int sg = cg, se = ce;
#pragma unroll
    for (int o = 1; o < 64; o <<= 1) { const int a = __builtin_amdgcn_ds_bpermute(((lane - o) & 63) << 2, sg), b = __builtin_amdgcn_ds_bpermute(((lane - o) & 63) << 2, se); if (lane >= o) { sg += a; se += b; } }
    __syncthreads();
    if (lane == 63) { ctl[8 + wid] = sg; ctl[16 + wid] = se; }
    __syncthreads();
    int og = sg - cg, oe = se - ce;
    for (int w = 0; w < wid; ++w) { og += ctl[8 + w]; oe += ctl[16 + w]; }
#pragma unroll
    for (int i = 0; i < 8; ++i) {
        const int idx = tid * 8 + i; int slot = -1;
        if (key[i] > thr) slot = og++;
        else if (key[i] == thr) { if (oe < need_eq) slot = n_gt + oe; ++oe; }
        if (slot >= 0) { rows[slot] = tokbase + idx; gate[slot] = __uint_as_float(key[i]); rsl[slot] = rr[i]; }
        inv[(size_t)(tokbase + idx) * E + e] = slot >= 0 ? slotbase + slot : -1;
    }
    __syncthreads();
}
}
namespace pg8 {
#define PG8_LAS __attribute__((address_space(3)))
typedef unsigned short bf16_t;
typedef short bf16x8 __attribute__((ext_vector_type(8)));
typedef float f32x4 __attribute__((ext_vector_type(4)));
typedef unsigned u32x4 __attribute__((ext_vector_type(4)));
typedef short s16x4 __attribute__((ext_vector_type(4)));
constexpr int BM = 256, BK = 64, HALF = 128, HTB = HALF * BK * 2  , STAGE_BYTES = 8 * HTB, NXCD = 8, WGM = 8;

__host__ __device__ __forceinline__ int lds_byte(int r, int c) { const int st = (r >> 4) * 2 + (c >> 5), rr = r & 15, cc = c & 31, ob = rr * 64 + cc * 2; return st * 1024 + (ob ^ (((ob >> 9) & 1) << 5)); }
__host__ __device__ __forceinline__ void stage_rc(int b, int& R, int& C) { const int st = b / 1024, sb = b % 1024, swz = sb ^ (((sb >> 9) & 1) << 5); R = (st >> 1) * 16 + swz / 64; C = (st & 1) * 32 + (swz % 64) / 2; }
__host__ __device__ __forceinline__ int perm32(int rho) { const int n = rho >> 4, i = rho & 15; return 8 * (i >> 2) + 4 * n + (i & 3); }

struct Unit { int pm, pn, pb, pa; };
struct Gemm { const bf16_t* A; const bf16_t* Bt; int M, N, K; int bN = 0, bsh = 0; size_t bes = 0; const int* arows = nullptr; };

struct StaticOrder {
    int nM, nN, nwg, G, c;
    __host__ __device__ void init(int M, int N, int G_, int c_) { nM = M / BM; nN = N / BM; nwg = nM * nN; G = G_; c = c_; }
    __host__ __device__ bool next(int i, Unit& u) const {
        const long L = (long)i * G + c; if (L >= nwg) return false;
        int wgid = (int)L; { const int q = nwg / NXCD, r = nwg % NXCD, xcd = wgid % NXCD, off = wgid / NXCD; wgid = (xcd < r ? xcd * (q + 1) : r * (q + 1) + (xcd - r) * q) + off; }
        const int nig = WGM * nN, gid = wgid / nig, fm = gid * WGM, gsz = (nM - fm) < WGM ? (nM - fm) : WGM;
        u.pm = fm + ((wgid % nig) % gsz); u.pn = (wgid % nig) / gsz; u.pb = u.pn; u.pa = u.pm; return true;
    }
    __device__ __forceinline__ void a_ready(const Unit&) const {}
    __device__ __forceinline__ void done(const Unit&) const {}
};

template <class Epi, class Sched, bool ALIGN_EPI = false, bool SP2 = false, bool BT = false, bool GA = false>
__device__ __forceinline__ void gemm_phase(PG8_LAS unsigned char* lds, const Gemm g, const Sched& S, const Epi& E, int tid) {
    asm volatile("" : "+v"(tid));
    const int wid = __builtin_amdgcn_readfirstlane(tid >> 6), lane = tid & 63, wr = wid >> 2, wc = wid & 3, fr = lane & 15, fq = lane >> 4;
    const int K = g.K, nt = K / BK;
    unsigned voffA[2], voffB[2];
#pragma unroll
    for (int i = 0; i < 2; ++i) { int R, C; stage_rc(tid * 16 + i * 8192, R, C); const int Rb = Epi::PERM ? ((R & ~31) + perm32(R & 31)) : R;
        voffA[i] = (unsigned)(R * K + C) * 2u; voffB[i] = (unsigned)(Rb * K + C) * 2u; if constexpr (GA) voffA[i] = (unsigned)C * 2u;
        if constexpr (BT) { const int p = i * 512 + tid, row = ((p >> 7) << 3) | ((p >> 2) & 7), ch = (((p >> 5) & 3) << 2) | ((p & 3) ^ ((row >> 2) & 3));
            voffB[i] = (unsigned)(row * g.bN + 8 * ch) * 2u; } }
    const size_t kstep = (size_t)(BK * 2);
    const size_t hstep = (size_t)HALF * K * 2;
    const size_t tstep = 2 * hstep;
    const size_t kstepB = BT ? (size_t)BK * g.bN * 2 : kstep, hstepB = BT ? (size_t)HALF * 2 : hstep;
    const size_t hstepA = GA ? 0 : hstep;
    unsigned curA[2][2] = {{0u, 0u}, {0u, 0u}};
    PG8_LAS int* rowtab0 = (PG8_LAS int*)(lds + STAGE_BYTES);
#define PG8_ROWTAB (rowtab0 + ((ui + 1) & 1) * 512)
#define PG8_NXTOFF(o_, h) do { int t_ = tid; asm volatile("" : "+v"(t_)); _Pragma("unroll") for (int i_ = 0; i_ < 2; ++i_) { int R_, C_; stage_rc(t_ * 16 + i_ * 8192, R_, C_); \
        o_[i_] = (unsigned)PG8_ROWTAB[(h) * 128 + R_] * (unsigned)(K * 2) + (unsigned)C_ * 2u; } } while (0)
#define PG8_STAGE_A(bufoff, kbase, h, nx) do { if constexpr (GA) { if (nx) { unsigned o_[2]; PG8_NXTOFF(o_, h); PG8_STAGE(bufoff, kbase, o_); } else PG8_STAGE(bufoff, kbase, curA[h]); } \
        else PG8_STAGE(bufoff, (kbase) + ((h) ? hstep : 0), voffA); } while (0)
#define PG8_BBASE(pb) ((const char*)g.Bt + (BT ? (size_t)((pb) >> g.bsh) * g.bes + (size_t)((pb) & ((1 << g.bsh) - 1)) * 512 : (size_t)(pb) * tstep))
    const unsigned ldsw = (unsigned)wid * 1024u;
    const int aoff = lds_byte(wr * 64 + fr, fq * 8), boff = lds_byte(wc * 32 + fr, fq * 8);
    int tr0 = 0, tr1 = 0;
    if constexpr (BT) { static_assert(Epi::PERM, "BT needs the PERM column order"); const int q_ = (lane >> 2) & 3, p_ = lane & 3, f1_ = fq & 1;
        const int L_ = (int)(size_t)lds + 2048 * fq + 512 * wc + 64 * q_ + 32 * ((p_ >> 1) ^ f1_); tr0 = L_ + 16 * (p_ & 1); tr1 = L_ + 256 + 16 * (1 - (p_ & 1)); }
#define PG8_SA(b, h) (((b) * 2 + (h)) * HTB)
#define PG8_SB(b, h) ((4 + (b) * 2 + (h)) * HTB)
#define PG8_STAGE(bufoff, gbase, voff) do { _Pragma("unroll") for (int _i = 0; _i < 2; ++_i) \
        __builtin_amdgcn_global_load_lds((const unsigned*)((const char*)(gbase) + (voff)[_i]), (PG8_LAS unsigned*)(lds + (bufoff) + ldsw + _i * 8192), 16, 0, 0); } while (0)
#define PG8_LDA(dst, b, h) do { _Pragma("unroll") for (int m = 0; m < 4; ++m) _Pragma("unroll") for (int k = 0; k < 2; ++k) dst[m][k] = *(const PG8_LAS bf16x8*)(lds + PG8_SA(b, h) + aoff + m * 2048 + k * 1024); } while (0)
#define PG8_TR(dst4, addr, OFF) asm volatile("ds_read_b64_tr_b16 %0, %1 offset:%2" : "=&v"(dst4) : "v"(addr), "i"(OFF) : "memory")
#define PG8_TRF(dst8, a0, a1, OFF) do { s16x4 lo_, hi_; PG8_TR(lo_, a0, OFF); PG8_TR(hi_, a1, OFF); dst8 = __builtin_shufflevector(lo_, hi_, 0, 1, 2, 3, 4, 5, 6, 7); } while (0)
#define PG8_LDB(dst, b, h) do { if constexpr (BT) { const int a0_ = tr0 + PG8_SB(b, h), a1_ = tr1 + PG8_SB(b, h); \
        PG8_TRF(dst[0][0], a0_, a1_, 0); PG8_TRF(dst[0][1], a0_, a1_, 8192); PG8_TRF(dst[1][0], a0_, a1_, 8); PG8_TRF(dst[1][1], a0_, a1_, 8200); } else { \
    _Pragma("unroll") for (int n = 0; n < 2; ++n) _Pragma("unroll") for (int k = 0; k < 2; ++k) dst[n][k] = *(const PG8_LAS bf16x8*)(lds + PG8_SB(b, h) + boff + n * 2048 + k * 1024); } } while (0)
#define PG8_MMA(ai, bj, At, Bt) do { __builtin_amdgcn_s_setprio(1); _Pragma("unroll") for (int m = 0; m < 4; ++m) _Pragma("unroll") for (int n = 0; n < 2; ++n) _Pragma("unroll") for (int k = 0; k < 2; ++k) \
        acc[ai][bj][m][n] = __builtin_amdgcn_mfma_f32_16x16x32_bf16(Bt[n][k], At[m][k], acc[ai][bj][m][n], 0, 0, 0); __builtin_amdgcn_s_setprio(0); } while (0)
#define PG8_WAIT_V(n) asm volatile("s_waitcnt vmcnt(" #n ")" ::: "memory")
#define PG8_WAIT_L(n) asm volatile("s_waitcnt lgkmcnt(" #n ")" ::: "memory")
#define PG8_BAR __builtin_amdgcn_s_barrier()
#define PG8_SCHED __builtin_amdgcn_sched_barrier(0)
    Unit cur, nxt; int ui = 0;
    if (!S.next(0, cur)) return;
    f32x4 acc[2][2][4][2];
#pragma unroll
    for (int a = 0; a < 2; ++a)
#pragma unroll
        for (int b = 0; b < 2; ++b)
#pragma unroll
            for (int m = 0; m < 4; ++m)
#pragma unroll
                for (int n = 0; n < 2; ++n) acc[a][b][m][n] = (f32x4){0.f, 0.f, 0.f, 0.f};
    bf16x8 At[4][2], B0[2][2], B1[2][2];
    const char* cA = (const char*)g.A + (GA ? 0 : (size_t)cur.pa * tstep); const char* cB = PG8_BBASE(cur.pb);
    if constexpr (GA) {
#pragma unroll
        for (int h = 0; h < 2; ++h)
#pragma unroll
            for (int i = 0; i < 2; ++i) { int R, C; stage_rc(tid * 16 + i * 8192, R, C);
                curA[h][i] = (unsigned)__hip_atomic_load(g.arows + cur.pa * 256 + h * 128 + R, __ATOMIC_RELAXED, __HIP_MEMORY_SCOPE_AGENT) * (unsigned)(K * 2) + (unsigned)C * 2u; } }
    S.a_ready(cur);
    if constexpr (SP2) {
        PG8_STAGE(PG8_SB(0, 0), cB, voffB); PG8_STAGE(PG8_SB(0, 1), cB + hstepB, voffB); PG8_STAGE_A(PG8_SA(0, 0), cA, 0, false); PG8_STAGE_A(PG8_SA(0, 1), cA, 1, false);
        if (wr == 1) PG8_BAR;
        PG8_WAIT_V(2); PG8_BAR;
        PG8_STAGE(PG8_SB(1, 0), cB + kstepB, voffB); PG8_STAGE_A(PG8_SA(1, 0), cA + kstep, 0, false); PG8_STAGE(PG8_SB(1, 1), cB + hstepB + kstepB, voffB);
        PG8_WAIT_V(6); PG8_BAR;
    } else {
        PG8_STAGE(PG8_SB(0, 0), cB, voffB); PG8_STAGE_A(PG8_SA(0, 0), cA, 0, false); PG8_STAGE(PG8_SB(0, 1), cB + hstepB, voffB); PG8_STAGE_A(PG8_SA(0, 1), cA, 1, false);
        if (wr == 1) PG8_BAR;
        PG8_WAIT_V(4); PG8_BAR;
        PG8_STAGE(PG8_SB(1, 0), cB + kstepB, voffB); PG8_STAGE_A(PG8_SA(1, 0), cA + kstep, 0, false); PG8_STAGE(PG8_SB(1, 1), cB + hstepB + kstepB, voffB);
        PG8_WAIT_V(6); PG8_BAR;
    }
    for (;;) {
        const bool has_next = S.next(ui + 1, nxt);
        const char* nA = (has_next && !GA) ? (const char*)g.A + (size_t)nxt.pa * tstep : cA; const char* nB = has_next ? PG8_BBASE(nxt.pb) : cB;
        for (int t = 0; t < nt; t += 2) {
            const bool last = (t == nt - 2);
            const char* a1 = cA + (size_t)(t + 1) * kstep;
            const char* a2 = last ? nA : cA + (size_t)(t + 2) * kstep; const char* b2 = last ? nB : cB + (size_t)(t + 2) * kstepB;
            const char* a3 = a2 + kstep; const char* b3 = b2 + kstepB;
            if (last && has_next) S.a_ready(nxt);
            const bool nx = GA && last && has_next;
            if constexpr (GA) {
                if (t == 0 && has_next) { int l_ = lane; asm volatile("" : "+v"(l_)); __builtin_amdgcn_global_load_lds((const unsigned*)(g.arows + nxt.pa * 256 + (wid & 3) * 64 + l_), (PG8_LAS unsigned*)(PG8_ROWTAB + wid * 64), 4, 0, 0); }
            }
            if constexpr (SP2) {
            PG8_LDB(B0, 0, 0); PG8_LDB(B1, 0, 1); PG8_SCHED; PG8_LDA(At, 0, 0); PG8_STAGE_A(PG8_SA(1, 1), a1, 1, false);
            PG8_WAIT_V(8); PG8_WAIT_L(0); PG8_BAR; PG8_MMA(0, 0, At, B0); PG8_MMA(0, 1, At, B1); PG8_BAR; PG8_SCHED;
            PG8_LDA(At, 0, 1); PG8_STAGE(PG8_SB(0, 0), b2, voffB); PG8_STAGE(PG8_SB(0, 1), b2 + hstepB, voffB); PG8_STAGE_A(PG8_SA(0, 0), a2, 0, nx);
            PG8_WAIT_V(8); PG8_WAIT_L(0); PG8_BAR; PG8_MMA(1, 0, At, B0); PG8_MMA(1, 1, At, B1); PG8_BAR; PG8_SCHED;
            PG8_LDB(B0, 1, 0); PG8_LDB(B1, 1, 1); PG8_SCHED; PG8_LDA(At, 1, 0); PG8_STAGE_A(PG8_SA(0, 1), a2, 1, nx);
            PG8_WAIT_V(8); PG8_WAIT_L(0); PG8_BAR; PG8_MMA(0, 0, At, B0); PG8_MMA(0, 1, At, B1); PG8_BAR; PG8_SCHED;
            PG8_LDA(At, 1, 1); PG8_STAGE(PG8_SB(1, 0), b3, voffB); PG8_STAGE(PG8_SB(1, 1), b3 + hstepB, voffB); PG8_STAGE_A(PG8_SA(1, 0), a3, 0, nx);
            PG8_WAIT_V(8); PG8_WAIT_L(0); PG8_BAR; PG8_MMA(1, 0, At, B0); PG8_MMA(1, 1, At, B1); PG8_BAR; PG8_SCHED;
            } else {
            PG8_LDB(B0, 0, 0); PG8_SCHED; PG8_LDA(At, 0, 0); PG8_STAGE_A(PG8_SA(1, 1), a1, 1, false);
            PG8_WAIT_L(8); PG8_BAR; PG8_WAIT_L(0); PG8_MMA(0, 0, At, B0); PG8_BAR; PG8_SCHED;
            PG8_LDB(B1, 0, 1); PG8_STAGE(PG8_SB(0, 0), b2, voffB);
            PG8_BAR; PG8_WAIT_L(0); PG8_MMA(0, 1, At, B1); PG8_BAR;
            PG8_LDA(At, 0, 1); PG8_STAGE_A(PG8_SA(0, 0), a2, 0, nx);
            PG8_BAR; PG8_WAIT_L(0); PG8_MMA(1, 0, At, B0); PG8_BAR; PG8_SCHED;
            PG8_STAGE(PG8_SB(0, 1), b2 + hstepB, voffB);
            PG8_WAIT_V(6); PG8_BAR; PG8_MMA(1, 1, At, B1); PG8_BAR;
            PG8_LDB(B0, 1, 0); PG8_SCHED; PG8_LDA(At, 1, 0); PG8_STAGE_A(PG8_SA(0, 1), a2, 1, nx);
            PG8_WAIT_L(8); PG8_BAR; PG8_WAIT_L(0); PG8_MMA(0, 0, At, B0); PG8_BAR; PG8_SCHED;
            PG8_LDB(B1, 1, 1); PG8_STAGE(PG8_SB(1, 0), b3, voffB);
            PG8_BAR; PG8_WAIT_L(0); PG8_MMA(0, 1, At, B1); PG8_BAR;
            PG8_LDA(At, 1, 1); PG8_STAGE_A(PG8_SA(1, 0), a3, 0, nx);
            PG8_BAR; PG8_WAIT_L(0); PG8_MMA(1, 0, At, B0); PG8_BAR; PG8_SCHED;
            PG8_STAGE(PG8_SB(1, 1), b3 + hstepB, voffB);
            PG8_WAIT_V(6); PG8_BAR; PG8_MMA(1, 1, At, B1); PG8_BAR;
            }
        }
        if constexpr (ALIGN_EPI) { if (wr == 0) PG8_BAR; }
        bool keep_acc = false;
        if constexpr (!Epi::AFTER_DRAIN) { int l2_ = lane; asm volatile("" : "+v"(l2_));
            if constexpr (Epi::PAIRED) { if (!(ui & 1) && has_next) { E.mid(acc, cur, wr, wc, l2_ & 15, l2_ >> 4); keep_acc = true; } else E(acc, cur, wr, wc, l2_ & 15, l2_ >> 4); }
            else E(acc, cur, wr, wc, l2_ & 15, l2_ >> 4);
            S.done(cur); }
        if (!has_next) break;
        if (!keep_acc) {
#pragma unroll
        for (int a = 0; a < 2; ++a)
#pragma unroll
            for (int b = 0; b < 2; ++b)
#pragma unroll
                for (int m = 0; m < 4; ++m)
#pragma unroll
                    for (int n = 0; n < 2; ++n) acc[a][b][m][n] = (f32x4){0.f, 0.f, 0.f, 0.f}; }
        if constexpr (GA) { PG8_NXTOFF(curA[0], 0); PG8_NXTOFF(curA[1], 1); }
        cur = nxt; cA = nA; cB = nB; ++ui;
        if constexpr (ALIGN_EPI) { if (wr == 1) PG8_BAR; }
    }
    PG8_WAIT_V(0);
    if constexpr (!ALIGN_EPI) { if (wr == 0) PG8_BAR; }
    PG8_BAR;
    if constexpr (Epi::AFTER_DRAIN) { E.fused(acc, cur, wr, wc, fr, fq, lds, wid, lane); S.done(cur); }
#undef PG8_SA
#undef PG8_SB
#undef PG8_STAGE
#undef PG8_STAGE_A
#undef PG8_NXTOFF
#undef PG8_ROWTAB
#undef PG8_LDA
#undef PG8_LDB
#undef PG8_TR
#undef PG8_TRF
#undef PG8_BBASE
#undef PG8_MMA
#undef PG8_WAIT_V
#undef PG8_WAIT_L
#undef PG8_BAR
#undef PG8_SCHED
}
}

namespace mk {
constexpr int D = 1024, B = 4, S = 4096, T = B * S, C = 512, INW = 5120, E = 16, CAP = 512, F = 2048, NTH = 512, NWAVES = 8;
typedef unsigned short bf16;
#define LAS __attribute__((address_space(3)))
typedef unsigned v4u __attribute__((ext_vector_type(4)));
typedef unsigned v2u __attribute__((ext_vector_type(2)));
typedef float f32x4 __attribute__((ext_vector_type(4)));
typedef short bf16x8 __attribute__((ext_vector_type(8)));
typedef float f32x16 __attribute__((ext_vector_type(16)));
typedef short s16x4 __attribute__((ext_vector_type(4)));

constexpr size_t MiB = 1u << 20;
constexpr size_t WS_WIN = 2 * MiB;
constexpr size_t WS_WUH = 22 * MiB;
constexpr size_t WS_WUA = 23 * MiB;
constexpr size_t WS_WOUT = 26 * MiB;
constexpr size_t WS_BINP = 30 * MiB;
constexpr size_t WS_WRP = 30 * MiB + 512 * 1024;
constexpr size_t WS_ROPE = 31 * MiB;
constexpr size_t WS_AFFT = 32 * MiB;
constexpr size_t WS_INV = 33 * MiB;
constexpr size_t WS_ROWS = 34 * MiB;
constexpr size_t WS_GATE = 34 * MiB + 512 * 1024;
constexpr size_t WS_RTOK = 35 * MiB + 512 * 1024;
constexpr size_t WS_RMIX = 35 * MiB + 640 * 1024;
constexpr size_t WS_RSL = 35 * MiB;
constexpr size_t WS_FILT = 36 * MiB;
constexpr size_t WS_X = 68 * MiB;
constexpr size_t WS_XN = 132 * MiB;
constexpr size_t WS_SH = 164 * MiB;
constexpr size_t WS_U = WS_SH;
constexpr size_t WS_UCT = WS_SH + 48 * MiB;
constexpr size_t WS_Q = WS_SH + 96 * MiB;
constexpr size_t WS_K = WS_SH + 112 * MiB;
constexpr size_t WS_V = WS_SH + 128 * MiB;
constexpr size_t WS_GH = WS_SH + 144 * MiB;
constexpr size_t WS_GA = WS_SH + 176 * MiB;
constexpr size_t WS_YH = WS_SH + 208 * MiB;
constexpr size_t WS_YA = WS_SH + 224 * MiB;
constexpr size_t WS_T1 = WS_U;
constexpr size_t WS_MG = WS_UCT;
constexpr size_t WS_PART = WS_SH;
constexpr size_t WS_HB = WS_SH + 64 * MiB;
constexpr size_t WS_YE = WS_SH + 192 * MiB;
constexpr size_t WS_WGU = 420 * MiB;
constexpr size_t WS_WD = 676 * MiB;
constexpr size_t WS_END = 804 * MiB;

constexpr int LDS_BYTES = 155648;
constexpr float QSCALE = 0.125f * 1.4426950408889634f;

struct Args {
    const float* in[29]; float* out; unsigned char* ws; int ph_lo, ph_hi; int p0_mask, pad;
};

__device__ __forceinline__ unsigned f2bf(float f) { unsigned u = __builtin_bit_cast(unsigned, f); return (u + 0x7fffu + ((u >> 16) & 1u)) >> 16; }
__device__ __forceinline__ unsigned pk2(float lo, float hi) { return f2bf(lo) | (f2bf(hi) << 16); }
__device__ __forceinline__ float bf2f(unsigned h) { return __builtin_bit_cast(float, h << 16); }
__device__ __forceinline__ float bflo(unsigned w) { return __builtin_bit_cast(float, w << 16); }
__device__ __forceinline__ float bfhi(unsigned w) { return __builtin_bit_cast(float, w & 0xffff0000u); }
template <int O> __device__ __forceinline__ float xor_f(float v) { return __builtin_bit_cast(float, __builtin_amdgcn_ds_swizzle(__builtin_bit_cast(int, v), (O << 10) | 0x1f)); }
__device__ __forceinline__ float wave_sum(float v) { v += xor_f<1>(v); v += xor_f<2>(v); v += xor_f<4>(v); v += xor_f<8>(v); v += xor_f<16>(v);
    const int b = __builtin_bit_cast(int, v); return __builtin_bit_cast(float, __builtin_amdgcn_readlane(b, 0)) + __builtin_bit_cast(float, __builtin_amdgcn_readlane(b, 32)); }

__device__ __forceinline__ float sigm(float x) { return 1.f / (1.f + __expf(-x)); }

struct Ctx { int tid, lane, wave, gw, ngw, vcu, G, bid, wave_s; LAS unsigned char* lds; unsigned char* ws; };

__device__ __forceinline__ int fresh_tid(int wave_s) { int l; asm volatile("v_mbcnt_lo_u32_b32 %0, -1, 0\n\tv_mbcnt_hi_u32_b32 %0, -1, %0" : "=v"(l)); return (wave_s << 6) | l; }
__device__ __forceinline__ Ctx relaunder(const Ctx& X) { Ctx Y = X; const int t = fresh_tid(X.wave_s); Y.tid = t; Y.lane = t & 63; return Y; }

template <int MAP> __device__ __forceinline__ int rowmap(int n) {
    if (MAP == 1) {
        if (n < 1536 || n >= 2560) return n;
        const int hb = (n - 1536) & ~63, d = (n - 1536) & 63, i = (d & 31) >> 2, j = d & 3;
        return 1536 + hb + 8 * i + ((d >> 5) << 2) + j;
    }
    if (MAP == 2) return ((n >> 7) << 8) + (n & 127);
    if (MAP == 3) return ((n >> 7) << 8) + 128 + (n & 127);
    return n;
}
__device__ __forceinline__ unsigned cvtpk_(float lo, float hi) { unsigned r; asm volatile("v_cvt_pk_bf16_f32 %0, %1, %2" : "=v"(r) : "v"(lo), "v"(hi)); return r; }
struct TrItem { const float* src; bf16* dst; };
template <int MAP> __device__ __forceinline__ void p0_transpose(const Ctx& X, const float* W, int K, int N, bf16* WT, int nmat, size_t sstride, size_t dstride, int rot = 0, const float* __restrict__ rscale = nullptr) {
    LAS float* scr = (LAS float*)(X.lds + X.wave * 16640);
    const int nblk = N / 64, per = (K / 64) * nblk, tot = per * nmat, lane = X.lane;
    const int nq = lane & 15, kr = lane >> 4, c = lane & 7, nsub = lane >> 3;
    f32x4 v[16];
    int it = X.gw - rot; if (it < 0) it += X.ngw;
#define TR_SRC(it_) (W + (size_t)((it_) / per) * sstride + (size_t)(64 * (((it_) % per) / nblk) + kr) * N + 64 * (((it_) % per) % nblk) + 4 * nq)
    if (it < tot) { const float* s = TR_SRC(it);
#pragma unroll
        for (int i = 0; i < 16; ++i) v[i] = __builtin_nontemporal_load((const f32x4*)(s + (size_t)(4 * i) * N)); }
    while (it < tot) {
#pragma unroll
        for (int i = 0; i < 16; ++i) { LAS float* d = scr + (4 * i + kr) * 65 + 4 * nq; d[0] = v[i][0]; d[1] = v[i][1]; d[2] = v[i][2]; d[3] = v[i][3]; }
        const int nit = it + X.ngw;
        if (nit < tot) { const float* s = TR_SRC(nit);
#pragma unroll
            for (int i = 0; i < 16; ++i) v[i] = __builtin_nontemporal_load((const f32x4*)(s + (size_t)(4 * i) * N)); }
        asm volatile("s_waitcnt lgkmcnt(0)" ::: "memory");
        const int m = it / per, r = it - m * per, k0 = 64 * (r / nblk), n0 = 64 * (r % nblk);
        bf16* dst = WT + (size_t)m * dstride;
        f32x4 ga = {1.f, 1.f, 1.f, 1.f}, gb = ga; if (rscale) { const f32x4* gp = (const f32x4*)(rscale + (size_t)m * K + k0 + 8 * c); ga = gp[0]; gb = gp[1]; }
#pragma unroll
        for (int j = 0; j < 8; ++j) { const int n = nsub + 8 * j; const LAS float* s = scr + (8 * c) * 65 + n;
            v4u o; o.x = cvtpk_(s[0 * 65] * ga[0], s[1 * 65] * ga[1]); o.y = cvtpk_(s[2 * 65] * ga[2], s[3 * 65] * ga[3]); o.z = cvtpk_(s[4 * 65] * gb[0], s[5 * 65] * gb[1]); o.w = cvtpk_(s[6 * 65] * gb[2], s[7 * 65] * gb[3]);
            __builtin_nontemporal_store(o, (v4u*)(dst + (size_t)rowmap<MAP>(n0 + n) * K + k0 + 8 * c)); }
        asm volatile("s_waitcnt lgkmcnt(0)" ::: "memory");
        it = nit;
    }
#undef TR_SRC
}
struct Row8 { f32x4 a[2][2]; };
__device__ __forceinline__ void row8_load(Row8& r, const float* p, int lane) {
#pragma unroll
    for (int j = 0; j < 2; ++j) { const f32x4* q = (const f32x4*)p + 2 * (lane + 64 * j); r.a[j][0] = q[0]; r.a[j][1] = q[1]; }
}
__device__ __forceinline__ void row8_load16(Row8& r, const bf16* p, int lane) {
#pragma unroll
    for (int j = 0; j < 2; ++j) { const v4u w = ((const v4u*)p)[lane + 64 * j];
        r.a[j][0] = (f32x4){bflo(w.x), bfhi(w.x), bflo(w.y), bfhi(w.y)}; r.a[j][1] = (f32x4){bflo(w.z), bfhi(w.z), bflo(w.w), bfhi(w.w)}; }
}
__device__ __forceinline__ float row8_sumsq(const Row8& r) {
    float s = 0.f;
#pragma unroll
    for (int j = 0; j < 2; ++j)
#pragma unroll
        for (int h = 0; h < 2; ++h) s += (r.a[j][h].x * r.a[j][h].x + r.a[j][h].y * r.a[j][h].y) + (r.a[j][h].z * r.a[j][h].z + r.a[j][h].w * r.a[j][h].w);
    return s;
}
__device__ __forceinline__ void rms_row_to_bf16(const float* __restrict__ xrow, const float* __restrict__ g, bf16* __restrict__ orow, int lane) {
    const f32x4* xr = (const f32x4*)xrow + lane; f32x4 v[4]; float s = 0.f;
#pragma unroll
    for (int j = 0; j < 4; ++j) { v[j] = xr[64 * j]; s += (v[j].x * v[j].x + v[j].y * v[j].y) + (v[j].z * v[j].z + v[j].w * v[j].w); }
    const float r = rsqrtf(wave_sum(s) * (1.f / D) + 1e-6f);
    v2u* o8 = (v2u*)orow + lane;
#pragma unroll
    for (int j = 0; j < 4; ++j) { const f32x4 gg = ((const f32x4*)g)[lane + 64 * j]; v2u w; w.x = pk2(v[j].x * r * gg.x, v[j].y * r * gg.y); w.y = pk2(v[j].z * r * gg.z, v[j].w * r * gg.w); o8[64 * j] = w; }
}
__device__ __forceinline__ void p0_filters(const Ctx& X, const Args& a) {
    LAS float* z = (LAS float*)X.lds;
    LAS float* h1 = z + 32 * 36;
    LAS float* h2r = h1 + 32 * 64;
    LAS float* w1s = h2r + 32 * 68;
    LAS float* w2s = w1s + 33 * 64;
    bf16* FILT = (bf16*)(X.ws + WS_FILT);
    const float min_decay = logf(1e-2f) / 0.3f, max_decay = logf(1e-2f) / 1.5f;
    for (int it = X.bid; it < 2 * (S / 32); it += X.G) {
        int tid = X.tid; asm volatile("" : "+v"(tid));
        const int j = tid & 63, tq = tid >> 6;
        const int l = it / (S / 32), t0 = (it % (S / 32)) * 32;
        const float *w1 = a.in[6] + l * 33 * 64, *b1 = a.in[7] + l * 64, *f1 = a.in[8] + l * 64, *w2 = a.in[9] + l * 64 * 64, *b2 = a.in[10] + l * 64, *f2 = a.in[11] + l * 64, *w3 = a.in[12] + (size_t)l * 64 * 2048;
        __syncthreads();
        for (int e = tid; e < 33 * 64; e += NTH) w1s[e] = w1[e];
        for (int e = tid; e < 64 * 64; e += NTH) w2s[e] = w2[e];
        for (int e = tid; e < 32 * 33; e += NTH) { const int tt = e / 33, jj0 = e - tt * 33, t = t0 + tt; float v;
            if (jj0 == 0) v = (float)t / (float)(S - 1);
            else { const int jj = (jj0 - 1) & 15; const float w = 2.0f * 3.14159265358979323846f * (float)t / (float)S; const float fr = 1e-4f + (float)jj * ((15.0f - 1e-4f) / 15.0f); const float ang = w * fr; v = (jj0 <= 16) ? cosf(ang) : -sinf(ang); }
            z[tt * 36 + jj0] = v; }
        const float bb1 = b1[j], ff1 = f1[j], bb2 = b2[j], ff2 = f2[j];
        __syncthreads();
        { float acc[4] = {bb1, bb1, bb1, bb1};
          for (int i = 0; i < 33; ++i) { const float w = w1s[i * 64 + j];
#pragma unroll
              for (int k = 0; k < 4; ++k) acc[k] += z[(tq + 8 * k) * 36 + i] * w; }
#pragma unroll
          for (int k = 0; k < 4; ++k) h1[(tq + 8 * k) * 64 + j] = sinf(ff1 * acc[k]); }
        __syncthreads();
        { float acc[4] = {bb2, bb2, bb2, bb2};
          for (int i = 0; i < 64; ++i) { const float w = w2s[i * 64 + j];
#pragma unroll
              for (int k = 0; k < 4; ++k) acc[k] += h1[(tq + 8 * k) * 64 + i] * w; }
#pragma unroll
          for (int k = 0; k < 4; ++k) h2r[(tq + 8 * k) * 68 + j] = sinf(ff2 * acc[k]); }
        __syncthreads();
        { const int wv = tid >> 6, ln = tid & 63, tl = ln & 31, kh = ln >> 5;
#define FSPLIT(HI, LO, V0, V1) do { v4u h_; h_.x = cvtpk_((V0)[0], (V0)[1]); h_.y = cvtpk_((V0)[2], (V0)[3]); h_.z = cvtpk_((V1)[0], (V1)[1]); h_.w = cvtpk_((V1)[2], (V1)[3]); \
            v4u l_; l_.x = cvtpk_((V0)[0] - bflo(h_.x), (V0)[1] - bfhi(h_.x)); l_.y = cvtpk_((V0)[2] - bflo(h_.y), (V0)[3] - bfhi(h_.y)); l_.z = cvtpk_((V1)[0] - bflo(h_.z), (V1)[1] - bfhi(h_.z)); l_.w = cvtpk_((V1)[2] - bflo(h_.w), (V1)[3] - bfhi(h_.w)); \
            HI = __builtin_bit_cast(bf16x8, h_); LO = __builtin_bit_cast(bf16x8, l_); } while (0)
            bf16x8 ah[4], al[4];
#pragma unroll
            for (int kb = 0; kb < 4; ++kb) { const f32x4 v0 = *(const LAS f32x4*)(h2r + tl * 68 + 16 * kb + 8 * kh), v1 = *(const LAS f32x4*)(h2r + tl * 68 + 16 * kb + 8 * kh + 4); FSPLIT(ah[kb], al[kb], v0, v1); }
            const float* wl = w3 + (size_t)(8 * kh) * 2048 + wv * 256 + tl;
            f32x4 wq[2][4][2];
#define FLOADW(BUF, NT) do { _Pragma("unroll") for (int kb_ = 0; kb_ < 4; ++kb_) _Pragma("unroll") for (int j_ = 0; j_ < 8; ++j_) wq[BUF][kb_][j_ >> 2][j_ & 3] = wl[(size_t)(16 * kb_ + j_) * 2048 + 32 * (NT)]; } while (0)
#define FTILE(BUF, NT) do { f32x16 d_ = {}; _Pragma("unroll") for (int kb_ = 0; kb_ < 4; ++kb_) { bf16x8 bh_, bl_; FSPLIT(bh_, bl_, wq[BUF][kb_][0], wq[BUF][kb_][1]); \
                d_ = __builtin_amdgcn_mfma_f32_32x32x16_bf16(ah[kb_], bh_, d_, 0, 0, 0); d_ = __builtin_amdgcn_mfma_f32_32x32x16_bf16(al[kb_], bh_, d_, 0, 0, 0); d_ = __builtin_amdgcn_mfma_f32_32x32x16_bf16(ah[kb_], bl_, d_, 0, 0, 0); } \
              const int n_ = wv * 256 + 32 * (NT) + tl, c_ = n_ & 511, od_ = n_ >> 9; const float dl_ = fabsf(min_decay + (float)c_ * ((max_decay - min_decay) / 511.0f)) * (1.0f / (float)(S - 1)); \
              bf16* fo_ = FILT + (((size_t)l * 4 + od_) * C + c_) * S + t0 + 4 * kh; \
              _Pragma("unroll") for (int g_ = 0; g_ < 4; ++g_) { const float tb_ = (float)(t0 + 8 * g_ + 4 * kh); v2u o_; \
                  o_.x = pk2(d_[4 * g_] * expf(-tb_ * dl_), d_[4 * g_ + 1] * expf(-(tb_ + 1.f) * dl_)); o_.y = pk2(d_[4 * g_ + 2] * expf(-(tb_ + 2.f) * dl_), d_[4 * g_ + 3] * expf(-(tb_ + 3.f) * dl_)); \
                  *(v2u*)(fo_ + 8 * g_) = o_; } } while (0)
            FLOADW(0, 0);
#pragma unroll 1
            for (int nt = 0; nt < 8; nt += 2) { FLOADW(1, nt + 1); FTILE(0, nt); if (nt + 2 < 8) FLOADW(0, nt + 2); FTILE(1, nt + 1); }
#undef FSPLIT
#undef FLOADW
#undef FTILE
        }
    }
    __syncthreads();
}
template <int MAP> __device__ __forceinline__ void p0_convert(const Ctx& X, const float* W, int K, int N, bf16* WB, int dN, int nmat, size_t sstride, size_t dstride, const float* __restrict__ rscale = nullptr) {
    const int nblk = N / 256, per = (K / 16) * nblk, tot = per * nmat, lane = X.lane;
    f32x4 v[16];
    int it = X.gw;
#define CV_SRC(it_) (W + (size_t)((it_) / per) * sstride + (size_t)(16 * (((it_) % per) / nblk)) * N + 256 * (((it_) % per) % nblk) + 4 * lane)
    if (it < tot) { const float* s = CV_SRC(it);
#pragma unroll
        for (int i = 0; i < 16; ++i) v[i] = __builtin_nontemporal_load((const f32x4*)(s + (size_t)i * N)); }
    while (it < tot) {
        v2u o[16];
        if (rscale) { const int k0s = 16 * ((it % per) / nblk);
#pragma unroll
            for (int i = 0; i < 16; ++i) { const float sc = rscale[k0s + i]; o[i].x = cvtpk_(v[i][0] * sc, v[i][1] * sc); o[i].y = cvtpk_(v[i][2] * sc, v[i][3] * sc); } }
        else {
#pragma unroll
        for (int i = 0; i < 16; ++i) { o[i].x = cvtpk_(v[i][0], v[i][1]); o[i].y = cvtpk_(v[i][2], v[i][3]); } }
        const int nit = it + X.ngw;
        if (nit < tot) { const float* s = CV_SRC(nit);
#pragma unroll
            for (int i = 0; i < 16; ++i) v[i] = __builtin_nontemporal_load((const f32x4*)(s + (size_t)i * N)); }
        const int mi = it / per, r = it - mi * per, k0 = 16 * (r / nblk), n = 256 * (r % nblk) + 4 * lane;
        const int dc = MAP == 0 ? n : (((n >> 7) << 8) + (n & 127) + (MAP == 3 ? 128 : 0));
        bf16* dst = WB + (size_t)mi * dstride + (size_t)k0 * dN + dc;
#pragma unroll
        for (int i = 0; i < 16; ++i) __builtin_nontemporal_store(o[i], (v2u*)(dst + (size_t)i * dN));
        it = nit;
    }
#undef CV_SRC
}
__device__ __forceinline__ void p0_experts(const Ctx& X, const Args& a, int l) {
    bf16* wgu = (bf16*)(X.ws + WS_WGU) + (size_t)l * E * 2 * F * D; bf16* wd = (bf16*)(X.ws + WS_WD) + (size_t)l * E * F * D;
    p0_convert<2>(X, a.in[25] + (size_t)l * E * D * F, D, F, wgu, 2 * F, E, (size_t)D * F, (size_t)2 * F * D, a.in[22] + l * D);
    p0_convert<3>(X, a.in[26] + (size_t)l * E * D * F, D, F, wgu, 2 * F, E, (size_t)D * F, (size_t)2 * F * D, a.in[22] + l * D);
    p0_convert<0>(X, a.in[27] + (size_t)l * E * D * F, F, D, wd, D, E, (size_t)F * D, (size_t)F * D);
}
__device__ __forceinline__ void p0_experts_rest(const Ctx& X, const Args& a, int l, int me0) {
    bf16* wgu = (bf16*)(X.ws + WS_WGU) + (size_t)l * E * 2 * F * D; bf16* wd = (bf16*)(X.ws + WS_WD) + (size_t)l * E * F * D;
    const int g0 = me0 < 16 ? me0 : 16, u0 = me0 < 16 ? 0 : (me0 < 32 ? me0 - 16 : 16), d0 = me0 < 32 ? 0 : me0 - 32;
    if (g0 < 16) p0_convert<2>(X, a.in[25] + ((size_t)l * E + g0) * D * F, D, F, wgu + (size_t)g0 * 2 * F * D, 2 * F, E - g0, (size_t)D * F, (size_t)2 * F * D, a.in[22] + l * D);
    if (u0 < 16) p0_convert<3>(X, a.in[26] + ((size_t)l * E + u0) * D * F, D, F, wgu + (size_t)u0 * 2 * F * D, 2 * F, E - u0, (size_t)D * F, (size_t)2 * F * D, a.in[22] + l * D);
    if (d0 < 16) p0_convert<0>(X, a.in[27] + ((size_t)l * E + d0) * D * F, F, D, wd + (size_t)d0 * F * D, D, E - d0, (size_t)F * D, (size_t)F * D);
}
#ifndef MK_P0_DUP
#define MK_P0_DUP 0
#endif
__device__ __forceinline__ void p0_prologue(const Ctx& X, const Args& a) {
    const int m = a.p0_mask;
    for (int dup_ = 0; dup_ < ((MK_P0_DUP & 1) ? 2 : 1); ++dup_)
    if (m & 1) {
        p0_transpose<1>(X, a.in[2], D, INW, (bf16*)(X.ws + WS_WIN), 2, (size_t)D * INW, (size_t)D * INW, 0, a.in[1]);
        p0_transpose<0>(X, a.in[19], C, D, (bf16*)(X.ws + WS_WUH), 2, (size_t)C * D, (size_t)2 * C * D, 512 % X.ngw);
        p0_transpose<0>(X, a.in[20], C, D, (bf16*)(X.ws + WS_WUA), 2, (size_t)C * D, (size_t)2 * C * D, 768 % X.ngw);
        p0_transpose<0>(X, a.in[21], D, D, (bf16*)(X.ws + WS_WOUT), 2, (size_t)D * D, (size_t)D * D, 1024 % X.ngw);
        float* binp = (float*)(X.ws + WS_BINP);
        for (int i = X.gw * 64 + X.lane; i < 2 * INW; i += X.ngw * 64) { const int l = i / INW, n = i - l * INW; binp[l * INW + rowmap<1>(n)] = a.in[3][i]; }
        { bf16* wrp = (bf16*)(X.ws + WS_WRP);
          for (int i = X.gw * 64 + X.lane; i < 2 * E * D; i += X.ngw * 64) { const int l = i / (E * D), e = (i / D) % E, k = i % D; const float v = a.in[22][l * D + k] * a.in[23][((size_t)l * D + k) * E + e];
              const unsigned hi = f2bf(v); const float lo = v - __builtin_bit_cast(float, hi << 16); wrp[((l * 2 + 0) * E + e) * D + k] = (bf16)hi; wrp[((l * 2 + 1) * E + e) * D + k] = (bf16)f2bf(lo); } }
        float* rope = (float*)(X.ws + WS_ROPE);
        for (int i = X.gw * 64 + X.lane; i < S * 32; i += X.ngw * 64) { const int pos = i >> 5, j = i & 31; const float inv = powf(10000.0f, -(float)j * 2.0f / 64.0f); float sn, cs; sincosf((float)pos * inv, &sn, &cs); rope[2 * i] = cs; rope[2 * i + 1] = sn; }
    }
    if (m & 2) { p0_experts(X, a, 0); p0_experts(X, a, 1); }
    for (int dup_ = 0; dup_ < ((MK_P0_DUP & 4) ? 2 : 1); ++dup_)
    if (m & 4) p0_filters(X, a);
    for (int dup_ = 0; dup_ < ((MK_P0_DUP & 8) ? 2 : 1); ++dup_)
    if (m & 8) {
        bf16* XB = (bf16*)(X.ws + WS_XN); float* rmix = (float*)(X.ws + WS_RMIX); const int lane = X.lane;
        int r = X.gw; Row8 cur; if (r < T) row8_load(cur, a.in[0] + (size_t)r * D, lane);
        while (r < T) { const int nr = r + X.ngw; Row8 nxt; if (nr < T) row8_load(nxt, a.in[0] + (size_t)nr * D, lane);
            const float rs = rsqrtf(wave_sum(row8_sumsq(cur)) * (1.f / D) + 1e-6f);
            if (lane == 0) rmix[r] = rs;
#pragma unroll
            for (int j = 0; j < 2; ++j) { const f32x4 y0 = cur.a[j][0], y1 = cur.a[j][1];
                v4u w; w.x = pk2(y0.x, y0.y); w.y = pk2(y0.z, y0.w); w.z = pk2(y1.x, y1.y); w.w = pk2(y1.z, y1.w); ((v4u*)(XB + (size_t)r * D))[lane + 64 * j] = w; }
            cur = nxt; r = nr; }
    }
}
}
namespace mk {
using pg8::Unit;
#ifndef MK_SIMPLE_ORDER
#define MK_SIMPLE_ORDER 0
#endif
__device__ __forceinline__ unsigned cvtpk(float lo, float hi) { unsigned r; asm volatile("v_cvt_pk_bf16_f32 %0, %1, %2" : "=v"(r) : "v"(lo), "v"(hi)); return r; }
__device__ __forceinline__ v4u pack8(f32x4 a, f32x4 b) { v4u w; w.x = cvtpk(a[0], a[1]); w.y = cvtpk(a[2], a[3]); w.z = cvtpk(b[0], b[1]); w.w = cvtpk(b[2], b[3]); return w; }
__device__ __forceinline__ void unpack8(v4u w, f32x4& a, f32x4& b) { a = (f32x4){bflo(w.x), bfhi(w.x), bflo(w.y), bfhi(w.y)}; b = (f32x4){bflo(w.z), bfhi(w.z), bflo(w.w), bfhi(w.w)}; }
__device__ __forceinline__ float fsig(float x) { return __builtin_amdgcn_rcpf(1.f + __expf(-x)); }

struct EpiWin {
    static constexpr bool PERM = true, AFTER_DRAIN = false, PAIRED = false;
    unsigned char* ws; const float* bias; const float* rope; const float* rmix;
    __device__ __forceinline__ void operator()(const f32x4 (&acc)[2][2][4][2], const Unit& u, int wr, int wc, int fr, int fq) const {
        const int colt = u.pn * 256, row0 = u.pm * 256 + wr * 64 + fr, cin = wc * 32 + 8 * fq;
        bf16* base; int ldc, col0, mode; float sc = 1.f;
        if (colt < 1536) { base = (bf16*)(ws + WS_U); ldc = 1536; col0 = colt; mode = 0; }
        else if (colt < 2048) { base = (bf16*)(ws + WS_Q); ldc = 512; col0 = colt - 1536; mode = 1; sc = QSCALE; }
        else if (colt < 2560) { base = (bf16*)(ws + WS_K); ldc = 512; col0 = colt - 2048; mode = 1; }
        else if (colt < 3072) { base = (bf16*)(ws + WS_V); ldc = 512; col0 = colt - 2560; mode = 0; }
        else if (colt < 4096) { base = (bf16*)(ws + WS_GH); ldc = 1024; col0 = colt - 3072; mode = 2; }
        else { base = (bf16*)(ws + WS_GA); ldc = 1024; col0 = colt - 4096; mode = 2; }
        f32x4 bv[2][2]; float rv[2][4];
#pragma unroll
        for (int ai = 0; ai < 2; ++ai)
#pragma unroll
            for (int m = 0; m < 4; ++m) rv[ai][m] = rmix[row0 + ai * 128 + m * 16];
#pragma unroll
        for (int bj = 0; bj < 2; ++bj)
#pragma unroll
            for (int n = 0; n < 2; ++n) bv[bj][n] = *(const f32x4*)(bias + colt + bj * 128 + cin + 4 * n);
#pragma unroll
        for (int ai = 0; ai < 2; ++ai)
#pragma unroll
            for (int m = 0; m < 4; ++m) {
                const int row = row0 + ai * 128 + m * 16; bf16* rowp = base + (size_t)row * ldc + col0 + cin;
                f32x4 rq[2][2];
                if (mode == 1) {
#pragma unroll
                    for (int bj = 0; bj < 2; ++bj) { const int i = ((bj * 128 + cin) & 63) >> 3; const float* rp = rope + ((size_t)(row & (S - 1)) * 32 + 4 * i) * 2; rq[bj][0] = *(const f32x4*)rp; rq[bj][1] = *(const f32x4*)(rp + 4); } }
#pragma unroll
                for (int bj = 0; bj < 2; ++bj) {
                    f32x4 v0 = acc[ai][bj][m][0] * rv[ai][m] + bv[bj][0], v1 = acc[ai][bj][m][1] * rv[ai][m] + bv[bj][1];
                    if (mode == 1) {
                        const f32x4 r0 = rq[bj][0], r1 = rq[bj][1];
                        const f32x4 cs = {r0[0], r0[2], r1[0], r1[2]}, sn = {r0[1], r0[3], r1[1], r1[3]};
                        const f32x4 o1 = (v0 * cs - v1 * sn) * sc, o2 = (v1 * cs + v0 * sn) * sc; v0 = o1; v1 = o2;
                    } else if (mode == 2) {
#pragma unroll
                        for (int e = 0; e < 4; ++e) { v0[e] = fsig(v0[e]); v1[e] = fsig(v1[e]); }
                    }
                    *(v4u*)(rowp + bj * 128) = pack8(v0, v1);
                }
            }
    }
};
struct EpiMerge2 {
    static constexpr bool PERM = true, AFTER_DRAIN = false, PAIRED = true;
    const bf16* GH; const bf16* GA; bf16* MG;
    __device__ __forceinline__ void mid(f32x4 (&acc)[2][2][4][2], const Unit& u, int wr, int wc, int fr, int fq) const {
        const int row0 = u.pm * 256 + wr * 64 + fr, col0 = u.pn * 256 + wc * 32 + 8 * fq;
#pragma unroll
        for (int ai = 0; ai < 2; ++ai) { v4u hq[4][2], aq[4][2];
#pragma unroll
            for (int m = 0; m < 4; ++m)
#pragma unroll
                for (int bj = 0; bj < 2; ++bj) { const size_t off = (size_t)(row0 + ai * 128 + m * 16) * D + col0 + bj * 128; hq[m][bj] = *(const v4u*)(GH + off); aq[m][bj] = *(const v4u*)(GA + off); }
#pragma unroll
            for (int m = 0; m < 4; ++m)
#pragma unroll
                for (int bj = 0; bj < 2; ++bj) { f32x4 h0, h1, a0, a1; unpack8(hq[m][bj], h0, h1); unpack8(aq[m][bj], a0, a1);
#pragma unroll
                    for (int e = 0; e < 4; ++e) { acc[ai][bj][m][0][e] *= h0[e] * __builtin_amdgcn_rcpf(fmaxf(a0[e], 1e-30f)); acc[ai][bj][m][1][e] *= h1[e] * __builtin_amdgcn_rcpf(fmaxf(a1[e], 1e-30f)); } } }
    }
    __device__ __forceinline__ void operator()(const f32x4 (&acc)[2][2][4][2], const Unit& u, int wr, int wc, int fr, int fq) const {
        const int row0 = u.pm * 256 + wr * 64 + fr, col0 = u.pn * 256 + wc * 32 + 8 * fq;
#pragma unroll
        for (int ai = 0; ai < 2; ++ai) { v4u aq[4][2];
#pragma unroll
            for (int m = 0; m < 4; ++m)
#pragma unroll
                for (int bj = 0; bj < 2; ++bj) aq[m][bj] = *(const v4u*)(GA + (size_t)(row0 + ai * 128 + m * 16) * D + col0 + bj * 128);
#pragma unroll
            for (int m = 0; m < 4; ++m)
#pragma unroll
                for (int bj = 0; bj < 2; ++bj) { f32x4 a0, a1; unpack8(aq[m][bj], a0, a1); f32x4 v0, v1;
#pragma unroll
                    for (int e = 0; e < 4; ++e) { v0[e] = acc[ai][bj][m][0][e] * fmaxf(a0[e], 1e-30f); v1[e] = acc[ai][bj][m][1][e] * fmaxf(a1[e], 1e-30f); }
                    *(v4u*)(MG + (size_t)(row0 + ai * 128 + m * 16) * D + col0 + bj * 128) = pack8(v0, v1); } }
    }
};
struct OrderMerge {
    pg8::StaticOrder so;
    __device__ __forceinline__ bool next(int i, Unit& u) const { if (!so.next(i >> 1, u)) return false; if (i & 1) { u.pa = u.pm + T / 256; u.pb = u.pn + 4; } return true; }
    __device__ __forceinline__ void a_ready(const Unit&) const {}
    __device__ __forceinline__ void done(const Unit&) const {}
};
struct EpiOut {
    static constexpr bool PERM = false, AFTER_DRAIN = false, PAIRED = false;
    const float* xin; float* X;
    __device__ __forceinline__ void operator()(const f32x4 (&acc)[2][2][4][2], const Unit& u, int wr, int wc, int fr, int fq) const {
        const int row0 = u.pm * 256 + wr * 64 + fr, col0 = u.pn * 256 + wc * 32 + 4 * fq;
#pragma unroll
        for (int ai = 0; ai < 2; ++ai)
#pragma unroll
            for (int m = 0; m < 4; ++m) { const size_t off = (size_t)(row0 + ai * 128 + m * 16) * D + col0;
#pragma unroll
                for (int bj = 0; bj < 2; ++bj)
#pragma unroll
                    for (int n = 0; n < 2; ++n) *(f32x4*)(X + off + bj * 128 + n * 16) = *(const f32x4*)(xin + off + bj * 128 + n * 16) + acc[ai][bj][m][n]; }
    }
};
struct EpiOutR {
    static constexpr bool PERM = true, AFTER_DRAIN = true, PAIRED = false;
    const bf16* xin16; bf16* XB; float* PART; const bf16* WRP; unsigned* tick; float* AFFT; float* RTOK; const float* br;
    __device__ __forceinline__ void operator()(const f32x4 (&)[2][2][4][2], const Unit&, int, int, int, int) const {}
    __device__ __forceinline__ void fused(const f32x4 (&acc)[2][2][4][2], const Unit& u, int wr, int wc, int fr, int fq, LAS unsigned char* lds, int wid, int lane) const {
        LAS float* SS = (LAS float*)lds;
        LAS float* LG = (LAS float*)(lds + 16384);
        const int rowl0 = wr * 64 + fr, colw = wc * 32 + 8 * fq;
        bf16x8 whi[2], wlo[2];
#pragma unroll
        for (int bj = 0; bj < 2; ++bj) { const bf16* wp = WRP + (size_t)fr * D + u.pn * 256 + bj * 128 + colw; whi[bj] = *(const bf16x8*)wp; wlo[bj] = *(const bf16x8*)(wp + (size_t)E * D); }
#pragma unroll
        for (int ai = 0; ai < 2; ++ai)
#pragma unroll
            for (int m = 0; m < 4; ++m) { const int rowl = rowl0 + ai * 128 + m * 16; float ss = 0.f; f32x4 lg = {0.f, 0.f, 0.f, 0.f};
                f32x4 xq[2][2];
#pragma unroll
                for (int bj = 0; bj < 2; ++bj) { const size_t off = (size_t)(u.pm * 256 + rowl) * D + u.pn * 256 + bj * 128 + colw; unpack8(*(const v4u*)(xin16 + off), xq[bj][0], xq[bj][1]); }
#pragma unroll
                for (int bj = 0; bj < 2; ++bj) { const size_t off = (size_t)(u.pm * 256 + rowl) * D + u.pn * 256 + bj * 128 + colw;
                    const f32x4 x0 = xq[bj][0] + acc[ai][bj][m][0], x1 = xq[bj][1] + acc[ai][bj][m][1];
                    const v4u hi = pack8(x0, x1); *(v4u*)(XB + off) = hi;
                    f32x4 h0, h1; unpack8(hi, h0, h1); const v4u lo = pack8(x0 - h0, x1 - h1);
                    ss += ((x0[0] * x0[0] + x0[1] * x0[1]) + (x0[2] * x0[2] + x0[3] * x0[3])) + ((x1[0] * x1[0] + x1[1] * x1[1]) + (x1[2] * x1[2] + x1[3] * x1[3]));
                    lg = __builtin_amdgcn_mfma_f32_16x16x32_bf16(whi[bj], __builtin_bit_cast(bf16x8, hi), lg, 0, 0, 0);
                    lg = __builtin_amdgcn_mfma_f32_16x16x32_bf16(whi[bj], __builtin_bit_cast(bf16x8, lo), lg, 0, 0, 0);
                    lg = __builtin_amdgcn_mfma_f32_16x16x32_bf16(wlo[bj], __builtin_bit_cast(bf16x8, hi), lg, 0, 0, 0); }
                SS[rowl * 16 + wc * 4 + fq] = ss;
                *(LAS f32x4*)(LG + ((wc * 256 + rowl) * 16 + 4 * fq)) = lg; }
        __syncthreads();
        const int t = wid * 64 + lane;
        if (t < 256) { float s = 0.f;
#pragma unroll
            for (int i = 0; i < 4; ++i) { const f32x4 v = *(const LAS f32x4*)(SS + t * 16 + 4 * i); s += (v[0] + v[1]) + (v[2] + v[3]); }
            float* pp = PART + ((size_t)u.pn * T + u.pm * 256 + t) * 20;
            __hip_atomic_store(pp, s, __ATOMIC_RELAXED, __HIP_MEMORY_SCOPE_AGENT);
#pragma unroll
            for (int i = 0; i < 4; ++i) { f32x4 a4 = *(const LAS f32x4*)(LG + (t * 16 + 4 * i));
#pragma unroll
                for (int w = 1; w < 4; ++w) a4 += *(const LAS f32x4*)(LG + ((w * 256 + t) * 16 + 4 * i));
#pragma unroll
                for (int q = 0; q < 4; ++q) __hip_atomic_store(pp + 4 + 4 * i + q, a4[q], __ATOMIC_RELAXED, __HIP_MEMORY_SCOPE_AGENT); } }
        asm volatile("s_waitcnt vmcnt(0)" ::: "memory");
        __syncthreads();
        LAS int* flag = (LAS int*)(lds + 16384 + 65536);
        if (t == 0) flag[0] = (int)__hip_atomic_fetch_add(tick + u.pm, 1u, __ATOMIC_RELAXED, __HIP_MEMORY_SCOPE_AGENT);
        __syncthreads();
        if (flag[0] == 3) {
            if (t < 256) { const int tok = u.pm * 256 + t; f32x4 s4 = {0.f, 0.f, 0.f, 0.f}, l4[4];
#pragma unroll
                for (int j = 0; j < 4; ++j) l4[j] = (f32x4){0.f, 0.f, 0.f, 0.f};
#pragma unroll
                for (int pn = 0; pn < 4; ++pn) { const float* pq = PART + ((size_t)pn * T + tok) * 20; s4[0] += __hip_atomic_load(pq, __ATOMIC_RELAXED, __HIP_MEMORY_SCOPE_AGENT);
#pragma unroll
                    for (int j = 0; j < 4; ++j)
#pragma unroll
                        for (int q = 0; q < 4; ++q) l4[j][q] += __hip_atomic_load(pq + 4 + 4 * j + q, __ATOMIC_RELAXED, __HIP_MEMORY_SCOPE_AGENT); }
                const float r = rsqrtf(s4[0] * (1.f / D) + 1e-6f); float mx = -1e30f;
#pragma unroll
                for (int j = 0; j < 4; ++j)
#pragma unroll
                    for (int q = 0; q < 4; ++q) { const float v = l4[j][q] * r + br[4 * j + q]; l4[j][q] = v; mx = fmaxf(mx, v); }
                float l = 0.f;
#pragma unroll
                for (int j = 0; j < 4; ++j)
#pragma unroll
                    for (int q = 0; q < 4; ++q) { l4[j][q] = expf(l4[j][q] - mx); l += l4[j][q]; }
                const int b = tok >> 12, s_ = tok & (S - 1);
#pragma unroll
                for (int j = 0; j < 4; ++j)
#pragma unroll
                    for (int q = 0; q < 4; ++q) AFFT[((size_t)b * E + 4 * j + q) * S + s_] = l4[j][q] / l;
                RTOK[tok] = r; } }
        __syncthreads();
    }
};
struct EpiSwiGLU {
    static constexpr bool PERM = true, AFTER_DRAIN = false, PAIRED = false;
    bf16* HB; const float* RSL;
    __device__ __forceinline__ void operator()(const f32x4 (&acc)[2][2][4][2], const Unit& u, int wr, int wc, int fr, int fq) const {
        const int row0 = u.pm * 256 + wr * 64 + fr, col0 = u.pn * 128 + wc * 32 + 8 * fq;
        float rrv[2][4];
#pragma unroll
        for (int ai = 0; ai < 2; ++ai)
#pragma unroll
            for (int m = 0; m < 4; ++m) rrv[ai][m] = RSL[row0 + ai * 128 + m * 16];
#pragma unroll
        for (int ai = 0; ai < 2; ++ai)
#pragma unroll
            for (int m = 0; m < 4; ++m) { f32x4 h[2]; const float rr = rrv[ai][m];
#pragma unroll
                for (int n = 0; n < 2; ++n) { const f32x4 g = acc[ai][0][m][n] * rr, up = acc[ai][1][m][n] * rr;
#pragma unroll
                    for (int e = 0; e < 4; ++e) h[n][e] = g[e] * fsig(g[e]) * up[e]; }
                *(v4u*)(HB + (size_t)(row0 + ai * 128 + m * 16) * F + col0) = pack8(h[0], h[1]); }
    }
};
struct EpiDown {
    static constexpr bool PERM = true, AFTER_DRAIN = false, PAIRED = false;
    bf16* YE; const float* gate;
    __device__ __forceinline__ void operator()(const f32x4 (&acc)[2][2][4][2], const Unit& u, int wr, int wc, int fr, int fq) const {
        const int row0 = u.pm * 256 + wr * 64 + fr, col0 = u.pn * 256 + wc * 32 + 8 * fq;
        float gv[2][4];
#pragma unroll
        for (int ai = 0; ai < 2; ++ai)
#pragma unroll
            for (int m = 0; m < 4; ++m) gv[ai][m] = gate[row0 + ai * 128 + m * 16];
#pragma unroll
        for (int ai = 0; ai < 2; ++ai)
#pragma unroll
            for (int m = 0; m < 4; ++m) { const int row = row0 + ai * 128 + m * 16; const float g = gv[ai][m];
#pragma unroll
                for (int bj = 0; bj < 2; ++bj) *(v4u*)(YE + (size_t)row * D + col0 + bj * 128) = pack8(acc[ai][bj][m][0] * g, acc[ai][bj][m][1] * g); }
    }
};
struct OrderMoE1 {
    int G, c;
    __device__ __forceinline__ bool next(int i, Unit& u) const {
        if (MK_SIMPLE_ORDER || G != 256) { const int L = i * G + c; if (L >= 2048) return false; const int e = L >> 7, r = L & 127; u.pm = e * 8 + (r & 7); u.pn = r >> 3; u.pb = e * 16 + u.pn; u.pa = u.pm; return true; }
        if (i >= 8) return false;
        const int ch = i * 8 + (c & 7), j = c >> 3, e = ch >> 2, ng = ch & 3; u.pm = e * 8 + (j & 7); u.pn = ng * 4 + (j >> 3); u.pb = e * 16 + u.pn; u.pa = u.pm; return true;
    }
    __device__ __forceinline__ void a_ready(const Unit&) const {}
    __device__ __forceinline__ void done(const Unit&) const {}
};
struct OrderMoE2 {
    int G, c;
    __device__ __forceinline__ bool next(int i, Unit& u) const {
        if (MK_SIMPLE_ORDER || G != 256) { const int L = i * G + c; if (L >= 512) return false; const int e = L >> 5, r = L & 31; u.pm = e * 8 + (r & 7); u.pn = r >> 3; u.pb = e * 4 + u.pn; u.pa = u.pm; return true; }
        if (i >= 2) return false;
        const int e = i * 8 + (c & 7), j = c >> 3; u.pm = e * 8 + (j & 7); u.pn = j >> 3; u.pb = e * 4 + u.pn; u.pa = u.pm; return true;
    }
    __device__ __forceinline__ void a_ready(const Unit&) const {}
    __device__ __forceinline__ void done(const Unit&) const {}
};

__device__ __forceinline__ void p6_topk(const Ctx& X) {
    const float* afft = (const float*)(X.ws + WS_AFFT); const float* rtok = (const float*)(X.ws + WS_RTOK); int* rows = (int*)(X.ws + WS_ROWS); float* gate = (float*)(X.ws + WS_GATE); float* rsl = (float*)(X.ws + WS_RSL); int* inv = (int*)(X.ws + WS_INV);
    for (int p = X.bid; p < B * E; p += X.G) { const int b = p >> 4, e = p & 15, slotbase = e * 2048 + b * 512;
        unsigned key[8]; float rr[8];
        { const uint4 k0 = ((const uint4*)(afft + (size_t)p * S))[X.tid * 2], k1 = ((const uint4*)(afft + (size_t)p * S))[X.tid * 2 + 1]; const f32x4 r0 = ((const f32x4*)(rtok + b * S))[X.tid * 2], r1 = ((const f32x4*)(rtok + b * S))[X.tid * 2 + 1];
          key[0] = k0.x; key[1] = k0.y; key[2] = k0.z; key[3] = k0.w; key[4] = k1.x; key[5] = k1.y; key[6] = k1.z; key[7] = k1.w;
          rr[0] = r0[0]; rr[1] = r0[1]; rr[2] = r0[2]; rr[3] = r0[3]; rr[4] = r1[0]; rr[5] = r1[1]; rr[6] = r1[2]; rr[7] = r1[3]; }
        tk::topk_problem(key, rr, b * S, e, slotbase, rows + slotbase, gate + slotbase, rsl + slotbase, inv, (int*)(X.lds), X.tid); }
}
__device__ __forceinline__ void p9_combine(const Ctx& X, bf16* XR, const float* __restrict__ g, bool final_, float* __restrict__ out) {
    const int* inv = (const int*)(X.ws + WS_INV); const bf16* YE = (const bf16*)(X.ws + WS_YE); bf16* XN = (bf16*)(X.ws + WS_XN); float* rmix = (float*)(X.ws + WS_RMIX); const int lane = X.lane;
    Row8 gg; row8_load(gg, g, lane);
    int tok = X.gw; Row8 cur; int myinv = -1;
    if (tok < T) { row8_load16(cur, XN + (size_t)tok * D, lane); if (lane < 16) myinv = inv[(size_t)tok * E + lane]; }
    while (tok < T) {
        const int ntok = tok + X.ngw; Row8 nxt; int ninv = -1;
        if (ntok < T) { row8_load16(nxt, XN + (size_t)ntok * D, lane); if (lane < 16) ninv = inv[(size_t)ntok * E + lane]; }
        unsigned long long m = __ballot(myinv >= 0);
        while (m) {
            int sl[4];
#pragma unroll
            for (int i = 0; i < 4; ++i) { if (m) { const int e = __builtin_ctzll(m); m &= m - 1; sl[i] = __builtin_amdgcn_readlane(myinv, e); } else sl[i] = -1; }
            v4u y[4][2];
#pragma unroll
            for (int i = 0; i < 4; ++i) if (sl[i] >= 0) { const v4u* yp = (const v4u*)(YE + (size_t)sl[i] * D); y[i][0] = __builtin_nontemporal_load(yp + lane); y[i][1] = __builtin_nontemporal_load(yp + lane + 64); }
#pragma unroll
            for (int i = 0; i < 4; ++i) if (sl[i] >= 0) {
#pragma unroll
                for (int j = 0; j < 2; ++j) { f32x4 p, q; unpack8(y[i][j], p, q); cur.a[j][0] += p; cur.a[j][1] += q; } }
        }
        const float r = rsqrtf(wave_sum(row8_sumsq(cur)) * (1.f / D) + 1e-6f);
        if (final_) {
#pragma unroll
            for (int j = 0; j < 2; ++j)
#pragma unroll
                for (int h = 0; h < 2; ++h) ((f32x4*)(out + (size_t)tok * D))[2 * (lane + 64 * j) + h] = cur.a[j][h] * gg.a[j][h] * r;
        } else {
            if (lane == 0) rmix[tok] = r;
#pragma unroll
            for (int j = 0; j < 2; ++j) { v4u xw; xw.x = pk2(cur.a[j][0].x, cur.a[j][0].y); xw.y = pk2(cur.a[j][0].z, cur.a[j][0].w); xw.z = pk2(cur.a[j][1].x, cur.a[j][1].y); xw.w = pk2(cur.a[j][1].z, cur.a[j][1].w); ((v4u*)(XR + (size_t)tok * D))[lane + 64 * j] = xw; }
        }
        cur = nxt; myinv = ninv; tok = ntok;
    }
}
}
namespace mk {
__device__ __forceinline__ void p1t_shortconv(const Ctx& X, const float* __restrict__ cw, const float* __restrict__ cb) {
    const bf16* U = (const bf16*)(X.ws + WS_U); bf16* UCT = (bf16*)(X.ws + WS_UCT);
    LAS float* raw = (LAS float*)(X.lds + X.wave * 17408);
    const int lane = X.lane, rq = lane >> 3, cq = lane & 7;
    constexpr int NIT = (T / 64) * 24;
    v4u w[9];
#define P1T_LOAD(it_) do { const int tt_ = (it_) / 24, cg_ = (it_) - tt_ * 24, tok0_ = tt_ * 64, tin_ = tok0_ & (S - 1); \
        _Pragma("unroll") for (int i = 0; i < 9; ++i) { const int r = 8 * i + rq, tpos = tin_ + r - 1; w[i] = (v4u){0u, 0u, 0u, 0u}; \
            if (r < 66 && tpos >= 0 && tpos < S) w[i] = *(const v4u*)(U + (size_t)(tok0_ + r - 1) * 1536 + cg_ * 64 + 8 * cq); } } while (0)
    int it = X.gw;
    if (it < NIT) P1T_LOAD(it);
    while (it < NIT) {
        const int tt = it / 24, cg = it - tt * 24, tok0 = tt * 64, ch0 = cg * 64;
#pragma unroll
        for (int i = 0; i < 9; ++i) { const int r = 8 * i + rq; if (r < 66) { LAS float* d = raw + r * 65 + 8 * cq; f32x4 p, q; unpack8(w[i], p, q);
            d[0] = p.x; d[1] = p.y; d[2] = p.z; d[3] = p.w; d[4] = q.x; d[5] = q.y; d[6] = q.z; d[7] = q.w; } }
        const int nit = it + X.ngw;
        if (nit < NIT) P1T_LOAD(nit);
        asm volatile("s_waitcnt lgkmcnt(0)" ::: "memory");
        const int chs = lane >> 3, tch = lane & 7;
#pragma unroll
        for (int g = 0; g < 8; ++g) { const int ch = 8 * g + chs, gc = ch0 + ch; const float w0 = cw[gc], w1 = cw[1536 + gc], w2 = cw[3072 + gc], bb = cb[gc];
            float v[10];
#pragma unroll
            for (int k = 0; k < 10; ++k) v[k] = raw[(8 * tch + k) * 65 + ch];
            float o[8];
#pragma unroll
            for (int k = 0; k < 8; ++k) o[k] = v[k] * w0 + v[k + 1] * w1 + v[k + 2] * w2 + bb;
            v4u pk; pk.x = pk2(o[0], o[1]); pk.y = pk2(o[2], o[3]); pk.z = pk2(o[4], o[5]); pk.w = pk2(o[6], o[7]);
            *(v4u*)(UCT + (size_t)gc * T + tok0 + 8 * tch) = pk; }
        asm volatile("s_waitcnt lgkmcnt(0)" ::: "memory");
        it = nit;
    }
#undef P1T_LOAD
}

__device__ __forceinline__ void p1t_kmax(const Ctx& X, unsigned* kmax2) {
    const bf16* K = (const bf16*)(X.ws + WS_K); const int lane = X.lane; LAS float* red = (LAS float*)(X.lds + 8 * 17408);
    const int b = X.gw / 512, t0 = X.gw % 512; float mx = 0.f;
    if (b < B) {
        v4u w[8];
#pragma unroll
        for (int i = 0; i < 8; ++i) w[i] = ((const v4u*)(K + ((size_t)b * S + t0 + 512 * i) * 512))[lane];
#pragma unroll
        for (int i = 0; i < 8; ++i) { f32x4 p, q; unpack8(w[i], p, q); float ss = (p.x * p.x + p.y * p.y) + (p.z * p.z + p.w * p.w) + (q.x * q.x + q.y * q.y) + (q.z * q.z + q.w * q.w);
            ss += xor_f<1>(ss); ss += xor_f<2>(ss); ss += xor_f<4>(ss); mx = fmaxf(mx, ss); }
    }
    __syncthreads();
    if ((lane & 7) == 0) red[X.wave * 8 + (lane >> 3)] = mx;
    __syncthreads();
    if (X.tid < 8 && b < B) { float m = red[X.tid]; for (int w_ = 1; w_ < 8; ++w_) m = fmaxf(m, red[w_ * 8 + X.tid]); atomicMax(kmax2 + b * 8 + X.tid, __float_as_uint(m)); }
}

namespace at {
constexpr int KVBLK = 64, LDK = 512;
constexpr int KPITCH = 272;
constexpr int SHM_V = 64 * 128 * 2, SHM_K = 64 * KPITCH;
constexpr int OFF_V = 0, OFF_K = 2 * SHM_V, OFF_Q = OFF_K + 2 * SHM_K, OFF_WS = OFF_Q + 256 * KPITCH, LDS_TOTAL = OFF_WS + 8 * 160 * 4;
constexpr float THR2 = 8.0f * 1.4426950408889634f;
#define KSWZ(row, colB) ((row) * KPITCH + (colB))
#define SBAR() __builtin_amdgcn_sched_barrier(0)
__device__ __forceinline__ int crow(int r, int hi) { return (r & 3) + 8 * (r >> 2) + 4 * hi; }
__device__ __forceinline__ int v_st(int k, int c) { const int kk = (k & ~0xC) | ((k & 4) << 1) | ((k & 8) >> 1); return ((kk >> 3) * 4 + (c >> 5)) * 512 + ((kk & 7) * 32 + (c & 31)) * 2; }
__device__ __forceinline__ int v_rd_base(int lane) { return ((lane & 3) << 3) | (((lane >> 2) & 3) << 6) | (((lane >> 4) & 1) << 5) | (((lane >> 5) & 1) << 8); }
constexpr int v_rd_off(int d0, int ks, int half) { return d0 * 512 + ks * 4096 + half * 2048; }
template <int OFF> __device__ __forceinline__ s16x4 tr_read(int vb) { s16x4 r; asm volatile("ds_read_b64_tr_b16 %0, %1 offset:%2" : "=&v"(r) : "v"(vb), "i"(OFF) : "memory"); return r; }

template <int CO> __device__ __forceinline__ void qkt(f32x16& p0, f32x16& p1, const char* Ks, const char* Qs, int qrow, int r32, int hi) {
    p0 = f32x16{}; p1 = f32x16{};
    const char* qp = Qs + KSWZ(qrow, (CO * 64 + hi * 8) * 2); const char* kp = Ks + KSWZ(r32, (CO * 64 + hi * 8) * 2);
#pragma unroll
    for (int d0 = 0; d0 < 4; ++d0) {
        const bf16x8 qf = *reinterpret_cast<const bf16x8*>(qp + d0 * 32);
        const bf16x8 b0 = *reinterpret_cast<const bf16x8*>(kp + d0 * 32);
        const bf16x8 b1 = *reinterpret_cast<const bf16x8*>(kp + 32 * KPITCH + d0 * 32);
        p0 = __builtin_amdgcn_mfma_f32_32x32x16_bf16(b0, qf, p0, 0, 0, 0);
        p1 = __builtin_amdgcn_mfma_f32_32x32x16_bf16(b1, qf, p1, 0, 0, 0);
        if (d0 == 1) asm volatile("" ::: "memory"); }
}
__device__ __forceinline__ void softmax_tile(f32x16& p0, f32x16& p1, float& m_reg, float& l_reg, float& alpha, bf16x8& pa0, bf16x8& pa1, bf16x8& pa2, bf16x8& pa3) {
    float pmax = p0[0];
#pragma unroll
    for (int r = 1; r < 16; ++r) pmax = fmaxf(pmax, p0[r]);
#pragma unroll
    for (int r = 0; r < 16; ++r) pmax = fmaxf(pmax, p1[r]);
    { auto rr = __builtin_amdgcn_permlane32_swap(__float_as_uint(pmax), __float_as_uint(pmax), false, false); pmax = fmaxf(__uint_as_float(rr[0]), __uint_as_float(rr[1])); }
    float mn;
    if (__builtin_expect(__all(pmax - m_reg <= THR2), 1)) { mn = m_reg; alpha = 1.f; }
    else { mn = fmaxf(m_reg, pmax); alpha = __builtin_amdgcn_exp2f(m_reg - mn); m_reg = mn; }
#pragma unroll
    for (int r = 0; r < 16; ++r) { p0[r] = __builtin_amdgcn_exp2f(p0[r] - mn); p1[r] = __builtin_amdgcn_exp2f(p1[r] - mn); }
    float ps = 0.f;
#pragma unroll
    for (int r = 0; r < 16; ++r) ps += p0[r];
#pragma unroll
    for (int r = 0; r < 16; ++r) ps += p1[r];
    { auto rr = __builtin_amdgcn_permlane32_swap(__float_as_uint(ps), __float_as_uint(ps), false, false); ps = __uint_as_float(rr[0]) + __uint_as_float(rr[1]); }
    l_reg = l_reg * alpha + ps;
#define PK4(P, BASE, OUT) do { unsigned a0 = cvtpk(P[BASE + 0], P[BASE + 1]), a1 = cvtpk(P[BASE + 2], P[BASE + 3]);   \
    unsigned b0 = cvtpk(P[BASE + 4], P[BASE + 5]), b1 = cvtpk(P[BASE + 6], P[BASE + 7]);                              \
    auto r0 = __builtin_amdgcn_permlane32_swap(a0, b0, false, false); auto r1 = __builtin_amdgcn_permlane32_swap(a1, b1, false, false); \
    v4u w = {r0[0], r1[0], r0[1], r1[1]}; OUT = *reinterpret_cast<bf16x8*>(&w); } while (0)
    PK4(p0, 0, pa0); PK4(p0, 8, pa1); PK4(p1, 0, pa2); PK4(p1, 8, pa3);
#undef PK4
}
__device__ __forceinline__ void softmax_fixed(f32x16& p0, f32x16& p1, float m, float& l_half, bf16x8& pa0, bf16x8& pa1, bf16x8& pa2, bf16x8& pa3) {
#pragma unroll
    for (int r = 0; r < 16; ++r) { p0[r] = __builtin_amdgcn_exp2f(p0[r] - m); p1[r] = __builtin_amdgcn_exp2f(p1[r] - m); }
    float ps = 0.f;
#pragma unroll
    for (int r = 0; r < 16; ++r) ps += p0[r] + p1[r];
    l_half += ps;
#define PK4(P, BASE, OUT) do { unsigned a0 = cvtpk(P[BASE + 0], P[BASE + 1]), a1 = cvtpk(P[BASE + 2], P[BASE + 3]);   \
    unsigned b0 = cvtpk(P[BASE + 4], P[BASE + 5]), b1 = cvtpk(P[BASE + 6], P[BASE + 7]);                              \
    auto r0 = __builtin_amdgcn_permlane32_swap(a0, b0, false, false); auto r1 = __builtin_amdgcn_permlane32_swap(a1, b1, false, false); \
    v4u w = {r0[0], r1[0], r0[1], r1[1]}; OUT = *reinterpret_cast<bf16x8*>(&w); } while (0)
    PK4(p0, 0, pa0); PK4(p0, 8, pa1); PK4(p1, 0, pa2); PK4(p1, 8, pa3);
#undef PK4
}
template <int D0> __device__ __forceinline__ void pv_one(f32x16& oa, int vb, const bf16x8 (&pa)[4]) {
#define PK(L, H) (bf16x8){L[0], L[1], L[2], L[3], H[0], H[1], H[2], H[3]}
    {   const s16x4 l0 = tr_read<v_rd_off(D0, 0, 0)>(vb), h0 = tr_read<v_rd_off(D0, 0, 1)>(vb), l1 = tr_read<v_rd_off(D0, 1, 0)>(vb), h1 = tr_read<v_rd_off(D0, 1, 1)>(vb);
        asm volatile("s_waitcnt lgkmcnt(0)" ::: "memory"); SBAR();
        oa = __builtin_amdgcn_mfma_f32_32x32x16_bf16(pa[0], PK(l0, h0), oa, 0, 0, 0);
        oa = __builtin_amdgcn_mfma_f32_32x32x16_bf16(pa[1], PK(l1, h1), oa, 0, 0, 0); }
    {   const s16x4 l2 = tr_read<v_rd_off(D0, 2, 0)>(vb), h2 = tr_read<v_rd_off(D0, 2, 1)>(vb), l3 = tr_read<v_rd_off(D0, 3, 0)>(vb), h3 = tr_read<v_rd_off(D0, 3, 1)>(vb);
        asm volatile("s_waitcnt lgkmcnt(0)" ::: "memory"); SBAR();
        oa = __builtin_amdgcn_mfma_f32_32x32x16_bf16(pa[2], PK(l2, h2), oa, 0, 0, 0);
        oa = __builtin_amdgcn_mfma_f32_32x32x16_bf16(pa[3], PK(l3, h3), oa, 0, 0, 0); }
#undef PK
}
template <int D0> __device__ __forceinline__ void pv_two(f32x16& oa, f32x16& ob, int vb, const bf16x8 (&pa)[4], const bf16x8 (&pb)[4]) {
#define PK(L, H) (bf16x8){L[0], L[1], L[2], L[3], H[0], H[1], H[2], H[3]}
    {   const s16x4 l0 = tr_read<v_rd_off(D0, 0, 0)>(vb), h0 = tr_read<v_rd_off(D0, 0, 1)>(vb), l1 = tr_read<v_rd_off(D0, 1, 0)>(vb), h1 = tr_read<v_rd_off(D0, 1, 1)>(vb);
        asm volatile("s_waitcnt lgkmcnt(0)" ::: "memory"); SBAR();
        const bf16x8 v0 = PK(l0, h0), v1 = PK(l1, h1);
        oa = __builtin_amdgcn_mfma_f32_32x32x16_bf16(pa[0], v0, oa, 0, 0, 0); ob = __builtin_amdgcn_mfma_f32_32x32x16_bf16(pb[0], v0, ob, 0, 0, 0);
        oa = __builtin_amdgcn_mfma_f32_32x32x16_bf16(pa[1], v1, oa, 0, 0, 0); ob = __builtin_amdgcn_mfma_f32_32x32x16_bf16(pb[1], v1, ob, 0, 0, 0); }
    {   const s16x4 l2 = tr_read<v_rd_off(D0, 2, 0)>(vb), h2 = tr_read<v_rd_off(D0, 2, 1)>(vb), l3 = tr_read<v_rd_off(D0, 3, 0)>(vb), h3 = tr_read<v_rd_off(D0, 3, 1)>(vb);
        asm volatile("s_waitcnt lgkmcnt(0)" ::: "memory"); SBAR();
        const bf16x8 v2 = PK(l2, h2), v3 = PK(l3, h3);
        oa = __builtin_amdgcn_mfma_f32_32x32x16_bf16(pa[2], v2, oa, 0, 0, 0); ob = __builtin_amdgcn_mfma_f32_32x32x16_bf16(pb[2], v2, ob, 0, 0, 0);
        oa = __builtin_amdgcn_mfma_f32_32x32x16_bf16(pa[3], v3, oa, 0, 0, 0); ob = __builtin_amdgcn_mfma_f32_32x32x16_bf16(pb[3], v3, ob, 0, 0, 0); }
#undef PK
}
__device__ __forceinline__ void rescale(f32x16 (&o)[4], float al, float* wsf, int r32, int hi) {
    if (__any(al < 1.f)) {
        if (hi == 0) wsf[r32] = al; asm volatile("s_waitcnt lgkmcnt(0)" ::: "memory");
#pragma unroll
        for (int r = 0; r < 16; ++r) { const float a = wsf[crow(r, hi)];
#pragma unroll
            for (int d = 0; d < 4; ++d) o[d][r] *= a; }
    }
}

__device__ __forceinline__ void epilogue(const Ctx& X, f32x16 (&oa)[4], f32x16 (&ob)[4], const float* wsf, int r32, int hi, int b, int h, int qb, float lam, float mul, const float* __restrict__ sg) {
    bf16* Yw = (bf16*)(X.ws + WS_YA) + ((size_t)b * S + qb * 256 + X.wave * 32) * 512 + h * 128;
    float gcol[4];
#pragma unroll
    for (int d = 0; d < 4; ++d) gcol[d] = sg[d * 32 + r32] * mul;
#pragma unroll
    for (int r = 0; r < 16; ++r) { const int orow = crow(r, hi); const float i0 = __builtin_amdgcn_rcpf(wsf[orow] + wsf[64 + orow]), i1 = lam * __builtin_amdgcn_rcpf(wsf[32 + orow] + wsf[96 + orow]);
        float v[4], ss = 0.f;
#pragma unroll
        for (int d = 0; d < 4; ++d) { v[d] = oa[d][r] * i0 - ob[d][r] * i1; ss += v[d] * v[d]; }
        ss += xor_f<1>(ss); ss += xor_f<2>(ss); ss += xor_f<4>(ss); ss += xor_f<8>(ss); ss += xor_f<16>(ss);
        const float rn = rsqrtf(ss * (1.f / 128.f) + 1e-5f);
#pragma unroll
        for (int d = 0; d < 4; ++d) Yw[(size_t)orow * 512 + d * 32 + r32] = (bf16)f2bf(v[d] * rn * gcol[d]); }
}
__device__ __forceinline__ int vkey(int T_, int lane) { const int kk = ((T_ >> 2) << 3) | ((lane & 31) >> 2); return (kk & ~0xC) | ((kk & 4) << 1) | ((kk & 8) >> 1); }
__device__ __forceinline__ int vcol(int T_, int lane) { return (T_ & 3) * 32 + (lane & 3) * 8; }
__device__ __forceinline__ void attn_unit(const Ctx& X, int b, int h, int qb, float lam, float mul, const float* __restrict__ sg, unsigned* kmax2) {
    char* lds = (char*)X.lds;
    const int tid = fresh_tid(X.wave_s);
    const int wid = X.wave, lane = tid & 63, r32 = lane & 31, hi = lane >> 5;
    const bf16* Qg = (const bf16*)(X.ws + WS_Q) + ((size_t)b * S + qb * 256) * LDK + h * 128;
    const bf16* Kh = (const bf16*)(X.ws + WS_K) + (size_t)b * S * LDK + h * 128;
    const bf16* Vh = (const bf16*)(X.ws + WS_V) + (size_t)b * S * LDK + h * 128;
    char* V_lds = lds + OFF_V; char* K_lds = lds + OFF_K; char* Q_lds = lds + OFF_Q;
    float* wsf = (float*)(lds + OFF_WS) + wid * 160;
    const int sr = tid >> 4, sc = (tid & 15) * 8, vst0 = v_st(sr, sc), vst1 = v_st(32 + sr, sc);
    const int vb0 = (int)(uintptr_t)V_lds + v_rd_base(lane);
#pragma unroll
    for (int i = 0; i < 8; ++i) { const int row = sr + 32 * i; *(bf16x8*)(Q_lds + KSWZ(row, sc * 2)) = *reinterpret_cast<const bf16x8*>(Qg + (size_t)row * LDK + sc); }
    bf16x8 st0, st1;
    const unsigned goff = (unsigned)(sr * LDK + sc) * 2u;
#define KLOAD(k0) do { const char* t_ = (const char*)Kh + (size_t)(k0) * (LDK * 2); st0 = *reinterpret_cast<const bf16x8*>(t_ + goff); st1 = *reinterpret_cast<const bf16x8*>(t_ + 32 * LDK * 2 + goff); } while (0)
#define VLOAD(k0) do { const char* t_ = (const char*)Vh + (size_t)(k0) * (LDK * 2); st0 = *reinterpret_cast<const bf16x8*>(t_ + goff); st1 = *reinterpret_cast<const bf16x8*>(t_ + 32 * LDK * 2 + goff); } while (0)
#define KWRITE(bb) do { *(bf16x8*)(K_lds + (bb) * SHM_K + KSWZ(sr, sc * 2)) = st0; *(bf16x8*)(K_lds + (bb) * SHM_K + KSWZ(32 + sr, sc * 2)) = st1; } while (0)
    const unsigned vsrc0 = (unsigned)(vkey(2 * wid + (lane >> 5), lane) * LDK + vcol(2 * wid + (lane >> 5), lane)) * 2u, vsrc1 = (unsigned)(vkey(2 * (wid + 8) + (lane >> 5), lane) * LDK + vcol(2 * (wid + 8) + (lane >> 5), lane)) * 2u;
#define VDMA(k0, bbn) do { const char* t_ = (const char*)Vh + (size_t)(k0) * (LDK * 2); LAS unsigned char* d_ = X.lds + OFF_V + (bbn) * SHM_V + wid * 1024; \
    __builtin_amdgcn_global_load_lds((const unsigned*)(t_ + vsrc0), (LAS unsigned*)d_, 16, 0, 0); __builtin_amdgcn_global_load_lds((const unsigned*)(t_ + vsrc1), (LAS unsigned*)(d_ + 8192), 16, 0, 0); } while (0)
    const unsigned ksrc = (unsigned)(wid * 8 * LDK * 2) + (unsigned)lane * 4u;
#define KDMA(k0, bbn) do { const char* t_ = (const char*)Kh + (size_t)(k0) * (LDK * 2) + ksrc; LAS unsigned char* d_ = X.lds + OFF_K + (bbn) * SHM_K + wid * 8 * KPITCH; \
    _Pragma("unroll") for (int i_ = 0; i_ < 8; ++i_) __builtin_amdgcn_global_load_lds((const unsigned*)(t_ + i_ * (LDK * 2)), (LAS unsigned*)(d_ + i_ * KPITCH), 4, 0, 0); } while (0)
#define VWRITE(bb) do { *(bf16x8*)(V_lds + (bb) * SHM_V + vst0) = st0; *(bf16x8*)(V_lds + (bb) * SHM_V + vst1) = st1; } while (0)
    float l0 = 0.f, l1 = 0.f; f32x16 oa[4] = {}, ob[4] = {};
    const int qrow = wid * 32 + r32; constexpr int NT = S / KVBLK;
    KDMA(0, 0); VDMA(0, 0); __syncthreads();
    float m0, m1;
    { float s0 = 0.f, s1 = 0.f;
#pragma unroll
      for (int d0 = 0; d0 < 8; ++d0) { const v4u w = *reinterpret_cast<const v4u*>(Q_lds + KSWZ(qrow, (d0 * 16 + hi * 8) * 2)); f32x4 p, q; unpack8(w, p, q);
          const float ss = (p.x * p.x + p.y * p.y) + (p.z * p.z + p.w * p.w) + (q.x * q.x + q.y * q.y) + (q.z * q.z + q.w * q.w); if (d0 < 4) s0 += ss; else s1 += ss; }
      wsf[hi * 64 + r32] = s0; wsf[hi * 64 + 32 + r32] = s1; asm volatile("s_waitcnt lgkmcnt(0)" ::: "memory");
      s0 += wsf[(hi ^ 1) * 64 + r32]; s1 += wsf[(hi ^ 1) * 64 + 32 + r32]; asm volatile("s_waitcnt lgkmcnt(0)" ::: "memory");
      const float k0 = __uint_as_float(__hip_atomic_load(kmax2 + b * 8 + h * 2, __ATOMIC_RELAXED, __HIP_MEMORY_SCOPE_AGENT)), k1 = __uint_as_float(__hip_atomic_load(kmax2 + b * 8 + h * 2 + 1, __ATOMIC_RELAXED, __HIP_MEMORY_SCOPE_AGENT));
      m0 = sqrtf(s0 * k0) * 1.001f + 1e-3f; m1 = sqrtf(s1 * k1) * 1.001f + 1e-3f; }
    for (int j = 0; j < NT; ++j) {
        const int bb = j & 1; const char* Ks = K_lds + bb * SHM_K;
        const int kn = (j + 1) * KVBLK;
        if (j + 1 < NT) { KDMA(kn, bb ^ 1); VDMA(kn, bb ^ 1); }
        const int vb = vb0 + bb * SHM_V;
        bf16x8 pa[4], pb[4];
        { f32x16 p0, p1, q0, q1;
          qkt<0>(p0, p1, Ks, Q_lds, qrow, r32, hi); qkt<1>(q0, q1, Ks, Q_lds, qrow, r32, hi);
          softmax_fixed(p0, p1, m0, l0, pa[0], pa[1], pa[2], pa[3]);
          softmax_fixed(q0, q1, m1, l1, pb[0], pb[1], pb[2], pb[3]); }
        SBAR();
        pv_two<0>(oa[0], ob[0], vb, pa, pb); pv_two<1>(oa[1], ob[1], vb, pa, pb); pv_two<2>(oa[2], ob[2], vb, pa, pb); pv_two<3>(oa[3], ob[3], vb, pa, pb);
        __syncthreads();
    }
#undef KLOAD
#undef VLOAD
#undef VDMA
#undef KDMA
#undef KWRITE
#undef VWRITE
    wsf[hi * 64 + r32] = l0; wsf[hi * 64 + 32 + r32] = l1; asm volatile("s_waitcnt lgkmcnt(0)" ::: "memory");
    { const int t2 = fresh_tid(X.wave_s); epilogue(X, oa, ob, wsf, t2 & 31, (t2 & 63) >> 5, b, h, qb, lam, mul, sg); }
    __syncthreads();
}
__device__ __forceinline__ void epilogue_unused() {}
#undef KSWZ
#undef SBAR
}
}
namespace mk {
namespace hy {
struct CvSet { int have; f32x4 ld0, ld1, ld2, ld3; float sc; };
struct CvState { int next, stride, nlim, cnt, par; CvSet a, b; };
#define CV_PDECL const float* cwg, const float* cwu, const float* cwd, bf16* ctgu, bf16* ctd, const float* cgn
#define CV_PARGS cwg, cwu, cwd, ctgu, ctd, cgn
constexpr int CV_TILES = 3 * 16 * 2048;
#ifndef CV_EVERY
#define CV_EVERY 5
#endif
__device__ __forceinline__ void cv_issue(CvState& s, CvSet& q, int lane, CV_PDECL) {
    if (s.next < s.nlim) { asm volatile("" : "+v"(lane));
        const int t = s.next, me = t >> 11, rr = t & 2047, mat = me >> 4, e = me & 15;
        const float* W = (mat == 0 ? cwg : (mat == 1 ? cwu : cwd)) + (size_t)e * D * F + rr * 1024 + 4 * lane;
        q.ld0 = __builtin_nontemporal_load((const f32x4*)W); q.ld1 = __builtin_nontemporal_load((const f32x4*)(W + 256)); q.ld2 = __builtin_nontemporal_load((const f32x4*)(W + 512)); q.ld3 = __builtin_nontemporal_load((const f32x4*)(W + 768));
        { const float g_ = cgn[mat < 2 ? (rr >> 1) : 0]; q.sc = mat < 2 ? g_ : 1.f; }
        q.have = t; s.next = t + s.stride; }
    else q.have = -1;
}
__device__ __forceinline__ void cv_finish_set(CvState& s, CvSet& q, int lane, CV_PDECL) {
    const int t = q.have; v2u o0 = {0u, 0u}, o1 = {0u, 0u}, o2 = {0u, 0u}, o3 = {0u, 0u};
    if (t >= 0) { const float sc = q.sc;
        o0.x = cvtpk_(q.ld0[0] * sc, q.ld0[1] * sc); o0.y = cvtpk_(q.ld0[2] * sc, q.ld0[3] * sc); o1.x = cvtpk_(q.ld1[0] * sc, q.ld1[1] * sc); o1.y = cvtpk_(q.ld1[2] * sc, q.ld1[3] * sc);
        o2.x = cvtpk_(q.ld2[0] * sc, q.ld2[1] * sc); o2.y = cvtpk_(q.ld2[2] * sc, q.ld2[3] * sc); o3.x = cvtpk_(q.ld3[0] * sc, q.ld3[1] * sc); o3.y = cvtpk_(q.ld3[2] * sc, q.ld3[3] * sc); }
    cv_issue(s, q, lane, CV_PARGS);
    if (t >= 0) { asm volatile("" : "+v"(lane)); const int me = t >> 11, rr = t & 2047, mat = me >> 4, e = me & 15;
        bf16* dst; int qs;
        if (mat == 2) { dst = ctd + (size_t)e * D * F + rr * 1024 + 4 * lane; qs = 256; }
        else { const int k = rr >> 1, n = (rr & 1) * 1024 + 4 * lane; dst = ctgu + ((size_t)e * D + k) * (2 * F) + 2 * (n & ~127) + (n & 127) + 128 * mat; qs = 512; }
        __builtin_nontemporal_store(o0, (v2u*)dst); __builtin_nontemporal_store(o1, (v2u*)(dst + qs)); __builtin_nontemporal_store(o2, (v2u*)(dst + 2 * qs)); __builtin_nontemporal_store(o3, (v2u*)(dst + 3 * qs)); }
}
__device__ __forceinline__ void cv_finish(CvState& s, int lane, CV_PDECL) { if (s.par) cv_finish_set(s, s.b, lane, CV_PARGS); else cv_finish_set(s, s.a, lane, CV_PARGS); s.par ^= 1; }

constexpr int CPS = 16704;
constexpr int NEL = 8352;
constexpr int OFF_Z = 4 * CPS;
constexpr int ZROW = 144, ZB = 128 * ZROW;
constexpr int LDS_TOTAL = OFF_Z + 4 * ZB;

__device__ __forceinline__ void build_hrev(const Ctx& X, const bf16* hf, const bf16* hb, float bias) {
    const int tid = X.tid;
    if (tid < 4 * 8) { const int m = tid >> 3, e = tid & 7; if (e < 5 - m) *(LAS bf16*)(X.lds + m * CPS + 2 * e) = 0; }
    for (int i = tid; i < 4 * (NEL - 8192); i += NTH) { const int m = i / (NEL - 8192), e = 8192 + (i - m * (NEL - 8192)); if (e > 8195 - m) *(LAS bf16*)(X.lds + m * CPS + 2 * e) = 0; }
#pragma unroll
    for (int half = 0; half < 2; ++half) {
        const v4u w = *(const v4u*)((half ? hb : hf) + 8 * tid);
        unsigned short v[8] = {(unsigned short)(w.x & 0xffff), (unsigned short)(w.x >> 16), (unsigned short)(w.y & 0xffff), (unsigned short)(w.y >> 16), (unsigned short)(w.z & 0xffff), (unsigned short)(w.z >> 16), (unsigned short)(w.w & 0xffff), (unsigned short)(w.w >> 16)};
        if (half == 0 && tid == 0) v[0] = (unsigned short)f2bf(bf2f(v[0]) + bias);
#pragma unroll
        for (int k = 0; k < 8; ++k) { const int d = 8 * tid + k; if (half == 1 && d == 0) continue;
            const int e0 = half ? 4100 + d : 4100 - d;
#pragma unroll
            for (int m = 0; m < 4; ++m) *(LAS bf16*)(X.lds + m * CPS + 2 * (e0 - m)) = v[k]; }
    }
}
#ifdef MK_HY_XLDS
#define HY_XL(qq) do { const v2u x0_ = *(const volatile LAS v2u*)(X.lds + baseA + 32 * (qq)), x1_ = *(const volatile LAS v2u*)(X.lds + baseA8 + 32 * (qq)); asm volatile("" :: "v"(x0_), "v"(x1_)); } while (0)
#else
#define HY_XL(qq) do {} while (0)
#endif
#define HY_LDA(dst, qq) do { HY_XL(qq); const v2u lo_ = *(const volatile LAS v2u*)(X.lds + baseA + 32 * (qq)), hi_ = *(const volatile LAS v2u*)(X.lds + baseA8 + 32 * (qq)); v4u w_ = {lo_.x, lo_.y, hi_.x, hi_.y}; dst = *reinterpret_cast<bf16x8*>(&w_); } while (0)
#define HY_LOAD_E(FA, FB, d1_, q_) do { const LAS unsigned char* zr_ = zb - (d1_) * ZROW; HY_LDA(FA[0], (q_)); HY_LDA(FA[1], (q_) + 1); \
    FB[0] = *(const LAS bf16x8*)(zr_); FB[1] = *(const LAS bf16x8*)(zr_ + 32); FB[2] = *(const LAS bf16x8*)(zr_ + 64); FB[3] = *(const LAS bf16x8*)(zr_ + 96); } while (0)
#define HY_LOAD_L(FA, q_) do { HY_LDA(FA[2], (q_) + 2); HY_LDA(FA[3], (q_) + 3); } while (0)
#ifdef MK_HY_XMFMA
#define HY_XM(A_, B_) do { dacc0 = __builtin_amdgcn_mfma_f32_32x32x16_bf16(A_, B_, dacc0, 0, 0, 0); } while (0)
#else
#define HY_XM(A_, B_) do {} while (0)
#endif
#define HY_MMA1(FA, FB, PA) do { __builtin_amdgcn_s_setprio(1); HY_XM(FA[0], FB[0]); HY_XM(PA[2], FB[0]); HY_XM(FA[1], FB[1]); HY_XM(PA[3], FB[1]); \
    acc0 = __builtin_amdgcn_mfma_f32_32x32x16_bf16(FA[0], FB[0], acc0, 0, 0, 0); acc1 = __builtin_amdgcn_mfma_f32_32x32x16_bf16(PA[2], FB[0], acc1, 0, 0, 0); \
    acc0 = __builtin_amdgcn_mfma_f32_32x32x16_bf16(FA[1], FB[1], acc0, 0, 0, 0); acc1 = __builtin_amdgcn_mfma_f32_32x32x16_bf16(PA[3], FB[1], acc1, 0, 0, 0); __builtin_amdgcn_s_setprio(0); } while (0)
#define HY_MMA2(FA, FB) do { __builtin_amdgcn_s_setprio(1); HY_XM(FA[2], FB[2]); HY_XM(FA[0], FB[2]); HY_XM(FA[3], FB[3]); HY_XM(FA[1], FB[3]); \
    acc0 = __builtin_amdgcn_mfma_f32_32x32x16_bf16(FA[2], FB[2], acc0, 0, 0, 0); acc1 = __builtin_amdgcn_mfma_f32_32x32x16_bf16(FA[0], FB[2], acc1, 0, 0, 0); \
    acc0 = __builtin_amdgcn_mfma_f32_32x32x16_bf16(FA[3], FB[3], acc0, 0, 0, 0); acc1 = __builtin_amdgcn_mfma_f32_32x32x16_bf16(FA[1], FB[3], acc1, 0, 0, 0); __builtin_amdgcn_s_setprio(0); } while (0)
template <int PAIR> __device__ __forceinline__ void channel(const Ctx& X, int l, int c, const float* __restrict__ hyb, CvState& cs, CV_PDECL) {
    const bf16* UCT = (const bf16*)(X.ws + WS_UCT); const bf16* FILT = (const bf16*)(X.ws + WS_FILT) + (size_t)l * 4 * C * S; bf16* YH = (bf16*)(X.ws + WS_YH);
    const int tid = X.tid, lane = X.lane, wid = X.wave, r = lane & 31, h = lane >> 5, b = wid >> 1, jt = wid & 1;
    LAS unsigned char* zl = X.lds + OFF_Z;
    v2u* const stash0 = (v2u*)(X.ws + WS_U) + (size_t)X.bid * 8 * NTH;
    __syncthreads();
    v4u zero4 = {0u, 0u, 0u, 0u}; asm volatile("" : "+v"(zero4));
    for (int i = tid; i < 4 * 64 * 9; i += NTH) { const int bb = i / 576, rr = (i % 576) / 9, ch = i % 9; const int row = rr < 32 ? rr : 64 + rr;
        *(LAS v4u*)(zl + bb * ZB + row * ZROW + ch * 16) = zero4; }
    for (int i = tid; i < 4 * 64 * 8; i += NTH) { const int bb = i >> 9, s1 = (i >> 3) & 63, ch = i & 7;
        *(LAS v4u*)(zl + bb * ZB + (32 + s1) * ZROW + ch * 16) = *(const v4u*)(UCT + (size_t)c * T + bb * S + s1 * 64 + ch * 8); }
    const int m4 = (4 - (r & 3)) & 3;
    const int baseA = m4 * CPS + 2 * (8 * h - r + 4100 - m4);
    int baseA8 = baseA + 8; asm volatile("" : "+v"(baseA8));
    for (int o = 0; o < 2; ++o) {
        build_hrev(X, FILT + ((size_t)(2 * o) * C + c) * S, FILT + ((size_t)(2 * o + 1) * C + c) * S, hyb[(l * 2 + o) * C + c]);
#ifdef MK_HY_DUPBUILD
        asm volatile("" ::: "memory"); build_hrev(X, FILT + ((size_t)(2 * o) * C + c) * S, FILT + ((size_t)(2 * o + 1) * C + c) * S, hyb[(l * 2 + o) * C + c]);
#endif
        const bf16* gate = UCT + (size_t)((o + 1) * C + c) * T + (size_t)b * S;
        const int t1 = 32 * jt + r;
        __syncthreads();
#ifndef MK_HY_SWEEPS
#define MK_HY_SWEEPS 1
#endif
        f32x16 acc0 = {}, acc1 = {};
#ifdef MK_HY_XMFMA
        f32x16 dacc0 = {};
#endif
        for (int rep = 0; rep < MK_HY_SWEEPS; ++rep) {
        const int d1max = 32 * jt + 31; int q = -4 * d1max;
        const LAS unsigned char* zb = zl + b * ZB + (32 + 32 * jt + r) * ZROW + 16 * h;
        bf16x8 fa0[4], fb0[4], fa1[4], fb1[4];
        HY_LDA(fa1[2], q - 2); HY_LDA(fa1[3], q - 1);
        HY_LOAD_E(fa0, fb0, d1max, q); HY_LOAD_L(fa0, q);
        int d1 = d1max;
        for (int it = 0; it < 47; ++it) {
            HY_LOAD_E(fa1, fb1, d1 - 1, q + 4);
            HY_MMA1(fa0, fb0, fa1);
            HY_LOAD_L(fa1, q + 4);
            HY_MMA2(fa0, fb0);
            HY_LOAD_E(fa0, fb0, d1 - 2, q + 8);
            HY_MMA1(fa1, fb1, fa0);
            HY_LOAD_L(fa0, q + 8);
            HY_MMA2(fa1, fb1);
            d1 -= 2; q += 8;
            if (++cs.cnt == CV_EVERY) { cs.cnt = 0; cv_finish(cs, lane, CV_PARGS); }
        }
        HY_MMA1(fa0, fb0, fa1); HY_MMA2(fa0, fb0);
        }
        if (MK_HY_SWEEPS == 2) { acc0 *= 0.5f; acc1 *= 0.5f; }
#ifdef MK_HY_XMFMA
        asm volatile("" :: "v"(dacc0));
#endif
        asm volatile("" ::: "memory");
        v2u gw[2][4];
#pragma unroll
        for (int mt = 0; mt < 2; ++mt)
#pragma unroll
            for (int g = 0; g < 4; ++g) gw[mt][g] = *(const v2u*)(gate + t1 * 64 + 32 * mt + 8 * g + 4 * h);
        v2u kpv[2][4]; v2u* stash;
        { int st = tid * 8; asm volatile("" : "+v"(st)); stash = stash0 + st; }
        if (PAIR == 1 && o == 1) {
#pragma unroll
            for (int i = 0; i < 4; ++i) { const v4u w = ((const v4u*)stash)[i]; kpv[i >> 1][2 * (i & 1)] = v2u{w.x, w.y}; kpv[i >> 1][2 * (i & 1) + 1] = v2u{w.z, w.w}; } }
        __syncthreads();
#pragma unroll
        for (int mt = 0; mt < 2; ++mt)
#pragma unroll
            for (int g = 0; g < 4; ++g) { const int t0 = 32 * mt + 8 * g + 4 * h; const v2u gwv = gw[mt][g];
                const f32x16& a = mt ? acc1 : acc0;
                const float y0 = a[4 * g] * bflo(gwv.x), y1 = a[4 * g + 1] * bfhi(gwv.x), y2 = a[4 * g + 2] * bflo(gwv.y), y3 = a[4 * g + 3] * bfhi(gwv.y);
                if (o == 0) { v2u w; w.x = pk2(y0, y1); w.y = pk2(y2, y3); *(LAS v2u*)(zl + b * ZB + (32 + t1) * ZROW + t0 * 2) = w; }
                else if (PAIR == 0) { v2u w; w.x = pk2(y0, y1); w.y = pk2(y2, y3); stash[mt * 4 + g] = w; }
                else { unsigned* yo = (unsigned*)(YH + ((size_t)b * S + t1 * 64 + t0) * C + (c - 1)); const v2u kp = kpv[mt][g];
                    yo[0] = (kp.x & 0xffffu) | (f2bf(y0) << 16); yo[C / 2] = (kp.x >> 16) | (f2bf(y1) << 16); yo[C] = (kp.y & 0xffffu) | (f2bf(y2) << 16); yo[3 * C / 2] = (kp.y >> 16) | (f2bf(y3) << 16); } }
    }
    __syncthreads();
}
#undef HY_LDA
#undef HY_LOAD_E
#undef HY_LOAD_L
#undef HY_MMA1
#undef HY_MMA2
}
}
namespace mk {
#define GAS __attribute__((address_space(1)))
typedef GAS unsigned gu32;
typedef GAS unsigned long long gu64;
#define RLX_AGENT __ATOMIC_RELAXED, __HIP_MEMORY_SCOPE_AGENT
#define LDS_WAIT() asm volatile("s_waitcnt lgkmcnt(0)" ::: "memory")
#define VM_WAIT() asm volatile("s_waitcnt vmcnt(0)" ::: "memory")
__device__ __forceinline__ unsigned long long rt() { return __builtin_amdgcn_s_memrealtime(); }
#define XB_TMO      128
#define XB_XCNT(j)  (256  + 64 * (j))
#define XB_XSUB(j)  (1280 + 64 * (j))
#define XB_XGEN(j)  (2304 + 64 * (j))
#define XB_TOP      3328
#define XB_TOPGEN   3392
#define XCD_BAR_WORDS 3456
#define XB_SPIN_CAP (1u << 18)

__device__ __forceinline__ unsigned xb_ld(unsigned* p)              { return __hip_atomic_load(p, __ATOMIC_RELAXED, __HIP_MEMORY_SCOPE_AGENT); }
__device__ __forceinline__ unsigned xb_add(unsigned* p, unsigned v) { return __hip_atomic_fetch_add(p, v, __ATOMIC_RELAXED, __HIP_MEMORY_SCOPE_AGENT); }
__device__ __forceinline__ unsigned xb_xcc_id() { return (unsigned)__builtin_amdgcn_s_getreg((3 << 11) | 20) & 0xFu; }
#define XB_SPIN(cond, bar) do { unsigned _sp = 0; while (cond) { __builtin_amdgcn_s_sleep(1); \
    if ((++_sp & 255u) == 0u) { if (xb_ld(&(bar)[XB_TMO])) break; if (_sp > XB_SPIN_CAP) { atomicAdd(&(bar)[XB_TMO], 1u); break; } } } } while (0)

struct XcdBarrier {
    unsigned* bar; unsigned x;
    volatile LAS unsigned* st;
};

__device__ __forceinline__ XcdBarrier xcd_barrier_post(unsigned* bar, volatile LAS unsigned* st) {
    XcdBarrier b; b.bar = bar; b.x = xb_xcc_id(); b.st = st;
    if (threadIdx.x == 0) (void)xb_add(&bar[XB_XCNT(b.x)], 1u);
    return b;
}
__device__ __forceinline__ void xcd_barrier_complete(unsigned* bar, unsigned x, unsigned& nloc, unsigned& nx) {
    const unsigned G = gridDim.x * gridDim.y * gridDim.z;
    unsigned sum, cnt, mine, sp = 0u;
    for (;;) {
        sum = 0u; cnt = 0u; mine = 0u;
#pragma unroll
        for (unsigned j = 0; j < 16; ++j) { const unsigned c = xb_ld(&bar[XB_XCNT(j)]); sum += c; cnt += (c > 0u) ? 1u : 0u; mine = (j == x) ? c : mine; }
        if (sum == G) break;
        __builtin_amdgcn_s_sleep(1);
        if ((++sp & 255u) == 0u) { if (xb_ld(&bar[XB_TMO])) break; if (sp > XB_SPIN_CAP) { atomicAdd(&bar[XB_TMO], 1u); break; } }
    }
    nloc = mine > 0u ? mine : 1u; nx = cnt > 0u ? cnt : 1u;
}

__device__ __forceinline__ void xcd_barrier(const XcdBarrier& b, int wave_s) {
    asm volatile("s_waitcnt vmcnt(0)" ::: "memory");
    __syncthreads();
    if (fresh_tid(wave_s) == 0) {
        unsigned* bar = b.bar;
        __builtin_amdgcn_s_waitcnt(0);
        unsigned nloc = b.st[0], nx = b.st[1];
        if (nloc == 0u) { xcd_barrier_complete(bar, b.x, nloc, nx); b.st[0] = nloc; b.st[1] = nx; }
        const unsigned old = xb_add(&bar[XB_XSUB(b.x)], 1u);
        const unsigned gen = old / nloc;
        if (old + 1u == (gen + 1u) * nloc) {
            __builtin_amdgcn_fence(__ATOMIC_RELEASE, "agent");
            asm volatile("s_waitcnt vmcnt(0)" ::: "memory");
            const unsigned og = xb_add(&bar[XB_TOP], 1u);
            const unsigned tg = og / nx;
            if (og + 1u == (tg + 1u) * nx) xb_add(&bar[XB_TOPGEN], 1u);
            else XB_SPIN(xb_ld(&bar[XB_TOPGEN]) == tg, bar);
            __builtin_amdgcn_fence(__ATOMIC_ACQUIRE, "agent");
            xb_add(&bar[XB_XGEN(b.x)], 1u);
            asm volatile("s_waitcnt vmcnt(0)" ::: "memory");
        } else {
            XB_SPIN(xb_ld(&bar[XB_XGEN(b.x)]) == gen, bar);
            __builtin_amdgcn_fence(__ATOMIC_ACQUIRE, "agent");
            asm volatile("s_waitcnt vmcnt(0)" ::: "memory");
        }
    }
    __syncthreads();
}

}
namespace mk {
namespace cg = cooperative_groups;
constexpr int PH_PER_LAYER = 9, N_PHASES = 1 + 2 * PH_PER_LAYER;

__device__ __forceinline__ float lam_of(const Args& a, int l, float lam_init) {
    const float *q1 = a.in[14] + l * 64, *k1 = a.in[15] + l * 64, *q2 = a.in[16] + l * 64, *k2 = a.in[17] + l * 64;
    float s1 = 0.f, s2 = 0.f; for (int i = 0; i < 64; ++i) { s1 += q1[i] * k1[i]; s2 += q2[i] * k2[i]; }
    return expf(s1) - expf(s2) + lam_init;
}

typedef const __attribute__((address_space(4))) Args* KArgPtr;
__global__ void __launch_bounds__(NTH, 2) fwd(Args a_byval) {
    extern __shared__ __attribute__((aligned(16))) unsigned char lds_raw[];
    cg::grid_group grid = cg::this_grid();
    const int ph_lo = a_byval.ph_lo, ph_hi = a_byval.ph_hi;
    const int wave_s = __builtin_amdgcn_readfirstlane((int)threadIdx.x >> 6);
    volatile LAS unsigned* bar_st = (volatile LAS unsigned*)((LAS unsigned char*)lds_raw + LDS_BYTES - 64);
    if (threadIdx.x == 0) { bar_st[0] = 0u; bar_st[1] = 0u; }
    __syncthreads();
    const XcdBarrier bar = xcd_barrier_post((unsigned*)a_byval.ws, bar_st);
    int rep_flag = 0;
    for (int ph = ph_lo; ph < ph_hi; ++ph) {
        KArgPtr ap = (KArgPtr)__builtin_amdgcn_kernarg_segment_ptr(); asm volatile("" : "+s"(ap));
        const Args a = *(const Args*)ap;
        bf16* Xr = (bf16*)(a.ws + WS_X);
        Ctx X; X.wave_s = wave_s; X.wave = wave_s; X.tid = 0; X.lane = 0;
#define FRESH() do { X.tid = fresh_tid(wave_s); X.lane = X.tid & 63; } while (0)
        { int g_ = gridDim.x, b_ = blockIdx.x; asm volatile("" : "+s"(g_), "+s"(b_)); X.G = g_; X.bid = b_; }
        { const int bx = X.bid; X.vcu = (X.G % 8 == 0) ? (bx % 8) * (X.G / 8) + bx / 8 : bx; }
        X.gw = X.vcu * NWAVES + X.wave; X.ngw = X.G * NWAVES; X.lds = (LAS unsigned char*)lds_raw; X.ws = a.ws;
#ifndef MK_EN
#define MK_EN 0xFFFF
#endif
#ifndef MK_ATT
#define MK_ATT 3
#endif
#ifndef MK_REP_SP
#define MK_REP_SP 99
#endif
        if (ph == 0) { if (MK_EN & 512) { FRESH(); p0_prologue(X, a); } }
        else {
            const int l = (ph - 1) / PH_PER_LAYER, sp = (ph - 1) % PH_PER_LAYER;
            const float lam_init = 0.8f - 0.6f * expf(-0.3f * (float)l);
            if (0) {}
#if MK_EN & 1
            else if (sp == 0) {
                FRESH();
                pg8::Gemm g{(const bf16*)(a.ws + (l == 0 ? WS_XN : WS_X)), (const bf16*)(a.ws + WS_WIN) + (size_t)l * INW * D, T, INW, D};
                pg8::StaticOrder So; So.init(T, INW, X.G, X.bid);
                EpiWin Ep{a.ws, (const float*)(a.ws + WS_BINP) + l * INW, (const float*)(a.ws + WS_ROPE), (const float*)(a.ws + WS_RMIX)};
                pg8::gemm_phase<EpiWin, pg8::StaticOrder, true, true>(X.lds, g, So, Ep, X.tid);
            }
#endif
#if MK_EN & 2
            else if (sp == 1) {
                FRESH();
                p1t_shortconv(X, a.in[4] + l * 3 * 1536, a.in[5] + l * 1536);
                p1t_kmax(X, (unsigned*)(a.ws + 14336) + l * 32);
            }
#endif
#if MK_EN & 4
            else if (sp == 2) {
                FRESH();
                const float lam = lam_of(a, l, lam_init);
                const int c = X.bid;
#ifndef MK_REP_ATT
#define MK_REP_ATT 1
#endif
#ifndef MK_CONV_REP
#define MK_CONV_REP 1
#endif
#ifndef MK_REP_HY
#define MK_REP_HY 1
#endif
#ifndef CV_ME_SWEEP
#define CV_ME_SWEEP 32
#endif
                const int cg_ = X.vcu & 3;
                if (cg_ == 0) { __syncthreads(); p0_experts_rest(relaunder(X), a, l, CV_ME_SWEEP); __syncthreads(); }
                for (int rep = 0; rep < MK_REP_ATT; ++rep) for (int u = c; u < 256; u += X.G) { const int bh = 2 * (u & 7) + ((u >> 3) >> 4), qb = (u >> 3) & 15; at::attn_unit(X, bh >> 2, bh & 3, qb, lam, 1.0f - lam_init, a.in[18] + l * 128, (unsigned*)(a.ws + 14336) + l * 32); }
                if (cg_ == 1) { __syncthreads(); p0_experts_rest(relaunder(X), a, l, CV_ME_SWEEP); __syncthreads(); }
                hy::CvState cs; const float* cwg = a.in[25] + (size_t)l * E * D * F; const float* cwu = a.in[26] + (size_t)l * E * D * F; const float* cwd = a.in[27] + (size_t)l * E * D * F; const float* cgn = a.in[22] + l * D;
                bf16* ctgu = (bf16*)(a.ws + WS_WGU) + (size_t)l * E * 2 * F * D; bf16* ctd = (bf16*)(a.ws + WS_WD) + (size_t)l * E * F * D;
                cs.next = __builtin_amdgcn_readfirstlane(X.bid * NWAVES + wave_s); cs.stride = __builtin_amdgcn_readfirstlane(X.G * NWAVES); cs.nlim = CV_ME_SWEEP * 2048; cs.cnt = 0; cs.par = 0;
                cs.a.have = cs.b.have = -1; cs.a.ld0 = cs.a.ld1 = cs.a.ld2 = cs.a.ld3 = cs.b.ld0 = cs.b.ld1 = cs.b.ld2 = cs.b.ld3 = f32x4{0.f, 0.f, 0.f, 0.f}; cs.a.sc = cs.b.sc = 1.f;
                hy::cv_issue(cs, cs.a, fresh_tid(wave_s) & 63, CV_PARGS); hy::cv_issue(cs, cs.b, fresh_tid(wave_s) & 63, CV_PARGS);
                for (int rep = 0; rep < MK_REP_HY; ++rep) for (int u = c; u < 256; u += X.G) { const int ch = 64 * (u & 7) + 2 * (u >> 3); hy::channel<0>(relaunder(X), l, ch, a.in[13], cs, CV_PARGS);
                    if (cg_ == 2) { __syncthreads(); p0_experts_rest(relaunder(X), a, l, CV_ME_SWEEP); __syncthreads(); }
                    hy::channel<1>(relaunder(X), l, ch + 1, a.in[13], cs, CV_PARGS); }
                while (cs.a.have >= 0 || cs.b.have >= 0) hy::cv_finish(cs, fresh_tid(wave_s) & 63, CV_PARGS);
                if (cg_ == 3) { __syncthreads(); p0_experts_rest(relaunder(X), a, l, CV_ME_SWEEP); __syncthreads(); }
            }
#endif
#if MK_EN & 8
            else if (sp == 3) {
                FRESH();
                OrderMerge So; So.so.init(T, D, X.G, X.bid);
                pg8::Gemm g{(const bf16*)(a.ws + WS_YH), (const bf16*)(a.ws + WS_WUH) + (size_t)l * 2 * D * C, 2 * T, 2 * D, C};
                EpiMerge2 Ep{(const bf16*)(a.ws + WS_GH), (const bf16*)(a.ws + WS_GA), (bf16*)(a.ws + WS_MG)};
                pg8::gemm_phase<EpiMerge2, OrderMerge, true, true>(X.lds, g, So, Ep, X.tid);
            }
#endif
#if MK_EN & 16
            else if (sp == 4) {
                FRESH();
                pg8::Gemm g{(const bf16*)(a.ws + WS_MG), (const bf16*)(a.ws + WS_WOUT) + (size_t)l * D * D, T, D, D};
                pg8::StaticOrder So; So.init(T, D, X.G, X.bid);
                EpiOutR Ep{l == 0 ? (const bf16*)(a.ws + WS_XN) : (const bf16*)Xr, (bf16*)(a.ws + WS_XN), (float*)(a.ws + WS_PART), (const bf16*)(a.ws + WS_WRP) + (size_t)l * 2 * E * D, (unsigned*)(a.ws + 15360) + l * 64, (float*)(a.ws + WS_AFFT), (float*)(a.ws + WS_RTOK), a.in[24] + l * E};
                pg8::gemm_phase<EpiOutR, pg8::StaticOrder, true, true>(X.lds, g, So, Ep, X.tid);
            }
#endif
#if MK_EN & 32
            else if (sp == 5) { FRESH(); p6_topk(X);
            }
#endif
#if MK_EN & 64
            else if (sp == 6) {
                FRESH();
                pg8::Gemm g{(const bf16*)(a.ws + WS_XN), (const bf16*)(a.ws + WS_WGU) + (size_t)l * E * 2 * F * D, E * 2048, 2 * F, D, 2 * F, 4, (size_t)2 * F * D * 2, (const int*)(a.ws + WS_ROWS)};
                OrderMoE1 So{X.G, X.bid}; EpiSwiGLU Ep{(bf16*)(a.ws + WS_HB), (const float*)(a.ws + WS_RSL)};
                pg8::gemm_phase<EpiSwiGLU, OrderMoE1, true, true, true, true>(X.lds, g, So, Ep, X.tid);
            }
#endif
#if MK_EN & 128
            else if (sp == 7) {
                FRESH();
                pg8::Gemm g{(const bf16*)(a.ws + WS_HB), (const bf16*)(a.ws + WS_WD) + (size_t)l * E * D * F, E * 2048, D, F, D, 2, (size_t)D * F * 2};
                OrderMoE2 So{X.G, X.bid}; EpiDown Ep{(bf16*)(a.ws + WS_YE), (const float*)(a.ws + WS_GATE)};
                pg8::gemm_phase<EpiDown, OrderMoE2, true, true, true>(X.lds, g, So, Ep, X.tid);
            }
#endif
#if MK_EN & 256
            else if (sp == 8) {
                FRESH();
                p9_combine(X, Xr, l == 0 ? a.in[1] + D : a.in[28], l == 1, a.out);
            }
#endif
        }
#ifndef MK_EXTRA_SYNC
#define MK_EXTRA_SYNC 0
#endif
        if (ph + 1 < ph_hi) { if (ph_hi > 4096) grid.sync(); else xcd_barrier(bar, wave_s); }
        for (int es = 0; es < MK_EXTRA_SYNC; ++es) xcd_barrier(bar, wave_s);
        if (MK_REP_SP != 99) { const int sp_ = ph == 0 ? -1 : (ph - 1) % PH_PER_LAYER; if (sp_ == MK_REP_SP && rep_flag == 0) { rep_flag = 1; --ph; } else rep_flag = 0; }
    }
}

static int g_grid = 0;
static bool mega_setup() {
    if (g_grid) return g_grid > 0;
    int dev = 0, cus = 0, per_cu = 0;
    if (hipGetDevice(&dev) != hipSuccess || hipDeviceGetAttribute(&cus, hipDeviceAttributeMultiprocessorCount, dev) != hipSuccess) { g_grid = -1; return false; }
    if (hipFuncSetAttribute((const void*)fwd, hipFuncAttributeMaxDynamicSharedMemorySize, LDS_BYTES) != hipSuccess) { fprintf(stderr, "hipFuncSetAttribute failed\n"); g_grid = -1; return false; }
    if (hipOccupancyMaxActiveBlocksPerMultiprocessor(&per_cu, (const void*)fwd, NTH, LDS_BYTES) != hipSuccess || per_cu < 1) { fprintf(stderr, "occupancy query failed (%d)\n", per_cu); g_grid = -1; return false; }
    g_grid = cus * 1;
    return true;
}
static void mega_launch(hipStream_t st, void* const* d_in, float* d_out, unsigned char* ws, int ph_lo, int ph_hi, int p0_mask) {
    if (!mega_setup()) return;
    Args a{};
    for (int i = 0; i < 29; ++i) a.in[i] = (const float*)d_in[i];
    a.out = d_out; a.ws = ws; a.ph_lo = ph_lo; a.ph_hi = ph_hi; a.p0_mask = p0_mask; a.pad = 0;
    if (hipMemsetAsync(ws, 0, 16384, st) != hipSuccess) { fprintf(stderr, "memset of the barrier words failed\n"); return; }
    void* args[] = {&a};
    const hipError_t e = hipLaunchCooperativeKernel((const void*)fwd, dim3(g_grid), dim3(NTH), args, LDS_BYTES, st);
    if (e != hipSuccess) fprintf(stderr, "cooperative launch failed: %s (grid %d)\n", hipGetErrorString(e), g_grid);
}
}
extern "C" void kernel_launch(void* const* d_in, const int* in_sizes, int n_in, void* d_out, int out_size, void* d_ws, size_t ws_size, hipStream_t stream) {
    if (n_in != 29 || out_size != mk::T * mk::D || ws_size < mk::WS_END) { fprintf(stderr, "kernel_launch: unexpected sizes n_in %d out %d ws %zu\n", n_in, out_size, ws_size); return; }
    mk::mega_launch(stream, d_in, (float*)d_out, (unsigned char*)d_ws, 0, mk::N_PHASES, 13);
}
```
